# Optimizing an MI355X kernel written in HIP

```python
import jax, jax.numpy as jnp
from jax import lax
import numpy as np

D_MODEL = 1024
BATCH = 8
SEQ = 4096
DEPTH = 4

LRU_WIDTH = D_MODEL
LRU_HEADS = 8
LRU_HEAD_DIM = LRU_WIDTH // LRU_HEADS
CONV_WIDTH = 4
LRU_C = 8.0
POOL_WINDOWS = (2, 4, 8, 16)
POOL_GROUPS = len(POOL_WINDOWS)
POOL_WIDTH = D_MODEL // 2
POOL_GROUP_DIM = POOL_WIDTH // POOL_GROUPS
N_BRANCHES = 2
IN_PROJ_WIDTH = 2 * LRU_WIDTH + POOL_WIDTH + N_BRANCHES * D_MODEL
N_EXPERTS = 32
TOP_K = 4
D_FF_EXPERT = D_MODEL
SWIGLU_LIMIT = 7.0
SWIGLU_ALPHA = 1.702
EXPERT_BLOCK = 128
NORM_EPS = 1e-6

kernel_name = 'hybrid_rglru_pool_moe_adaln'


def _rmsnorm(x, g):
    xf = x.astype(jnp.float32)
    y = xf * lax.rsqrt(jnp.mean(xf * xf, axis=-1, keepdims=True) + NORM_EPS)
    return (y * g.astype(jnp.float32)).astype(x.dtype)


def _modulate(h, shift, scale):
    return h * (1 + scale[:, None, :]) + shift[:, None, :]


def _block_diag(x, w):
    bsz, s, _ = x.shape
    n, di, do = w.shape
    y = jnp.einsum('bsgi,gio->bsgo', x.reshape(bsz, s, n, di), w)
    return y.reshape(bsz, s, n * do)


def _causal_depthwise_conv(x, w, b):
    y = lax.conv_general_dilated(x, w[:, None, :], window_strides=(1,), padding=[(CONV_WIDTH - 1, 0)], dimension_numbers=('NWC', 'WIO', 'NWC'), feature_group_count=x.shape[-1])
    return y + b


def _rg_lru(x, w_a, b_a, w_x, b_x, lam):
    r = jax.nn.sigmoid((_block_diag(x, w_a) + b_a).astype(jnp.float32))
    i = jax.nn.sigmoid((_block_diag(x, w_x) + b_x).astype(jnp.float32))
    log_a = -LRU_C * r * jax.nn.softplus(-lam.astype(jnp.float32))
    a = jnp.exp(log_a)
    mult = jnp.sqrt(-jnp.expm1(2.0 * log_a))
    u = mult * (i * x.astype(jnp.float32))

    def combine(left, right):
        a_l, b_l = left
        a_r, b_r = right
        return a_l * a_r, a_r * b_l + b_r

    _, h = lax.associative_scan(combine, (a, u), axis=1)
    return h.astype(x.dtype)


def _multiscale_pool(x):
    bsz, s, _ = x.shape
    xf = x.astype(jnp.float32)
    cs = lax.cumsum(xf, axis=1)
    w_max = max(POOL_WINDOWS)
    cs_pad = jnp.pad(cs, ((0, 0), (w_max, 0), (0, 0)))
    t = jnp.arange(s, dtype=jnp.float32)
    outs = []
    for g, w in enumerate(POOL_WINDOWS):
        lo, hi = g * POOL_GROUP_DIM, (g + 1) * POOL_GROUP_DIM
        win_sum = cs[:, :, lo:hi] - cs_pad[:, w_max - w:w_max - w + s, lo:hi]
        count = jnp.minimum(t + 1.0, float(w))[None, :, None]
        outs.append(win_sum / count - xf[:, :, lo:hi])
    return jnp.concatenate(outs, axis=-1).astype(x.dtype)


def _hybrid_mixer(h, w_in, conv_w, conv_b, w_rg_a, b_rg_a, w_rg_x, b_rg_x, lam, w_pool, pool_scale, w_up_a, w_up_b, w_out):
    bsz, s, _ = h.shape
    z = h @ w_in
    o1 = LRU_WIDTH
    o2 = o1 + LRU_WIDTH
    o3 = o2 + POOL_WIDTH
    x_lru, g_lru, x_pool, gate_logits = z[..., :o1], z[..., o1:o2], z[..., o2:o3], z[..., o3:]
    y_lru = _rg_lru(_causal_depthwise_conv(x_lru, conv_w, conv_b), w_rg_a, b_rg_a, w_rg_x, b_rg_x, lam)
    y_lru = y_lru * jax.nn.gelu(g_lru)
    y_pool = _block_diag(_multiscale_pool(x_pool), w_pool) * pool_scale
    p_a = y_lru @ w_up_a
    p_b = y_pool @ w_up_b
    gates = jax.nn.sigmoid(gate_logits).reshape(bsz, s, N_BRANCHES, D_MODEL)
    merged = gates[:, :, 0, :] * p_a + gates[:, :, 1, :] * p_b
    return merged @ w_out


def _moe(h, w_router, b_router, w_e_in, b_e_in, w_e_out, b_e_out):
    bsz, s, d = h.shape
    n_tok = bsz * s
    ht = h.reshape(n_tok, d)
    logits = (ht @ w_router + b_router).astype(jnp.float32)
    top_vals, top_idx = lax.top_k(logits, TOP_K)
    weights = jax.nn.softmax(top_vals, axis=-1)
    n_assign = n_tok * TOP_K
    flat_e = top_idx.reshape(n_assign).astype(jnp.int32)
    flat_tok = jnp.repeat(jnp.arange(n_tok, dtype=jnp.int32), TOP_K)
    flat_w = weights.reshape(n_assign)
    order = jnp.argsort(flat_e)
    sorted_e = flat_e[order]
    sorted_tok = flat_tok[order]
    sorted_w = flat_w[order]
    counts = jnp.bincount(flat_e, length=N_EXPERTS)
    padded = ((counts + EXPERT_BLOCK - 1) // EXPERT_BLOCK) * EXPERT_BLOCK
    start_sorted = jnp.cumsum(counts) - counts
    pad_end = jnp.cumsum(padded)
    start_pad = pad_end - padded
    dest = start_pad[sorted_e] + jnp.arange(n_assign, dtype=jnp.int32) - start_sorted[sorted_e]
    n_blocks = -(-n_assign // EXPERT_BLOCK) + N_EXPERTS
    n_slots = n_blocks * EXPERT_BLOCK
    buf_tok = jnp.zeros((n_slots,), jnp.int32).at[dest].set(sorted_tok)
    buf_w = jnp.zeros((n_slots,), jnp.float32).at[dest].set(sorted_w)
    block_start = jnp.arange(n_blocks, dtype=jnp.int32) * EXPERT_BLOCK
    block_e = jnp.minimum(jnp.searchsorted(pad_end, block_start, side='right'), N_EXPERTS - 1).astype(jnp.int32)

    def expert_block(args):
        tok, e = args
        xb = ht[tok]
        gu = xb @ w_e_in[e] + b_e_in[e]
        gate, up = gu[:, :D_FF_EXPERT], gu[:, D_FF_EXPERT:]
        gate = jnp.minimum(gate, SWIGLU_LIMIT)
        up = jnp.clip(up, -SWIGLU_LIMIT, SWIGLU_LIMIT)
        act = gate * jax.nn.sigmoid(SWIGLU_ALPHA * gate) * (up + 1)
        return act @ w_e_out[e] + b_e_out[e]

    outs = lax.map(expert_block, (buf_tok.reshape(n_blocks, EXPERT_BLOCK), block_e))
    y = jnp.zeros((n_tok, d), jnp.float32).at[buf_tok].add(outs.reshape(n_slots, d).astype(jnp.float32) * buf_w[:, None])
    return y.reshape(bsz, s, d).astype(h.dtype)


def setup_inputs(seed: int = 0) -> dict:
    key = jax.random.key(seed)
    ks = jax.random.split(key, 26)
    f32 = jnp.float32
    L, D = DEPTH, D_MODEL

    def nrm(k, shape, scale):
        return jax.random.normal(k, shape, f32) * scale

    u = jax.random.uniform(ks[14], (L, LRU_WIDTH), f32, 0.9, 0.999)
    s = u ** (1.0 / LRU_C)
    lru_lambda = jnp.log(s) - jnp.log1p(-s)
    return {
        'x': nrm(ks[0], (BATCH, SEQ, D), 1.0),
        'c': nrm(ks[1], (BATCH, D), 1.0),
        'norm1_g': 1.0 + nrm(ks[2], (L, D), 0.05),
        'norm2_g': 1.0 + nrm(ks[3], (L, D), 0.05),
        'w_ada': nrm(ks[4], (L, D, 6 * D), 0.5 * D ** -0.5),
        'b_ada': nrm(ks[5], (L, 6 * D), 0.02),
        'w_in': nrm(ks[6], (L, D, IN_PROJ_WIDTH), D ** -0.5),
        'conv_w': nrm(ks[7], (L, CONV_WIDTH, LRU_WIDTH), CONV_WIDTH ** -0.5),
        'conv_b': nrm(ks[8], (L, LRU_WIDTH), 0.02),
        'w_rg_a': nrm(ks[9], (L, LRU_HEADS, LRU_HEAD_DIM, LRU_HEAD_DIM), LRU_HEAD_DIM ** -0.5),
        'b_rg_a': nrm(ks[10], (L, LRU_WIDTH), 0.1),
        'w_rg_x': nrm(ks[11], (L, LRU_HEADS, LRU_HEAD_DIM, LRU_HEAD_DIM), LRU_HEAD_DIM ** -0.5),
        'b_rg_x': nrm(ks[12], (L, LRU_WIDTH), 0.1),
        'lru_lambda': lru_lambda,
        'w_pool': nrm(ks[13], (L, POOL_GROUPS, POOL_GROUP_DIM, POOL_GROUP_DIM), POOL_GROUP_DIM ** -0.5),
        'pool_scale': 1.0 + nrm(ks[15], (L, POOL_WIDTH), 0.1),
        'w_up_a': nrm(ks[16], (L, LRU_WIDTH, D), LRU_WIDTH ** -0.5),
        'w_up_b': nrm(ks[17], (L, POOL_WIDTH, D), POOL_WIDTH ** -0.5),
        'w_out': nrm(ks[18], (L, D, D), D ** -0.5),
        'w_router': nrm(ks[19], (L, D, N_EXPERTS), D ** -0.5),
        'b_router': nrm(ks[20], (L, N_EXPERTS), 0.01),
        'w_e_in': nrm(ks[21], (L, N_EXPERTS, D, 2 * D_FF_EXPERT), D ** -0.5),
        'b_e_in': nrm(ks[22], (L, N_EXPERTS, 2 * D_FF_EXPERT), 0.02),
        'w_e_out': nrm(ks[23], (L, N_EXPERTS, D_FF_EXPERT, D), D_FF_EXPERT ** -0.5),
        'b_e_out': nrm(ks[24], (L, N_EXPERTS, D), 0.02),
        'final_g': 1.0 + nrm(ks[25], (D,), 0.05),
    }


def reference(x, c, norm1_g, norm2_g, w_ada, b_ada, w_in, conv_w, conv_b, w_rg_a, b_rg_a, w_rg_x, b_rg_x, lru_lambda, w_pool, pool_scale, w_up_a, w_up_b, w_out, w_router, b_router, w_e_in, b_e_in, w_e_out, b_e_out, final_g):
    c_act = jax.nn.silu(c)
    for l in range(DEPTH):
        mod = c_act @ w_ada[l] + b_ada[l]
        shift1, scale1, gate1, shift2, scale2, gate2 = jnp.split(mod, 6, axis=-1)
        h = _modulate(_rmsnorm(x, norm1_g[l]), shift1, scale1)
        mix = _hybrid_mixer(h, w_in[l], conv_w[l], conv_b[l], w_rg_a[l], b_rg_a[l], w_rg_x[l], b_rg_x[l], lru_lambda[l], w_pool[l], pool_scale[l], w_up_a[l], w_up_b[l], w_out[l])
        x = x + gate1[:, None, :] * mix
        h = _modulate(_rmsnorm(x, norm2_g[l]), shift2, scale2)
        ffn = _moe(h, w_router[l], b_router[l], w_e_in[l], b_e_in[l], w_e_out[l], b_e_out[l])
        x = x + gate2[:, None, :] * ffn
    return _rmsnorm(x, final_g)
```

```cpp
#include <hip/hip_runtime.h>
#include <cstdio>
#include <cstdint>

#ifndef MK_PER_PHASE
#define MK_PER_PHASE 0
#endif

#define LAS __attribute__((address_space(3)))
typedef unsigned short bf16_t;
typedef short bf16x8 __attribute__((ext_vector_type(8)));
typedef float f32x4 __attribute__((ext_vector_type(4)));
typedef float f32x2 __attribute__((ext_vector_type(2)));
typedef float f32x16 __attribute__((ext_vector_type(16)));
typedef unsigned u32x4 __attribute__((ext_vector_type(4)));
typedef unsigned u32x2 __attribute__((ext_vector_type(2)));

constexpr int D = 1024, NBATCH = 8, SEQ = 4096, T = NBATCH * SEQ, DEPTH = 4;
constexpr int NZ = 4608, ZO_GLRU = 1024, ZO_XPOOL = 2048, ZO_GL0 = 2560, ZO_GL1 = 3584;
constexpr int NE = 32, TOPK = 4;
constexpr int KCAT = 1536;
constexpr int SLOT_CAP = T * TOPK + NE * 256;
constexpr int MAX_MT = SLOT_CAP / 256;
constexpr float NORM_EPS = 1e-6f;
constexpr int NTHREADS = 512, NWAVES = 8;

constexpr size_t MiB = 1u << 20;
constexpr size_t WS_CTL = 0, CTL_ZERO_BYTES = 256 * 1024;
constexpr size_t WS_MOD = 1 * MiB;
constexpr size_t WS_CB = 2 * MiB;
constexpr size_t WS_AGG = 3 * MiB;
constexpr size_t WS_TOKOF = 6 * MiB;
constexpr size_t WS_SLOTINFO = 10 * MiB;
constexpr size_t WS_WGT = 11 * MiB;
constexpr size_t WS_WRG = 12 * MiB;
constexpr size_t WS_WPOOL = 14 * MiB;
constexpr size_t WS_WIN = 16 * MiB;
constexpr size_t WS_WCAT = 52 * MiB;
constexpr size_t WS_WOUT = 64 * MiB;
constexpr size_t WS_WEIN = 128 * MiB;
constexpr size_t WS_WEOUT = 640 * MiB;
constexpr size_t WS_XRES = 896 * MiB;
constexpr size_t WS_H = 1024 * MiB;
constexpr size_t WS_Z = 1088 * MiB;
constexpr size_t WS_ACAT = 1376 * MiB;
constexpr size_t WS_MERGED = 1472 * MiB;
constexpr size_t WS_ACT = 1536 * MiB;
constexpr size_t WS_OUTB = 1808 * MiB;
constexpr size_t WS_END = 2080 * MiB;
static_assert(WS_ACT + (size_t)SLOT_CAP * 1024 * 2 <= WS_OUTB && WS_OUTB + (size_t)SLOT_CAP * 1024 * 2 <= WS_END, "ws map");
constexpr int CW_BAR = 4096;
constexpr int CW_CNT = 8192;

constexpr int LDS_BYTES = 163840;
constexpr int LDS_TAB = 131072;
constexpr int LDS_MISC = LDS_BYTES - 256;

__device__ __forceinline__ unsigned cvt_pk_bf16(float lo, float hi) { unsigned r; asm("v_cvt_pk_bf16_f32 %0, %1, %2" : "=v"(r) : "v"(lo), "v"(hi)); return r; }
__device__ __forceinline__ float bflo(unsigned w) { return __uint_as_float(w << 16); }
__device__ __forceinline__ float bfhi(unsigned w) { return __uint_as_float(w & 0xffff0000u); }
__device__ __forceinline__ float bf1(bf16_t w) { return __uint_as_float(((unsigned)w) << 16); }
__device__ __forceinline__ float sigmoidf_(float x) { return __builtin_amdgcn_rcpf(1.0f + __expf(-x)); }
__device__ __forceinline__ float wave_sum(float v) {
#pragma unroll
    for (int o = 1; o < 64; o <<= 1) v += __shfl_xor(v, o);
    return v;
}
#define LDS_WAIT() asm volatile("s_waitcnt lgkmcnt(0)" ::: "memory")
#define VM_WAIT() asm volatile("s_waitcnt vmcnt(0)" ::: "memory")

namespace pg8 {
constexpr int BM = 256, BK = 64, HALF = 128, HTB = HALF * BK * 2, STAGE_BYTES = 8 * HTB, NXCD = 8, WGM = 8;
__host__ __device__ __forceinline__ int lds_byte(int r, int c) { const int st = (r >> 4) * 2 + (c >> 5), rr = r & 15, cc = c & 31, ob = rr * 64 + cc * 2; return st * 1024 + (ob ^ (((ob >> 9) & 1) << 5)); }
__host__ __device__ __forceinline__ void stage_rc(int b, int& R, int& C) { const int st = b / 1024, sb = b % 1024, swz = sb ^ (((sb >> 9) & 1) << 5); R = (st >> 1) * 16 + swz / 64; C = (st & 1) * 32 + (swz % 64) / 2; }
__host__ __device__ __forceinline__ int perm32(int rho) { const int n = rho >> 4, i = rho & 15; return 8 * (i >> 2) + 4 * n + (i & 3); }

struct Unit { int pm, pn, e, j, row0, rows; };

__device__ __forceinline__ bool order_map(int i, int G, int c, int nM, int nN, int& pm, int& pn) {
    const int nwg = nM * nN; const long L = (long)i * G + c; if (L >= nwg) return false;
    int wgid = (int)L; { const int q = nwg / NXCD, r = nwg % NXCD, xcd = wgid % NXCD, off = wgid / NXCD; wgid = (xcd < r ? xcd * (q + 1) : r * (q + 1) + (xcd - r) * q) + off; }
    const int nig = WGM * nN, gid = wgid / nig, fm = gid * WGM, gsz = (nM - fm) < WGM ? (nM - fm) : WGM;
    pm = fm + ((wgid % nig) % gsz); pn = (wgid % nig) / gsz; return true;
}

struct PlainSched {
    const char* A; const char* Bt; int K, nM, nN, G, c;
    __device__ __forceinline__ bool next(int i, Unit& u) const { int pm, pn; if (!order_map(i, G, c, nM, nN, pm, pn)) return false; u.pm = pm; u.pn = pn; u.e = 0; u.j = 0; u.row0 = pm * BM; u.rows = BM; return true; }
    __device__ __forceinline__ const char* a_base(const Unit& u) const { return A + (size_t)u.row0 * K * 2; }
    __device__ __forceinline__ const char* b_base(const Unit& u) const { return Bt + (size_t)u.pn * BM * K * 2; }
    __device__ __forceinline__ void a_voff(const Unit&, unsigned (&v)[2][2], const int (&R)[2], const int (&C)[2]) const {
#pragma unroll
        for (int h = 0; h < 2; ++h)
#pragma unroll
            for (int i = 0; i < 2; ++i) v[h][i] = (unsigned)((h * HALF + R[i]) * K + C[i]) * 2u;
    }
};

template <class Epi, class Sched, bool ALIGN_EPI>
__device__ __forceinline__ void gemm_phase(LAS unsigned char* lds, const int K, const Sched& S, const Epi& E) {
    int tid = threadIdx.x; asm volatile("" : "+v"(tid));
    const int wid = __builtin_amdgcn_readfirstlane(tid >> 6), lane = tid & 63, wr = wid >> 2, wc = wid & 3, fr = lane & 15, fq = lane >> 4;
    const int nt = K / BK;
    int Rr[2], Cc[2]; unsigned voffB[2];
#pragma unroll
    for (int i = 0; i < 2; ++i) { int R, C; stage_rc(tid * 16 + i * 8192, R, C); Rr[i] = R; Cc[i] = C; const int Rb = Epi::PERM ? ((R & ~31) + perm32(R & 31)) : R; voffB[i] = (unsigned)(Rb * K + C) * 2u; }
    const size_t kstep = (size_t)(BK * 2);
    const size_t hstep = (size_t)HALF * K * 2;
    const unsigned ldsw = (unsigned)wid * 1024u;
    const int aoff = lds_byte(wr * 64 + fr, fq * 8), boff = lds_byte(wc * 32 + fr, fq * 8);
#define PG8_SA(b, h) (((b) * 2 + (h)) * HTB)
#define PG8_SB(b, h) ((4 + (b) * 2 + (h)) * HTB)
#define PG8_STAGE(bufoff, gbase, voff) do { _Pragma("unroll") for (int _i = 0; _i < 2; ++_i) \
        __builtin_amdgcn_global_load_lds((const unsigned*)((const char*)(gbase) + (voff)[_i]), (LAS unsigned*)(lds + (bufoff) + ldsw + _i * 8192), 16, 0, 0); } while (0)
#define PG8_LDA(dst, b, h) do { _Pragma("unroll") for (int m = 0; m < 4; ++m) _Pragma("unroll") for (int k = 0; k < 2; ++k) dst[m][k] = *(const LAS bf16x8*)(lds + PG8_SA(b, h) + aoff + m * 2048 + k * 1024); } while (0)
#define PG8_LDB(dst, b, h) do { _Pragma("unroll") for (int n = 0; n < 2; ++n) _Pragma("unroll") for (int k = 0; k < 2; ++k) dst[n][k] = *(const LAS bf16x8*)(lds + PG8_SB(b, h) + boff + n * 2048 + k * 1024); } while (0)
#define PG8_MMA(ai, bj, At, Bt) do { __builtin_amdgcn_s_setprio(1); _Pragma("unroll") for (int m = 0; m < 4; ++m) _Pragma("unroll") for (int n = 0; n < 2; ++n) _Pragma("unroll") for (int k = 0; k < 2; ++k) \
        acc[ai][bj][m][n] = __builtin_amdgcn_mfma_f32_16x16x32_bf16(Bt[n][k], At[m][k], acc[ai][bj][m][n], 0, 0, 0); __builtin_amdgcn_s_setprio(0); } while (0)
#define PG8_WAIT_V(n) asm volatile("s_waitcnt vmcnt(" #n ")" ::: "memory")
#define PG8_WAIT_L(n) asm volatile("s_waitcnt lgkmcnt(" #n ")" ::: "memory")
#define PG8_BAR __builtin_amdgcn_s_barrier()
#define PG8_SCHED __builtin_amdgcn_sched_barrier(0)
    Unit cur, nxt; int ui = 0;
    if (!S.next(0, cur)) return;
    f32x4 acc[2][2][4][2];
#pragma unroll
    for (int a = 0; a < 2; ++a)
#pragma unroll
        for (int b = 0; b < 2; ++b)
#pragma unroll
            for (int m = 0; m < 4; ++m)
#pragma unroll
                for (int n = 0; n < 2; ++n) acc[a][b][m][n] = (f32x4){0.f, 0.f, 0.f, 0.f};
    bf16x8 At[4][2], B0[2][2], B1[2][2];
    unsigned cvA[2][2], nvA[2][2];
    S.a_voff(cur, cvA, Rr, Cc);
    const char* cA = S.a_base(cur); const char* cB = S.b_base(cur);
    PG8_STAGE(PG8_SB(0, 0), cB, voffB); PG8_STAGE(PG8_SB(0, 1), cB + hstep, voffB); PG8_STAGE(PG8_SA(0, 0), cA, cvA[0]); PG8_STAGE(PG8_SA(0, 1), cA, cvA[1]);
    if (wr == 1) PG8_BAR;
    PG8_WAIT_V(2); PG8_BAR;
    PG8_STAGE(PG8_SB(1, 0), cB + kstep, voffB); PG8_STAGE(PG8_SA(1, 0), cA + kstep, cvA[0]); PG8_STAGE(PG8_SB(1, 1), cB + hstep + kstep, voffB);
    PG8_WAIT_V(6); PG8_BAR;
    for (;;) {
        const bool has_next = S.next(ui + 1, nxt);
        const char* nA = cA; const char* nB = cB;
#pragma unroll
        for (int h = 0; h < 2; ++h)
#pragma unroll
            for (int i = 0; i < 2; ++i) nvA[h][i] = cvA[h][i];
        if (has_next) { nA = S.a_base(nxt); nB = S.b_base(nxt); S.a_voff(nxt, nvA, Rr, Cc); }
        for (int t = 0; t < nt; t += 2) {
            const bool last = (t == nt - 2);
            const char* a1 = cA + (size_t)(t + 1) * kstep;
            const char* a2 = last ? nA : cA + (size_t)(t + 2) * kstep; const char* b2 = last ? nB : cB + (size_t)(t + 2) * kstep;
            const char* a3 = a2 + kstep; const char* b3 = b2 + kstep;
            unsigned sA[2][2];
#pragma unroll
            for (int h = 0; h < 2; ++h)
#pragma unroll
                for (int i = 0; i < 2; ++i) sA[h][i] = last ? nvA[h][i] : cvA[h][i];
            if constexpr (Epi::HOOK_T >= 0) { if (t == Epi::HOOK_T) E.mid(acc, cur, wr, wc, fr, fq); }
            PG8_LDB(B0, 0, 0); PG8_LDB(B1, 0, 1); PG8_SCHED; PG8_LDA(At, 0, 0); PG8_STAGE(PG8_SA(1, 1), a1, cvA[1]);
            PG8_WAIT_V(8); PG8_WAIT_L(0); PG8_BAR; PG8_MMA(0, 0, At, B0); PG8_MMA(0, 1, At, B1); PG8_BAR; PG8_SCHED;
            PG8_LDA(At, 0, 1); PG8_STAGE(PG8_SB(0, 0), b2, voffB); PG8_STAGE(PG8_SB(0, 1), b2 + hstep, voffB); PG8_STAGE(PG8_SA(0, 0), a2, sA[0]);
            PG8_WAIT_V(8); PG8_WAIT_L(0); PG8_BAR; PG8_MMA(1, 0, At, B0); PG8_MMA(1, 1, At, B1); PG8_BAR; PG8_SCHED;
            PG8_LDB(B0, 1, 0); PG8_LDB(B1, 1, 1); PG8_SCHED; PG8_LDA(At, 1, 0); PG8_STAGE(PG8_SA(0, 1), a2, sA[1]);
            PG8_WAIT_V(8); PG8_WAIT_L(0); PG8_BAR; PG8_MMA(0, 0, At, B0); PG8_MMA(0, 1, At, B1); PG8_BAR; PG8_SCHED;
            PG8_LDA(At, 1, 1); PG8_STAGE(PG8_SB(1, 0), b3, voffB); PG8_STAGE(PG8_SB(1, 1), b3 + hstep, voffB); PG8_STAGE(PG8_SA(1, 0), a3, sA[0]);
            PG8_WAIT_V(8); PG8_WAIT_L(0); PG8_BAR; PG8_MMA(1, 0, At, B0); PG8_MMA(1, 1, At, B1); PG8_BAR; PG8_SCHED;
        }
        if constexpr (ALIGN_EPI) { if (wr == 0) PG8_BAR; }
        E(acc, cur, wr, wc, fr, fq);
        if (!has_next) break;
#pragma unroll
        for (int a = 0; a < 2; ++a)
#pragma unroll
            for (int b = 0; b < 2; ++b)
#pragma unroll
                for (int m = 0; m < 4; ++m)
#pragma unroll
                    for (int n = 0; n < 2; ++n) acc[a][b][m][n] = (f32x4){0.f, 0.f, 0.f, 0.f};
        cur = nxt; cA = nA; cB = nB; ++ui;
#pragma unroll
        for (int h = 0; h < 2; ++h)
#pragma unroll
            for (int i = 0; i < 2; ++i) cvA[h][i] = nvA[h][i];
        if constexpr (ALIGN_EPI) { if (wr == 1) PG8_BAR; }
    }
    PG8_WAIT_V(0);
    if constexpr (!ALIGN_EPI) { if (wr == 0) PG8_BAR; }
    PG8_BAR;
#undef PG8_SA
#undef PG8_SB
#undef PG8_STAGE
#undef PG8_LDA
#undef PG8_LDB
#undef PG8_MMA
#undef PG8_WAIT_V
#undef PG8_WAIT_L
#undef PG8_BAR
#undef PG8_SCHED
}

struct EpiBf16 {
    static constexpr bool PERM = true; static constexpr int HOOK_T = -1;
    bf16_t* O; int ldc; const float* bias;
    __device__ __forceinline__ void mid(f32x4 (&)[2][2][4][2], const Unit&, int, int, int, int) const {}
    __device__ __forceinline__ void operator()(const f32x4 (&acc)[2][2][4][2], const Unit& u, int wr, int wc, int fr, int fq) const {
        int row0 = u.row0 + wr * 64 + fr; asm volatile("" : "+v"(row0)); const int col0 = u.pn * BM + wc * 32 + 8 * fq;
        f32x4 bv[2][2];
#pragma unroll
        for (int bj = 0; bj < 2; ++bj)
#pragma unroll
            for (int n = 0; n < 2; ++n) bv[bj][n] = bias ? *(const f32x4*)(bias + col0 + bj * HALF + 4 * n) : (f32x4){0.f, 0.f, 0.f, 0.f};
#pragma unroll
        for (int ai = 0; ai < 2; ++ai)
#pragma unroll
            for (int m = 0; m < 4; ++m) { bf16_t* rowp = O + (size_t)(row0 + ai * HALF + m * 16) * ldc + col0;
#pragma unroll
                for (int bj = 0; bj < 2; ++bj) { const f32x4 v0 = acc[ai][bj][m][0] + bv[bj][0], v1 = acc[ai][bj][m][1] + bv[bj][1];
                    u32x4 w; w.x = cvt_pk_bf16(v0[0], v0[1]); w.y = cvt_pk_bf16(v0[2], v0[3]); w.z = cvt_pk_bf16(v1[0], v1[1]); w.w = cvt_pk_bf16(v1[2], v1[3]);
                    *(u32x4*)(rowp + bj * HALF) = w; } }
    }
};
struct EpiMerged {
    static constexpr bool PERM = true; static constexpr int HOOK_T = 8;
    bf16_t* O; const bf16_t* Z;
    __device__ __forceinline__ void mid(f32x4 (&acc)[2][2][4][2], const Unit& u, int wr, int wc, int fr, int fq) const {
        int row0 = u.row0 + wr * 64 + fr; asm volatile("" : "+v"(row0)); const int col0 = u.pn * BM + wc * 32 + 8 * fq;
#pragma unroll
        for (int ai = 0; ai < 2; ++ai)
#pragma unroll
            for (int m = 0; m < 4; ++m) { const bf16_t* zr = Z + (size_t)(row0 + ai * HALF + m * 16) * NZ + col0;
#pragma unroll
                for (int bj = 0; bj < 2; ++bj) {
                    const u32x4 l0 = *(const u32x4*)(zr + ZO_GL0 + bj * HALF), l1 = *(const u32x4*)(zr + ZO_GL1 + bj * HALF);
                    const unsigned a0[4] = {l0.x, l0.y, l0.z, l0.w}, a1[4] = {l1.x, l1.y, l1.z, l1.w};
#pragma unroll
                    for (int q = 0; q < 4; ++q) {
                        const float r0 = (1.0f + __expf(-bflo(a0[q]))) * __builtin_amdgcn_rcpf(1.0f + __expf(-bflo(a1[q])));
                        const float r1 = (1.0f + __expf(-bfhi(a0[q]))) * __builtin_amdgcn_rcpf(1.0f + __expf(-bfhi(a1[q])));
                        acc[ai][bj][m][q >> 1][(q & 1) * 2 + 0] *= r0; acc[ai][bj][m][q >> 1][(q & 1) * 2 + 1] *= r1; } }
                asm volatile("" ::: "memory"); }
    }
    __device__ __forceinline__ void operator()(const f32x4 (&acc)[2][2][4][2], const Unit& u, int wr, int wc, int fr, int fq) const {
        int row0 = u.row0 + wr * 64 + fr; asm volatile("" : "+v"(row0)); const int col0 = u.pn * BM + wc * 32 + 8 * fq;
#pragma unroll
        for (int ai = 0; ai < 2; ++ai)
#pragma unroll
            for (int m = 0; m < 4; ++m) { const size_t r = (size_t)(row0 + ai * HALF + m * 16); const bf16_t* zr = Z + r * NZ + col0; bf16_t* orow = O + r * D + col0;
#pragma unroll
                for (int bj = 0; bj < 2; ++bj) {
                    const u32x4 l0 = *(const u32x4*)(zr + ZO_GL0 + bj * HALF); const unsigned a0[4] = {l0.x, l0.y, l0.z, l0.w};
                    float o[8];
#pragma unroll
                    for (int q = 0; q < 4; ++q) { o[2 * q] = acc[ai][bj][m][q >> 1][(q & 1) * 2 + 0] * sigmoidf_(bflo(a0[q])); o[2 * q + 1] = acc[ai][bj][m][q >> 1][(q & 1) * 2 + 1] * sigmoidf_(bfhi(a0[q])); }
                    u32x4 w; w.x = cvt_pk_bf16(o[0], o[1]); w.y = cvt_pk_bf16(o[2], o[3]); w.z = cvt_pk_bf16(o[4], o[5]); w.w = cvt_pk_bf16(o[6], o[7]);
                    *(u32x4*)(orow + bj * HALF) = w; }
                asm volatile("" ::: "memory"); }
    }
};
struct EpiResid {
    static constexpr bool PERM = false; static constexpr int HOOK_T = -1;
    float* X; const float* gate;
    __device__ __forceinline__ void mid(f32x4 (&)[2][2][4][2], const Unit&, int, int, int, int) const {}
    __device__ __forceinline__ void operator()(const f32x4 (&acc)[2][2][4][2], const Unit& u, int wr, int wc, int fr, int fq) const {
        int row0 = u.row0 + wr * 64 + fr; asm volatile("" : "+v"(row0)); const int col0 = u.pn * BM + wc * 32 + 4 * fq;
        const float* gp = gate + (size_t)(u.row0 / SEQ) * (6 * D) + col0;
        f32x4 gv[2][2];
#pragma unroll
        for (int bj = 0; bj < 2; ++bj)
#pragma unroll
            for (int n = 0; n < 2; ++n) gv[bj][n] = *(const f32x4*)(gp + bj * HALF + n * 16);
#pragma unroll
        for (int ai = 0; ai < 2; ++ai)
#pragma unroll
            for (int m = 0; m < 4; ++m) { float* rowp = X + (size_t)(row0 + ai * HALF + m * 16) * D + col0;
#pragma unroll
                for (int bj = 0; bj < 2; ++bj)
#pragma unroll
                    for (int n = 0; n < 2; ++n) { f32x4* p = (f32x4*)(rowp + bj * HALF + n * 16); *p = *p + gv[bj][n] * acc[ai][bj][m][n]; } }
    }
};
struct EpiSwiglu {
    static constexpr bool PERM = true; static constexpr int HOOK_T = -1;
    bf16_t* ACT; const float* bias;
    __device__ __forceinline__ void mid(f32x4 (&)[2][2][4][2], const Unit&, int, int, int, int) const {}
    __device__ __forceinline__ void operator()(const f32x4 (&acc)[2][2][4][2], const Unit& u, int wr, int wc, int fr, int fq) const {
        int row0 = u.row0 + wr * 64 + fr; asm volatile("" : "+v"(row0)); const int cc = u.pn * HALF + wc * 32 + 8 * fq;
        const float* bp = bias + (size_t)u.e * 2048 + cc;
        f32x4 bg[2], bu[2];
#pragma unroll
        for (int n = 0; n < 2; ++n) { bg[n] = *(const f32x4*)(bp + 4 * n); bu[n] = *(const f32x4*)(bp + 1024 + 4 * n); }
#pragma unroll
        for (int ai = 0; ai < 2; ++ai)
#pragma unroll
            for (int m = 0; m < 4; ++m) { bf16_t* rowp = ACT + (size_t)(row0 + ai * HALF + m * 16) * D + cc;
                float o[8];
#pragma unroll
                for (int n = 0; n < 2; ++n)
#pragma unroll
                    for (int j = 0; j < 4; ++j) { float g = acc[ai][0][m][n][j] + bg[n][j], up = acc[ai][1][m][n][j] + bu[n][j];
                        g = fminf(g, 7.0f); up = fminf(fmaxf(up, -7.0f), 7.0f);
                        o[4 * n + j] = g * sigmoidf_(1.702f * g) * (up + 1.0f); }
                u32x4 w; w.x = cvt_pk_bf16(o[0], o[1]); w.y = cvt_pk_bf16(o[2], o[3]); w.z = cvt_pk_bf16(o[4], o[5]); w.w = cvt_pk_bf16(o[6], o[7]);
                *(u32x4*)rowp = w; }
    }
};
struct EpiMoeOut {
    static constexpr bool PERM = true; static constexpr int HOOK_T = -1;
    bf16_t* O; const float* bias;
    __device__ __forceinline__ void mid(f32x4 (&)[2][2][4][2], const Unit&, int, int, int, int) const {}
    __device__ __forceinline__ void operator()(const f32x4 (&acc)[2][2][4][2], const Unit& u, int wr, int wc, int fr, int fq) const {
        const EpiBf16 e{O, D, bias + (size_t)u.e * D}; e(acc, u, wr, wc, fr, fq);
    }
};
}

#define XB_TMO      128
#define XB_XCNT(j)  (256  + 64 * (j))
#define XB_XSUB(j)  (1280 + 64 * (j))
#define XB_XGEN(j)  (2304 + 64 * (j))
#define XB_TOP      3328
#define XB_TOPGEN   3392
#define XCD_BAR_WORDS 3456
#define XB_SPIN_CAP (1u << 18)
__device__ __forceinline__ unsigned xb_ld(unsigned* p)              { return __hip_atomic_load(p, __ATOMIC_RELAXED, __HIP_MEMORY_SCOPE_AGENT); }
__device__ __forceinline__ unsigned xb_add(unsigned* p, unsigned v) { return __hip_atomic_fetch_add(p, v, __ATOMIC_RELAXED, __HIP_MEMORY_SCOPE_AGENT); }
__device__ __forceinline__ unsigned xb_xcc_id() { return (unsigned)__builtin_amdgcn_s_getreg((3 << 11) | 20) & 0xFu; }
#define XB_SPIN(cond, bar) do { unsigned _sp = 0; while (cond) { __builtin_amdgcn_s_sleep(1); \
    if ((++_sp & 255u) == 0u) { if (xb_ld(&(bar)[XB_TMO])) break; if (_sp > XB_SPIN_CAP) { atomicAdd(&(bar)[XB_TMO], 1u); break; } } } } while (0)
struct XcdBarrier { unsigned* bar; unsigned x; volatile LAS unsigned* st; };
__device__ __forceinline__ XcdBarrier xcd_barrier_post(unsigned* bar, volatile LAS unsigned* st) {
    XcdBarrier b; b.bar = bar; b.x = xb_xcc_id(); b.st = st;
    if (threadIdx.x == 0) (void)xb_add(&bar[XB_XCNT(b.x)], 1u);
    return b;
}
__device__ __forceinline__ void xcd_barrier_complete(unsigned* bar, unsigned x, unsigned& nloc, unsigned& nx) {
    const unsigned G = gridDim.x * gridDim.y * gridDim.z;
    unsigned sum, cnt, mine, sp = 0u;
    for (;;) {
        sum = 0u; cnt = 0u; mine = 0u;
#pragma unroll
        for (unsigned j = 0; j < 16; ++j) { const unsigned c = xb_ld(&bar[XB_XCNT(j)]); sum += c; cnt += (c > 0u) ? 1u : 0u; mine = (j == x) ? c : mine; }
        if (sum == G) break;
        __builtin_amdgcn_s_sleep(1);
        if ((++sp & 255u) == 0u) { if (xb_ld(&bar[XB_TMO])) break; if (sp > XB_SPIN_CAP) { atomicAdd(&bar[XB_TMO], 1u); break; } }
    }
    nloc = mine > 0u ? mine : 1u; nx = cnt > 0u ? cnt : 1u;
}
__device__ __forceinline__ void xcd_barrier(const XcdBarrier& b) {
    asm volatile("s_waitcnt vmcnt(0)" ::: "memory");
    __syncthreads();
    if (threadIdx.x == 0) {
        unsigned* bar = b.bar; asm volatile("" : "+s"(bar));
        __builtin_amdgcn_s_waitcnt(0);
        unsigned nloc = b.st[0], nx = b.st[1];
        if (nloc == 0u) { xcd_barrier_complete(bar, b.x, nloc, nx); b.st[0] = nloc; b.st[1] = nx; }
        const unsigned old = xb_add(&bar[XB_XSUB(b.x)], 1u);
        const unsigned gen = old / nloc;
        if (old + 1u == (gen + 1u) * nloc) {
            __builtin_amdgcn_fence(__ATOMIC_RELEASE, "agent");
            asm volatile("s_waitcnt vmcnt(0)" ::: "memory");
            const unsigned og = xb_add(&bar[XB_TOP], 1u);
            const unsigned tg = og / nx;
            if (og + 1u == (tg + 1u) * nx) xb_add(&bar[XB_TOPGEN], 1u);
            else XB_SPIN(xb_ld(&bar[XB_TOPGEN]) == tg, bar);
            __builtin_amdgcn_fence(__ATOMIC_ACQUIRE, "agent");
            xb_add(&bar[XB_XGEN(b.x)], 1u);
            asm volatile("s_waitcnt vmcnt(0)" ::: "memory");
        } else {
            XB_SPIN(xb_ld(&bar[XB_XGEN(b.x)]) == gen, bar);
            __builtin_amdgcn_fence(__ATOMIC_ACQUIRE, "agent");
            asm volatile("s_waitcnt vmcnt(0)" ::: "memory");
        }
    }
    __syncthreads();
}

struct Args { const float* in[26]; float* out; unsigned char* ws; int ph_lo, ph_hi; };
enum { I_X = 0, I_C, I_N1G, I_N2G, I_WADA, I_BADA, I_WIN, I_CONVW, I_CONVB, I_WRGA, I_BRGA, I_WRGX, I_BRGX, I_LAM, I_WPOOL, I_PSCALE, I_WUPA, I_WUPB, I_WOUT, I_WROUTER, I_BROUTER, I_WEIN, I_BEIN, I_WEOUT, I_BEOUT, I_FINALG };

template <int ROWMODE>
__device__ __forceinline__ void tr_item(const float* W, int N, bf16_t* WT, int dst_ld, int dst_off, int k0, int n0, LAS float* scr, int lane) {
#pragma unroll 8
    for (int i = 0; i < 32; ++i) { const int kk = 2 * i + (lane >> 5); scr[kk * 33 + (lane & 31)] = W[(size_t)(k0 + kk) * N + n0 + (lane & 31)]; }
    LDS_WAIT();
    const int c = lane & 7;
#pragma unroll
    for (int j = 0; j < 4; ++j) { const int n = (lane >> 3) + 8 * j; const LAS float* s = scr + (8 * c) * 33 + n;
        u32x4 o; o.x = cvt_pk_bf16(s[0 * 33], s[1 * 33]); o.y = cvt_pk_bf16(s[2 * 33], s[3 * 33]); o.z = cvt_pk_bf16(s[4 * 33], s[5 * 33]); o.w = cvt_pk_bf16(s[6 * 33], s[7 * 33]);
        const int nn = n0 + n; int drow = nn;
        if (ROWMODE == 1) { drow = (nn < 1024) ? (256 * (nn >> 7) + (nn & 127)) : (256 * ((nn - 1024) >> 7) + 128 + ((nn - 1024) & 127)); }
        *(u32x4*)(WT + (size_t)drow * dst_ld + dst_off + k0 + 8 * c) = o; }
    LDS_WAIT();
}
template <int ROWMODE>
__device__ __forceinline__ void tr_job(int item, const float* src, int K, int N, bf16_t* dst, size_t dst_bstride, int dst_ld, int dst_off, LAS float* scr, int lane) {
    const int nnb = N / 32, nkb = K / 64; const int nb = item % nnb; const int r = item / nnb; const int kb = r % nkb; const int bt = r / nkb;
    tr_item<ROWMODE>(src + (size_t)bt * K * N, N, dst + (size_t)bt * dst_bstride, dst_ld, dst_off, 64 * kb, 32 * nb, scr, lane);
}

__device__ __forceinline__ void phase_prologue(const Args& a, LAS unsigned char* lds) {
    int tid_ = threadIdx.x; asm volatile("" : "+v"(tid_)); const int tid = tid_, lane = tid & 63, wave = __builtin_amdgcn_readfirstlane(tid >> 6);
    const int G = gridDim.x;
    unsigned char* ws = a.ws;
    {
        LAS float* cact = (LAS float*)lds;
        LAS float* red = (LAS float*)(lds + 32768);
        for (int i = tid; i < NBATCH * D; i += NTHREADS) { const float v = a.in[I_C][i]; cact[i] = v * sigmoidf_(v); }
        __syncthreads();
        float* mod = (float*)(ws + WS_MOD);
        for (int u = blockIdx.x; u < DEPTH * 96; u += G) {
            const int l = u / 96, cg = u % 96; const int n = cg * 64 + lane;
            const float* w = a.in[I_WADA] + (size_t)l * D * 6144 + n;
            float acc[8] = {0.f, 0.f, 0.f, 0.f, 0.f, 0.f, 0.f, 0.f};
            const int kb = wave * 128;
#pragma unroll 8
            for (int k = 0; k < 128; ++k) { const float wv = w[(size_t)(kb + k) * 6144];
#pragma unroll
                for (int b = 0; b < 8; ++b) acc[b] += cact[b * D + kb + k] * wv; }
#pragma unroll
            for (int b = 0; b < 8; ++b) red[(wave * 8 + b) * 64 + lane] = acc[b];
            __syncthreads();
            { const int b = tid >> 6; float s = 0.f;
#pragma unroll
              for (int w8 = 0; w8 < 8; ++w8) s += red[(w8 * 8 + b) * 64 + lane];
              mod[((size_t)l * NBATCH + b) * 6144 + n] = s + a.in[I_BADA][(size_t)l * 6144 + n]; }
            __syncthreads();
        }
    }
    {
        LAS float* scr = (LAS float*)(lds + wave * 8448);
        const int gw = blockIdx.x * NWAVES + wave, NGW = G * NWAVES;
        constexpr int I_EIN = DEPTH * NE * 16 * 64, I_EOUT = DEPTH * NE * 16 * 32, I_WINI = DEPTH * 16 * 144, I_UPA = DEPTH * 16 * 32, I_UPB = DEPTH * 8 * 32, I_OUT = DEPTH * 16 * 32,
                      I_RGA = DEPTH * 8 * 2 * 4, I_RGX = I_RGA, I_POOL = DEPTH * 4 * 2 * 4;
        constexpr int NITEMS = I_EIN + I_EOUT + I_WINI + I_UPA + I_UPB + I_OUT + I_RGA + I_RGX + I_POOL;
        for (int it = gw; it < NITEMS; it += NGW) {
            int r = it;
            if (r < I_EIN) { tr_job<1>(r, a.in[I_WEIN], 1024, 2048, (bf16_t*)(ws + WS_WEIN), (size_t)2048 * 1024, 1024, 0, scr, lane); continue; } r -= I_EIN;
            if (r < I_EOUT) { tr_job<0>(r, a.in[I_WEOUT], 1024, 1024, (bf16_t*)(ws + WS_WEOUT), (size_t)1024 * 1024, 1024, 0, scr, lane); continue; } r -= I_EOUT;
            if (r < I_WINI) { tr_job<0>(r, a.in[I_WIN], 1024, NZ, (bf16_t*)(ws + WS_WIN), (size_t)NZ * 1024, 1024, 0, scr, lane); continue; } r -= I_WINI;
            if (r < I_UPA) { tr_job<0>(r, a.in[I_WUPA], 1024, 1024, (bf16_t*)(ws + WS_WCAT), (size_t)1024 * KCAT, KCAT, 512, scr, lane); continue; } r -= I_UPA;
            if (r < I_UPB) { tr_job<0>(r, a.in[I_WUPB], 512, 1024, (bf16_t*)(ws + WS_WCAT), (size_t)1024 * KCAT, KCAT, 0, scr, lane); continue; } r -= I_UPB;
            if (r < I_OUT) { tr_job<0>(r, a.in[I_WOUT], 1024, 1024, (bf16_t*)(ws + WS_WOUT), (size_t)1024 * 1024, 1024, 0, scr, lane); continue; } r -= I_OUT;
            if (r < I_RGA) { tr_job<0>(r, a.in[I_WRGA], 128, 128, (bf16_t*)(ws + WS_WRG), (size_t)256 * 128, 128, 0, scr, lane); continue; } r -= I_RGA;
            if (r < I_RGX) { tr_job<0>(r, a.in[I_WRGX], 128, 128, (bf16_t*)(ws + WS_WRG) + 128 * 128, (size_t)256 * 128, 128, 0, scr, lane); continue; } r -= I_RGX;
            tr_job<0>(r, a.in[I_WPOOL], 128, 128, (bf16_t*)(ws + WS_WPOOL), (size_t)128 * 128, 128, 0, scr, lane);
        }
    }
}

struct MoeTab { LAS int* cnt; LAS int* padstart; LAS int* tilestart; LAS int* tab; };
__device__ __forceinline__ MoeTab moe_tab_ptrs(LAS unsigned char* lds) { MoeTab t; t.cnt = (LAS int*)(lds + LDS_TAB); t.padstart = t.cnt + 32; t.tilestart = t.padstart + 40; t.tab = t.tilestart + 40; return t; }
__device__ __forceinline__ void moe_tables(const Args& a, int l, LAS unsigned char* lds) {
    const MoeTab mt = moe_tab_ptrs(lds); int tid_ = threadIdx.x; asm volatile("" : "+v"(tid_)); const int tid = tid_;
    unsigned* ctl = (unsigned*)(a.ws + WS_CTL);
    __syncthreads();
    if (tid < NE) mt.cnt[tid] = (int)__hip_atomic_load(ctl + CW_CNT + (l * NE + tid) * 16, __ATOMIC_RELAXED, __HIP_MEMORY_SCOPE_AGENT);
    __syncthreads();
    if (tid == 0) { int ps = 0, ts = 0; for (int e = 0; e < NE; ++e) { mt.padstart[e] = ps; mt.tilestart[e] = ts; const int nt = (mt.cnt[e] + 255) >> 8; ps += nt * 256; ts += nt; } mt.padstart[NE] = ps; mt.tilestart[NE] = ts; }
    __syncthreads();
    const int nMt = mt.tilestart[NE];
    for (int m = tid; m < nMt; m += NTHREADS) { int e = 0; for (int q = 1; q < NE; ++q) e = (mt.tilestart[q] <= m) ? q : e; mt.tab[m] = (e << 16) | (m - mt.tilestart[e]); }
    __syncthreads();
}
struct MoeSched1 {
    const char* H; const char* W; const int* tokof; MoeTab mt; int nMt, G, c;
    __device__ __forceinline__ bool next(int i, pg8::Unit& u) const { int pm, pn; if (!pg8::order_map(i, G, c, nMt, 8, pm, pn)) return false;
        const int en = mt.tab[pm]; u.pm = pm; u.pn = pn; u.e = en >> 16; u.j = en & 0xffff; u.row0 = mt.padstart[u.e] + 256 * u.j; u.rows = mt.cnt[u.e] - 256 * u.j; return true; }
    __device__ __forceinline__ const char* a_base(const pg8::Unit&) const { return H; }
    __device__ __forceinline__ const char* b_base(const pg8::Unit& u) const { return W + ((size_t)u.e * 2048 + (size_t)u.pn * 256) * 1024 * 2; }
    __device__ __forceinline__ void a_voff(const pg8::Unit& u, unsigned (&v)[2][2], const int (&R)[2], const int (&C)[2]) const {
        const int* tl = tokof + (size_t)u.e * T + 256 * u.j;
#pragma unroll
        for (int h = 0; h < 2; ++h)
#pragma unroll
            for (int i = 0; i < 2; ++i) { const int idx = h * 128 + R[i]; const int tk = (idx < u.rows) ? tl[idx] : 0; v[h][i] = (unsigned)tk * 2048u + (unsigned)C[i] * 2u; }
    }
};
struct MoeSched2 {
    const char* ACT; const char* W; MoeTab mt; int nMt, G, c;
    __device__ __forceinline__ bool next(int i, pg8::Unit& u) const { int pm, pn; if (!pg8::order_map(i, G, c, nMt, 4, pm, pn)) return false;
        const int en = mt.tab[pm]; u.pm = pm; u.pn = pn; u.e = en >> 16; u.j = en & 0xffff; u.row0 = mt.padstart[u.e] + 256 * u.j; u.rows = mt.cnt[u.e] - 256 * u.j; return true; }
    __device__ __forceinline__ const char* a_base(const pg8::Unit& u) const { return ACT + (size_t)u.row0 * 2048; }
    __device__ __forceinline__ const char* b_base(const pg8::Unit& u) const { return W + ((size_t)u.e * 1024 + (size_t)u.pn * 256) * 1024 * 2; }
    __device__ __forceinline__ void a_voff(const pg8::Unit&, unsigned (&v)[2][2], const int (&R)[2], const int (&C)[2]) const {
#pragma unroll
        for (int h = 0; h < 2; ++h)
#pragma unroll
            for (int i = 0; i < 2; ++i) v[h][i] = (unsigned)((h * 128 + R[i]) * 1024 + C[i]) * 2u;
    }
};

__device__ __forceinline__ void phase_a(const Args& a, int l, LAS unsigned char* lds) {
    int tid_ = threadIdx.x; asm volatile("" : "+v"(tid_)); const int tid = tid_, lane = tid & 63, wave = __builtin_amdgcn_readfirstlane(tid >> 6);
    const int G = gridDim.x; unsigned char* ws = a.ws;
    const float* mod = (const float*)(ws + WS_MOD);
    float* xres = (float*)(ws + WS_XRES);
    if (l < DEPTH && blockIdx.x < NBATCH) {
        LAS float* red = (LAS float*)lds;
        const int b = blockIdx.x, e = tid & 31, kp = tid >> 5;
        const float* sh2 = mod + ((size_t)l * NBATCH + b) * 6144 + 3 * D; const float* wr = a.in[I_WROUTER] + (size_t)l * D * NE;
        float s = 0.f;
        for (int k = kp * 64; k < kp * 64 + 64; ++k) s += sh2[k] * wr[k * NE + e];
        red[kp * 32 + e] = s;
        __syncthreads();
        if (tid < 32) { float t = a.in[I_BROUTER][l * NE + tid]; for (int q = 0; q < 16; ++q) t += red[q * 32 + tid]; ((float*)(ws + WS_CB))[(l * NBATCH + b) * NE + tid] = t; }
        __syncthreads();
    }
    if (l > 0) moe_tables(a, l - 1, lds);
    const MoeTab mt = moe_tab_ptrs(lds);
    const int* slotinfo = (const int*)(ws + WS_SLOTINFO); const float* wgt = (const float*)(ws + WS_WGT);
    const bf16_t* outb = (const bf16_t*)(ws + WS_OUTB);
    bf16_t* hb = (bf16_t*)(ws + WS_H);
    for (int chunk = blockIdx.x; chunk < T / 128; chunk += G) {
        for (int i = 0; i < 16; ++i) {
            const int row = chunk * 128 + wave * 16 + i; const int b = row / SEQ;
            const float* xin = (l == 0) ? (a.in[I_X] + (size_t)row * D) : (xres + (size_t)row * D);
            f32x4 v[4];
#pragma unroll
            for (int j = 0; j < 4; ++j) v[j] = *(const f32x4*)(xin + 4 * lane + 256 * j);
            if (l > 0) {
                const int4 si = *(const int4*)(slotinfo + (size_t)row * 4); const f32x4 wv = *(const f32x4*)(wgt + (size_t)row * 4);
                const int sl[4] = {si.x, si.y, si.z, si.w};
                f32x4 y[4];
#pragma unroll
                for (int j = 0; j < 4; ++j) y[j] = (f32x4){0.f, 0.f, 0.f, 0.f};
#pragma unroll
                for (int kk = 0; kk < 4; ++kk) { const int e = sl[kk] >> 24, li = sl[kk] & 0xffffff; const size_t slot = (size_t)(mt.padstart[e] + li); const float w = wv[kk];
                    const bf16_t* orow = outb + slot * D + 4 * lane;
#pragma unroll
                    for (int j = 0; j < 4; ++j) { const u32x2 p = *(const u32x2*)(orow + 256 * j); y[j] += w * (f32x4){bflo(p.x), bfhi(p.x), bflo(p.y), bfhi(p.y)}; } }
                const float* g2 = mod + ((size_t)(l - 1) * NBATCH + b) * 6144 + 5 * D + 4 * lane;
#pragma unroll
                for (int j = 0; j < 4; ++j) v[j] += *(const f32x4*)(g2 + 256 * j) * y[j];
            }
            if (l < DEPTH) {
#pragma unroll
                for (int j = 0; j < 4; ++j) *(f32x4*)(xres + (size_t)row * D + 4 * lane + 256 * j) = v[j];
            }
            float ss = 0.f;
#pragma unroll
            for (int j = 0; j < 4; ++j) ss += (v[j].x * v[j].x + v[j].y * v[j].y) + (v[j].z * v[j].z + v[j].w * v[j].w);
            const float rinv = 1.0f / sqrtf(wave_sum(ss) * (1.0f / D) + NORM_EPS);
            if (l < DEPTH) {
                const float* ng = a.in[I_N1G] + (size_t)l * D + 4 * lane; const float* mb = mod + ((size_t)l * NBATCH + b) * 6144 + 4 * lane;
#pragma unroll
                for (int j = 0; j < 4; ++j) { const f32x4 g = *(const f32x4*)(ng + 256 * j), sh = *(const f32x4*)(mb + 256 * j), sc = *(const f32x4*)(mb + D + 256 * j);
                    const f32x4 h = (v[j] * rinv * g) * (1.0f + sc) + sh;
                    u32x2 p; p.x = cvt_pk_bf16(h.x, h.y); p.y = cvt_pk_bf16(h.z, h.w); *(u32x2*)(hb + (size_t)row * D + 4 * lane + 256 * j) = p; }
            } else {
                const float* fg = a.in[I_FINALG] + 4 * lane;
#pragma unroll
                for (int j = 0; j < 4; ++j) *(f32x4*)(a.out + (size_t)row * D + 4 * lane + 256 * j) = v[j] * rinv * *(const f32x4*)(fg + 256 * j);
            }
        }
    }
}

__device__ __forceinline__ void phase_h(const Args& a, int l, LAS unsigned char* lds) {
    int tid_ = threadIdx.x; asm volatile("" : "+v"(tid_)); const int tid = tid_, lane = tid & 63, wave = __builtin_amdgcn_readfirstlane(tid >> 6);
    const int G = gridDim.x; unsigned char* ws = a.ws;
    const float* mod = (const float*)(ws + WS_MOD); const float* xres = (const float*)(ws + WS_XRES);
    bf16_t* hb = (bf16_t*)(ws + WS_H);
    LAS float* rinvs = (LAS float*)lds;
    LAS float* lgt = (LAS float*)(lds + 1024);
    LAS int* hist = (LAS int*)(lds + 1024 + 8 * 16 * 33 * 4);
    LAS int* base = hist + 32;
    unsigned* ctl = (unsigned*)(ws + WS_CTL);
    const float* wr = a.in[I_WROUTER] + (size_t)l * D * NE;
    const float* ng = a.in[I_N2G] + (size_t)l * D;
    const float* cbv = (const float*)(ws + WS_CB);
    int* tokof = (int*)(ws + WS_TOKOF); int* slotinfo = (int*)(ws + WS_SLOTINFO); float* wgt = (float*)(ws + WS_WGT);
    for (int chunk = blockIdx.x; chunk < T / 128; chunk += G) {
        const int row0 = chunk * 128 + wave * 16; const int b = row0 / SEQ;
        const float* mb = mod + ((size_t)l * NBATCH + b) * 6144 + 3 * D;
        if (tid < 32) hist[tid] = 0;
        for (int i = 0; i < 16; ++i) {
            const int row = row0 + i; const float* xr = xres + (size_t)row * D;
            f32x4 v[4]; float ss = 0.f;
#pragma unroll
            for (int j = 0; j < 4; ++j) { v[j] = *(const f32x4*)(xr + 4 * lane + 256 * j); ss += (v[j].x * v[j].x + v[j].y * v[j].y) + (v[j].z * v[j].z + v[j].w * v[j].w); }
            const float rinv = 1.0f / sqrtf(wave_sum(ss) * (1.0f / D) + NORM_EPS);
            if (lane == 0) rinvs[wave * 16 + i] = rinv;
#pragma unroll
            for (int j = 0; j < 4; ++j) { const f32x4 g = *(const f32x4*)(ng + 4 * lane + 256 * j), sh = *(const f32x4*)(mb + 4 * lane + 256 * j), sc = *(const f32x4*)(mb + D + 4 * lane + 256 * j);
                const f32x4 h = (v[j] * rinv * g) * (1.0f + sc) + sh;
                u32x2 p; p.x = cvt_pk_bf16(h.x, h.y); p.y = cvt_pk_bf16(h.z, h.w); *(u32x2*)(hb + (size_t)row * D + 4 * lane + 256 * j) = p; }
        }
        {
            const int ri = lane & 15, q = lane >> 4;
            const float* xr = xres + (size_t)(row0 + ri) * D + 4 * q;
            f32x4 acc0 = {0.f, 0.f, 0.f, 0.f}, acc1 = {0.f, 0.f, 0.f, 0.f};
#pragma unroll 2
            for (int g = 0; g < 64; ++g) {
                const int k0 = 16 * g + 4 * q;
                const f32x4 xv = *(const f32x4*)(xr + 16 * g); const f32x4 gv = *(const f32x4*)(ng + k0), sc = *(const f32x4*)(mb + D + k0);
                const f32x4 av = xv * gv * (1.0f + sc);
#pragma unroll
                for (int e = 0; e < 4; ++e) { const float* wp = wr + (size_t)(k0 + e) * NE + ri;
                    acc0 = __builtin_amdgcn_mfma_f32_16x16x4f32(av[e], wp[0], acc0, 0, 0, 0);
                    acc1 = __builtin_amdgcn_mfma_f32_16x16x4f32(av[e], wp[16], acc1, 0, 0, 0); }
            }
            LDS_WAIT();
            const float c0 = cbv[(l * NBATCH + b) * NE + ri], c1 = cbv[(l * NBATCH + b) * NE + 16 + ri];
#pragma unroll
            for (int r = 0; r < 4; ++r) { const int ti = 4 * q + r; const float rv = rinvs[wave * 16 + ti];
                lgt[(wave * 16 + ti) * 33 + ri] = acc0[r] * rv + c0; lgt[(wave * 16 + ti) * 33 + 16 + ri] = acc1[r] * rv + c1; }
        }
        __syncthreads();
        int se[4] = {0, 0, 0, 0}; float sw[4] = {0.f, 0.f, 0.f, 0.f}; int rk[4] = {0, 0, 0, 0};
        if (lane < 16) {
            float v[32];
#pragma unroll
            for (int e = 0; e < 32; ++e) v[e] = lgt[(wave * 16 + lane) * 33 + e];
            float sv[4];
#pragma unroll
            for (int kk = 0; kk < 4; ++kk) { float best = v[0]; int bi = 0;
#pragma unroll
                for (int e = 1; e < 32; ++e) { if (v[e] > best) { best = v[e]; bi = e; } }
                sv[kk] = best; se[kk] = bi;
#pragma unroll
                for (int e = 0; e < 32; ++e) v[e] = (e == bi) ? -3.0e38f : v[e]; }
            float den = 0.f;
#pragma unroll
            for (int kk = 0; kk < 4; ++kk) { sw[kk] = __expf(sv[kk] - sv[0]); den += sw[kk]; }
            const float inv = 1.0f / den;
#pragma unroll
            for (int kk = 0; kk < 4; ++kk) { sw[kk] *= inv; rk[kk] = __hip_atomic_fetch_add(hist + se[kk], 1, __ATOMIC_RELAXED, __HIP_MEMORY_SCOPE_WORKGROUP); }
        }
        __syncthreads();
        if (tid < 32) base[tid] = (int)__hip_atomic_fetch_add(ctl + CW_CNT + (l * NE + tid) * 16, (unsigned)hist[tid], __ATOMIC_RELAXED, __HIP_MEMORY_SCOPE_AGENT);
        __syncthreads();
        if (lane < 16) {
            const int row = row0 + lane; int si[4];
#pragma unroll
            for (int kk = 0; kk < 4; ++kk) { const int li = base[se[kk]] + rk[kk]; tokof[(size_t)se[kk] * T + li] = row; si[kk] = (se[kk] << 24) | li; }
            *(int4*)(slotinfo + (size_t)row * 4) = make_int4(si[0], si[1], si[2], si[3]);
            *(f32x4*)(wgt + (size_t)row * 4) = (f32x4){sw[0], sw[1], sw[2], sw[3]};
        }
        __syncthreads();
    }
}

constexpr int ZT_STRIDE = 528;
template <int PASS>
__device__ __forceinline__ void lru_unit(const Args& a, int l, int u, LAS unsigned char* lds) {
    int tid_ = threadIdx.x; asm volatile("" : "+v"(tid_)); const int tid = tid_, lane = tid & 63, wave = __builtin_amdgcn_readfirstlane(tid >> 6);
    unsigned char* ws = a.ws;
    const bf16_t* z = (const bf16_t*)(ws + WS_Z);
    LAS unsigned char* zt = lds; LAS unsigned char* xc = lds + 131 * ZT_STRIDE;
    const int hp = u & 3, b = (u >> 2) & 7, s = u >> 5;
    const int t0 = b * SEQ + s * 128, p0 = s * 128;
    for (int idx = tid; idx < 131 * 32; idx += NTHREADS) { const int r = idx >> 5, o = idx & 31; const int p = p0 - 3 + r;
        u32x4 v = {0u, 0u, 0u, 0u}; if (p >= 0) v = *(const u32x4*)(z + (size_t)(b * SEQ + p) * NZ + hp * 256 + o * 8);
        *(LAS u32x4*)(zt + r * ZT_STRIDE + o * 16) = v; }
    __syncthreads();
    {
        const int o = tid & 31, rb = tid >> 5; const int ch0 = hp * 256 + o * 8;
        float cw[4][8], cbias[8];
#pragma unroll
        for (int k = 0; k < 4; ++k) { const f32x4 w0 = *(const f32x4*)(a.in[I_CONVW] + ((size_t)l * 4 + k) * D + ch0), w1 = *(const f32x4*)(a.in[I_CONVW] + ((size_t)l * 4 + k) * D + ch0 + 4);
            cw[k][0] = w0.x; cw[k][1] = w0.y; cw[k][2] = w0.z; cw[k][3] = w0.w; cw[k][4] = w1.x; cw[k][5] = w1.y; cw[k][6] = w1.z; cw[k][7] = w1.w; }
        { const f32x4 b0 = *(const f32x4*)(a.in[I_CONVB] + (size_t)l * D + ch0), b1 = *(const f32x4*)(a.in[I_CONVB] + (size_t)l * D + ch0 + 4);
          cbias[0] = b0.x; cbias[1] = b0.y; cbias[2] = b0.z; cbias[3] = b0.w; cbias[4] = b1.x; cbias[5] = b1.y; cbias[6] = b1.z; cbias[7] = b1.w; }
#pragma unroll 2
        for (int i = 0; i < 8; ++i) { const int r = rb + 16 * i; float acc[8];
#pragma unroll
            for (int j = 0; j < 8; ++j) acc[j] = cbias[j];
#pragma unroll
            for (int k = 0; k < 4; ++k) { const u32x4 v = *(const LAS u32x4*)(zt + (r + k) * ZT_STRIDE + o * 16);
                acc[0] += cw[k][0] * bflo(v.x); acc[1] += cw[k][1] * bfhi(v.x); acc[2] += cw[k][2] * bflo(v.y); acc[3] += cw[k][3] * bfhi(v.y);
                acc[4] += cw[k][4] * bflo(v.z); acc[5] += cw[k][5] * bfhi(v.z); acc[6] += cw[k][6] * bflo(v.w); acc[7] += cw[k][7] * bfhi(v.w); }
            u32x4 w; w.x = cvt_pk_bf16(acc[0], acc[1]); w.y = cvt_pk_bf16(acc[2], acc[3]); w.z = cvt_pk_bf16(acc[4], acc[5]); w.w = cvt_pk_bf16(acc[6], acc[7]);
            *(LAS u32x4*)(xc + r * ZT_STRIDE + o * 16) = w; }
    }
    __syncthreads();
    {
        const int hsel = wave >> 2, wc = wave & 3, head = 2 * hp + hsel, c31 = lane & 31, hh = lane >> 5;
        const int ch = head * 128 + 32 * wc + c31;
        const bf16_t* wb = (const bf16_t*)(ws + WS_WRG) + ((size_t)(l * 8 + head) * 256 + 32 * wc + c31) * 128 + 8 * hh;
        bf16x8 Ba[8], Bi[8];
#pragma unroll
        for (int ks = 0; ks < 8; ++ks) { Ba[ks] = *(const bf16x8*)(wb + 16 * ks); Bi[ks] = *(const bf16x8*)(wb + 128 * 128 + 16 * ks); }
        const float ba = a.in[I_BRGA][(size_t)l * D + ch], bx = a.in[I_BRGX][(size_t)l * D + ch];
        const float lam = a.in[I_LAM][(size_t)l * D + ch];
        const float sp8 = 8.0f * log1pf(__expf(-lam));
        float* agg = (float*)(ws + WS_AGG);
        float cin = 0.f;
        if (PASS == 2) { for (int j = 0; j < s; ++j) { const f32x2 ab = *(const f32x2*)(agg + ((size_t)(b * 32 + j) * D + ch) * 2); cin = ab.x * cin + ab.y; } }
        float Pr = 1.f, Hr = 0.f;
        const bf16_t* zg = z + (size_t)t0 * NZ + ZO_GLRU + ch;
        bf16_t* yo = (bf16_t*)(ws + WS_ACAT) + (size_t)t0 * KCAT + 512 + ch;
#pragma unroll 1
        for (int rb = 0; rb < 4; ++rb) {
            f32x16 aa, ai;
#pragma unroll
            for (int r = 0; r < 16; ++r) { aa[r] = 0.f; ai[r] = 0.f; }
            const LAS unsigned char* ap = xc + (32 * rb + c31) * ZT_STRIDE + (hsel * 128 + 8 * hh) * 2;
#pragma unroll
            for (int ks = 0; ks < 8; ++ks) { const bf16x8 A = *(const LAS bf16x8*)(ap + 32 * ks);
                aa = __builtin_amdgcn_mfma_f32_32x32x16_bf16(A, Ba[ks], aa, 0, 0, 0); ai = __builtin_amdgcn_mfma_f32_32x32x16_bf16(A, Bi[ks], ai, 0, 0, 0); }
            const LAS unsigned char* xp = xc + (32 * rb + 4 * hh) * ZT_STRIDE + (hsel * 128 + 32 * wc + c31) * 2;
#pragma unroll
            for (int q = 0; q < 4; ++q) {
                float p = 1.f, h = 0.f, hl[4], pl[4];
#pragma unroll
                for (int r3 = 0; r3 < 4; ++r3) { const int reg = 4 * q + r3;
                    const float xcv = bf1(*(const LAS bf16_t*)(xp + (8 * q + r3) * ZT_STRIDE));
                    const float rg = sigmoidf_(aa[reg] + ba), ig = sigmoidf_(ai[reg] + bx);
                    const float av = __expf(-sp8 * rg); const float mult = sqrtf(fmaxf(1.0f - av * av, 0.f));
                    h = av * h + mult * (ig * xcv); p *= av; hl[r3] = h; pl[r3] = p; }
                const float Ao = __shfl_xor(p, 32), Bo = __shfl_xor(h, 32);
                const float A0 = hh ? Ao : p, B0 = hh ? Bo : h, A1 = hh ? p : Ao, B1 = hh ? h : Bo;
                const float P1 = Pr * A0, H1 = Hr * A0 + B0;
                const float Pst = hh ? P1 : Pr, Hst = hh ? H1 : Hr;
                Pr = P1 * A1; Hr = H1 * A1 + B1;
                if (PASS == 2) {
#pragma unroll
                    for (int r3 = 0; r3 < 4; ++r3) { const int tok = 32 * rb + 8 * q + 4 * hh + r3;
                        const float hf = (Hst * pl[r3] + hl[r3]) + (Pst * pl[r3]) * cin;
                        const float g = bf1(zg[(size_t)tok * NZ]);
                        const float ge = g * __builtin_amdgcn_rcpf(1.0f + __expf(-1.5957691216f * (g + 0.044715f * g * g * g)));
                        yo[(size_t)tok * KCAT] = (bf16_t)(cvt_pk_bf16(hf * ge, 0.f) & 0xffffu); }
                }
            }
        }
        if (PASS == 1 && hh == 0) *(f32x2*)(agg + ((size_t)(b * 32 + s) * D + ch) * 2) = (f32x2){Pr, Hr};
    }
    __syncthreads();
}
__device__ __forceinline__ void pool_unit(const Args& a, int l, int u, LAS unsigned char* lds) {
    int tid_ = threadIdx.x; asm volatile("" : "+v"(tid_)); const int tid = tid_, lane = tid & 63, wave = __builtin_amdgcn_readfirstlane(tid >> 6);
    unsigned char* ws = a.ws;
    const bf16_t* z = (const bf16_t*)(ws + WS_Z);
    LAS unsigned char* zt = lds; LAS unsigned char* pt = lds + 143 * ZT_STRIDE;
    const int gp = u & 1, b = (u >> 1) & 7, s = u >> 4;
    const int t0 = b * SEQ + s * 128, p0 = s * 128;
    for (int idx = tid; idx < 143 * 32; idx += NTHREADS) { const int r = idx >> 5, o = idx & 31; const int p = p0 - 15 + r;
        u32x4 v = {0u, 0u, 0u, 0u}; if (p >= 0) v = *(const u32x4*)(z + (size_t)(b * SEQ + p) * NZ + ZO_XPOOL + gp * 256 + o * 8);
        *(LAS u32x4*)(zt + r * ZT_STRIDE + o * 16) = v; }
    __syncthreads();
    {
        const int o = tid & 31, rb = tid >> 5; const int g = 2 * gp + (o >> 4); const int w = 2 << g;
#pragma unroll 1
        for (int i = 0; i < 8; ++i) { const int r = rb + 16 * i; float acc[8];
#pragma unroll
            for (int j = 0; j < 8; ++j) acc[j] = 0.f;
            for (int jj = 0; jj < w; ++jj) { const u32x4 v = *(const LAS u32x4*)(zt + (r + 15 - jj) * ZT_STRIDE + o * 16);
                acc[0] += bflo(v.x); acc[1] += bfhi(v.x); acc[2] += bflo(v.y); acc[3] += bfhi(v.y); acc[4] += bflo(v.z); acc[5] += bfhi(v.z); acc[6] += bflo(v.w); acc[7] += bfhi(v.w); }
            const int cnt = (p0 + r + 1 < w) ? (p0 + r + 1) : w; const float ic = 1.0f / (float)cnt;
            const u32x4 v = *(const LAS u32x4*)(zt + (r + 15) * ZT_STRIDE + o * 16);
            const float x0[8] = {bflo(v.x), bfhi(v.x), bflo(v.y), bfhi(v.y), bflo(v.z), bfhi(v.z), bflo(v.w), bfhi(v.w)};
#pragma unroll
            for (int j = 0; j < 8; ++j) acc[j] = acc[j] * ic - x0[j];
            u32x4 wv; wv.x = cvt_pk_bf16(acc[0], acc[1]); wv.y = cvt_pk_bf16(acc[2], acc[3]); wv.z = cvt_pk_bf16(acc[4], acc[5]); wv.w = cvt_pk_bf16(acc[6], acc[7]);
            *(LAS u32x4*)(pt + r * ZT_STRIDE + o * 16) = wv; }
    }
    __syncthreads();
    {
        const int gsel = wave >> 2, wc = wave & 3, g = 2 * gp + gsel, c31 = lane & 31, hh = lane >> 5;
        const int oc = g * 128 + 32 * wc + c31;
        const bf16_t* wb = (const bf16_t*)(ws + WS_WPOOL) + ((size_t)(l * 4 + g) * 128 + 32 * wc + c31) * 128 + 8 * hh;
        bf16x8 Bf[8];
#pragma unroll
        for (int ks = 0; ks < 8; ++ks) Bf[ks] = *(const bf16x8*)(wb + 16 * ks);
        const float psc = a.in[I_PSCALE][(size_t)l * 512 + oc];
        bf16_t* yo = (bf16_t*)(ws + WS_ACAT) + (size_t)t0 * KCAT + oc;
#pragma unroll 1
        for (int rb = 0; rb < 4; ++rb) {
            f32x16 acc;
#pragma unroll
            for (int r = 0; r < 16; ++r) acc[r] = 0.f;
            const LAS unsigned char* ap = pt + (32 * rb + c31) * ZT_STRIDE + (gsel * 128 + 8 * hh) * 2;
#pragma unroll
            for (int ks = 0; ks < 8; ++ks) { const bf16x8 A = *(const LAS bf16x8*)(ap + 32 * ks); acc = __builtin_amdgcn_mfma_f32_32x32x16_bf16(A, Bf[ks], acc, 0, 0, 0); }
#pragma unroll
            for (int reg = 0; reg < 16; ++reg) { const int tok = 32 * rb + 8 * (reg >> 2) + 4 * hh + (reg & 3);
                yo[(size_t)tok * KCAT] = (bf16_t)(cvt_pk_bf16(acc[reg] * psc, 0.f) & 0xffffu); }
        }
    }
    __syncthreads();
}

constexpr int PH_PER_LAYER = 9;
constexpr int N_PHASES = 1 + DEPTH * PH_PER_LAYER + 1;

__global__ void __launch_bounds__(NTHREADS, 2) fwd_kernel(Args a) {
    extern __shared__ __attribute__((aligned(16))) unsigned char lds_raw[];
    LAS unsigned char* lds = (LAS unsigned char*)lds_raw;
    const int tid = threadIdx.x; const int G = gridDim.x;
    unsigned char* ws = a.ws;
    unsigned* ctl = (unsigned*)(ws + WS_CTL);
    volatile LAS unsigned* misc = (volatile LAS unsigned*)(lds + LDS_MISC);
    if (tid < 4) misc[tid] = 0u;
    __syncthreads();
    XcdBarrier bar; bar.bar = ctl + CW_BAR; bar.x = 0; bar.st = misc;
    const int lo = a.ph_lo, hi = a.ph_hi;
    if (hi - lo > 1) bar = xcd_barrier_post(ctl + CW_BAR, misc);
#ifndef PH_MASK
#define PH_MASK 0x7ff
#endif
#define EN(b) ((PH_MASK >> (b)) & 1)
#define IN(k) (lo <= (k) && (k) < hi)
#define SEAM(k) do { if (IN((k) + 1)) xcd_barrier(bar); } while (0)

    if (EN(0) && IN(0)) { phase_prologue(a, lds); SEAM(0); }

    for (int l = 0; l < DEPTH; ++l) {
        const int pb = 1 + l * PH_PER_LAYER;
        const float* mod_l = (const float*)(ws + WS_MOD) + (size_t)l * NBATCH * 6144;
        if (EN(1) && IN(pb + 0)) { phase_a(a, l, lds); SEAM(pb + 0); }
        if (EN(2) && IN(pb + 1)) {
            pg8::PlainSched S{(const char*)(ws + WS_H), (const char*)(ws + WS_WIN) + (size_t)l * NZ * 1024 * 2, 1024, T / 256, NZ / 256, G, (int)blockIdx.x};
            pg8::EpiBf16 E{(bf16_t*)(ws + WS_Z), NZ, nullptr};
            pg8::gemm_phase<pg8::EpiBf16, pg8::PlainSched, true>(lds, 1024, S, E);
            SEAM(pb + 1);
        }
        if (EN(3) && IN(pb + 2)) {
            for (int u = blockIdx.x; u < 1024 + 512; u += G) { if (u < 1024) lru_unit<1>(a, l, u, lds); else pool_unit(a, l, u - 1024, lds); }
            SEAM(pb + 2);
        }
        if (EN(4) && IN(pb + 3)) {
            for (int u = blockIdx.x; u < 1024; u += G) lru_unit<2>(a, l, u, lds);
            SEAM(pb + 3);
        }
        if (EN(5) && IN(pb + 4)) {
            pg8::PlainSched S{(const char*)(ws + WS_ACAT), (const char*)(ws + WS_WCAT) + (size_t)l * 1024 * KCAT * 2, KCAT, T / 256, D / 256, G, (int)blockIdx.x};
            pg8::EpiMerged E{(bf16_t*)(ws + WS_MERGED), (const bf16_t*)(ws + WS_Z)};
            pg8::gemm_phase<pg8::EpiMerged, pg8::PlainSched, true>(lds, KCAT, S, E);
            SEAM(pb + 4);
        }
        if (EN(6) && IN(pb + 5)) {
            pg8::PlainSched S{(const char*)(ws + WS_MERGED), (const char*)(ws + WS_WOUT) + (size_t)l * 1024 * 1024 * 2, 1024, T / 256, D / 256, G, (int)blockIdx.x};
            pg8::EpiResid E{(float*)(ws + WS_XRES), mod_l + 2 * D};
            pg8::gemm_phase<pg8::EpiResid, pg8::PlainSched, true>(lds, 1024, S, E);
            SEAM(pb + 5);
        }
        if (EN(7) && IN(pb + 6)) { phase_h(a, l, lds); SEAM(pb + 6); }
        if (EN(8) && IN(pb + 7)) {
            moe_tables(a, l, lds);
            const MoeTab mt = moe_tab_ptrs(lds);
            MoeSched1 S{(const char*)(ws + WS_H), (const char*)(ws + WS_WEIN) + (size_t)l * NE * 2048 * 1024 * 2, (const int*)(ws + WS_TOKOF), mt, mt.tilestart[NE], G, (int)blockIdx.x};
            pg8::EpiSwiglu E{(bf16_t*)(ws + WS_ACT), a.in[I_BEIN] + (size_t)l * NE * 2048};
            pg8::gemm_phase<pg8::EpiSwiglu, MoeSched1, true>(lds, 1024, S, E);
            SEAM(pb + 7);
        }
        if (EN(9) && IN(pb + 8)) {
            moe_tables(a, l, lds);
            const MoeTab mt = moe_tab_ptrs(lds);
            MoeSched2 S{(const char*)(ws + WS_ACT), (const char*)(ws + WS_WEOUT) + (size_t)l * NE * 1024 * 1024 * 2, mt, mt.tilestart[NE], G, (int)blockIdx.x};
            pg8::EpiMoeOut E{(bf16_t*)(ws + WS_OUTB), a.in[I_BEOUT] + (size_t)l * NE * D};
            pg8::gemm_phase<pg8::EpiMoeOut, MoeSched2, true>(lds, 1024, S, E);
            SEAM(pb + 8);
        }
    }
    if (EN(10) && IN(N_PHASES - 1)) phase_a(a, DEPTH, lds);
#undef IN
#undef SEAM
}

extern "C" void kernel_launch(void* const* d_in, const int* in_sizes, int n_in, void* d_out, int out_size, void* d_ws, size_t ws_size, hipStream_t stream) {
    static int grid = 0;
    if (grid == 0) {
        if (n_in != 26 || out_size != T * D || ws_size < WS_END) { fprintf(stderr, "kernel_launch: unexpected problem (n_in %d out %d ws %zu)\n", n_in, out_size, ws_size); grid = -1; return; }
        int dev = 0, cus = 0, per_cu = 0;
        if (hipGetDevice(&dev) != hipSuccess || hipDeviceGetAttribute(&cus, hipDeviceAttributeMultiprocessorCount, dev) != hipSuccess) { grid = -1; return; }
        if (hipFuncSetAttribute((const void*)fwd_kernel, hipFuncAttributeMaxDynamicSharedMemorySize, LDS_BYTES) != hipSuccess) { fprintf(stderr, "kernel_launch: hipFuncSetAttribute failed\n"); grid = -1; return; }
        if (hipOccupancyMaxActiveBlocksPerMultiprocessor(&per_cu, (const void*)fwd_kernel, NTHREADS, LDS_BYTES) != hipSuccess || per_cu < 1) fprintf(stderr, "kernel_launch: occupancy query says %d\n", per_cu);
        (void)hipGetLastError();
        grid = cus;
    }
    if (grid < 0) return;
    if (hipMemsetAsync((char*)d_ws + WS_CTL, 0, CTL_ZERO_BYTES, stream) != hipSuccess) return;
    Args a{};
    for (int i = 0; i < 26; ++i) a.in[i] = (const float*)d_in[i];
    a.out = (float*)d_out; a.ws = (unsigned char*)d_ws;
#if MK_PER_PHASE
    for (int p = 0; p < N_PHASES; ++p) { a.ph_lo = p; a.ph_hi = p + 1; hipLaunchKernelGGL(fwd_kernel, dim3(grid), dim3(NTHREADS), LDS_BYTES, stream, a); }
#else
    a.ph_lo = 0; a.ph_hi = N_PHASES;
    hipLaunchKernelGGL(fwd_kernel, dim3(grid), dim3(NTHREADS), LDS_BYTES, stream, a);
#endif
    const hipError_t le = hipPeekAtLastError();
    if (le != hipSuccess) fprintf(stderr, "kernel_launch: launch failed: %s\n", hipGetErrorName(le));
}
```

```cpp
#include <hip/hip_runtime.h>
#include <cstdio>
#include <cstdint>

#define REP_MASK 0x0
#ifndef PH_MASK
#define PH_MASK 0x7ff
#endif
#define EN(b) ((PH_MASK >> (b)) & 1)
#ifndef REP_MASK
#define REP_MASK 0
#endif
#define REPN(b) ((((REP_MASK) >> (b)) & 1) ? 2 : 1)
#ifndef MK_PER_PHASE
#define MK_PER_PHASE 0
#endif

#define LAS __attribute__((address_space(3)))
typedef unsigned short bf16_t;
typedef short bf16x8 __attribute__((ext_vector_type(8)));
typedef float f32x4 __attribute__((ext_vector_type(4)));
typedef float f32x2 __attribute__((ext_vector_type(2)));
typedef float f32x16 __attribute__((ext_vector_type(16)));
typedef unsigned u32x4 __attribute__((ext_vector_type(4)));
typedef unsigned u32x2 __attribute__((ext_vector_type(2)));

constexpr int D = 1024, NBATCH = 8, SEQ = 4096, T = NBATCH * SEQ, DEPTH = 4;
constexpr int NZ = 4608, ZO_GLRU = 1024, ZO_XPOOL = 2048, ZO_GL0 = 2560, ZO_GL1 = 3584;
constexpr int NE = 32, TOPK = 4;
constexpr int KCAT = 1536;
constexpr int SLOT_CAP = T * TOPK + NE * 256;
constexpr int MAX_MT = SLOT_CAP / 256;
constexpr float NORM_EPS = 1e-6f;
constexpr float WEIN_SCALE = 64.0f;
constexpr int NTHREADS = 512, NWAVES = 8;

constexpr size_t MiB = 1u << 20;
constexpr size_t WS_CTL = 0, CTL_ZERO_BYTES = 256 * 1024;
constexpr size_t WS_MOD = 1 * MiB;
constexpr size_t WS_CB = 2 * MiB;
constexpr size_t WS_AGG = 3 * MiB;
constexpr size_t WS_TOKOF = 6 * MiB;
constexpr size_t WS_SLOTINFO = 10 * MiB;
constexpr size_t WS_WGT = 11 * MiB;
constexpr size_t WS_WRG = 12 * MiB;
constexpr size_t WS_WPOOL = 14 * MiB;
constexpr size_t WS_WIN = 16 * MiB;
constexpr size_t WS_WCAT = 52 * MiB;
constexpr size_t WS_WOUT = 64 * MiB;
constexpr size_t WS_WEIN = 128 * MiB;
constexpr size_t WS_WEOUT = 640 * MiB;
constexpr size_t WS_XRES = 896 * MiB;
constexpr size_t WS_H = 1024 * MiB;
constexpr size_t WS_Z = 1088 * MiB;
constexpr size_t WS_ACAT = 1376 * MiB;
constexpr size_t WS_MERGED = 1472 * MiB;
constexpr size_t WS_ACT = 1536 * MiB;
constexpr size_t WS_OUTB = 1808 * MiB;
constexpr size_t WS_END = 2080 * MiB;
static_assert(WS_ACT + (size_t)SLOT_CAP * 1024 * 2 <= WS_OUTB && WS_OUTB + (size_t)SLOT_CAP * 1024 * 2 <= WS_END, "ws map");
constexpr int CW_BAR = 4096;
constexpr int CW_CNT = 8192;

constexpr int LDS_BYTES = 163840;
constexpr int LDS_TAB = 131072;
constexpr int LDS_NVA = 131072 + 8192;
constexpr int LDS_MISC = LDS_BYTES - 256;

__device__ __forceinline__ unsigned cvt_pk_bf16(float lo, float hi) { unsigned r; asm("v_cvt_pk_bf16_f32 %0, %1, %2" : "=v"(r) : "v"(lo), "v"(hi)); return r; }
__device__ __forceinline__ float bflo(unsigned w) { return __uint_as_float(w << 16); }
__device__ __forceinline__ float bfhi(unsigned w) { return __uint_as_float(w & 0xffff0000u); }
__device__ __forceinline__ float bf1(bf16_t w) { return __uint_as_float(((unsigned)w) << 16); }
__device__ __forceinline__ float sigmoidf_(float x) { return __builtin_amdgcn_rcpf(1.0f + __expf(-x)); }
__device__ __forceinline__ float wave_sum(float v) {
#pragma unroll
    for (int o = 1; o < 64; o <<= 1) v += __shfl_xor(v, o);
    return v;
}
__device__ __forceinline__ int tid_of(int wv) { int l; asm volatile("v_mbcnt_lo_u32_b32 %0, -1, 0\n\tv_mbcnt_hi_u32_b32 %0, -1, %0" : "=v"(l)); return wv * 64 + l; }
#define LDS_WAIT() asm volatile("s_waitcnt lgkmcnt(0)" ::: "memory")
#define VM_WAIT() asm volatile("s_waitcnt vmcnt(0)" ::: "memory")

namespace pg8 {
constexpr int BM = 256, BK = 64, HALF = 128, HTB = HALF * BK * 2, STAGE_BYTES = 8 * HTB, NXCD = 8, WGM = 8;
__host__ __device__ __forceinline__ int lds_byte(int r, int c) { const int st = (r >> 4) * 2 + (c >> 5), rr = r & 15, cc = c & 31, ob = rr * 64 + cc * 2; return st * 1024 + (ob ^ (((ob >> 9) & 1) << 5)); }
__host__ __device__ __forceinline__ void stage_rc(int b, int& R, int& C) { const int st = b / 1024, sb = b % 1024, swz = sb ^ (((sb >> 9) & 1) << 5); R = (st >> 1) * 16 + swz / 64; C = (st & 1) * 32 + (swz % 64) / 2; }
__host__ __device__ __forceinline__ int perm32(int rho) { const int n = rho >> 4, i = rho & 15; return 8 * (i >> 2) + 4 * n + (i & 3); }

struct Unit { int pm, pn, e, j, row0, rows; };
typedef int v8i32 __attribute__((ext_vector_type(8)));
__device__ __forceinline__ v8i32 cat8(bf16x8 lo, bf16x8 hi) { typedef int v4i32 __attribute__((ext_vector_type(4))); const v4i32 a = __builtin_bit_cast(v4i32, lo), b = __builtin_bit_cast(v4i32, hi); return (v8i32){a.x, a.y, a.z, a.w, b.x, b.y, b.z, b.w}; }

__device__ __forceinline__ bool order_map(int i, int G, int c, int nM, int nN, int& pm, int& pn) {
    const int nwg = nM * nN; const long L = (long)i * G + c; if (L >= nwg) return false;
    int wgid = (int)L; { const int q = nwg / NXCD, r = nwg % NXCD, xcd = wgid % NXCD, off = wgid / NXCD; wgid = (xcd < r ? xcd * (q + 1) : r * (q + 1) + (xcd - r) * q) + off; }
    const int nig = WGM * nN, gid = wgid / nig, fm = gid * WGM, gsz = (nM - fm) < WGM ? (nM - fm) : WGM;
    pm = fm + ((wgid % nig) % gsz); pn = (wgid % nig) / gsz; return true;
}

struct PlainSched {
    static constexpr bool DYN_A = false;
    const char* A; const char* Bt; int K, nM, nN, G, c;
    __device__ __forceinline__ bool next(int i, Unit& u) const { int pm, pn; if (!order_map(i, G, c, nM, nN, pm, pn)) return false; u.pm = pm; u.pn = pn; u.e = 0; u.j = 0; u.row0 = pm * BM; u.rows = BM; return true; }
    __device__ __forceinline__ const char* a_ptr() const { return A; }
    __device__ __forceinline__ const char* b_ptr() const { return Bt; }
    __device__ __forceinline__ unsigned a_off(const Unit& u) const { return (unsigned)u.row0 * (unsigned)K * 2u; }
    __device__ __forceinline__ unsigned b_off(const Unit& u) const { return (unsigned)u.pn * (unsigned)(BM * K * 2); }
    __device__ __forceinline__ void a_voff(const Unit&, unsigned (&v)[2][2], int wv) const {
        int tid = tid_of(wv); asm volatile("" : "+v"(tid));
#pragma unroll
        for (int i = 0; i < 2; ++i) { int R, C; stage_rc(tid * 16 + i * 8192, R, C);
#pragma unroll
            for (int h = 0; h < 2; ++h) v[h][i] = (unsigned)((h * HALF + R) * K + C) * 2u; }
    }
};

template <class Epi, class Sched, bool ALIGN_EPI, bool FP8 = false>
__device__ __forceinline__ void gemm_phase(LAS unsigned char* lds, const int K, const Sched& S, const Epi& E, const int wv) {
    int tid = tid_of(wv); asm volatile("" : "+v"(tid));
    const int wid = __builtin_amdgcn_readfirstlane(tid >> 6), lane = tid & 63, wr = wid >> 2, wc = wid & 3, fr = lane & 15, fq = lane >> 4;
    const int nt = K / BK;
    unsigned voffB[2];
#pragma unroll
    for (int i = 0; i < 2; ++i) { int R, C; stage_rc(tid * 16 + i * 8192, R, C); const int Rb = Epi::PERM ? ((R & ~31) + perm32(R & 31)) : R; voffB[i] = (unsigned)(Rb * K + C) * 2u; }
    const unsigned kstep = (unsigned)(BK * 2);
    const unsigned hstep = (unsigned)(HALF * K * 2);
    const __amdgpu_buffer_rsrc_t rsA = __builtin_amdgcn_make_buffer_rsrc((void*)S.a_ptr(), 0, 0xffffffff, 0x00020000);
    const __amdgpu_buffer_rsrc_t rsB = __builtin_amdgcn_make_buffer_rsrc((void*)S.b_ptr(), 0, 0xffffffff, 0x00020000);
    const unsigned ldsw = (unsigned)wid * 1024u;
    const int aoff = lds_byte(wr * 64 + fr, fq * 8), boff = lds_byte(wc * 32 + fr, fq * 8);
#define PG8_SA(b, h) (((b) * 2 + (h)) * HTB)
#define PG8_SB(b, h) ((4 + (b) * 2 + (h)) * HTB)
#define PG8_STAGE_(rs, bufoff, soff, voff) do { _Pragma("unroll") for (int _i = 0; _i < 2; ++_i) \
        __builtin_amdgcn_raw_ptr_buffer_load_lds(rs, (LAS void*)(lds + (bufoff) + ldsw + _i * 8192), 16, (voff)[_i], (soff), 0, 0); } while (0)
#define PG8_STAGE_A(bufoff, soff, voff) PG8_STAGE_(rsA, bufoff, soff, voff)
#define PG8_STAGE_B(bufoff, soff, voff) PG8_STAGE_(rsB, bufoff, soff, voff)
#define PG8_LDA(dst, b, h) do { _Pragma("unroll") for (int m = 0; m < 4; ++m) _Pragma("unroll") for (int k = 0; k < 2; ++k) dst[m][k] = *(const LAS bf16x8*)(lds + PG8_SA(b, h) + aoff + m * 2048 + k * 1024); } while (0)
#define PG8_LDB(dst, b, h) do { _Pragma("unroll") for (int n = 0; n < 2; ++n) _Pragma("unroll") for (int k = 0; k < 2; ++k) dst[n][k] = *(const LAS bf16x8*)(lds + PG8_SB(b, h) + boff + n * 2048 + k * 1024); } while (0)
#define PG8_MMA(ai, bj, At, Bt) do { __builtin_amdgcn_s_setprio(1); _Pragma("unroll") for (int m = 0; m < 4; ++m) _Pragma("unroll") for (int n = 0; n < 2; ++n) { \
        if constexpr (FP8) { acc[ai][bj][m][n] = __builtin_amdgcn_mfma_scale_f32_16x16x128_f8f6f4(cat8(Bt[n][0], Bt[n][1]), cat8(At[m][0], At[m][1]), acc[ai][bj][m][n], 0, 0, 0, 0x7f7f7f7f, 0, 0x7f7f7f7f); } \
        else { _Pragma("unroll") for (int k = 0; k < 2; ++k) acc[ai][bj][m][n] = __builtin_amdgcn_mfma_f32_16x16x32_bf16(Bt[n][k], At[m][k], acc[ai][bj][m][n], 0, 0, 0); } } \
        __builtin_amdgcn_s_setprio(0); } while (0)
#define PG8_WAIT_V(n) asm volatile("s_waitcnt vmcnt(" #n ")" ::: "memory")
#define PG8_WAIT_L(n) asm volatile("s_waitcnt lgkmcnt(" #n ")" ::: "memory")
#define PG8_BAR __builtin_amdgcn_s_barrier()
#define PG8_SCHED __builtin_amdgcn_sched_barrier(0)
    Unit cur, nxt; int ui = 0;
    if (!S.next(0, cur)) return;
    f32x4 acc[2][2][4][2];
    { float z0 = 0.f; asm volatile("" : "+v"(z0));
#pragma unroll
    for (int a = 0; a < 2; ++a)
#pragma unroll
        for (int b = 0; b < 2; ++b)
#pragma unroll
            for (int m = 0; m < 4; ++m)
#pragma unroll
                for (int n = 0; n < 2; ++n) acc[a][b][m][n] = (f32x4){z0, z0, z0, z0}; }
    bf16x8 At[4][2], B0[2][2], B1[2][2];
    unsigned cvA[2][2];
    LAS u32x4* nvp = (LAS u32x4*)(lds + LDS_NVA) + tid;
    S.a_voff(cur, cvA, wv);
    unsigned cA = S.a_off(cur), cB = S.b_off(cur);
    PG8_STAGE_B(PG8_SB(0, 0), cB, voffB); PG8_STAGE_B(PG8_SB(0, 1), cB + hstep, voffB); PG8_STAGE_A(PG8_SA(0, 0), cA, cvA[0]); PG8_STAGE_A(PG8_SA(0, 1), cA, cvA[1]);
    if (wr == 1) PG8_BAR;
    PG8_WAIT_V(2); PG8_BAR;
    PG8_STAGE_B(PG8_SB(1, 0), cB + kstep, voffB); PG8_STAGE_A(PG8_SA(1, 0), cA + kstep, cvA[0]); PG8_STAGE_B(PG8_SB(1, 1), cB + hstep + kstep, voffB);
    PG8_WAIT_V(6); PG8_BAR;
    for (;;) {
        const bool has_next = S.next(ui + 1, nxt);
        unsigned nA = cA, nB = cB;
        if (has_next) { nA = S.a_off(nxt); nB = S.b_off(nxt); }
        if constexpr (Sched::DYN_A) { unsigned nv[2][2];
            if (has_next) S.a_voff(nxt, nv, wv); else {
#pragma unroll
                for (int h = 0; h < 2; ++h)
#pragma unroll
                    for (int i = 0; i < 2; ++i) nv[h][i] = cvA[h][i]; }
            *nvp = (u32x4){nv[0][0], nv[0][1], nv[1][0], nv[1][1]}; }
#pragma unroll 1
        for (int t = 0; t < nt; t += 2) {
            const bool last = (t == nt - 2);
            const unsigned a1 = cA + (unsigned)(t + 1) * kstep;
            const unsigned a2 = last ? nA : cA + (unsigned)(t + 2) * kstep, b2 = last ? nB : cB + (unsigned)(t + 2) * kstep;
            const unsigned a3 = a2 + kstep, b3 = b2 + kstep;
            unsigned nx1[2] = {cvA[1][0], cvA[1][1]};
            if constexpr (Sched::DYN_A) { if (last) { const u32x4 q = *nvp; cvA[0][0] = q.x; cvA[0][1] = q.y; nx1[0] = q.z; nx1[1] = q.w; } }
            if constexpr (Epi::HOOK_T >= 0) { if (t == Epi::HOOK_T) E.mid(acc, cur, wr, wc, fr, fq); }
            PG8_LDB(B0, 0, 0); PG8_LDB(B1, 0, 1); PG8_SCHED; PG8_LDA(At, 0, 0); PG8_STAGE_A(PG8_SA(1, 1), a1, cvA[1]);
            if constexpr (Sched::DYN_A) { cvA[1][0] = nx1[0]; cvA[1][1] = nx1[1]; }
            PG8_WAIT_V(8); PG8_WAIT_L(0); PG8_BAR; PG8_MMA(0, 0, At, B0); PG8_MMA(0, 1, At, B1); PG8_BAR; PG8_SCHED;
            PG8_LDA(At, 0, 1); PG8_STAGE_B(PG8_SB(0, 0), b2, voffB); PG8_STAGE_B(PG8_SB(0, 1), b2 + hstep, voffB); PG8_STAGE_A(PG8_SA(0, 0), a2, cvA[0]);
            PG8_WAIT_V(8); PG8_WAIT_L(0); PG8_BAR; PG8_MMA(1, 0, At, B0); PG8_MMA(1, 1, At, B1); PG8_BAR; PG8_SCHED;
            PG8_LDB(B0, 1, 0); PG8_LDB(B1, 1, 1); PG8_SCHED; PG8_LDA(At, 1, 0); PG8_STAGE_A(PG8_SA(0, 1), a2, cvA[1]);
            PG8_WAIT_V(8); PG8_WAIT_L(0); PG8_BAR; PG8_MMA(0, 0, At, B0); PG8_MMA(0, 1, At, B1); PG8_BAR; PG8_SCHED;
            PG8_LDA(At, 1, 1); PG8_STAGE_B(PG8_SB(1, 0), b3, voffB); PG8_STAGE_B(PG8_SB(1, 1), b3 + hstep, voffB); PG8_STAGE_A(PG8_SA(1, 0), a3, cvA[0]);
            PG8_WAIT_V(8); PG8_WAIT_L(0); PG8_BAR; PG8_MMA(1, 0, At, B0); PG8_MMA(1, 1, At, B1); PG8_BAR; PG8_SCHED;
        }
        if constexpr (ALIGN_EPI) { if (wr == 0) PG8_BAR; }
        E(acc, cur, wr, wc, fr, fq);
        if (!has_next) break;
        { float z0 = 0.f; asm volatile("" : "+v"(z0));
#pragma unroll
        for (int a = 0; a < 2; ++a)
#pragma unroll
            for (int b = 0; b < 2; ++b)
#pragma unroll
                for (int m = 0; m < 4; ++m)
#pragma unroll
                    for (int n = 0; n < 2; ++n) acc[a][b][m][n] = (f32x4){z0, z0, z0, z0}; }
        cur = nxt; cA = nA; cB = nB; ++ui;
        if constexpr (ALIGN_EPI) { if (wr == 1) PG8_BAR; }
    }
    PG8_WAIT_V(0);
    if constexpr (!ALIGN_EPI) { if (wr == 0) PG8_BAR; }
    PG8_BAR;
#undef PG8_SA
#undef PG8_SB
#undef PG8_STAGE_
#undef PG8_STAGE_A
#undef PG8_STAGE_B
#undef PG8_LDA
#undef PG8_LDB
#undef PG8_MMA
#undef PG8_WAIT_V
#undef PG8_WAIT_L
#undef PG8_BAR
#undef PG8_SCHED
}

struct EpiBf16 {
    static constexpr bool PERM = true; static constexpr int HOOK_T = -1;
    bf16_t* O; int ldc; const float* bias; int noepi;
    __device__ __forceinline__ void mid(f32x4 (&)[2][2][4][2], const Unit&, int, int, int, int) const {}
    __device__ __forceinline__ void operator()(const f32x4 (&acc)[2][2][4][2], const Unit& u, int wr, int wc, int fr, int fq) const {
        { const int l_ = tid_of(0); fr = l_ & 15; fq = l_ >> 4; }
        if (noepi) { if (acc[0][0][0][0][0] == 1.2345e-30f) O[0] = 0; return; }
        int row0 = u.row0 + wr * 64 + fr; asm volatile("" : "+v"(row0)); int col0 = u.pn * BM + wc * 32 + 8 * fq; asm volatile("" : "+v"(col0));
        f32x4 bv[2][2];
#pragma unroll
        for (int bj = 0; bj < 2; ++bj)
#pragma unroll
            for (int n = 0; n < 2; ++n) bv[bj][n] = bias ? *(const f32x4*)(bias + col0 + bj * HALF + 4 * n) : (f32x4){0.f, 0.f, 0.f, 0.f};
#pragma unroll
        for (int ai = 0; ai < 2; ++ai)
#pragma unroll
            for (int m = 0; m < 4; ++m) { bf16_t* rowp = O + (size_t)(row0 + ai * HALF + m * 16) * ldc + col0;
#pragma unroll
                for (int bj = 0; bj < 2; ++bj) { const f32x4 v0 = acc[ai][bj][m][0] + bv[bj][0], v1 = acc[ai][bj][m][1] + bv[bj][1];
                    u32x4 w; w.x = cvt_pk_bf16(v0[0], v0[1]); w.y = cvt_pk_bf16(v0[2], v0[3]); w.z = cvt_pk_bf16(v1[0], v1[1]); w.w = cvt_pk_bf16(v1[2], v1[3]);
                    *(u32x4*)(rowp + bj * HALF) = w; } }
    }
};
struct EpiMerged {
    static constexpr bool PERM = true; static constexpr int HOOK_T = 8;
    bf16_t* O; const bf16_t* Z;
    __device__ __forceinline__ void mid(f32x4 (&acc)[2][2][4][2], const Unit& u, int wr, int wc, int fr, int fq) const {
        { const int l_ = tid_of(0); fr = l_ & 15; fq = l_ >> 4; }
        int row0 = u.row0 + wr * 64 + fr; asm volatile("" : "+v"(row0)); int col0 = u.pn * BM + wc * 32 + 8 * fq; asm volatile("" : "+v"(col0));
#pragma unroll
        for (int ai = 0; ai < 2; ++ai) {
            u32x4 l0[4][2], l1[4][2];
#pragma unroll
            for (int m = 0; m < 4; ++m) { const bf16_t* zr = Z + (size_t)(row0 + ai * HALF + m * 16) * NZ + col0;
#pragma unroll
                for (int bj = 0; bj < 2; ++bj) { l0[m][bj] = *(const u32x4*)(zr + ZO_GL0 + bj * HALF); l1[m][bj] = *(const u32x4*)(zr + ZO_GL1 + bj * HALF); } }
#pragma unroll
            for (int m = 0; m < 4; ++m)
#pragma unroll
                for (int bj = 0; bj < 2; ++bj) {
                    const unsigned a0[4] = {l0[m][bj].x, l0[m][bj].y, l0[m][bj].z, l0[m][bj].w}, a1[4] = {l1[m][bj].x, l1[m][bj].y, l1[m][bj].z, l1[m][bj].w};
#pragma unroll
                    for (int q = 0; q < 4; ++q) {
                        const float r0 = (1.0f + __expf(-bflo(a0[q]))) * __builtin_amdgcn_rcpf(1.0f + __expf(-bflo(a1[q])));
                        const float r1 = (1.0f + __expf(-bfhi(a0[q]))) * __builtin_amdgcn_rcpf(1.0f + __expf(-bfhi(a1[q])));
                        acc[ai][bj][m][q >> 1][(q & 1) * 2 + 0] *= r0; acc[ai][bj][m][q >> 1][(q & 1) * 2 + 1] *= r1; } }
            asm volatile("" ::: "memory"); }
    }
    __device__ __forceinline__ void operator()(const f32x4 (&acc)[2][2][4][2], const Unit& u, int wr, int wc, int fr, int fq) const {
        { const int l_ = tid_of(0); fr = l_ & 15; fq = l_ >> 4; }
        int row0 = u.row0 + wr * 64 + fr; asm volatile("" : "+v"(row0)); int col0 = u.pn * BM + wc * 32 + 8 * fq; asm volatile("" : "+v"(col0));
        u32x4 l0[2][4][2];
#pragma unroll
        for (int ai = 0; ai < 2; ++ai)
#pragma unroll
            for (int m = 0; m < 4; ++m) { const bf16_t* zr = Z + (size_t)(row0 + ai * HALF + m * 16) * NZ + col0;
#pragma unroll
                for (int bj = 0; bj < 2; ++bj) l0[ai][m][bj] = *(const u32x4*)(zr + ZO_GL0 + bj * HALF); }
#pragma unroll
        for (int ai = 0; ai < 2; ++ai)
#pragma unroll
            for (int m = 0; m < 4; ++m) { bf16_t* orow = O + (size_t)(row0 + ai * HALF + m * 16) * D + col0;
#pragma unroll
                for (int bj = 0; bj < 2; ++bj) {
                    const unsigned a0[4] = {l0[ai][m][bj].x, l0[ai][m][bj].y, l0[ai][m][bj].z, l0[ai][m][bj].w};
                    float o[8];
#pragma unroll
                    for (int q = 0; q < 4; ++q) { o[2 * q] = acc[ai][bj][m][q >> 1][(q & 1) * 2 + 0] * sigmoidf_(bflo(a0[q])); o[2 * q + 1] = acc[ai][bj][m][q >> 1][(q & 1) * 2 + 1] * sigmoidf_(bfhi(a0[q])); }
                    u32x4 w; w.x = cvt_pk_bf16(o[0], o[1]); w.y = cvt_pk_bf16(o[2], o[3]); w.z = cvt_pk_bf16(o[4], o[5]); w.w = cvt_pk_bf16(o[6], o[7]);
                    *(u32x4*)(orow + bj * HALF) = w; } }
    }
};
struct EpiResid {
    static constexpr bool PERM = false; static constexpr int HOOK_T = -1;
    float* X; float* XO; const float* gate;
    __device__ __forceinline__ void mid(f32x4 (&)[2][2][4][2], const Unit&, int, int, int, int) const {}
    __device__ __forceinline__ void operator()(const f32x4 (&acc)[2][2][4][2], const Unit& u, int wr, int wc, int fr, int fq) const {
        { const int l_ = tid_of(0); fr = l_ & 15; fq = l_ >> 4; }
        int row0 = u.row0 + wr * 64 + fr; asm volatile("" : "+v"(row0)); int col0 = u.pn * BM + wc * 32 + 4 * fq; asm volatile("" : "+v"(col0));
        const float* gp = gate + (size_t)(u.row0 / SEQ) * (6 * D) + col0;
        f32x4 gv[2][2];
#pragma unroll
        for (int bj = 0; bj < 2; ++bj)
#pragma unroll
            for (int n = 0; n < 2; ++n) gv[bj][n] = *(const f32x4*)(gp + bj * HALF + n * 16);
#pragma unroll
        for (int ai = 0; ai < 2; ++ai) {
            f32x4 xv[4][2][2];
#pragma unroll
            for (int m = 0; m < 4; ++m) { const float* rowp = X + (size_t)(row0 + ai * HALF + m * 16) * D + col0;
#pragma unroll
                for (int bj = 0; bj < 2; ++bj)
#pragma unroll
                    for (int n = 0; n < 2; ++n) xv[m][bj][n] = *(const f32x4*)(rowp + bj * HALF + n * 16); }
#pragma unroll
            for (int m = 0; m < 4; ++m) { float* rowo = XO + (size_t)(row0 + ai * HALF + m * 16) * D + col0;
#pragma unroll
                for (int bj = 0; bj < 2; ++bj)
#pragma unroll
                    for (int n = 0; n < 2; ++n) *(f32x4*)(rowo + bj * HALF + n * 16) = xv[m][bj][n] + gv[bj][n] * acc[ai][bj][m][n]; }
            asm volatile("" ::: "memory"); }
    }
};
struct EpiSwiglu {
    static constexpr bool PERM = true; static constexpr int HOOK_T = -1;
    bf16_t* ACT; const float* bias; float wscale;
    __device__ __forceinline__ void mid(f32x4 (&)[2][2][4][2], const Unit&, int, int, int, int) const {}
    __device__ __forceinline__ void operator()(const f32x4 (&acc)[2][2][4][2], const Unit& u, int wr, int wc, int fr, int fq) const {
        { const int l_ = tid_of(0); fr = l_ & 15; fq = l_ >> 4; }
        int row0 = u.row0 + wr * 64 + fr; asm volatile("" : "+v"(row0)); int cc = u.pn * HALF + wc * 32 + 8 * fq; asm volatile("" : "+v"(cc));
        const float* bp = bias + (size_t)u.e * 2048 + cc;
        f32x4 bg[2], bu[2];
#pragma unroll
        for (int n = 0; n < 2; ++n) { bg[n] = *(const f32x4*)(bp + 4 * n); bu[n] = *(const f32x4*)(bp + 1024 + 4 * n); }
#pragma unroll
        for (int ai = 0; ai < 2; ++ai)
#pragma unroll
            for (int m = 0; m < 4; ++m) { bf16_t* rowp = ACT + (size_t)(row0 + ai * HALF + m * 16) * D + cc;
                float o[8];
#pragma unroll
                for (int n = 0; n < 2; ++n)
#pragma unroll
                    for (int j = 0; j < 4; ++j) { float g = acc[ai][0][m][n][j] * wscale + bg[n][j], up = acc[ai][1][m][n][j] * wscale + bu[n][j];
                        g = fminf(g, 7.0f); up = fminf(fmaxf(up, -7.0f), 7.0f);
                        o[4 * n + j] = g * sigmoidf_(1.702f * g) * (up + 1.0f); }
                u32x4 w; w.x = cvt_pk_bf16(o[0], o[1]); w.y = cvt_pk_bf16(o[2], o[3]); w.z = cvt_pk_bf16(o[4], o[5]); w.w = cvt_pk_bf16(o[6], o[7]);
                *(u32x4*)rowp = w; }
    }
};
struct EpiMoeOut {
    static constexpr bool PERM = true; static constexpr int HOOK_T = -1;
    bf16_t* O; const float* bias;
    __device__ __forceinline__ void mid(f32x4 (&)[2][2][4][2], const Unit&, int, int, int, int) const {}
    __device__ __forceinline__ void operator()(const f32x4 (&acc)[2][2][4][2], const Unit& u, int wr, int wc, int fr, int fq) const {
        const EpiBf16 e{O, D, bias + (size_t)u.e * D, 0}; e(acc, u, wr, wc, fr, fq);
    }
};
}

#define XB_TMO      128
#define XB_XCNT(j)  (256  + 64 * (j))
#define XB_XSUB(j)  (1280 + 64 * (j))
#define XB_XGEN(j)  (2304 + 64 * (j))
#define XB_TOP      3328
#define XB_TOPGEN   3392
#define XCD_BAR_WORDS 3456
#define XB_SPIN_CAP (1u << 18)
__device__ __forceinline__ unsigned xb_ld(unsigned* p)              { return __hip_atomic_load(p, __ATOMIC_RELAXED, __HIP_MEMORY_SCOPE_AGENT); }
__device__ __forceinline__ unsigned xb_add(unsigned* p, unsigned v) { return __hip_atomic_fetch_add(p, v, __ATOMIC_RELAXED, __HIP_MEMORY_SCOPE_AGENT); }
__device__ __forceinline__ unsigned xb_xcc_id() { return (unsigned)__builtin_amdgcn_s_getreg((3 << 11) | 20) & 0xFu; }
#define XB_SPIN(cond, bar) do { unsigned _sp = 0; while (cond) { __builtin_amdgcn_s_sleep(1); \
    if ((++_sp & 255u) == 0u) { if (xb_ld(&(bar)[XB_TMO])) break; if (_sp > XB_SPIN_CAP) { atomicAdd(&(bar)[XB_TMO], 1u); break; } } } } while (0)
struct XcdBarrier { unsigned* bar; unsigned x; volatile LAS unsigned* st; int wv; };
__device__ __forceinline__ XcdBarrier xcd_barrier_post(unsigned* bar, volatile LAS unsigned* st, int wv) {
    XcdBarrier b; b.bar = bar; b.x = xb_xcc_id(); b.st = st; b.wv = wv;
    if (tid_of(wv) == 0) (void)xb_add(&bar[XB_XCNT(b.x)], 1u);
    return b;
}
__device__ __forceinline__ void xcd_barrier_complete(unsigned* bar, unsigned x, unsigned& nloc, unsigned& nx) {
    const unsigned G = gridDim.x * gridDim.y * gridDim.z;
    unsigned sum, cnt, mine, sp = 0u;
    for (;;) {
        sum = 0u; cnt = 0u; mine = 0u;
#pragma unroll
        for (unsigned j = 0; j < 16; ++j) { const unsigned c = xb_ld(&bar[XB_XCNT(j)]); sum += c; cnt += (c > 0u) ? 1u : 0u; mine = (j == x) ? c : mine; }
        if (sum == G) break;
        __builtin_amdgcn_s_sleep(1);
        if ((++sp & 255u) == 0u) { if (xb_ld(&bar[XB_TMO])) break; if (sp > XB_SPIN_CAP) { atomicAdd(&bar[XB_TMO], 1u); break; } }
    }
    nloc = mine > 0u ? mine : 1u; nx = cnt > 0u ? cnt : 1u;
}
__device__ __forceinline__ void xcd_barrier(const XcdBarrier& b) {
    asm volatile("s_waitcnt vmcnt(0)" ::: "memory");
    __syncthreads();
    if (tid_of(b.wv) == 0) {
        unsigned* bar = b.bar; asm volatile("" : "+s"(bar));
        __builtin_amdgcn_s_waitcnt(0);
        unsigned nloc = b.st[0], nx = b.st[1];
        if (nloc == 0u) { xcd_barrier_complete(bar, b.x, nloc, nx); b.st[0] = nloc; b.st[1] = nx; }
        const unsigned old = xb_add(&bar[XB_XSUB(b.x)], 1u);
        const unsigned gen = old / nloc;
        if (old + 1u == (gen + 1u) * nloc) {
            __builtin_amdgcn_fence(__ATOMIC_RELEASE, "agent");
            asm volatile("s_waitcnt vmcnt(0)" ::: "memory");
            const unsigned og = xb_add(&bar[XB_TOP], 1u);
            const unsigned tg = og / nx;
            if (og + 1u == (tg + 1u) * nx) xb_add(&bar[XB_TOPGEN], 1u);
            else XB_SPIN(xb_ld(&bar[XB_TOPGEN]) == tg, bar);
            __builtin_amdgcn_fence(__ATOMIC_ACQUIRE, "agent");
            xb_add(&bar[XB_XGEN(b.x)], 1u);
            asm volatile("s_waitcnt vmcnt(0)" ::: "memory");
        } else {
            XB_SPIN(xb_ld(&bar[XB_XGEN(b.x)]) == gen, bar);
            __builtin_amdgcn_fence(__ATOMIC_ACQUIRE, "agent");
            asm volatile("s_waitcnt vmcnt(0)" ::: "memory");
        }
    }
    __syncthreads();
}

struct Args { const float* in[26]; float* out; unsigned char* ws; int ph_lo, ph_hi; };
enum { I_X = 0, I_C, I_N1G, I_N2G, I_WADA, I_BADA, I_WIN, I_CONVW, I_CONVB, I_WRGA, I_BRGA, I_WRGX, I_BRGX, I_LAM, I_WPOOL, I_PSCALE, I_WUPA, I_WUPB, I_WOUT, I_WROUTER, I_BROUTER, I_WEIN, I_BEIN, I_WEOUT, I_BEOUT, I_FINALG };

template <int ROWMODE>
__device__ __forceinline__ void tr_item(const float* W, int N, bf16_t* WT, int dst_ld, int dst_off, int k0, int n0, LAS float* scr, int lane) {
#pragma unroll 8
    for (int i = 0; i < 32; ++i) { const int kk = 2 * i + (lane >> 5); scr[kk * 33 + (lane & 31)] = W[(size_t)(k0 + kk) * N + n0 + (lane & 31)]; }
    LDS_WAIT();
    const int c = lane & 7;
#pragma unroll
    for (int j = 0; j < 4; ++j) { const int n = (lane >> 3) + 8 * j; const LAS float* s = scr + (8 * c) * 33 + n;
        u32x4 o; o.x = cvt_pk_bf16(s[0 * 33], s[1 * 33]); o.y = cvt_pk_bf16(s[2 * 33], s[3 * 33]); o.z = cvt_pk_bf16(s[4 * 33], s[5 * 33]); o.w = cvt_pk_bf16(s[6 * 33], s[7 * 33]);
        const int nn = n0 + n; int drow = nn;
        if (ROWMODE == 1) { drow = (nn < 1024) ? (256 * (nn >> 7) + (nn & 127)) : (256 * ((nn - 1024) >> 7) + 128 + ((nn - 1024) & 127)); }
        *(u32x4*)(WT + (size_t)drow * dst_ld + dst_off + k0 + 8 * c) = o; }
    LDS_WAIT();
}
__device__ __forceinline__ void tr_item_fp8(const float* W, int N, unsigned char* WT, int k0, int n0, LAS float* scr, int lane) {
#pragma unroll 8
    for (int i = 0; i < 64; ++i) { const int kk = 2 * i + (lane >> 5); scr[kk * 33 + (lane & 31)] = W[(size_t)(k0 + kk) * N + n0 + (lane & 31)]; }
    LDS_WAIT();
    const int c = lane & 7;
#pragma unroll
    for (int j = 0; j < 4; ++j) { const int n = (lane >> 3) + 8 * j; const LAS float* s = scr + (16 * c) * 33 + n;
        int o[4];
#pragma unroll
        for (int q = 0; q < 4; ++q) { int w = 0; w = __builtin_amdgcn_cvt_pk_fp8_f32(s[(4 * q) * 33] * WEIN_SCALE, s[(4 * q + 1) * 33] * WEIN_SCALE, w, false);
            w = __builtin_amdgcn_cvt_pk_fp8_f32(s[(4 * q + 2) * 33] * WEIN_SCALE, s[(4 * q + 3) * 33] * WEIN_SCALE, w, true); o[q] = w; }
        const int nn = n0 + n; const int drow = (nn < 1024) ? (256 * (nn >> 7) + (nn & 127)) : (256 * ((nn - 1024) >> 7) + 128 + ((nn - 1024) & 127));
        *(u32x4*)(WT + (size_t)drow * 1024 + k0 + 16 * c) = (u32x4){(unsigned)o[0], (unsigned)o[1], (unsigned)o[2], (unsigned)o[3]}; }
    LDS_WAIT();
}
template <int ROWMODE>
__device__ __forceinline__ void tr_job(int item, const float* src, int K, int N, bf16_t* dst, size_t dst_bstride, int dst_ld, int dst_off, LAS float* scr, int lane) {
    const int nnb = N / 32, nkb = K / 64; const int nb = item % nnb; const int r = item / nnb; const int kb = r % nkb; const int bt = r / nkb;
    tr_item<ROWMODE>(src + (size_t)bt * K * N, N, dst + (size_t)bt * dst_bstride, dst_ld, dst_off, 64 * kb, 32 * nb, scr, lane);
}

__device__ __forceinline__ void phase_prologue(const Args& a, LAS unsigned char* lds, const int wv) {
    int tid_ = tid_of(wv); asm volatile("" : "+v"(tid_)); const int tid = tid_, lane = tid & 63, wave = __builtin_amdgcn_readfirstlane(tid >> 6);
    const int G = gridDim.x;
    unsigned char* ws = a.ws;
    {
        LAS float* cact = (LAS float*)lds;
        LAS float* red = (LAS float*)(lds + 32768);
        for (int i = tid; i < NBATCH * D; i += NTHREADS) { const float v = a.in[I_C][i]; cact[i] = v * sigmoidf_(v); }
        __syncthreads();
        float* mod = (float*)(ws + WS_MOD);
        for (int u = blockIdx.x; u < DEPTH * 96; u += G) {
            const int l = u / 96, cg = u % 96; const int n = cg * 64 + lane;
            const float* w = a.in[I_WADA] + (size_t)l * D * 6144 + n;
            float acc[8] = {0.f, 0.f, 0.f, 0.f, 0.f, 0.f, 0.f, 0.f};
            const int kb = wave * 128;
#pragma unroll 8
            for (int k = 0; k < 128; ++k) { const float wv = w[(size_t)(kb + k) * 6144];
#pragma unroll
                for (int b = 0; b < 8; ++b) acc[b] += cact[b * D + kb + k] * wv; }
#pragma unroll
            for (int b = 0; b < 8; ++b) red[(wave * 8 + b) * 64 + lane] = acc[b];
            __syncthreads();
            { const int b = tid >> 6; float s = 0.f;
#pragma unroll
              for (int w8 = 0; w8 < 8; ++w8) s += red[(w8 * 8 + b) * 64 + lane];
              mod[((size_t)l * NBATCH + b) * 6144 + n] = s + a.in[I_BADA][(size_t)l * 6144 + n]; }
            __syncthreads();
        }
    }
    {
        LAS float* scr = (LAS float*)(lds + wave * 16896);
        const int gw = blockIdx.x * NWAVES + wave, NGW = G * NWAVES;
        constexpr int I_EIN = DEPTH * NE * 8 * 64, I_EOUT = DEPTH * NE * 16 * 32, I_WINI = DEPTH * 16 * 144, I_UPA = DEPTH * 16 * 32, I_UPB = DEPTH * 8 * 32, I_OUT = DEPTH * 16 * 32,
                      I_RGA = DEPTH * 8 * 2 * 4, I_RGX = I_RGA, I_POOL = DEPTH * 4 * 2 * 4;
        constexpr int NITEMS = I_EIN + I_EOUT + I_WINI + I_UPA + I_UPB + I_OUT + I_RGA + I_RGX + I_POOL;
        for (int it = gw; it < NITEMS; it += NGW) {
            int r = it;
            if (r < I_EIN) { const int nb = r % 64, r2 = r / 64, kb = r2 % 8, bt = r2 / 8;
                tr_item_fp8(a.in[I_WEIN] + (size_t)bt * 1024 * 2048, 2048, (unsigned char*)(ws + WS_WEIN) + (size_t)bt * 2048 * 1024, 128 * kb, 32 * nb, scr, lane); continue; } r -= I_EIN;
            if (r < I_EOUT) { tr_job<0>(r, a.in[I_WEOUT], 1024, 1024, (bf16_t*)(ws + WS_WEOUT), (size_t)1024 * 1024, 1024, 0, scr, lane); continue; } r -= I_EOUT;
            if (r < I_WINI) { tr_job<0>(r, a.in[I_WIN], 1024, NZ, (bf16_t*)(ws + WS_WIN), (size_t)NZ * 1024, 1024, 0, scr, lane); continue; } r -= I_WINI;
            if (r < I_UPA) { tr_job<0>(r, a.in[I_WUPA], 1024, 1024, (bf16_t*)(ws + WS_WCAT), (size_t)1024 * KCAT, KCAT, 512, scr, lane); continue; } r -= I_UPA;
            if (r < I_UPB) { tr_job<0>(r, a.in[I_WUPB], 512, 1024, (bf16_t*)(ws + WS_WCAT), (size_t)1024 * KCAT, KCAT, 0, scr, lane); continue; } r -= I_UPB;
            if (r < I_OUT) { tr_job<0>(r, a.in[I_WOUT], 1024, 1024, (bf16_t*)(ws + WS_WOUT), (size_t)1024 * 1024, 1024, 0, scr, lane); continue; } r -= I_OUT;
            if (r < I_RGA) { tr_job<0>(r, a.in[I_WRGA], 128, 128, (bf16_t*)(ws + WS_WRG), (size_t)256 * 128, 128, 0, scr, lane); continue; } r -= I_RGA;
            if (r < I_RGX) { tr_job<0>(r, a.in[I_WRGX], 128, 128, (bf16_t*)(ws + WS_WRG) + 128 * 128, (size_t)256 * 128, 128, 0, scr, lane); continue; } r -= I_RGX;
            tr_job<0>(r, a.in[I_WPOOL], 128, 128, (bf16_t*)(ws + WS_WPOOL), (size_t)128 * 128, 128, 0, scr, lane);
        }
    }
}

struct MoeTab { LAS int* cnt; LAS int* padstart; LAS int* tilestart; LAS int* tab; };
__device__ __forceinline__ MoeTab moe_tab_ptrs(LAS unsigned char* lds) { MoeTab t; t.cnt = (LAS int*)(lds + LDS_TAB); t.padstart = t.cnt + 32; t.tilestart = t.padstart + 40; t.tab = t.tilestart + 40; return t; }
__device__ __forceinline__ void moe_tables(const Args& a, int l, LAS unsigned char* lds, const int wv) {
    const MoeTab mt = moe_tab_ptrs(lds); int tid_ = tid_of(wv); asm volatile("" : "+v"(tid_)); const int tid = tid_;
    unsigned* ctl = (unsigned*)(a.ws + WS_CTL);
    __syncthreads();
    if (tid < NE) mt.cnt[tid] = (int)__hip_atomic_load(ctl + CW_CNT + (l * NE + tid) * 16, __ATOMIC_RELAXED, __HIP_MEMORY_SCOPE_AGENT);
    __syncthreads();
    if (tid == 0) { int ps = 0, ts = 0; for (int e = 0; e < NE; ++e) { mt.padstart[e] = ps; mt.tilestart[e] = ts; const int nt = (mt.cnt[e] + 255) >> 8; ps += nt * 256; ts += nt; } mt.padstart[NE] = ps; mt.tilestart[NE] = ts; }
    __syncthreads();
    const int nMt = mt.tilestart[NE];
    for (int m = tid; m < nMt; m += NTHREADS) { int e = 0; for (int q = 1; q < NE; ++q) e = (mt.tilestart[q] <= m) ? q : e; mt.tab[m] = (e << 16) | (m - mt.tilestart[e]); }
    __syncthreads();
}
struct MoeSched1 {
    static constexpr bool DYN_A = true;
    const char* H; const char* W; const int* tokof; MoeTab mt; int nMt, G, c;
    __device__ __forceinline__ bool next(int i, pg8::Unit& u) const { int pm, pn; if (!pg8::order_map(i, G, c, nMt, 8, pm, pn)) return false;
        const int en = __builtin_amdgcn_readfirstlane(mt.tab[pm]); u.pm = pm; u.pn = pn; u.e = en >> 16; u.j = en & 0xffff;
        u.row0 = __builtin_amdgcn_readfirstlane(mt.padstart[u.e]) + 256 * u.j; u.rows = __builtin_amdgcn_readfirstlane(mt.cnt[u.e]) - 256 * u.j; return true; }
    __device__ __forceinline__ const char* a_ptr() const { return H; }
    __device__ __forceinline__ const char* b_ptr() const { return W; }
    __device__ __forceinline__ unsigned a_off(const pg8::Unit&) const { return 0u; }
    __device__ __forceinline__ unsigned b_off(const pg8::Unit& u) const { return ((unsigned)u.e * 2048u + (unsigned)u.pn * 256u) * 1024u; }
    __device__ __forceinline__ void a_voff(const pg8::Unit& u, unsigned (&v)[2][2], int wv) const {
        int tid = tid_of(wv); asm volatile("" : "+v"(tid));
        const int* tl = tokof + (size_t)u.e * T + 256 * u.j; const int rmax = u.rows - 1;
#pragma unroll
        for (int i = 0; i < 2; ++i) { int R, C; pg8::stage_rc(tid * 16 + i * 8192, R, C);
#pragma unroll
            for (int h = 0; h < 2; ++h) { int idx = h * 128 + R; idx = idx < rmax ? idx : rmax; v[h][i] = (unsigned)tl[idx] * 1024u + (unsigned)C * 2u; } }
    }
};
struct MoeSched2 {
    static constexpr bool DYN_A = false;
    const char* ACT; const char* W; MoeTab mt; int nMt, G, c;
    __device__ __forceinline__ bool next(int i, pg8::Unit& u) const { int pm, pn; if (!pg8::order_map(i, G, c, nMt, 4, pm, pn)) return false;
        const int en = __builtin_amdgcn_readfirstlane(mt.tab[pm]); u.pm = pm; u.pn = pn; u.e = en >> 16; u.j = en & 0xffff;
        u.row0 = __builtin_amdgcn_readfirstlane(mt.padstart[u.e]) + 256 * u.j; u.rows = __builtin_amdgcn_readfirstlane(mt.cnt[u.e]) - 256 * u.j; return true; }
    __device__ __forceinline__ const char* a_ptr() const { return ACT; }
    __device__ __forceinline__ const char* b_ptr() const { return W; }
    __device__ __forceinline__ unsigned a_off(const pg8::Unit& u) const { return (unsigned)u.row0 * 2048u; }
    __device__ __forceinline__ unsigned b_off(const pg8::Unit& u) const { return ((unsigned)u.e * 1024u + (unsigned)u.pn * 256u) * 2048u; }
    __device__ __forceinline__ void a_voff(const pg8::Unit&, unsigned (&v)[2][2], int wv) const {
        int tid = tid_of(wv); asm volatile("" : "+v"(tid));
#pragma unroll
        for (int i = 0; i < 2; ++i) { int R, C; pg8::stage_rc(tid * 16 + i * 8192, R, C);
#pragma unroll
            for (int h = 0; h < 2; ++h) v[h][i] = (unsigned)((h * 128 + R) * 1024 + C) * 2u; }
    }
};

__device__ __forceinline__ void phase_a(const Args& a, int l, LAS unsigned char* lds, bool dry, const int wv) {
    int tid_ = tid_of(wv); asm volatile("" : "+v"(tid_)); const int tid = tid_, lane = tid & 63, wave = __builtin_amdgcn_readfirstlane(tid >> 6);
    const int G = gridDim.x; unsigned char* ws = a.ws;
    const float* mod = (const float*)(ws + WS_MOD);
    float* xres = (float*)(ws + WS_XRES); float* xout = dry ? (float*)(ws + WS_Z) : xres;
    if (l < DEPTH && blockIdx.x < NBATCH) {
        LAS float* red = (LAS float*)lds;
        const int b = blockIdx.x, e = tid & 31, kp = tid >> 5;
        const float* sh2 = mod + ((size_t)l * NBATCH + b) * 6144 + 3 * D; const float* wr = a.in[I_WROUTER] + (size_t)l * D * NE;
        float s = 0.f;
        for (int k = kp * 64; k < kp * 64 + 64; ++k) s += sh2[k] * wr[k * NE + e];
        red[kp * 32 + e] = s;
        __syncthreads();
        if (tid < 32) { float t = a.in[I_BROUTER][l * NE + tid]; for (int q = 0; q < 16; ++q) t += red[q * 32 + tid]; ((float*)(ws + WS_CB))[(l * NBATCH + b) * NE + tid] = t; }
        __syncthreads();
    }
    if (l > 0) moe_tables(a, (l - 1) + DEPTH * (REPN(7) - 1), lds, wv);
    const MoeTab mt = moe_tab_ptrs(lds);
    const int* slotinfo = (const int*)(ws + WS_SLOTINFO); const float* wgt = (const float*)(ws + WS_WGT);
    const bf16_t* outb = (const bf16_t*)(ws + WS_OUTB);
    bf16_t* hb = (bf16_t*)(ws + WS_H);
    for (int chunk = blockIdx.x; chunk < T / 128; chunk += G) {
        const int rowb = chunk * 128 + wave * 16; const int b = rowb / SEQ;
        const float* xin = (l == 0) ? (a.in[I_X] + (size_t)rowb * D) : (xres + (size_t)rowb * D);
        f32x4 xv[3][4]; int4 si[3]; f32x4 wv[3]; u32x2 gv[2][4][4];
#define PA_S0(r) do { if ((r) < 16) { _Pragma("unroll") for (int j = 0; j < 4; ++j) xv[(r) % 3][j] = *(const f32x4*)(xin + (size_t)(r) * D + 4 * lane + 256 * j); \
            if (l > 0) { si[(r) % 3] = *(const int4*)(slotinfo + (size_t)(rowb + (r)) * 4); wv[(r) % 3] = *(const f32x4*)(wgt + (size_t)(rowb + (r)) * 4); } } } while (0)
#define PA_S1(r) do { if ((r) < 16 && l > 0) { const int sl_[4] = {si[(r) % 3].x, si[(r) % 3].y, si[(r) % 3].z, si[(r) % 3].w}; \
            _Pragma("unroll") for (int kk = 0; kk < 4; ++kk) { const int e_ = sl_[kk] >> 24, li_ = sl_[kk] & 0xffffff; const bf16_t* orow = outb + (size_t)(mt.padstart[e_] + li_) * D + 4 * lane; \
                _Pragma("unroll") for (int j = 0; j < 4; ++j) gv[(r) % 2][kk][j] = *(const u32x2*)(orow + 256 * j); } } } while (0)
        PA_S0(0); PA_S0(1); PA_S1(0);
#pragma unroll
        for (int i = 0; i < 16; ++i) {
            const int row = rowb + i;
            PA_S0(i + 2); PA_S1(i + 1);
            f32x4 v[4];
#pragma unroll
            for (int j = 0; j < 4; ++j) v[j] = xv[i % 3][j];
            if (l > 0) {
                f32x4 y[4];
#pragma unroll
                for (int j = 0; j < 4; ++j) y[j] = (f32x4){0.f, 0.f, 0.f, 0.f};
#pragma unroll
                for (int kk = 0; kk < 4; ++kk) { const float w = wv[i % 3][kk];
#pragma unroll
                    for (int j = 0; j < 4; ++j) { const u32x2 p = gv[i % 2][kk][j]; y[j] += w * (f32x4){bflo(p.x), bfhi(p.x), bflo(p.y), bfhi(p.y)}; } }
                const float* g2 = mod + ((size_t)(l - 1) * NBATCH + b) * 6144 + 5 * D + 4 * lane;
#pragma unroll
                for (int j = 0; j < 4; ++j) v[j] += *(const f32x4*)(g2 + 256 * j) * y[j];
            }
            if (l < DEPTH) {
#pragma unroll
                for (int j = 0; j < 4; ++j) *(f32x4*)(xout + (size_t)row * D + 4 * lane + 256 * j) = v[j];
            }
            float ss = 0.f;
#pragma unroll
            for (int j = 0; j < 4; ++j) ss += (v[j].x * v[j].x + v[j].y * v[j].y) + (v[j].z * v[j].z + v[j].w * v[j].w);
            const float rinv = 1.0f / sqrtf(wave_sum(ss) * (1.0f / D) + NORM_EPS);
            if (l < DEPTH) {
                const float* ng = a.in[I_N1G] + (size_t)l * D + 4 * lane; const float* mb = mod + ((size_t)l * NBATCH + b) * 6144 + 4 * lane;
#pragma unroll
                for (int j = 0; j < 4; ++j) { const f32x4 g = *(const f32x4*)(ng + 256 * j), sh = *(const f32x4*)(mb + 256 * j), sc = *(const f32x4*)(mb + D + 256 * j);
                    const f32x4 h = (v[j] * rinv * g) * (1.0f + sc) + sh;
                    u32x2 p; p.x = cvt_pk_bf16(h.x, h.y); p.y = cvt_pk_bf16(h.z, h.w); *(u32x2*)(hb + (size_t)row * D + 4 * lane + 256 * j) = p; }
            } else {
                const float* fg = a.in[I_FINALG] + 4 * lane;
#pragma unroll
                for (int j = 0; j < 4; ++j) *(f32x4*)(a.out + (size_t)row * D + 4 * lane + 256 * j) = v[j] * rinv * *(const f32x4*)(fg + 256 * j);
            }
        }
#undef PA_S0
#undef PA_S1
    }
}

__device__ __forceinline__ void phase_h(const Args& a, int l, int cset, LAS unsigned char* lds, const int wv) {
    int tid_ = tid_of(wv); asm volatile("" : "+v"(tid_)); const int tid = tid_, lane = tid & 63, wave = __builtin_amdgcn_readfirstlane(tid >> 6);
    const int G = gridDim.x; unsigned char* ws = a.ws;
    const float* mod = (const float*)(ws + WS_MOD); const float* xres = (const float*)(ws + WS_XRES);
    unsigned char* h8 = (unsigned char*)(ws + WS_H);
    LAS float* rinvs = (LAS float*)lds;
    LAS float* lgt = (LAS float*)(lds + 1024);
    LAS int* hist = (LAS int*)(lds + 1024 + 8 * 16 * 33 * 4);
    LAS int* base = hist + 32;
    unsigned* ctl = (unsigned*)(ws + WS_CTL);
    const float* wr = a.in[I_WROUTER] + (size_t)l * D * NE;
    const float* ng = a.in[I_N2G] + (size_t)l * D;
    const float* cbv = (const float*)(ws + WS_CB);
    int* tokof = (int*)(ws + WS_TOKOF); int* slotinfo = (int*)(ws + WS_SLOTINFO); float* wgt = (float*)(ws + WS_WGT);
    for (int chunk = blockIdx.x; chunk < T / 128; chunk += G) {
        const int row0 = chunk * 128 + wave * 16; const int b = row0 / SEQ;
        const float* mb = mod + ((size_t)l * NBATCH + b) * 6144 + 3 * D;
        if (tid < 32) hist[tid] = 0;
        f32x4 xq[3][4];
#pragma unroll
        for (int r = 0; r < 2; ++r)
#pragma unroll
            for (int j = 0; j < 4; ++j) xq[r][j] = *(const f32x4*)(xres + (size_t)(row0 + r) * D + 4 * lane + 256 * j);
#pragma unroll
        for (int i = 0; i < 16; ++i) {
            const int row = row0 + i;
            if (i + 2 < 16) {
#pragma unroll
                for (int j = 0; j < 4; ++j) xq[(i + 2) % 3][j] = *(const f32x4*)(xres + (size_t)(row + 2) * D + 4 * lane + 256 * j); }
            f32x4 v[4]; float ss = 0.f;
#pragma unroll
            for (int j = 0; j < 4; ++j) { v[j] = xq[i % 3][j]; ss += (v[j].x * v[j].x + v[j].y * v[j].y) + (v[j].z * v[j].z + v[j].w * v[j].w); }
            const float rinv = 1.0f / sqrtf(wave_sum(ss) * (1.0f / D) + NORM_EPS);
            if (lane == 0) rinvs[wave * 16 + i] = rinv;
#pragma unroll
            for (int j = 0; j < 4; ++j) { const f32x4 g = *(const f32x4*)(ng + 4 * lane + 256 * j), sh = *(const f32x4*)(mb + 4 * lane + 256 * j), sc = *(const f32x4*)(mb + D + 4 * lane + 256 * j);
                const f32x4 h = (v[j] * rinv * g) * (1.0f + sc) + sh;
                int p = 0; p = __builtin_amdgcn_cvt_pk_fp8_f32(h.x, h.y, p, false); p = __builtin_amdgcn_cvt_pk_fp8_f32(h.z, h.w, p, true);
                *(int*)(h8 + (size_t)row * D + 4 * lane + 256 * j) = p; }
        }
        {
            const int ri = lane & 15, q = lane >> 4;
            const float* xr = xres + (size_t)(row0 + ri) * D + 4 * q;
            f32x4 acc0 = {0.f, 0.f, 0.f, 0.f}, acc1 = {0.f, 0.f, 0.f, 0.f};
#pragma unroll 4
            for (int g = 0; g < 64; ++g) {
                const int k0 = 16 * g + 4 * q;
                const f32x4 xv = *(const f32x4*)(xr + 16 * g); const f32x4 gv = *(const f32x4*)(ng + k0), sc = *(const f32x4*)(mb + D + k0);
                const f32x4 av = xv * gv * (1.0f + sc);
#pragma unroll
                for (int e = 0; e < 4; ++e) { const float* wp = wr + (size_t)(k0 + e) * NE + ri;
                    acc0 = __builtin_amdgcn_mfma_f32_16x16x4f32(av[e], wp[0], acc0, 0, 0, 0);
                    acc1 = __builtin_amdgcn_mfma_f32_16x16x4f32(av[e], wp[16], acc1, 0, 0, 0); }
            }
            LDS_WAIT();
            const float c0 = cbv[(l * NBATCH + b) * NE + ri], c1 = cbv[(l * NBATCH + b) * NE + 16 + ri];
#pragma unroll
            for (int r = 0; r < 4; ++r) { const int ti = 4 * q + r; const float rv = rinvs[wave * 16 + ti];
                lgt[(wave * 16 + ti) * 33 + ri] = acc0[r] * rv + c0; lgt[(wave * 16 + ti) * 33 + 16 + ri] = acc1[r] * rv + c1; }
        }
        __syncthreads();
        int se[4] = {0, 0, 0, 0}; float sw[4] = {0.f, 0.f, 0.f, 0.f}; int rk[4] = {0, 0, 0, 0};
        if (lane < 16) {
            float v[32];
#pragma unroll
            for (int e = 0; e < 32; ++e) v[e] = lgt[(wave * 16 + lane) * 33 + e];
            float sv[4];
#pragma unroll
            for (int kk = 0; kk < 4; ++kk) { float best = v[0]; int bi = 0;
#pragma unroll
                for (int e = 1; e < 32; ++e) { if (v[e] > best) { best = v[e]; bi = e; } }
                sv[kk] = best; se[kk] = bi;
#pragma unroll
                for (int e = 0; e < 32; ++e) v[e] = (e == bi) ? -3.0e38f : v[e]; }
            float den = 0.f;
#pragma unroll
            for (int kk = 0; kk < 4; ++kk) { sw[kk] = __expf(sv[kk] - sv[0]); den += sw[kk]; }
            const float inv = 1.0f / den;
#pragma unroll
            for (int kk = 0; kk < 4; ++kk) { sw[kk] *= inv; rk[kk] = __hip_atomic_fetch_add(hist + se[kk], 1, __ATOMIC_RELAXED, __HIP_MEMORY_SCOPE_WORKGROUP); }
        }
        __syncthreads();
        if (tid < 32) base[tid] = (int)__hip_atomic_fetch_add(ctl + CW_CNT + (cset * NE + tid) * 16, (unsigned)hist[tid], __ATOMIC_RELAXED, __HIP_MEMORY_SCOPE_AGENT);
        __syncthreads();
        if (lane < 16) {
            const int row = row0 + lane; int si[4];
#pragma unroll
            for (int kk = 0; kk < 4; ++kk) { const int li = base[se[kk]] + rk[kk]; tokof[(size_t)se[kk] * T + li] = row; si[kk] = (se[kk] << 24) | li; }
            *(int4*)(slotinfo + (size_t)row * 4) = make_int4(si[0], si[1], si[2], si[3]);
            *(f32x4*)(wgt + (size_t)row * 4) = (f32x4){sw[0], sw[1], sw[2], sw[3]};
        }
        __syncthreads();
    }
}

constexpr int ZT_STRIDE = 528;
template <int PASS>
__device__ __forceinline__ void lru_unit(const Args& a, int l, int u, LAS unsigned char* lds, const int wv) {
    int tid_ = tid_of(wv); asm volatile("" : "+v"(tid_)); const int tid = tid_, lane = tid & 63, wave = __builtin_amdgcn_readfirstlane(tid >> 6);
    unsigned char* ws = a.ws;
    const bf16_t* z = (const bf16_t*)(ws + WS_Z);
    LAS unsigned char* zt = lds; LAS unsigned char* xc = lds + 131 * ZT_STRIDE;
    const int hp = u & 3, b = (u >> 2) & 7, s = u >> 5;
    const int t0 = b * SEQ + s * 128, p0 = s * 128;
    {   u32x4 sv[9];
#pragma unroll
        for (int k = 0; k < 9; ++k) { int idx = tid + NTHREADS * k; idx = idx < 131 * 32 ? idx : 131 * 32 - 1; const int r = idx >> 5, o = idx & 31; const int p = p0 - 3 + r; const int pc = p < 0 ? 0 : p;
            sv[k] = *(const u32x4*)(z + (size_t)(b * SEQ + pc) * NZ + hp * 256 + o * 8); if (p < 0) sv[k] = (u32x4){0u, 0u, 0u, 0u}; }
#pragma unroll
        for (int k = 0; k < 9; ++k) { int idx = tid + NTHREADS * k; idx = idx < 131 * 32 ? idx : 131 * 32 - 1; const int r = idx >> 5, o = idx & 31;
            *(LAS u32x4*)(zt + r * ZT_STRIDE + o * 16) = sv[k]; }
    }
    __syncthreads();
    {
        const int o = tid & 31, rb = tid >> 5; const int ch0 = hp * 256 + o * 8;
        float cw[4][8], cbias[8];
#pragma unroll
        for (int k = 0; k < 4; ++k) { const f32x4 w0 = *(const f32x4*)(a.in[I_CONVW] + ((size_t)l * 4 + k) * D + ch0), w1 = *(const f32x4*)(a.in[I_CONVW] + ((size_t)l * 4 + k) * D + ch0 + 4);
            cw[k][0] = w0.x; cw[k][1] = w0.y; cw[k][2] = w0.z; cw[k][3] = w0.w; cw[k][4] = w1.x; cw[k][5] = w1.y; cw[k][6] = w1.z; cw[k][7] = w1.w; }
        { const f32x4 b0 = *(const f32x4*)(a.in[I_CONVB] + (size_t)l * D + ch0), b1 = *(const f32x4*)(a.in[I_CONVB] + (size_t)l * D + ch0 + 4);
          cbias[0] = b0.x; cbias[1] = b0.y; cbias[2] = b0.z; cbias[3] = b0.w; cbias[4] = b1.x; cbias[5] = b1.y; cbias[6] = b1.z; cbias[7] = b1.w; }
#pragma unroll 2
        for (int i = 0; i < 8; ++i) { const int r = rb + 16 * i; float acc[8];
#pragma unroll
            for (int j = 0; j < 8; ++j) acc[j] = cbias[j];
#pragma unroll
            for (int k = 0; k < 4; ++k) { const u32x4 v = *(const LAS u32x4*)(zt + (r + k) * ZT_STRIDE + o * 16);
                acc[0] += cw[k][0] * bflo(v.x); acc[1] += cw[k][1] * bfhi(v.x); acc[2] += cw[k][2] * bflo(v.y); acc[3] += cw[k][3] * bfhi(v.y);
                acc[4] += cw[k][4] * bflo(v.z); acc[5] += cw[k][5] * bfhi(v.z); acc[6] += cw[k][6] * bflo(v.w); acc[7] += cw[k][7] * bfhi(v.w); }
            u32x4 w; w.x = cvt_pk_bf16(acc[0], acc[1]); w.y = cvt_pk_bf16(acc[2], acc[3]); w.z = cvt_pk_bf16(acc[4], acc[5]); w.w = cvt_pk_bf16(acc[6], acc[7]);
            *(LAS u32x4*)(xc + r * ZT_STRIDE + o * 16) = w; }
    }
    __syncthreads();
    {
        const int hsel = wave >> 2, wc = wave & 3, head = 2 * hp + hsel, c31 = lane & 31, hh = lane >> 5;
        const int ch = head * 128 + 32 * wc + c31;
        const bf16_t* wb = (const bf16_t*)(ws + WS_WRG) + ((size_t)(l * 8 + head) * 256 + 32 * wc + c31) * 128 + 8 * hh;
        bf16x8 Ba[8], Bi[8];
#pragma unroll
        for (int ks = 0; ks < 8; ++ks) { Ba[ks] = *(const bf16x8*)(wb + 16 * ks); Bi[ks] = *(const bf16x8*)(wb + 128 * 128 + 16 * ks); }
        const float ba = a.in[I_BRGA][(size_t)l * D + ch], bx = a.in[I_BRGX][(size_t)l * D + ch];
        const float lam = a.in[I_LAM][(size_t)l * D + ch];
        const float sp8 = 8.0f * log1pf(__expf(-lam));
        float* agg = (float*)(ws + WS_AGG);
        float cin = 0.f;
        if (PASS == 2) { for (int j0 = 0; j0 < s; j0 += 8) { f32x2 ab[8];
#pragma unroll
                for (int k = 0; k < 8; ++k) { const int j = (j0 + k < s) ? (j0 + k) : (s - 1); ab[k] = *(const f32x2*)(agg + ((size_t)(b * 32 + j) * D + ch) * 2); }
#pragma unroll
                for (int k = 0; k < 8; ++k) { if (j0 + k < s) cin = ab[k].x * cin + ab[k].y; } } }
        float Pr = 1.f, Hr = 0.f;
        const bf16_t* zg = z + (size_t)t0 * NZ + ZO_GLRU + ch;
        bf16_t* yo = (bf16_t*)(ws + WS_ACAT) + (size_t)t0 * KCAT + 512 + ch;
        bf16_t gcur[16], gnxt[16];
        if (PASS == 2) {
#pragma unroll
            for (int reg = 0; reg < 16; ++reg) gcur[reg] = zg[(size_t)(8 * (reg >> 2) + 4 * hh + (reg & 3)) * NZ];
        }
#pragma unroll 1
        for (int rb = 0; rb < 4; ++rb) {
            if (PASS == 2) { const int rbn = rb < 3 ? rb + 1 : 3;
#pragma unroll
                for (int reg = 0; reg < 16; ++reg) gnxt[reg] = zg[(size_t)(32 * rbn + 8 * (reg >> 2) + 4 * hh + (reg & 3)) * NZ]; }
            f32x16 aa, ai;
#pragma unroll
            for (int r = 0; r < 16; ++r) { aa[r] = 0.f; ai[r] = 0.f; }
            const LAS unsigned char* ap = xc + (32 * rb + c31) * ZT_STRIDE + (hsel * 128 + 8 * hh) * 2;
#pragma unroll
            for (int ks = 0; ks < 8; ++ks) { const bf16x8 A = *(const LAS bf16x8*)(ap + 32 * ks);
                aa = __builtin_amdgcn_mfma_f32_32x32x16_bf16(A, Ba[ks], aa, 0, 0, 0); ai = __builtin_amdgcn_mfma_f32_32x32x16_bf16(A, Bi[ks], ai, 0, 0, 0); }
            const LAS unsigned char* xp = xc + (32 * rb + 4 * hh) * ZT_STRIDE + (hsel * 128 + 32 * wc + c31) * 2;
#pragma unroll
            for (int q = 0; q < 4; ++q) {
                float p = 1.f, h = 0.f, hl[4], pl[4];
#pragma unroll
                for (int r3 = 0; r3 < 4; ++r3) { const int reg = 4 * q + r3;
                    const float xcv = bf1(*(const LAS bf16_t*)(xp + (8 * q + r3) * ZT_STRIDE));
                    const float rg = sigmoidf_(aa[reg] + ba), ig = sigmoidf_(ai[reg] + bx);
                    const float av = __expf(-sp8 * rg); const float mult = sqrtf(fmaxf(1.0f - av * av, 0.f));
                    h = av * h + mult * (ig * xcv); p *= av; hl[r3] = h; pl[r3] = p; }
                const float Ao = __shfl_xor(p, 32), Bo = __shfl_xor(h, 32);
                const float A0 = hh ? Ao : p, B0 = hh ? Bo : h, A1 = hh ? p : Ao, B1 = hh ? h : Bo;
                const float P1 = Pr * A0, H1 = Hr * A0 + B0;
                const float Pst = hh ? P1 : Pr, Hst = hh ? H1 : Hr;
                Pr = P1 * A1; Hr = H1 * A1 + B1;
                if (PASS == 2) {
#pragma unroll
                    for (int r3 = 0; r3 < 4; ++r3) { const int tok = 32 * rb + 8 * q + 4 * hh + r3;
                        const float hf = (Hst * pl[r3] + hl[r3]) + (Pst * pl[r3]) * cin;
                        const float g = bf1(gcur[4 * q + r3]);
                        const float ge = g * __builtin_amdgcn_rcpf(1.0f + __expf(-1.5957691216f * (g + 0.044715f * g * g * g)));
                        yo[(size_t)tok * KCAT] = (bf16_t)(cvt_pk_bf16(hf * ge, 0.f) & 0xffffu); }
                }
            }
            if (PASS == 2) {
#pragma unroll
                for (int reg = 0; reg < 16; ++reg) gcur[reg] = gnxt[reg];
            }
        }
        if (PASS == 1 && hh == 0) *(f32x2*)(agg + ((size_t)(b * 32 + s) * D + ch) * 2) = (f32x2){Pr, Hr};
    }
    __syncthreads();
}
__device__ __forceinline__ void pool_unit(const Args& a, int l, int u, LAS unsigned char* lds, const int wv) {
    int tid_ = tid_of(wv); asm volatile("" : "+v"(tid_)); const int tid = tid_, lane = tid & 63, wave = __builtin_amdgcn_readfirstlane(tid >> 6);
    unsigned char* ws = a.ws;
    const bf16_t* z = (const bf16_t*)(ws + WS_Z);
    LAS unsigned char* zt = lds; LAS unsigned char* pt = lds + 143 * ZT_STRIDE;
    const int gp = u & 1, b = (u >> 1) & 7, s = u >> 4;
    const int t0 = b * SEQ + s * 128, p0 = s * 128;
    {   u32x4 sv[9];
#pragma unroll
        for (int k = 0; k < 9; ++k) { int idx = tid + NTHREADS * k; idx = idx < 143 * 32 ? idx : 143 * 32 - 1; const int r = idx >> 5, o = idx & 31; const int p = p0 - 15 + r; const int pc = p < 0 ? 0 : p;
            sv[k] = *(const u32x4*)(z + (size_t)(b * SEQ + pc) * NZ + ZO_XPOOL + gp * 256 + o * 8); if (p < 0) sv[k] = (u32x4){0u, 0u, 0u, 0u}; }
#pragma unroll
        for (int k = 0; k < 9; ++k) { int idx = tid + NTHREADS * k; idx = idx < 143 * 32 ? idx : 143 * 32 - 1; const int r = idx >> 5, o = idx & 31;
            *(LAS u32x4*)(zt + r * ZT_STRIDE + o * 16) = sv[k]; }
    }
    __syncthreads();
    {
        const int o = tid & 31, rb = tid >> 5; const int g = 2 * gp + (o >> 4); const int w = 2 << g;
#pragma unroll 1
        for (int i = 0; i < 8; ++i) { const int r = rb + 16 * i; float acc[8];
#pragma unroll
            for (int j = 0; j < 8; ++j) acc[j] = 0.f;
            for (int jj = 0; jj < w; ++jj) { const u32x4 v = *(const LAS u32x4*)(zt + (r + 15 - jj) * ZT_STRIDE + o * 16);
                acc[0] += bflo(v.x); acc[1] += bfhi(v.x); acc[2] += bflo(v.y); acc[3] += bfhi(v.y); acc[4] += bflo(v.z); acc[5] += bfhi(v.z); acc[6] += bflo(v.w); acc[7] += bfhi(v.w); }
            const int cnt = (p0 + r + 1 < w) ? (p0 + r + 1) : w; const float ic = 1.0f / (float)cnt;
            const u32x4 v = *(const LAS u32x4*)(zt + (r + 15) * ZT_STRIDE + o * 16);
            const float x0[8] = {bflo(v.x), bfhi(v.x), bflo(v.y), bfhi(v.y), bflo(v.z), bfhi(v.z), bflo(v.w), bfhi(v.w)};
#pragma unroll
            for (int j = 0; j < 8; ++j) acc[j] = acc[j] * ic - x0[j];
            u32x4 wv; wv.x = cvt_pk_bf16(acc[0], acc[1]); wv.y = cvt_pk_bf16(acc[2], acc[3]); wv.z = cvt_pk_bf16(acc[4], acc[5]); wv.w = cvt_pk_bf16(acc[6], acc[7]);
            *(LAS u32x4*)(pt + r * ZT_STRIDE + o * 16) = wv; }
    }
    __syncthreads();
    {
        const int gsel = wave >> 2, wc = wave & 3, g = 2 * gp + gsel, c31 = lane & 31, hh = lane >> 5;
        const int oc = g * 128 + 32 * wc + c31;
        const bf16_t* wb = (const bf16_t*)(ws + WS_WPOOL) + ((size_t)(l * 4 + g) * 128 + 32 * wc + c31) * 128 + 8 * hh;
        bf16x8 Bf[8];
#pragma unroll
        for (int ks = 0; ks < 8; ++ks) Bf[ks] = *(const bf16x8*)(wb + 16 * ks);
        const float psc = a.in[I_PSCALE][(size_t)l * 512 + oc];
        bf16_t* yo = (bf16_t*)(ws + WS_ACAT) + (size_t)t0 * KCAT + oc;
#pragma unroll 1
        for (int rb = 0; rb < 4; ++rb) {
            f32x16 acc;
#pragma unroll
            for (int r = 0; r < 16; ++r) acc[r] = 0.f;
            const LAS unsigned char* ap = pt + (32 * rb + c31) * ZT_STRIDE + (gsel * 128 + 8 * hh) * 2;
#pragma unroll
            for (int ks = 0; ks < 8; ++ks) { const bf16x8 A = *(const LAS bf16x8*)(ap + 32 * ks); acc = __builtin_amdgcn_mfma_f32_32x32x16_bf16(A, Bf[ks], acc, 0, 0, 0); }
#pragma unroll
            for (int reg = 0; reg < 16; ++reg) { const int tok = 32 * rb + 8 * (reg >> 2) + 4 * hh + (reg & 3);
                yo[(size_t)tok * KCAT] = (bf16_t)(cvt_pk_bf16(acc[reg] * psc, 0.f) & 0xffffu); }
        }
    }
    __syncthreads();
}

constexpr int PH_PER_LAYER = 9;
constexpr int N_PHASES = 1 + DEPTH * PH_PER_LAYER + 1;

__global__ void __launch_bounds__(NTHREADS, 2) fwd_kernel(Args a) {
    extern __shared__ __attribute__((aligned(16))) unsigned char lds_raw[];
    LAS unsigned char* lds = (LAS unsigned char*)lds_raw;
    const int wv = __builtin_amdgcn_readfirstlane(threadIdx.x >> 6); const int tid = threadIdx.x; const int G = gridDim.x;
    unsigned char* ws = a.ws;
    unsigned* ctl = (unsigned*)(ws + WS_CTL);
    volatile LAS unsigned* misc = (volatile LAS unsigned*)(lds + LDS_MISC);
    if (tid < 4) misc[tid] = 0u;
    __syncthreads();
    XcdBarrier bar; bar.bar = ctl + CW_BAR; bar.x = 0; bar.st = misc; bar.wv = wv;
    const int lo = a.ph_lo, hi = a.ph_hi;
    if (hi - lo > 1) bar = xcd_barrier_post(ctl + CW_BAR, misc, wv);
#define IN(k) (lo <= (k) && (k) < hi)
#define SEAM(k) do { if (IN((k) + 1)) xcd_barrier(bar); } while (0)

    if (EN(0) && IN(0)) for (int rr = 0; rr < REPN(0); ++rr) { phase_prologue(a, lds, wv); SEAM(0); }

    for (int l = 0; l < DEPTH; ++l) {
        const int pb = 1 + l * PH_PER_LAYER;
        const float* mod_l = (const float*)(ws + WS_MOD) + (size_t)l * NBATCH * 6144;
        if (EN(1) && IN(pb + 0)) for (int rr = 0; rr < REPN(1); ++rr) { phase_a(a, l, lds, rr + 1 < REPN(1), wv); SEAM(pb + 0); }
        if (EN(2) && IN(pb + 1)) for (int rr = 0; rr < REPN(2); ++rr) {
            pg8::PlainSched S{(const char*)(ws + WS_H), (const char*)(ws + WS_WIN) + (size_t)l * NZ * 1024 * 2, 1024, T / 256, NZ / 256, G, (int)blockIdx.x};
            pg8::EpiBf16 E{(bf16_t*)(ws + WS_Z), NZ, nullptr, (rr + 1 < REPN(2)) && (a.ph_lo == 0)};
            pg8::gemm_phase<pg8::EpiBf16, pg8::PlainSched, true>(lds, 1024, S, E, wv);
            SEAM(pb + 1);
        }
        if (EN(3) && IN(pb + 2)) for (int rr = 0; rr < REPN(3); ++rr) {
            for (int u = blockIdx.x; u < 1024 + 512; u += G) { if (u < 1024) lru_unit<1>(a, l, u, lds, wv); else pool_unit(a, l, u - 1024, lds, wv); }
            SEAM(pb + 2);
        }
        if (EN(4) && IN(pb + 3)) for (int rr = 0; rr < REPN(4); ++rr) {
            for (int u = blockIdx.x; u < 1024; u += G) lru_unit<2>(a, l, u, lds, wv);
            SEAM(pb + 3);
        }
        if (EN(5) && IN(pb + 4)) for (int rr = 0; rr < REPN(5); ++rr) {
            pg8::PlainSched S{(const char*)(ws + WS_ACAT), (const char*)(ws + WS_WCAT) + (size_t)l * 1024 * KCAT * 2, KCAT, T / 256, D / 256, G, (int)blockIdx.x};
            pg8::EpiMerged E{(bf16_t*)(ws + WS_MERGED), (const bf16_t*)(ws + WS_Z)};
            pg8::gemm_phase<pg8::EpiMerged, pg8::PlainSched, true>(lds, KCAT, S, E, wv);
            SEAM(pb + 4);
        }
        if (EN(6) && IN(pb + 5)) for (int rr = 0; rr < REPN(6); ++rr) {
            pg8::PlainSched S{(const char*)(ws + WS_MERGED), (const char*)(ws + WS_WOUT) + (size_t)l * 1024 * 1024 * 2, 1024, T / 256, D / 256, G, (int)blockIdx.x};
            pg8::EpiResid E{(float*)(ws + WS_XRES), (rr + 1 < REPN(6)) ? (float*)(ws + WS_OUTB) : (float*)(ws + WS_XRES), mod_l + 2 * D};
            pg8::gemm_phase<pg8::EpiResid, pg8::PlainSched, true>(lds, 1024, S, E, wv);
            SEAM(pb + 5);
        }
        if (EN(7) && IN(pb + 6)) for (int rr = 0; rr < REPN(7); ++rr) { phase_h(a, l, l + DEPTH * rr, lds, wv); SEAM(pb + 6); }
        if (EN(8) && IN(pb + 7)) for (int rr = 0; rr < REPN(8); ++rr) {
            moe_tables(a, l + DEPTH * (REPN(7) - 1), lds, wv);
            const MoeTab mt = moe_tab_ptrs(lds);
            MoeSched1 S{(const char*)(ws + WS_H), (const char*)(ws + WS_WEIN) + (size_t)l * NE * 2048 * 1024, (const int*)(ws + WS_TOKOF), mt, __builtin_amdgcn_readfirstlane(mt.tilestart[NE]), G, (int)blockIdx.x};
            pg8::EpiSwiglu E{(bf16_t*)(ws + WS_ACT), a.in[I_BEIN] + (size_t)l * NE * 2048, 1.0f / WEIN_SCALE};
            pg8::gemm_phase<pg8::EpiSwiglu, MoeSched1, true, true>(lds, 512, S, E, wv);
            SEAM(pb + 7);
        }
        if (EN(9) && IN(pb + 8)) for (int rr = 0; rr < REPN(9); ++rr) {
            moe_tables(a, l + DEPTH * (REPN(7) - 1), lds, wv);
            const MoeTab mt = moe_tab_ptrs(lds);
            MoeSched2 S{(const char*)(ws + WS_ACT), (const char*)(ws + WS_WEOUT) + (size_t)l * NE * 1024 * 1024 * 2, mt, __builtin_amdgcn_readfirstlane(mt.tilestart[NE]), G, (int)blockIdx.x};
            pg8::EpiMoeOut E{(bf16_t*)(ws + WS_OUTB), a.in[I_BEOUT] + (size_t)l * NE * D};
            pg8::gemm_phase<pg8::EpiMoeOut, MoeSched2, true>(lds, 1024, S, E, wv);
            SEAM(pb + 8);
        }
    }
    if (EN(10) && IN(N_PHASES - 1)) phase_a(a, DEPTH, lds, false, wv);
#undef IN
#undef SEAM
}

extern "C" void kernel_launch(void* const* d_in, const int* in_sizes, int n_in, void* d_out, int out_size, void* d_ws, size_t ws_size, hipStream_t stream) {
    static int grid = 0;
    if (grid == 0) {
        if (n_in != 26 || out_size != T * D || ws_size < WS_END) { fprintf(stderr, "kernel_launch: unexpected problem (n_in %d out %d ws %zu)\n", n_in, out_size, ws_size); grid = -1; return; }
        int dev = 0, cus = 0, per_cu = 0;
        if (hipGetDevice(&dev) != hipSuccess || hipDeviceGetAttribute(&cus, hipDeviceAttributeMultiprocessorCount, dev) != hipSuccess) { grid = -1; return; }
        if (hipFuncSetAttribute((const void*)fwd_kernel, hipFuncAttributeMaxDynamicSharedMemorySize, LDS_BYTES) != hipSuccess) { fprintf(stderr, "kernel_launch: hipFuncSetAttribute failed\n"); grid = -1; return; }
        if (hipOccupancyMaxActiveBlocksPerMultiprocessor(&per_cu, (const void*)fwd_kernel, NTHREADS, LDS_BYTES) != hipSuccess || per_cu < 1) fprintf(stderr, "kernel_launch: occupancy query says %d\n", per_cu);
        (void)hipGetLastError();
        grid = cus;
    }
    if (grid < 0) return;
    if (hipMemsetAsync((char*)d_ws + WS_CTL, 0, CTL_ZERO_BYTES, stream) != hipSuccess) return;
    Args a{};
    for (int i = 0; i < 26; ++i) a.in[i] = (const float*)d_in[i];
    a.out = (float*)d_out; a.ws = (unsigned char*)d_ws;
#if MK_PER_PHASE
    for (int p = 0; p < N_PHASES; ++p) { a.ph_lo = p; a.ph_hi = p + 1; hipLaunchKernelGGL(fwd_kernel, dim3(grid), dim3(NTHREADS), LDS_BYTES, stream, a); }
#else
    a.ph_lo = 0; a.ph_hi = N_PHASES;
    hipLaunchKernelGGL(fwd_kernel, dim3(grid), dim3(NTHREADS), LDS_BYTES, stream, a);
#endif
    const hipError_t le = hipPeekAtLastError();
    if (le != hipSuccess) fprintf(stderr, "kernel_launch: launch failed: %s\n", hipGetErrorName(le));
}
```

```cpp
#include <hip/hip_runtime.h>
#include <cstdio>
#include <cstdint>

#define REP_MASK 0x0
#ifndef PH_MASK
#define PH_MASK 0x7ff
#endif
#define EN(b) ((PH_MASK >> (b)) & 1)
#ifndef REP_MASK
#define REP_MASK 0
#endif
#define REPN(b) ((((REP_MASK) >> (b)) & 1) ? 2 : 1)
#ifndef MK_PER_PHASE
#define MK_PER_PHASE 0
#endif

#define LAS __attribute__((address_space(3)))
typedef unsigned short bf16_t;
typedef short bf16x8 __attribute__((ext_vector_type(8)));
typedef float f32x4 __attribute__((ext_vector_type(4)));
typedef float f32x2 __attribute__((ext_vector_type(2)));
typedef float f32x16 __attribute__((ext_vector_type(16)));
typedef unsigned u32x4 __attribute__((ext_vector_type(4)));
typedef unsigned u32x2 __attribute__((ext_vector_type(2)));

constexpr int D = 1024, NBATCH = 8, SEQ = 4096, T = NBATCH * SEQ, DEPTH = 4;
constexpr int NZ = 4608, ZO_GLRU = 1024, ZO_XPOOL = 2048, ZO_GL0 = 2560, ZO_GL1 = 3584;
constexpr int NE = 32, TOPK = 4;
constexpr int KCAT = 1536;
constexpr int SLOT_CAP = T * TOPK + NE * 256;
constexpr int MAX_MT = SLOT_CAP / 256;
constexpr float NORM_EPS = 1e-6f;
constexpr float WEIN_SCALE = 64.0f;
constexpr int NTHREADS = 512, NWAVES = 8;

constexpr size_t MiB = 1u << 20;
constexpr size_t WS_CTL = 0, CTL_ZERO_BYTES = 256 * 1024;
constexpr size_t WS_MOD = 1 * MiB;
constexpr size_t WS_CB = 2 * MiB;
constexpr size_t WS_AGG = 3 * MiB;
constexpr size_t WS_TOKOF = 6 * MiB;
constexpr size_t WS_SLOTINFO = 10 * MiB;
constexpr size_t WS_WGT = 11 * MiB;
constexpr size_t WS_WRG = 12 * MiB;
constexpr size_t WS_WPOOL = 14 * MiB;
constexpr size_t WS_WIN = 16 * MiB;
constexpr size_t WS_WCAT = 52 * MiB;
constexpr size_t WS_WOUT = 64 * MiB;
constexpr size_t WS_WEIN = 128 * MiB;
constexpr size_t WS_WEOUT = 640 * MiB;
constexpr size_t WS_XRES = 896 * MiB;
constexpr size_t WS_H = 1024 * MiB;
constexpr size_t WS_Z = 1088 * MiB;
constexpr size_t WS_ACAT = 1376 * MiB;
constexpr size_t WS_MERGED = 1472 * MiB;
constexpr size_t WS_ACT = 1536 * MiB;
constexpr size_t WS_OUTB = 1808 * MiB;
constexpr size_t WS_END = 2080 * MiB;
static_assert(WS_ACT + (size_t)SLOT_CAP * 1024 * 2 <= WS_OUTB && WS_OUTB + (size_t)SLOT_CAP * 1024 * 2 <= WS_END, "ws map");
constexpr int CW_BAR = 4096;
constexpr int CW_CNT = 8192;

constexpr int LDS_BYTES = 163840;
constexpr int LDS_TAB = 131072;
constexpr int LDS_NVA = 131072 + 8192;
constexpr int LDS_MISC = LDS_BYTES - 256;

__device__ __forceinline__ unsigned cvt_pk_bf16(float lo, float hi) { unsigned r; asm("v_cvt_pk_bf16_f32 %0, %1, %2" : "=v"(r) : "v"(lo), "v"(hi)); return r; }
__device__ __forceinline__ float bflo(unsigned w) { return __uint_as_float(w << 16); }
__device__ __forceinline__ float bfhi(unsigned w) { return __uint_as_float(w & 0xffff0000u); }
__device__ __forceinline__ float bf1(bf16_t w) { return __uint_as_float(((unsigned)w) << 16); }
__device__ __forceinline__ float sigmoidf_(float x) { return __builtin_amdgcn_rcpf(1.0f + __expf(-x)); }
__device__ __forceinline__ float shflx(float v, int mask, int lane) { return __int_as_float(__builtin_amdgcn_ds_bpermute((lane ^ mask) << 2, __float_as_int(v))); }
__device__ __forceinline__ float wave_sum(float v, int lane) {
#pragma unroll
    for (int o = 1; o < 64; o <<= 1) v += shflx(v, o, lane);
    return v;
}
__device__ __forceinline__ int tid_of(int wv) { int l; asm volatile("v_mbcnt_lo_u32_b32 %0, -1, 0\n\tv_mbcnt_hi_u32_b32 %0, -1, %0" : "=v"(l)); return wv * 64 + l; }
__device__ __forceinline__ int opaque_bid() { int b = blockIdx.x; asm volatile("" : "+s"(b)); return b; }
__device__ __forceinline__ unsigned char* opaque_ptr(unsigned char* p) { asm volatile("" : "+s"(p)); return p; }
#define LDS_WAIT() asm volatile("s_waitcnt lgkmcnt(0)" ::: "memory")
#define VM_WAIT() asm volatile("s_waitcnt vmcnt(0)" ::: "memory")

namespace pg8 {
constexpr int BM = 256, BK = 64, HALF = 128, HTB = HALF * BK * 2, STAGE_BYTES = 8 * HTB, NXCD = 8, WGM = 8;
__host__ __device__ __forceinline__ int lds_byte(int r, int c) { const int st = (r >> 4) * 2 + (c >> 5), rr = r & 15, cc = c & 31, ob = rr * 64 + cc * 2; return st * 1024 + (ob ^ (((ob >> 9) & 1) << 5)); }
__host__ __device__ __forceinline__ void stage_rc(int b, int& R, int& C) { const int st = b / 1024, sb = b % 1024, swz = sb ^ (((sb >> 9) & 1) << 5); R = (st >> 1) * 16 + swz / 64; C = (st & 1) * 32 + (swz % 64) / 2; }
__host__ __device__ __forceinline__ int perm32(int rho) { const int n = rho >> 4, i = rho & 15; return 8 * (i >> 2) + 4 * n + (i & 3); }

struct Unit { int pm, pn, e, j, row0, rows; };
typedef int v8i32 __attribute__((ext_vector_type(8)));
__device__ __forceinline__ v8i32 cat8(bf16x8 lo, bf16x8 hi) { typedef int v4i32 __attribute__((ext_vector_type(4))); const v4i32 a = __builtin_bit_cast(v4i32, lo), b = __builtin_bit_cast(v4i32, hi); return (v8i32){a.x, a.y, a.z, a.w, b.x, b.y, b.z, b.w}; }

__device__ __forceinline__ bool order_map(int i, int G, int c, int nM, int nN, int& pm, int& pn) {
    const int nwg = nM * nN; const long L = (long)i * G + c; if (L >= nwg) return false;
    int wgid = (int)L; { const int q = nwg / NXCD, r = nwg % NXCD, xcd = wgid % NXCD, off = wgid / NXCD; wgid = (xcd < r ? xcd * (q + 1) : r * (q + 1) + (xcd - r) * q) + off; }
    const int nig = WGM * nN, gid = wgid / nig, fm = gid * WGM, gsz = (nM - fm) < WGM ? (nM - fm) : WGM;
    pm = fm + ((wgid % nig) % gsz); pn = (wgid % nig) / gsz; return true;
}

struct PlainSched {
    static constexpr bool DYN_A = false;
    const char* A; const char* Bt; int K, nM, nN, G, c;
    __device__ __forceinline__ bool next(int i, Unit& u) const { int pm, pn; if (!order_map(i, G, c, nM, nN, pm, pn)) return false; u.pm = pm; u.pn = pn; u.e = 0; u.j = 0; u.row0 = pm * BM; u.rows = BM; return true; }
    __device__ __forceinline__ const char* a_ptr() const { return A; }
    __device__ __forceinline__ const char* b_ptr() const { return Bt; }
    __device__ __forceinline__ unsigned a_off(const Unit& u) const { return (unsigned)u.row0 * (unsigned)K * 2u; }
    __device__ __forceinline__ unsigned b_off(const Unit& u) const { return (unsigned)u.pn * (unsigned)(BM * K * 2); }
    __device__ __forceinline__ void a_voff(const Unit&, unsigned (&v)[2][2], int wv) const {
        int tid = tid_of(wv); asm volatile("" : "+v"(tid));
#pragma unroll
        for (int i = 0; i < 2; ++i) { int R, C; stage_rc(tid * 16 + i * 8192, R, C);
#pragma unroll
            for (int h = 0; h < 2; ++h) v[h][i] = (unsigned)((h * HALF + R) * K + C) * 2u; }
    }
};

template <class Epi, class Sched, bool ALIGN_EPI, bool FP8 = false>
__device__ __forceinline__ void gemm_phase(LAS unsigned char* lds, const int K, const Sched& S, const Epi& E, const int wv) {
    int tid = tid_of(wv); asm volatile("" : "+v"(tid));
    const int wid = __builtin_amdgcn_readfirstlane(tid >> 6), lane = tid & 63, wr = wid >> 2, wc = wid & 3, fr = lane & 15, fq = lane >> 4;
    const int nt = K / BK;
    unsigned voffB[2];
#pragma unroll
    for (int i = 0; i < 2; ++i) { int R, C; stage_rc(tid * 16 + i * 8192, R, C); const int Rb = Epi::PERM ? ((R & ~31) + perm32(R & 31)) : R; voffB[i] = (unsigned)(Rb * K + C) * 2u; }
    const unsigned kstep = (unsigned)(BK * 2);
    const unsigned hstep = (unsigned)(HALF * K * 2);
    const __amdgpu_buffer_rsrc_t rsA = __builtin_amdgcn_make_buffer_rsrc((void*)S.a_ptr(), 0, 0xffffffff, 0x00020000);
    const __amdgpu_buffer_rsrc_t rsB = __builtin_amdgcn_make_buffer_rsrc((void*)S.b_ptr(), 0, 0xffffffff, 0x00020000);
    const unsigned ldsw = (unsigned)wid * 1024u;
    const int aoff = lds_byte(wr * 64 + fr, fq * 8), boff = lds_byte(wc * 32 + fr, fq * 8);
#define PG8_SA(b, h) (((b) * 2 + (h)) * HTB)
#define PG8_SB(b, h) ((4 + (b) * 2 + (h)) * HTB)
#define PG8_STAGE_(rs, bufoff, soff, voff) do { _Pragma("unroll") for (int _i = 0; _i < 2; ++_i) \
        __builtin_amdgcn_raw_ptr_buffer_load_lds(rs, (LAS void*)(lds + (bufoff) + ldsw + _i * 8192), 16, (voff)[_i], (soff), 0, 0); } while (0)
#define PG8_STAGE_A(bufoff, soff, voff) PG8_STAGE_(rsA, bufoff, soff, voff)
#define PG8_STAGE_B(bufoff, soff, voff) PG8_STAGE_(rsB, bufoff, soff, voff)
#define PG8_LDA(dst, b, h) do { _Pragma("unroll") for (int m = 0; m < 4; ++m) _Pragma("unroll") for (int k = 0; k < 2; ++k) dst[m][k] = *(const LAS bf16x8*)(lds + PG8_SA(b, h) + aoff + m * 2048 + k * 1024); } while (0)
#define PG8_LDB(dst, b, h) do { _Pragma("unroll") for (int n = 0; n < 2; ++n) _Pragma("unroll") for (int k = 0; k < 2; ++k) dst[n][k] = *(const LAS bf16x8*)(lds + PG8_SB(b, h) + boff + n * 2048 + k * 1024); } while (0)
#define PG8_MMA(ai, bj, At, Bt) do { __builtin_amdgcn_s_setprio(1); _Pragma("unroll") for (int m = 0; m < 4; ++m) _Pragma("unroll") for (int n = 0; n < 2; ++n) { \
        if constexpr (FP8) { acc[ai][bj][m][n] = __builtin_amdgcn_mfma_scale_f32_16x16x128_f8f6f4(cat8(Bt[n][0], Bt[n][1]), cat8(At[m][0], At[m][1]), acc[ai][bj][m][n], 0, 0, 0, 0x7f7f7f7f, 0, 0x7f7f7f7f); } \
        else { _Pragma("unroll") for (int k = 0; k < 2; ++k) acc[ai][bj][m][n] = __builtin_amdgcn_mfma_f32_16x16x32_bf16(Bt[n][k], At[m][k], acc[ai][bj][m][n], 0, 0, 0); } } \
        __builtin_amdgcn_s_setprio(0); } while (0)
#define PG8_WAIT_V(n) asm volatile("s_waitcnt vmcnt(" #n ")" ::: "memory")
#define PG8_WAIT_L(n) asm volatile("s_waitcnt lgkmcnt(" #n ")" ::: "memory")
#define PG8_BAR __builtin_amdgcn_s_barrier()
#define PG8_SCHED __builtin_amdgcn_sched_barrier(0)
    Unit cur, nxt; int ui = 0;
    if (!S.next(0, cur)) return;
    f32x4 acc[2][2][4][2];
    { float z0 = 0.f; asm volatile("" : "+v"(z0));
#pragma unroll
    for (int a = 0; a < 2; ++a)
#pragma unroll
        for (int b = 0; b < 2; ++b)
#pragma unroll
            for (int m = 0; m < 4; ++m)
#pragma unroll
                for (int n = 0; n < 2; ++n) acc[a][b][m][n] = (f32x4){z0, z0, z0, z0}; }
    bf16x8 At[4][2], B0[2][2], B1[2][2];
    unsigned cvA[2][2];
    LAS u32x4* nvp = (LAS u32x4*)(lds + LDS_NVA) + tid;
    S.a_voff(cur, cvA, wv);
    unsigned cA = S.a_off(cur), cB = S.b_off(cur);
    PG8_STAGE_B(PG8_SB(0, 0), cB, voffB); PG8_STAGE_B(PG8_SB(0, 1), cB + hstep, voffB); PG8_STAGE_A(PG8_SA(0, 0), cA, cvA[0]); PG8_STAGE_A(PG8_SA(0, 1), cA, cvA[1]);
    if (wr == 1) PG8_BAR;
    PG8_WAIT_V(2); PG8_BAR;
    PG8_STAGE_B(PG8_SB(1, 0), cB + kstep, voffB); PG8_STAGE_A(PG8_SA(1, 0), cA + kstep, cvA[0]); PG8_STAGE_B(PG8_SB(1, 1), cB + hstep + kstep, voffB);
    PG8_WAIT_V(6); PG8_BAR;
    for (;;) {
        const bool has_next = S.next(ui + 1, nxt);
        unsigned nA = cA, nB = cB;
        if (has_next) { nA = S.a_off(nxt); nB = S.b_off(nxt); }
        if constexpr (Sched::DYN_A) { unsigned nv[2][2];
            if (has_next) S.a_voff(nxt, nv, wv); else {
#pragma unroll
                for (int h = 0; h < 2; ++h)
#pragma unroll
                    for (int i = 0; i < 2; ++i) nv[h][i] = cvA[h][i]; }
            *nvp = (u32x4){nv[0][0], nv[0][1], nv[1][0], nv[1][1]}; }
#pragma unroll 1
        for (int t = 0; t < nt; t += 2) {
            const bool last = (t == nt - 2);
            const unsigned a1 = cA + (unsigned)(t + 1) * kstep;
            const unsigned a2 = last ? nA : cA + (unsigned)(t + 2) * kstep, b2 = last ? nB : cB + (unsigned)(t + 2) * kstep;
            const unsigned a3 = a2 + kstep, b3 = b2 + kstep;
            unsigned nx1[2] = {cvA[1][0], cvA[1][1]};
            if constexpr (Sched::DYN_A) { if (last) { const u32x4 q = *nvp; cvA[0][0] = q.x; cvA[0][1] = q.y; nx1[0] = q.z; nx1[1] = q.w; } }
            if constexpr (Epi::HOOK_T >= 0) { if (t == Epi::HOOK_T) E.mid(acc, cur, wr, wc, fr, fq); }
            PG8_LDB(B0, 0, 0); PG8_LDB(B1, 0, 1); PG8_SCHED; PG8_LDA(At, 0, 0); PG8_STAGE_A(PG8_SA(1, 1), a1, cvA[1]);
            if constexpr (Sched::DYN_A) { cvA[1][0] = nx1[0]; cvA[1][1] = nx1[1]; }
            PG8_WAIT_V(8); PG8_WAIT_L(0); PG8_BAR; PG8_MMA(0, 0, At, B0); PG8_MMA(0, 1, At, B1); PG8_BAR; PG8_SCHED;
            PG8_LDA(At, 0, 1); PG8_STAGE_B(PG8_SB(0, 0), b2, voffB); PG8_STAGE_B(PG8_SB(0, 1), b2 + hstep, voffB); PG8_STAGE_A(PG8_SA(0, 0), a2, cvA[0]);
            PG8_WAIT_V(8); PG8_WAIT_L(0); PG8_BAR; PG8_MMA(1, 0, At, B0); PG8_MMA(1, 1, At, B1); PG8_BAR; PG8_SCHED;
            PG8_LDB(B0, 1, 0); PG8_LDB(B1, 1, 1); PG8_SCHED; PG8_LDA(At, 1, 0); PG8_STAGE_A(PG8_SA(0, 1), a2, cvA[1]);
            PG8_WAIT_V(8); PG8_WAIT_L(0); PG8_BAR; PG8_MMA(0, 0, At, B0); PG8_MMA(0, 1, At, B1); PG8_BAR; PG8_SCHED;
            PG8_LDA(At, 1, 1); PG8_STAGE_B(PG8_SB(1, 0), b3, voffB); PG8_STAGE_B(PG8_SB(1, 1), b3 + hstep, voffB); PG8_STAGE_A(PG8_SA(1, 0), a3, cvA[0]);
            PG8_WAIT_V(8); PG8_WAIT_L(0); PG8_BAR; PG8_MMA(1, 0, At, B0); PG8_MMA(1, 1, At, B1); PG8_BAR; PG8_SCHED;
        }
        if constexpr (ALIGN_EPI) { if (wr == 0) PG8_BAR; }
        E(acc, cur, wr, wc, fr, fq);
        if (!has_next) break;
        { float z0 = 0.f; asm volatile("" : "+v"(z0));
#pragma unroll
        for (int a = 0; a < 2; ++a)
#pragma unroll
            for (int b = 0; b < 2; ++b)
#pragma unroll
                for (int m = 0; m < 4; ++m)
#pragma unroll
                    for (int n = 0; n < 2; ++n) acc[a][b][m][n] = (f32x4){z0, z0, z0, z0}; }
        cur = nxt; cA = nA; cB = nB; ++ui;
        if constexpr (ALIGN_EPI) { if (wr == 1) PG8_BAR; }
    }
    PG8_WAIT_V(0);
    if constexpr (!ALIGN_EPI) { if (wr == 0) PG8_BAR; }
    PG8_BAR;
#undef PG8_SA
#undef PG8_SB
#undef PG8_STAGE_
#undef PG8_STAGE_A
#undef PG8_STAGE_B
#undef PG8_LDA
#undef PG8_LDB
#undef PG8_MMA
#undef PG8_WAIT_V
#undef PG8_WAIT_L
#undef PG8_BAR
#undef PG8_SCHED
}

struct EpiBf16 {
    static constexpr bool PERM = true; static constexpr int HOOK_T = -1;
    bf16_t* O; int ldc; const float* bias; int noepi; float scale;
    __device__ __forceinline__ void mid(f32x4 (&)[2][2][4][2], const Unit&, int, int, int, int) const {}
    __device__ __forceinline__ void operator()(const f32x4 (&acc)[2][2][4][2], const Unit& u, int wr, int wc, int fr, int fq) const {
        { const int l_ = tid_of(0); fr = l_ & 15; fq = l_ >> 4; }
        if (noepi) { if (acc[0][0][0][0][0] == 1.2345e-30f) O[0] = 0; return; }
        int row0 = u.row0 + wr * 64 + fr; asm volatile("" : "+v"(row0)); int col0 = u.pn * BM + wc * 32 + 8 * fq; asm volatile("" : "+v"(col0));
        f32x4 bv[2][2];
#pragma unroll
        for (int bj = 0; bj < 2; ++bj)
#pragma unroll
            for (int n = 0; n < 2; ++n) bv[bj][n] = bias ? *(const f32x4*)(bias + col0 + bj * HALF + 4 * n) : (f32x4){0.f, 0.f, 0.f, 0.f};
#pragma unroll
        for (int ai = 0; ai < 2; ++ai)
#pragma unroll
            for (int m = 0; m < 4; ++m) { bf16_t* rowp = O + (size_t)(row0 + ai * HALF + m * 16) * ldc + col0;
#pragma unroll
                for (int bj = 0; bj < 2; ++bj) { const f32x4 v0 = acc[ai][bj][m][0] * scale + bv[bj][0], v1 = acc[ai][bj][m][1] * scale + bv[bj][1];
                    u32x4 w; w.x = cvt_pk_bf16(v0[0], v0[1]); w.y = cvt_pk_bf16(v0[2], v0[3]); w.z = cvt_pk_bf16(v1[0], v1[1]); w.w = cvt_pk_bf16(v1[2], v1[3]);
                    *(u32x4*)(rowp + bj * HALF) = w; } }
    }
};
struct EpiMerged {
    static constexpr bool PERM = true; static constexpr int HOOK_T = 8;
    bf16_t* O; const bf16_t* Z;
    __device__ __forceinline__ void mid(f32x4 (&acc)[2][2][4][2], const Unit& u, int wr, int wc, int fr, int fq) const {
        { const int l_ = tid_of(0); fr = l_ & 15; fq = l_ >> 4; }
        int row0 = u.row0 + wr * 64 + fr; asm volatile("" : "+v"(row0)); int col0 = u.pn * BM + wc * 32 + 8 * fq; asm volatile("" : "+v"(col0));
#pragma unroll
        for (int ai = 0; ai < 2; ++ai) {
            u32x4 l0[4][2], l1[4][2];
#pragma unroll
            for (int m = 0; m < 4; ++m) { const bf16_t* zr = Z + (size_t)(row0 + ai * HALF + m * 16) * NZ + col0;
#pragma unroll
                for (int bj = 0; bj < 2; ++bj) { l0[m][bj] = *(const u32x4*)(zr + ZO_GL0 + bj * HALF); l1[m][bj] = *(const u32x4*)(zr + ZO_GL1 + bj * HALF); } }
#pragma unroll
            for (int m = 0; m < 4; ++m)
#pragma unroll
                for (int bj = 0; bj < 2; ++bj) {
                    const unsigned a0[4] = {l0[m][bj].x, l0[m][bj].y, l0[m][bj].z, l0[m][bj].w}, a1[4] = {l1[m][bj].x, l1[m][bj].y, l1[m][bj].z, l1[m][bj].w};
#pragma unroll
                    for (int q = 0; q < 4; ++q) {
                        const float r0 = (1.0f + __expf(-bflo(a0[q]))) * __builtin_amdgcn_rcpf(1.0f + __expf(-bflo(a1[q])));
                        const float r1 = (1.0f + __expf(-bfhi(a0[q]))) * __builtin_amdgcn_rcpf(1.0f + __expf(-bfhi(a1[q])));
                        acc[ai][bj][m][q >> 1][(q & 1) * 2 + 0] *= r0; acc[ai][bj][m][q >> 1][(q & 1) * 2 + 1] *= r1; } }
            asm volatile("" ::: "memory"); }
    }
    __device__ __forceinline__ void operator()(const f32x4 (&acc)[2][2][4][2], const Unit& u, int wr, int wc, int fr, int fq) const {
        { const int l_ = tid_of(0); fr = l_ & 15; fq = l_ >> 4; }
        int row0 = u.row0 + wr * 64 + fr; asm volatile("" : "+v"(row0)); int col0 = u.pn * BM + wc * 32 + 8 * fq; asm volatile("" : "+v"(col0));
        u32x4 l0[2][4][2];
#pragma unroll
        for (int ai = 0; ai < 2; ++ai)
#pragma unroll
            for (int m = 0; m < 4; ++m) { const bf16_t* zr = Z + (size_t)(row0 + ai * HALF + m * 16) * NZ + col0;
#pragma unroll
                for (int bj = 0; bj < 2; ++bj) l0[ai][m][bj] = *(const u32x4*)(zr + ZO_GL0 + bj * HALF); }
#pragma unroll
        for (int ai = 0; ai < 2; ++ai)
#pragma unroll
            for (int m = 0; m < 4; ++m) { bf16_t* orow = O + (size_t)(row0 + ai * HALF + m * 16) * D + col0;
#pragma unroll
                for (int bj = 0; bj < 2; ++bj) {
                    const unsigned a0[4] = {l0[ai][m][bj].x, l0[ai][m][bj].y, l0[ai][m][bj].z, l0[ai][m][bj].w};
                    float o[8];
#pragma unroll
                    for (int q = 0; q < 4; ++q) { o[2 * q] = acc[ai][bj][m][q >> 1][(q & 1) * 2 + 0] * sigmoidf_(bflo(a0[q])); o[2 * q + 1] = acc[ai][bj][m][q >> 1][(q & 1) * 2 + 1] * sigmoidf_(bfhi(a0[q])); }
                    u32x4 w; w.x = cvt_pk_bf16(o[0], o[1]); w.y = cvt_pk_bf16(o[2], o[3]); w.z = cvt_pk_bf16(o[4], o[5]); w.w = cvt_pk_bf16(o[6], o[7]);
                    *(u32x4*)(orow + bj * HALF) = w; } }
    }
};
struct EpiResid {
    static constexpr bool PERM = false; static constexpr int HOOK_T = -1;
    float* X; float* XO; const float* gate;
    __device__ __forceinline__ void mid(f32x4 (&)[2][2][4][2], const Unit&, int, int, int, int) const {}
    __device__ __forceinline__ void operator()(const f32x4 (&acc)[2][2][4][2], const Unit& u, int wr, int wc, int fr, int fq) const {
        { const int l_ = tid_of(0); fr = l_ & 15; fq = l_ >> 4; }
        int row0 = u.row0 + wr * 64 + fr; asm volatile("" : "+v"(row0)); int col0 = u.pn * BM + wc * 32 + 4 * fq; asm volatile("" : "+v"(col0));
        const float* gp = gate + (size_t)(u.row0 / SEQ) * (6 * D) + col0;
        f32x4 gv[2][2];
#pragma unroll
        for (int bj = 0; bj < 2; ++bj)
#pragma unroll
            for (int n = 0; n < 2; ++n) gv[bj][n] = *(const f32x4*)(gp + bj * HALF + n * 16);
#pragma unroll
        for (int ai = 0; ai < 2; ++ai) {
            f32x4 xv[4][2][2];
#pragma unroll
            for (int m = 0; m < 4; ++m) { const float* rowp = X + (size_t)(row0 + ai * HALF + m * 16) * D + col0;
#pragma unroll
                for (int bj = 0; bj < 2; ++bj)
#pragma unroll
                    for (int n = 0; n < 2; ++n) xv[m][bj][n] = *(const f32x4*)(rowp + bj * HALF + n * 16); }
#pragma unroll
            for (int m = 0; m < 4; ++m) { float* rowo = XO + (size_t)(row0 + ai * HALF + m * 16) * D + col0;
#pragma unroll
                for (int bj = 0; bj < 2; ++bj)
#pragma unroll
                    for (int n = 0; n < 2; ++n) *(f32x4*)(rowo + bj * HALF + n * 16) = xv[m][bj][n] + gv[bj][n] * acc[ai][bj][m][n]; }
            asm volatile("" ::: "memory"); }
    }
};
struct EpiSwiglu {
    static constexpr bool PERM = true; static constexpr int HOOK_T = -1;
    unsigned char* ACT; const float* bias; float wscale;
    __device__ __forceinline__ void mid(f32x4 (&)[2][2][4][2], const Unit&, int, int, int, int) const {}
    __device__ __forceinline__ void operator()(const f32x4 (&acc)[2][2][4][2], const Unit& u, int wr, int wc, int fr, int fq) const {
        { const int l_ = tid_of(0); fr = l_ & 15; fq = l_ >> 4; }
        int row0 = u.row0 + wr * 64 + fr; asm volatile("" : "+v"(row0)); int cc = u.pn * HALF + wc * 32 + 8 * fq; asm volatile("" : "+v"(cc));
        const float* bp = bias + (size_t)u.e * 2048 + cc;
        f32x4 bg[2], bu[2];
#pragma unroll
        for (int n = 0; n < 2; ++n) { bg[n] = *(const f32x4*)(bp + 4 * n); bu[n] = *(const f32x4*)(bp + 1024 + 4 * n); }
#pragma unroll
        for (int ai = 0; ai < 2; ++ai)
#pragma unroll
            for (int m = 0; m < 4; ++m) { unsigned char* rowp = ACT + (size_t)(row0 + ai * HALF + m * 16) * D + cc;
                float o[8];
#pragma unroll
                for (int n = 0; n < 2; ++n)
#pragma unroll
                    for (int j = 0; j < 4; ++j) { float g = acc[ai][0][m][n][j] * wscale + bg[n][j], up = acc[ai][1][m][n][j] * wscale + bu[n][j];
                        g = fminf(g, 7.0f); up = fminf(fmaxf(up, -7.0f), 7.0f);
                        o[4 * n + j] = g * sigmoidf_(1.702f * g) * (up + 1.0f); }
                int w0 = 0, w1 = 0;
                w0 = __builtin_amdgcn_cvt_pk_fp8_f32(o[0], o[1], w0, false); w0 = __builtin_amdgcn_cvt_pk_fp8_f32(o[2], o[3], w0, true);
                w1 = __builtin_amdgcn_cvt_pk_fp8_f32(o[4], o[5], w1, false); w1 = __builtin_amdgcn_cvt_pk_fp8_f32(o[6], o[7], w1, true);
                *(u32x2*)rowp = (u32x2){(unsigned)w0, (unsigned)w1}; }
    }
};
struct EpiMoeOut {
    static constexpr bool PERM = true; static constexpr int HOOK_T = -1;
    bf16_t* O; const float* bias; float wscale;
    __device__ __forceinline__ void mid(f32x4 (&)[2][2][4][2], const Unit&, int, int, int, int) const {}
    __device__ __forceinline__ void operator()(const f32x4 (&acc)[2][2][4][2], const Unit& u, int wr, int wc, int fr, int fq) const {
        const EpiBf16 e{O, D, bias + (size_t)u.e * D, 0, wscale}; e(acc, u, wr, wc, fr, fq);
    }
};
}

#define XB_TMO      128
#define XB_XCNT(j)  (256  + 64 * (j))
#define XB_XSUB(j)  (1280 + 64 * (j))
#define XB_XGEN(j)  (2304 + 64 * (j))
#define XB_TOP      3328
#define XB_TOPGEN   3392
#define XCD_BAR_WORDS 3456
#define XB_SPIN_CAP (1u << 18)
__device__ __forceinline__ unsigned xb_ld(unsigned* p)              { return __hip_atomic_load(p, __ATOMIC_RELAXED, __HIP_MEMORY_SCOPE_AGENT); }
__device__ __forceinline__ unsigned xb_add(unsigned* p, unsigned v) { return __hip_atomic_fetch_add(p, v, __ATOMIC_RELAXED, __HIP_MEMORY_SCOPE_AGENT); }
__device__ __forceinline__ unsigned xb_xcc_id() { return (unsigned)__builtin_amdgcn_s_getreg((3 << 11) | 20) & 0xFu; }
#define XB_SPIN(cond, bar) do { unsigned _sp = 0; while (cond) { __builtin_amdgcn_s_sleep(1); \
    if ((++_sp & 255u) == 0u) { if (xb_ld(&(bar)[XB_TMO])) break; if (_sp > XB_SPIN_CAP) { atomicAdd(&(bar)[XB_TMO], 1u); break; } } } } while (0)
struct XcdBarrier { unsigned* bar; unsigned x; volatile LAS unsigned* st; int wv; };
__device__ __forceinline__ XcdBarrier xcd_barrier_post(unsigned* bar, volatile LAS unsigned* st, int wv) {
    XcdBarrier b; b.bar = bar; b.x = xb_xcc_id(); b.st = st; b.wv = wv;
    if (tid_of(wv) == 0) (void)xb_add(&bar[XB_XCNT(b.x)], 1u);
    return b;
}
__device__ __forceinline__ void xcd_barrier_complete(unsigned* bar, unsigned x, unsigned& nloc, unsigned& nx) {
    const unsigned G = gridDim.x * gridDim.y * gridDim.z;
    unsigned sum, cnt, mine, sp = 0u;
    for (;;) {
        sum = 0u; cnt = 0u; mine = 0u;
#pragma unroll
        for (unsigned j = 0; j < 16; ++j) { const unsigned c = xb_ld(&bar[XB_XCNT(j)]); sum += c; cnt += (c > 0u) ? 1u : 0u; mine = (j == x) ? c : mine; }
        if (sum == G) break;
        __builtin_amdgcn_s_sleep(1);
        if ((++sp & 255u) == 0u) { if (xb_ld(&bar[XB_TMO])) break; if (sp > XB_SPIN_CAP) { atomicAdd(&bar[XB_TMO], 1u); break; } }
    }
    nloc = mine > 0u ? mine : 1u; nx = cnt > 0u ? cnt : 1u;
}
__device__ __forceinline__ void xcd_barrier(const XcdBarrier& b) {
    asm volatile("s_waitcnt vmcnt(0)" ::: "memory");
    __syncthreads();
    if (tid_of(b.wv) == 0) {
        unsigned* bar = b.bar; asm volatile("" : "+s"(bar)); unsigned bx = b.x; asm volatile("" : "+s"(bx));
        __builtin_amdgcn_s_waitcnt(0);
        unsigned nloc = b.st[0], nx = b.st[1];
        if (nloc == 0u) { xcd_barrier_complete(bar, bx, nloc, nx); b.st[0] = nloc; b.st[1] = nx; }
        const unsigned old = xb_add(&bar[XB_XSUB(bx)], 1u);
        const unsigned gen = old / nloc;
        if (old + 1u == (gen + 1u) * nloc) {
            __builtin_amdgcn_fence(__ATOMIC_RELEASE, "agent");
            asm volatile("s_waitcnt vmcnt(0)" ::: "memory");
            const unsigned og = xb_add(&bar[XB_TOP], 1u);
            const unsigned tg = og / nx;
            if (og + 1u == (tg + 1u) * nx) xb_add(&bar[XB_TOPGEN], 1u);
            else XB_SPIN(xb_ld(&bar[XB_TOPGEN]) == tg, bar);
            __builtin_amdgcn_fence(__ATOMIC_ACQUIRE, "agent");
            xb_add(&bar[XB_XGEN(bx)], 1u);
            asm volatile("s_waitcnt vmcnt(0)" ::: "memory");
        } else {
            XB_SPIN(xb_ld(&bar[XB_XGEN(bx)]) == gen, bar);
            __builtin_amdgcn_fence(__ATOMIC_ACQUIRE, "agent");
            asm volatile("s_waitcnt vmcnt(0)" ::: "memory");
        }
    }
    __syncthreads();
}

struct Args { const float* in[26]; float* out; unsigned char* ws; int ph_lo, ph_hi; };
enum { I_X = 0, I_C, I_N1G, I_N2G, I_WADA, I_BADA, I_WIN, I_CONVW, I_CONVB, I_WRGA, I_BRGA, I_WRGX, I_BRGX, I_LAM, I_WPOOL, I_PSCALE, I_WUPA, I_WUPB, I_WOUT, I_WROUTER, I_BROUTER, I_WEIN, I_BEIN, I_WEOUT, I_BEOUT, I_FINALG };

template <int ROWMODE>
__device__ __forceinline__ void tr_item(const float* W, int N, bf16_t* WT, int dst_ld, int dst_off, int k0, int n0, LAS float* scr, int lane) {
#pragma unroll 8
    for (int i = 0; i < 32; ++i) { const int kk = 2 * i + (lane >> 5); scr[kk * 33 + (lane & 31)] = W[(size_t)(k0 + kk) * N + n0 + (lane & 31)]; }
    LDS_WAIT();
    const int c = lane & 7;
#pragma unroll
    for (int j = 0; j < 4; ++j) { const int n = (lane >> 3) + 8 * j; const LAS float* s = scr + (8 * c) * 33 + n;
        u32x4 o; o.x = cvt_pk_bf16(s[0 * 33], s[1 * 33]); o.y = cvt_pk_bf16(s[2 * 33], s[3 * 33]); o.z = cvt_pk_bf16(s[4 * 33], s[5 * 33]); o.w = cvt_pk_bf16(s[6 * 33], s[7 * 33]);
        const int nn = n0 + n; int drow = nn;
        if (ROWMODE == 1) { drow = (nn < 1024) ? (256 * (nn >> 7) + (nn & 127)) : (256 * ((nn - 1024) >> 7) + 128 + ((nn - 1024) & 127)); }
        *(u32x4*)(WT + (size_t)drow * dst_ld + dst_off + k0 + 8 * c) = o; }
    LDS_WAIT();
}
template <int ROWMODE>
__device__ __forceinline__ void tr_item_fp8(const float* W, int N, unsigned char* WT, int k0, int n0, LAS float* scr, int lane) {
#pragma unroll 8
    for (int i = 0; i < 64; ++i) { const int kk = 2 * i + (lane >> 5); scr[kk * 33 + (lane & 31)] = W[(size_t)(k0 + kk) * N + n0 + (lane & 31)]; }
    LDS_WAIT();
    const int c = lane & 7;
#pragma unroll
    for (int j = 0; j < 4; ++j) { const int n = (lane >> 3) + 8 * j; const LAS float* s = scr + (16 * c) * 33 + n;
        int o[4];
#pragma unroll
        for (int q = 0; q < 4; ++q) { int w = 0; w = __builtin_amdgcn_cvt_pk_fp8_f32(s[(4 * q) * 33] * WEIN_SCALE, s[(4 * q + 1) * 33] * WEIN_SCALE, w, false);
            w = __builtin_amdgcn_cvt_pk_fp8_f32(s[(4 * q + 2) * 33] * WEIN_SCALE, s[(4 * q + 3) * 33] * WEIN_SCALE, w, true); o[q] = w; }
        const int nn = n0 + n; const int drow = (ROWMODE == 0) ? nn : ((nn < 1024) ? (256 * (nn >> 7) + (nn & 127)) : (256 * ((nn - 1024) >> 7) + 128 + ((nn - 1024) & 127)));
        *(u32x4*)(WT + (size_t)drow * 1024 + k0 + 16 * c) = (u32x4){(unsigned)o[0], (unsigned)o[1], (unsigned)o[2], (unsigned)o[3]}; }
    LDS_WAIT();
}
template <int ROWMODE>
__device__ __forceinline__ void tr_job(int item, const float* src, int K, int N, bf16_t* dst, size_t dst_bstride, int dst_ld, int dst_off, LAS float* scr, int lane) {
    const int nnb = N / 32, nkb = K / 64; const int nb = item % nnb; const int r = item / nnb; const int kb = r % nkb; const int bt = r / nkb;
    tr_item<ROWMODE>(src + (size_t)bt * K * N, N, dst + (size_t)bt * dst_bstride, dst_ld, dst_off, 64 * kb, 32 * nb, scr, lane);
}

__device__ __forceinline__ void phase_prologue(const Args& a, LAS unsigned char* lds, const int wv) {
    int tid_ = tid_of(wv); asm volatile("" : "+v"(tid_)); const int tid = tid_, lane = tid & 63, wave = __builtin_amdgcn_readfirstlane(tid >> 6);
    const int G = gridDim.x;
    unsigned char* ws = opaque_ptr(a.ws); const int bid = opaque_bid();
    {
        LAS float* cact = (LAS float*)lds;
        LAS float* red = (LAS float*)(lds + 32768);
        for (int i = tid; i < NBATCH * D; i += NTHREADS) { const float v = a.in[I_C][i]; cact[i] = v * sigmoidf_(v); }
        __syncthreads();
        float* mod = (float*)(ws + WS_MOD);
        for (int u = bid; u < DEPTH * 96; u += G) {
            const int l = u / 96, cg = u % 96; const int n = cg * 64 + lane;
            const float* w = a.in[I_WADA] + (size_t)l * D * 6144 + n;
            float acc[8] = {0.f, 0.f, 0.f, 0.f, 0.f, 0.f, 0.f, 0.f};
            const int kb = wave * 128;
#pragma unroll 8
            for (int k = 0; k < 128; ++k) { const float wv = w[(size_t)(kb + k) * 6144];
#pragma unroll
                for (int b = 0; b < 8; ++b) acc[b] += cact[b * D + kb + k] * wv; }
#pragma unroll
            for (int b = 0; b < 8; ++b) red[(wave * 8 + b) * 64 + lane] = acc[b];
            __syncthreads();
            { const int b = tid >> 6; float s = 0.f;
#pragma unroll
              for (int w8 = 0; w8 < 8; ++w8) s += red[(w8 * 8 + b) * 64 + lane];
              mod[((size_t)l * NBATCH + b) * 6144 + n] = s + a.in[I_BADA][(size_t)l * 6144 + n]; }
            __syncthreads();
        }
    }
    {
        LAS float* scr = (LAS float*)(lds + wave * 16896);
        const int gw = bid * NWAVES + wave, NGW = G * NWAVES;
        constexpr int I_EIN = DEPTH * NE * 8 * 64, I_EOUT = DEPTH * NE * 8 * 32, I_WINI = DEPTH * 16 * 144, I_UPA = DEPTH * 16 * 32, I_UPB = DEPTH * 8 * 32, I_OUT = DEPTH * 16 * 32,
                      I_RGA = DEPTH * 8 * 2 * 4, I_RGX = I_RGA, I_POOL = DEPTH * 4 * 2 * 4;
        constexpr int NITEMS = I_EIN + I_EOUT + I_WINI + I_UPA + I_UPB + I_OUT + I_RGA + I_RGX + I_POOL;
        for (int it = gw; it < NITEMS; it += NGW) {
            int r = it;
            if (r < I_EIN) { const int nb = r % 64, r2 = r / 64, kb = r2 % 8, bt = r2 / 8;
                tr_item_fp8<1>(a.in[I_WEIN] + (size_t)bt * 1024 * 2048, 2048, (unsigned char*)(ws + WS_WEIN) + (size_t)bt * 2048 * 1024, 128 * kb, 32 * nb, scr, lane); continue; } r -= I_EIN;
            if (r < I_EOUT) { const int nb = r % 32, r2 = r / 32, kb = r2 % 8, bt = r2 / 8;
                tr_item_fp8<0>(a.in[I_WEOUT] + (size_t)bt * 1024 * 1024, 1024, (unsigned char*)(ws + WS_WEOUT) + (size_t)bt * 1024 * 1024, 128 * kb, 32 * nb, scr, lane); continue; } r -= I_EOUT;
            if (r < I_WINI) { tr_job<0>(r, a.in[I_WIN], 1024, NZ, (bf16_t*)(ws + WS_WIN), (size_t)NZ * 1024, 1024, 0, scr, lane); continue; } r -= I_WINI;
            if (r < I_UPA) { tr_job<0>(r, a.in[I_WUPA], 1024, 1024, (bf16_t*)(ws + WS_WCAT), (size_t)1024 * KCAT, KCAT, 512, scr, lane); continue; } r -= I_UPA;
            if (r < I_UPB) { tr_job<0>(r, a.in[I_WUPB], 512, 1024, (bf16_t*)(ws + WS_WCAT), (size_t)1024 * KCAT, KCAT, 0, scr, lane); continue; } r -= I_UPB;
            if (r < I_OUT) { tr_job<0>(r, a.in[I_WOUT], 1024, 1024, (bf16_t*)(ws + WS_WOUT), (size_t)1024 * 1024, 1024, 0, scr, lane); continue; } r -= I_OUT;
            if (r < I_RGA) { tr_job<0>(r, a.in[I_WRGA], 128, 128, (bf16_t*)(ws + WS_WRG), (size_t)256 * 128, 128, 0, scr, lane); continue; } r -= I_RGA;
            if (r < I_RGX) { tr_job<0>(r, a.in[I_WRGX], 128, 128, (bf16_t*)(ws + WS_WRG) + 128 * 128, (size_t)256 * 128, 128, 0, scr, lane); continue; } r -= I_RGX;
            tr_job<0>(r, a.in[I_WPOOL], 128, 128, (bf16_t*)(ws + WS_WPOOL), (size_t)128 * 128, 128, 0, scr, lane);
        }
    }
}

struct MoeTab { LAS int* cnt; LAS int* padstart; LAS int* tilestart; LAS int* tab; };
__device__ __forceinline__ MoeTab moe_tab_ptrs(LAS unsigned char* lds) { MoeTab t; t.cnt = (LAS int*)(lds + LDS_TAB); t.padstart = t.cnt + 32; t.tilestart = t.padstart + 40; t.tab = t.tilestart + 40; return t; }
__device__ __forceinline__ void moe_tables(const Args& a, int l, LAS unsigned char* lds, const int wv) {
    const MoeTab mt = moe_tab_ptrs(lds); int tid_ = tid_of(wv); asm volatile("" : "+v"(tid_)); const int tid = tid_;
    unsigned* ctl = (unsigned*)(opaque_ptr(a.ws) + WS_CTL);
    __syncthreads();
    if (tid < NE) mt.cnt[tid] = (int)__hip_atomic_load(ctl + CW_CNT + (l * NE + tid) * 16, __ATOMIC_RELAXED, __HIP_MEMORY_SCOPE_AGENT);
    __syncthreads();
    if (tid == 0) { int ps = 0, ts = 0; for (int e = 0; e < NE; ++e) { mt.padstart[e] = ps; mt.tilestart[e] = ts; const int nt = (mt.cnt[e] + 255) >> 8; ps += nt * 256; ts += nt; } mt.padstart[NE] = ps; mt.tilestart[NE] = ts; }
    __syncthreads();
    const int nMt = mt.tilestart[NE];
    for (int m = tid; m < nMt; m += NTHREADS) { int e = 0; for (int q = 1; q < NE; ++q) e = (mt.tilestart[q] <= m) ? q : e; mt.tab[m] = (e << 16) | (m - mt.tilestart[e]); }
    __syncthreads();
}
struct MoeSched1 {
    static constexpr bool DYN_A = true;
    const char* H; const char* W; const int* tokof; MoeTab mt; int nMt, G, c;
    __device__ __forceinline__ bool next(int i, pg8::Unit& u) const { int pm, pn; if (!pg8::order_map(i, G, c, nMt, 8, pm, pn)) return false;
        const int en = __builtin_amdgcn_readfirstlane(mt.tab[pm]); u.pm = pm; u.pn = pn; u.e = en >> 16; u.j = en & 0xffff;
        u.row0 = __builtin_amdgcn_readfirstlane(mt.padstart[u.e]) + 256 * u.j; u.rows = __builtin_amdgcn_readfirstlane(mt.cnt[u.e]) - 256 * u.j; return true; }
    __device__ __forceinline__ const char* a_ptr() const { return H; }
    __device__ __forceinline__ const char* b_ptr() const { return W; }
    __device__ __forceinline__ unsigned a_off(const pg8::Unit&) const { return 0u; }
    __device__ __forceinline__ unsigned b_off(const pg8::Unit& u) const { return ((unsigned)u.e * 2048u + (unsigned)u.pn * 256u) * 1024u; }
    __device__ __forceinline__ void a_voff(const pg8::Unit& u, unsigned (&v)[2][2], int wv) const {
        int tid = tid_of(wv); asm volatile("" : "+v"(tid));
        const int* tl = tokof + (size_t)u.e * T + 256 * u.j; const int rmax = u.rows - 1;
#pragma unroll
        for (int i = 0; i < 2; ++i) { int R, C; pg8::stage_rc(tid * 16 + i * 8192, R, C);
#pragma unroll
            for (int h = 0; h < 2; ++h) { int idx = h * 128 + R; idx = idx < rmax ? idx : rmax; v[h][i] = (unsigned)tl[idx] * 1024u + (unsigned)C * 2u; } }
    }
};
struct MoeSched2 {
    static constexpr bool DYN_A = false;
    const char* ACT; const char* W; MoeTab mt; int nMt, G, c;
    __device__ __forceinline__ bool next(int i, pg8::Unit& u) const { int pm, pn; if (!pg8::order_map(i, G, c, nMt, 4, pm, pn)) return false;
        const int en = __builtin_amdgcn_readfirstlane(mt.tab[pm]); u.pm = pm; u.pn = pn; u.e = en >> 16; u.j = en & 0xffff;
        u.row0 = __builtin_amdgcn_readfirstlane(mt.padstart[u.e]) + 256 * u.j; u.rows = __builtin_amdgcn_readfirstlane(mt.cnt[u.e]) - 256 * u.j; return true; }
    __device__ __forceinline__ const char* a_ptr() const { return ACT; }
    __device__ __forceinline__ const char* b_ptr() const { return W; }
    __device__ __forceinline__ unsigned a_off(const pg8::Unit& u) const { return (unsigned)u.row0 * 1024u; }
    __device__ __forceinline__ unsigned b_off(const pg8::Unit& u) const { return ((unsigned)u.e * 1024u + (unsigned)u.pn * 256u) * 1024u; }
    __device__ __forceinline__ void a_voff(const pg8::Unit&, unsigned (&v)[2][2], int wv) const {
        int tid = tid_of(wv); asm volatile("" : "+v"(tid));
#pragma unroll
        for (int i = 0; i < 2; ++i) { int R, C; pg8::stage_rc(tid * 16 + i * 8192, R, C);
#pragma unroll
            for (int h = 0; h < 2; ++h) v[h][i] = (unsigned)((h * 128 + R) * 512 + C) * 2u; }
    }
};

__device__ __forceinline__ void phase_a(const Args& a, int l, LAS unsigned char* lds, bool dry, const int wv) {
    int tid_ = tid_of(wv); asm volatile("" : "+v"(tid_)); const int tid = tid_, lane = tid & 63, wave = __builtin_amdgcn_readfirstlane(tid >> 6);
    const int G = gridDim.x; unsigned char* ws = opaque_ptr(a.ws); const int bid = opaque_bid();
    const float* mod = (const float*)(ws + WS_MOD);
    float* xres = (float*)(ws + WS_XRES); float* xout = dry ? (float*)(ws + WS_Z) : xres;
    if (l < DEPTH && bid < NBATCH) {
        LAS float* red = (LAS float*)lds;
        const int b = bid, e = tid & 31, kp = tid >> 5;
        const float* sh2 = mod + ((size_t)l * NBATCH + b) * 6144 + 3 * D; const float* wr = a.in[I_WROUTER] + (size_t)l * D * NE;
        float s = 0.f;
        for (int k = kp * 64; k < kp * 64 + 64; ++k) s += sh2[k] * wr[k * NE + e];
        red[kp * 32 + e] = s;
        __syncthreads();
        if (tid < 32) { float t = a.in[I_BROUTER][l * NE + tid]; for (int q = 0; q < 16; ++q) t += red[q * 32 + tid]; ((float*)(ws + WS_CB))[(l * NBATCH + b) * NE + tid] = t; }
        __syncthreads();
    }
    if (l > 0) moe_tables(a, (l - 1) + DEPTH * (REPN(7) - 1), lds, wv);
    const MoeTab mt = moe_tab_ptrs(lds);
    const int* slotinfo = (const int*)(ws + WS_SLOTINFO); const float* wgt = (const float*)(ws + WS_WGT);
    const bf16_t* outb = (const bf16_t*)(ws + WS_OUTB);
    bf16_t* hb = (bf16_t*)(ws + WS_H);
    for (int chunk = bid; chunk < T / 128; chunk += G) {
        const int rowb = chunk * 128 + wave * 16; const int b = rowb / SEQ;
        const float* xin = (l == 0) ? (a.in[I_X] + (size_t)rowb * D) : (xres + (size_t)rowb * D);
        f32x4 xv[2][4]; int4 si[4]; f32x4 wv[4]; u32x2 gv[2][4][4];
#define PA_SX(r, q) do { if ((r) < 16) { _Pragma("unroll") for (int j = 0; j < 4; ++j) xv[(q) & 1][j] = *(const f32x4*)(xin + (size_t)(r) * D + 4 * lane + 256 * j); } } while (0)
#define PA_S0(r, q) do { if ((r) < 16 && l > 0) { si[(q) & 3] = *(const int4*)(slotinfo + (size_t)(rowb + (r)) * 4); wv[(q) & 3] = *(const f32x4*)(wgt + (size_t)(rowb + (r)) * 4); } } while (0)
#define PA_S1(r, q) do { if ((r) < 16 && l > 0) { const int sl_[4] = {si[(q) & 3].x, si[(q) & 3].y, si[(q) & 3].z, si[(q) & 3].w}; \
            _Pragma("unroll") for (int kk = 0; kk < 4; ++kk) { const int e_ = sl_[kk] >> 24, li_ = sl_[kk] & 0xffffff; const bf16_t* orow = outb + (size_t)(mt.padstart[e_] + li_) * D + 4 * lane; \
                _Pragma("unroll") for (int j = 0; j < 4; ++j) gv[(q) & 1][kk][j] = *(const u32x2*)(orow + 256 * j); } } } while (0)
        PA_S0(0, 0); PA_S0(1, 1); PA_SX(0, 0); PA_S1(0, 0);
#pragma unroll 1
        for (int i0 = 0; i0 < 16; i0 += 4) {
#pragma unroll
          for (int ii = 0; ii < 4; ++ii) {
            const int i = i0 + ii; const int row = rowb + i;
            PA_S0(i + 2, ii + 2); PA_SX(i + 1, ii + 1); PA_S1(i + 1, ii + 1);
            f32x4 v[4];
#pragma unroll
            for (int j = 0; j < 4; ++j) v[j] = xv[ii & 1][j];
            if (l > 0) {
                f32x4 y[4];
#pragma unroll
                for (int j = 0; j < 4; ++j) y[j] = (f32x4){0.f, 0.f, 0.f, 0.f};
#pragma unroll
                for (int kk = 0; kk < 4; ++kk) { const float w = wv[ii][kk];
#pragma unroll
                    for (int j = 0; j < 4; ++j) { const u32x2 p = gv[ii & 1][kk][j]; y[j] += w * (f32x4){bflo(p.x), bfhi(p.x), bflo(p.y), bfhi(p.y)}; } }
                const float* g2 = mod + ((size_t)(l - 1) * NBATCH + b) * 6144 + 5 * D + 4 * lane;
#pragma unroll
                for (int j = 0; j < 4; ++j) v[j] += *(const f32x4*)(g2 + 256 * j) * y[j];
            }
            if (l < DEPTH) {
#pragma unroll
                for (int j = 0; j < 4; ++j) *(f32x4*)(xout + (size_t)row * D + 4 * lane + 256 * j) = v[j];
            }
            float ss = 0.f;
#pragma unroll
            for (int j = 0; j < 4; ++j) ss += (v[j].x * v[j].x + v[j].y * v[j].y) + (v[j].z * v[j].z + v[j].w * v[j].w);
            const float rinv = 1.0f / sqrtf(wave_sum(ss, lane) * (1.0f / D) + NORM_EPS);
            if (l < DEPTH) {
                const float* ng = a.in[I_N1G] + (size_t)l * D + 4 * lane; const float* mb = mod + ((size_t)l * NBATCH + b) * 6144 + 4 * lane;
#pragma unroll
                for (int j = 0; j < 4; ++j) { const f32x4 g = *(const f32x4*)(ng + 256 * j), sh = *(const f32x4*)(mb + 256 * j), sc = *(const f32x4*)(mb + D + 256 * j);
                    const f32x4 h = (v[j] * rinv * g) * (1.0f + sc) + sh;
                    u32x2 p; p.x = cvt_pk_bf16(h.x, h.y); p.y = cvt_pk_bf16(h.z, h.w); *(u32x2*)(hb + (size_t)row * D + 4 * lane + 256 * j) = p; }
            } else {
                const float* fg = a.in[I_FINALG] + 4 * lane;
#pragma unroll
                for (int j = 0; j < 4; ++j) *(f32x4*)(a.out + (size_t)row * D + 4 * lane + 256 * j) = v[j] * rinv * *(const f32x4*)(fg + 256 * j);
            }
          }
        }
#undef PA_S0
#undef PA_SX
#undef PA_S1
    }
}

__device__ __forceinline__ void phase_h(const Args& a, int l, int cset, LAS unsigned char* lds, const int wv) {
    int tid_ = tid_of(wv); asm volatile("" : "+v"(tid_)); const int tid = tid_, lane = tid & 63, wave = __builtin_amdgcn_readfirstlane(tid >> 6);
    const int G = gridDim.x; unsigned char* ws = opaque_ptr(a.ws); const int bid = opaque_bid();
    const float* mod = (const float*)(ws + WS_MOD); const float* xres = (const float*)(ws + WS_XRES);
    unsigned char* h8 = (unsigned char*)(ws + WS_H);
    LAS float* rinvs = (LAS float*)lds;
    LAS float* lgt = (LAS float*)(lds + 1024);
    LAS int* hist = (LAS int*)(lds + 1024 + 8 * 16 * 33 * 4);
    LAS int* base = hist + 32;
    unsigned* ctl = (unsigned*)(ws + WS_CTL);
    const float* wr = a.in[I_WROUTER] + (size_t)l * D * NE;
    const float* ng = a.in[I_N2G] + (size_t)l * D;
    const float* cbv = (const float*)(ws + WS_CB);
    int* tokof = (int*)(ws + WS_TOKOF); int* slotinfo = (int*)(ws + WS_SLOTINFO); float* wgt = (float*)(ws + WS_WGT);
    for (int chunk = bid; chunk < T / 128; chunk += G) {
        const int row0 = chunk * 128 + wave * 16; const int b = row0 / SEQ;
        const float* mb = mod + ((size_t)l * NBATCH + b) * 6144 + 3 * D;
        if (tid < 32) hist[tid] = 0;
        f32x4 xq[3][4];
#pragma unroll
        for (int r = 0; r < 2; ++r)
#pragma unroll
            for (int j = 0; j < 4; ++j) xq[r][j] = *(const f32x4*)(xres + (size_t)(row0 + r) * D + 4 * lane + 256 * j);
#pragma unroll
        for (int i = 0; i < 16; ++i) {
            const int row = row0 + i;
            if (i + 2 < 16) {
#pragma unroll
                for (int j = 0; j < 4; ++j) xq[(i + 2) % 3][j] = *(const f32x4*)(xres + (size_t)(row + 2) * D + 4 * lane + 256 * j); }
            f32x4 v[4]; float ss = 0.f;
#pragma unroll
            for (int j = 0; j < 4; ++j) { v[j] = xq[i % 3][j]; ss += (v[j].x * v[j].x + v[j].y * v[j].y) + (v[j].z * v[j].z + v[j].w * v[j].w); }
            const float rinv = 1.0f / sqrtf(wave_sum(ss, lane) * (1.0f / D) + NORM_EPS);
            if (lane == 0) rinvs[wave * 16 + i] = rinv;
#pragma unroll
            for (int j = 0; j < 4; ++j) { const f32x4 g = *(const f32x4*)(ng + 4 * lane + 256 * j), sh = *(const f32x4*)(mb + 4 * lane + 256 * j), sc = *(const f32x4*)(mb + D + 4 * lane + 256 * j);
                const f32x4 h = (v[j] * rinv * g) * (1.0f + sc) + sh;
                int p = 0; p = __builtin_amdgcn_cvt_pk_fp8_f32(h.x, h.y, p, false); p = __builtin_amdgcn_cvt_pk_fp8_f32(h.z, h.w, p, true);
                *(int*)(h8 + (size_t)row * D + 4 * lane + 256 * j) = p; }
        }
        {
            const int ri = lane & 15, q = lane >> 4;
            const float* xr = xres + (size_t)(row0 + ri) * D + 4 * q;
            f32x4 acc0 = {0.f, 0.f, 0.f, 0.f}, acc1 = {0.f, 0.f, 0.f, 0.f};
#pragma unroll 4
            for (int g = 0; g < 64; ++g) {
                const int k0 = 16 * g + 4 * q;
                const f32x4 xv = *(const f32x4*)(xr + 16 * g); const f32x4 gv = *(const f32x4*)(ng + k0), sc = *(const f32x4*)(mb + D + k0);
                const f32x4 av = xv * gv * (1.0f + sc);
#pragma unroll
                for (int e = 0; e < 4; ++e) { const float* wp = wr + (size_t)(k0 + e) * NE + ri;
                    acc0 = __builtin_amdgcn_mfma_f32_16x16x4f32(av[e], wp[0], acc0, 0, 0, 0);
                    acc1 = __builtin_amdgcn_mfma_f32_16x16x4f32(av[e], wp[16], acc1, 0, 0, 0); }
            }
            LDS_WAIT();
            const float c0 = cbv[(l * NBATCH + b) * NE + ri], c1 = cbv[(l * NBATCH + b) * NE + 16 + ri];
#pragma unroll
            for (int r = 0; r < 4; ++r) { const int ti = 4 * q + r; const float rv = rinvs[wave * 16 + ti];
                lgt[(wave * 16 + ti) * 33 + ri] = acc0[r] * rv + c0; lgt[(wave * 16 + ti) * 33 + 16 + ri] = acc1[r] * rv + c1; }
        }
        __syncthreads();
        int se[4] = {0, 0, 0, 0}; float sw[4] = {0.f, 0.f, 0.f, 0.f}; int rk[4] = {0, 0, 0, 0};
        if (lane < 16) {
            float v[32];
#pragma unroll
            for (int e = 0; e < 32; ++e) v[e] = lgt[(wave * 16 + lane) * 33 + e];
            float sv[4];
#pragma unroll
            for (int kk = 0; kk < 4; ++kk) { float best = v[0]; int bi = 0;
#pragma unroll
                for (int e = 1; e < 32; ++e) { if (v[e] > best) { best = v[e]; bi = e; } }
                sv[kk] = best; se[kk] = bi;
#pragma unroll
                for (int e = 0; e < 32; ++e) v[e] = (e == bi) ? -3.0e38f : v[e]; }
            float den = 0.f;
#pragma unroll
            for (int kk = 0; kk < 4; ++kk) { sw[kk] = __expf(sv[kk] - sv[0]); den += sw[kk]; }
            const float inv = 1.0f / den;
#pragma unroll
            for (int kk = 0; kk < 4; ++kk) { sw[kk] *= inv; rk[kk] = __hip_atomic_fetch_add(hist + se[kk], 1, __ATOMIC_RELAXED, __HIP_MEMORY_SCOPE_WORKGROUP); }
        }
        __syncthreads();
        if (tid < 32) base[tid] = (int)__hip_atomic_fetch_add(ctl + CW_CNT + (cset * NE + tid) * 16, (unsigned)hist[tid], __ATOMIC_RELAXED, __HIP_MEMORY_SCOPE_AGENT);
        __syncthreads();
        if (lane < 16) {
            const int row = row0 + lane; int si[4];
#pragma unroll
            for (int kk = 0; kk < 4; ++kk) { const int li = base[se[kk]] + rk[kk]; tokof[(size_t)se[kk] * T + li] = row; si[kk] = (se[kk] << 24) | li; }
            *(int4*)(slotinfo + (size_t)row * 4) = make_int4(si[0], si[1], si[2], si[3]);
            *(f32x4*)(wgt + (size_t)row * 4) = (f32x4){sw[0], sw[1], sw[2], sw[3]};
        }
        __syncthreads();
    }
}

constexpr int ZT_STRIDE = 528;
template <int PASS>
__device__ __forceinline__ void lru_unit(const Args& a, int l, int u, LAS unsigned char* lds, const int wv) {
    int tid_ = tid_of(wv); asm volatile("" : "+v"(tid_)); const int tid = tid_, lane = tid & 63, wave = __builtin_amdgcn_readfirstlane(tid >> 6);
    unsigned char* ws = opaque_ptr(a.ws);
    const bf16_t* z = (const bf16_t*)(ws + WS_Z);
    LAS unsigned char* zt = lds; LAS unsigned char* xc = lds + 131 * ZT_STRIDE;
    const int hp = u & 3, b = (u >> 2) & 7, s = u >> 5;
    const int t0 = b * SEQ + s * 128, p0 = s * 128;
    {   u32x4 sv[9];
#pragma unroll
        for (int k = 0; k < 9; ++k) { int idx = tid + NTHREADS * k; idx = idx < 131 * 32 ? idx : 131 * 32 - 1; const int r = idx >> 5, o = idx & 31; const int p = p0 - 3 + r; const int pc = p < 0 ? 0 : p;
            sv[k] = *(const u32x4*)(z + (size_t)(b * SEQ + pc) * NZ + hp * 256 + o * 8); if (p < 0) sv[k] = (u32x4){0u, 0u, 0u, 0u}; }
#pragma unroll
        for (int k = 0; k < 9; ++k) { int idx = tid + NTHREADS * k; idx = idx < 131 * 32 ? idx : 131 * 32 - 1; const int r = idx >> 5, o = idx & 31;
            *(LAS u32x4*)(zt + r * ZT_STRIDE + o * 16) = sv[k]; }
    }
    __syncthreads();
    {
        const int o = tid & 31, rb = tid >> 5; const int ch0 = hp * 256 + o * 8;
        float cw[4][8], cbias[8];
#pragma unroll
        for (int k = 0; k < 4; ++k) { const f32x4 w0 = *(const f32x4*)(a.in[I_CONVW] + ((size_t)l * 4 + k) * D + ch0), w1 = *(const f32x4*)(a.in[I_CONVW] + ((size_t)l * 4 + k) * D + ch0 + 4);
            cw[k][0] = w0.x; cw[k][1] = w0.y; cw[k][2] = w0.z; cw[k][3] = w0.w; cw[k][4] = w1.x; cw[k][5] = w1.y; cw[k][6] = w1.z; cw[k][7] = w1.w; }
        { const f32x4 b0 = *(const f32x4*)(a.in[I_CONVB] + (size_t)l * D + ch0), b1 = *(const f32x4*)(a.in[I_CONVB] + (size_t)l * D + ch0 + 4);
          cbias[0] = b0.x; cbias[1] = b0.y; cbias[2] = b0.z; cbias[3] = b0.w; cbias[4] = b1.x; cbias[5] = b1.y; cbias[6] = b1.z; cbias[7] = b1.w; }
#pragma unroll 2
        for (int i = 0; i < 8; ++i) { const int r = rb + 16 * i; float acc[8];
#pragma unroll
            for (int j = 0; j < 8; ++j) acc[j] = cbias[j];
#pragma unroll
            for (int k = 0; k < 4; ++k) { const u32x4 v = *(const LAS u32x4*)(zt + (r + k) * ZT_STRIDE + o * 16);
                acc[0] += cw[k][0] * bflo(v.x); acc[1] += cw[k][1] * bfhi(v.x); acc[2] += cw[k][2] * bflo(v.y); acc[3] += cw[k][3] * bfhi(v.y);
                acc[4] += cw[k][4] * bflo(v.z); acc[5] += cw[k][5] * bfhi(v.z); acc[6] += cw[k][6] * bflo(v.w); acc[7] += cw[k][7] * bfhi(v.w); }
            u32x4 w; w.x = cvt_pk_bf16(acc[0], acc[1]); w.y = cvt_pk_bf16(acc[2], acc[3]); w.z = cvt_pk_bf16(acc[4], acc[5]); w.w = cvt_pk_bf16(acc[6], acc[7]);
            *(LAS u32x4*)(xc + r * ZT_STRIDE + o * 16) = w; }
    }
    __syncthreads();
    {
        const int hsel = wave >> 2, wc = wave & 3, head = 2 * hp + hsel, c31 = lane & 31, hh = lane >> 5;
        const int ch = head * 128 + 32 * wc + c31;
        const bf16_t* wb = (const bf16_t*)(ws + WS_WRG) + ((size_t)(l * 8 + head) * 256 + 32 * wc + c31) * 128 + 8 * hh;
        bf16x8 Ba[8], Bi[8];
#pragma unroll
        for (int ks = 0; ks < 8; ++ks) { Ba[ks] = *(const bf16x8*)(wb + 16 * ks); Bi[ks] = *(const bf16x8*)(wb + 128 * 128 + 16 * ks); }
        const float ba = a.in[I_BRGA][(size_t)l * D + ch], bx = a.in[I_BRGX][(size_t)l * D + ch];
        const float lam = a.in[I_LAM][(size_t)l * D + ch];
        const float sp8 = 8.0f * log1pf(__expf(-lam));
        float* agg = (float*)(ws + WS_AGG);
        float cin = 0.f;
        if (PASS == 2) { for (int j0 = 0; j0 < s; j0 += 8) { f32x2 ab[8];
#pragma unroll
                for (int k = 0; k < 8; ++k) { const int j = (j0 + k < s) ? (j0 + k) : (s - 1); ab[k] = *(const f32x2*)(agg + ((size_t)(b * 32 + j) * D + ch) * 2); }
#pragma unroll
                for (int k = 0; k < 8; ++k) { if (j0 + k < s) cin = ab[k].x * cin + ab[k].y; } } }
        float Pr = 1.f, Hr = 0.f;
        const bf16_t* zg = z + (size_t)t0 * NZ + ZO_GLRU + ch;
        bf16_t* yo = (bf16_t*)(ws + WS_ACAT) + (size_t)t0 * KCAT + 512 + ch;
        bf16_t gcur[16], gnxt[16];
        if (PASS == 2) {
#pragma unroll
            for (int reg = 0; reg < 16; ++reg) gcur[reg] = zg[(size_t)(8 * (reg >> 2) + 4 * hh + (reg & 3)) * NZ];
        }
#pragma unroll 1
        for (int rb = 0; rb < 4; ++rb) {
            if (PASS == 2) { const int rbn = rb < 3 ? rb + 1 : 3;
#pragma unroll
                for (int reg = 0; reg < 16; ++reg) gnxt[reg] = zg[(size_t)(32 * rbn + 8 * (reg >> 2) + 4 * hh + (reg & 3)) * NZ]; }
            f32x16 aa, ai;
#pragma unroll
            for (int r = 0; r < 16; ++r) { aa[r] = 0.f; ai[r] = 0.f; }
            const LAS unsigned char* ap = xc + (32 * rb + c31) * ZT_STRIDE + (hsel * 128 + 8 * hh) * 2;
#pragma unroll
            for (int ks = 0; ks < 8; ++ks) { const bf16x8 A = *(const LAS bf16x8*)(ap + 32 * ks);
                aa = __builtin_amdgcn_mfma_f32_32x32x16_bf16(A, Ba[ks], aa, 0, 0, 0); ai = __builtin_amdgcn_mfma_f32_32x32x16_bf16(A, Bi[ks], ai, 0, 0, 0); }
            const LAS unsigned char* xp = xc + (32 * rb + 4 * hh) * ZT_STRIDE + (hsel * 128 + 32 * wc + c31) * 2;
#pragma unroll
            for (int q = 0; q < 4; ++q) {
                float p = 1.f, h = 0.f, hl[4], pl[4];
#pragma unroll
                for (int r3 = 0; r3 < 4; ++r3) { const int reg = 4 * q + r3;
                    const float xcv = bf1(*(const LAS bf16_t*)(xp + (8 * q + r3) * ZT_STRIDE));
                    const float rg = sigmoidf_(aa[reg] + ba), ig = sigmoidf_(ai[reg] + bx);
                    const float av = __expf(-sp8 * rg); const float mult = sqrtf(fmaxf(1.0f - av * av, 0.f));
                    h = av * h + mult * (ig * xcv); p *= av; hl[r3] = h; pl[r3] = p; }
                const float Ao = shflx(p, 32, lane), Bo = shflx(h, 32, lane);
                const float A0 = hh ? Ao : p, B0 = hh ? Bo : h, A1 = hh ? p : Ao, B1 = hh ? h : Bo;
                const float P1 = Pr * A0, H1 = Hr * A0 + B0;
                const float Pst = hh ? P1 : Pr, Hst = hh ? H1 : Hr;
                Pr = P1 * A1; Hr = H1 * A1 + B1;
                if (PASS == 2) {
#pragma unroll
                    for (int r3 = 0; r3 < 4; ++r3) { const int tok = 32 * rb + 8 * q + 4 * hh + r3;
                        const float hf = (Hst * pl[r3] + hl[r3]) + (Pst * pl[r3]) * cin;
                        const float g = bf1(gcur[4 * q + r3]);
                        const float ge = g * __builtin_amdgcn_rcpf(1.0f + __expf(-1.5957691216f * (g + 0.044715f * g * g * g)));
                        yo[(size_t)tok * KCAT] = (bf16_t)(cvt_pk_bf16(hf * ge, 0.f) & 0xffffu); }
                }
            }
            if (PASS == 2) {
#pragma unroll
                for (int reg = 0; reg < 16; ++reg) gcur[reg] = gnxt[reg];
            }
        }
        if (PASS == 1 && hh == 0) *(f32x2*)(agg + ((size_t)(b * 32 + s) * D + ch) * 2) = (f32x2){Pr, Hr};
    }
    __syncthreads();
}
__device__ __forceinline__ void pool_unit(const Args& a, int l, int u, LAS unsigned char* lds, const int wv) {
    int tid_ = tid_of(wv); asm volatile("" : "+v"(tid_)); const int tid = tid_, lane = tid & 63, wave = __builtin_amdgcn_readfirstlane(tid >> 6);
    unsigned char* ws = opaque_ptr(a.ws);
    const bf16_t* z = (const bf16_t*)(ws + WS_Z);
    LAS unsigned char* zt = lds; LAS unsigned char* pt = lds + 143 * ZT_STRIDE;
    const int gp = u & 1, b = (u >> 1) & 7, s = u >> 4;
    const int t0 = b * SEQ + s * 128, p0 = s * 128;
    {   u32x4 sv[9];
#pragma unroll
        for (int k = 0; k < 9; ++k) { int idx = tid + NTHREADS * k; idx = idx < 143 * 32 ? idx : 143 * 32 - 1; const int r = idx >> 5, o = idx & 31; const int p = p0 - 15 + r; const int pc = p < 0 ? 0 : p;
            sv[k] = *(const u32x4*)(z + (size_t)(b * SEQ + pc) * NZ + ZO_XPOOL + gp * 256 + o * 8); if (p < 0) sv[k] = (u32x4){0u, 0u, 0u, 0u}; }
#pragma unroll
        for (int k = 0; k < 9; ++k) { int idx = tid + NTHREADS * k; idx = idx < 143 * 32 ? idx : 143 * 32 - 1; const int r = idx >> 5, o = idx & 31;
            *(LAS u32x4*)(zt + r * ZT_STRIDE + o * 16) = sv[k]; }
    }
    __syncthreads();
    {
        const int o = tid & 31, rb = tid >> 5; const int g = 2 * gp + (o >> 4); const int w = 2 << g;
#pragma unroll 1
        for (int i = 0; i < 8; ++i) { const int r = rb + 16 * i; float acc[8];
#pragma unroll
            for (int j = 0; j < 8; ++j) acc[j] = 0.f;
            for (int jj = 0; jj < w; ++jj) { const u32x4 v = *(const LAS u32x4*)(zt + (r + 15 - jj) * ZT_STRIDE + o * 16);
                acc[0] += bflo(v.x); acc[1] += bfhi(v.x); acc[2] += bflo(v.y); acc[3] += bfhi(v.y); acc[4] += bflo(v.z); acc[5] += bfhi(v.z); acc[6] += bflo(v.w); acc[7] += bfhi(v.w); }
            const int cnt = (p0 + r + 1 < w) ? (p0 + r + 1) : w; const float ic = 1.0f / (float)cnt;
            const u32x4 v = *(const LAS u32x4*)(zt + (r + 15) * ZT_STRIDE + o * 16);
            const float x0[8] = {bflo(v.x), bfhi(v.x), bflo(v.y), bfhi(v.y), bflo(v.z), bfhi(v.z), bflo(v.w), bfhi(v.w)};
#pragma unroll
            for (int j = 0; j < 8; ++j) acc[j] = acc[j] * ic - x0[j];
            u32x4 wv; wv.x = cvt_pk_bf16(acc[0], acc[1]); wv.y = cvt_pk_bf16(acc[2], acc[3]); wv.z = cvt_pk_bf16(acc[4], acc[5]); wv.w = cvt_pk_bf16(acc[6], acc[7]);
            *(LAS u32x4*)(pt + r * ZT_STRIDE + o * 16) = wv; }
    }
    __syncthreads();
    {
        const int gsel = wave >> 2, wc = wave & 3, g = 2 * gp + gsel, c31 = lane & 31, hh = lane >> 5;
        const int oc = g * 128 + 32 * wc + c31;
        const bf16_t* wb = (const bf16_t*)(ws + WS_WPOOL) + ((size_t)(l * 4 + g) * 128 + 32 * wc + c31) * 128 + 8 * hh;
        bf16x8 Bf[8];
#pragma unroll
        for (int ks = 0; ks < 8; ++ks) Bf[ks] = *(const bf16x8*)(wb + 16 * ks);
        const float psc = a.in[I_PSCALE][(size_t)l * 512 + oc];
        bf16_t* yo = (bf16_t*)(ws + WS_ACAT) + (size_t)t0 * KCAT + oc;
#pragma unroll 1
        for (int rb = 0; rb < 4; ++rb) {
            f32x16 acc;
#pragma unroll
            for (int r = 0; r < 16; ++r) acc[r] = 0.f;
            const LAS unsigned char* ap = pt + (32 * rb + c31) * ZT_STRIDE + (gsel * 128 + 8 * hh) * 2;
#pragma unroll
            for (int ks = 0; ks < 8; ++ks) { const bf16x8 A = *(const LAS bf16x8*)(ap + 32 * ks); acc = __builtin_amdgcn_mfma_f32_32x32x16_bf16(A, Bf[ks], acc, 0, 0, 0); }
#pragma unroll
            for (int reg = 0; reg < 16; ++reg) { const int tok = 32 * rb + 8 * (reg >> 2) + 4 * hh + (reg & 3);
                yo[(size_t)tok * KCAT] = (bf16_t)(cvt_pk_bf16(acc[reg] * psc, 0.f) & 0xffffu); }
        }
    }
    __syncthreads();
}

constexpr int PH_PER_LAYER = 9;
constexpr int N_PHASES = 1 + DEPTH * PH_PER_LAYER + 1;

__global__ void __launch_bounds__(NTHREADS, 2) fwd_kernel(Args a) {
    extern __shared__ __attribute__((aligned(16))) unsigned char lds_raw[];
    LAS unsigned char* lds = (LAS unsigned char*)lds_raw;
    const int wv = __builtin_amdgcn_readfirstlane(threadIdx.x >> 6); const int tid = threadIdx.x; const int G = gridDim.x;
    unsigned char* ws0 = a.ws;
    unsigned* ctl = (unsigned*)(ws0 + WS_CTL);
    volatile LAS unsigned* misc = (volatile LAS unsigned*)(lds + LDS_MISC);
    if (tid < 4) misc[tid] = 0u;
    __syncthreads();
    XcdBarrier bar; bar.bar = ctl + CW_BAR; bar.x = 0; bar.st = misc; bar.wv = wv;
#if MK_PER_PHASE
    const int lo = a.ph_lo, hi = a.ph_hi;
#else
    constexpr int lo = 0, hi = N_PHASES;
#endif
    if (hi - lo > 1) bar = xcd_barrier_post(ctl + CW_BAR, misc, wv);
#define IN(k) (lo <= (k) && (k) < hi)
#define SEAM(k) do { if (IN((k) + 1)) xcd_barrier(bar); } while (0)

    if (EN(0) && IN(0)) for (int rr = 0; rr < REPN(0); ++rr) { phase_prologue(a, lds, wv); SEAM(0); }

    for (int l = 0; l < DEPTH; ++l) {
        const int pb = 1 + l * PH_PER_LAYER;
        if (EN(1) && IN(pb + 0)) for (int rr = 0; rr < REPN(1); ++rr) { unsigned char* ws = opaque_ptr(ws0); const int bid = opaque_bid(); (void)bid; (void)ws; phase_a(a, l, lds, rr + 1 < REPN(1), wv); SEAM(pb + 0); }
        if (EN(2) && IN(pb + 1)) for (int rr = 0; rr < REPN(2); ++rr) { unsigned char* ws = opaque_ptr(ws0); const int bid = opaque_bid(); (void)bid; (void)ws;
            pg8::PlainSched S{(const char*)(ws + WS_H), (const char*)(ws + WS_WIN) + (size_t)l * NZ * 1024 * 2, 1024, T / 256, NZ / 256, G, bid};
            pg8::EpiBf16 E{(bf16_t*)(ws + WS_Z), NZ, nullptr, (rr + 1 < REPN(2)) && (a.ph_lo == 0), 1.0f};
            pg8::gemm_phase<pg8::EpiBf16, pg8::PlainSched, true>(lds, 1024, S, E, wv);
            SEAM(pb + 1);
        }
        if (EN(3) && IN(pb + 2)) for (int rr = 0; rr < REPN(3); ++rr) { unsigned char* ws = opaque_ptr(ws0); const int bid = opaque_bid(); (void)bid; (void)ws;
            for (int u = bid; u < 1024 + 512; u += G) { if (u < 1024) lru_unit<1>(a, l, u, lds, wv); else pool_unit(a, l, u - 1024, lds, wv); }
            SEAM(pb + 2);
        }
        if (EN(4) && IN(pb + 3)) for (int rr = 0; rr < REPN(4); ++rr) { unsigned char* ws = opaque_ptr(ws0); const int bid = opaque_bid(); (void)bid; (void)ws;
            for (int u = bid; u < 1024; u += G) lru_unit<2>(a, l, u, lds, wv);
            SEAM(pb + 3);
        }
        if (EN(5) && IN(pb + 4)) for (int rr = 0; rr < REPN(5); ++rr) { unsigned char* ws = opaque_ptr(ws0); const int bid = opaque_bid(); (void)bid; (void)ws;
            pg8::PlainSched S{(const char*)(ws + WS_ACAT), (const char*)(ws + WS_WCAT) + (size_t)l * 1024 * KCAT * 2, KCAT, T / 256, D / 256, G, bid};
            pg8::EpiMerged E{(bf16_t*)(ws + WS_MERGED), (const bf16_t*)(ws + WS_Z)};
            pg8::gemm_phase<pg8::EpiMerged, pg8::PlainSched, true>(lds, KCAT, S, E, wv);
            SEAM(pb + 4);
        }
        if (EN(6) && IN(pb + 5)) for (int rr = 0; rr < REPN(6); ++rr) { unsigned char* ws = opaque_ptr(ws0); const int bid = opaque_bid(); (void)bid; (void)ws;
            pg8::PlainSched S{(const char*)(ws + WS_MERGED), (const char*)(ws + WS_WOUT) + (size_t)l * 1024 * 1024 * 2, 1024, T / 256, D / 256, G, bid};
            pg8::EpiResid E{(float*)(ws + WS_XRES), (rr + 1 < REPN(6)) ? (float*)(ws + WS_OUTB) : (float*)(ws + WS_XRES), (const float*)(ws + WS_MOD) + (size_t)l * NBATCH * 6144 + 2 * D};
            pg8::gemm_phase<pg8::EpiResid, pg8::PlainSched, true>(lds, 1024, S, E, wv);
            SEAM(pb + 5);
        }
        if (EN(7) && IN(pb + 6)) for (int rr = 0; rr < REPN(7); ++rr) { unsigned char* ws = opaque_ptr(ws0); const int bid = opaque_bid(); (void)bid; (void)ws; phase_h(a, l, l + DEPTH * rr, lds, wv); SEAM(pb + 6); }
        if (EN(8) && IN(pb + 7)) for (int rr = 0; rr < REPN(8); ++rr) { unsigned char* ws = opaque_ptr(ws0); const int bid = opaque_bid(); (void)bid; (void)ws;
            moe_tables(a, l + DEPTH * (REPN(7) - 1), lds, wv);
            const MoeTab mt = moe_tab_ptrs(lds);
            MoeSched1 S{(const char*)(ws + WS_H), (const char*)(ws + WS_WEIN) + (size_t)l * NE * 2048 * 1024, (const int*)(ws + WS_TOKOF), mt, __builtin_amdgcn_readfirstlane(mt.tilestart[NE]), G, bid};
            pg8::EpiSwiglu E{(unsigned char*)(ws + WS_ACT), a.in[I_BEIN] + (size_t)l * NE * 2048, 1.0f / WEIN_SCALE};
            pg8::gemm_phase<pg8::EpiSwiglu, MoeSched1, true, true>(lds, 512, S, E, wv);
            SEAM(pb + 7);
        }
        if (EN(9) && IN(pb + 8)) for (int rr = 0; rr < REPN(9); ++rr) { unsigned char* ws = opaque_ptr(ws0); const int bid = opaque_bid(); (void)bid; (void)ws;
            moe_tables(a, l + DEPTH * (REPN(7) - 1), lds, wv);
            const MoeTab mt = moe_tab_ptrs(lds);
            MoeSched2 S{(const char*)(ws + WS_ACT), (const char*)(ws + WS_WEOUT) + (size_t)l * NE * 1024 * 1024, mt, __builtin_amdgcn_readfirstlane(mt.tilestart[NE]), G, bid};
            pg8::EpiMoeOut E{(bf16_t*)(ws + WS_OUTB), a.in[I_BEOUT] + (size_t)l * NE * D, 1.0f / WEIN_SCALE};
            pg8::gemm_phase<pg8::EpiMoeOut, MoeSched2, true, true>(lds, 512, S, E, wv);
            SEAM(pb + 8);
        }
    }
    if (EN(10) && IN(N_PHASES - 1)) phase_a(a, DEPTH, lds, false, wv);
#undef IN
#undef SEAM
}

extern "C" void kernel_launch(void* const* d_in, const int* in_sizes, int n_in, void* d_out, int out_size, void* d_ws, size_t ws_size, hipStream_t stream) {
    static int grid = 0;
    if (grid == 0) {
        if (n_in != 26 || out_size != T * D || ws_size < WS_END) { fprintf(stderr, "kernel_launch: unexpected problem (n_in %d out %d ws %zu)\n", n_in, out_size, ws_size); grid = -1; return; }
        int dev = 0, cus = 0, per_cu = 0;
        if (hipGetDevice(&dev) != hipSuccess || hipDeviceGetAttribute(&cus, hipDeviceAttributeMultiprocessorCount, dev) != hipSuccess) { grid = -1; return; }
        if (hipFuncSetAttribute((const void*)fwd_kernel, hipFuncAttributeMaxDynamicSharedMemorySize, LDS_BYTES) != hipSuccess) { fprintf(stderr, "kernel_launch: hipFuncSetAttribute failed\n"); grid = -1; return; }
        if (hipOccupancyMaxActiveBlocksPerMultiprocessor(&per_cu, (const void*)fwd_kernel, NTHREADS, LDS_BYTES) != hipSuccess || per_cu < 1) fprintf(stderr, "kernel_launch: occupancy query says %d\n", per_cu);
        (void)hipGetLastError();
        grid = cus;
    }
    if (grid < 0) return;
    if (hipMemsetAsync((char*)d_ws + WS_CTL, 0, CTL_ZERO_BYTES, stream) != hipSuccess) return;
    Args a{};
    for (int i = 0; i < 26; ++i) a.in[i] = (const float*)d_in[i];
    a.out = (float*)d_out; a.ws = (unsigned char*)d_ws;
#if MK_PER_PHASE
    for (int p = 0; p < N_PHASES; ++p) { a.ph_lo = p; a.ph_hi = p + 1; hipLaunchKernelGGL(fwd_kernel, dim3(grid), dim3(NTHREADS), LDS_BYTES, stream, a); }
#else
    a.ph_lo = 0; a.ph_hi = N_PHASES;
    hipLaunchKernelGGL(fwd_kernel, dim3(grid), dim3(NTHREADS), LDS_BYTES, stream, a);
#endif
    const hipError_t le = hipPeekAtLastError();
    if (le != hipSuccess) fprintf(stderr, "kernel_launch: launch failed: %s\n", hipGetErrorName(le));
}
```

```cpp
#include <hip/hip_runtime.h>
#include <cstdio>
#include <cstdint>

#define REP_MASK 0x0
#ifndef PH_MASK
#define PH_MASK 0x7ff
#endif
#define EN(b) ((PH_MASK >> (b)) & 1)
#ifndef REP_MASK
#define REP_MASK 0
#endif
#define REPN(b) ((((REP_MASK) >> (b)) & 1) ? 2 : 1)
#ifndef Z_FP8
#define Z_FP8 0
#endif
#ifndef MK_PER_PHASE
#define MK_PER_PHASE 0
#endif

#define LAS __attribute__((address_space(3)))
typedef unsigned short bf16_t;
typedef short bf16x8 __attribute__((ext_vector_type(8)));
typedef float f32x4 __attribute__((ext_vector_type(4)));
typedef float f32x2 __attribute__((ext_vector_type(2)));
typedef float f32x16 __attribute__((ext_vector_type(16)));
typedef unsigned u32x4 __attribute__((ext_vector_type(4)));
typedef unsigned u32x2 __attribute__((ext_vector_type(2)));

constexpr int D = 1024, NBATCH = 8, SEQ = 4096, T = NBATCH * SEQ, DEPTH = 4;
constexpr int NZ = 4608, ZO_GLRU = 1024, ZO_XPOOL = 2048, ZO_GL0 = 2560, ZO_GL1 = 3584;
constexpr int NE = 32, TOPK = 4;
constexpr int KCAT = 1536;
constexpr int SLOT_CAP = T * TOPK + NE * 256;
constexpr int MAX_MT = SLOT_CAP / 256;
constexpr float NORM_EPS = 1e-6f;
constexpr float WEIN_SCALE = 64.0f;
constexpr int NTHREADS = 512, NWAVES = 8;

constexpr size_t MiB = 1u << 20;
constexpr size_t WS_CTL = 0, CTL_ZERO_BYTES = 256 * 1024;
constexpr size_t WS_MOD = 1 * MiB;
constexpr size_t WS_CB = 2 * MiB;
constexpr size_t WS_AGG = 72 * MiB;
constexpr size_t AGG_BYTES = (size_t)DEPTH * NBATCH * 32 * D * 8;
constexpr size_t WS_TOKOF = 6 * MiB;
constexpr size_t WS_SLOTINFO = 10 * MiB;
constexpr size_t WS_WGT = 11 * MiB;
constexpr size_t WS_WRG = 12 * MiB;
constexpr size_t WS_WPOOL = 14 * MiB;
constexpr size_t WS_WIN = 16 * MiB;
constexpr size_t WS_WCAT = 52 * MiB;
constexpr size_t WS_WOUT = 64 * MiB;
constexpr size_t WS_WEIN = 128 * MiB;
constexpr size_t WS_WEOUT = 640 * MiB;
constexpr size_t WS_XRES = 896 * MiB;
constexpr size_t WS_H = 1024 * MiB;
constexpr size_t WS_Z = 1088 * MiB;
constexpr size_t WS_ACAT = 1376 * MiB;
constexpr size_t WS_MERGED = 1472 * MiB;
constexpr size_t WS_ACT = 1536 * MiB;
constexpr size_t WS_OUTB = 1808 * MiB;
constexpr size_t WS_END = 2080 * MiB;
static_assert(WS_ACT + (size_t)SLOT_CAP * 1024 * 2 <= WS_OUTB && WS_OUTB + (size_t)SLOT_CAP * 1024 * 2 <= WS_END, "ws map");
constexpr int CW_BAR = 4096;
constexpr int CW_CNT = 8192;

constexpr int LDS_BYTES = 163840;
constexpr int LDS_TAB = 131072;
constexpr int LDS_NVA = 131072 + 8192;
constexpr int LDS_MISC = LDS_BYTES - 256;

__device__ __forceinline__ unsigned cvt_pk_bf16(float lo, float hi) { unsigned r; asm("v_cvt_pk_bf16_f32 %0, %1, %2" : "=v"(r) : "v"(lo), "v"(hi)); return r; }
__device__ __forceinline__ float bflo(unsigned w) { return __uint_as_float(w << 16); }
__device__ __forceinline__ float bfhi(unsigned w) { return __uint_as_float(w & 0xffff0000u); }
__device__ __forceinline__ float bf1(bf16_t w) { return __uint_as_float(((unsigned)w) << 16); }
__device__ __forceinline__ float sigmoidf_(float x) { return __builtin_amdgcn_rcpf(1.0f + __expf(-x)); }
__device__ __forceinline__ float shflx(float v, int mask, int lane) { return __int_as_float(__builtin_amdgcn_ds_bpermute((lane ^ mask) << 2, __float_as_int(v))); }
__device__ __forceinline__ float wave_sum(float v, int lane) {
#pragma unroll
    for (int o = 1; o < 64; o <<= 1) v += shflx(v, o, lane);
    return v;
}
__device__ __forceinline__ int tid_of(int wv) { int l; asm volatile("v_mbcnt_lo_u32_b32 %0, -1, 0\n\tv_mbcnt_hi_u32_b32 %0, -1, %0" : "=v"(l)); return wv * 64 + l; }
__device__ __forceinline__ int opaque_bid() { int b = blockIdx.x; asm volatile("" : "+s"(b)); return b; }
__device__ __forceinline__ unsigned char* opaque_ptr(unsigned char* p) { size_t z = 0; asm volatile("" : "+s"(z)); return p + z; }
#define LDS_WAIT() asm volatile("s_waitcnt lgkmcnt(0)" ::: "memory")
#define VM_WAIT() asm volatile("s_waitcnt vmcnt(0)" ::: "memory")

namespace pg8 {
constexpr int BM = 256, BK = 64, HALF = 128, HTB = HALF * BK * 2, STAGE_BYTES = 8 * HTB, NXCD = 8, WGM = 8;
__host__ __device__ __forceinline__ int lds_byte(int r, int c) { const int st = (r >> 4) * 2 + (c >> 5), rr = r & 15, cc = c & 31, ob = rr * 64 + cc * 2; return st * 1024 + (ob ^ (((ob >> 9) & 1) << 5)); }
__host__ __device__ __forceinline__ void stage_rc(int b, int& R, int& C) { const int st = b / 1024, sb = b % 1024, swz = sb ^ (((sb >> 9) & 1) << 5); R = (st >> 1) * 16 + swz / 64; C = (st & 1) * 32 + (swz % 64) / 2; }
__host__ __device__ __forceinline__ int perm32(int rho) { const int n = rho >> 4, i = rho & 15; return 8 * (i >> 2) + 4 * n + (i & 3); }

struct Unit { int pm, pn, e, j, row0, rows; };
typedef int v8i32 __attribute__((ext_vector_type(8)));
__device__ __forceinline__ v8i32 cat8(bf16x8 lo, bf16x8 hi) { typedef int v4i32 __attribute__((ext_vector_type(4))); const v4i32 a = __builtin_bit_cast(v4i32, lo), b = __builtin_bit_cast(v4i32, hi); return (v8i32){a.x, a.y, a.z, a.w, b.x, b.y, b.z, b.w}; }

__device__ __forceinline__ bool order_map(int i, int G, int c, int nM, int nN, int& pm, int& pn) {
    const int nwg = nM * nN; const long L = (long)i * G + c; if (L >= nwg) return false;
    int wgid = (int)L; { const int q = nwg / NXCD, r = nwg % NXCD, xcd = wgid % NXCD, off = wgid / NXCD; wgid = (xcd < r ? xcd * (q + 1) : r * (q + 1) + (xcd - r) * q) + off; }
    const int nig = WGM * nN, gid = wgid / nig, fm = gid * WGM, gsz = (nM - fm) < WGM ? (nM - fm) : WGM;
    pm = fm + ((wgid % nig) % gsz); pn = (wgid % nig) / gsz; return true;
}

struct PlainSched {
    static constexpr bool DYN_A = false;
    const char* A; const char* Bt; int K, nM, nN, G, c;
    __device__ __forceinline__ bool next(int i, Unit& u) const { int pm, pn; if (!order_map(i, G, c, nM, nN, pm, pn)) return false; u.pm = pm; u.pn = pn; u.e = 0; u.j = 0; u.row0 = pm * BM; u.rows = BM; return true; }
    __device__ __forceinline__ const char* a_ptr() const { return A; }
    __device__ __forceinline__ const char* b_ptr() const { return Bt; }
    __device__ __forceinline__ unsigned a_off(const Unit& u) const { return (unsigned)u.row0 * (unsigned)K * 2u; }
    __device__ __forceinline__ unsigned b_off(const Unit& u) const { return (unsigned)u.pn * (unsigned)(BM * K * 2); }
    __device__ __forceinline__ void a_voff(const Unit&, unsigned (&v)[2][2], int wv) const {
        int tid = tid_of(wv); asm volatile("" : "+v"(tid));
#pragma unroll
        for (int i = 0; i < 2; ++i) { int R, C; stage_rc(tid * 16 + i * 8192, R, C);
#pragma unroll
            for (int h = 0; h < 2; ++h) v[h][i] = (unsigned)((h * HALF + R) * K + C) * 2u; }
    }
};

template <class Epi, class Sched, bool ALIGN_EPI, bool FP8 = false>
__device__ __forceinline__ void gemm_phase(LAS unsigned char* lds, const int K, const Sched& S, const Epi& E, const int wv) {
    int tid = tid_of(wv); asm volatile("" : "+v"(tid));
    const int wid = __builtin_amdgcn_readfirstlane(tid >> 6), lane = tid & 63, wr = wid >> 2, wc = wid & 3, fr = lane & 15, fq = lane >> 4;
    const int nt = K / BK;
    unsigned voffB;
    { int R, C; stage_rc(tid * 16, R, C); const int Rb = Epi::PERM ? ((R & ~31) + perm32(R & 31)) : R; voffB = (unsigned)(Rb * K + C) * 2u; }
    const unsigned q64 = (unsigned)(64 * K * 2);
    const unsigned kstep = (unsigned)(BK * 2);
    const unsigned hstep = (unsigned)(HALF * K * 2);
    const __amdgpu_buffer_rsrc_t rsA = __builtin_amdgcn_make_buffer_rsrc((void*)S.a_ptr(), 0, 0xffffffff, 0x00020000);
    const __amdgpu_buffer_rsrc_t rsB = __builtin_amdgcn_make_buffer_rsrc((void*)S.b_ptr(), 0, 0xffffffff, 0x00020000);
    const unsigned ldsw = (unsigned)wid * 1024u;
    const int aoff = lds_byte(wr * 64 + fr, fq * 8), boff = lds_byte(wc * 32 + fr, fq * 8);
#define PG8_SA(b, h) (((b) * 2 + (h)) * HTB)
#define PG8_SB(b, h) ((4 + (b) * 2 + (h)) * HTB)
#define PG8_STAGE_(rs, bufoff, v0, s0, v1, s1) do { \
        __builtin_amdgcn_raw_ptr_buffer_load_lds(rs, (LAS void*)(lds + (bufoff) + ldsw), 16, (v0), (s0), 0, 0); \
        __builtin_amdgcn_raw_ptr_buffer_load_lds(rs, (LAS void*)(lds + (bufoff) + ldsw + 8192), 16, (v1), (s1), 0, 0); } while (0)
#define PG8_STAGE_B(bufoff, soff, unused) PG8_STAGE_(rsB, bufoff, voffB, (soff), voffB, (soff) + q64)
#define PG8_STAGE_A(bufoff, soff, h) do { if constexpr (Sched::DYN_A) PG8_STAGE_(rsA, bufoff, cvA[h][0], (soff), cvA[h][1], (soff)); \
        else PG8_STAGE_(rsA, bufoff, cvA[0][0], (soff) + (h) * 2u * q64, cvA[0][0], (soff) + (h) * 2u * q64 + q64); } while (0)
#define PG8_LDA(dst, b, h) do { _Pragma("unroll") for (int m = 0; m < 4; ++m) _Pragma("unroll") for (int k = 0; k < 2; ++k) dst[m][k] = *(const LAS bf16x8*)(lds + PG8_SA(b, h) + aoff + m * 2048 + k * 1024); } while (0)
#define PG8_LDB(dst, b, h) do { _Pragma("unroll") for (int n = 0; n < 2; ++n) _Pragma("unroll") for (int k = 0; k < 2; ++k) dst[n][k] = *(const LAS bf16x8*)(lds + PG8_SB(b, h) + boff + n * 2048 + k * 1024); } while (0)
#define PG8_MMA(ai, bj, At, Bt) do { __builtin_amdgcn_s_setprio(1); _Pragma("unroll") for (int m = 0; m < 4; ++m) _Pragma("unroll") for (int n = 0; n < 2; ++n) { \
        if constexpr (FP8) { acc[ai][bj][m][n] = __builtin_amdgcn_mfma_scale_f32_16x16x128_f8f6f4(cat8(Bt[n][0], Bt[n][1]), cat8(At[m][0], At[m][1]), acc[ai][bj][m][n], 0, 0, 0, 0x7f7f7f7f, 0, 0x7f7f7f7f); } \
        else { _Pragma("unroll") for (int k = 0; k < 2; ++k) acc[ai][bj][m][n] = __builtin_amdgcn_mfma_f32_16x16x32_bf16(Bt[n][k], At[m][k], acc[ai][bj][m][n], 0, 0, 0); } } \
        __builtin_amdgcn_s_setprio(0); } while (0)
#define PG8_WAIT_V(n) asm volatile("s_waitcnt vmcnt(" #n ")" ::: "memory")
#define PG8_WAIT_L(n) asm volatile("s_waitcnt lgkmcnt(" #n ")" ::: "memory")
#define PG8_BAR __builtin_amdgcn_s_barrier()
#define PG8_SCHED __builtin_amdgcn_sched_barrier(0)
    Unit cur, nxt; int ui = 0;
    if (!S.next(0, cur)) return;
    f32x4 acc[2][2][4][2];
    { float z0 = 0.f; asm volatile("" : "+v"(z0));
#pragma unroll
    for (int a = 0; a < 2; ++a)
#pragma unroll
        for (int b = 0; b < 2; ++b)
#pragma unroll
            for (int m = 0; m < 4; ++m)
#pragma unroll
                for (int n = 0; n < 2; ++n) acc[a][b][m][n] = (f32x4){z0, z0, z0, z0}; }
    bf16x8 At[4][2], B0[2][2], B1[2][2];
    unsigned cvA[2][2];
    LAS u32x4* nvp = (LAS u32x4*)(lds + LDS_NVA) + tid;
    S.a_voff(cur, cvA, wv);
    unsigned cA = S.a_off(cur), cB = S.b_off(cur);
    PG8_STAGE_B(PG8_SB(0, 0), cB, voffB); PG8_STAGE_B(PG8_SB(0, 1), cB + hstep, voffB); PG8_STAGE_A(PG8_SA(0, 0), cA, 0); PG8_STAGE_A(PG8_SA(0, 1), cA, 1);
    if (wr == 1) PG8_BAR;
    PG8_WAIT_V(2); PG8_BAR;
    PG8_STAGE_B(PG8_SB(1, 0), cB + kstep, voffB); PG8_STAGE_A(PG8_SA(1, 0), cA + kstep, 0); PG8_STAGE_B(PG8_SB(1, 1), cB + hstep + kstep, voffB);
    PG8_WAIT_V(6); PG8_BAR;
    for (;;) {
        const bool has_next = S.next(ui + 1, nxt);
        unsigned nA = cA, nB = cB;
        if (has_next) { nA = S.a_off(nxt); nB = S.b_off(nxt); }
        if constexpr (Sched::DYN_A) { unsigned nv[2][2];
            if (has_next) S.a_voff(nxt, nv, wv); else {
#pragma unroll
                for (int h = 0; h < 2; ++h)
#pragma unroll
                    for (int i = 0; i < 2; ++i) nv[h][i] = cvA[h][i]; }
            *nvp = (u32x4){nv[0][0], nv[0][1], nv[1][0], nv[1][1]}; }
#pragma unroll 1
        for (int t = 0; t < nt; t += 2) {
            const bool last = (t == nt - 2);
            const unsigned a1 = cA + (unsigned)(t + 1) * kstep;
            const unsigned a2 = last ? nA : cA + (unsigned)(t + 2) * kstep, b2 = last ? nB : cB + (unsigned)(t + 2) * kstep;
            const unsigned a3 = a2 + kstep, b3 = b2 + kstep;
            unsigned nx1[2] = {cvA[1][0], cvA[1][1]};
            if constexpr (Sched::DYN_A) { if (last) { const u32x4 q = *nvp; cvA[0][0] = q.x; cvA[0][1] = q.y; nx1[0] = q.z; nx1[1] = q.w; } }
            if constexpr (Epi::HOOK_T >= 0) { if (t == Epi::HOOK_T) E.mid(acc, cur, wr, wc, fr, fq); }
            PG8_LDB(B0, 0, 0); PG8_LDB(B1, 0, 1); PG8_SCHED; PG8_LDA(At, 0, 0); PG8_STAGE_A(PG8_SA(1, 1), a1, 1);
            if constexpr (Sched::DYN_A) { cvA[1][0] = nx1[0]; cvA[1][1] = nx1[1]; }
            PG8_WAIT_V(8); PG8_WAIT_L(0); PG8_BAR; PG8_MMA(0, 0, At, B0); PG8_MMA(0, 1, At, B1); PG8_BAR; PG8_SCHED;
            PG8_LDA(At, 0, 1); PG8_STAGE_B(PG8_SB(0, 0), b2, voffB); PG8_STAGE_B(PG8_SB(0, 1), b2 + hstep, voffB); PG8_STAGE_A(PG8_SA(0, 0), a2, 0);
            PG8_WAIT_V(8); PG8_WAIT_L(0); PG8_BAR; PG8_MMA(1, 0, At, B0); PG8_MMA(1, 1, At, B1); PG8_BAR; PG8_SCHED;
            PG8_LDB(B0, 1, 0); PG8_LDB(B1, 1, 1); PG8_SCHED; PG8_LDA(At, 1, 0); PG8_STAGE_A(PG8_SA(0, 1), a2, 1);
            PG8_WAIT_V(8); PG8_WAIT_L(0); PG8_BAR; PG8_MMA(0, 0, At, B0); PG8_MMA(0, 1, At, B1); PG8_BAR; PG8_SCHED;
            PG8_LDA(At, 1, 1); PG8_STAGE_B(PG8_SB(1, 0), b3, voffB); PG8_STAGE_B(PG8_SB(1, 1), b3 + hstep, voffB); PG8_STAGE_A(PG8_SA(1, 0), a3, 0);
            PG8_WAIT_V(8); PG8_WAIT_L(0); PG8_BAR; PG8_MMA(1, 0, At, B0); PG8_MMA(1, 1, At, B1); PG8_BAR; PG8_SCHED;
        }
        if constexpr (ALIGN_EPI) { if (wr == 0) PG8_BAR; }
        E(acc, cur, wr, wc, fr, fq);
        if (!has_next) break;
        { float z0 = 0.f; asm volatile("" : "+v"(z0));
#pragma unroll
        for (int a = 0; a < 2; ++a)
#pragma unroll
            for (int b = 0; b < 2; ++b)
#pragma unroll
                for (int m = 0; m < 4; ++m)
#pragma unroll
                    for (int n = 0; n < 2; ++n) acc[a][b][m][n] = (f32x4){z0, z0, z0, z0}; }
        cur = nxt; cA = nA; cB = nB; ++ui;
        if constexpr (ALIGN_EPI) { if (wr == 1) PG8_BAR; }
    }
    PG8_WAIT_V(0);
    if constexpr (!ALIGN_EPI) { if (wr == 0) PG8_BAR; }
    PG8_BAR;
#undef PG8_SA
#undef PG8_SB
#undef PG8_STAGE_
#undef PG8_STAGE_A
#undef PG8_STAGE_B
#undef PG8_LDA
#undef PG8_LDB
#undef PG8_MMA
#undef PG8_WAIT_V
#undef PG8_WAIT_L
#undef PG8_BAR
#undef PG8_SCHED
}

struct EpiBf16 {
    static constexpr bool PERM = true; static constexpr int HOOK_T = -1;
    bf16_t* O; int ldc; const float* bias; int noepi; float scale;
    __device__ __forceinline__ void mid(f32x4 (&)[2][2][4][2], const Unit&, int, int, int, int) const {}
    __device__ __forceinline__ void operator()(const f32x4 (&acc)[2][2][4][2], const Unit& u, int wr, int wc, int fr, int fq) const {
        { const int l_ = tid_of(0); fr = l_ & 15; fq = l_ >> 4; }
        if (noepi) { if (acc[0][0][0][0][0] == 1.2345e-30f) O[0] = 0; return; }
        int row0 = u.row0 + wr * 64 + fr; asm volatile("" : "+v"(row0)); int col0 = u.pn * BM + wc * 32 + 8 * fq; asm volatile("" : "+v"(col0));
        f32x4 bv[2][2];
#pragma unroll
        for (int bj = 0; bj < 2; ++bj)
#pragma unroll
            for (int n = 0; n < 2; ++n) bv[bj][n] = bias ? *(const f32x4*)(bias + col0 + bj * HALF + 4 * n) : (f32x4){0.f, 0.f, 0.f, 0.f};
#pragma unroll
        for (int ai = 0; ai < 2; ++ai)
#pragma unroll
            for (int m = 0; m < 4; ++m) { bf16_t* rowp = O + (size_t)(row0 + ai * HALF + m * 16) * ldc + col0;
#pragma unroll
                for (int bj = 0; bj < 2; ++bj) { const f32x4 v0 = acc[ai][bj][m][0] * scale + bv[bj][0], v1 = acc[ai][bj][m][1] * scale + bv[bj][1];
                    u32x4 w; w.x = cvt_pk_bf16(v0[0], v0[1]); w.y = cvt_pk_bf16(v0[2], v0[3]); w.z = cvt_pk_bf16(v1[0], v1[1]); w.w = cvt_pk_bf16(v1[2], v1[3]);
                    *(u32x4*)(rowp + bj * HALF) = w; } }
    }
};
struct EpiMerged {
    static constexpr bool PERM = true; static constexpr int HOOK_T = 8;
    bf16_t* O; const bf16_t* Z;
    __device__ __forceinline__ void mid(f32x4 (&acc)[2][2][4][2], const Unit& u, int wr, int wc, int fr, int fq) const {
        { const int l_ = tid_of(0); fr = l_ & 15; fq = l_ >> 4; }
        int row0 = u.row0 + wr * 64 + fr; asm volatile("" : "+v"(row0)); int col0 = u.pn * BM + wc * 32 + 8 * fq; asm volatile("" : "+v"(col0));
#pragma unroll
        for (int ai = 0; ai < 2; ++ai) {
            u32x4 l0[4][2], l1[4][2];
#pragma unroll
            for (int m = 0; m < 4; ++m) { const bf16_t* zr = Z + (size_t)(row0 + ai * HALF + m * 16) * NZ + col0;
#pragma unroll
                for (int bj = 0; bj < 2; ++bj) { l0[m][bj] = *(const u32x4*)(zr + ZO_GL0 + bj * HALF); l1[m][bj] = *(const u32x4*)(zr + ZO_GL1 + bj * HALF); } }
#pragma unroll
            for (int m = 0; m < 4; ++m)
#pragma unroll
                for (int bj = 0; bj < 2; ++bj) {
                    const unsigned a0[4] = {l0[m][bj].x, l0[m][bj].y, l0[m][bj].z, l0[m][bj].w}, a1[4] = {l1[m][bj].x, l1[m][bj].y, l1[m][bj].z, l1[m][bj].w};
#pragma unroll
                    for (int q = 0; q < 4; ++q) {
                        const float r0 = (1.0f + __expf(-bflo(a0[q]))) * __builtin_amdgcn_rcpf(1.0f + __expf(-bflo(a1[q])));
                        const float r1 = (1.0f + __expf(-bfhi(a0[q]))) * __builtin_amdgcn_rcpf(1.0f + __expf(-bfhi(a1[q])));
                        acc[ai][bj][m][q >> 1][(q & 1) * 2 + 0] *= r0; acc[ai][bj][m][q >> 1][(q & 1) * 2 + 1] *= r1; } }
            asm volatile("" ::: "memory"); }
    }
    __device__ __forceinline__ void operator()(const f32x4 (&acc)[2][2][4][2], const Unit& u, int wr, int wc, int fr, int fq) const {
        { const int l_ = tid_of(0); fr = l_ & 15; fq = l_ >> 4; }
        int row0 = u.row0 + wr * 64 + fr; asm volatile("" : "+v"(row0)); int col0 = u.pn * BM + wc * 32 + 8 * fq; asm volatile("" : "+v"(col0));
        u32x4 l0[2][4][2];
#pragma unroll
        for (int ai = 0; ai < 2; ++ai)
#pragma unroll
            for (int m = 0; m < 4; ++m) { const bf16_t* zr = Z + (size_t)(row0 + ai * HALF + m * 16) * NZ + col0;
#pragma unroll
                for (int bj = 0; bj < 2; ++bj) l0[ai][m][bj] = *(const u32x4*)(zr + ZO_GL0 + bj * HALF); }
#pragma unroll
        for (int ai = 0; ai < 2; ++ai)
#pragma unroll
            for (int m = 0; m < 4; ++m) { bf16_t* orow = O + (size_t)(row0 + ai * HALF + m * 16) * D + col0;
#pragma unroll
                for (int bj = 0; bj < 2; ++bj) {
                    const unsigned a0[4] = {l0[ai][m][bj].x, l0[ai][m][bj].y, l0[ai][m][bj].z, l0[ai][m][bj].w};
                    float o[8];
#pragma unroll
                    for (int q = 0; q < 4; ++q) { o[2 * q] = acc[ai][bj][m][q >> 1][(q & 1) * 2 + 0] * sigmoidf_(bflo(a0[q])); o[2 * q + 1] = acc[ai][bj][m][q >> 1][(q & 1) * 2 + 1] * sigmoidf_(bfhi(a0[q])); }
                    u32x4 w; w.x = cvt_pk_bf16(o[0], o[1]); w.y = cvt_pk_bf16(o[2], o[3]); w.z = cvt_pk_bf16(o[4], o[5]); w.w = cvt_pk_bf16(o[6], o[7]);
                    *(u32x4*)(orow + bj * HALF) = w; } }
    }
};
struct EpiResid {
    static constexpr bool PERM = false; static constexpr int HOOK_T = -1;
    float* X; float* XO; const float* gate;
    __device__ __forceinline__ void mid(f32x4 (&)[2][2][4][2], const Unit&, int, int, int, int) const {}
    __device__ __forceinline__ void operator()(const f32x4 (&acc)[2][2][4][2], const Unit& u, int wr, int wc, int fr, int fq) const {
        { const int l_ = tid_of(0); fr = l_ & 15; fq = l_ >> 4; }
        int row0 = u.row0 + wr * 64 + fr; asm volatile("" : "+v"(row0)); int col0 = u.pn * BM + wc * 32 + 4 * fq; asm volatile("" : "+v"(col0));
        const float* gp = gate + (size_t)(u.row0 / SEQ) * (6 * D) + col0;
        f32x4 gv[2][2];
#pragma unroll
        for (int bj = 0; bj < 2; ++bj)
#pragma unroll
            for (int n = 0; n < 2; ++n) gv[bj][n] = *(const f32x4*)(gp + bj * HALF + n * 16);
#pragma unroll
        for (int ai = 0; ai < 2; ++ai) {
            f32x4 xv[4][2][2];
#pragma unroll
            for (int m = 0; m < 4; ++m) { const float* rowp = X + (size_t)(row0 + ai * HALF + m * 16) * D + col0;
#pragma unroll
                for (int bj = 0; bj < 2; ++bj)
#pragma unroll
                    for (int n = 0; n < 2; ++n) xv[m][bj][n] = *(const f32x4*)(rowp + bj * HALF + n * 16); }
#pragma unroll
            for (int m = 0; m < 4; ++m) { float* rowo = XO + (size_t)(row0 + ai * HALF + m * 16) * D + col0;
#pragma unroll
                for (int bj = 0; bj < 2; ++bj)
#pragma unroll
                    for (int n = 0; n < 2; ++n) *(f32x4*)(rowo + bj * HALF + n * 16) = xv[m][bj][n] + gv[bj][n] * acc[ai][bj][m][n]; }
            asm volatile("" ::: "memory"); }
    }
};
struct EpiSwiglu {
    static constexpr bool PERM = true; static constexpr int HOOK_T = -1;
    unsigned char* ACT; const float* bias; float wscale;
    __device__ __forceinline__ void mid(f32x4 (&)[2][2][4][2], const Unit&, int, int, int, int) const {}
    __device__ __forceinline__ void operator()(const f32x4 (&acc)[2][2][4][2], const Unit& u, int wr, int wc, int fr, int fq) const {
        { const int l_ = tid_of(0); fr = l_ & 15; fq = l_ >> 4; }
        int row0 = u.row0 + wr * 64 + fr; asm volatile("" : "+v"(row0)); int cc = u.pn * HALF + wc * 32 + 8 * fq; asm volatile("" : "+v"(cc));
        const float* bp = bias + (size_t)u.e * 2048 + cc;
        f32x4 bg[2], bu[2];
#pragma unroll
        for (int n = 0; n < 2; ++n) { bg[n] = *(const f32x4*)(bp + 4 * n); bu[n] = *(const f32x4*)(bp + 1024 + 4 * n); }
#pragma unroll
        for (int ai = 0; ai < 2; ++ai)
#pragma unroll
            for (int m = 0; m < 4; ++m) { unsigned char* rowp = ACT + (size_t)(row0 + ai * HALF + m * 16) * D + cc;
                float o[8];
#pragma unroll
                for (int n = 0; n < 2; ++n)
#pragma unroll
                    for (int j = 0; j < 4; ++j) { float g = acc[ai][0][m][n][j] * wscale + bg[n][j], up = acc[ai][1][m][n][j] * wscale + bu[n][j];
                        g = fminf(g, 7.0f); up = fminf(fmaxf(up, -7.0f), 7.0f);
                        o[4 * n + j] = g * sigmoidf_(1.702f * g) * (up + 1.0f); }
                int w0 = 0, w1 = 0;
                w0 = __builtin_amdgcn_cvt_pk_fp8_f32(o[0], o[1], w0, false); w0 = __builtin_amdgcn_cvt_pk_fp8_f32(o[2], o[3], w0, true);
                w1 = __builtin_amdgcn_cvt_pk_fp8_f32(o[4], o[5], w1, false); w1 = __builtin_amdgcn_cvt_pk_fp8_f32(o[6], o[7], w1, true);
                *(u32x2*)rowp = (u32x2){(unsigned)w0, (unsigned)w1}; }
    }
};
struct EpiMoeOut {
    static constexpr bool PERM = true; static constexpr int HOOK_T = -1;
    bf16_t* O; const float* bias; float wscale;
    __device__ __forceinline__ void mid(f32x4 (&)[2][2][4][2], const Unit&, int, int, int, int) const {}
    __device__ __forceinline__ void operator()(const f32x4 (&acc)[2][2][4][2], const Unit& u, int wr, int wc, int fr, int fq) const {
        const EpiBf16 e{O, D, bias + (size_t)u.e * D, 0, wscale}; e(acc, u, wr, wc, fr, fq);
    }
};
}

#define XB_TMO      128
#define XB_XCNT(j)  (256  + 64 * (j))
#define XB_XSUB(j)  (1280 + 64 * (j))
#define XB_XGEN(j)  (2304 + 64 * (j))
#define XB_TOP      3328
#define XB_TOPGEN   3392
#define XCD_BAR_WORDS 3456
#define XB_SPIN_CAP (1u << 18)
__device__ __forceinline__ unsigned xb_ld(unsigned* p)              { return __hip_atomic_load(p, __ATOMIC_RELAXED, __HIP_MEMORY_SCOPE_AGENT); }
__device__ __forceinline__ unsigned xb_add(unsigned* p, unsigned v) { return __hip_atomic_fetch_add(p, v, __ATOMIC_RELAXED, __HIP_MEMORY_SCOPE_AGENT); }
__device__ __forceinline__ unsigned xb_xcc_id() { return (unsigned)__builtin_amdgcn_s_getreg((3 << 11) | 20) & 0xFu; }
#define XB_SPIN(cond, bar) do { unsigned _sp = 0; while (cond) { __builtin_amdgcn_s_sleep(1); \
    if ((++_sp & 255u) == 0u) { if (xb_ld(&(bar)[XB_TMO])) break; if (_sp > XB_SPIN_CAP) { atomicAdd(&(bar)[XB_TMO], 1u); break; } } } } while (0)
struct XcdBarrier { unsigned* bar; unsigned x; volatile LAS unsigned* st; int wv; };
__device__ __forceinline__ XcdBarrier xcd_barrier_post(unsigned* bar, volatile LAS unsigned* st, int wv) {
    XcdBarrier b; b.bar = bar; b.x = xb_xcc_id(); b.st = st; b.wv = wv;
    if (tid_of(wv) == 0) (void)xb_add(&bar[XB_XCNT(b.x)], 1u);
    return b;
}
__device__ __forceinline__ void xcd_barrier_complete(unsigned* bar, unsigned x, unsigned& nloc, unsigned& nx) {
    const unsigned G = gridDim.x * gridDim.y * gridDim.z;
    unsigned sum, cnt, mine, sp = 0u;
    for (;;) {
        sum = 0u; cnt = 0u; mine = 0u;
#pragma unroll
        for (unsigned j = 0; j < 16; ++j) { const unsigned c = xb_ld(&bar[XB_XCNT(j)]); sum += c; cnt += (c > 0u) ? 1u : 0u; mine = (j == x) ? c : mine; }
        if (sum == G) break;
        __builtin_amdgcn_s_sleep(1);
        if ((++sp & 255u) == 0u) { if (xb_ld(&bar[XB_TMO])) break; if (sp > XB_SPIN_CAP) { atomicAdd(&bar[XB_TMO], 1u); break; } }
    }
    nloc = mine > 0u ? mine : 1u; nx = cnt > 0u ? cnt : 1u;
}
__device__ __forceinline__ void xcd_barrier(const XcdBarrier& b) {
    asm volatile("s_waitcnt vmcnt(0)" ::: "memory");
    __syncthreads();
    if (tid_of(b.wv) == 0) {
        size_t zb = 0; asm volatile("" : "+s"(zb)); unsigned* bar = b.bar + zb; unsigned bx = b.x; asm volatile("" : "+s"(bx));
        __builtin_amdgcn_s_waitcnt(0);
        unsigned nloc = b.st[0], nx = b.st[1];
        if (nloc == 0u) { xcd_barrier_complete(bar, bx, nloc, nx); b.st[0] = nloc; b.st[1] = nx; }
        const unsigned old = xb_add(&bar[XB_XSUB(bx)], 1u);
        const unsigned gen = old / nloc;
        if (old + 1u == (gen + 1u) * nloc) {
            __builtin_amdgcn_fence(__ATOMIC_RELEASE, "agent");
            asm volatile("s_waitcnt vmcnt(0)" ::: "memory");
            const unsigned og = xb_add(&bar[XB_TOP], 1u);
            const unsigned tg = og / nx;
            if (og + 1u == (tg + 1u) * nx) xb_add(&bar[XB_TOPGEN], 1u);
            else XB_SPIN(xb_ld(&bar[XB_TOPGEN]) == tg, bar);
            __builtin_amdgcn_fence(__ATOMIC_ACQUIRE, "agent");
            xb_add(&bar[XB_XGEN(bx)], 1u);
            asm volatile("s_waitcnt vmcnt(0)" ::: "memory");
        } else {
            XB_SPIN(xb_ld(&bar[XB_XGEN(bx)]) == gen, bar);
            __builtin_amdgcn_fence(__ATOMIC_ACQUIRE, "agent");
            asm volatile("s_waitcnt vmcnt(0)" ::: "memory");
        }
    }
    __syncthreads();
}

struct Args { const float* in[26]; float* out; unsigned char* ws; int ph_lo, ph_hi; };
enum { I_X = 0, I_C, I_N1G, I_N2G, I_WADA, I_BADA, I_WIN, I_CONVW, I_CONVB, I_WRGA, I_BRGA, I_WRGX, I_BRGX, I_LAM, I_WPOOL, I_PSCALE, I_WUPA, I_WUPB, I_WOUT, I_WROUTER, I_BROUTER, I_WEIN, I_BEIN, I_WEOUT, I_BEOUT, I_FINALG };

template <int ROWMODE>
__device__ __forceinline__ void tr_item(const float* W, int N, bf16_t* WT, int dst_ld, int dst_off, int k0, int n0, LAS float* scr, int lane) {
#pragma unroll 8
    for (int i = 0; i < 32; ++i) { const int kk = 2 * i + (lane >> 5); scr[kk * 33 + (lane & 31)] = W[(size_t)(k0 + kk) * N + n0 + (lane & 31)]; }
    LDS_WAIT();
    const int c = lane & 7;
#pragma unroll
    for (int j = 0; j < 4; ++j) { const int n = (lane >> 3) + 8 * j; const LAS float* s = scr + (8 * c) * 33 + n;
        u32x4 o; o.x = cvt_pk_bf16(s[0 * 33], s[1 * 33]); o.y = cvt_pk_bf16(s[2 * 33], s[3 * 33]); o.z = cvt_pk_bf16(s[4 * 33], s[5 * 33]); o.w = cvt_pk_bf16(s[6 * 33], s[7 * 33]);
        const int nn = n0 + n; int drow = nn;
        if (ROWMODE == 1) { drow = (nn < 1024) ? (256 * (nn >> 7) + (nn & 127)) : (256 * ((nn - 1024) >> 7) + 128 + ((nn - 1024) & 127)); }
        *(u32x4*)(WT + (size_t)drow * dst_ld + dst_off + k0 + 8 * c) = o; }
    LDS_WAIT();
}
template <int ROWMODE>
__device__ __forceinline__ void tr_item_fp8(const float* W, int N, unsigned char* WT, int k0, int n0, LAS float* scr, int lane) {
#pragma unroll 8
    for (int i = 0; i < 64; ++i) { const int kk = 2 * i + (lane >> 5); scr[kk * 33 + (lane & 31)] = W[(size_t)(k0 + kk) * N + n0 + (lane & 31)]; }
    LDS_WAIT();
    const int c = lane & 7;
#pragma unroll
    for (int j = 0; j < 4; ++j) { const int n = (lane >> 3) + 8 * j; const LAS float* s = scr + (16 * c) * 33 + n;
        int o[4];
#pragma unroll
        for (int q = 0; q < 4; ++q) { int w = 0; w = __builtin_amdgcn_cvt_pk_fp8_f32(s[(4 * q) * 33] * WEIN_SCALE, s[(4 * q + 1) * 33] * WEIN_SCALE, w, false);
            w = __builtin_amdgcn_cvt_pk_fp8_f32(s[(4 * q + 2) * 33] * WEIN_SCALE, s[(4 * q + 3) * 33] * WEIN_SCALE, w, true); o[q] = w; }
        const int nn = n0 + n; const int drow = (ROWMODE == 0) ? nn : ((nn < 1024) ? (256 * (nn >> 7) + (nn & 127)) : (256 * ((nn - 1024) >> 7) + 128 + ((nn - 1024) & 127)));
        *(u32x4*)(WT + (size_t)drow * 1024 + k0 + 16 * c) = (u32x4){(unsigned)o[0], (unsigned)o[1], (unsigned)o[2], (unsigned)o[3]}; }
    LDS_WAIT();
}
template <int ROWMODE>
__device__ __forceinline__ void tr_job(int item, const float* src, int K, int N, bf16_t* dst, size_t dst_bstride, int dst_ld, int dst_off, LAS float* scr, int lane) {
    const int nnb = N / 32, nkb = K / 64; const int nb = item % nnb; const int r = item / nnb; const int kb = r % nkb; const int bt = r / nkb;
    tr_item<ROWMODE>(src + (size_t)bt * K * N, N, dst + (size_t)bt * dst_bstride, dst_ld, dst_off, 64 * kb, 32 * nb, scr, lane);
}

__device__ __forceinline__ void phase_prologue(const Args& a, LAS unsigned char* lds, const int wv) {
    int tid_ = tid_of(wv); asm volatile("" : "+v"(tid_)); const int tid = tid_, lane = tid & 63, wave = __builtin_amdgcn_readfirstlane(tid >> 6);
    const int G = gridDim.x;
    unsigned char* ws = opaque_ptr(a.ws); const int bid = opaque_bid();
    {
        LAS float* cact = (LAS float*)lds;
        LAS float* red = (LAS float*)(lds + 32768);
        for (int i = tid; i < NBATCH * D; i += NTHREADS) { const float v = a.in[I_C][i]; cact[i] = v * sigmoidf_(v); }
        __syncthreads();
        float* mod = (float*)(ws + WS_MOD);
        for (int u = bid; u < DEPTH * 96; u += G) {
            const int l = u / 96, cg = u % 96; const int n = cg * 64 + lane;
            const float* w = a.in[I_WADA] + (size_t)l * D * 6144 + n;
            float acc[8] = {0.f, 0.f, 0.f, 0.f, 0.f, 0.f, 0.f, 0.f};
            const int kb = wave * 128;
#pragma unroll 8
            for (int k = 0; k < 128; ++k) { const float wv = w[(size_t)(kb + k) * 6144];
#pragma unroll
                for (int b = 0; b < 8; ++b) acc[b] += cact[b * D + kb + k] * wv; }
#pragma unroll
            for (int b = 0; b < 8; ++b) red[(wave * 8 + b) * 64 + lane] = acc[b];
            __syncthreads();
            { const int b = tid >> 6; float s = 0.f;
#pragma unroll
              for (int w8 = 0; w8 < 8; ++w8) s += red[(w8 * 8 + b) * 64 + lane];
              mod[((size_t)l * NBATCH + b) * 6144 + n] = s + a.in[I_BADA][(size_t)l * 6144 + n]; }
            __syncthreads();
        }
    }
    {
        LAS float* scr = (LAS float*)(lds + wave * 16896);
        const int gw = bid * NWAVES + wave, NGW = G * NWAVES;
        constexpr int I_EIN = DEPTH * NE * 8 * 64, I_EOUT = DEPTH * NE * 8 * 32, I_WINI = DEPTH * (Z_FP8 ? 8 : 16) * 144, I_UPA = DEPTH * 16 * 32, I_UPB = DEPTH * 8 * 32, I_OUT = DEPTH * 16 * 32,
                      I_RGA = DEPTH * 8 * 2 * 4, I_RGX = I_RGA, I_POOL = DEPTH * 4 * 2 * 4;
        constexpr int NITEMS = I_EIN + I_EOUT + I_WINI + I_UPA + I_UPB + I_OUT + I_RGA + I_RGX + I_POOL;
        for (int it = gw; it < NITEMS; it += NGW) {
            int r = it;
            if (r < I_EIN) { const int nb = r % 64, r2 = r / 64, kb = r2 % 8, bt = r2 / 8;
                tr_item_fp8<1>(a.in[I_WEIN] + (size_t)bt * 1024 * 2048, 2048, (unsigned char*)(ws + WS_WEIN) + (size_t)bt * 2048 * 1024, 128 * kb, 32 * nb, scr, lane); continue; } r -= I_EIN;
            if (r < I_EOUT) { const int nb = r % 32, r2 = r / 32, kb = r2 % 8, bt = r2 / 8;
                tr_item_fp8<0>(a.in[I_WEOUT] + (size_t)bt * 1024 * 1024, 1024, (unsigned char*)(ws + WS_WEOUT) + (size_t)bt * 1024 * 1024, 128 * kb, 32 * nb, scr, lane); continue; } r -= I_EOUT;
#if Z_FP8
            if (r < I_WINI) { const int nb = r % 144, r2 = r / 144, kb = r2 % 8, bt = r2 / 8;
                tr_item_fp8<0>(a.in[I_WIN] + (size_t)bt * 1024 * NZ, NZ, (unsigned char*)(ws + WS_WIN) + (size_t)bt * NZ * 1024, 128 * kb, 32 * nb, scr, lane); continue; } r -= I_WINI;
#else
            if (r < I_WINI) { tr_job<0>(r, a.in[I_WIN], 1024, NZ, (bf16_t*)(ws + WS_WIN), (size_t)NZ * 1024, 1024, 0, scr, lane); continue; } r -= I_WINI;
#endif
            if (r < I_UPA) { tr_job<0>(r, a.in[I_WUPA], 1024, 1024, (bf16_t*)(ws + WS_WCAT), (size_t)1024 * KCAT, KCAT, 512, scr, lane); continue; } r -= I_UPA;
            if (r < I_UPB) { tr_job<0>(r, a.in[I_WUPB], 512, 1024, (bf16_t*)(ws + WS_WCAT), (size_t)1024 * KCAT, KCAT, 0, scr, lane); continue; } r -= I_UPB;
            if (r < I_OUT) { tr_job<0>(r, a.in[I_WOUT], 1024, 1024, (bf16_t*)(ws + WS_WOUT), (size_t)1024 * 1024, 1024, 0, scr, lane); continue; } r -= I_OUT;
            if (r < I_RGA) { tr_job<0>(r, a.in[I_WRGA], 128, 128, (bf16_t*)(ws + WS_WRG), (size_t)256 * 128, 128, 0, scr, lane); continue; } r -= I_RGA;
            if (r < I_RGX) { tr_job<0>(r, a.in[I_WRGX], 128, 128, (bf16_t*)(ws + WS_WRG) + 128 * 128, (size_t)256 * 128, 128, 0, scr, lane); continue; } r -= I_RGX;
            tr_job<0>(r, a.in[I_WPOOL], 128, 128, (bf16_t*)(ws + WS_WPOOL), (size_t)128 * 128, 128, 0, scr, lane);
        }
    }
}

struct MoeTab { LAS int* cnt; LAS int* padstart; LAS int* tilestart; LAS int* tab; };
__device__ __forceinline__ MoeTab moe_tab_ptrs(LAS unsigned char* lds) { MoeTab t; t.cnt = (LAS int*)(lds + LDS_TAB); t.padstart = t.cnt + 32; t.tilestart = t.padstart + 40; t.tab = t.tilestart + 40; return t; }
__device__ __forceinline__ void moe_tables(const Args& a, int l, LAS unsigned char* lds, const int wv) {
    const MoeTab mt = moe_tab_ptrs(lds); int tid_ = tid_of(wv); asm volatile("" : "+v"(tid_)); const int tid = tid_;
    unsigned* ctl = (unsigned*)(opaque_ptr(a.ws) + WS_CTL);
    __syncthreads();
    if (tid < NE) mt.cnt[tid] = (int)__hip_atomic_load(ctl + CW_CNT + (l * NE + tid) * 16, __ATOMIC_RELAXED, __HIP_MEMORY_SCOPE_AGENT);
    __syncthreads();
    if (tid == 0) { int ps = 0, ts = 0; for (int e = 0; e < NE; ++e) { mt.padstart[e] = ps; mt.tilestart[e] = ts; const int nt = (mt.cnt[e] + 255) >> 8; ps += nt * 256; ts += nt; } mt.padstart[NE] = ps; mt.tilestart[NE] = ts; }
    __syncthreads();
    const int nMt = mt.tilestart[NE];
    for (int m = tid; m < nMt; m += NTHREADS) { int e = 0; for (int q = 1; q < NE; ++q) e = (mt.tilestart[q] <= m) ? q : e; mt.tab[m] = (e << 16) | (m - mt.tilestart[e]); }
    __syncthreads();
}
struct MoeSched1 {
    static constexpr bool DYN_A = true;
    const char* H; const char* W; const int* tokof; MoeTab mt; int nMt, G, c;
    __device__ __forceinline__ bool next(int i, pg8::Unit& u) const { int pm, pn; if (!pg8::order_map(i, G, c, nMt, 8, pm, pn)) return false;
        const int en = __builtin_amdgcn_readfirstlane(mt.tab[pm]); u.pm = pm; u.pn = pn; u.e = en >> 16; u.j = en & 0xffff;
        u.row0 = __builtin_amdgcn_readfirstlane(mt.padstart[u.e]) + 256 * u.j; u.rows = __builtin_amdgcn_readfirstlane(mt.cnt[u.e]) - 256 * u.j; return true; }
    __device__ __forceinline__ const char* a_ptr() const { return H; }
    __device__ __forceinline__ const char* b_ptr() const { return W; }
    __device__ __forceinline__ unsigned a_off(const pg8::Unit&) const { return 0u; }
    __device__ __forceinline__ unsigned b_off(const pg8::Unit& u) const { return ((unsigned)u.e * 2048u + (unsigned)u.pn * 256u) * 1024u; }
    __device__ __forceinline__ void a_voff(const pg8::Unit& u, unsigned (&v)[2][2], int wv) const {
        int tid = tid_of(wv); asm volatile("" : "+v"(tid));
        const int* tl = tokof + (size_t)u.e * T + 256 * u.j; const int rmax = u.rows - 1;
#pragma unroll
        for (int i = 0; i < 2; ++i) { int R, C; pg8::stage_rc(tid * 16 + i * 8192, R, C);
#pragma unroll
            for (int h = 0; h < 2; ++h) { int idx = h * 128 + R; idx = idx < rmax ? idx : rmax; v[h][i] = (unsigned)tl[idx] * 1024u + (unsigned)C * 2u; } }
    }
};
struct MoeSched2 {
    static constexpr bool DYN_A = false;
    const char* ACT; const char* W; MoeTab mt; int nMt, G, c;
    __device__ __forceinline__ bool next(int i, pg8::Unit& u) const { int pm, pn; if (!pg8::order_map(i, G, c, nMt, 4, pm, pn)) return false;
        const int en = __builtin_amdgcn_readfirstlane(mt.tab[pm]); u.pm = pm; u.pn = pn; u.e = en >> 16; u.j = en & 0xffff;
        u.row0 = __builtin_amdgcn_readfirstlane(mt.padstart[u.e]) + 256 * u.j; u.rows = __builtin_amdgcn_readfirstlane(mt.cnt[u.e]) - 256 * u.j; return true; }
    __device__ __forceinline__ const char* a_ptr() const { return ACT; }
    __device__ __forceinline__ const char* b_ptr() const { return W; }
    __device__ __forceinline__ unsigned a_off(const pg8::Unit& u) const { return (unsigned)u.row0 * 1024u; }
    __device__ __forceinline__ unsigned b_off(const pg8::Unit& u) const { return ((unsigned)u.e * 1024u + (unsigned)u.pn * 256u) * 1024u; }
    __device__ __forceinline__ void a_voff(const pg8::Unit&, unsigned (&v)[2][2], int wv) const {
        int tid = tid_of(wv); asm volatile("" : "+v"(tid));
#pragma unroll
        for (int i = 0; i < 2; ++i) { int R, C; pg8::stage_rc(tid * 16 + i * 8192, R, C);
#pragma unroll
            for (int h = 0; h < 2; ++h) v[h][i] = (unsigned)((h * 128 + R) * 512 + C) * 2u; }
    }
};

__device__ __forceinline__ void phase_a(const Args& a, int l, LAS unsigned char* lds, bool dry, const int wv) {
    int tid_ = tid_of(wv); asm volatile("" : "+v"(tid_)); const int tid = tid_, lane = tid & 63, wave = __builtin_amdgcn_readfirstlane(tid >> 6);
    const int G = gridDim.x; unsigned char* ws = opaque_ptr(a.ws); const int bid = opaque_bid();
    const float* mod = (const float*)(ws + WS_MOD);
    float* xres = (float*)(ws + WS_XRES); float* xout = dry ? (float*)(ws + WS_Z) : xres;
    if (l < DEPTH && bid < NBATCH) {
        LAS float* red = (LAS float*)lds;
        const int b = bid, e = tid & 31, kp = tid >> 5;
        const float* sh2 = mod + ((size_t)l * NBATCH + b) * 6144 + 3 * D; const float* wr = a.in[I_WROUTER] + (size_t)l * D * NE;
        float s = 0.f;
        for (int k = kp * 64; k < kp * 64 + 64; ++k) s += sh2[k] * wr[k * NE + e];
        red[kp * 32 + e] = s;
        __syncthreads();
        if (tid < 32) { float t = a.in[I_BROUTER][l * NE + tid]; for (int q = 0; q < 16; ++q) t += red[q * 32 + tid]; ((float*)(ws + WS_CB))[(l * NBATCH + b) * NE + tid] = t; }
        __syncthreads();
    }
    if (l > 0) moe_tables(a, (l - 1) + DEPTH * (REPN(7) - 1), lds, wv);
    const MoeTab mt = moe_tab_ptrs(lds);
    const int* slotinfo = (const int*)(ws + WS_SLOTINFO); const float* wgt = (const float*)(ws + WS_WGT);
    const bf16_t* outb = (const bf16_t*)(ws + WS_OUTB);
    unsigned char* hb = (unsigned char*)(ws + WS_H);
    for (int chunk = bid; chunk < T / 128; chunk += G) {
        const int rowb = chunk * 128 + wave * 16; const int b = rowb / SEQ;
        const float* xin = (l == 0) ? (a.in[I_X] + (size_t)rowb * D) : (xres + (size_t)rowb * D);
        f32x4 xv[2][4]; int4 si[4]; f32x4 wv[4]; u32x2 gv[2][4][4];
#define PA_SX(r, q) do { if ((r) < 16) { _Pragma("unroll") for (int j = 0; j < 4; ++j) xv[(q) & 1][j] = *(const f32x4*)(xin + (size_t)(r) * D + 4 * lane + 256 * j); } } while (0)
#define PA_S0(r, q) do { if ((r) < 16 && l > 0) { si[(q) & 3] = *(const int4*)(slotinfo + (size_t)(rowb + (r)) * 4); wv[(q) & 3] = *(const f32x4*)(wgt + (size_t)(rowb + (r)) * 4); } } while (0)
#define PA_S1(r, q) do { if ((r) < 16 && l > 0) { const int sl_[4] = {si[(q) & 3].x, si[(q) & 3].y, si[(q) & 3].z, si[(q) & 3].w}; \
            _Pragma("unroll") for (int kk = 0; kk < 4; ++kk) { const int e_ = sl_[kk] >> 24, li_ = sl_[kk] & 0xffffff; const bf16_t* orow = outb + (size_t)(mt.padstart[e_] + li_) * D + 4 * lane; \
                _Pragma("unroll") for (int j = 0; j < 4; ++j) gv[(q) & 1][kk][j] = *(const u32x2*)(orow + 256 * j); } } } while (0)
        PA_S0(0, 0); PA_S0(1, 1); PA_SX(0, 0); PA_S1(0, 0);
#pragma unroll 1
        for (int i0 = 0; i0 < 16; i0 += 4) {
#pragma unroll
          for (int ii = 0; ii < 4; ++ii) {
            const int i = i0 + ii; const int row = rowb + i;
            PA_S0(i + 2, ii + 2); PA_SX(i + 1, ii + 1); PA_S1(i + 1, ii + 1);
            f32x4 v[4];
#pragma unroll
            for (int j = 0; j < 4; ++j) v[j] = xv[ii & 1][j];
            if (l > 0) {
                f32x4 y[4];
#pragma unroll
                for (int j = 0; j < 4; ++j) y[j] = (f32x4){0.f, 0.f, 0.f, 0.f};
#pragma unroll
                for (int kk = 0; kk < 4; ++kk) { const float w = wv[ii][kk];
#pragma unroll
                    for (int j = 0; j < 4; ++j) { const u32x2 p = gv[ii & 1][kk][j]; y[j] += w * (f32x4){bflo(p.x), bfhi(p.x), bflo(p.y), bfhi(p.y)}; } }
                const float* g2 = mod + ((size_t)(l - 1) * NBATCH + b) * 6144 + 5 * D + 4 * lane;
#pragma unroll
                for (int j = 0; j < 4; ++j) v[j] += *(const f32x4*)(g2 + 256 * j) * y[j];
            }
            if (l < DEPTH) {
#pragma unroll
                for (int j = 0; j < 4; ++j) *(f32x4*)(xout + (size_t)row * D + 4 * lane + 256 * j) = v[j];
            }
            float ss = 0.f;
#pragma unroll
            for (int j = 0; j < 4; ++j) ss += (v[j].x * v[j].x + v[j].y * v[j].y) + (v[j].z * v[j].z + v[j].w * v[j].w);
            const float rinv = 1.0f / sqrtf(wave_sum(ss, lane) * (1.0f / D) + NORM_EPS);
            if (l < DEPTH) {
                const float* ng = a.in[I_N1G] + (size_t)l * D + 4 * lane; const float* mb = mod + ((size_t)l * NBATCH + b) * 6144 + 4 * lane;
#pragma unroll
                for (int j = 0; j < 4; ++j) { const f32x4 g = *(const f32x4*)(ng + 256 * j), sh = *(const f32x4*)(mb + 256 * j), sc = *(const f32x4*)(mb + D + 256 * j);
                    const f32x4 h = (v[j] * rinv * g) * (1.0f + sc) + sh;
#if Z_FP8
                    int p = 0; p = __builtin_amdgcn_cvt_pk_fp8_f32(h.x, h.y, p, false); p = __builtin_amdgcn_cvt_pk_fp8_f32(h.z, h.w, p, true);
                    *(int*)(hb + (size_t)row * D + 4 * lane + 256 * j) = p; }
#else
                    u32x2 p; p.x = cvt_pk_bf16(h.x, h.y); p.y = cvt_pk_bf16(h.z, h.w); *(u32x2*)((bf16_t*)hb + (size_t)row * D + 4 * lane + 256 * j) = p; }
#endif
            } else {
                const float* fg = a.in[I_FINALG] + 4 * lane;
#pragma unroll
                for (int j = 0; j < 4; ++j) *(f32x4*)(a.out + (size_t)row * D + 4 * lane + 256 * j) = v[j] * rinv * *(const f32x4*)(fg + 256 * j);
            }
          }
        }
#undef PA_S0
#undef PA_SX
#undef PA_S1
    }
}

__device__ __forceinline__ void phase_h(const Args& a, int l, int cset, LAS unsigned char* lds, const int wv) {
    int tid_ = tid_of(wv); asm volatile("" : "+v"(tid_)); const int tid = tid_, lane = tid & 63, wave = __builtin_amdgcn_readfirstlane(tid >> 6);
    const int G = gridDim.x; unsigned char* ws = opaque_ptr(a.ws); const int bid = opaque_bid();
    const float* mod = (const float*)(ws + WS_MOD); const float* xres = (const float*)(ws + WS_XRES);
    unsigned char* h8 = (unsigned char*)(ws + WS_H);
    LAS float* rinvs = (LAS float*)lds;
    LAS float* lgt = (LAS float*)(lds + 1024);
    LAS int* hist = (LAS int*)(lds + 1024 + 8 * 16 * 33 * 4);
    LAS int* base = hist + 32;
    unsigned* ctl = (unsigned*)(ws + WS_CTL);
    const float* wr = a.in[I_WROUTER] + (size_t)l * D * NE;
    const float* ng = a.in[I_N2G] + (size_t)l * D;
    const float* cbv = (const float*)(ws + WS_CB);
    int* tokof = (int*)(ws + WS_TOKOF); int* slotinfo = (int*)(ws + WS_SLOTINFO); float* wgt = (float*)(ws + WS_WGT);
    for (int chunk = bid; chunk < T / 128; chunk += G) {
        const int row0 = chunk * 128 + wave * 16; const int b = row0 / SEQ;
        const float* mb = mod + ((size_t)l * NBATCH + b) * 6144 + 3 * D;
        if (tid < 32) hist[tid] = 0;
        f32x4 xq[3][4];
#pragma unroll
        for (int r = 0; r < 2; ++r)
#pragma unroll
            for (int j = 0; j < 4; ++j) xq[r][j] = *(const f32x4*)(xres + (size_t)(row0 + r) * D + 4 * lane + 256 * j);
#pragma unroll
        for (int i = 0; i < 16; ++i) {
            const int row = row0 + i;
            if (i + 2 < 16) {
#pragma unroll
                for (int j = 0; j < 4; ++j) xq[(i + 2) % 3][j] = *(const f32x4*)(xres + (size_t)(row + 2) * D + 4 * lane + 256 * j); }
            f32x4 v[4]; float ss = 0.f;
#pragma unroll
            for (int j = 0; j < 4; ++j) { v[j] = xq[i % 3][j]; ss += (v[j].x * v[j].x + v[j].y * v[j].y) + (v[j].z * v[j].z + v[j].w * v[j].w); }
            const float rinv = 1.0f / sqrtf(wave_sum(ss, lane) * (1.0f / D) + NORM_EPS);
            if (lane == 0) rinvs[wave * 16 + i] = rinv;
#pragma unroll
            for (int j = 0; j < 4; ++j) { const f32x4 g = *(const f32x4*)(ng + 4 * lane + 256 * j), sh = *(const f32x4*)(mb + 4 * lane + 256 * j), sc = *(const f32x4*)(mb + D + 4 * lane + 256 * j);
                const f32x4 h = (v[j] * rinv * g) * (1.0f + sc) + sh;
                int p = 0; p = __builtin_amdgcn_cvt_pk_fp8_f32(h.x, h.y, p, false); p = __builtin_amdgcn_cvt_pk_fp8_f32(h.z, h.w, p, true);
                *(int*)(h8 + (size_t)row * D + 4 * lane + 256 * j) = p; }
        }
        {
            const int ri = lane & 15, q = lane >> 4;
            const float* xr = xres + (size_t)(row0 + ri) * D + 4 * q;
            f32x4 acc0 = {0.f, 0.f, 0.f, 0.f}, acc1 = {0.f, 0.f, 0.f, 0.f};
#pragma unroll 4
            for (int g = 0; g < 64; ++g) {
                const int k0 = 16 * g + 4 * q;
                const f32x4 xv = *(const f32x4*)(xr + 16 * g); const f32x4 gv = *(const f32x4*)(ng + k0), sc = *(const f32x4*)(mb + D + k0);
                const f32x4 av = xv * gv * (1.0f + sc);
#pragma unroll
                for (int e = 0; e < 4; ++e) { const float* wp = wr + (size_t)(k0 + e) * NE + ri;
                    acc0 = __builtin_amdgcn_mfma_f32_16x16x4f32(av[e], wp[0], acc0, 0, 0, 0);
                    acc1 = __builtin_amdgcn_mfma_f32_16x16x4f32(av[e], wp[16], acc1, 0, 0, 0); }
            }
            LDS_WAIT();
            const float c0 = cbv[(l * NBATCH + b) * NE + ri], c1 = cbv[(l * NBATCH + b) * NE + 16 + ri];
#pragma unroll
            for (int r = 0; r < 4; ++r) { const int ti = 4 * q + r; const float rv = rinvs[wave * 16 + ti];
                lgt[(wave * 16 + ti) * 33 + ri] = acc0[r] * rv + c0; lgt[(wave * 16 + ti) * 33 + 16 + ri] = acc1[r] * rv + c1; }
        }
        __syncthreads();
        int se[4] = {0, 0, 0, 0}; float sw[4] = {0.f, 0.f, 0.f, 0.f}; int rk[4] = {0, 0, 0, 0};
        if (lane < 16) {
            float v[32];
#pragma unroll
            for (int e = 0; e < 32; ++e) v[e] = lgt[(wave * 16 + lane) * 33 + e];
            float sv[4];
#pragma unroll
            for (int kk = 0; kk < 4; ++kk) { float best = v[0]; int bi = 0;
#pragma unroll
                for (int e = 1; e < 32; ++e) { if (v[e] > best) { best = v[e]; bi = e; } }
                sv[kk] = best; se[kk] = bi;
#pragma unroll
                for (int e = 0; e < 32; ++e) v[e] = (e == bi) ? -3.0e38f : v[e]; }
            float den = 0.f;
#pragma unroll
            for (int kk = 0; kk < 4; ++kk) { sw[kk] = __expf(sv[kk] - sv[0]); den += sw[kk]; }
            const float inv = 1.0f / den;
#pragma unroll
            for (int kk = 0; kk < 4; ++kk) { sw[kk] *= inv; rk[kk] = __hip_atomic_fetch_add(hist + se[kk], 1, __ATOMIC_RELAXED, __HIP_MEMORY_SCOPE_WORKGROUP); }
        }
        __syncthreads();
        if (tid < 32) base[tid] = (int)__hip_atomic_fetch_add(ctl + CW_CNT + (cset * NE + tid) * 16, (unsigned)hist[tid], __ATOMIC_RELAXED, __HIP_MEMORY_SCOPE_AGENT);
        __syncthreads();
        if (lane < 16) {
            const int row = row0 + lane; int si[4];
#pragma unroll
            for (int kk = 0; kk < 4; ++kk) { const int li = base[se[kk]] + rk[kk]; tokof[(size_t)se[kk] * T + li] = row; si[kk] = (se[kk] << 24) | li; }
            *(int4*)(slotinfo + (size_t)row * 4) = make_int4(si[0], si[1], si[2], si[3]);
            *(f32x4*)(wgt + (size_t)row * 4) = (f32x4){sw[0], sw[1], sw[2], sw[3]};
        }
        __syncthreads();
    }
}

constexpr int ZT_STRIDE = 528;
__device__ __forceinline__ void lru_unit(const Args& a, int l, int u, LAS unsigned char* lds, const int wv) {
    int tid_ = tid_of(wv); asm volatile("" : "+v"(tid_)); const int tid = tid_, lane = tid & 63, wave = __builtin_amdgcn_readfirstlane(tid >> 6);
    unsigned char* ws = opaque_ptr(a.ws);
    const bf16_t* z = (const bf16_t*)(ws + WS_Z);
    LAS unsigned char* zt = lds; LAS unsigned char* xc = lds + 131 * ZT_STRIDE;
    const int hp = u & 3, b = (u >> 2) & 7, s = u >> 5;
    const int t0 = b * SEQ + s * 128, p0 = s * 128;
    {   u32x4 sv[9];
#pragma unroll
        for (int k = 0; k < 9; ++k) { int idx = tid + NTHREADS * k; idx = idx < 131 * 32 ? idx : 131 * 32 - 1; const int r = idx >> 5, o = idx & 31; const int p = p0 - 3 + r; const int pc = p < 0 ? 0 : p;
            sv[k] = *(const u32x4*)(z + (size_t)(b * SEQ + pc) * NZ + hp * 256 + o * 8); if (p < 0) sv[k] = (u32x4){0u, 0u, 0u, 0u}; }
#pragma unroll
        for (int k = 0; k < 9; ++k) { int idx = tid + NTHREADS * k; idx = idx < 131 * 32 ? idx : 131 * 32 - 1; const int r = idx >> 5, o = idx & 31;
            *(LAS u32x4*)(zt + r * ZT_STRIDE + o * 16) = sv[k]; }
    }
    __syncthreads();
    {
        const int o = tid & 31, rb = tid >> 5; const int ch0 = hp * 256 + o * 8;
        float cw[4][8], cbias[8];
#pragma unroll
        for (int k = 0; k < 4; ++k) { const f32x4 w0 = *(const f32x4*)(a.in[I_CONVW] + ((size_t)l * 4 + k) * D + ch0), w1 = *(const f32x4*)(a.in[I_CONVW] + ((size_t)l * 4 + k) * D + ch0 + 4);
            cw[k][0] = w0.x; cw[k][1] = w0.y; cw[k][2] = w0.z; cw[k][3] = w0.w; cw[k][4] = w1.x; cw[k][5] = w1.y; cw[k][6] = w1.z; cw[k][7] = w1.w; }
        { const f32x4 b0 = *(const f32x4*)(a.in[I_CONVB] + (size_t)l * D + ch0), b1 = *(const f32x4*)(a.in[I_CONVB] + (size_t)l * D + ch0 + 4);
          cbias[0] = b0.x; cbias[1] = b0.y; cbias[2] = b0.z; cbias[3] = b0.w; cbias[4] = b1.x; cbias[5] = b1.y; cbias[6] = b1.z; cbias[7] = b1.w; }
#pragma unroll 2
        for (int i = 0; i < 8; ++i) { const int r = rb + 16 * i; float acc[8];
#pragma unroll
            for (int j = 0; j < 8; ++j) acc[j] = cbias[j];
#pragma unroll
            for (int k = 0; k < 4; ++k) { const u32x4 v = *(const LAS u32x4*)(zt + (r + k) * ZT_STRIDE + o * 16);
                acc[0] += cw[k][0] * bflo(v.x); acc[1] += cw[k][1] * bfhi(v.x); acc[2] += cw[k][2] * bflo(v.y); acc[3] += cw[k][3] * bfhi(v.y);
                acc[4] += cw[k][4] * bflo(v.z); acc[5] += cw[k][5] * bfhi(v.z); acc[6] += cw[k][6] * bflo(v.w); acc[7] += cw[k][7] * bfhi(v.w); }
            u32x4 w; w.x = cvt_pk_bf16(acc[0], acc[1]); w.y = cvt_pk_bf16(acc[2], acc[3]); w.z = cvt_pk_bf16(acc[4], acc[5]); w.w = cvt_pk_bf16(acc[6], acc[7]);
            *(LAS u32x4*)(xc + r * ZT_STRIDE + o * 16) = w; }
    }
    __syncthreads();
    {
        const int hsel = wave >> 2, wc = wave & 3, head = 2 * hp + hsel, c31 = lane & 31, hh = lane >> 5;
        const int ch = head * 128 + 32 * wc + c31;
        const bf16_t* wb = (const bf16_t*)(ws + WS_WRG) + ((size_t)(l * 8 + head) * 256 + 32 * wc + c31) * 128 + 8 * hh;
        bf16x8 Ba[8], Bi[8];
#pragma unroll
        for (int ks = 0; ks < 8; ++ks) { Ba[ks] = *(const bf16x8*)(wb + 16 * ks); Bi[ks] = *(const bf16x8*)(wb + 128 * 128 + 16 * ks); }
        const float ba = a.in[I_BRGA][(size_t)l * D + ch], bx = a.in[I_BRGX][(size_t)l * D + ch];
        const float lam = a.in[I_LAM][(size_t)l * D + ch];
        const float sp8 = 8.0f * log1pf(__expf(-lam));
        typedef __attribute__((address_space(1))) unsigned long long gu64;
        gu64* aggq = (gu64*)(ws + WS_AGG) + ((size_t)l * NBATCH * 32 + (size_t)b * 32) * D + ch;
        float Pr = 1.f, Hr = 0.f;
        unsigned hpk[64];
#pragma unroll
        for (int rb = 0; rb < 4; ++rb) {
            f32x16 aa, ai;
#pragma unroll
            for (int r = 0; r < 16; ++r) { aa[r] = 0.f; ai[r] = 0.f; }
            const LAS unsigned char* ap = xc + (32 * rb + c31) * ZT_STRIDE + (hsel * 128 + 8 * hh) * 2;
#pragma unroll
            for (int ks = 0; ks < 8; ++ks) { const bf16x8 A = *(const LAS bf16x8*)(ap + 32 * ks);
                aa = __builtin_amdgcn_mfma_f32_32x32x16_bf16(A, Ba[ks], aa, 0, 0, 0); ai = __builtin_amdgcn_mfma_f32_32x32x16_bf16(A, Bi[ks], ai, 0, 0, 0); }
            const LAS unsigned char* xp = xc + (32 * rb + 4 * hh) * ZT_STRIDE + (hsel * 128 + 32 * wc + c31) * 2;
#pragma unroll
            for (int q = 0; q < 4; ++q) {
                float p = 1.f, h = 0.f, hl[4], pl[4];
#pragma unroll
                for (int r3 = 0; r3 < 4; ++r3) { const int reg = 4 * q + r3;
                    const float xcv = bf1(*(const LAS bf16_t*)(xp + (8 * q + r3) * ZT_STRIDE));
                    const float rg = sigmoidf_(aa[reg] + ba), ig = sigmoidf_(ai[reg] + bx);
                    const float av = __expf(-sp8 * rg); const float mult = sqrtf(fmaxf(1.0f - av * av, 0.f));
                    h = av * h + mult * (ig * xcv); p *= av; hl[r3] = h; pl[r3] = p; }
                const float Ao = shflx(p, 32, lane), Bo = shflx(h, 32, lane);
                const float A0 = hh ? Ao : p, B0 = hh ? Bo : h, A1 = hh ? p : Ao, B1 = hh ? h : Bo;
                const float P1 = Pr * A0, H1 = Hr * A0 + B0;
                const float Pst = hh ? P1 : Pr, Hst = hh ? H1 : Hr;
                Pr = P1 * A1; Hr = H1 * A1 + B1;
#pragma unroll
                for (int r3 = 0; r3 < 4; ++r3) hpk[rb * 16 + 4 * q + r3] = cvt_pk_bf16(Hst * pl[r3] + hl[r3], Pst * pl[r3]);
            }
        }
        if (hh == 0) __hip_atomic_store(aggq + (size_t)s * D, ((unsigned long long)__float_as_uint(Hr) << 32) | (unsigned long long)__float_as_uint(fmaxf(Pr, 1e-37f)), __ATOMIC_RELAXED, __HIP_MEMORY_SCOPE_AGENT);
        const bf16_t* zg = z + (size_t)t0 * NZ + ZO_GLRU + ch;
        bf16_t* yo = (bf16_t*)(ws + WS_ACAT) + (size_t)t0 * KCAT + 512 + ch;
        bf16_t gcur[16], gnxt[16];
#pragma unroll
        for (int reg = 0; reg < 16; ++reg) gcur[reg] = zg[(size_t)(8 * (reg >> 2) + 4 * hh + (reg & 3)) * NZ];
        float cin = 0.f;
        for (int j0 = 0; j0 < s; j0 += 8) {
            unsigned long long w[8]; unsigned spins = 0;
            for (;;) { bool ok = true;
#pragma unroll
                for (int k = 0; k < 8; ++k) { const int j = (j0 + k < s) ? (j0 + k) : (s - 1); w[k] = __hip_atomic_load(aggq + (size_t)j * D, __ATOMIC_RELAXED, __HIP_MEMORY_SCOPE_AGENT); ok = ok && ((unsigned)w[k] != 0u); }
                if (__all(ok)) break;
                __builtin_amdgcn_s_sleep(4);
                if (++spins > (1u << 17)) break;
            }
#pragma unroll
            for (int k = 0; k < 8; ++k) { if (j0 + k < s) cin = __uint_as_float((unsigned)w[k]) * cin + __uint_as_float((unsigned)(w[k] >> 32)); }
        }
#pragma unroll
        for (int rb = 0; rb < 4; ++rb) {
            if (rb < 3) {
#pragma unroll
                for (int reg = 0; reg < 16; ++reg) gnxt[reg] = zg[(size_t)(32 * (rb + 1) + 8 * (reg >> 2) + 4 * hh + (reg & 3)) * NZ]; }
#pragma unroll
            for (int reg = 0; reg < 16; ++reg) { const int tok = 32 * rb + 8 * (reg >> 2) + 4 * hh + (reg & 3);
                const unsigned pk = hpk[rb * 16 + reg];
                const float hf = bflo(pk) + bfhi(pk) * cin;
                const float g = bf1(gcur[reg]);
                const float ge = g * __builtin_amdgcn_rcpf(1.0f + __expf(-1.5957691216f * (g + 0.044715f * g * g * g)));
                yo[(size_t)tok * KCAT] = (bf16_t)(cvt_pk_bf16(hf * ge, 0.f) & 0xffffu); }
#pragma unroll
            for (int reg = 0; reg < 16; ++reg) gcur[reg] = gnxt[reg];
        }
    }
    __syncthreads();
}
__device__ __forceinline__ void pool_unit(const Args& a, int l, int u, LAS unsigned char* lds, const int wv) {
    int tid_ = tid_of(wv); asm volatile("" : "+v"(tid_)); const int tid = tid_, lane = tid & 63, wave = __builtin_amdgcn_readfirstlane(tid >> 6);
    unsigned char* ws = opaque_ptr(a.ws);
    const bf16_t* z = (const bf16_t*)(ws + WS_Z);
    LAS unsigned char* zt = lds; LAS unsigned char* pt = lds + 143 * ZT_STRIDE;
    const int gp = u & 1, b = (u >> 1) & 7, s = u >> 4;
    const int t0 = b * SEQ + s * 128, p0 = s * 128;
    {   u32x4 sv[9];
#pragma unroll
        for (int k = 0; k < 9; ++k) { int idx = tid + NTHREADS * k; idx = idx < 143 * 32 ? idx : 143 * 32 - 1; const int r = idx >> 5, o = idx & 31; const int p = p0 - 15 + r; const int pc = p < 0 ? 0 : p;
            sv[k] = *(const u32x4*)(z + (size_t)(b * SEQ + pc) * NZ + ZO_XPOOL + gp * 256 + o * 8); if (p < 0) sv[k] = (u32x4){0u, 0u, 0u, 0u}; }
#pragma unroll
        for (int k = 0; k < 9; ++k) { int idx = tid + NTHREADS * k; idx = idx < 143 * 32 ? idx : 143 * 32 - 1; const int r = idx >> 5, o = idx & 31;
            *(LAS u32x4*)(zt + r * ZT_STRIDE + o * 16) = sv[k]; }
    }
    __syncthreads();
    {
        const int o = tid & 31, rb = tid >> 5; const int g = 2 * gp + (o >> 4); const int w = 2 << g;
#pragma unroll 1
        for (int i = 0; i < 8; ++i) { const int r = rb + 16 * i; float acc[8];
#pragma unroll
            for (int j = 0; j < 8; ++j) acc[j] = 0.f;
            for (int jj = 0; jj < w; ++jj) { const u32x4 v = *(const LAS u32x4*)(zt + (r + 15 - jj) * ZT_STRIDE + o * 16);
                acc[0] += bflo(v.x); acc[1] += bfhi(v.x); acc[2] += bflo(v.y); acc[3] += bfhi(v.y); acc[4] += bflo(v.z); acc[5] += bfhi(v.z); acc[6] += bflo(v.w); acc[7] += bfhi(v.w); }
            const int cnt = (p0 + r + 1 < w) ? (p0 + r + 1) : w; const float ic = 1.0f / (float)cnt;
            const u32x4 v = *(const LAS u32x4*)(zt + (r + 15) * ZT_STRIDE + o * 16);
            const float x0[8] = {bflo(v.x), bfhi(v.x), bflo(v.y), bfhi(v.y), bflo(v.z), bfhi(v.z), bflo(v.w), bfhi(v.w)};
#pragma unroll
            for (int j = 0; j < 8; ++j) acc[j] = acc[j] * ic - x0[j];
            u32x4 wv; wv.x = cvt_pk_bf16(acc[0], acc[1]); wv.y = cvt_pk_bf16(acc[2], acc[3]); wv.z = cvt_pk_bf16(acc[4], acc[5]); wv.w = cvt_pk_bf16(acc[6], acc[7]);
            *(LAS u32x4*)(pt + r * ZT_STRIDE + o * 16) = wv; }
    }
    __syncthreads();
    {
        const int gsel = wave >> 2, wc = wave & 3, g = 2 * gp + gsel, c31 = lane & 31, hh = lane >> 5;
        const int oc = g * 128 + 32 * wc + c31;
        const bf16_t* wb = (const bf16_t*)(ws + WS_WPOOL) + ((size_t)(l * 4 + g) * 128 + 32 * wc + c31) * 128 + 8 * hh;
        bf16x8 Bf[8];
#pragma unroll
        for (int ks = 0; ks < 8; ++ks) Bf[ks] = *(const bf16x8*)(wb + 16 * ks);
        const float psc = a.in[I_PSCALE][(size_t)l * 512 + oc];
        bf16_t* yo = (bf16_t*)(ws + WS_ACAT) + (size_t)t0 * KCAT + oc;
#pragma unroll 1
        for (int rb = 0; rb < 4; ++rb) {
            f32x16 acc;
#pragma unroll
            for (int r = 0; r < 16; ++r) acc[r] = 0.f;
            const LAS unsigned char* ap = pt + (32 * rb + c31) * ZT_STRIDE + (gsel * 128 + 8 * hh) * 2;
#pragma unroll
            for (int ks = 0; ks < 8; ++ks) { const bf16x8 A = *(const LAS bf16x8*)(ap + 32 * ks); acc = __builtin_amdgcn_mfma_f32_32x32x16_bf16(A, Bf[ks], acc, 0, 0, 0); }
#pragma unroll
            for (int reg = 0; reg < 16; ++reg) { const int tok = 32 * rb + 8 * (reg >> 2) + 4 * hh + (reg & 3);
                yo[(size_t)tok * KCAT] = (bf16_t)(cvt_pk_bf16(acc[reg] * psc, 0.f) & 0xffffu); }
        }
    }
    __syncthreads();
}

constexpr int PH_PER_LAYER = 9;
constexpr int N_PHASES = 1 + DEPTH * PH_PER_LAYER + 1;

__global__ void __launch_bounds__(NTHREADS, 2) fwd_kernel(Args a) {
    extern __shared__ __attribute__((aligned(16))) unsigned char lds_raw[];
    LAS unsigned char* lds = (LAS unsigned char*)lds_raw;
    const int wv = __builtin_amdgcn_readfirstlane(threadIdx.x >> 6); const int tid = threadIdx.x; const int G = gridDim.x;
    unsigned char* ws0 = a.ws;
    unsigned* ctl = (unsigned*)(ws0 + WS_CTL);
    volatile LAS unsigned* misc = (volatile LAS unsigned*)(lds + LDS_MISC);
    if (tid < 4) misc[tid] = 0u;
    __syncthreads();
    XcdBarrier bar; bar.bar = ctl + CW_BAR; bar.x = 0; bar.st = misc; bar.wv = wv;
#if MK_PER_PHASE
    const int lo = a.ph_lo, hi = a.ph_hi;
#else
    constexpr int lo = 0, hi = N_PHASES;
#endif
    if (hi - lo > 1) bar = xcd_barrier_post(ctl + CW_BAR, misc, wv);
#define IN(k) (lo <= (k) && (k) < hi)
#define SEAM(k) do { if (IN((k) + 1)) xcd_barrier(bar); } while (0)

    if (EN(0) && IN(0)) for (int rr = 0; rr < REPN(0); ++rr) { phase_prologue(a, lds, wv); SEAM(0); }

    for (int l = 0; l < DEPTH; ++l) {
        const int pb = 1 + l * PH_PER_LAYER;
        if (EN(1) && IN(pb + 0)) for (int rr = 0; rr < REPN(1); ++rr) { unsigned char* ws = opaque_ptr(ws0); const int bid = opaque_bid(); (void)bid; (void)ws; phase_a(a, l, lds, rr + 1 < REPN(1), wv); SEAM(pb + 0); }
        if (EN(2) && IN(pb + 1)) for (int rr = 0; rr < REPN(2); ++rr) { unsigned char* ws = opaque_ptr(ws0); const int bid = opaque_bid(); (void)bid; (void)ws;
            #if Z_FP8
            pg8::PlainSched S{(const char*)(ws + WS_H), (const char*)(ws + WS_WIN) + (size_t)l * NZ * 1024, 512, T / 256, NZ / 256, G, bid};
            pg8::EpiBf16 E{(bf16_t*)(ws + WS_Z), NZ, nullptr, (rr + 1 < REPN(2)) && (a.ph_lo == 0), 1.0f / WEIN_SCALE};
            pg8::gemm_phase<pg8::EpiBf16, pg8::PlainSched, true, true>(lds, 512, S, E, wv);
#else
            pg8::PlainSched S{(const char*)(ws + WS_H), (const char*)(ws + WS_WIN) + (size_t)l * NZ * 1024 * 2, 1024, T / 256, NZ / 256, G, bid};
            pg8::EpiBf16 E{(bf16_t*)(ws + WS_Z), NZ, nullptr, (rr + 1 < REPN(2)) && (a.ph_lo == 0), 1.0f};
            pg8::gemm_phase<pg8::EpiBf16, pg8::PlainSched, true>(lds, 1024, S, E, wv);
#endif
            SEAM(pb + 1);
        }
        if (EN(3) && IN(pb + 2)) for (int rr = 0; rr < REPN(3); ++rr) { unsigned char* ws = opaque_ptr(ws0); const int bid = opaque_bid(); (void)bid; (void)ws;
            for (int u = bid; u < 1024 + 512; u += G) { if (u < 1024) lru_unit(a, l, u, lds, wv); else pool_unit(a, l, u - 1024, lds, wv); }
            SEAM(pb + 2);
        }
        if (EN(5) && IN(pb + 4)) for (int rr = 0; rr < REPN(5); ++rr) { unsigned char* ws = opaque_ptr(ws0); const int bid = opaque_bid(); (void)bid; (void)ws;
            pg8::PlainSched S{(const char*)(ws + WS_ACAT), (const char*)(ws + WS_WCAT) + (size_t)l * 1024 * KCAT * 2, KCAT, T / 256, D / 256, G, bid};
            pg8::EpiMerged E{(bf16_t*)(ws + WS_MERGED), (const bf16_t*)(ws + WS_Z)};
            pg8::gemm_phase<pg8::EpiMerged, pg8::PlainSched, true>(lds, KCAT, S, E, wv);
            SEAM(pb + 4);
        }
        if (EN(6) && IN(pb + 5)) for (int rr = 0; rr < REPN(6); ++rr) { unsigned char* ws = opaque_ptr(ws0); const int bid = opaque_bid(); (void)bid; (void)ws;
            pg8::PlainSched S{(const char*)(ws + WS_MERGED), (const char*)(ws + WS_WOUT) + (size_t)l * 1024 * 1024 * 2, 1024, T / 256, D / 256, G, bid};
            pg8::EpiResid E{(float*)(ws + WS_XRES), (rr + 1 < REPN(6)) ? (float*)(ws + WS_OUTB) : (float*)(ws + WS_XRES), (const float*)(ws + WS_MOD) + (size_t)l * NBATCH * 6144 + 2 * D};
            pg8::gemm_phase<pg8::EpiResid, pg8::PlainSched, true>(lds, 1024, S, E, wv);
            SEAM(pb + 5);
        }
        if (EN(7) && IN(pb + 6)) for (int rr = 0; rr < REPN(7); ++rr) { unsigned char* ws = opaque_ptr(ws0); const int bid = opaque_bid(); (void)bid; (void)ws; phase_h(a, l, l + DEPTH * rr, lds, wv); SEAM(pb + 6); }
        if (EN(8) && IN(pb + 7)) for (int rr = 0; rr < REPN(8); ++rr) { unsigned char* ws = opaque_ptr(ws0); const int bid = opaque_bid(); (void)bid; (void)ws;
            moe_tables(a, l + DEPTH * (REPN(7) - 1), lds, wv);
            const MoeTab mt = moe_tab_ptrs(lds);
            MoeSched1 S{(const char*)(ws + WS_H), (const char*)(ws + WS_WEIN) + (size_t)l * NE * 2048 * 1024, (const int*)(ws + WS_TOKOF), mt, __builtin_amdgcn_readfirstlane(mt.tilestart[NE]), G, bid};
            pg8::EpiSwiglu E{(unsigned char*)(ws + WS_ACT), a.in[I_BEIN] + (size_t)l * NE * 2048, 1.0f / WEIN_SCALE};
            pg8::gemm_phase<pg8::EpiSwiglu, MoeSched1, true, true>(lds, 512, S, E, wv);
            SEAM(pb + 7);
        }
        if (EN(9) && IN(pb + 8)) for (int rr = 0; rr < REPN(9); ++rr) { unsigned char* ws = opaque_ptr(ws0); const int bid = opaque_bid(); (void)bid; (void)ws;
            moe_tables(a, l + DEPTH * (REPN(7) - 1), lds, wv);
            const MoeTab mt = moe_tab_ptrs(lds);
            MoeSched2 S{(const char*)(ws + WS_ACT), (const char*)(ws + WS_WEOUT) + (size_t)l * NE * 1024 * 1024, mt, __builtin_amdgcn_readfirstlane(mt.tilestart[NE]), G, bid};
            pg8::EpiMoeOut E{(bf16_t*)(ws + WS_OUTB), a.in[I_BEOUT] + (size_t)l * NE * D, 1.0f / WEIN_SCALE};
            pg8::gemm_phase<pg8::EpiMoeOut, MoeSched2, true, true>(lds, 512, S, E, wv);
            SEAM(pb + 8);
        }
    }
    if (EN(10) && IN(N_PHASES - 1)) phase_a(a, DEPTH, lds, false, wv);
#undef IN
#undef SEAM
}

extern "C" void kernel_launch(void* const* d_in, const int* in_sizes, int n_in, void* d_out, int out_size, void* d_ws, size_t ws_size, hipStream_t stream) {
    static int grid = 0;
    if (grid == 0) {
        if (n_in != 26 || out_size != T * D || ws_size < WS_END) { fprintf(stderr, "kernel_launch: unexpected problem (n_in %d out %d ws %zu)\n", n_in, out_size, ws_size); grid = -1; return; }
        int dev = 0, cus = 0, per_cu = 0;
        if (hipGetDevice(&dev) != hipSuccess || hipDeviceGetAttribute(&cus, hipDeviceAttributeMultiprocessorCount, dev) != hipSuccess) { grid = -1; return; }
        if (hipFuncSetAttribute((const void*)fwd_kernel, hipFuncAttributeMaxDynamicSharedMemorySize, LDS_BYTES) != hipSuccess) { fprintf(stderr, "kernel_launch: hipFuncSetAttribute failed\n"); grid = -1; return; }
        if (hipOccupancyMaxActiveBlocksPerMultiprocessor(&per_cu, (const void*)fwd_kernel, NTHREADS, LDS_BYTES) != hipSuccess || per_cu < 1) fprintf(stderr, "kernel_launch: occupancy query says %d\n", per_cu);
        (void)hipGetLastError();
        grid = cus;
    }
    if (grid < 0) return;
    if (hipMemsetAsync((char*)d_ws + WS_CTL, 0, CTL_ZERO_BYTES, stream) != hipSuccess) return;
    if (hipMemsetAsync((char*)d_ws + WS_AGG, 0, AGG_BYTES, stream) != hipSuccess) return;
    Args a{};
    for (int i = 0; i < 26; ++i) a.in[i] = (const float*)d_in[i];
    a.out = (float*)d_out; a.ws = (unsigned char*)d_ws;
#if MK_PER_PHASE
    for (int p = 0; p < N_PHASES; ++p) { a.ph_lo = p; a.ph_hi = p + 1; hipLaunchKernelGGL(fwd_kernel, dim3(grid), dim3(NTHREADS), LDS_BYTES, stream, a); }
#else
    a.ph_lo = 0; a.ph_hi = N_PHASES;
    hipLaunchKernelGGL(fwd_kernel, dim3(grid), dim3(NTHREADS), LDS_BYTES, stream, a);
#endif
    const hipError_t le = hipPeekAtLastError();
    if (le != hipSuccess) fprintf(stderr, "kernel_launch: launch failed: %s\n", hipGetErrorName(le));
}
```

```cpp
#include <hip/hip_runtime.h>
#include <cstdio>
#include <cstdint>

#define REP_MASK 0x0
#ifndef PH_MASK
#define PH_MASK 0x7ff
#endif
#define EN(b) ((PH_MASK >> (b)) & 1)
#ifndef REP_MASK
#define REP_MASK 0
#endif
#define REPN(b) ((((REP_MASK) >> (b)) & 1) ? 2 : 1)
#ifndef Z_FP8
#define Z_FP8 0
#endif
#ifndef MK_PER_PHASE
#define MK_PER_PHASE 0
#endif

#define LAS __attribute__((address_space(3)))
typedef unsigned short bf16_t;
typedef short bf16x8 __attribute__((ext_vector_type(8)));
typedef float f32x4 __attribute__((ext_vector_type(4)));
typedef float f32x2 __attribute__((ext_vector_type(2)));
typedef float f32x16 __attribute__((ext_vector_type(16)));
typedef unsigned u32x4 __attribute__((ext_vector_type(4)));
typedef unsigned u32x2 __attribute__((ext_vector_type(2)));

constexpr int D = 1024, NBATCH = 8, SEQ = 4096, T = NBATCH * SEQ, DEPTH = 4;
constexpr int NZ = 4608, ZO_GLRU = 1024, ZO_XPOOL = 2048, ZO_GL0 = 2560, ZO_GL1 = 3584;
constexpr int NE = 32, TOPK = 4;
constexpr int KCAT = 1536;
constexpr int SLOT_CAP = T * TOPK + NE * 256;
constexpr int MAX_MT = SLOT_CAP / 256;
constexpr float NORM_EPS = 1e-6f;
constexpr float WEIN_SCALE = 64.0f;
constexpr int NTHREADS = 512, NWAVES = 8;

constexpr size_t MiB = 1u << 20;
constexpr size_t WS_CTL = 0, CTL_ZERO_BYTES = 256 * 1024;
constexpr size_t WS_MOD = 1 * MiB;
constexpr size_t WS_CB = 2 * MiB;
constexpr size_t WS_AGG = 72 * MiB;
constexpr size_t AGG_BYTES = (size_t)DEPTH * NBATCH * 32 * D * 8;
constexpr size_t WS_WRS = 3 * MiB;
constexpr size_t WS_TOKOF = 6 * MiB;
constexpr size_t WS_SLOTINFO = 10 * MiB;
constexpr size_t WS_WGT = 11 * MiB;
constexpr size_t WS_WRG = 12 * MiB;
constexpr size_t WS_WPOOL = 14 * MiB;
constexpr size_t WS_WIN = 16 * MiB;
constexpr size_t WS_WCAT = 52 * MiB;
constexpr size_t WS_WOUT = 64 * MiB;
constexpr size_t WS_WEIN = 128 * MiB;
constexpr size_t WS_WEOUT = 640 * MiB;
constexpr size_t WS_XRES = 896 * MiB;
constexpr size_t WS_H = 1024 * MiB;
constexpr size_t WS_Z = 1088 * MiB;
constexpr size_t WS_ACAT = 1376 * MiB;
constexpr size_t WS_MERGED = 1472 * MiB;
constexpr size_t WS_ACT = 1536 * MiB;
constexpr size_t WS_OUTB = 1808 * MiB;
constexpr size_t WS_END = 2080 * MiB;
static_assert(WS_ACT + (size_t)SLOT_CAP * 1024 * 2 <= WS_OUTB && WS_OUTB + (size_t)SLOT_CAP * 1024 * 2 <= WS_END, "ws map");
constexpr int CW_BAR = 4096;
constexpr int CW_CNT = 8192;

constexpr int LDS_BYTES = 163840;
constexpr int LDS_TAB = 131072;
constexpr int LDS_NVA = 131072 + 8192;
constexpr int LDS_MISC = LDS_BYTES - 256;

__device__ __forceinline__ unsigned cvt_pk_bf16(float lo, float hi) { unsigned r; asm("v_cvt_pk_bf16_f32 %0, %1, %2" : "=v"(r) : "v"(lo), "v"(hi)); return r; }
__device__ __forceinline__ float bflo(unsigned w) { return __uint_as_float(w << 16); }
__device__ __forceinline__ float bfhi(unsigned w) { return __uint_as_float(w & 0xffff0000u); }
__device__ __forceinline__ float bf1(bf16_t w) { return __uint_as_float(((unsigned)w) << 16); }
__device__ __forceinline__ float sigmoidf_(float x) { return __builtin_amdgcn_rcpf(1.0f + __expf(-x)); }
__device__ __forceinline__ float shflx(float v, int mask, int lane) { return __int_as_float(__builtin_amdgcn_ds_bpermute((lane ^ mask) << 2, __float_as_int(v))); }
__device__ __forceinline__ float wave_sum(float v, int lane) {
#pragma unroll
    for (int o = 1; o < 64; o <<= 1) v += shflx(v, o, lane);
    return v;
}
__device__ __forceinline__ int tid_of(int wv) { int l; asm volatile("v_mbcnt_lo_u32_b32 %0, -1, 0\n\tv_mbcnt_hi_u32_b32 %0, -1, %0" : "=v"(l)); return wv * 64 + l; }
__device__ __forceinline__ int opaque_bid() { int b = blockIdx.x; asm volatile("" : "+s"(b)); return b; }
__device__ __forceinline__ unsigned char* opaque_ptr(unsigned char* p) { size_t z = 0; asm volatile("" : "+s"(z)); return p + z; }
#define LDS_WAIT() asm volatile("s_waitcnt lgkmcnt(0)" ::: "memory")
#define VM_WAIT() asm volatile("s_waitcnt vmcnt(0)" ::: "memory")

namespace pg8 {
constexpr int BM = 256, BK = 64, HALF = 128, HTB = HALF * BK * 2, STAGE_BYTES = 8 * HTB, NXCD = 8, WGM = 8;
__host__ __device__ __forceinline__ int lds_byte(int r, int c) { const int st = (r >> 4) * 2 + (c >> 5), rr = r & 15, cc = c & 31, ob = rr * 64 + cc * 2; return st * 1024 + (ob ^ (((ob >> 9) & 1) << 5)); }
__host__ __device__ __forceinline__ void stage_rc(int b, int& R, int& C) { const int st = b / 1024, sb = b % 1024, swz = sb ^ (((sb >> 9) & 1) << 5); R = (st >> 1) * 16 + swz / 64; C = (st & 1) * 32 + (swz % 64) / 2; }
__host__ __device__ __forceinline__ int perm32(int rho) { const int n = rho >> 4, i = rho & 15; return 8 * (i >> 2) + 4 * n + (i & 3); }

struct Unit { int pm, pn, e, j, row0, rows; };
typedef int v8i32 __attribute__((ext_vector_type(8)));
__device__ __forceinline__ v8i32 cat8(bf16x8 lo, bf16x8 hi) { typedef int v4i32 __attribute__((ext_vector_type(4))); const v4i32 a = __builtin_bit_cast(v4i32, lo), b = __builtin_bit_cast(v4i32, hi); return (v8i32){a.x, a.y, a.z, a.w, b.x, b.y, b.z, b.w}; }

__device__ __forceinline__ bool order_map(int i, int G, int c, int nM, int nN, int& pm, int& pn) {
    const int nwg = nM * nN; const int L = i * G + c; if (L >= nwg) return false;
    int wgid = L; { const int q = nwg / NXCD, r = nwg % NXCD, xcd = wgid % NXCD, off = wgid / NXCD; wgid = (xcd < r ? xcd * (q + 1) : r * (q + 1) + (xcd - r) * q) + off; }
    const int nig = WGM * nN, gid = wgid / nig, fm = gid * WGM, gsz = (nM - fm) < WGM ? (nM - fm) : WGM;
    pm = fm + ((wgid % nig) % gsz); pn = (wgid % nig) / gsz; return true;
}

struct PlainSched {
    static constexpr bool DYN_A = false;
    const char* A; const char* Bt; int K, nM, nN, G, c;
    __device__ __forceinline__ bool next(int i, Unit& u) const { int pm, pn; if (!order_map(i, G, c, nM, nN, pm, pn)) return false; u.pm = pm; u.pn = pn; u.e = 0; u.j = 0; u.row0 = pm * BM; u.rows = BM; return true; }
    __device__ __forceinline__ const char* a_ptr() const { return A; }
    __device__ __forceinline__ const char* b_ptr() const { return Bt; }
    __device__ __forceinline__ unsigned a_off(const Unit& u) const { return (unsigned)u.row0 * (unsigned)K * 2u; }
    __device__ __forceinline__ unsigned b_off(const Unit& u) const { return (unsigned)u.pn * (unsigned)(BM * K * 2); }
    __device__ __forceinline__ void a_voff(const Unit&, unsigned (&v)[2][2], int wv) const {
        int tid = tid_of(wv); asm volatile("" : "+v"(tid));
#pragma unroll
        for (int i = 0; i < 2; ++i) { int R, C; stage_rc(tid * 16 + i * 8192, R, C);
#pragma unroll
            for (int h = 0; h < 2; ++h) v[h][i] = (unsigned)((h * HALF + R) * K + C) * 2u; }
    }
};

template <class Epi, class Sched, bool ALIGN_EPI, bool FP8 = false>
__device__ __forceinline__ void gemm_phase(LAS unsigned char* lds, const int K, const Sched& S, const Epi& E, const int wv) {
    int tid = tid_of(wv); asm volatile("" : "+v"(tid));
    const int wid = __builtin_amdgcn_readfirstlane(tid >> 6), lane = tid & 63, wr = wid >> 2, wc = wid & 3, fr = lane & 15, fq = lane >> 4;
    const int nt = K / BK;
    unsigned voffB;
    { int R, C; stage_rc(tid * 16, R, C); const int Rb = Epi::PERM ? ((R & ~31) + perm32(R & 31)) : R; voffB = (unsigned)(Rb * K + C) * 2u; }
    const unsigned q64 = (unsigned)(64 * K * 2);
    const unsigned kstep = (unsigned)(BK * 2);
    const unsigned hstep = (unsigned)(HALF * K * 2);
    const __amdgpu_buffer_rsrc_t rsA = __builtin_amdgcn_make_buffer_rsrc((void*)S.a_ptr(), 0, 0xffffffff, 0x00020000);
    const __amdgpu_buffer_rsrc_t rsB = __builtin_amdgcn_make_buffer_rsrc((void*)S.b_ptr(), 0, 0xffffffff, 0x00020000);
    const unsigned ldsw = (unsigned)wid * 1024u;
    const int aoff = lds_byte(wr * 64 + fr, fq * 8), boff = lds_byte(wc * 32 + fr, fq * 8);
#define PG8_SA(b, h) (((b) * 2 + (h)) * HTB)
#define PG8_SB(b, h) ((4 + (b) * 2 + (h)) * HTB)
#define PG8_STAGE_(rs, bufoff, v0, s0, v1, s1) do { \
        __builtin_amdgcn_raw_ptr_buffer_load_lds(rs, (LAS void*)(lds + (bufoff) + ldsw), 16, (v0), (s0), 0, 0); \
        __builtin_amdgcn_raw_ptr_buffer_load_lds(rs, (LAS void*)(lds + (bufoff) + ldsw + 8192), 16, (v1), (s1), 0, 0); } while (0)
#define PG8_STAGE_B(bufoff, soff, unused) PG8_STAGE_(rsB, bufoff, voffB, (soff), voffB, (soff) + q64)
#define PG8_STAGE_A(bufoff, soff, h) do { if constexpr (Sched::DYN_A) PG8_STAGE_(rsA, bufoff, cvA[h][0], (soff), cvA[h][1], (soff)); \
        else PG8_STAGE_(rsA, bufoff, cvA[0][0], (soff) + (h) * 2u * q64, cvA[0][0], (soff) + (h) * 2u * q64 + q64); } while (0)
#define PG8_LDA(dst, b, h) do { _Pragma("unroll") for (int m = 0; m < 4; ++m) _Pragma("unroll") for (int k = 0; k < 2; ++k) dst[m][k] = *(const LAS bf16x8*)(lds + PG8_SA(b, h) + aoff + m * 2048 + k * 1024); } while (0)
#define PG8_LDB(dst, b, h) do { _Pragma("unroll") for (int n = 0; n < 2; ++n) _Pragma("unroll") for (int k = 0; k < 2; ++k) dst[n][k] = *(const LAS bf16x8*)(lds + PG8_SB(b, h) + boff + n * 2048 + k * 1024); } while (0)
#define PG8_MMA(ai, bj, At, Bt) do { __builtin_amdgcn_s_setprio(1); _Pragma("unroll") for (int m = 0; m < 4; ++m) _Pragma("unroll") for (int n = 0; n < 2; ++n) { \
        if constexpr (FP8) { acc[ai][bj][m][n] = __builtin_amdgcn_mfma_scale_f32_16x16x128_f8f6f4(cat8(Bt[n][0], Bt[n][1]), cat8(At[m][0], At[m][1]), acc[ai][bj][m][n], 0, 0, 0, 0x7f7f7f7f, 0, 0x7f7f7f7f); } \
        else { _Pragma("unroll") for (int k = 0; k < 2; ++k) acc[ai][bj][m][n] = __builtin_amdgcn_mfma_f32_16x16x32_bf16(Bt[n][k], At[m][k], acc[ai][bj][m][n], 0, 0, 0); } } \
        __builtin_amdgcn_s_setprio(0); } while (0)
#define PG8_WAIT_V(n) asm volatile("s_waitcnt vmcnt(" #n ")" ::: "memory")
#define PG8_WAIT_L(n) asm volatile("s_waitcnt lgkmcnt(" #n ")" ::: "memory")
#define PG8_BAR __builtin_amdgcn_s_barrier()
#define PG8_SCHED __builtin_amdgcn_sched_barrier(0)
    Unit cur, nxt; int ui = 0;
    if (!S.next(0, cur)) return;
    f32x4 acc[2][2][4][2];
    { float z0 = 0.f; asm volatile("" : "+v"(z0));
#pragma unroll
    for (int a = 0; a < 2; ++a)
#pragma unroll
        for (int b = 0; b < 2; ++b)
#pragma unroll
            for (int m = 0; m < 4; ++m)
#pragma unroll
                for (int n = 0; n < 2; ++n) acc[a][b][m][n] = (f32x4){z0, z0, z0, z0}; }
    bf16x8 At[4][2], B0[2][2], B1[2][2];
    unsigned cvA[2][2];
    LAS u32x4* nvp = (LAS u32x4*)(lds + LDS_NVA) + tid;
    S.a_voff(cur, cvA, wv);
    unsigned cA = S.a_off(cur), cB = S.b_off(cur);
    PG8_STAGE_B(PG8_SB(0, 0), cB, voffB); PG8_STAGE_B(PG8_SB(0, 1), cB + hstep, voffB); PG8_STAGE_A(PG8_SA(0, 0), cA, 0); PG8_STAGE_A(PG8_SA(0, 1), cA, 1);
    if (wr == 1) PG8_BAR;
    PG8_WAIT_V(2); PG8_BAR;
    PG8_STAGE_B(PG8_SB(1, 0), cB + kstep, voffB); PG8_STAGE_A(PG8_SA(1, 0), cA + kstep, 0); PG8_STAGE_B(PG8_SB(1, 1), cB + hstep + kstep, voffB);
    PG8_WAIT_V(6); PG8_BAR;
    for (;;) {
        const bool has_next = S.next(ui + 1, nxt);
        unsigned nA = cA, nB = cB;
        if (has_next) { nA = S.a_off(nxt); nB = S.b_off(nxt); }
        if constexpr (Sched::DYN_A) { unsigned nv[2][2];
            if (has_next) S.a_voff(nxt, nv, wv); else {
#pragma unroll
                for (int h = 0; h < 2; ++h)
#pragma unroll
                    for (int i = 0; i < 2; ++i) nv[h][i] = cvA[h][i]; }
            *nvp = (u32x4){nv[0][0], nv[0][1], nv[1][0], nv[1][1]}; }
#pragma unroll 1
        for (int t = 0; t < nt; t += 2) {
            const bool last = (t == nt - 2);
            const unsigned a1 = cA + (unsigned)(t + 1) * kstep;
            const unsigned a2 = last ? nA : cA + (unsigned)(t + 2) * kstep, b2 = last ? nB : cB + (unsigned)(t + 2) * kstep;
            const unsigned a3 = a2 + kstep, b3 = b2 + kstep;
            unsigned nx1[2] = {cvA[1][0], cvA[1][1]};
            if constexpr (Sched::DYN_A) { if (last) { const u32x4 q = *nvp; cvA[0][0] = q.x; cvA[0][1] = q.y; nx1[0] = q.z; nx1[1] = q.w; } }
            if constexpr (Epi::HOOK_T >= 0) { if (t == Epi::HOOK_T) E.mid(acc, cur, wr, wc, fr, fq); }
            PG8_LDB(B0, 0, 0); PG8_LDB(B1, 0, 1); PG8_SCHED; PG8_LDA(At, 0, 0); PG8_STAGE_A(PG8_SA(1, 1), a1, 1);
            if constexpr (Sched::DYN_A) { cvA[1][0] = nx1[0]; cvA[1][1] = nx1[1]; }
            PG8_WAIT_V(8); PG8_WAIT_L(0); PG8_BAR; PG8_MMA(0, 0, At, B0); PG8_MMA(0, 1, At, B1); PG8_BAR; PG8_SCHED;
            PG8_LDA(At, 0, 1); PG8_STAGE_B(PG8_SB(0, 0), b2, voffB); PG8_STAGE_B(PG8_SB(0, 1), b2 + hstep, voffB); PG8_STAGE_A(PG8_SA(0, 0), a2, 0);
            PG8_WAIT_V(8); PG8_WAIT_L(0); PG8_BAR; PG8_MMA(1, 0, At, B0); PG8_MMA(1, 1, At, B1); PG8_BAR; PG8_SCHED;
            PG8_LDB(B0, 1, 0); PG8_LDB(B1, 1, 1); PG8_SCHED; PG8_LDA(At, 1, 0); PG8_STAGE_A(PG8_SA(0, 1), a2, 1);
            PG8_WAIT_V(8); PG8_WAIT_L(0); PG8_BAR; PG8_MMA(0, 0, At, B0); PG8_MMA(0, 1, At, B1); PG8_BAR; PG8_SCHED;
            PG8_LDA(At, 1, 1); PG8_STAGE_B(PG8_SB(1, 0), b3, voffB); PG8_STAGE_B(PG8_SB(1, 1), b3 + hstep, voffB); PG8_STAGE_A(PG8_SA(1, 0), a3, 0);
            PG8_WAIT_V(8); PG8_WAIT_L(0); PG8_BAR; PG8_MMA(1, 0, At, B0); PG8_MMA(1, 1, At, B1); PG8_BAR; PG8_SCHED;
        }
        if constexpr (ALIGN_EPI) { if (wr == 0) PG8_BAR; }
        E(acc, cur, wr, wc, fr, fq);
        if (!has_next) break;
        { float z0 = 0.f; asm volatile("" : "+v"(z0));
#pragma unroll
        for (int a = 0; a < 2; ++a)
#pragma unroll
            for (int b = 0; b < 2; ++b)
#pragma unroll
                for (int m = 0; m < 4; ++m)
#pragma unroll
                    for (int n = 0; n < 2; ++n) acc[a][b][m][n] = (f32x4){z0, z0, z0, z0}; }
        cur = nxt; cA = nA; cB = nB; ++ui;
        if constexpr (ALIGN_EPI) { if (wr == 1) PG8_BAR; }
    }
    PG8_WAIT_V(0);
    if constexpr (!ALIGN_EPI) { if (wr == 0) PG8_BAR; }
    PG8_BAR;
#undef PG8_SA
#undef PG8_SB
#undef PG8_STAGE_
#undef PG8_STAGE_A
#undef PG8_STAGE_B
#undef PG8_LDA
#undef PG8_LDB
#undef PG8_MMA
#undef PG8_WAIT_V
#undef PG8_WAIT_L
#undef PG8_BAR
#undef PG8_SCHED
}

struct EpiBf16 {
    static constexpr bool PERM = true; static constexpr int HOOK_T = -1;
    bf16_t* O; int ldc; const float* bias; int noepi; float scale;
    __device__ __forceinline__ void mid(f32x4 (&)[2][2][4][2], const Unit&, int, int, int, int) const {}
    __device__ __forceinline__ void operator()(const f32x4 (&acc)[2][2][4][2], const Unit& u, int wr, int wc, int fr, int fq) const {
        { const int l_ = tid_of(0); fr = l_ & 15; fq = l_ >> 4; }
        if (noepi) { if (acc[0][0][0][0][0] == 1.2345e-30f) O[0] = 0; return; }
        int row0 = u.row0 + wr * 64 + fr; asm volatile("" : "+v"(row0)); int col0 = u.pn * BM + wc * 32 + 8 * fq; asm volatile("" : "+v"(col0));
        f32x4 bv[2][2];
#pragma unroll
        for (int bj = 0; bj < 2; ++bj)
#pragma unroll
            for (int n = 0; n < 2; ++n) bv[bj][n] = bias ? *(const f32x4*)(bias + col0 + bj * HALF + 4 * n) : (f32x4){0.f, 0.f, 0.f, 0.f};
#pragma unroll
        for (int ai = 0; ai < 2; ++ai)
#pragma unroll
            for (int m = 0; m < 4; ++m) { bf16_t* rowp = O + (size_t)(row0 + ai * HALF + m * 16) * ldc + col0;
#pragma unroll
                for (int bj = 0; bj < 2; ++bj) { const f32x4 v0 = acc[ai][bj][m][0] * scale + bv[bj][0], v1 = acc[ai][bj][m][1] * scale + bv[bj][1];
                    u32x4 w; w.x = cvt_pk_bf16(v0[0], v0[1]); w.y = cvt_pk_bf16(v0[2], v0[3]); w.z = cvt_pk_bf16(v1[0], v1[1]); w.w = cvt_pk_bf16(v1[2], v1[3]);
                    *(u32x4*)(rowp + bj * HALF) = w; } }
    }
};
struct EpiMerged {
    static constexpr bool PERM = true; static constexpr int HOOK_T = 8;
    bf16_t* O; const bf16_t* Z;
    __device__ __forceinline__ void mid(f32x4 (&acc)[2][2][4][2], const Unit& u, int wr, int wc, int fr, int fq) const {
        { const int l_ = tid_of(0); fr = l_ & 15; fq = l_ >> 4; }
        int row0 = u.row0 + wr * 64 + fr; asm volatile("" : "+v"(row0)); int col0 = u.pn * BM + wc * 32 + 8 * fq; asm volatile("" : "+v"(col0));
#pragma unroll
        for (int ai = 0; ai < 2; ++ai) {
            u32x4 l0[4][2], l1[4][2];
#pragma unroll
            for (int m = 0; m < 4; ++m) { const bf16_t* zr = Z + (size_t)(row0 + ai * HALF + m * 16) * NZ + col0;
#pragma unroll
                for (int bj = 0; bj < 2; ++bj) { l0[m][bj] = *(const u32x4*)(zr + ZO_GL0 + bj * HALF); l1[m][bj] = *(const u32x4*)(zr + ZO_GL1 + bj * HALF); } }
#pragma unroll
            for (int m = 0; m < 4; ++m)
#pragma unroll
                for (int bj = 0; bj < 2; ++bj) {
                    const unsigned a0[4] = {l0[m][bj].x, l0[m][bj].y, l0[m][bj].z, l0[m][bj].w}, a1[4] = {l1[m][bj].x, l1[m][bj].y, l1[m][bj].z, l1[m][bj].w};
#pragma unroll
                    for (int q = 0; q < 4; ++q) {
                        const float r0 = (1.0f + __expf(-bflo(a0[q]))) * __builtin_amdgcn_rcpf(1.0f + __expf(-bflo(a1[q])));
                        const float r1 = (1.0f + __expf(-bfhi(a0[q]))) * __builtin_amdgcn_rcpf(1.0f + __expf(-bfhi(a1[q])));
                        acc[ai][bj][m][q >> 1][(q & 1) * 2 + 0] *= r0; acc[ai][bj][m][q >> 1][(q & 1) * 2 + 1] *= r1; } }
            asm volatile("" ::: "memory"); }
    }
    __device__ __forceinline__ void operator()(const f32x4 (&acc)[2][2][4][2], const Unit& u, int wr, int wc, int fr, int fq) const {
        { const int l_ = tid_of(0); fr = l_ & 15; fq = l_ >> 4; }
        int row0 = u.row0 + wr * 64 + fr; asm volatile("" : "+v"(row0)); int col0 = u.pn * BM + wc * 32 + 8 * fq; asm volatile("" : "+v"(col0));
        u32x4 l0[2][4][2];
#pragma unroll
        for (int ai = 0; ai < 2; ++ai)
#pragma unroll
            for (int m = 0; m < 4; ++m) { const bf16_t* zr = Z + (size_t)(row0 + ai * HALF + m * 16) * NZ + col0;
#pragma unroll
                for (int bj = 0; bj < 2; ++bj) l0[ai][m][bj] = *(const u32x4*)(zr + ZO_GL0 + bj * HALF); }
#pragma unroll
        for (int ai = 0; ai < 2; ++ai)
#pragma unroll
            for (int m = 0; m < 4; ++m) { bf16_t* orow = O + (size_t)(row0 + ai * HALF + m * 16) * D + col0;
#pragma unroll
                for (int bj = 0; bj < 2; ++bj) {
                    const unsigned a0[4] = {l0[ai][m][bj].x, l0[ai][m][bj].y, l0[ai][m][bj].z, l0[ai][m][bj].w};
                    float o[8];
#pragma unroll
                    for (int q = 0; q < 4; ++q) { o[2 * q] = acc[ai][bj][m][q >> 1][(q & 1) * 2 + 0] * sigmoidf_(bflo(a0[q])); o[2 * q + 1] = acc[ai][bj][m][q >> 1][(q & 1) * 2 + 1] * sigmoidf_(bfhi(a0[q])); }
                    u32x4 w; w.x = cvt_pk_bf16(o[0], o[1]); w.y = cvt_pk_bf16(o[2], o[3]); w.z = cvt_pk_bf16(o[4], o[5]); w.w = cvt_pk_bf16(o[6], o[7]);
                    *(u32x4*)(orow + bj * HALF) = w; } }
    }
};
struct EpiResid {
    static constexpr bool PERM = false; static constexpr int HOOK_T = -1;
    float* X; float* XO; const float* gate;
    __device__ __forceinline__ void mid(f32x4 (&)[2][2][4][2], const Unit&, int, int, int, int) const {}
    __device__ __forceinline__ void operator()(const f32x4 (&acc)[2][2][4][2], const Unit& u, int wr, int wc, int fr, int fq) const {
        { const int l_ = tid_of(0); fr = l_ & 15; fq = l_ >> 4; }
        int row0 = u.row0 + wr * 64 + fr; asm volatile("" : "+v"(row0)); int col0 = u.pn * BM + wc * 32 + 4 * fq; asm volatile("" : "+v"(col0));
        const float* gp = gate + (size_t)(u.row0 / SEQ) * (6 * D) + col0;
        f32x4 gv[2][2];
#pragma unroll
        for (int bj = 0; bj < 2; ++bj)
#pragma unroll
            for (int n = 0; n < 2; ++n) gv[bj][n] = *(const f32x4*)(gp + bj * HALF + n * 16);
#pragma unroll
        for (int ai = 0; ai < 2; ++ai) {
            f32x4 xv[4][2][2];
#pragma unroll
            for (int m = 0; m < 4; ++m) { const float* rowp = X + (size_t)(row0 + ai * HALF + m * 16) * D + col0;
#pragma unroll
                for (int bj = 0; bj < 2; ++bj)
#pragma unroll
                    for (int n = 0; n < 2; ++n) xv[m][bj][n] = *(const f32x4*)(rowp + bj * HALF + n * 16); }
#pragma unroll
            for (int m = 0; m < 4; ++m) { float* rowo = XO + (size_t)(row0 + ai * HALF + m * 16) * D + col0;
#pragma unroll
                for (int bj = 0; bj < 2; ++bj)
#pragma unroll
                    for (int n = 0; n < 2; ++n) *(f32x4*)(rowo + bj * HALF + n * 16) = xv[m][bj][n] + gv[bj][n] * acc[ai][bj][m][n]; }
            asm volatile("" ::: "memory"); }
    }
};
struct EpiSwiglu {
    static constexpr bool PERM = true; static constexpr int HOOK_T = -1;
    unsigned char* ACT; const float* bias; float wscale;
    __device__ __forceinline__ void mid(f32x4 (&)[2][2][4][2], const Unit&, int, int, int, int) const {}
    __device__ __forceinline__ void operator()(const f32x4 (&acc)[2][2][4][2], const Unit& u, int wr, int wc, int fr, int fq) const {
        { const int l_ = tid_of(0); fr = l_ & 15; fq = l_ >> 4; }
        int row0 = u.row0 + wr * 64 + fr; asm volatile("" : "+v"(row0)); int cc = u.pn * HALF + wc * 32 + 8 * fq; asm volatile("" : "+v"(cc));
        const float* bp = bias + (size_t)u.e * 2048 + cc;
        f32x4 bg[2], bu[2];
#pragma unroll
        for (int n = 0; n < 2; ++n) { bg[n] = *(const f32x4*)(bp + 4 * n); bu[n] = *(const f32x4*)(bp + 1024 + 4 * n); }
#pragma unroll
        for (int ai = 0; ai < 2; ++ai)
#pragma unroll
            for (int m = 0; m < 4; ++m) { unsigned char* rowp = ACT + (size_t)(row0 + ai * HALF + m * 16) * D + cc;
                float o[8];
#pragma unroll
                for (int n = 0; n < 2; ++n)
#pragma unroll
                    for (int j = 0; j < 4; ++j) { float g = acc[ai][0][m][n][j] * wscale + bg[n][j], up = acc[ai][1][m][n][j] * wscale + bu[n][j];
                        g = fminf(g, 7.0f); up = fminf(fmaxf(up, -7.0f), 7.0f);
                        o[4 * n + j] = g * sigmoidf_(1.702f * g) * (up + 1.0f); }
                int w0 = 0, w1 = 0;
                w0 = __builtin_amdgcn_cvt_pk_fp8_f32(o[0], o[1], w0, false); w0 = __builtin_amdgcn_cvt_pk_fp8_f32(o[2], o[3], w0, true);
                w1 = __builtin_amdgcn_cvt_pk_fp8_f32(o[4], o[5], w1, false); w1 = __builtin_amdgcn_cvt_pk_fp8_f32(o[6], o[7], w1, true);
                *(u32x2*)rowp = (u32x2){(unsigned)w0, (unsigned)w1}; }
    }
};
struct EpiMoeOut {
    static constexpr bool PERM = true; static constexpr int HOOK_T = -1;
    bf16_t* O; const float* bias; float wscale;
    __device__ __forceinline__ void mid(f32x4 (&)[2][2][4][2], const Unit&, int, int, int, int) const {}
    __device__ __forceinline__ void operator()(const f32x4 (&acc)[2][2][4][2], const Unit& u, int wr, int wc, int fr, int fq) const {
        const EpiBf16 e{O, D, bias + (size_t)u.e * D, 0, wscale}; e(acc, u, wr, wc, fr, fq);
    }
};
}

#define XB_TMO      128
#define XB_XCNT(j)  (256  + 64 * (j))
#define XB_XSUB(j)  (1280 + 64 * (j))
#define XB_XGEN(j)  (2304 + 64 * (j))
#define XB_TOP      3328
#define XB_TOPGEN   3392
#define XCD_BAR_WORDS 3456
#define XB_SPIN_CAP (1u << 18)
__device__ __forceinline__ unsigned xb_ld(unsigned* p)              { return __hip_atomic_load(p, __ATOMIC_RELAXED, __HIP_MEMORY_SCOPE_AGENT); }
__device__ __forceinline__ unsigned xb_add(unsigned* p, unsigned v) { return __hip_atomic_fetch_add(p, v, __ATOMIC_RELAXED, __HIP_MEMORY_SCOPE_AGENT); }
__device__ __forceinline__ unsigned xb_xcc_id() { return (unsigned)__builtin_amdgcn_s_getreg((3 << 11) | 20) & 0xFu; }
#define XB_SPIN(cond, bar) do { unsigned _sp = 0; while (cond) { __builtin_amdgcn_s_sleep(1); \
    if ((++_sp & 255u) == 0u) { if (xb_ld(&(bar)[XB_TMO])) break; if (_sp > XB_SPIN_CAP) { atomicAdd(&(bar)[XB_TMO], 1u); break; } } } } while (0)
struct XcdBarrier { unsigned* bar; unsigned x; volatile LAS unsigned* st; int wv; };
__device__ __forceinline__ XcdBarrier xcd_barrier_post(unsigned* bar, volatile LAS unsigned* st, int wv) {
    XcdBarrier b; b.bar = bar; b.x = xb_xcc_id(); b.st = st; b.wv = wv;
    if (tid_of(wv) == 0) (void)xb_add(&bar[XB_XCNT(b.x)], 1u);
    return b;
}
__device__ __forceinline__ void xcd_barrier_complete(unsigned* bar, unsigned x, unsigned& nloc, unsigned& nx) {
    const unsigned G = gridDim.x * gridDim.y * gridDim.z;
    unsigned sum, cnt, mine, sp = 0u;
    for (;;) {
        sum = 0u; cnt = 0u; mine = 0u;
#pragma unroll
        for (unsigned j = 0; j < 16; ++j) { const unsigned c = xb_ld(&bar[XB_XCNT(j)]); sum += c; cnt += (c > 0u) ? 1u : 0u; mine = (j == x) ? c : mine; }
        if (sum == G) break;
        __builtin_amdgcn_s_sleep(1);
        if ((++sp & 255u) == 0u) { if (xb_ld(&bar[XB_TMO])) break; if (sp > XB_SPIN_CAP) { atomicAdd(&bar[XB_TMO], 1u); break; } }
    }
    nloc = mine > 0u ? mine : 1u; nx = cnt > 0u ? cnt : 1u;
}
__device__ __forceinline__ void xcd_barrier(const XcdBarrier& b) {
    asm volatile("s_waitcnt vmcnt(0)" ::: "memory");
    __syncthreads();
    if (tid_of(b.wv) == 0) {
        size_t zb = 0; asm volatile("" : "+s"(zb)); unsigned* bar = b.bar + zb; unsigned bx = b.x; asm volatile("" : "+s"(bx));
        __builtin_amdgcn_s_waitcnt(0);
        unsigned nloc = b.st[0], nx = b.st[1];
        if (nloc == 0u) { xcd_barrier_complete(bar, bx, nloc, nx); b.st[0] = nloc; b.st[1] = nx; }
        const unsigned old = xb_add(&bar[XB_XSUB(bx)], 1u);
        const unsigned gen = old / nloc;
        if (old + 1u == (gen + 1u) * nloc) {
            __builtin_amdgcn_fence(__ATOMIC_RELEASE, "agent");
            asm volatile("s_waitcnt vmcnt(0)" ::: "memory");
            const unsigned og = xb_add(&bar[XB_TOP], 1u);
            const unsigned tg = og / nx;
            if (og + 1u == (tg + 1u) * nx) xb_add(&bar[XB_TOPGEN], 1u);
            else XB_SPIN(xb_ld(&bar[XB_TOPGEN]) == tg, bar);
            __builtin_amdgcn_fence(__ATOMIC_ACQUIRE, "agent");
            xb_add(&bar[XB_XGEN(bx)], 1u);
            asm volatile("s_waitcnt vmcnt(0)" ::: "memory");
        } else {
            XB_SPIN(xb_ld(&bar[XB_XGEN(bx)]) == gen, bar);
            __builtin_amdgcn_fence(__ATOMIC_ACQUIRE, "agent");
            asm volatile("s_waitcnt vmcnt(0)" ::: "memory");
        }
    }
    __syncthreads();
}

struct Args { const float* in[26]; float* out; unsigned char* ws; int ph_lo, ph_hi; };
enum { I_X = 0, I_C, I_N1G, I_N2G, I_WADA, I_BADA, I_WIN, I_CONVW, I_CONVB, I_WRGA, I_BRGA, I_WRGX, I_BRGX, I_LAM, I_WPOOL, I_PSCALE, I_WUPA, I_WUPB, I_WOUT, I_WROUTER, I_BROUTER, I_WEIN, I_BEIN, I_WEOUT, I_BEOUT, I_FINALG };

template <int ROWMODE>
__device__ __forceinline__ void tr_item(const float* W, int N, bf16_t* WT, int dst_ld, int dst_off, int k0, int n0, LAS float* scr, int lane) {
    { float tv[32];
#pragma unroll
    for (int i = 0; i < 32; ++i) tv[i] = W[(size_t)(k0 + 2 * i + (lane >> 5)) * N + n0 + (lane & 31)];
#pragma unroll
    for (int i = 0; i < 32; ++i) scr[(2 * i + (lane >> 5)) * 33 + (lane & 31)] = tv[i]; }
    LDS_WAIT();
    const int c = lane & 7;
#pragma unroll
    for (int j = 0; j < 4; ++j) { const int n = (lane >> 3) + 8 * j; const LAS float* s = scr + (8 * c) * 33 + n;
        u32x4 o; o.x = cvt_pk_bf16(s[0 * 33], s[1 * 33]); o.y = cvt_pk_bf16(s[2 * 33], s[3 * 33]); o.z = cvt_pk_bf16(s[4 * 33], s[5 * 33]); o.w = cvt_pk_bf16(s[6 * 33], s[7 * 33]);
        const int nn = n0 + n; int drow = nn;
        if (ROWMODE == 1) { drow = (nn < 1024) ? (256 * (nn >> 7) + (nn & 127)) : (256 * ((nn - 1024) >> 7) + 128 + ((nn - 1024) & 127)); }
        *(u32x4*)(WT + (size_t)drow * dst_ld + dst_off + k0 + 8 * c) = o; }
    LDS_WAIT();
}
template <int ROWMODE>
__device__ __forceinline__ void tr_item_fp8(const float* W, int N, unsigned char* WT, int k0, int n0, LAS float* scr, int lane) {
    { float tv[64];
#pragma unroll
    for (int i = 0; i < 64; ++i) tv[i] = W[(size_t)(k0 + 2 * i + (lane >> 5)) * N + n0 + (lane & 31)];
#pragma unroll
    for (int i = 0; i < 64; ++i) scr[(2 * i + (lane >> 5)) * 33 + (lane & 31)] = tv[i]; }
    LDS_WAIT();
    const int c = lane & 7;
#pragma unroll
    for (int j = 0; j < 4; ++j) { const int n = (lane >> 3) + 8 * j; const LAS float* s = scr + (16 * c) * 33 + n;
        int o[4];
#pragma unroll
        for (int q = 0; q < 4; ++q) { int w = 0; w = __builtin_amdgcn_cvt_pk_fp8_f32(s[(4 * q) * 33] * WEIN_SCALE, s[(4 * q + 1) * 33] * WEIN_SCALE, w, false);
            w = __builtin_amdgcn_cvt_pk_fp8_f32(s[(4 * q + 2) * 33] * WEIN_SCALE, s[(4 * q + 3) * 33] * WEIN_SCALE, w, true); o[q] = w; }
        const int nn = n0 + n; const int drow = (ROWMODE == 0) ? nn : ((nn < 1024) ? (256 * (nn >> 7) + (nn & 127)) : (256 * ((nn - 1024) >> 7) + 128 + ((nn - 1024) & 127)));
        *(u32x4*)(WT + (size_t)drow * 1024 + k0 + 16 * c) = (u32x4){(unsigned)o[0], (unsigned)o[1], (unsigned)o[2], (unsigned)o[3]}; }
    LDS_WAIT();
}
template <int ROWMODE>
__device__ __forceinline__ void tr_job(int item, const float* src, int K, int N, bf16_t* dst, size_t dst_bstride, int dst_ld, int dst_off, LAS float* scr, int lane) {
    const int nnb = N / 32, nkb = K / 64; const int nb = item % nnb; const int r = item / nnb; const int kb = r % nkb; const int bt = r / nkb;
    tr_item<ROWMODE>(src + (size_t)bt * K * N, N, dst + (size_t)bt * dst_bstride, dst_ld, dst_off, 64 * kb, 32 * nb, scr, lane);
}

__device__ __forceinline__ void phase_prologue(const Args& a, LAS unsigned char* lds, const int wv) {
    int tid_ = tid_of(wv); asm volatile("" : "+v"(tid_)); const int tid = tid_, lane = tid & 63, wave = __builtin_amdgcn_readfirstlane(tid >> 6);
    const int G = gridDim.x;
    unsigned char* ws = opaque_ptr(a.ws); const int bid = opaque_bid();
    {
        LAS float* cact = (LAS float*)lds;
        LAS float* red = (LAS float*)(lds + 32768);
        for (int i = tid; i < NBATCH * D; i += NTHREADS) { const float v = a.in[I_C][i]; cact[i] = v * sigmoidf_(v); }
        __syncthreads();
        float* mod = (float*)(ws + WS_MOD);
        for (int u = bid; u < DEPTH * 96; u += G) {
            const int l = u / 96, cg = u % 96; const int n = cg * 64 + lane;
            const float* w = a.in[I_WADA] + (size_t)l * D * 6144 + n;
            float acc[8] = {0.f, 0.f, 0.f, 0.f, 0.f, 0.f, 0.f, 0.f};
            const int kb = wave * 128;
#pragma unroll 8
            for (int k = 0; k < 128; ++k) { const float wv = w[(size_t)(kb + k) * 6144];
#pragma unroll
                for (int b = 0; b < 8; ++b) acc[b] += cact[b * D + kb + k] * wv; }
#pragma unroll
            for (int b = 0; b < 8; ++b) red[(wave * 8 + b) * 64 + lane] = acc[b];
            __syncthreads();
            { const int b = tid >> 6; float s = 0.f;
#pragma unroll
              for (int w8 = 0; w8 < 8; ++w8) s += red[(w8 * 8 + b) * 64 + lane];
              mod[((size_t)l * NBATCH + b) * 6144 + n] = s + a.in[I_BADA][(size_t)l * 6144 + n]; }
            __syncthreads();
        }
    }
    {
        bf16_t* wrs = (bf16_t*)(ws + WS_WRS);
        for (int idx = bid * NTHREADS + tid; idx < DEPTH * D * NE; idx += G * NTHREADS) { const int e = idx & 31, k = (idx >> 5) & 1023, l = idx >> 15;
            const float w = a.in[I_WROUTER][idx]; const unsigned hi = cvt_pk_bf16(w, 0.f) & 0xffffu; const unsigned lo = cvt_pk_bf16(w - bflo(hi), 0.f) & 0xffffu;
            wrs[((size_t)(l * 2 + 0) * NE + e) * D + k] = (bf16_t)hi; wrs[((size_t)(l * 2 + 1) * NE + e) * D + k] = (bf16_t)lo; }
    }
    {
        LAS float* scr = (LAS float*)(lds + wave * 16896);
        const int gw = bid * NWAVES + wave, NGW = G * NWAVES;
        constexpr int I_EIN = DEPTH * NE * 8 * 64, I_EOUT = DEPTH * NE * 8 * 32, I_WINI = DEPTH * (Z_FP8 ? 8 : 16) * 144, I_UPA = DEPTH * 16 * 32, I_UPB = DEPTH * 8 * 32, I_OUT = DEPTH * 16 * 32,
                      I_RGA = DEPTH * 8 * 2 * 4, I_RGX = I_RGA, I_POOL = DEPTH * 4 * 2 * 4;
        constexpr int NITEMS = I_EIN + I_EOUT + I_WINI + I_UPA + I_UPB + I_OUT + I_RGA + I_RGX + I_POOL;
        for (int it = gw; it < NITEMS; it += NGW) {
            int r = it;
            if (r < I_EIN) { const int nb = r % 64, r2 = r / 64, kb = r2 % 8, bt = r2 / 8;
                tr_item_fp8<1>(a.in[I_WEIN] + (size_t)bt * 1024 * 2048, 2048, (unsigned char*)(ws + WS_WEIN) + (size_t)bt * 2048 * 1024, 128 * kb, 32 * nb, scr, lane); continue; } r -= I_EIN;
            if (r < I_EOUT) { const int nb = r % 32, r2 = r / 32, kb = r2 % 8, bt = r2 / 8;
                tr_item_fp8<0>(a.in[I_WEOUT] + (size_t)bt * 1024 * 1024, 1024, (unsigned char*)(ws + WS_WEOUT) + (size_t)bt * 1024 * 1024, 128 * kb, 32 * nb, scr, lane); continue; } r -= I_EOUT;
#if Z_FP8
            if (r < I_WINI) { const int nb = r % 144, r2 = r / 144, kb = r2 % 8, bt = r2 / 8;
                tr_item_fp8<0>(a.in[I_WIN] + (size_t)bt * 1024 * NZ, NZ, (unsigned char*)(ws + WS_WIN) + (size_t)bt * NZ * 1024, 128 * kb, 32 * nb, scr, lane); continue; } r -= I_WINI;
#else
            if (r < I_WINI) { tr_job<0>(r, a.in[I_WIN], 1024, NZ, (bf16_t*)(ws + WS_WIN), (size_t)NZ * 1024, 1024, 0, scr, lane); continue; } r -= I_WINI;
#endif
            if (r < I_UPA) { tr_job<0>(r, a.in[I_WUPA], 1024, 1024, (bf16_t*)(ws + WS_WCAT), (size_t)1024 * KCAT, KCAT, 512, scr, lane); continue; } r -= I_UPA;
            if (r < I_UPB) { tr_job<0>(r, a.in[I_WUPB], 512, 1024, (bf16_t*)(ws + WS_WCAT), (size_t)1024 * KCAT, KCAT, 0, scr, lane); continue; } r -= I_UPB;
            if (r < I_OUT) { tr_job<0>(r, a.in[I_WOUT], 1024, 1024, (bf16_t*)(ws + WS_WOUT), (size_t)1024 * 1024, 1024, 0, scr, lane); continue; } r -= I_OUT;
            if (r < I_RGA) { tr_job<0>(r, a.in[I_WRGA], 128, 128, (bf16_t*)(ws + WS_WRG), (size_t)256 * 128, 128, 0, scr, lane); continue; } r -= I_RGA;
            if (r < I_RGX) { tr_job<0>(r, a.in[I_WRGX], 128, 128, (bf16_t*)(ws + WS_WRG) + 128 * 128, (size_t)256 * 128, 128, 0, scr, lane); continue; } r -= I_RGX;
            tr_job<0>(r, a.in[I_WPOOL], 128, 128, (bf16_t*)(ws + WS_WPOOL), (size_t)128 * 128, 128, 0, scr, lane);
        }
    }
}

struct MoeTab { LAS int* cnt; LAS int* padstart; LAS int* tilestart; LAS int* tab; };
__device__ __forceinline__ MoeTab moe_tab_ptrs(LAS unsigned char* lds) { MoeTab t; t.cnt = (LAS int*)(lds + LDS_TAB); t.padstart = t.cnt + 32; t.tilestart = t.padstart + 40; t.tab = t.tilestart + 40; return t; }
__device__ __forceinline__ void moe_tables(const Args& a, int l, LAS unsigned char* lds, const int wv) {
    const MoeTab mt = moe_tab_ptrs(lds); int tid_ = tid_of(wv); asm volatile("" : "+v"(tid_)); const int tid = tid_;
    unsigned* ctl = (unsigned*)(opaque_ptr(a.ws) + WS_CTL);
    __syncthreads();
    if (tid < NE) mt.cnt[tid] = (int)__hip_atomic_load(ctl + CW_CNT + (l * NE + tid) * 16, __ATOMIC_RELAXED, __HIP_MEMORY_SCOPE_AGENT);
    __syncthreads();
    if (tid == 0) { int ps = 0, ts = 0; for (int e = 0; e < NE; ++e) { mt.padstart[e] = ps; mt.tilestart[e] = ts; const int nt = (mt.cnt[e] + 255) >> 8; ps += nt * 256; ts += nt; } mt.padstart[NE] = ps; mt.tilestart[NE] = ts; }
    __syncthreads();
    const int nMt = mt.tilestart[NE];
    for (int m = tid; m < nMt; m += NTHREADS) { int e = 0; for (int q = 1; q < NE; ++q) e = (mt.tilestart[q] <= m) ? q : e; mt.tab[m] = (e << 16) | (m - mt.tilestart[e]); }
    __syncthreads();
}
struct MoeSched1 {
    static constexpr bool DYN_A = true;
    const char* H; const char* W; const int* tokof; MoeTab mt; int nMt, G, c;
    __device__ __forceinline__ bool next(int i, pg8::Unit& u) const { int pm, pn; if (!pg8::order_map(i, G, c, nMt, 8, pm, pn)) return false;
        const int en = __builtin_amdgcn_readfirstlane(mt.tab[pm]); u.pm = pm; u.pn = pn; u.e = en >> 16; u.j = en & 0xffff;
        u.row0 = __builtin_amdgcn_readfirstlane(mt.padstart[u.e]) + 256 * u.j; u.rows = __builtin_amdgcn_readfirstlane(mt.cnt[u.e]) - 256 * u.j; return true; }
    __device__ __forceinline__ const char* a_ptr() const { return H; }
    __device__ __forceinline__ const char* b_ptr() const { return W; }
    __device__ __forceinline__ unsigned a_off(const pg8::Unit&) const { return 0u; }
    __device__ __forceinline__ unsigned b_off(const pg8::Unit& u) const { return ((unsigned)u.e * 2048u + (unsigned)u.pn * 256u) * 1024u; }
    __device__ __forceinline__ void a_voff(const pg8::Unit& u, unsigned (&v)[2][2], int wv) const {
        int tid = tid_of(wv); asm volatile("" : "+v"(tid));
        const int* tl = tokof + (size_t)u.e * T + 256 * u.j; const int rmax = u.rows - 1;
#pragma unroll
        for (int i = 0; i < 2; ++i) { int R, C; pg8::stage_rc(tid * 16 + i * 8192, R, C);
#pragma unroll
            for (int h = 0; h < 2; ++h) { int idx = h * 128 + R; idx = idx < rmax ? idx : rmax; v[h][i] = (unsigned)tl[idx] * 1024u + (unsigned)C * 2u; } }
    }
};
struct MoeSched2 {
    static constexpr bool DYN_A = false;
    const char* ACT; const char* W; MoeTab mt; int nMt, G, c;
    __device__ __forceinline__ bool next(int i, pg8::Unit& u) const { int pm, pn; if (!pg8::order_map(i, G, c, nMt, 4, pm, pn)) return false;
        const int en = __builtin_amdgcn_readfirstlane(mt.tab[pm]); u.pm = pm; u.pn = pn; u.e = en >> 16; u.j = en & 0xffff;
        u.row0 = __builtin_amdgcn_readfirstlane(mt.padstart[u.e]) + 256 * u.j; u.rows = __builtin_amdgcn_readfirstlane(mt.cnt[u.e]) - 256 * u.j; return true; }
    __device__ __forceinline__ const char* a_ptr() const { return ACT; }
    __device__ __forceinline__ const char* b_ptr() const { return W; }
    __device__ __forceinline__ unsigned a_off(const pg8::Unit& u) const { return (unsigned)u.row0 * 1024u; }
    __device__ __forceinline__ unsigned b_off(const pg8::Unit& u) const { return ((unsigned)u.e * 1024u + (unsigned)u.pn * 256u) * 1024u; }
    __device__ __forceinline__ void a_voff(const pg8::Unit&, unsigned (&v)[2][2], int wv) const {
        int tid = tid_of(wv); asm volatile("" : "+v"(tid));
#pragma unroll
        for (int i = 0; i < 2; ++i) { int R, C; pg8::stage_rc(tid * 16 + i * 8192, R, C);
#pragma unroll
            for (int h = 0; h < 2; ++h) v[h][i] = (unsigned)((h * 128 + R) * 512 + C) * 2u; }
    }
};

__device__ __forceinline__ void phase_a(const Args& a, int l, LAS unsigned char* lds, bool dry, const int wv) {
    int tid_ = tid_of(wv); asm volatile("" : "+v"(tid_)); const int tid = tid_, lane = tid & 63, wave = __builtin_amdgcn_readfirstlane(tid >> 6);
    const int G = gridDim.x; unsigned char* ws = opaque_ptr(a.ws); const int bid = opaque_bid();
    const float* mod = (const float*)(ws + WS_MOD);
    float* xres = (float*)(ws + WS_XRES); float* xout = dry ? (float*)(ws + WS_Z) : xres;
    if (l < DEPTH && bid < NBATCH) {
        LAS float* red = (LAS float*)lds;
        const int b = bid, e = tid & 31, kp = tid >> 5;
        const float* sh2 = mod + ((size_t)l * NBATCH + b) * 6144 + 3 * D; const float* wr = a.in[I_WROUTER] + (size_t)l * D * NE;
        float s = 0.f;
        for (int k = kp * 64; k < kp * 64 + 64; ++k) s += sh2[k] * wr[k * NE + e];
        red[kp * 32 + e] = s;
        __syncthreads();
        if (tid < 32) { float t = a.in[I_BROUTER][l * NE + tid]; for (int q = 0; q < 16; ++q) t += red[q * 32 + tid]; ((float*)(ws + WS_CB))[(l * NBATCH + b) * NE + tid] = t; }
        __syncthreads();
    }
    if (l > 0) moe_tables(a, (l - 1) + DEPTH * (REPN(7) - 1), lds, wv);
    const MoeTab mt = moe_tab_ptrs(lds);
    const int* slotinfo = (const int*)(ws + WS_SLOTINFO); const float* wgt = (const float*)(ws + WS_WGT);
    const bf16_t* outb = (const bf16_t*)(ws + WS_OUTB);
    unsigned char* hb = (unsigned char*)(ws + WS_H);
    for (int chunk = bid; chunk < T / 128; chunk += G) {
        const int rowb = chunk * 128 + wave * 16; const int b = rowb / SEQ;
        const float* xin = (l == 0) ? (a.in[I_X] + (size_t)rowb * D) : (xres + (size_t)rowb * D);
        f32x4 xv[2][4]; int4 si[4]; f32x4 wv[4]; u32x2 gv[2][4][4];
#define PA_SX(r, q) do { if ((r) < 16) { _Pragma("unroll") for (int j = 0; j < 4; ++j) xv[(q) & 1][j] = *(const f32x4*)(xin + (size_t)(r) * D + 4 * lane + 256 * j); } } while (0)
#define PA_S0(r, q) do { if ((r) < 16 && l > 0) { si[(q) & 3] = *(const int4*)(slotinfo + (size_t)(rowb + (r)) * 4); wv[(q) & 3] = *(const f32x4*)(wgt + (size_t)(rowb + (r)) * 4); } } while (0)
#define PA_S1(r, q) do { if ((r) < 16 && l > 0) { const int sl_[4] = {si[(q) & 3].x, si[(q) & 3].y, si[(q) & 3].z, si[(q) & 3].w}; \
            _Pragma("unroll") for (int kk = 0; kk < 4; ++kk) { const int e_ = sl_[kk] >> 24, li_ = sl_[kk] & 0xffffff; const bf16_t* orow = outb + (size_t)(mt.padstart[e_] + li_) * D + 4 * lane; \
                _Pragma("unroll") for (int j = 0; j < 4; ++j) gv[(q) & 1][kk][j] = *(const u32x2*)(orow + 256 * j); } } } while (0)
        PA_S0(0, 0); PA_S0(1, 1); PA_SX(0, 0); PA_S1(0, 0);
#pragma unroll 1
        for (int i0 = 0; i0 < 16; i0 += 4) {
#pragma unroll
          for (int ii = 0; ii < 4; ++ii) {
            const int i = i0 + ii; const int row = rowb + i;
            PA_S0(i + 2, ii + 2); PA_SX(i + 1, ii + 1); PA_S1(i + 1, ii + 1);
            f32x4 v[4];
#pragma unroll
            for (int j = 0; j < 4; ++j) v[j] = xv[ii & 1][j];
            if (l > 0) {
                f32x4 y[4];
#pragma unroll
                for (int j = 0; j < 4; ++j) y[j] = (f32x4){0.f, 0.f, 0.f, 0.f};
#pragma unroll
                for (int kk = 0; kk < 4; ++kk) { const float w = wv[ii][kk];
#pragma unroll
                    for (int j = 0; j < 4; ++j) { const u32x2 p = gv[ii & 1][kk][j]; y[j] += w * (f32x4){bflo(p.x), bfhi(p.x), bflo(p.y), bfhi(p.y)}; } }
                const float* g2 = mod + ((size_t)(l - 1) * NBATCH + b) * 6144 + 5 * D + 4 * lane;
#pragma unroll
                for (int j = 0; j < 4; ++j) v[j] += *(const f32x4*)(g2 + 256 * j) * y[j];
            }
            if (l < DEPTH) {
#pragma unroll
                for (int j = 0; j < 4; ++j) *(f32x4*)(xout + (size_t)row * D + 4 * lane + 256 * j) = v[j];
            }
            float ss = 0.f;
#pragma unroll
            for (int j = 0; j < 4; ++j) ss += (v[j].x * v[j].x + v[j].y * v[j].y) + (v[j].z * v[j].z + v[j].w * v[j].w);
            const float rinv = 1.0f / sqrtf(wave_sum(ss, lane) * (1.0f / D) + NORM_EPS);
            if (l < DEPTH) {
                const float* ng = a.in[I_N1G] + (size_t)l * D + 4 * lane; const float* mb = mod + ((size_t)l * NBATCH + b) * 6144 + 4 * lane;
#pragma unroll
                for (int j = 0; j < 4; ++j) { const f32x4 g = *(const f32x4*)(ng + 256 * j), sh = *(const f32x4*)(mb + 256 * j), sc = *(const f32x4*)(mb + D + 256 * j);
                    const f32x4 h = (v[j] * rinv * g) * (1.0f + sc) + sh;
#if Z_FP8
                    int p = 0; p = __builtin_amdgcn_cvt_pk_fp8_f32(h.x, h.y, p, false); p = __builtin_amdgcn_cvt_pk_fp8_f32(h.z, h.w, p, true);
                    *(int*)(hb + (size_t)row * D + 4 * lane + 256 * j) = p; }
#else
                    u32x2 p; p.x = cvt_pk_bf16(h.x, h.y); p.y = cvt_pk_bf16(h.z, h.w); *(u32x2*)((bf16_t*)hb + (size_t)row * D + 4 * lane + 256 * j) = p; }
#endif
            } else {
                const float* fg = a.in[I_FINALG] + 4 * lane;
#pragma unroll
                for (int j = 0; j < 4; ++j) *(f32x4*)(a.out + (size_t)row * D + 4 * lane + 256 * j) = v[j] * rinv * *(const f32x4*)(fg + 256 * j);
            }
          }
        }
#undef PA_S0
#undef PA_SX
#undef PA_S1
    }
}

__device__ __forceinline__ void phase_h(const Args& a, int l, int cset, LAS unsigned char* lds, const int wv) {
    int tid_ = tid_of(wv); asm volatile("" : "+v"(tid_)); const int tid = tid_, lane = tid & 63, wave = __builtin_amdgcn_readfirstlane(tid >> 6);
    const int G = gridDim.x; unsigned char* ws = opaque_ptr(a.ws); const int bid = opaque_bid();
    const float* mod = (const float*)(ws + WS_MOD); const float* xres = (const float*)(ws + WS_XRES);
    unsigned char* h8 = (unsigned char*)(ws + WS_H);
    LAS float* rinvs = (LAS float*)lds;
    LAS float* lgt = (LAS float*)(lds + 1024);
    LAS int* hist = (LAS int*)(lds + 1024 + 8 * 16 * 33 * 4);
    LAS int* base = hist + 32;
    unsigned* ctl = (unsigned*)(ws + WS_CTL);
    const float* ng = a.in[I_N2G] + (size_t)l * D;
    const float* cbv = (const float*)(ws + WS_CB);
    int* tokof = (int*)(ws + WS_TOKOF); int* slotinfo = (int*)(ws + WS_SLOTINFO); float* wgt = (float*)(ws + WS_WGT);
    for (int chunk = bid; chunk < T / 128; chunk += G) {
        const int row0 = chunk * 128 + wave * 16; const int b = row0 / SEQ;
        const float* mb = mod + ((size_t)l * NBATCH + b) * 6144 + 3 * D;
        if (tid < 32) hist[tid] = 0;
        f32x4 xq[3][4];
#pragma unroll
        for (int r = 0; r < 2; ++r)
#pragma unroll
            for (int j = 0; j < 4; ++j) xq[r][j] = *(const f32x4*)(xres + (size_t)(row0 + r) * D + 4 * lane + 256 * j);
#pragma unroll
        for (int i = 0; i < 16; ++i) {
            const int row = row0 + i;
            if (i + 2 < 16) {
#pragma unroll
                for (int j = 0; j < 4; ++j) xq[(i + 2) % 3][j] = *(const f32x4*)(xres + (size_t)(row + 2) * D + 4 * lane + 256 * j); }
            f32x4 v[4]; float ss = 0.f;
#pragma unroll
            for (int j = 0; j < 4; ++j) { v[j] = xq[i % 3][j]; ss += (v[j].x * v[j].x + v[j].y * v[j].y) + (v[j].z * v[j].z + v[j].w * v[j].w); }
            const float rinv = 1.0f / sqrtf(wave_sum(ss, lane) * (1.0f / D) + NORM_EPS);
            if (lane == 0) rinvs[wave * 16 + i] = rinv;
#pragma unroll
            for (int j = 0; j < 4; ++j) { const f32x4 g = *(const f32x4*)(ng + 4 * lane + 256 * j), sh = *(const f32x4*)(mb + 4 * lane + 256 * j), sc = *(const f32x4*)(mb + D + 4 * lane + 256 * j);
                const f32x4 h = (v[j] * rinv * g) * (1.0f + sc) + sh;
                int p = 0; p = __builtin_amdgcn_cvt_pk_fp8_f32(h.x, h.y, p, false); p = __builtin_amdgcn_cvt_pk_fp8_f32(h.z, h.w, p, true);
                *(int*)(h8 + (size_t)row * D + 4 * lane + 256 * j) = p; }
        }
        {
            const int ri = lane & 15, q = lane >> 4;
            const float* xr = xres + (size_t)(row0 + ri) * D + 8 * q;
            const bf16_t* wh = (const bf16_t*)(ws + WS_WRS) + ((size_t)(l * 2 + 0) * NE + ri) * D + 8 * q; const bf16_t* wl = wh + (size_t)NE * D;
            f32x4 acc0 = {0.f, 0.f, 0.f, 0.f}, acc1 = {0.f, 0.f, 0.f, 0.f};
#pragma unroll 4
            for (int kb = 0; kb < 32; ++kb) {
                const int k0 = 32 * kb + 8 * q;
                const f32x4 x0 = *(const f32x4*)(xr + 32 * kb), x1 = *(const f32x4*)(xr + 32 * kb + 4);
                const f32x4 g0 = *(const f32x4*)(ng + k0), g1 = *(const f32x4*)(ng + k0 + 4), s0 = *(const f32x4*)(mb + D + k0), s1 = *(const f32x4*)(mb + D + k0 + 4);
                const bf16x8 bh0 = *(const bf16x8*)(wh + 32 * kb), bl0 = *(const bf16x8*)(wl + 32 * kb), bh1 = *(const bf16x8*)(wh + 16 * D + 32 * kb), bl1 = *(const bf16x8*)(wl + 16 * D + 32 * kb);
                const f32x4 a0 = x0 * g0 * (1.0f + s0), a1 = x1 * g1 * (1.0f + s1);
                u32x4 hi, lo;
                hi.x = cvt_pk_bf16(a0.x, a0.y); hi.y = cvt_pk_bf16(a0.z, a0.w); hi.z = cvt_pk_bf16(a1.x, a1.y); hi.w = cvt_pk_bf16(a1.z, a1.w);
                lo.x = cvt_pk_bf16(a0.x - bflo(hi.x), a0.y - bfhi(hi.x)); lo.y = cvt_pk_bf16(a0.z - bflo(hi.y), a0.w - bfhi(hi.y));
                lo.z = cvt_pk_bf16(a1.x - bflo(hi.z), a1.y - bfhi(hi.z)); lo.w = cvt_pk_bf16(a1.z - bflo(hi.w), a1.w - bfhi(hi.w));
                const bf16x8 ah = __builtin_bit_cast(bf16x8, hi), al = __builtin_bit_cast(bf16x8, lo);
                acc0 = __builtin_amdgcn_mfma_f32_16x16x32_bf16(ah, bh0, acc0, 0, 0, 0); acc0 = __builtin_amdgcn_mfma_f32_16x16x32_bf16(ah, bl0, acc0, 0, 0, 0); acc0 = __builtin_amdgcn_mfma_f32_16x16x32_bf16(al, bh0, acc0, 0, 0, 0);
                acc1 = __builtin_amdgcn_mfma_f32_16x16x32_bf16(ah, bh1, acc1, 0, 0, 0); acc1 = __builtin_amdgcn_mfma_f32_16x16x32_bf16(ah, bl1, acc1, 0, 0, 0); acc1 = __builtin_amdgcn_mfma_f32_16x16x32_bf16(al, bh1, acc1, 0, 0, 0);
            }
            LDS_WAIT();
            const float c0 = cbv[(l * NBATCH + b) * NE + ri], c1 = cbv[(l * NBATCH + b) * NE + 16 + ri];
#pragma unroll
            for (int r = 0; r < 4; ++r) { const int ti = 4 * q + r; const float rv = rinvs[wave * 16 + ti];
                lgt[(wave * 16 + ti) * 33 + ri] = acc0[r] * rv + c0; lgt[(wave * 16 + ti) * 33 + 16 + ri] = acc1[r] * rv + c1; }
        }
        __syncthreads();
        int se[4] = {0, 0, 0, 0}; float sw[4] = {0.f, 0.f, 0.f, 0.f}; int rk[4] = {0, 0, 0, 0};
        if (lane < 16) {
            float v[32];
#pragma unroll
            for (int e = 0; e < 32; ++e) v[e] = lgt[(wave * 16 + lane) * 33 + e];
            float sv[4];
#pragma unroll
            for (int kk = 0; kk < 4; ++kk) { float best = v[0]; int bi = 0;
#pragma unroll
                for (int e = 1; e < 32; ++e) { if (v[e] > best) { best = v[e]; bi = e; } }
                sv[kk] = best; se[kk] = bi;
#pragma unroll
                for (int e = 0; e < 32; ++e) v[e] = (e == bi) ? -3.0e38f : v[e]; }
            float den = 0.f;
#pragma unroll
            for (int kk = 0; kk < 4; ++kk) { sw[kk] = __expf(sv[kk] - sv[0]); den += sw[kk]; }
            const float inv = 1.0f / den;
#pragma unroll
            for (int kk = 0; kk < 4; ++kk) { sw[kk] *= inv; rk[kk] = __hip_atomic_fetch_add(hist + se[kk], 1, __ATOMIC_RELAXED, __HIP_MEMORY_SCOPE_WORKGROUP); }
        }
        __syncthreads();
        if (tid < 32) base[tid] = (int)__hip_atomic_fetch_add(ctl + CW_CNT + (cset * NE + tid) * 16, (unsigned)hist[tid], __ATOMIC_RELAXED, __HIP_MEMORY_SCOPE_AGENT);
        __syncthreads();
        if (lane < 16) {
            const int row = row0 + lane; int si[4];
#pragma unroll
            for (int kk = 0; kk < 4; ++kk) { const int li = base[se[kk]] + rk[kk]; tokof[(size_t)se[kk] * T + li] = row; si[kk] = (se[kk] << 24) | li; }
            *(int4*)(slotinfo + (size_t)row * 4) = make_int4(si[0], si[1], si[2], si[3]);
            *(f32x4*)(wgt + (size_t)row * 4) = (f32x4){sw[0], sw[1], sw[2], sw[3]};
        }
        __syncthreads();
    }
}

constexpr int ZT_STRIDE = 528;
__device__ __forceinline__ void lru_unit(const Args& a, int l, int u, LAS unsigned char* lds, const int wv) {
    int tid_ = tid_of(wv); asm volatile("" : "+v"(tid_)); const int tid = tid_, lane = tid & 63, wave = __builtin_amdgcn_readfirstlane(tid >> 6);
    unsigned char* ws = opaque_ptr(a.ws);
    const bf16_t* z = (const bf16_t*)(ws + WS_Z);
    LAS unsigned char* zt = lds; LAS unsigned char* xc = lds + 131 * ZT_STRIDE;
    const int hp = u & 3, b = (u >> 2) & 7, s = u >> 5;
    const int t0 = b * SEQ + s * 128, p0 = s * 128;
    {   u32x4 sv[9];
#pragma unroll
        for (int k = 0; k < 9; ++k) { int idx = tid + NTHREADS * k; idx = idx < 131 * 32 ? idx : 131 * 32 - 1; const int r = idx >> 5, o = idx & 31; const int p = p0 - 3 + r; const int pc = p < 0 ? 0 : p;
            sv[k] = *(const u32x4*)(z + (size_t)(b * SEQ + pc) * NZ + hp * 256 + o * 8); if (p < 0) sv[k] = (u32x4){0u, 0u, 0u, 0u}; }
#pragma unroll
        for (int k = 0; k < 9; ++k) { int idx = tid + NTHREADS * k; idx = idx < 131 * 32 ? idx : 131 * 32 - 1; const int r = idx >> 5, o = idx & 31;
            *(LAS u32x4*)(zt + r * ZT_STRIDE + o * 16) = sv[k]; }
    }
    __syncthreads();
    {
        const int o = tid & 31, rb = tid >> 5; const int ch0 = hp * 256 + o * 8;
        float cw[4][8], cbias[8];
#pragma unroll
        for (int k = 0; k < 4; ++k) { const f32x4 w0 = *(const f32x4*)(a.in[I_CONVW] + ((size_t)l * 4 + k) * D + ch0), w1 = *(const f32x4*)(a.in[I_CONVW] + ((size_t)l * 4 + k) * D + ch0 + 4);
            cw[k][0] = w0.x; cw[k][1] = w0.y; cw[k][2] = w0.z; cw[k][3] = w0.w; cw[k][4] = w1.x; cw[k][5] = w1.y; cw[k][6] = w1.z; cw[k][7] = w1.w; }
        { const f32x4 b0 = *(const f32x4*)(a.in[I_CONVB] + (size_t)l * D + ch0), b1 = *(const f32x4*)(a.in[I_CONVB] + (size_t)l * D + ch0 + 4);
          cbias[0] = b0.x; cbias[1] = b0.y; cbias[2] = b0.z; cbias[3] = b0.w; cbias[4] = b1.x; cbias[5] = b1.y; cbias[6] = b1.z; cbias[7] = b1.w; }
#pragma unroll 2
        for (int i = 0; i < 8; ++i) { const int r = rb + 16 * i; float acc[8];
#pragma unroll
            for (int j = 0; j < 8; ++j) acc[j] = cbias[j];
#pragma unroll
            for (int k = 0; k < 4; ++k) { const u32x4 v = *(const LAS u32x4*)(zt + (r + k) * ZT_STRIDE + o * 16);
                acc[0] += cw[k][0] * bflo(v.x); acc[1] += cw[k][1] * bfhi(v.x); acc[2] += cw[k][2] * bflo(v.y); acc[3] += cw[k][3] * bfhi(v.y);
                acc[4] += cw[k][4] * bflo(v.z); acc[5] += cw[k][5] * bfhi(v.z); acc[6] += cw[k][6] * bflo(v.w); acc[7] += cw[k][7] * bfhi(v.w); }
            u32x4 w; w.x = cvt_pk_bf16(acc[0], acc[1]); w.y = cvt_pk_bf16(acc[2], acc[3]); w.z = cvt_pk_bf16(acc[4], acc[5]); w.w = cvt_pk_bf16(acc[6], acc[7]);
            *(LAS u32x4*)(xc + r * ZT_STRIDE + o * 16) = w; }
    }
    __syncthreads();
    {
        const int hsel = wave >> 2, wc = wave & 3, head = 2 * hp + hsel, c31 = lane & 31, hh = lane >> 5;
        const int ch = head * 128 + 32 * wc + c31;
        const bf16_t* wb = (const bf16_t*)(ws + WS_WRG) + ((size_t)(l * 8 + head) * 256 + 32 * wc + c31) * 128 + 8 * hh;
        bf16x8 Ba[8], Bi[8];
#pragma unroll
        for (int ks = 0; ks < 8; ++ks) { Ba[ks] = *(const bf16x8*)(wb + 16 * ks); Bi[ks] = *(const bf16x8*)(wb + 128 * 128 + 16 * ks); }
        const float ba = a.in[I_BRGA][(size_t)l * D + ch], bx = a.in[I_BRGX][(size_t)l * D + ch];
        const float lam = a.in[I_LAM][(size_t)l * D + ch];
        const float sp8 = 8.0f * log1pf(__expf(-lam));
        typedef __attribute__((address_space(1))) unsigned long long gu64;
        gu64* aggq = (gu64*)(ws + WS_AGG) + ((size_t)l * NBATCH * 32 + (size_t)b * 32) * D + ch;
        float Pr = 1.f, Hr = 0.f;
        unsigned hpk[64];
#pragma unroll
        for (int rb = 0; rb < 4; ++rb) {
            f32x16 aa, ai;
#pragma unroll
            for (int r = 0; r < 16; ++r) { aa[r] = 0.f; ai[r] = 0.f; }
            const LAS unsigned char* ap = xc + (32 * rb + c31) * ZT_STRIDE + (hsel * 128 + 8 * hh) * 2;
#pragma unroll
            for (int ks = 0; ks < 8; ++ks) { const bf16x8 A = *(const LAS bf16x8*)(ap + 32 * ks);
                aa = __builtin_amdgcn_mfma_f32_32x32x16_bf16(A, Ba[ks], aa, 0, 0, 0); ai = __builtin_amdgcn_mfma_f32_32x32x16_bf16(A, Bi[ks], ai, 0, 0, 0); }
            const LAS unsigned char* xp = xc + (32 * rb + 4 * hh) * ZT_STRIDE + (hsel * 128 + 32 * wc + c31) * 2;
#pragma unroll
            for (int q = 0; q < 4; ++q) {
                float p = 1.f, h = 0.f, hl[4], pl[4];
#pragma unroll
                for (int r3 = 0; r3 < 4; ++r3) { const int reg = 4 * q + r3;
                    const float xcv = bf1(*(const LAS bf16_t*)(xp + (8 * q + r3) * ZT_STRIDE));
                    const float rg = sigmoidf_(aa[reg] + ba), ig = sigmoidf_(ai[reg] + bx);
                    const float av = __expf(-sp8 * rg); const float mult = sqrtf(fmaxf(1.0f - av * av, 0.f));
                    h = av * h + mult * (ig * xcv); p *= av; hl[r3] = h; pl[r3] = p; }
                const float Ao = shflx(p, 32, lane), Bo = shflx(h, 32, lane);
                const float A0 = hh ? Ao : p, B0 = hh ? Bo : h, A1 = hh ? p : Ao, B1 = hh ? h : Bo;
                const float P1 = Pr * A0, H1 = Hr * A0 + B0;
                const float Pst = hh ? P1 : Pr, Hst = hh ? H1 : Hr;
                Pr = P1 * A1; Hr = H1 * A1 + B1;
#pragma unroll
                for (int r3 = 0; r3 < 4; ++r3) hpk[rb * 16 + 4 * q + r3] = cvt_pk_bf16(Hst * pl[r3] + hl[r3], Pst * pl[r3]);
            }
        }
        if (hh == 0) __hip_atomic_store(aggq + (size_t)s * D, ((unsigned long long)__float_as_uint(Hr) << 32) | (unsigned long long)__float_as_uint(fmaxf(Pr, 1e-37f)), __ATOMIC_RELAXED, __HIP_MEMORY_SCOPE_AGENT);
        const bf16_t* zg = z + (size_t)t0 * NZ + ZO_GLRU + ch;
        bf16_t* yo = (bf16_t*)(ws + WS_ACAT) + (size_t)t0 * KCAT + 512 + ch;
        bf16_t gcur[16], gnxt[16];
#pragma unroll
        for (int reg = 0; reg < 16; ++reg) gcur[reg] = zg[(size_t)(8 * (reg >> 2) + 4 * hh + (reg & 3)) * NZ];
        float cin = 0.f;
        for (int j0 = 0; j0 < s; j0 += 8) {
            unsigned long long w[8]; unsigned spins = 0;
            for (;;) { bool ok = true;
#pragma unroll
                for (int k = 0; k < 8; ++k) { const int j = (j0 + k < s) ? (j0 + k) : (s - 1); w[k] = __hip_atomic_load(aggq + (size_t)j * D, __ATOMIC_RELAXED, __HIP_MEMORY_SCOPE_AGENT); ok = ok && ((unsigned)w[k] != 0u); }
                if (__all(ok)) break;
                __builtin_amdgcn_s_sleep(4);
                if (++spins > (1u << 17)) break;
            }
#pragma unroll
            for (int k = 0; k < 8; ++k) { if (j0 + k < s) cin = __uint_as_float((unsigned)w[k]) * cin + __uint_as_float((unsigned)(w[k] >> 32)); }
        }
#pragma unroll
        for (int rb = 0; rb < 4; ++rb) {
            if (rb < 3) {
#pragma unroll
                for (int reg = 0; reg < 16; ++reg) gnxt[reg] = zg[(size_t)(32 * (rb + 1) + 8 * (reg >> 2) + 4 * hh + (reg & 3)) * NZ]; }
#pragma unroll
            for (int reg = 0; reg < 16; ++reg) { const int tok = 32 * rb + 8 * (reg >> 2) + 4 * hh + (reg & 3);
                const unsigned pk = hpk[rb * 16 + reg];
                const float hf = bflo(pk) + bfhi(pk) * cin;
                const float g = bf1(gcur[reg]);
                const float ge = g * __builtin_amdgcn_rcpf(1.0f + __expf(-1.5957691216f * (g + 0.044715f * g * g * g)));
                yo[(size_t)tok * KCAT] = (bf16_t)(cvt_pk_bf16(hf * ge, 0.f) & 0xffffu); }
#pragma unroll
            for (int reg = 0; reg < 16; ++reg) gcur[reg] = gnxt[reg];
        }
    }
    __syncthreads();
}
__device__ __forceinline__ void pool_unit(const Args& a, int l, int u, LAS unsigned char* lds, const int wv) {
    int tid_ = tid_of(wv); asm volatile("" : "+v"(tid_)); const int tid = tid_, lane = tid & 63, wave = __builtin_amdgcn_readfirstlane(tid >> 6);
    unsigned char* ws = opaque_ptr(a.ws);
    const bf16_t* z = (const bf16_t*)(ws + WS_Z);
    LAS unsigned char* zt = lds; LAS unsigned char* pt = lds + 143 * ZT_STRIDE;
    const int gp = u & 1, b = (u >> 1) & 7, s = u >> 4;
    const int t0 = b * SEQ + s * 128, p0 = s * 128;
    {   u32x4 sv[9];
#pragma unroll
        for (int k = 0; k < 9; ++k) { int idx = tid + NTHREADS * k; idx = idx < 143 * 32 ? idx : 143 * 32 - 1; const int r = idx >> 5, o = idx & 31; const int p = p0 - 15 + r; const int pc = p < 0 ? 0 : p;
            sv[k] = *(const u32x4*)(z + (size_t)(b * SEQ + pc) * NZ + ZO_XPOOL + gp * 256 + o * 8); if (p < 0) sv[k] = (u32x4){0u, 0u, 0u, 0u}; }
#pragma unroll
        for (int k = 0; k < 9; ++k) { int idx = tid + NTHREADS * k; idx = idx < 143 * 32 ? idx : 143 * 32 - 1; const int r = idx >> 5, o = idx & 31;
            *(LAS u32x4*)(zt + r * ZT_STRIDE + o * 16) = sv[k]; }
    }
    __syncthreads();
    {
        const int o = tid & 31, rb = tid >> 5; const int g = 2 * gp + (o >> 4); const int w = 2 << g;
#pragma unroll 1
        for (int i = 0; i < 8; ++i) { const int r = rb + 16 * i; float acc[8];
#pragma unroll
            for (int j = 0; j < 8; ++j) acc[j] = 0.f;
            for (int jj = 0; jj < w; ++jj) { const u32x4 v = *(const LAS u32x4*)(zt + (r + 15 - jj) * ZT_STRIDE + o * 16);
                acc[0] += bflo(v.x); acc[1] += bfhi(v.x); acc[2] += bflo(v.y); acc[3] += bfhi(v.y); acc[4] += bflo(v.z); acc[5] += bfhi(v.z); acc[6] += bflo(v.w); acc[7] += bfhi(v.w); }
            const int cnt = (p0 + r + 1 < w) ? (p0 + r + 1) : w; const float ic = 1.0f / (float)cnt;
            const u32x4 v = *(const LAS u32x4*)(zt + (r + 15) * ZT_STRIDE + o * 16);
            const float x0[8] = {bflo(v.x), bfhi(v.x), bflo(v.y), bfhi(v.y), bflo(v.z), bfhi(v.z), bflo(v.w), bfhi(v.w)};
#pragma unroll
            for (int j = 0; j < 8; ++j) acc[j] = acc[j] * ic - x0[j];
            u32x4 wv; wv.x = cvt_pk_bf16(acc[0], acc[1]); wv.y = cvt_pk_bf16(acc[2], acc[3]); wv.z = cvt_pk_bf16(acc[4], acc[5]); wv.w = cvt_pk_bf16(acc[6], acc[7]);
            *(LAS u32x4*)(pt + r * ZT_STRIDE + o * 16) = wv; }
    }
    __syncthreads();
    {
        const int gsel = wave >> 2, wc = wave & 3, g = 2 * gp + gsel, c31 = lane & 31, hh = lane >> 5;
        const int oc = g * 128 + 32 * wc + c31;
        const bf16_t* wb = (const bf16_t*)(ws + WS_WPOOL) + ((size_t)(l * 4 + g) * 128 + 32 * wc + c31) * 128 + 8 * hh;
        bf16x8 Bf[8];
#pragma unroll
        for (int ks = 0; ks < 8; ++ks) Bf[ks] = *(const bf16x8*)(wb + 16 * ks);
        const float psc = a.in[I_PSCALE][(size_t)l * 512 + oc];
        bf16_t* yo = (bf16_t*)(ws + WS_ACAT) + (size_t)t0 * KCAT + oc;
#pragma unroll 1
        for (int rb = 0; rb < 4; ++rb) {
            f32x16 acc;
#pragma unroll
            for (int r = 0; r < 16; ++r) acc[r] = 0.f;
            const LAS unsigned char* ap = pt + (32 * rb + c31) * ZT_STRIDE + (gsel * 128 + 8 * hh) * 2;
#pragma unroll
            for (int ks = 0; ks < 8; ++ks) { const bf16x8 A = *(const LAS bf16x8*)(ap + 32 * ks); acc = __builtin_amdgcn_mfma_f32_32x32x16_bf16(A, Bf[ks], acc, 0, 0, 0); }
#pragma unroll
            for (int reg = 0; reg < 16; ++reg) { const int tok = 32 * rb + 8 * (reg >> 2) + 4 * hh + (reg & 3);
                yo[(size_t)tok * KCAT] = (bf16_t)(cvt_pk_bf16(acc[reg] * psc, 0.f) & 0xffffu); }
        }
    }
    __syncthreads();
}

constexpr int PH_PER_LAYER = 9;
constexpr int N_PHASES = 1 + DEPTH * PH_PER_LAYER + 1;

__global__ void __launch_bounds__(NTHREADS, 2) fwd_kernel(Args a) {
    extern __shared__ __attribute__((aligned(16))) unsigned char lds_raw[];
    LAS unsigned char* lds = (LAS unsigned char*)lds_raw;
    const int wv = __builtin_amdgcn_readfirstlane(threadIdx.x >> 6); const int tid = threadIdx.x; const int G = gridDim.x;
    unsigned char* ws0 = a.ws;
    unsigned* ctl = (unsigned*)(ws0 + WS_CTL);
    volatile LAS unsigned* misc = (volatile LAS unsigned*)(lds + LDS_MISC);
    if (tid < 4) misc[tid] = 0u;
    __syncthreads();
    XcdBarrier bar; bar.bar = ctl + CW_BAR; bar.x = 0; bar.st = misc; bar.wv = wv;
#if MK_PER_PHASE
    const int lo = a.ph_lo, hi = a.ph_hi;
#else
    constexpr int lo = 0, hi = N_PHASES;
#endif
    if (hi - lo > 1) bar = xcd_barrier_post(ctl + CW_BAR, misc, wv);
#define IN(k) (lo <= (k) && (k) < hi)
#define SEAM(k) do { if (IN((k) + 1)) xcd_barrier(bar); } while (0)

    if (EN(0) && IN(0)) for (int rr = 0; rr < REPN(0); ++rr) { phase_prologue(a, lds, wv); SEAM(0); }

    for (int l = 0; l < DEPTH; ++l) {
        const int pb = 1 + l * PH_PER_LAYER;
        if (EN(1) && IN(pb + 0)) for (int rr = 0; rr < REPN(1); ++rr) { unsigned char* ws = opaque_ptr(ws0); const int bid = opaque_bid(); (void)bid; (void)ws; phase_a(a, l, lds, rr + 1 < REPN(1), wv); SEAM(pb + 0); }
        if (EN(2) && IN(pb + 1)) for (int rr = 0; rr < REPN(2); ++rr) { unsigned char* ws = opaque_ptr(ws0); const int bid = opaque_bid(); (void)bid; (void)ws;
            #if Z_FP8
            pg8::PlainSched S{(const char*)(ws + WS_H), (const char*)(ws + WS_WIN) + (size_t)l * NZ * 1024, 512, T / 256, NZ / 256, G, bid};
            pg8::EpiBf16 E{(bf16_t*)(ws + WS_Z), NZ, nullptr, (rr + 1 < REPN(2)) && (a.ph_lo == 0), 1.0f / WEIN_SCALE};
            pg8::gemm_phase<pg8::EpiBf16, pg8::PlainSched, true, true>(lds, 512, S, E, wv);
#else
            pg8::PlainSched S{(const char*)(ws + WS_H), (const char*)(ws + WS_WIN) + (size_t)l * NZ * 1024 * 2, 1024, T / 256, NZ / 256, G, bid};
            pg8::EpiBf16 E{(bf16_t*)(ws + WS_Z), NZ, nullptr, (rr + 1 < REPN(2)) && (a.ph_lo == 0), 1.0f};
            pg8::gemm_phase<pg8::EpiBf16, pg8::PlainSched, true>(lds, 1024, S, E, wv);
#endif
            SEAM(pb + 1);
        }
        if (EN(3) && IN(pb + 2)) for (int rr = 0; rr < REPN(3); ++rr) { unsigned char* ws = opaque_ptr(ws0); const int bid = opaque_bid(); (void)bid; (void)ws;
            for (int u = bid; u < 1024 + 512; u += G) { if (u < 1024) lru_unit(a, l, u, lds, wv); else pool_unit(a, l, u - 1024, lds, wv); }
            SEAM(pb + 2);
        }
        if (EN(5) && IN(pb + 4)) for (int rr = 0; rr < REPN(5); ++rr) { unsigned char* ws = opaque_ptr(ws0); const int bid = opaque_bid(); (void)bid; (void)ws;
            pg8::PlainSched S{(const char*)(ws + WS_ACAT), (const char*)(ws + WS_WCAT) + (size_t)l * 1024 * KCAT * 2, KCAT, T / 256, D / 256, G, bid};
            pg8::EpiMerged E{(bf16_t*)(ws + WS_MERGED), (const bf16_t*)(ws + WS_Z)};
            pg8::gemm_phase<pg8::EpiMerged, pg8::PlainSched, true>(lds, KCAT, S, E, wv);
            SEAM(pb + 4);
        }
        if (EN(6) && IN(pb + 5)) for (int rr = 0; rr < REPN(6); ++rr) { unsigned char* ws = opaque_ptr(ws0); const int bid = opaque_bid(); (void)bid; (void)ws;
            pg8::PlainSched S{(const char*)(ws + WS_MERGED), (const char*)(ws + WS_WOUT) + (size_t)l * 1024 * 1024 * 2, 1024, T / 256, D / 256, G, bid};
            pg8::EpiResid E{(float*)(ws + WS_XRES), (rr + 1 < REPN(6)) ? (float*)(ws + WS_OUTB) : (float*)(ws + WS_XRES), (const float*)(ws + WS_MOD) + (size_t)l * NBATCH * 6144 + 2 * D};
            pg8::gemm_phase<pg8::EpiResid, pg8::PlainSched, true>(lds, 1024, S, E, wv);
            SEAM(pb + 5);
        }
        if (EN(7) && IN(pb + 6)) for (int rr = 0; rr < REPN(7); ++rr) { unsigned char* ws = opaque_ptr(ws0); const int bid = opaque_bid(); (void)bid; (void)ws; phase_h(a, l, l + DEPTH * rr, lds, wv); SEAM(pb + 6); }
        if (EN(8) && IN(pb + 7)) for (int rr = 0; rr < REPN(8); ++rr) { unsigned char* ws = opaque_ptr(ws0); const int bid = opaque_bid(); (void)bid; (void)ws;
            moe_tables(a, l + DEPTH * (REPN(7) - 1), lds, wv);
            const MoeTab mt = moe_tab_ptrs(lds);
            MoeSched1 S{(const char*)(ws + WS_H), (const char*)(ws + WS_WEIN) + (size_t)l * NE * 2048 * 1024, (const int*)(ws + WS_TOKOF), mt, __builtin_amdgcn_readfirstlane(mt.tilestart[NE]), G, bid};
            pg8::EpiSwiglu E{(unsigned char*)(ws + WS_ACT), a.in[I_BEIN] + (size_t)l * NE * 2048, 1.0f / WEIN_SCALE};
            pg8::gemm_phase<pg8::EpiSwiglu, MoeSched1, true, true>(lds, 512, S, E, wv);
            SEAM(pb + 7);
        }
        if (EN(9) && IN(pb + 8)) for (int rr = 0; rr < REPN(9); ++rr) { unsigned char* ws = opaque_ptr(ws0); const int bid = opaque_bid(); (void)bid; (void)ws;
            moe_tables(a, l + DEPTH * (REPN(7) - 1), lds, wv);
            const MoeTab mt = moe_tab_ptrs(lds);
            MoeSched2 S{(const char*)(ws + WS_ACT), (const char*)(ws + WS_WEOUT) + (size_t)l * NE * 1024 * 1024, mt, __builtin_amdgcn_readfirstlane(mt.tilestart[NE]), G, bid};
            pg8::EpiMoeOut E{(bf16_t*)(ws + WS_OUTB), a.in[I_BEOUT] + (size_t)l * NE * D, 1.0f / WEIN_SCALE};
            pg8::gemm_phase<pg8::EpiMoeOut, MoeSched2, true, true>(lds, 512, S, E, wv);
            SEAM(pb + 8);
        }
    }
    if (EN(10) && IN(N_PHASES - 1)) phase_a(a, DEPTH, lds, false, wv);
#undef IN
#undef SEAM
}

extern "C" void kernel_launch(void* const* d_in, const int* in_sizes, int n_in, void* d_out, int out_size, void* d_ws, size_t ws_size, hipStream_t stream) {
    static int grid = 0;
    if (grid == 0) {
        if (n_in != 26 || out_size != T * D || ws_size < WS_END) { fprintf(stderr, "kernel_launch: unexpected problem (n_in %d out %d ws %zu)\n", n_in, out_size, ws_size); grid = -1; return; }
        int dev = 0, cus = 0, per_cu = 0;
        if (hipGetDevice(&dev) != hipSuccess || hipDeviceGetAttribute(&cus, hipDeviceAttributeMultiprocessorCount, dev) != hipSuccess) { grid = -1; return; }
        if (hipFuncSetAttribute((const void*)fwd_kernel, hipFuncAttributeMaxDynamicSharedMemorySize, LDS_BYTES) != hipSuccess) { fprintf(stderr, "kernel_launch: hipFuncSetAttribute failed\n"); grid = -1; return; }
        if (hipOccupancyMaxActiveBlocksPerMultiprocessor(&per_cu, (const void*)fwd_kernel, NTHREADS, LDS_BYTES) != hipSuccess || per_cu < 1) fprintf(stderr, "kernel_launch: occupancy query says %d\n", per_cu);
        (void)hipGetLastError();
        grid = cus;
    }
    if (grid < 0) return;
    if (hipMemsetAsync((char*)d_ws + WS_CTL, 0, CTL_ZERO_BYTES, stream) != hipSuccess) return;
    if (hipMemsetAsync((char*)d_ws + WS_AGG, 0, AGG_BYTES, stream) != hipSuccess) return;
    Args a{};
    for (int i = 0; i < 26; ++i) a.in[i] = (const float*)d_in[i];
    a.out = (float*)d_out; a.ws = (unsigned char*)d_ws;
#if MK_PER_PHASE
    for (int p = 0; p < N_PHASES; ++p) { a.ph_lo = p; a.ph_hi = p + 1; hipLaunchKernelGGL(fwd_kernel, dim3(grid), dim3(NTHREADS), LDS_BYTES, stream, a); }
#else
    a.ph_lo = 0; a.ph_hi = N_PHASES;
    hipLaunchKernelGGL(fwd_kernel, dim3(grid), dim3(NTHREADS), LDS_BYTES, stream, a);
#endif
    const hipError_t le = hipPeekAtLastError();
    if (le != hipSuccess) fprintf(stderr, "kernel_launch: launch failed: %s\n", hipGetErrorName(le));
}
```

```cpp
#include <hip/hip_runtime.h>
#include <cstdio>
#include <cstdint>

#define REP_MASK 0x0
#ifndef PH_MASK
#define PH_MASK 0x7ff
#endif
#define EN(b) ((PH_MASK >> (b)) & 1)
#ifndef REP_MASK
#define REP_MASK 0
#endif
#define REPN(b) ((((REP_MASK) >> (b)) & 1) ? 2 : 1)
#ifndef Z_I8
#define Z_I8 1
#endif
#ifndef Z_FP8
#define Z_FP8 0
#endif
#ifndef MK_PER_PHASE
#define MK_PER_PHASE 0
#endif

#define LAS __attribute__((address_space(3)))
typedef unsigned short bf16_t;
typedef short bf16x8 __attribute__((ext_vector_type(8)));
typedef float f32x4 __attribute__((ext_vector_type(4)));
typedef float f32x2 __attribute__((ext_vector_type(2)));
typedef float f32x16 __attribute__((ext_vector_type(16)));
typedef unsigned u32x4 __attribute__((ext_vector_type(4)));
typedef unsigned u32x2 __attribute__((ext_vector_type(2)));

constexpr int D = 1024, NBATCH = 8, SEQ = 4096, T = NBATCH * SEQ, DEPTH = 4;
constexpr int NZ = 4608, ZO_GLRU = 1024, ZO_XPOOL = 2048, ZO_GL0 = 2560, ZO_GL1 = 3584;
constexpr int NE = 32, TOPK = 4;
constexpr int KCAT = 1536;
constexpr int SLOT_CAP = T * TOPK + NE * 256;
constexpr int MAX_MT = SLOT_CAP / 256;
constexpr float NORM_EPS = 1e-6f;
constexpr float WEIN_SCALE = 64.0f;
constexpr int NTHREADS = 512, NWAVES = 8;

constexpr size_t MiB = 1u << 20;
constexpr size_t WS_CTL = 0, CTL_ZERO_BYTES = 256 * 1024;
constexpr size_t WS_MOD = 1 * MiB;
constexpr size_t WS_CB = 2 * MiB;
constexpr size_t WS_AGG = 72 * MiB;
constexpr size_t AGG_BYTES = (size_t)DEPTH * NBATCH * 32 * D * 8;
constexpr size_t WS_WRS = 3 * MiB;
constexpr size_t WS_HSC = 4 * MiB;
constexpr size_t WS_WINSC = 5 * MiB;
constexpr size_t WS_TOKOF = 6 * MiB;
constexpr size_t WS_SLOTINFO = 10 * MiB;
constexpr size_t WS_WGT = 11 * MiB;
constexpr size_t WS_WRG = 12 * MiB;
constexpr size_t WS_WPOOL = 14 * MiB;
constexpr size_t WS_WIN = 16 * MiB;
constexpr size_t WS_WCAT = 52 * MiB;
constexpr size_t WS_WOUT = 64 * MiB;
constexpr size_t WS_WEIN = 128 * MiB;
constexpr size_t WS_WEOUT = 640 * MiB;
constexpr size_t WS_XRES = 896 * MiB;
constexpr size_t WS_H = 1024 * MiB;
constexpr size_t WS_Z = 1088 * MiB;
constexpr size_t WS_ACAT = 1376 * MiB;
constexpr size_t WS_MERGED = 1472 * MiB;
constexpr size_t WS_ACT = 1536 * MiB;
constexpr size_t WS_OUTB = 1808 * MiB;
constexpr size_t WS_END = 2080 * MiB;
static_assert(WS_ACT + (size_t)SLOT_CAP * 1024 * 2 <= WS_OUTB && WS_OUTB + (size_t)SLOT_CAP * 1024 * 2 <= WS_END, "ws map");
constexpr int CW_BAR = 4096;
constexpr int CW_CNT = 8192;

constexpr int LDS_BYTES = 163840;
constexpr int LDS_TAB = 131072;
constexpr int LDS_NVA = 131072 + 8192;
constexpr int LDS_MISC = LDS_BYTES - 256;

__device__ __forceinline__ unsigned cvt_pk_bf16(float lo, float hi) { unsigned r; asm("v_cvt_pk_bf16_f32 %0, %1, %2" : "=v"(r) : "v"(lo), "v"(hi)); return r; }
__device__ __forceinline__ float bflo(unsigned w) { return __uint_as_float(w << 16); }
__device__ __forceinline__ float bfhi(unsigned w) { return __uint_as_float(w & 0xffff0000u); }
__device__ __forceinline__ float bf1(bf16_t w) { return __uint_as_float(((unsigned)w) << 16); }
__device__ __forceinline__ float sigmoidf_(float x) { return __builtin_amdgcn_rcpf(1.0f + __expf(-x)); }
__device__ __forceinline__ float shflx(float v, int mask, int lane) { return __int_as_float(__builtin_amdgcn_ds_bpermute((lane ^ mask) << 2, __float_as_int(v))); }
__device__ __forceinline__ float wave_sum(float v, int lane) {
#pragma unroll
    for (int o = 1; o < 64; o <<= 1) v += shflx(v, o, lane);
    return v;
}
__device__ __forceinline__ int tid_of(int wv) { int l; asm volatile("v_mbcnt_lo_u32_b32 %0, -1, 0\n\tv_mbcnt_hi_u32_b32 %0, -1, %0" : "=v"(l)); return wv * 64 + l; }
__device__ __forceinline__ int opaque_bid() { int b = blockIdx.x; asm volatile("" : "+s"(b)); return b; }
__device__ __forceinline__ unsigned char* opaque_ptr(unsigned char* p) { size_t z = 0; asm volatile("" : "+s"(z)); return p + z; }
#define LDS_WAIT() asm volatile("s_waitcnt lgkmcnt(0)" ::: "memory")
#define VM_WAIT() asm volatile("s_waitcnt vmcnt(0)" ::: "memory")

namespace pg8 {
constexpr int BM = 256, BK = 64, HALF = 128, HTB = HALF * BK * 2, STAGE_BYTES = 8 * HTB, NXCD = 8, WGM = 8;
__host__ __device__ __forceinline__ int lds_byte(int r, int c) { const int st = (r >> 4) * 2 + (c >> 5), rr = r & 15, cc = c & 31, ob = rr * 64 + cc * 2; return st * 1024 + (ob ^ (((ob >> 9) & 1) << 5)); }
__host__ __device__ __forceinline__ void stage_rc(int b, int& R, int& C) { const int st = b / 1024, sb = b % 1024, swz = sb ^ (((sb >> 9) & 1) << 5); R = (st >> 1) * 16 + swz / 64; C = (st & 1) * 32 + (swz % 64) / 2; }
__host__ __device__ __forceinline__ int perm32(int rho) { const int n = rho >> 4, i = rho & 15; return 8 * (i >> 2) + 4 * n + (i & 3); }

struct Unit { int pm, pn, e, j, row0, rows; };
typedef int v8i32 __attribute__((ext_vector_type(8)));
typedef int v4i32_t __attribute__((ext_vector_type(4)));
__device__ __forceinline__ v8i32 cat8(bf16x8 lo, bf16x8 hi) { typedef int v4i32 __attribute__((ext_vector_type(4))); const v4i32 a = __builtin_bit_cast(v4i32, lo), b = __builtin_bit_cast(v4i32, hi); return (v8i32){a.x, a.y, a.z, a.w, b.x, b.y, b.z, b.w}; }

__device__ __forceinline__ bool order_map(int i, int G, int c, int nM, int nN, int& pm, int& pn) {
    const int nwg = nM * nN; const int L = i * G + c; if (L >= nwg) return false;
    int wgid = L; { const int q = nwg / NXCD, r = nwg % NXCD, xcd = wgid % NXCD, off = wgid / NXCD; wgid = (xcd < r ? xcd * (q + 1) : r * (q + 1) + (xcd - r) * q) + off; }
    const int nig = WGM * nN, gid = wgid / nig, fm = gid * WGM, gsz = (nM - fm) < WGM ? (nM - fm) : WGM;
    pm = fm + ((wgid % nig) % gsz); pn = (wgid % nig) / gsz; return true;
}

struct PlainSched {
    static constexpr bool DYN_A = false;
    const char* A; const char* Bt; int K, nM, nN, G, c;
    __device__ __forceinline__ bool next(int i, Unit& u) const { int pm, pn; if (!order_map(i, G, c, nM, nN, pm, pn)) return false; u.pm = pm; u.pn = pn; u.e = 0; u.j = 0; u.row0 = pm * BM; u.rows = BM; return true; }
    __device__ __forceinline__ const char* a_ptr() const { return A; }
    __device__ __forceinline__ const char* b_ptr() const { return Bt; }
    __device__ __forceinline__ unsigned a_off(const Unit& u) const { return (unsigned)u.row0 * (unsigned)K * 2u; }
    __device__ __forceinline__ unsigned b_off(const Unit& u) const { return (unsigned)u.pn * (unsigned)(BM * K * 2); }
    __device__ __forceinline__ void a_voff(const Unit&, unsigned (&v)[2][2], int wv) const {
        int tid = tid_of(wv); asm volatile("" : "+v"(tid));
#pragma unroll
        for (int i = 0; i < 2; ++i) { int R, C; stage_rc(tid * 16 + i * 8192, R, C);
#pragma unroll
            for (int h = 0; h < 2; ++h) v[h][i] = (unsigned)((h * HALF + R) * K + C) * 2u; }
    }
};

template <class Epi, class Sched, bool ALIGN_EPI, int MODE = 0>
__device__ __forceinline__ void gemm_phase(LAS unsigned char* lds, const int K, const Sched& S, const Epi& E, const int wv) {
    asm volatile("" : "+s"(lds));
    int tid = tid_of(wv); asm volatile("" : "+v"(tid));
    const int wid = __builtin_amdgcn_readfirstlane(tid >> 6), lane = tid & 63, wr = wid >> 2, wc = wid & 3, fr = lane & 15, fq = lane >> 4;
    const int nt = K / BK;
    unsigned voffB;
    { int R, C; stage_rc(tid * 16, R, C); const int Rb = Epi::PERM ? ((R & ~31) + perm32(R & 31)) : R; voffB = (unsigned)(Rb * K + C) * 2u; }
    const unsigned q64 = (unsigned)(64 * K * 2);
    const unsigned kstep = (unsigned)(BK * 2);
    const unsigned hstep = (unsigned)(HALF * K * 2);
    const __amdgpu_buffer_rsrc_t rsA = __builtin_amdgcn_make_buffer_rsrc((void*)S.a_ptr(), 0, 0xffffffff, 0x00020000);
    const __amdgpu_buffer_rsrc_t rsB = __builtin_amdgcn_make_buffer_rsrc((void*)S.b_ptr(), 0, 0xffffffff, 0x00020000);
    const unsigned ldsw = (unsigned)wid * 1024u;
    const int aoff = lds_byte(wr * 64 + fr, fq * 8), boff = lds_byte(wc * 32 + fr, fq * 8);
#define PG8_SA(b, h) (((b) * 2 + (h)) * HTB)
#define PG8_SB(b, h) ((4 + (b) * 2 + (h)) * HTB)
#define PG8_STAGE_(rs, bufoff, v0, s0, v1, s1) do { \
        __builtin_amdgcn_raw_ptr_buffer_load_lds(rs, (LAS void*)(lds + (bufoff) + ldsw), 16, (v0), (s0), 0, 0); \
        __builtin_amdgcn_raw_ptr_buffer_load_lds(rs, (LAS void*)(lds + (bufoff) + ldsw + 8192), 16, (v1), (s1), 0, 0); } while (0)
#define PG8_STAGE_B(bufoff, soff, unused) PG8_STAGE_(rsB, bufoff, voffB, (soff), voffB, (soff) + q64)
#define PG8_STAGE_A(bufoff, soff, h) do { if constexpr (Sched::DYN_A) PG8_STAGE_(rsA, bufoff, cvA[h][0], (soff), cvA[h][1], (soff)); \
        else PG8_STAGE_(rsA, bufoff, cvA[0][0], (soff) + (h) * 2u * q64, cvA[0][0], (soff) + (h) * 2u * q64 + q64); } while (0)
#define PG8_LDA(dst, b, h) do { _Pragma("unroll") for (int m = 0; m < 4; ++m) _Pragma("unroll") for (int k = 0; k < 2; ++k) dst[m][k] = *(const LAS bf16x8*)(lds + PG8_SA(b, h) + aoff + m * 2048 + k * 1024); } while (0)
#define PG8_LDB(dst, b, h) do { _Pragma("unroll") for (int n = 0; n < 2; ++n) _Pragma("unroll") for (int k = 0; k < 2; ++k) dst[n][k] = *(const LAS bf16x8*)(lds + PG8_SB(b, h) + boff + n * 2048 + k * 1024); } while (0)
#define PG8_MMA(ai, bj, At, Bt) do { __builtin_amdgcn_s_setprio(1); _Pragma("unroll") for (int m = 0; m < 4; ++m) _Pragma("unroll") for (int n = 0; n < 2; ++n) { \
        if constexpr (MODE == 1) { acc[ai][bj][m][n] = __builtin_amdgcn_mfma_scale_f32_16x16x128_f8f6f4(cat8(Bt[n][0], Bt[n][1]), cat8(At[m][0], At[m][1]), acc[ai][bj][m][n], 0, 0, 0, 0x7f7f7f7f, 0, 0x7f7f7f7f); } \
        else if constexpr (MODE == 2) { _Pragma("unroll") for (int k = 0; k < 2; ++k) acc[ai][bj][m][n] = __builtin_bit_cast(f32x4, __builtin_amdgcn_mfma_i32_16x16x64_i8(__builtin_bit_cast(v4i32_t, Bt[n][k]), __builtin_bit_cast(v4i32_t, At[m][k]), __builtin_bit_cast(v4i32_t, acc[ai][bj][m][n]), 0, 0, 0)); } \
        else { _Pragma("unroll") for (int k = 0; k < 2; ++k) acc[ai][bj][m][n] = __builtin_amdgcn_mfma_f32_16x16x32_bf16(Bt[n][k], At[m][k], acc[ai][bj][m][n], 0, 0, 0); } } \
        __builtin_amdgcn_s_setprio(0); } while (0)
#define PG8_WAIT_V(n) asm volatile("s_waitcnt vmcnt(" #n ")" ::: "memory")
#define PG8_WAIT_L(n) asm volatile("s_waitcnt lgkmcnt(" #n ")" ::: "memory")
#define PG8_BAR __builtin_amdgcn_s_barrier()
#define PG8_SCHED __builtin_amdgcn_sched_barrier(0)
    Unit cur, nxt; int ui = 0;
    if (!S.next(0, cur)) return;
    f32x4 acc[2][2][4][2];
    { float z0 = 0.f; asm volatile("" : "+v"(z0));
#pragma unroll
    for (int a = 0; a < 2; ++a)
#pragma unroll
        for (int b = 0; b < 2; ++b)
#pragma unroll
            for (int m = 0; m < 4; ++m)
#pragma unroll
                for (int n = 0; n < 2; ++n) acc[a][b][m][n] = (f32x4){z0, z0, z0, z0}; }
    bf16x8 At[4][2], B0[2][2], B1[2][2];
    unsigned cvA[2][2];
    LAS u32x4* nvp = (LAS u32x4*)(lds + LDS_NVA) + tid;
    S.a_voff(cur, cvA, wv);
    unsigned cA = S.a_off(cur), cB = S.b_off(cur);
    PG8_STAGE_B(PG8_SB(0, 0), cB, voffB); PG8_STAGE_B(PG8_SB(0, 1), cB + hstep, voffB); PG8_STAGE_A(PG8_SA(0, 0), cA, 0); PG8_STAGE_A(PG8_SA(0, 1), cA, 1);
    if (wr == 1) PG8_BAR;
    PG8_WAIT_V(2); PG8_BAR;
    PG8_STAGE_B(PG8_SB(1, 0), cB + kstep, voffB); PG8_STAGE_A(PG8_SA(1, 0), cA + kstep, 0); PG8_STAGE_B(PG8_SB(1, 1), cB + hstep + kstep, voffB);
    PG8_WAIT_V(6); PG8_BAR;
    for (;;) {
        const bool has_next = S.next(ui + 1, nxt);
        unsigned nA = cA, nB = cB;
        if (has_next) { nA = S.a_off(nxt); nB = S.b_off(nxt); }
        if constexpr (Sched::DYN_A) { unsigned nv[2][2];
            if (has_next) S.a_voff(nxt, nv, wv); else {
#pragma unroll
                for (int h = 0; h < 2; ++h)
#pragma unroll
                    for (int i = 0; i < 2; ++i) nv[h][i] = cvA[h][i]; }
            *nvp = (u32x4){nv[0][0], nv[0][1], nv[1][0], nv[1][1]}; }
#pragma unroll 1
        for (int t = 0; t < nt; t += 2) {
            const bool last = (t == nt - 2);
            const unsigned a1 = cA + (unsigned)(t + 1) * kstep;
            const unsigned a2 = last ? nA : cA + (unsigned)(t + 2) * kstep, b2 = last ? nB : cB + (unsigned)(t + 2) * kstep;
            const unsigned a3 = a2 + kstep, b3 = b2 + kstep;
            unsigned nx1[2] = {cvA[1][0], cvA[1][1]};
            if constexpr (Sched::DYN_A) { if (last) { const u32x4 q = *nvp; cvA[0][0] = q.x; cvA[0][1] = q.y; nx1[0] = q.z; nx1[1] = q.w; } }
            if constexpr (Epi::HOOK_T >= 0) { if (t == Epi::HOOK_T) E.mid(acc, cur, wr, wc, fr, fq); }
            PG8_LDB(B0, 0, 0); PG8_LDB(B1, 0, 1); PG8_SCHED; PG8_LDA(At, 0, 0); PG8_STAGE_A(PG8_SA(1, 1), a1, 1);
            if constexpr (Sched::DYN_A) { cvA[1][0] = nx1[0]; cvA[1][1] = nx1[1]; }
            PG8_WAIT_V(8); PG8_WAIT_L(0); PG8_BAR; PG8_MMA(0, 0, At, B0); PG8_MMA(0, 1, At, B1); PG8_BAR; PG8_SCHED;
            PG8_LDA(At, 0, 1); PG8_STAGE_B(PG8_SB(0, 0), b2, voffB); PG8_STAGE_B(PG8_SB(0, 1), b2 + hstep, voffB); PG8_STAGE_A(PG8_SA(0, 0), a2, 0);
            PG8_WAIT_V(8); PG8_WAIT_L(0); PG8_BAR; PG8_MMA(1, 0, At, B0); PG8_MMA(1, 1, At, B1); PG8_BAR; PG8_SCHED;
            PG8_LDB(B0, 1, 0); PG8_LDB(B1, 1, 1); PG8_SCHED; PG8_LDA(At, 1, 0); PG8_STAGE_A(PG8_SA(0, 1), a2, 1);
            PG8_WAIT_V(8); PG8_WAIT_L(0); PG8_BAR; PG8_MMA(0, 0, At, B0); PG8_MMA(0, 1, At, B1); PG8_BAR; PG8_SCHED;
            PG8_LDA(At, 1, 1); PG8_STAGE_B(PG8_SB(1, 0), b3, voffB); PG8_STAGE_B(PG8_SB(1, 1), b3 + hstep, voffB); PG8_STAGE_A(PG8_SA(1, 0), a3, 0);
            PG8_WAIT_V(8); PG8_WAIT_L(0); PG8_BAR; PG8_MMA(1, 0, At, B0); PG8_MMA(1, 1, At, B1); PG8_BAR; PG8_SCHED;
        }
        if constexpr (ALIGN_EPI) { if (wr == 0) PG8_BAR; }
        E(acc, cur, wr, wc, fr, fq);
        if (!has_next) break;
        { float z0 = 0.f; asm volatile("" : "+v"(z0));
#pragma unroll
        for (int a = 0; a < 2; ++a)
#pragma unroll
            for (int b = 0; b < 2; ++b)
#pragma unroll
                for (int m = 0; m < 4; ++m)
#pragma unroll
                    for (int n = 0; n < 2; ++n) acc[a][b][m][n] = (f32x4){z0, z0, z0, z0}; }
        cur = nxt; cA = nA; cB = nB; ++ui;
        if constexpr (ALIGN_EPI) { if (wr == 1) PG8_BAR; }
    }
    PG8_WAIT_V(0);
    if constexpr (!ALIGN_EPI) { if (wr == 0) PG8_BAR; }
    PG8_BAR;
#undef PG8_SA
#undef PG8_SB
#undef PG8_STAGE_
#undef PG8_STAGE_A
#undef PG8_STAGE_B
#undef PG8_LDA
#undef PG8_LDB
#undef PG8_MMA
#undef PG8_WAIT_V
#undef PG8_WAIT_L
#undef PG8_BAR
#undef PG8_SCHED
}

struct EpiBf16 {
    static constexpr bool PERM = true; static constexpr int HOOK_T = -1;
    bf16_t* O; int ldc; const float* bias; int noepi; float scale;
    __device__ __forceinline__ void mid(f32x4 (&)[2][2][4][2], const Unit&, int, int, int, int) const {}
    __device__ __forceinline__ void operator()(const f32x4 (&acc)[2][2][4][2], const Unit& u, int wr, int wc, int fr, int fq) const {
        { const int l_ = tid_of(0); fr = l_ & 15; fq = l_ >> 4; }
        if (noepi) { if (acc[0][0][0][0][0] == 1.2345e-30f) O[0] = 0; return; }
        int row0 = u.row0 + wr * 64 + fr; asm volatile("" : "+v"(row0)); int col0 = u.pn * BM + wc * 32 + 8 * fq; asm volatile("" : "+v"(col0));
        f32x4 bv[2][2];
#pragma unroll
        for (int bj = 0; bj < 2; ++bj)
#pragma unroll
            for (int n = 0; n < 2; ++n) bv[bj][n] = bias ? *(const f32x4*)(bias + col0 + bj * HALF + 4 * n) : (f32x4){0.f, 0.f, 0.f, 0.f};
#pragma unroll
        for (int ai = 0; ai < 2; ++ai)
#pragma unroll
            for (int m = 0; m < 4; ++m) { bf16_t* rowp = O + (size_t)(row0 + ai * HALF + m * 16) * ldc + col0;
#pragma unroll
                for (int bj = 0; bj < 2; ++bj) { const f32x4 v0 = acc[ai][bj][m][0] * scale + bv[bj][0], v1 = acc[ai][bj][m][1] * scale + bv[bj][1];
                    u32x4 w; w.x = cvt_pk_bf16(v0[0], v0[1]); w.y = cvt_pk_bf16(v0[2], v0[3]); w.z = cvt_pk_bf16(v1[0], v1[1]); w.w = cvt_pk_bf16(v1[2], v1[3]);
                    *(u32x4*)(rowp + bj * HALF) = w; } }
    }
};
struct EpiZI8 {
    static constexpr bool PERM = true; static constexpr int HOOK_T = -1;
    bf16_t* O; const float* rsc; const float* csc;
    __device__ __forceinline__ void mid(f32x4 (&)[2][2][4][2], const Unit&, int, int, int, int) const {}
    __device__ __forceinline__ void operator()(const f32x4 (&acc)[2][2][4][2], const Unit& u, int wr, int wc, int fr, int fq) const {
        { const int l_ = tid_of(0); fr = l_ & 15; fq = l_ >> 4; }
        int row0 = u.row0 + wr * 64 + fr; asm volatile("" : "+v"(row0)); int col0 = u.pn * BM + wc * 32 + 8 * fq; asm volatile("" : "+v"(col0));
        f32x4 cs[2][2];
#pragma unroll
        for (int bj = 0; bj < 2; ++bj)
#pragma unroll
            for (int n = 0; n < 2; ++n) cs[bj][n] = *(const f32x4*)(csc + col0 + bj * HALF + 4 * n);
#pragma unroll
        for (int ai = 0; ai < 2; ++ai)
#pragma unroll
            for (int m = 0; m < 4; ++m) { const int r = row0 + ai * HALF + m * 16; const float rs = rsc[r]; bf16_t* rowp = O + (size_t)r * NZ + col0;
#pragma unroll
                for (int bj = 0; bj < 2; ++bj) { const v4i32_t i0 = __builtin_bit_cast(v4i32_t, acc[ai][bj][m][0]), i1 = __builtin_bit_cast(v4i32_t, acc[ai][bj][m][1]);
                    const f32x4 v0 = (f32x4){(float)i0.x, (float)i0.y, (float)i0.z, (float)i0.w} * rs * cs[bj][0], v1 = (f32x4){(float)i1.x, (float)i1.y, (float)i1.z, (float)i1.w} * rs * cs[bj][1];
                    u32x4 w; w.x = cvt_pk_bf16(v0[0], v0[1]); w.y = cvt_pk_bf16(v0[2], v0[3]); w.z = cvt_pk_bf16(v1[0], v1[1]); w.w = cvt_pk_bf16(v1[2], v1[3]);
                    *(u32x4*)(rowp + bj * HALF) = w; } }
    }
};
struct EpiMerged {
    static constexpr bool PERM = true; static constexpr int HOOK_T = 8;
    bf16_t* O; const bf16_t* Z;
    __device__ __forceinline__ void mid(f32x4 (&acc)[2][2][4][2], const Unit& u, int wr, int wc, int fr, int fq) const {
        { const int l_ = tid_of(0); fr = l_ & 15; fq = l_ >> 4; }
        int row0 = u.row0 + wr * 64 + fr; asm volatile("" : "+v"(row0)); int col0 = u.pn * BM + wc * 32 + 8 * fq; asm volatile("" : "+v"(col0));
#pragma unroll
        for (int ai = 0; ai < 2; ++ai) {
            u32x4 l0[4][2], l1[4][2];
#pragma unroll
            for (int m = 0; m < 4; ++m) { const bf16_t* zr = Z + (size_t)(row0 + ai * HALF + m * 16) * NZ + col0;
#pragma unroll
                for (int bj = 0; bj < 2; ++bj) { l0[m][bj] = *(const u32x4*)(zr + ZO_GL0 + bj * HALF); l1[m][bj] = *(const u32x4*)(zr + ZO_GL1 + bj * HALF); } }
#pragma unroll
            for (int m = 0; m < 4; ++m)
#pragma unroll
                for (int bj = 0; bj < 2; ++bj) {
                    const unsigned a0[4] = {l0[m][bj].x, l0[m][bj].y, l0[m][bj].z, l0[m][bj].w}, a1[4] = {l1[m][bj].x, l1[m][bj].y, l1[m][bj].z, l1[m][bj].w};
#pragma unroll
                    for (int q = 0; q < 4; ++q) {
                        const float r0 = (1.0f + __expf(-bflo(a0[q]))) * __builtin_amdgcn_rcpf(1.0f + __expf(-bflo(a1[q])));
                        const float r1 = (1.0f + __expf(-bfhi(a0[q]))) * __builtin_amdgcn_rcpf(1.0f + __expf(-bfhi(a1[q])));
                        acc[ai][bj][m][q >> 1][(q & 1) * 2 + 0] *= r0; acc[ai][bj][m][q >> 1][(q & 1) * 2 + 1] *= r1; } }
            asm volatile("" ::: "memory"); }
    }
    __device__ __forceinline__ void operator()(const f32x4 (&acc)[2][2][4][2], const Unit& u, int wr, int wc, int fr, int fq) const {
        { const int l_ = tid_of(0); fr = l_ & 15; fq = l_ >> 4; }
        int row0 = u.row0 + wr * 64 + fr; asm volatile("" : "+v"(row0)); int col0 = u.pn * BM + wc * 32 + 8 * fq; asm volatile("" : "+v"(col0));
        u32x4 l0[2][4][2];
#pragma unroll
        for (int ai = 0; ai < 2; ++ai)
#pragma unroll
            for (int m = 0; m < 4; ++m) { const bf16_t* zr = Z + (size_t)(row0 + ai * HALF + m * 16) * NZ + col0;
#pragma unroll
                for (int bj = 0; bj < 2; ++bj) l0[ai][m][bj] = *(const u32x4*)(zr + ZO_GL0 + bj * HALF); }
#pragma unroll
        for (int ai = 0; ai < 2; ++ai)
#pragma unroll
            for (int m = 0; m < 4; ++m) { bf16_t* orow = O + (size_t)(row0 + ai * HALF + m * 16) * D + col0;
#pragma unroll
                for (int bj = 0; bj < 2; ++bj) {
                    const unsigned a0[4] = {l0[ai][m][bj].x, l0[ai][m][bj].y, l0[ai][m][bj].z, l0[ai][m][bj].w};
                    float o[8];
#pragma unroll
                    for (int q = 0; q < 4; ++q) { o[2 * q] = acc[ai][bj][m][q >> 1][(q & 1) * 2 + 0] * sigmoidf_(bflo(a0[q])); o[2 * q + 1] = acc[ai][bj][m][q >> 1][(q & 1) * 2 + 1] * sigmoidf_(bfhi(a0[q])); }
                    u32x4 w; w.x = cvt_pk_bf16(o[0], o[1]); w.y = cvt_pk_bf16(o[2], o[3]); w.z = cvt_pk_bf16(o[4], o[5]); w.w = cvt_pk_bf16(o[6], o[7]);
                    *(u32x4*)(orow + bj * HALF) = w; } }
    }
};
struct EpiResid {
    static constexpr bool PERM = false; static constexpr int HOOK_T = -1;
    float* X; float* XO; const float* gate;
    __device__ __forceinline__ void mid(f32x4 (&)[2][2][4][2], const Unit&, int, int, int, int) const {}
    __device__ __forceinline__ void operator()(const f32x4 (&acc)[2][2][4][2], const Unit& u, int wr, int wc, int fr, int fq) const {
        { const int l_ = tid_of(0); fr = l_ & 15; fq = l_ >> 4; }
        int row0 = u.row0 + wr * 64 + fr; asm volatile("" : "+v"(row0)); int col0 = u.pn * BM + wc * 32 + 4 * fq; asm volatile("" : "+v"(col0));
        const float* gp = gate + (size_t)(u.row0 / SEQ) * (6 * D) + col0;
        f32x4 gv[2][2];
#pragma unroll
        for (int bj = 0; bj < 2; ++bj)
#pragma unroll
            for (int n = 0; n < 2; ++n) gv[bj][n] = *(const f32x4*)(gp + bj * HALF + n * 16);
#pragma unroll
        for (int ai = 0; ai < 2; ++ai) {
            f32x4 xv[4][2][2];
#pragma unroll
            for (int m = 0; m < 4; ++m) { const float* rowp = X + (size_t)(row0 + ai * HALF + m * 16) * D + col0;
#pragma unroll
                for (int bj = 0; bj < 2; ++bj)
#pragma unroll
                    for (int n = 0; n < 2; ++n) xv[m][bj][n] = *(const f32x4*)(rowp + bj * HALF + n * 16); }
#pragma unroll
            for (int m = 0; m < 4; ++m) { float* rowo = XO + (size_t)(row0 + ai * HALF + m * 16) * D + col0;
#pragma unroll
                for (int bj = 0; bj < 2; ++bj)
#pragma unroll
                    for (int n = 0; n < 2; ++n) *(f32x4*)(rowo + bj * HALF + n * 16) = xv[m][bj][n] + gv[bj][n] * acc[ai][bj][m][n]; }
            asm volatile("" ::: "memory"); }
    }
};
struct EpiSwiglu {
    static constexpr bool PERM = true; static constexpr int HOOK_T = -1;
    unsigned char* ACT; const float* bias; float wscale;
    __device__ __forceinline__ void mid(f32x4 (&)[2][2][4][2], const Unit&, int, int, int, int) const {}
    __device__ __forceinline__ void operator()(const f32x4 (&acc)[2][2][4][2], const Unit& u, int wr, int wc, int fr, int fq) const {
        { const int l_ = tid_of(0); fr = l_ & 15; fq = l_ >> 4; }
        int row0 = u.row0 + wr * 64 + fr; asm volatile("" : "+v"(row0)); int cc = u.pn * HALF + wc * 32 + 8 * fq; asm volatile("" : "+v"(cc));
        const float* bp = bias + (size_t)u.e * 2048 + cc;
        f32x4 bg[2], bu[2];
#pragma unroll
        for (int n = 0; n < 2; ++n) { bg[n] = *(const f32x4*)(bp + 4 * n); bu[n] = *(const f32x4*)(bp + 1024 + 4 * n); }
#pragma unroll
        for (int ai = 0; ai < 2; ++ai)
#pragma unroll
            for (int m = 0; m < 4; ++m) { unsigned char* rowp = ACT + (size_t)(row0 + ai * HALF + m * 16) * D + cc;
                float o[8];
#pragma unroll
                for (int n = 0; n < 2; ++n)
#pragma unroll
                    for (int j = 0; j < 4; ++j) { float g = acc[ai][0][m][n][j] * wscale + bg[n][j], up = acc[ai][1][m][n][j] * wscale + bu[n][j];
                        g = fminf(g, 7.0f); up = fminf(fmaxf(up, -7.0f), 7.0f);
                        o[4 * n + j] = g * sigmoidf_(1.702f * g) * (up + 1.0f); }
                int w0 = 0, w1 = 0;
                w0 = __builtin_amdgcn_cvt_pk_fp8_f32(o[0], o[1], w0, false); w0 = __builtin_amdgcn_cvt_pk_fp8_f32(o[2], o[3], w0, true);
                w1 = __builtin_amdgcn_cvt_pk_fp8_f32(o[4], o[5], w1, false); w1 = __builtin_amdgcn_cvt_pk_fp8_f32(o[6], o[7], w1, true);
                *(u32x2*)rowp = (u32x2){(unsigned)w0, (unsigned)w1}; }
    }
};
struct EpiMoeOut {
    static constexpr bool PERM = true; static constexpr int HOOK_T = -1;
    bf16_t* O; const float* bias; float wscale;
    __device__ __forceinline__ void mid(f32x4 (&)[2][2][4][2], const Unit&, int, int, int, int) const {}
    __device__ __forceinline__ void operator()(const f32x4 (&acc)[2][2][4][2], const Unit& u, int wr, int wc, int fr, int fq) const {
        const EpiBf16 e{O, D, bias + (size_t)u.e * D, 0, wscale}; e(acc, u, wr, wc, fr, fq);
    }
};
}

#define XB_TMO      128
#define XB_XCNT(j)  (256  + 64 * (j))
#define XB_XSUB(j)  (1280 + 64 * (j))
#define XB_XGEN(j)  (2304 + 64 * (j))
#define XB_TOP      3328
#define XB_TOPGEN   3392
#define XCD_BAR_WORDS 3456
#define XB_SPIN_CAP (1u << 18)
__device__ __forceinline__ unsigned xb_ld(unsigned* p)              { return __hip_atomic_load(p, __ATOMIC_RELAXED, __HIP_MEMORY_SCOPE_AGENT); }
__device__ __forceinline__ unsigned xb_add(unsigned* p, unsigned v) { return __hip_atomic_fetch_add(p, v, __ATOMIC_RELAXED, __HIP_MEMORY_SCOPE_AGENT); }
__device__ __forceinline__ unsigned xb_xcc_id() { return (unsigned)__builtin_amdgcn_s_getreg((3 << 11) | 20) & 0xFu; }
#define XB_SPIN(cond, bar) do { unsigned _sp = 0; while (cond) { __builtin_amdgcn_s_sleep(1); \
    if ((++_sp & 255u) == 0u) { if (xb_ld(&(bar)[XB_TMO])) break; if (_sp > XB_SPIN_CAP) { atomicAdd(&(bar)[XB_TMO], 1u); break; } } } } while (0)
struct XcdBarrier { unsigned* bar; unsigned x; volatile LAS unsigned* st; int wv; };
__device__ __forceinline__ XcdBarrier xcd_barrier_post(unsigned* bar, volatile LAS unsigned* st, int wv) {
    XcdBarrier b; b.bar = bar; b.x = xb_xcc_id(); b.st = st; b.wv = wv;
    if (tid_of(wv) == 0) (void)xb_add(&bar[XB_XCNT(b.x)], 1u);
    return b;
}
__device__ __forceinline__ void xcd_barrier_complete(unsigned* bar, unsigned x, unsigned& nloc, unsigned& nx) {
    const unsigned G = gridDim.x * gridDim.y * gridDim.z;
    unsigned sum, cnt, mine, sp = 0u;
    for (;;) {
        sum = 0u; cnt = 0u; mine = 0u;
#pragma unroll
        for (unsigned j = 0; j < 16; ++j) { const unsigned c = xb_ld(&bar[XB_XCNT(j)]); sum += c; cnt += (c > 0u) ? 1u : 0u; mine = (j == x) ? c : mine; }
        if (sum == G) break;
        __builtin_amdgcn_s_sleep(1);
        if ((++sp & 255u) == 0u) { if (xb_ld(&bar[XB_TMO])) break; if (sp > XB_SPIN_CAP) { atomicAdd(&bar[XB_TMO], 1u); break; } }
    }
    nloc = mine > 0u ? mine : 1u; nx = cnt > 0u ? cnt : 1u;
}
__device__ __forceinline__ void xcd_barrier(const XcdBarrier& b) {
    asm volatile("s_waitcnt vmcnt(0)" ::: "memory");
    __syncthreads();
    if (tid_of(b.wv) == 0) {
        size_t zb = 0; asm volatile("" : "+s"(zb)); unsigned* bar = b.bar + zb; unsigned bx = b.x; asm volatile("" : "+s"(bx));
        __builtin_amdgcn_s_waitcnt(0);
        unsigned nloc = b.st[0], nx = b.st[1];
        if (nloc == 0u) { xcd_barrier_complete(bar, bx, nloc, nx); b.st[0] = nloc; b.st[1] = nx; }
        const unsigned old = xb_add(&bar[XB_XSUB(bx)], 1u);
        const unsigned gen = old / nloc;
        if (old + 1u == (gen + 1u) * nloc) {
            __builtin_amdgcn_fence(__ATOMIC_RELEASE, "agent");
            asm volatile("s_waitcnt vmcnt(0)" ::: "memory");
            const unsigned og = xb_add(&bar[XB_TOP], 1u);
            const unsigned tg = og / nx;
            if (og + 1u == (tg + 1u) * nx) xb_add(&bar[XB_TOPGEN], 1u);
            else XB_SPIN(xb_ld(&bar[XB_TOPGEN]) == tg, bar);
            __builtin_amdgcn_fence(__ATOMIC_ACQUIRE, "agent");
            xb_add(&bar[XB_XGEN(bx)], 1u);
            asm volatile("s_waitcnt vmcnt(0)" ::: "memory");
        } else {
            XB_SPIN(xb_ld(&bar[XB_XGEN(bx)]) == gen, bar);
            __builtin_amdgcn_fence(__ATOMIC_ACQUIRE, "agent");
            asm volatile("s_waitcnt vmcnt(0)" ::: "memory");
        }
    }
    __syncthreads();
}

struct Args { const float* in[26]; float* out; unsigned char* ws; int ph_lo, ph_hi; };
enum { I_X = 0, I_C, I_N1G, I_N2G, I_WADA, I_BADA, I_WIN, I_CONVW, I_CONVB, I_WRGA, I_BRGA, I_WRGX, I_BRGX, I_LAM, I_WPOOL, I_PSCALE, I_WUPA, I_WUPB, I_WOUT, I_WROUTER, I_BROUTER, I_WEIN, I_BEIN, I_WEOUT, I_BEOUT, I_FINALG };

template <int ROWMODE>
__device__ __forceinline__ void tr_item(const float* W, int N, bf16_t* WT, int dst_ld, int dst_off, int k0, int n0, LAS float* scr, int lane) {
    { float tv[32];
#pragma unroll
    for (int i = 0; i < 32; ++i) tv[i] = W[(size_t)(k0 + 2 * i + (lane >> 5)) * N + n0 + (lane & 31)];
#pragma unroll
    for (int i = 0; i < 32; ++i) scr[(2 * i + (lane >> 5)) * 33 + (lane & 31)] = tv[i]; }
    LDS_WAIT();
    const int c = lane & 7;
#pragma unroll
    for (int j = 0; j < 4; ++j) { const int n = (lane >> 3) + 8 * j; const LAS float* s = scr + (8 * c) * 33 + n;
        u32x4 o; o.x = cvt_pk_bf16(s[0 * 33], s[1 * 33]); o.y = cvt_pk_bf16(s[2 * 33], s[3 * 33]); o.z = cvt_pk_bf16(s[4 * 33], s[5 * 33]); o.w = cvt_pk_bf16(s[6 * 33], s[7 * 33]);
        const int nn = n0 + n; int drow = nn;
        if (ROWMODE == 1) { drow = (nn < 1024) ? (256 * (nn >> 7) + (nn & 127)) : (256 * ((nn - 1024) >> 7) + 128 + ((nn - 1024) & 127)); }
        *(u32x4*)(WT + (size_t)drow * dst_ld + dst_off + k0 + 8 * c) = o; }
    LDS_WAIT();
}
template <int ROWMODE>
__device__ __forceinline__ void tr_item_fp8(const float* W, int N, unsigned char* WT, int k0, int n0, LAS float* scr, int lane) {
    { float tv[64];
#pragma unroll
    for (int i = 0; i < 64; ++i) tv[i] = W[(size_t)(k0 + 2 * i + (lane >> 5)) * N + n0 + (lane & 31)];
#pragma unroll
    for (int i = 0; i < 64; ++i) scr[(2 * i + (lane >> 5)) * 33 + (lane & 31)] = tv[i]; }
    LDS_WAIT();
    const int c = lane & 7;
#pragma unroll
    for (int j = 0; j < 4; ++j) { const int n = (lane >> 3) + 8 * j; const LAS float* s = scr + (16 * c) * 33 + n;
        int o[4];
#pragma unroll
        for (int q = 0; q < 4; ++q) { int w = 0; w = __builtin_amdgcn_cvt_pk_fp8_f32(s[(4 * q) * 33] * WEIN_SCALE, s[(4 * q + 1) * 33] * WEIN_SCALE, w, false);
            w = __builtin_amdgcn_cvt_pk_fp8_f32(s[(4 * q + 2) * 33] * WEIN_SCALE, s[(4 * q + 3) * 33] * WEIN_SCALE, w, true); o[q] = w; }
        const int nn = n0 + n; const int drow = (ROWMODE == 0) ? nn : ((nn < 1024) ? (256 * (nn >> 7) + (nn & 127)) : (256 * ((nn - 1024) >> 7) + 128 + ((nn - 1024) & 127)));
        *(u32x4*)(WT + (size_t)drow * 1024 + k0 + 16 * c) = (u32x4){(unsigned)o[0], (unsigned)o[1], (unsigned)o[2], (unsigned)o[3]}; }
    LDS_WAIT();
}
template <int ROWMODE>
__device__ __forceinline__ void tr_job(int item, const float* src, int K, int N, bf16_t* dst, size_t dst_bstride, int dst_ld, int dst_off, LAS float* scr, int lane) {
    const int nnb = N / 32, nkb = K / 64; const int nb = item % nnb; const int r = item / nnb; const int kb = r % nkb; const int bt = r / nkb;
    tr_item<ROWMODE>(src + (size_t)bt * K * N, N, dst + (size_t)bt * dst_bstride, dst_ld, dst_off, 64 * kb, 32 * nb, scr, lane);
}

__device__ __forceinline__ void phase_prologue(const Args& a, LAS unsigned char* lds, const int wv) {
    asm volatile("" : "+s"(lds));
    int tid_ = tid_of(wv); asm volatile("" : "+v"(tid_)); const int tid = tid_, lane = tid & 63, wave = __builtin_amdgcn_readfirstlane(tid >> 6);
    const int G = gridDim.x;
    unsigned char* ws = opaque_ptr(a.ws); const int bid = opaque_bid();
    {
        LAS float* cact = (LAS float*)lds;
        LAS float* red = (LAS float*)(lds + 32768);
        for (int i = tid; i < NBATCH * D; i += NTHREADS) { const float v = a.in[I_C][i]; cact[i] = v * sigmoidf_(v); }
        __syncthreads();
        float* mod = (float*)(ws + WS_MOD);
        for (int u = bid; u < DEPTH * 96; u += G) {
            const int l = u / 96, cg = u % 96; const int n = cg * 64 + lane;
            const float* w = a.in[I_WADA] + (size_t)l * D * 6144 + n;
            float acc[8] = {0.f, 0.f, 0.f, 0.f, 0.f, 0.f, 0.f, 0.f};
            const int kb = wave * 128;
#pragma unroll 8
            for (int k = 0; k < 128; ++k) { const float wv = w[(size_t)(kb + k) * 6144];
#pragma unroll
                for (int b = 0; b < 8; ++b) acc[b] += cact[b * D + kb + k] * wv; }
#pragma unroll
            for (int b = 0; b < 8; ++b) red[(wave * 8 + b) * 64 + lane] = acc[b];
            __syncthreads();
            { const int b = tid >> 6; float s = 0.f;
#pragma unroll
              for (int w8 = 0; w8 < 8; ++w8) s += red[(w8 * 8 + b) * 64 + lane];
              mod[((size_t)l * NBATCH + b) * 6144 + n] = s + a.in[I_BADA][(size_t)l * 6144 + n]; }
            __syncthreads();
        }
    }
    {
        bf16_t* wrs = (bf16_t*)(ws + WS_WRS);
        for (int idx = bid * NTHREADS + tid; idx < DEPTH * D * NE; idx += G * NTHREADS) { const int e = idx & 31, k = (idx >> 5) & 1023, l = idx >> 15;
            const float w = a.in[I_WROUTER][idx]; const unsigned hi = cvt_pk_bf16(w, 0.f) & 0xffffu; const unsigned lo = cvt_pk_bf16(w - bflo(hi), 0.f) & 0xffffu;
            wrs[((size_t)(l * 2 + 0) * NE + e) * D + k] = (bf16_t)hi; wrs[((size_t)(l * 2 + 1) * NE + e) * D + k] = (bf16_t)lo; }
    }
#if Z_I8
    {
        LAS float* tile = (LAS float*)lds; LAS float* red = (LAS float*)(lds + 1024 * 33 * 4);
        signed char* w8 = (signed char*)(ws + WS_WIN); float* wsc = (float*)(ws + WS_WINSC);
        __syncthreads();
        for (int u = bid; u < DEPTH * (NZ / 32); u += G) {
            const int l = u / (NZ / 32), n0 = (u % (NZ / 32)) * 32; const float* W = a.in[I_WIN] + (size_t)l * D * NZ + n0;
            const int n = tid & 31, kr = tid >> 5;
#pragma unroll 1
            for (int k0 = 0; k0 < 1024; k0 += 256) { float tv[16];
#pragma unroll
                for (int i = 0; i < 16; ++i) tv[i] = W[(size_t)(k0 + 16 * i + kr) * NZ + n];
#pragma unroll
                for (int i = 0; i < 16; ++i) tile[(k0 + 16 * i + kr) * 33 + n] = tv[i]; }
            __syncthreads();
            { float am = 0.f;
#pragma unroll 8
              for (int i = 0; i < 64; ++i) am = fmaxf(am, fabsf(tile[(kr * 64 + i) * 33 + n]));
              red[kr * 32 + n] = am; }
            __syncthreads();
            if (tid < 32) { float am = 1e-30f;
#pragma unroll
                for (int q = 0; q < 16; ++q) am = fmaxf(am, red[q * 32 + tid]);
                red[512 + tid] = 127.0f / am; wsc[(size_t)l * NZ + n0 + tid] = am * (1.0f / 127.0f); }
            __syncthreads();
            { const float inv = red[512 + n]; signed char* dst = w8 + ((size_t)l * NZ + n0 + n) * D + kr * 64;
#pragma unroll
              for (int c = 0; c < 4; ++c) { int w4[4];
#pragma unroll
                  for (int q = 0; q < 4; ++q) { int pk = 0;
#pragma unroll
                      for (int e = 0; e < 4; ++e) pk |= (((int)rintf(tile[(kr * 64 + c * 16 + q * 4 + e) * 33 + n] * inv)) & 0xff) << (8 * e);
                      w4[q] = pk; }
                  *(u32x4*)(dst + 16 * c) = (u32x4){(unsigned)w4[0], (unsigned)w4[1], (unsigned)w4[2], (unsigned)w4[3]}; } }
            __syncthreads();
        }
    }
#endif
    {
        LAS float* scr = (LAS float*)(lds + wave * 16896);
        const int gw = bid * NWAVES + wave, NGW = G * NWAVES;
        constexpr int I_EIN = DEPTH * NE * 8 * 64, I_EOUT = DEPTH * NE * 8 * 32, I_WINI = Z_I8 ? 0 : DEPTH * (Z_FP8 ? 8 : 16) * 144, I_UPA = DEPTH * 16 * 32, I_UPB = DEPTH * 8 * 32, I_OUT = DEPTH * 16 * 32,
                      I_RGA = DEPTH * 8 * 2 * 4, I_RGX = I_RGA, I_POOL = DEPTH * 4 * 2 * 4;
        constexpr int NITEMS = I_EIN + I_EOUT + I_WINI + I_UPA + I_UPB + I_OUT + I_RGA + I_RGX + I_POOL;
        for (int it = gw; it < NITEMS; it += NGW) {
            int r = it;
            if (r < I_EIN) { const int nb = r % 64, r2 = r / 64, kb = r2 % 8, bt = r2 / 8;
                tr_item_fp8<1>(a.in[I_WEIN] + (size_t)bt * 1024 * 2048, 2048, (unsigned char*)(ws + WS_WEIN) + (size_t)bt * 2048 * 1024, 128 * kb, 32 * nb, scr, lane); continue; } r -= I_EIN;
            if (r < I_EOUT) { const int nb = r % 32, r2 = r / 32, kb = r2 % 8, bt = r2 / 8;
                tr_item_fp8<0>(a.in[I_WEOUT] + (size_t)bt * 1024 * 1024, 1024, (unsigned char*)(ws + WS_WEOUT) + (size_t)bt * 1024 * 1024, 128 * kb, 32 * nb, scr, lane); continue; } r -= I_EOUT;
#if Z_I8
#elif Z_FP8
            if (r < I_WINI) { const int nb = r % 144, r2 = r / 144, kb = r2 % 8, bt = r2 / 8;
                tr_item_fp8<0>(a.in[I_WIN] + (size_t)bt * 1024 * NZ, NZ, (unsigned char*)(ws + WS_WIN) + (size_t)bt * NZ * 1024, 128 * kb, 32 * nb, scr, lane); continue; } r -= I_WINI;
#else
            if (r < I_WINI) { tr_job<0>(r, a.in[I_WIN], 1024, NZ, (bf16_t*)(ws + WS_WIN), (size_t)NZ * 1024, 1024, 0, scr, lane); continue; } r -= I_WINI;
#endif
            if (r < I_UPA) { tr_job<0>(r, a.in[I_WUPA], 1024, 1024, (bf16_t*)(ws + WS_WCAT), (size_t)1024 * KCAT, KCAT, 512, scr, lane); continue; } r -= I_UPA;
            if (r < I_UPB) { tr_job<0>(r, a.in[I_WUPB], 512, 1024, (bf16_t*)(ws + WS_WCAT), (size_t)1024 * KCAT, KCAT, 0, scr, lane); continue; } r -= I_UPB;
            if (r < I_OUT) { tr_job<0>(r, a.in[I_WOUT], 1024, 1024, (bf16_t*)(ws + WS_WOUT), (size_t)1024 * 1024, 1024, 0, scr, lane); continue; } r -= I_OUT;
            if (r < I_RGA) { tr_job<0>(r, a.in[I_WRGA], 128, 128, (bf16_t*)(ws + WS_WRG), (size_t)256 * 128, 128, 0, scr, lane); continue; } r -= I_RGA;
            if (r < I_RGX) { tr_job<0>(r, a.in[I_WRGX], 128, 128, (bf16_t*)(ws + WS_WRG) + 128 * 128, (size_t)256 * 128, 128, 0, scr, lane); continue; } r -= I_RGX;
            tr_job<0>(r, a.in[I_WPOOL], 128, 128, (bf16_t*)(ws + WS_WPOOL), (size_t)128 * 128, 128, 0, scr, lane);
        }
    }
}

struct MoeTab { LAS int* cnt; LAS int* padstart; LAS int* tilestart; LAS int* tab; };
__device__ __forceinline__ MoeTab moe_tab_ptrs(LAS unsigned char* lds) { MoeTab t; t.cnt = (LAS int*)(lds + LDS_TAB); t.padstart = t.cnt + 32; t.tilestart = t.padstart + 40; t.tab = t.tilestart + 40; return t; }
__device__ __forceinline__ void moe_tables(const Args& a, int l, LAS unsigned char* lds, const int wv) {
    asm volatile("" : "+s"(lds));
    const MoeTab mt = moe_tab_ptrs(lds); int tid_ = tid_of(wv); asm volatile("" : "+v"(tid_)); const int tid = tid_;
    unsigned* ctl = (unsigned*)(opaque_ptr(a.ws) + WS_CTL);
    __syncthreads();
    if (tid < NE) mt.cnt[tid] = (int)__hip_atomic_load(ctl + CW_CNT + (l * NE + tid) * 16, __ATOMIC_RELAXED, __HIP_MEMORY_SCOPE_AGENT);
    __syncthreads();
    if (tid == 0) { int ps = 0, ts = 0; for (int e = 0; e < NE; ++e) { mt.padstart[e] = ps; mt.tilestart[e] = ts; const int nt = (mt.cnt[e] + 255) >> 8; ps += nt * 256; ts += nt; } mt.padstart[NE] = ps; mt.tilestart[NE] = ts; }
    __syncthreads();
    const int nMt = mt.tilestart[NE];
    for (int m = tid; m < nMt; m += NTHREADS) { int e = 0; for (int q = 1; q < NE; ++q) e = (mt.tilestart[q] <= m) ? q : e; mt.tab[m] = (e << 16) | (m - mt.tilestart[e]); }
    __syncthreads();
}
struct MoeSched1 {
    static constexpr bool DYN_A = true;
    const char* H; const char* W; const int* tokof; MoeTab mt; int nMt, G, c;
    __device__ __forceinline__ bool next(int i, pg8::Unit& u) const { int pm, pn; if (!pg8::order_map(i, G, c, nMt, 8, pm, pn)) return false;
        const int en = __builtin_amdgcn_readfirstlane(mt.tab[pm]); u.pm = pm; u.pn = pn; u.e = en >> 16; u.j = en & 0xffff;
        u.row0 = __builtin_amdgcn_readfirstlane(mt.padstart[u.e]) + 256 * u.j; u.rows = __builtin_amdgcn_readfirstlane(mt.cnt[u.e]) - 256 * u.j; return true; }
    __device__ __forceinline__ const char* a_ptr() const { return H; }
    __device__ __forceinline__ const char* b_ptr() const { return W; }
    __device__ __forceinline__ unsigned a_off(const pg8::Unit&) const { return 0u; }
    __device__ __forceinline__ unsigned b_off(const pg8::Unit& u) const { return ((unsigned)u.e * 2048u + (unsigned)u.pn * 256u) * 1024u; }
    __device__ __forceinline__ void a_voff(const pg8::Unit& u, unsigned (&v)[2][2], int wv) const {
        int tid = tid_of(wv); asm volatile("" : "+v"(tid));
        const int* tl = tokof + (size_t)u.e * T + 256 * u.j; const int rmax = u.rows - 1;
#pragma unroll
        for (int i = 0; i < 2; ++i) { int R, C; pg8::stage_rc(tid * 16 + i * 8192, R, C);
#pragma unroll
            for (int h = 0; h < 2; ++h) { int idx = h * 128 + R; idx = idx < rmax ? idx : rmax; v[h][i] = (unsigned)tl[idx] * 1024u + (unsigned)C * 2u; } }
    }
};
struct MoeSched2 {
    static constexpr bool DYN_A = false;
    const char* ACT; const char* W; MoeTab mt; int nMt, G, c;
    __device__ __forceinline__ bool next(int i, pg8::Unit& u) const { int pm, pn; if (!pg8::order_map(i, G, c, nMt, 4, pm, pn)) return false;
        const int en = __builtin_amdgcn_readfirstlane(mt.tab[pm]); u.pm = pm; u.pn = pn; u.e = en >> 16; u.j = en & 0xffff;
        u.row0 = __builtin_amdgcn_readfirstlane(mt.padstart[u.e]) + 256 * u.j; u.rows = __builtin_amdgcn_readfirstlane(mt.cnt[u.e]) - 256 * u.j; return true; }
    __device__ __forceinline__ const char* a_ptr() const { return ACT; }
    __device__ __forceinline__ const char* b_ptr() const { return W; }
    __device__ __forceinline__ unsigned a_off(const pg8::Unit& u) const { return (unsigned)u.row0 * 1024u; }
    __device__ __forceinline__ unsigned b_off(const pg8::Unit& u) const { return ((unsigned)u.e * 1024u + (unsigned)u.pn * 256u) * 1024u; }
    __device__ __forceinline__ void a_voff(const pg8::Unit&, unsigned (&v)[2][2], int wv) const {
        int tid = tid_of(wv); asm volatile("" : "+v"(tid));
#pragma unroll
        for (int i = 0; i < 2; ++i) { int R, C; pg8::stage_rc(tid * 16 + i * 8192, R, C);
#pragma unroll
            for (int h = 0; h < 2; ++h) v[h][i] = (unsigned)((h * 128 + R) * 512 + C) * 2u; }
    }
};

__device__ __forceinline__ void phase_a(const Args& a, int l, LAS unsigned char* lds, bool dry, const int wv) {
    asm volatile("" : "+s"(lds));
    int tid_ = tid_of(wv); asm volatile("" : "+v"(tid_)); const int tid = tid_, lane = tid & 63, wave = __builtin_amdgcn_readfirstlane(tid >> 6);
    const int G = gridDim.x; unsigned char* ws = opaque_ptr(a.ws); const int bid = opaque_bid();
    const float* mod = (const float*)(ws + WS_MOD);
    float* xres = (float*)(ws + WS_XRES); float* xout = dry ? (float*)(ws + WS_Z) : xres;
    if (l < DEPTH && bid < NBATCH) {
        LAS float* red = (LAS float*)lds;
        const int b = bid, e = tid & 31, kp = tid >> 5;
        const float* sh2 = mod + ((size_t)l * NBATCH + b) * 6144 + 3 * D; const float* wr = a.in[I_WROUTER] + (size_t)l * D * NE;
        float s = 0.f;
        for (int k = kp * 64; k < kp * 64 + 64; ++k) s += sh2[k] * wr[k * NE + e];
        red[kp * 32 + e] = s;
        __syncthreads();
        if (tid < 32) { float t = a.in[I_BROUTER][l * NE + tid]; for (int q = 0; q < 16; ++q) t += red[q * 32 + tid]; ((float*)(ws + WS_CB))[(l * NBATCH + b) * NE + tid] = t; }
        __syncthreads();
    }
    if (l > 0) moe_tables(a, (l - 1) + DEPTH * (REPN(7) - 1), lds, wv);
    const MoeTab mt = moe_tab_ptrs(lds);
    const int* slotinfo = (const int*)(ws + WS_SLOTINFO); const float* wgt = (const float*)(ws + WS_WGT);
    const bf16_t* outb = (const bf16_t*)(ws + WS_OUTB);
    unsigned char* hb = (unsigned char*)(ws + WS_H);
    for (int chunk = bid; chunk < T / 128; chunk += G) {
        const int rowb = chunk * 128 + wave * 16; const int b = rowb / SEQ;
        const float* xin = (l == 0) ? (a.in[I_X] + (size_t)rowb * D) : (xres + (size_t)rowb * D);
        f32x4 xv[2][4]; int4 si[4]; f32x4 wv[4]; u32x2 gv[2][4][4];
#define PA_SX(r, q) do { if ((r) < 16) { _Pragma("unroll") for (int j = 0; j < 4; ++j) xv[(q) & 1][j] = *(const f32x4*)(xin + (size_t)(r) * D + 4 * lane + 256 * j); } } while (0)
#define PA_S0(r, q) do { if ((r) < 16 && l > 0) { si[(q) & 3] = *(const int4*)(slotinfo + (size_t)(rowb + (r)) * 4); wv[(q) & 3] = *(const f32x4*)(wgt + (size_t)(rowb + (r)) * 4); } } while (0)
#define PA_S1(r, q) do { if ((r) < 16 && l > 0) { const int sl_[4] = {si[(q) & 3].x, si[(q) & 3].y, si[(q) & 3].z, si[(q) & 3].w}; \
            _Pragma("unroll") for (int kk = 0; kk < 4; ++kk) { const int e_ = sl_[kk] >> 24, li_ = sl_[kk] & 0xffffff; const bf16_t* orow = outb + (size_t)(mt.padstart[e_] + li_) * D + 4 * lane; \
                _Pragma("unroll") for (int j = 0; j < 4; ++j) gv[(q) & 1][kk][j] = *(const u32x2*)(orow + 256 * j); } } } while (0)
        PA_S0(0, 0); PA_S0(1, 1); PA_SX(0, 0); PA_S1(0, 0);
#pragma unroll 1
        for (int i0 = 0; i0 < 16; i0 += 4) {
#pragma unroll
          for (int ii = 0; ii < 4; ++ii) {
            const int i = i0 + ii; const int row = rowb + i;
            PA_S0(i + 2, ii + 2); PA_SX(i + 1, ii + 1); PA_S1(i + 1, ii + 1);
            f32x4 v[4];
#pragma unroll
            for (int j = 0; j < 4; ++j) v[j] = xv[ii & 1][j];
            if (l > 0) {
                f32x4 y[4];
#pragma unroll
                for (int j = 0; j < 4; ++j) y[j] = (f32x4){0.f, 0.f, 0.f, 0.f};
#pragma unroll
                for (int kk = 0; kk < 4; ++kk) { const float w = wv[ii][kk];
#pragma unroll
                    for (int j = 0; j < 4; ++j) { const u32x2 p = gv[ii & 1][kk][j]; y[j] += w * (f32x4){bflo(p.x), bfhi(p.x), bflo(p.y), bfhi(p.y)}; } }
                const float* g2 = mod + ((size_t)(l - 1) * NBATCH + b) * 6144 + 5 * D + 4 * lane;
#pragma unroll
                for (int j = 0; j < 4; ++j) v[j] += *(const f32x4*)(g2 + 256 * j) * y[j];
            }
            if (l < DEPTH) {
#pragma unroll
                for (int j = 0; j < 4; ++j) *(f32x4*)(xout + (size_t)row * D + 4 * lane + 256 * j) = v[j];
            }
            float ss = 0.f;
#pragma unroll
            for (int j = 0; j < 4; ++j) ss += (v[j].x * v[j].x + v[j].y * v[j].y) + (v[j].z * v[j].z + v[j].w * v[j].w);
            const float rinv = 1.0f / sqrtf(wave_sum(ss, lane) * (1.0f / D) + NORM_EPS);
            if (l < DEPTH) {
                const float* ng = a.in[I_N1G] + (size_t)l * D + 4 * lane; const float* mb = mod + ((size_t)l * NBATCH + b) * 6144 + 4 * lane;
                f32x4 hq[4]; (void)hq;
#pragma unroll
                for (int j = 0; j < 4; ++j) { const f32x4 g = *(const f32x4*)(ng + 256 * j), sh = *(const f32x4*)(mb + 256 * j), sc = *(const f32x4*)(mb + D + 256 * j);
                    const f32x4 h = (v[j] * rinv * g) * (1.0f + sc) + sh;
#if Z_I8
                    hq[j] = h; }
                {   float am = 0.f;
#pragma unroll
                    for (int j = 0; j < 4; ++j) am = fmaxf(fmaxf(fmaxf(fabsf(hq[j].x), fabsf(hq[j].y)), fmaxf(fabsf(hq[j].z), fabsf(hq[j].w))), am);
#pragma unroll
                    for (int o = 1; o < 64; o <<= 1) am = fmaxf(am, shflx(am, o, lane));
                    am = fmaxf(am, 1e-20f); const float inv = 127.0f / am;
                    if (lane == 0) ((float*)(ws + WS_HSC))[row] = am * (1.0f / 127.0f);
#pragma unroll
                    for (int j = 0; j < 4; ++j) { const int q0 = (int)rintf(hq[j].x * inv), q1 = (int)rintf(hq[j].y * inv), q2 = (int)rintf(hq[j].z * inv), q3 = (int)rintf(hq[j].w * inv);
                        *(int*)(hb + (size_t)row * D + 4 * lane + 256 * j) = (q0 & 0xff) | ((q1 & 0xff) << 8) | ((q2 & 0xff) << 16) | ((q3 & 0xff) << 24); }
                }
#elif Z_FP8
                    int p = 0; p = __builtin_amdgcn_cvt_pk_fp8_f32(h.x, h.y, p, false); p = __builtin_amdgcn_cvt_pk_fp8_f32(h.z, h.w, p, true);
                    *(int*)(hb + (size_t)row * D + 4 * lane + 256 * j) = p; }
#else
                    u32x2 p; p.x = cvt_pk_bf16(h.x, h.y); p.y = cvt_pk_bf16(h.z, h.w); *(u32x2*)((bf16_t*)hb + (size_t)row * D + 4 * lane + 256 * j) = p; }
#endif
            } else {
                const float* fg = a.in[I_FINALG] + 4 * lane;
#pragma unroll
                for (int j = 0; j < 4; ++j) *(f32x4*)(a.out + (size_t)row * D + 4 * lane + 256 * j) = v[j] * rinv * *(const f32x4*)(fg + 256 * j);
            }
          }
        }
#undef PA_S0
#undef PA_SX
#undef PA_S1
    }
}

__device__ __forceinline__ void phase_h(const Args& a, int l, int cset, LAS unsigned char* lds, const int wv) {
    asm volatile("" : "+s"(lds));
    int tid_ = tid_of(wv); asm volatile("" : "+v"(tid_)); const int tid = tid_, lane = tid & 63, wave = __builtin_amdgcn_readfirstlane(tid >> 6);
    const int G = gridDim.x; unsigned char* ws = opaque_ptr(a.ws); const int bid = opaque_bid();
    const float* mod = (const float*)(ws + WS_MOD); const float* xres = (const float*)(ws + WS_XRES);
    unsigned char* h8 = (unsigned char*)(ws + WS_H);
    LAS float* rinvs = (LAS float*)lds;
    LAS float* lgt = (LAS float*)(lds + 1024);
    LAS int* hist = (LAS int*)(lds + 1024 + 8 * 16 * 33 * 4);
    LAS int* base = hist + 32;
    unsigned* ctl = (unsigned*)(ws + WS_CTL);
    const float* ng = a.in[I_N2G] + (size_t)l * D;
    const float* cbv = (const float*)(ws + WS_CB);
    int* tokof = (int*)(ws + WS_TOKOF); int* slotinfo = (int*)(ws + WS_SLOTINFO); float* wgt = (float*)(ws + WS_WGT);
    for (int chunk = bid; chunk < T / 128; chunk += G) {
        const int row0 = chunk * 128 + wave * 16; const int b = row0 / SEQ;
        const float* mb = mod + ((size_t)l * NBATCH + b) * 6144 + 3 * D;
        if (tid < 32) hist[tid] = 0;
        f32x4 xq[3][4];
#pragma unroll
        for (int r = 0; r < 2; ++r)
#pragma unroll
            for (int j = 0; j < 4; ++j) xq[r][j] = *(const f32x4*)(xres + (size_t)(row0 + r) * D + 4 * lane + 256 * j);
#pragma unroll
        for (int i = 0; i < 16; ++i) {
            const int row = row0 + i;
            if (i + 2 < 16) {
#pragma unroll
                for (int j = 0; j < 4; ++j) xq[(i + 2) % 3][j] = *(const f32x4*)(xres + (size_t)(row + 2) * D + 4 * lane + 256 * j); }
            f32x4 v[4]; float ss = 0.f;
#pragma unroll
            for (int j = 0; j < 4; ++j) { v[j] = xq[i % 3][j]; ss += (v[j].x * v[j].x + v[j].y * v[j].y) + (v[j].z * v[j].z + v[j].w * v[j].w); }
            const float rinv = 1.0f / sqrtf(wave_sum(ss, lane) * (1.0f / D) + NORM_EPS);
            if (lane == 0) rinvs[wave * 16 + i] = rinv;
#pragma unroll
            for (int j = 0; j < 4; ++j) { const f32x4 g = *(const f32x4*)(ng + 4 * lane + 256 * j), sh = *(const f32x4*)(mb + 4 * lane + 256 * j), sc = *(const f32x4*)(mb + D + 4 * lane + 256 * j);
                const f32x4 h = (v[j] * rinv * g) * (1.0f + sc) + sh;
                int p = 0; p = __builtin_amdgcn_cvt_pk_fp8_f32(h.x, h.y, p, false); p = __builtin_amdgcn_cvt_pk_fp8_f32(h.z, h.w, p, true);
                *(int*)(h8 + (size_t)row * D + 4 * lane + 256 * j) = p; }
        }
        {
            const int ri = lane & 15, q = lane >> 4;
            const float* xr = xres + (size_t)(row0 + ri) * D + 8 * q;
            const bf16_t* wh = (const bf16_t*)(ws + WS_WRS) + ((size_t)(l * 2 + 0) * NE + ri) * D + 8 * q; const bf16_t* wl = wh + (size_t)NE * D;
            f32x4 acc0 = {0.f, 0.f, 0.f, 0.f}, acc1 = {0.f, 0.f, 0.f, 0.f};
#pragma unroll 4
            for (int kb = 0; kb < 32; ++kb) {
                const int k0 = 32 * kb + 8 * q;
                const f32x4 x0 = *(const f32x4*)(xr + 32 * kb), x1 = *(const f32x4*)(xr + 32 * kb + 4);
                const f32x4 g0 = *(const f32x4*)(ng + k0), g1 = *(const f32x4*)(ng + k0 + 4), s0 = *(const f32x4*)(mb + D + k0), s1 = *(const f32x4*)(mb + D + k0 + 4);
                const bf16x8 bh0 = *(const bf16x8*)(wh + 32 * kb), bl0 = *(const bf16x8*)(wl + 32 * kb), bh1 = *(const bf16x8*)(wh + 16 * D + 32 * kb), bl1 = *(const bf16x8*)(wl + 16 * D + 32 * kb);
                const f32x4 a0 = x0 * g0 * (1.0f + s0), a1 = x1 * g1 * (1.0f + s1);
                u32x4 hi, lo;
                hi.x = cvt_pk_bf16(a0.x, a0.y); hi.y = cvt_pk_bf16(a0.z, a0.w); hi.z = cvt_pk_bf16(a1.x, a1.y); hi.w = cvt_pk_bf16(a1.z, a1.w);
                lo.x = cvt_pk_bf16(a0.x - bflo(hi.x), a0.y - bfhi(hi.x)); lo.y = cvt_pk_bf16(a0.z - bflo(hi.y), a0.w - bfhi(hi.y));
                lo.z = cvt_pk_bf16(a1.x - bflo(hi.z), a1.y - bfhi(hi.z)); lo.w = cvt_pk_bf16(a1.z - bflo(hi.w), a1.w - bfhi(hi.w));
                const bf16x8 ah = __builtin_bit_cast(bf16x8, hi), al = __builtin_bit_cast(bf16x8, lo);
                acc0 = __builtin_amdgcn_mfma_f32_16x16x32_bf16(ah, bh0, acc0, 0, 0, 0); acc0 = __builtin_amdgcn_mfma_f32_16x16x32_bf16(ah, bl0, acc0, 0, 0, 0); acc0 = __builtin_amdgcn_mfma_f32_16x16x32_bf16(al, bh0, acc0, 0, 0, 0);
                acc1 = __builtin_amdgcn_mfma_f32_16x16x32_bf16(ah, bh1, acc1, 0, 0, 0); acc1 = __builtin_amdgcn_mfma_f32_16x16x32_bf16(ah, bl1, acc1, 0, 0, 0); acc1 = __builtin_amdgcn_mfma_f32_16x16x32_bf16(al, bh1, acc1, 0, 0, 0);
            }
            LDS_WAIT();
            const float c0 = cbv[(l * NBATCH + b) * NE + ri], c1 = cbv[(l * NBATCH + b) * NE + 16 + ri];
#pragma unroll
            for (int r = 0; r < 4; ++r) { const int ti = 4 * q + r; const float rv = rinvs[wave * 16 + ti];
                lgt[(wave * 16 + ti) * 33 + ri] = acc0[r] * rv + c0; lgt[(wave * 16 + ti) * 33 + 16 + ri] = acc1[r] * rv + c1; }
        }
        __syncthreads();
        int se[4] = {0, 0, 0, 0}; float sw[4] = {0.f, 0.f, 0.f, 0.f}; int rk[4] = {0, 0, 0, 0};
        if (lane < 16) {
            float v[32];
#pragma unroll
            for (int e = 0; e < 32; ++e) v[e] = lgt[(wave * 16 + lane) * 33 + e];
            float sv[4];
#pragma unroll
            for (int kk = 0; kk < 4; ++kk) { float best = v[0]; int bi = 0;
#pragma unroll
                for (int e = 1; e < 32; ++e) { if (v[e] > best) { best = v[e]; bi = e; } }
                sv[kk] = best; se[kk] = bi;
#pragma unroll
                for (int e = 0; e < 32; ++e) v[e] = (e == bi) ? -3.0e38f : v[e]; }
            float den = 0.f;
#pragma unroll
            for (int kk = 0; kk < 4; ++kk) { sw[kk] = __expf(sv[kk] - sv[0]); den += sw[kk]; }
            const float inv = 1.0f / den;
#pragma unroll
            for (int kk = 0; kk < 4; ++kk) { sw[kk] *= inv; rk[kk] = __hip_atomic_fetch_add(hist + se[kk], 1, __ATOMIC_RELAXED, __HIP_MEMORY_SCOPE_WORKGROUP); }
        }
        __syncthreads();
        if (tid < 32) base[tid] = (int)__hip_atomic_fetch_add(ctl + CW_CNT + (cset * NE + tid) * 16, (unsigned)hist[tid], __ATOMIC_RELAXED, __HIP_MEMORY_SCOPE_AGENT);
        __syncthreads();
        if (lane < 16) {
            const int row = row0 + lane; int si[4];
#pragma unroll
            for (int kk = 0; kk < 4; ++kk) { const int li = base[se[kk]] + rk[kk]; tokof[(size_t)se[kk] * T + li] = row; si[kk] = (se[kk] << 24) | li; }
            *(int4*)(slotinfo + (size_t)row * 4) = make_int4(si[0], si[1], si[2], si[3]);
            *(f32x4*)(wgt + (size_t)row * 4) = (f32x4){sw[0], sw[1], sw[2], sw[3]};
        }
        __syncthreads();
    }
}

constexpr int ZT_STRIDE = 528;
__device__ __forceinline__ void lru_unit(const Args& a, int l, int u, LAS unsigned char* lds, const int wv) {
    asm volatile("" : "+s"(lds));
    int tid_ = tid_of(wv); asm volatile("" : "+v"(tid_)); const int tid = tid_, lane = tid & 63, wave = __builtin_amdgcn_readfirstlane(tid >> 6);
    unsigned char* ws = opaque_ptr(a.ws);
    const bf16_t* z = (const bf16_t*)(ws + WS_Z);
    LAS unsigned char* zt = lds; LAS unsigned char* xc = lds + 131 * ZT_STRIDE;
    const int hp = u & 3, b = (u >> 2) & 7, s = u >> 5;
    const int t0 = b * SEQ + s * 128, p0 = s * 128;
    {   u32x4 sv[9];
#pragma unroll
        for (int k = 0; k < 9; ++k) { int idx = tid + NTHREADS * k; idx = idx < 131 * 32 ? idx : 131 * 32 - 1; const int r = idx >> 5, o = idx & 31; const int p = p0 - 3 + r; const int pc = p < 0 ? 0 : p;
            sv[k] = *(const u32x4*)(z + (size_t)(b * SEQ + pc) * NZ + hp * 256 + o * 8); if (p < 0) sv[k] = (u32x4){0u, 0u, 0u, 0u}; }
#pragma unroll
        for (int k = 0; k < 9; ++k) { int idx = tid + NTHREADS * k; idx = idx < 131 * 32 ? idx : 131 * 32 - 1; const int r = idx >> 5, o = idx & 31;
            *(LAS u32x4*)(zt + r * ZT_STRIDE + o * 16) = sv[k]; }
    }
    __syncthreads();
    {
        const int o = tid & 31, rb = tid >> 5; const int ch0 = hp * 256 + o * 8;
        float cw[4][8], cbias[8];
#pragma unroll
        for (int k = 0; k < 4; ++k) { const f32x4 w0 = *(const f32x4*)(a.in[I_CONVW] + ((size_t)l * 4 + k) * D + ch0), w1 = *(const f32x4*)(a.in[I_CONVW] + ((size_t)l * 4 + k) * D + ch0 + 4);
            cw[k][0] = w0.x; cw[k][1] = w0.y; cw[k][2] = w0.z; cw[k][3] = w0.w; cw[k][4] = w1.x; cw[k][5] = w1.y; cw[k][6] = w1.z; cw[k][7] = w1.w; }
        { const f32x4 b0 = *(const f32x4*)(a.in[I_CONVB] + (size_t)l * D + ch0), b1 = *(const f32x4*)(a.in[I_CONVB] + (size_t)l * D + ch0 + 4);
          cbias[0] = b0.x; cbias[1] = b0.y; cbias[2] = b0.z; cbias[3] = b0.w; cbias[4] = b1.x; cbias[5] = b1.y; cbias[6] = b1.z; cbias[7] = b1.w; }
#pragma unroll 2
        for (int i = 0; i < 8; ++i) { const int r = rb + 16 * i; float acc[8];
#pragma unroll
            for (int j = 0; j < 8; ++j) acc[j] = cbias[j];
#pragma unroll
            for (int k = 0; k < 4; ++k) { const u32x4 v = *(const LAS u32x4*)(zt + (r + k) * ZT_STRIDE + o * 16);
                acc[0] += cw[k][0] * bflo(v.x); acc[1] += cw[k][1] * bfhi(v.x); acc[2] += cw[k][2] * bflo(v.y); acc[3] += cw[k][3] * bfhi(v.y);
                acc[4] += cw[k][4] * bflo(v.z); acc[5] += cw[k][5] * bfhi(v.z); acc[6] += cw[k][6] * bflo(v.w); acc[7] += cw[k][7] * bfhi(v.w); }
            u32x4 w; w.x = cvt_pk_bf16(acc[0], acc[1]); w.y = cvt_pk_bf16(acc[2], acc[3]); w.z = cvt_pk_bf16(acc[4], acc[5]); w.w = cvt_pk_bf16(acc[6], acc[7]);
            *(LAS u32x4*)(xc + r * ZT_STRIDE + o * 16) = w; }
    }
    __syncthreads();
    {
        const int hsel = wave >> 2, wc = wave & 3, head = 2 * hp + hsel, c31 = lane & 31, hh = lane >> 5;
        const int ch = head * 128 + 32 * wc + c31;
        const bf16_t* wb = (const bf16_t*)(ws + WS_WRG) + ((size_t)(l * 8 + head) * 256 + 32 * wc + c31) * 128 + 8 * hh;
        bf16x8 Ba[8], Bi[8];
#pragma unroll
        for (int ks = 0; ks < 8; ++ks) { Ba[ks] = *(const bf16x8*)(wb + 16 * ks); Bi[ks] = *(const bf16x8*)(wb + 128 * 128 + 16 * ks); }
        const float ba = a.in[I_BRGA][(size_t)l * D + ch], bx = a.in[I_BRGX][(size_t)l * D + ch];
        const float lam = a.in[I_LAM][(size_t)l * D + ch];
        const float sp8 = 8.0f * log1pf(__expf(-lam));
        typedef __attribute__((address_space(1))) unsigned long long gu64;
        gu64* aggq = (gu64*)(ws + WS_AGG) + ((size_t)l * NBATCH * 32 + (size_t)b * 32) * D + ch;
        float Pr = 1.f, Hr = 0.f;
        unsigned hpk[64];
#pragma unroll
        for (int rb = 0; rb < 4; ++rb) {
            f32x16 aa, ai;
#pragma unroll
            for (int r = 0; r < 16; ++r) { aa[r] = 0.f; ai[r] = 0.f; }
            const LAS unsigned char* ap = xc + (32 * rb + c31) * ZT_STRIDE + (hsel * 128 + 8 * hh) * 2;
#pragma unroll
            for (int ks = 0; ks < 8; ++ks) { const bf16x8 A = *(const LAS bf16x8*)(ap + 32 * ks);
                aa = __builtin_amdgcn_mfma_f32_32x32x16_bf16(A, Ba[ks], aa, 0, 0, 0); ai = __builtin_amdgcn_mfma_f32_32x32x16_bf16(A, Bi[ks], ai, 0, 0, 0); }
            const LAS unsigned char* xp = xc + (32 * rb + 4 * hh) * ZT_STRIDE + (hsel * 128 + 32 * wc + c31) * 2;
#pragma unroll
            for (int q = 0; q < 4; ++q) {
                float p = 1.f, h = 0.f, hl[4], pl[4];
#pragma unroll
                for (int r3 = 0; r3 < 4; ++r3) { const int reg = 4 * q + r3;
                    const float xcv = bf1(*(const LAS bf16_t*)(xp + (8 * q + r3) * ZT_STRIDE));
                    const float rg = sigmoidf_(aa[reg] + ba), ig = sigmoidf_(ai[reg] + bx);
                    const float av = __expf(-sp8 * rg); const float mult = sqrtf(fmaxf(1.0f - av * av, 0.f));
                    h = av * h + mult * (ig * xcv); p *= av; hl[r3] = h; pl[r3] = p; }
                const float Ao = shflx(p, 32, lane), Bo = shflx(h, 32, lane);
                const float A0 = hh ? Ao : p, B0 = hh ? Bo : h, A1 = hh ? p : Ao, B1 = hh ? h : Bo;
                const float P1 = Pr * A0, H1 = Hr * A0 + B0;
                const float Pst = hh ? P1 : Pr, Hst = hh ? H1 : Hr;
                Pr = P1 * A1; Hr = H1 * A1 + B1;
#pragma unroll
                for (int r3 = 0; r3 < 4; ++r3) hpk[rb * 16 + 4 * q + r3] = cvt_pk_bf16(Hst * pl[r3] + hl[r3], Pst * pl[r3]);
            }
        }
        if (hh == 0) __hip_atomic_store(aggq + (size_t)s * D, ((unsigned long long)__float_as_uint(Hr) << 32) | (unsigned long long)__float_as_uint(fmaxf(Pr, 1e-37f)), __ATOMIC_RELAXED, __HIP_MEMORY_SCOPE_AGENT);
        const bf16_t* zg = z + (size_t)t0 * NZ + ZO_GLRU + ch;
        bf16_t* yo = (bf16_t*)(ws + WS_ACAT) + (size_t)t0 * KCAT + 512 + ch;
        bf16_t gcur[16], gnxt[16];
#pragma unroll
        for (int reg = 0; reg < 16; ++reg) gcur[reg] = zg[(size_t)(8 * (reg >> 2) + 4 * hh + (reg & 3)) * NZ];
        float cin = 0.f;
        for (int j0 = 0; j0 < s; j0 += 8) {
            unsigned long long w[8]; unsigned spins = 0;
            for (;;) { bool ok = true;
#pragma unroll
                for (int k = 0; k < 8; ++k) { const int j = (j0 + k < s) ? (j0 + k) : (s - 1); w[k] = __hip_atomic_load(aggq + (size_t)j * D, __ATOMIC_RELAXED, __HIP_MEMORY_SCOPE_AGENT); ok = ok && ((unsigned)w[k] != 0u); }
                if (__all(ok)) break;
                __builtin_amdgcn_s_sleep(4);
                if (++spins > (1u << 17)) break;
            }
#pragma unroll
            for (int k = 0; k < 8; ++k) { if (j0 + k < s) cin = __uint_as_float((unsigned)w[k]) * cin + __uint_as_float((unsigned)(w[k] >> 32)); }
        }
#pragma unroll
        for (int rb = 0; rb < 4; ++rb) {
            if (rb < 3) {
#pragma unroll
                for (int reg = 0; reg < 16; ++reg) gnxt[reg] = zg[(size_t)(32 * (rb + 1) + 8 * (reg >> 2) + 4 * hh + (reg & 3)) * NZ]; }
#pragma unroll
            for (int reg = 0; reg < 16; ++reg) { const int tok = 32 * rb + 8 * (reg >> 2) + 4 * hh + (reg & 3);
                const unsigned pk = hpk[rb * 16 + reg];
                const float hf = bflo(pk) + bfhi(pk) * cin;
                const float g = bf1(gcur[reg]);
                const float ge = g * __builtin_amdgcn_rcpf(1.0f + __expf(-1.5957691216f * (g + 0.044715f * g * g * g)));
                yo[(size_t)tok * KCAT] = (bf16_t)(cvt_pk_bf16(hf * ge, 0.f) & 0xffffu); }
#pragma unroll
            for (int reg = 0; reg < 16; ++reg) gcur[reg] = gnxt[reg];
        }
    }
    __syncthreads();
}
__device__ __forceinline__ void pool_unit(const Args& a, int l, int u, LAS unsigned char* lds, const int wv) {
    asm volatile("" : "+s"(lds));
    int tid_ = tid_of(wv); asm volatile("" : "+v"(tid_)); const int tid = tid_, lane = tid & 63, wave = __builtin_amdgcn_readfirstlane(tid >> 6);
    unsigned char* ws = opaque_ptr(a.ws);
    const bf16_t* z = (const bf16_t*)(ws + WS_Z);
    LAS unsigned char* zt = lds; LAS unsigned char* pt = lds + 143 * ZT_STRIDE;
    const int gp = u & 1, b = (u >> 1) & 7, s = u >> 4;
    const int t0 = b * SEQ + s * 128, p0 = s * 128;
    {   u32x4 sv[9];
#pragma unroll
        for (int k = 0; k < 9; ++k) { int idx = tid + NTHREADS * k; idx = idx < 143 * 32 ? idx : 143 * 32 - 1; const int r = idx >> 5, o = idx & 31; const int p = p0 - 15 + r; const int pc = p < 0 ? 0 : p;
            sv[k] = *(const u32x4*)(z + (size_t)(b * SEQ + pc) * NZ + ZO_XPOOL + gp * 256 + o * 8); if (p < 0) sv[k] = (u32x4){0u, 0u, 0u, 0u}; }
#pragma unroll
        for (int k = 0; k < 9; ++k) { int idx = tid + NTHREADS * k; idx = idx < 143 * 32 ? idx : 143 * 32 - 1; const int r = idx >> 5, o = idx & 31;
            *(LAS u32x4*)(zt + r * ZT_STRIDE + o * 16) = sv[k]; }
    }
    __syncthreads();
    {
        const int o = tid & 31, rb = tid >> 5; const int g = 2 * gp + (o >> 4); const int w = 2 << g;
#pragma unroll 1
        for (int i = 0; i < 8; ++i) { const int r = rb + 16 * i; float acc[8];
#pragma unroll
            for (int j = 0; j < 8; ++j) acc[j] = 0.f;
            for (int jj = 0; jj < w; ++jj) { const u32x4 v = *(const LAS u32x4*)(zt + (r + 15 - jj) * ZT_STRIDE + o * 16);
                acc[0] += bflo(v.x); acc[1] += bfhi(v.x); acc[2] += bflo(v.y); acc[3] += bfhi(v.y); acc[4] += bflo(v.z); acc[5] += bfhi(v.z); acc[6] += bflo(v.w); acc[7] += bfhi(v.w); }
            const int cnt = (p0 + r + 1 < w) ? (p0 + r + 1) : w; const float ic = 1.0f / (float)cnt;
            const u32x4 v = *(const LAS u32x4*)(zt + (r + 15) * ZT_STRIDE + o * 16);
            const float x0[8] = {bflo(v.x), bfhi(v.x), bflo(v.y), bfhi(v.y), bflo(v.z), bfhi(v.z), bflo(v.w), bfhi(v.w)};
#pragma unroll
            for (int j = 0; j < 8; ++j) acc[j] = acc[j] * ic - x0[j];
            u32x4 wv; wv.x = cvt_pk_bf16(acc[0], acc[1]); wv.y = cvt_pk_bf16(acc[2], acc[3]); wv.z = cvt_pk_bf16(acc[4], acc[5]); wv.w = cvt_pk_bf16(acc[6], acc[7]);
            *(LAS u32x4*)(pt + r * ZT_STRIDE + o * 16) = wv; }
    }
    __syncthreads();
    {
        const int gsel = wave >> 2, wc = wave & 3, g = 2 * gp + gsel, c31 = lane & 31, hh = lane >> 5;
        const int oc = g * 128 + 32 * wc + c31;
        const bf16_t* wb = (const bf16_t*)(ws + WS_WPOOL) + ((size_t)(l * 4 + g) * 128 + 32 * wc + c31) * 128 + 8 * hh;
        bf16x8 Bf[8];
#pragma unroll
        for (int ks = 0; ks < 8; ++ks) Bf[ks] = *(const bf16x8*)(wb + 16 * ks);
        const float psc = a.in[I_PSCALE][(size_t)l * 512 + oc];
        bf16_t* yo = (bf16_t*)(ws + WS_ACAT) + (size_t)t0 * KCAT + oc;
#pragma unroll 1
        for (int rb = 0; rb < 4; ++rb) {
            f32x16 acc;
#pragma unroll
            for (int r = 0; r < 16; ++r) acc[r] = 0.f;
            const LAS unsigned char* ap = pt + (32 * rb + c31) * ZT_STRIDE + (gsel * 128 + 8 * hh) * 2;
#pragma unroll
            for (int ks = 0; ks < 8; ++ks) { const bf16x8 A = *(const LAS bf16x8*)(ap + 32 * ks); acc = __builtin_amdgcn_mfma_f32_32x32x16_bf16(A, Bf[ks], acc, 0, 0, 0); }
#pragma unroll
            for (int reg = 0; reg < 16; ++reg) { const int tok = 32 * rb + 8 * (reg >> 2) + 4 * hh + (reg & 3);
                yo[(size_t)tok * KCAT] = (bf16_t)(cvt_pk_bf16(acc[reg] * psc, 0.f) & 0xffffu); }
        }
    }
    __syncthreads();
}

constexpr int PH_PER_LAYER = 9;
constexpr int N_PHASES = 1 + DEPTH * PH_PER_LAYER + 1;

__global__ void __launch_bounds__(NTHREADS, 2) fwd_kernel(Args a) {
    extern __shared__ __attribute__((aligned(16))) unsigned char lds_raw[];
    LAS unsigned char* lds = (LAS unsigned char*)lds_raw;
    const int wv = __builtin_amdgcn_readfirstlane(threadIdx.x >> 6); const int tid = threadIdx.x; const int G = gridDim.x;
    unsigned char* ws0 = a.ws;
    unsigned* ctl = (unsigned*)(ws0 + WS_CTL);
    volatile LAS unsigned* misc = (volatile LAS unsigned*)(lds + LDS_MISC);
    if (tid < 4) misc[tid] = 0u;
    __syncthreads();
    XcdBarrier bar; bar.bar = ctl + CW_BAR; bar.x = 0; bar.st = misc; bar.wv = wv;
#if MK_PER_PHASE
    const int lo = a.ph_lo, hi = a.ph_hi;
#else
    constexpr int lo = 0, hi = N_PHASES;
#endif
    if (hi - lo > 1) bar = xcd_barrier_post(ctl + CW_BAR, misc, wv);
#define IN(k) (lo <= (k) && (k) < hi)
#define SEAM(k) do { if (IN((k) + 1)) xcd_barrier(bar); } while (0)

    if (EN(0) && IN(0)) for (int rr = 0; rr < REPN(0); ++rr) { phase_prologue(a, lds, wv); SEAM(0); }

    for (int l = 0; l < DEPTH; ++l) {
        const int pb = 1 + l * PH_PER_LAYER;
        if (EN(1) && IN(pb + 0)) for (int rr = 0; rr < REPN(1); ++rr) { unsigned char* ws = opaque_ptr(ws0); const int bid = opaque_bid(); (void)bid; (void)ws; phase_a(a, l, lds, rr + 1 < REPN(1), wv); SEAM(pb + 0); }
        if (EN(2) && IN(pb + 1)) for (int rr = 0; rr < REPN(2); ++rr) { unsigned char* ws = opaque_ptr(ws0); const int bid = opaque_bid(); (void)bid; (void)ws;
            #if Z_I8
            pg8::PlainSched S{(const char*)(ws + WS_H), (const char*)(ws + WS_WIN) + (size_t)l * NZ * 1024, 512, T / 256, NZ / 256, G, bid};
            pg8::EpiZI8 E{(bf16_t*)(ws + WS_Z), (const float*)(ws + WS_HSC), (const float*)(ws + WS_WINSC) + (size_t)l * NZ};
            pg8::gemm_phase<pg8::EpiZI8, pg8::PlainSched, true, 2>(lds, 512, S, E, wv);
#elif Z_FP8
            pg8::PlainSched S{(const char*)(ws + WS_H), (const char*)(ws + WS_WIN) + (size_t)l * NZ * 1024, 512, T / 256, NZ / 256, G, bid};
            pg8::EpiBf16 E{(bf16_t*)(ws + WS_Z), NZ, nullptr, (rr + 1 < REPN(2)) && (a.ph_lo == 0), 1.0f / WEIN_SCALE};
            pg8::gemm_phase<pg8::EpiBf16, pg8::PlainSched, true, 1>(lds, 512, S, E, wv);
#else
            pg8::PlainSched S{(const char*)(ws + WS_H), (const char*)(ws + WS_WIN) + (size_t)l * NZ * 1024 * 2, 1024, T / 256, NZ / 256, G, bid};
            pg8::EpiBf16 E{(bf16_t*)(ws + WS_Z), NZ, nullptr, (rr + 1 < REPN(2)) && (a.ph_lo == 0), 1.0f};
            pg8::gemm_phase<pg8::EpiBf16, pg8::PlainSched, true>(lds, 1024, S, E, wv);
#endif
            SEAM(pb + 1);
        }
        if (EN(3) && IN(pb + 2)) for (int rr = 0; rr < REPN(3); ++rr) { unsigned char* ws = opaque_ptr(ws0); const int bid = opaque_bid(); (void)bid; (void)ws;
            for (int u = bid; u < 1024 + 512; u += G) { if (u < 1024) lru_unit(a, l, u, lds, wv); else pool_unit(a, l, u - 1024, lds, wv); }
            SEAM(pb + 2);
        }
        if (EN(5) && IN(pb + 4)) for (int rr = 0; rr < REPN(5); ++rr) { unsigned char* ws = opaque_ptr(ws0); const int bid = opaque_bid(); (void)bid; (void)ws;
            pg8::PlainSched S{(const char*)(ws + WS_ACAT), (const char*)(ws + WS_WCAT) + (size_t)l * 1024 * KCAT * 2, KCAT, T / 256, D / 256, G, bid};
            pg8::EpiMerged E{(bf16_t*)(ws + WS_MERGED), (const bf16_t*)(ws + WS_Z)};
            pg8::gemm_phase<pg8::EpiMerged, pg8::PlainSched, true>(lds, KCAT, S, E, wv);
            SEAM(pb + 4);
        }
        if (EN(6) && IN(pb + 5)) for (int rr = 0; rr < REPN(6); ++rr) { unsigned char* ws = opaque_ptr(ws0); const int bid = opaque_bid(); (void)bid; (void)ws;
            pg8::PlainSched S{(const char*)(ws + WS_MERGED), (const char*)(ws + WS_WOUT) + (size_t)l * 1024 * 1024 * 2, 1024, T / 256, D / 256, G, bid};
            pg8::EpiResid E{(float*)(ws + WS_XRES), (rr + 1 < REPN(6)) ? (float*)(ws + WS_OUTB) : (float*)(ws + WS_XRES), (const float*)(ws + WS_MOD) + (size_t)l * NBATCH * 6144 + 2 * D};
            pg8::gemm_phase<pg8::EpiResid, pg8::PlainSched, true>(lds, 1024, S, E, wv);
            SEAM(pb + 5);
        }
        if (EN(7) && IN(pb + 6)) for (int rr = 0; rr < REPN(7); ++rr) { unsigned char* ws = opaque_ptr(ws0); const int bid = opaque_bid(); (void)bid; (void)ws; phase_h(a, l, l + DEPTH * rr, lds, wv); SEAM(pb + 6); }
        if (EN(8) && IN(pb + 7)) for (int rr = 0; rr < REPN(8); ++rr) { unsigned char* ws = opaque_ptr(ws0); const int bid = opaque_bid(); (void)bid; (void)ws;
            moe_tables(a, l + DEPTH * (REPN(7) - 1), lds, wv);
            LAS unsigned char* lds_o = lds; asm volatile("" : "+s"(lds_o)); const MoeTab mt = moe_tab_ptrs(lds_o);
            MoeSched1 S{(const char*)(ws + WS_H), (const char*)(ws + WS_WEIN) + (size_t)l * NE * 2048 * 1024, (const int*)(ws + WS_TOKOF), mt, __builtin_amdgcn_readfirstlane(mt.tilestart[NE]), G, bid};
            pg8::EpiSwiglu E{(unsigned char*)(ws + WS_ACT), a.in[I_BEIN] + (size_t)l * NE * 2048, 1.0f / WEIN_SCALE};
            pg8::gemm_phase<pg8::EpiSwiglu, MoeSched1, true, 1>(lds, 512, S, E, wv);
            SEAM(pb + 7);
        }
        if (EN(9) && IN(pb + 8)) for (int rr = 0; rr < REPN(9); ++rr) { unsigned char* ws = opaque_ptr(ws0); const int bid = opaque_bid(); (void)bid; (void)ws;
            moe_tables(a, l + DEPTH * (REPN(7) - 1), lds, wv);
            LAS unsigned char* lds_o = lds; asm volatile("" : "+s"(lds_o)); const MoeTab mt = moe_tab_ptrs(lds_o);
            MoeSched2 S{(const char*)(ws + WS_ACT), (const char*)(ws + WS_WEOUT) + (size_t)l * NE * 1024 * 1024, mt, __builtin_amdgcn_readfirstlane(mt.tilestart[NE]), G, bid};
            pg8::EpiMoeOut E{(bf16_t*)(ws + WS_OUTB), a.in[I_BEOUT] + (size_t)l * NE * D, 1.0f / WEIN_SCALE};
            pg8::gemm_phase<pg8::EpiMoeOut, MoeSched2, true, 1>(lds, 512, S, E, wv);
            SEAM(pb + 8);
        }
    }
    if (EN(10) && IN(N_PHASES - 1)) phase_a(a, DEPTH, lds, false, wv);
#undef IN
#undef SEAM
}

extern "C" void kernel_launch(void* const* d_in, const int* in_sizes, int n_in, void* d_out, int out_size, void* d_ws, size_t ws_size, hipStream_t stream) {
    static int grid = 0;
    if (grid == 0) {
        if (n_in != 26 || out_size != T * D || ws_size < WS_END) { fprintf(stderr, "kernel_launch: unexpected problem (n_in %d out %d ws %zu)\n", n_in, out_size, ws_size); grid = -1; return; }
        int dev = 0, cus = 0, per_cu = 0;
        if (hipGetDevice(&dev) != hipSuccess || hipDeviceGetAttribute(&cus, hipDeviceAttributeMultiprocessorCount, dev) != hipSuccess) { grid = -1; return; }
        if (hipFuncSetAttribute((const void*)fwd_kernel, hipFuncAttributeMaxDynamicSharedMemorySize, LDS_BYTES) != hipSuccess) { fprintf(stderr, "kernel_launch: hipFuncSetAttribute failed\n"); grid = -1; return; }
        if (hipOccupancyMaxActiveBlocksPerMultiprocessor(&per_cu, (const void*)fwd_kernel, NTHREADS, LDS_BYTES) != hipSuccess || per_cu < 1) fprintf(stderr, "kernel_launch: occupancy query says %d\n", per_cu);
        (void)hipGetLastError();
        grid = cus;
    }
    if (grid < 0) return;
    if (hipMemsetAsync((char*)d_ws + WS_CTL, 0, CTL_ZERO_BYTES, stream) != hipSuccess) return;
    if (hipMemsetAsync((char*)d_ws + WS_AGG, 0, AGG_BYTES, stream) != hipSuccess) return;
    Args a{};
    for (int i = 0; i < 26; ++i) a.in[i] = (const float*)d_in[i];
    a.out = (float*)d_out; a.ws = (unsigned char*)d_ws;
#if MK_PER_PHASE
    for (int p = 0; p < N_PHASES; ++p) { a.ph_lo = p; a.ph_hi = p + 1; hipLaunchKernelGGL(fwd_kernel, dim3(grid), dim3(NTHREADS), LDS_BYTES, stream, a); }
#else
    a.ph_lo = 0; a.ph_hi = N_PHASES;
    hipLaunchKernelGGL(fwd_kernel, dim3(grid), dim3(NTHREADS), LDS_BYTES, stream, a);
#endif
    const hipError_t le = hipPeekAtLastError();
    if (le != hipSuccess) fprintf(stderr, "kernel_launch: launch failed: %s\n", hipGetErrorName(le));
}
```

```cpp
#include <hip/hip_runtime.h>
#include <cstdio>
#include <cstdint>

#define REP_MASK 0x0
#ifndef PH_MASK
#define PH_MASK 0x7ff
#endif
#define EN(b) ((PH_MASK >> (b)) & 1)
#ifndef REP_MASK
#define REP_MASK 0
#endif
#define REPN(b) ((((REP_MASK) >> (b)) & 1) ? 2 : 1)
#ifndef Z_I8
#define Z_I8 1
#endif
#ifndef Z_FP8
#define Z_FP8 0
#endif
#ifndef MK_PER_PHASE
#define MK_PER_PHASE 0
#endif

#define LAS __attribute__((address_space(3)))
typedef unsigned short bf16_t;
typedef short bf16x8 __attribute__((ext_vector_type(8)));
typedef float f32x4 __attribute__((ext_vector_type(4)));
typedef float f32x2 __attribute__((ext_vector_type(2)));
typedef float f32x16 __attribute__((ext_vector_type(16)));
typedef unsigned u32x4 __attribute__((ext_vector_type(4)));
typedef unsigned u32x2 __attribute__((ext_vector_type(2)));

constexpr int D = 1024, NBATCH = 8, SEQ = 4096, T = NBATCH * SEQ, DEPTH = 4;
constexpr int NZ = 4608, ZO_GLRU = 1024, ZO_XPOOL = 2048, ZO_GL0 = 2560, ZO_GL1 = 3584;
constexpr int NE = 32, TOPK = 4;
constexpr int KCAT = 1536;
constexpr int SLOT_CAP = T * TOPK + NE * 256;
constexpr int MAX_MT = SLOT_CAP / 256;
constexpr float NORM_EPS = 1e-6f;
constexpr float WEIN_SCALE = 64.0f;
constexpr int NTHREADS = 512, NWAVES = 8;

constexpr size_t MiB = 1u << 20;
constexpr size_t WS_CTL = 0, CTL_ZERO_BYTES = 256 * 1024;
constexpr size_t WS_MOD = 1 * MiB;
constexpr size_t WS_CB = 2 * MiB;
constexpr size_t WS_AGG = 72 * MiB;
constexpr size_t AGG_BYTES = (size_t)DEPTH * NBATCH * 32 * D * 8;
constexpr size_t WS_WRS = 3 * MiB;
constexpr size_t WS_HSC = 4 * MiB;
constexpr size_t WS_WINSC = 5 * MiB;
constexpr size_t WS_TOKOF = 6 * MiB;
constexpr size_t WS_SLOTINFO = 10 * MiB;
constexpr size_t WS_WGT = 11 * MiB;
constexpr size_t WS_WRG = 12 * MiB;
constexpr size_t WS_WPOOL = 14 * MiB;
constexpr size_t WS_WIN = 16 * MiB;
constexpr size_t WS_WCAT = 52 * MiB;
constexpr size_t WS_WOUT = 64 * MiB;
constexpr size_t WS_WEIN = 128 * MiB;
constexpr size_t WS_WEOUT = 640 * MiB;
constexpr size_t WS_XRES = 896 * MiB;
constexpr size_t WS_H = 1024 * MiB;
constexpr size_t WS_Z = 1088 * MiB;
constexpr size_t WS_ACAT = 1376 * MiB;
constexpr size_t WS_MERGED = 1472 * MiB;
constexpr size_t WS_ACT = 1536 * MiB;
constexpr size_t WS_OUTB = 1808 * MiB;
constexpr size_t WS_OUTSC = WS_OUTB + 144 * MiB;
constexpr size_t WS_END = 2080 * MiB;
static_assert(WS_ACT + (size_t)SLOT_CAP * 1024 * 2 <= WS_OUTB && WS_OUTB + (size_t)SLOT_CAP * 1024 * 2 <= WS_END, "ws map");
constexpr int CW_BAR = 4096;
constexpr int CW_CONVQ = 7680;
constexpr int CW_CNT = 8192;

constexpr int LDS_BYTES = 163840;
constexpr int LDS_TAB = 131072;
constexpr int LDS_NVA = 131072 + 8192;
constexpr int LDS_MISC = LDS_BYTES - 256;

__device__ __forceinline__ unsigned cvt_pk_bf16(float lo, float hi) { unsigned r; asm("v_cvt_pk_bf16_f32 %0, %1, %2" : "=v"(r) : "v"(lo), "v"(hi)); return r; }
__device__ __forceinline__ float bflo(unsigned w) { return __uint_as_float(w << 16); }
__device__ __forceinline__ float bfhi(unsigned w) { return __uint_as_float(w & 0xffff0000u); }
__device__ __forceinline__ float bf1(bf16_t w) { return __uint_as_float(((unsigned)w) << 16); }
__device__ __forceinline__ float sigmoidf_(float x) { return __builtin_amdgcn_rcpf(1.0f + __expf(-x)); }
__device__ __forceinline__ float shflx(float v, int mask, int lane) { return __int_as_float(__builtin_amdgcn_ds_bpermute((lane ^ mask) << 2, __float_as_int(v))); }
__device__ __forceinline__ float wave_sum(float v, int lane) {
#pragma unroll
    for (int o = 1; o < 64; o <<= 1) v += shflx(v, o, lane);
    return v;
}
__device__ __forceinline__ int tid_of(int wv) { int l; asm volatile("v_mbcnt_lo_u32_b32 %0, -1, 0\n\tv_mbcnt_hi_u32_b32 %0, -1, %0" : "=v"(l)); return wv * 64 + l; }
__device__ __forceinline__ int opaque_bid() { int b = blockIdx.x; asm volatile("" : "+s"(b)); return b; }
__device__ __forceinline__ unsigned char* opaque_ptr(unsigned char* p) { size_t z = 0; asm volatile("" : "+s"(z)); return p + z; }
#define LDS_WAIT() asm volatile("s_waitcnt lgkmcnt(0)" ::: "memory")
#define VM_WAIT() asm volatile("s_waitcnt vmcnt(0)" ::: "memory")

namespace pg8 {
constexpr int BM = 256, BK = 64, HALF = 128, HTB = HALF * BK * 2, STAGE_BYTES = 8 * HTB, NXCD = 8, WGM = 8;
__host__ __device__ __forceinline__ int lds_byte(int r, int c) { const int st = (r >> 4) * 2 + (c >> 5), rr = r & 15, cc = c & 31, ob = rr * 64 + cc * 2; return st * 1024 + (ob ^ (((ob >> 9) & 1) << 5)); }
__host__ __device__ __forceinline__ void stage_rc(int b, int& R, int& C) { const int st = b / 1024, sb = b % 1024, swz = sb ^ (((sb >> 9) & 1) << 5); R = (st >> 1) * 16 + swz / 64; C = (st & 1) * 32 + (swz % 64) / 2; }
__host__ __device__ __forceinline__ int perm32(int rho) { const int n = rho >> 4, i = rho & 15; return 8 * (i >> 2) + 4 * n + (i & 3); }

struct Unit { int pm, pn, e, j, row0, rows; };
typedef int v8i32 __attribute__((ext_vector_type(8)));
typedef int v4i32_t __attribute__((ext_vector_type(4)));
__device__ __forceinline__ v8i32 cat8(bf16x8 lo, bf16x8 hi) { typedef int v4i32 __attribute__((ext_vector_type(4))); const v4i32 a = __builtin_bit_cast(v4i32, lo), b = __builtin_bit_cast(v4i32, hi); return (v8i32){a.x, a.y, a.z, a.w, b.x, b.y, b.z, b.w}; }

__device__ __forceinline__ bool order_map(int i, int G, int c, int nM, int nN, int& pm, int& pn) {
    const int nwg = nM * nN; const int L = i * G + c; if (L >= nwg) return false;
    int wgid = L; { const int q = nwg / NXCD, r = nwg % NXCD, xcd = wgid % NXCD, off = wgid / NXCD; wgid = (xcd < r ? xcd * (q + 1) : r * (q + 1) + (xcd - r) * q) + off; }
    const int nig = WGM * nN, gid = wgid / nig, fm = gid * WGM, gsz = (nM - fm) < WGM ? (nM - fm) : WGM;
    pm = fm + ((wgid % nig) % gsz); pn = (wgid % nig) / gsz; return true;
}

struct PlainSched {
    static constexpr bool DYN_A = false;
    const char* A; const char* Bt; int K, nM, nN, G, c;
    __device__ __forceinline__ bool next(int i, Unit& u) const { int pm, pn; if (!order_map(i, G, c, nM, nN, pm, pn)) return false; u.pm = pm; u.pn = pn; u.e = 0; u.j = 0; u.row0 = pm * BM; u.rows = BM; return true; }
    __device__ __forceinline__ const char* a_ptr() const { return A; }
    __device__ __forceinline__ const char* b_ptr() const { return Bt; }
    __device__ __forceinline__ unsigned a_off(const Unit& u) const { return (unsigned)u.row0 * (unsigned)K * 2u; }
    __device__ __forceinline__ unsigned b_off(const Unit& u) const { return (unsigned)u.pn * (unsigned)(BM * K * 2); }
    __device__ __forceinline__ void a_voff(const Unit&, unsigned (&v)[2][2], int wv) const {
        int tid = tid_of(wv); asm volatile("" : "+v"(tid));
#pragma unroll
        for (int i = 0; i < 2; ++i) { int R, C; stage_rc(tid * 16 + i * 8192, R, C);
#pragma unroll
            for (int h = 0; h < 2; ++h) v[h][i] = (unsigned)((h * HALF + R) * K + C) * 2u; }
    }
};

template <class Epi, class Sched, bool ALIGN_EPI, int MODE = 0>
__device__ __forceinline__ void gemm_phase(LAS unsigned char* lds, const int K, const Sched& S, const Epi& E, const int wv) {
    asm volatile("" : "+s"(lds));
    int tid = tid_of(wv); asm volatile("" : "+v"(tid));
    const int wid = __builtin_amdgcn_readfirstlane(tid >> 6), lane = tid & 63, wr = wid >> 2, wc = wid & 3, fr = lane & 15, fq = lane >> 4;
    const int nt = K / BK;
    unsigned voffB;
    { int R, C; stage_rc(tid * 16, R, C); const int Rb = Epi::PERM ? ((R & ~31) + perm32(R & 31)) : R; voffB = (unsigned)(Rb * K + C) * 2u; }
    const unsigned q64 = (unsigned)(64 * K * 2);
    const unsigned kstep = (unsigned)(BK * 2);
    const unsigned hstep = (unsigned)(HALF * K * 2);
    const __amdgpu_buffer_rsrc_t rsA = __builtin_amdgcn_make_buffer_rsrc((void*)S.a_ptr(), 0, 0xffffffff, 0x00020000);
    const __amdgpu_buffer_rsrc_t rsB = __builtin_amdgcn_make_buffer_rsrc((void*)S.b_ptr(), 0, 0xffffffff, 0x00020000);
    const unsigned ldsw = (unsigned)wid * 1024u;
    const int aoff = lds_byte(wr * 64 + fr, fq * 8), boff = lds_byte(wc * 32 + fr, fq * 8);
#define PG8_SA(b, h) (((b) * 2 + (h)) * HTB)
#define PG8_SB(b, h) ((4 + (b) * 2 + (h)) * HTB)
#define PG8_STAGE_(rs, bufoff, v0, s0, v1, s1) do { \
        __builtin_amdgcn_raw_ptr_buffer_load_lds(rs, (LAS void*)(lds + (bufoff) + ldsw), 16, (v0), (s0), 0, 0); \
        __builtin_amdgcn_raw_ptr_buffer_load_lds(rs, (LAS void*)(lds + (bufoff) + ldsw + 8192), 16, (v1), (s1), 0, 0); } while (0)
#define PG8_STAGE_B(bufoff, soff, unused) PG8_STAGE_(rsB, bufoff, voffB, (soff), voffB, (soff) + q64)
#define PG8_STAGE_A(bufoff, soff, h) do { if constexpr (Sched::DYN_A) PG8_STAGE_(rsA, bufoff, cvA[h][0], (soff), cvA[h][1], (soff)); \
        else PG8_STAGE_(rsA, bufoff, cvA[0][0], (soff) + (h) * 2u * q64, cvA[0][0], (soff) + (h) * 2u * q64 + q64); } while (0)
#define PG8_LDA(dst, b, h) do { _Pragma("unroll") for (int m = 0; m < 4; ++m) _Pragma("unroll") for (int k = 0; k < 2; ++k) dst[m][k] = *(const LAS bf16x8*)(lds + PG8_SA(b, h) + aoff + m * 2048 + k * 1024); } while (0)
#define PG8_LDB(dst, b, h) do { _Pragma("unroll") for (int n = 0; n < 2; ++n) _Pragma("unroll") for (int k = 0; k < 2; ++k) dst[n][k] = *(const LAS bf16x8*)(lds + PG8_SB(b, h) + boff + n * 2048 + k * 1024); } while (0)
#define PG8_MMA(ai, bj, At, Bt) do { __builtin_amdgcn_s_setprio(1); _Pragma("unroll") for (int m = 0; m < 4; ++m) _Pragma("unroll") for (int n = 0; n < 2; ++n) { \
        if constexpr (MODE == 1) { acc[ai][bj][m][n] = __builtin_amdgcn_mfma_scale_f32_16x16x128_f8f6f4(cat8(Bt[n][0], Bt[n][1]), cat8(At[m][0], At[m][1]), acc[ai][bj][m][n], 0, 0, 0, 0x7f7f7f7f, 0, 0x7f7f7f7f); } \
        else if constexpr (MODE == 2) { _Pragma("unroll") for (int k = 0; k < 2; ++k) acc[ai][bj][m][n] = __builtin_bit_cast(f32x4, __builtin_amdgcn_mfma_i32_16x16x64_i8(__builtin_bit_cast(v4i32_t, Bt[n][k]), __builtin_bit_cast(v4i32_t, At[m][k]), __builtin_bit_cast(v4i32_t, acc[ai][bj][m][n]), 0, 0, 0)); } \
        else { _Pragma("unroll") for (int k = 0; k < 2; ++k) acc[ai][bj][m][n] = __builtin_amdgcn_mfma_f32_16x16x32_bf16(Bt[n][k], At[m][k], acc[ai][bj][m][n], 0, 0, 0); } } \
        __builtin_amdgcn_s_setprio(0); } while (0)
#define PG8_WAIT_V(n) asm volatile("s_waitcnt vmcnt(" #n ")" ::: "memory")
#define PG8_WAIT_L(n) asm volatile("s_waitcnt lgkmcnt(" #n ")" ::: "memory")
#define PG8_BAR __builtin_amdgcn_s_barrier()
#define PG8_SCHED __builtin_amdgcn_sched_barrier(0)
    Unit cur, nxt; int ui = 0;
    if (!S.next(0, cur)) return;
    f32x4 acc[2][2][4][2];
    { float z0 = 0.f; asm volatile("" : "+v"(z0));
#pragma unroll
    for (int a = 0; a < 2; ++a)
#pragma unroll
        for (int b = 0; b < 2; ++b)
#pragma unroll
            for (int m = 0; m < 4; ++m)
#pragma unroll
                for (int n = 0; n < 2; ++n) acc[a][b][m][n] = (f32x4){z0, z0, z0, z0}; }
    bf16x8 At[4][2], B0[2][2], B1[2][2];
    unsigned cvA[2][2];
    LAS u32x4* nvp = (LAS u32x4*)(lds + LDS_NVA) + tid;
    S.a_voff(cur, cvA, wv);
    unsigned cA = S.a_off(cur), cB = S.b_off(cur);
    PG8_STAGE_B(PG8_SB(0, 0), cB, voffB); PG8_STAGE_B(PG8_SB(0, 1), cB + hstep, voffB); PG8_STAGE_A(PG8_SA(0, 0), cA, 0); PG8_STAGE_A(PG8_SA(0, 1), cA, 1);
    if (wr == 1) PG8_BAR;
    PG8_WAIT_V(2); PG8_BAR;
    PG8_STAGE_B(PG8_SB(1, 0), cB + kstep, voffB); PG8_STAGE_A(PG8_SA(1, 0), cA + kstep, 0); PG8_STAGE_B(PG8_SB(1, 1), cB + hstep + kstep, voffB);
    PG8_WAIT_V(6); PG8_BAR;
    for (;;) {
        const bool has_next = S.next(ui + 1, nxt);
        unsigned nA = cA, nB = cB;
        if (has_next) { nA = S.a_off(nxt); nB = S.b_off(nxt); }
        if constexpr (Sched::DYN_A) { unsigned nv[2][2];
            if (has_next) S.a_voff(nxt, nv, wv); else {
#pragma unroll
                for (int h = 0; h < 2; ++h)
#pragma unroll
                    for (int i = 0; i < 2; ++i) nv[h][i] = cvA[h][i]; }
            *nvp = (u32x4){nv[0][0], nv[0][1], nv[1][0], nv[1][1]}; }
#pragma unroll 1
        for (int t = 0; t < nt; t += 2) {
            const bool last = (t == nt - 2);
            const unsigned a1 = cA + (unsigned)(t + 1) * kstep;
            const unsigned a2 = last ? nA : cA + (unsigned)(t + 2) * kstep, b2 = last ? nB : cB + (unsigned)(t + 2) * kstep;
            const unsigned a3 = a2 + kstep, b3 = b2 + kstep;
            unsigned nx1[2] = {cvA[1][0], cvA[1][1]};
            if constexpr (Sched::DYN_A) { if (last) { const u32x4 q = *nvp; cvA[0][0] = q.x; cvA[0][1] = q.y; nx1[0] = q.z; nx1[1] = q.w; } }
            if constexpr (Epi::HOOK_T >= 0) { if (t == Epi::HOOK_T) E.mid(acc, cur, wr, wc, fr, fq); }
            PG8_LDB(B0, 0, 0); PG8_LDB(B1, 0, 1); PG8_SCHED; PG8_LDA(At, 0, 0); PG8_STAGE_A(PG8_SA(1, 1), a1, 1);
            if constexpr (Sched::DYN_A) { cvA[1][0] = nx1[0]; cvA[1][1] = nx1[1]; }
            PG8_WAIT_V(8); PG8_WAIT_L(0); PG8_BAR; PG8_MMA(0, 0, At, B0); PG8_MMA(0, 1, At, B1); PG8_BAR; PG8_SCHED;
            PG8_LDA(At, 0, 1); PG8_STAGE_B(PG8_SB(0, 0), b2, voffB); PG8_STAGE_B(PG8_SB(0, 1), b2 + hstep, voffB); PG8_STAGE_A(PG8_SA(0, 0), a2, 0);
            PG8_WAIT_V(8); PG8_WAIT_L(0); PG8_BAR; PG8_MMA(1, 0, At, B0); PG8_MMA(1, 1, At, B1); PG8_BAR; PG8_SCHED;
            PG8_LDB(B0, 1, 0); PG8_LDB(B1, 1, 1); PG8_SCHED; PG8_LDA(At, 1, 0); PG8_STAGE_A(PG8_SA(0, 1), a2, 1);
            PG8_WAIT_V(8); PG8_WAIT_L(0); PG8_BAR; PG8_MMA(0, 0, At, B0); PG8_MMA(0, 1, At, B1); PG8_BAR; PG8_SCHED;
            PG8_LDA(At, 1, 1); PG8_STAGE_B(PG8_SB(1, 0), b3, voffB); PG8_STAGE_B(PG8_SB(1, 1), b3 + hstep, voffB); PG8_STAGE_A(PG8_SA(1, 0), a3, 0);
            PG8_WAIT_V(8); PG8_WAIT_L(0); PG8_BAR; PG8_MMA(1, 0, At, B0); PG8_MMA(1, 1, At, B1); PG8_BAR; PG8_SCHED;
        }
        if constexpr (ALIGN_EPI) { if (wr == 0) PG8_BAR; }
        E(acc, cur, wr, wc, fr, fq);
        if (!has_next) break;
        { float z0 = 0.f; asm volatile("" : "+v"(z0));
#pragma unroll
        for (int a = 0; a < 2; ++a)
#pragma unroll
            for (int b = 0; b < 2; ++b)
#pragma unroll
                for (int m = 0; m < 4; ++m)
#pragma unroll
                    for (int n = 0; n < 2; ++n) acc[a][b][m][n] = (f32x4){z0, z0, z0, z0}; }
        cur = nxt; cA = nA; cB = nB; ++ui;
        if constexpr (ALIGN_EPI) { if (wr == 1) PG8_BAR; }
    }
    PG8_WAIT_V(0);
    if constexpr (!ALIGN_EPI) { if (wr == 0) PG8_BAR; }
    PG8_BAR;
#undef PG8_SA
#undef PG8_SB
#undef PG8_STAGE_
#undef PG8_STAGE_A
#undef PG8_STAGE_B
#undef PG8_LDA
#undef PG8_LDB
#undef PG8_MMA
#undef PG8_WAIT_V
#undef PG8_WAIT_L
#undef PG8_BAR
#undef PG8_SCHED
}

struct EpiBf16 {
    static constexpr bool PERM = true; static constexpr int HOOK_T = -1;
    bf16_t* O; int ldc; const float* bias; int noepi; float scale;
    __device__ __forceinline__ void mid(f32x4 (&)[2][2][4][2], const Unit&, int, int, int, int) const {}
    __device__ __forceinline__ void operator()(const f32x4 (&acc)[2][2][4][2], const Unit& u, int wr, int wc, int fr, int fq) const {
        { const int l_ = tid_of(0); fr = l_ & 15; fq = l_ >> 4; }
        if (noepi) { if (acc[0][0][0][0][0] == 1.2345e-30f) O[0] = 0; return; }
        int row0 = u.row0 + wr * 64 + fr; asm volatile("" : "+v"(row0)); int col0 = u.pn * BM + wc * 32 + 8 * fq; asm volatile("" : "+v"(col0));
        f32x4 bv[2][2];
#pragma unroll
        for (int bj = 0; bj < 2; ++bj)
#pragma unroll
            for (int n = 0; n < 2; ++n) bv[bj][n] = bias ? *(const f32x4*)(bias + col0 + bj * HALF + 4 * n) : (f32x4){0.f, 0.f, 0.f, 0.f};
#pragma unroll
        for (int ai = 0; ai < 2; ++ai)
#pragma unroll
            for (int m = 0; m < 4; ++m) { bf16_t* rowp = O + (size_t)(row0 + ai * HALF + m * 16) * ldc + col0;
#pragma unroll
                for (int bj = 0; bj < 2; ++bj) { const f32x4 v0 = acc[ai][bj][m][0] * scale + bv[bj][0], v1 = acc[ai][bj][m][1] * scale + bv[bj][1];
                    u32x4 w; w.x = cvt_pk_bf16(v0[0], v0[1]); w.y = cvt_pk_bf16(v0[2], v0[3]); w.z = cvt_pk_bf16(v1[0], v1[1]); w.w = cvt_pk_bf16(v1[2], v1[3]);
                    *(u32x4*)(rowp + bj * HALF) = w; } }
    }
};
struct EpiZI8 {
    static constexpr bool PERM = true; static constexpr int HOOK_T = -1;
    bf16_t* O; const float* rsc; const float* csc;
    __device__ __forceinline__ void mid(f32x4 (&)[2][2][4][2], const Unit&, int, int, int, int) const {}
    __device__ __forceinline__ void operator()(const f32x4 (&acc)[2][2][4][2], const Unit& u, int wr, int wc, int fr, int fq) const {
        { const int l_ = tid_of(0); fr = l_ & 15; fq = l_ >> 4; }
        int row0 = u.row0 + wr * 64 + fr; asm volatile("" : "+v"(row0)); int col0 = u.pn * BM + wc * 32 + 8 * fq; asm volatile("" : "+v"(col0));
        f32x4 cs[2][2];
#pragma unroll
        for (int bj = 0; bj < 2; ++bj)
#pragma unroll
            for (int n = 0; n < 2; ++n) cs[bj][n] = *(const f32x4*)(csc + col0 + bj * HALF + 4 * n);
#pragma unroll
        for (int ai = 0; ai < 2; ++ai)
#pragma unroll
            for (int m = 0; m < 4; ++m) { const int r = row0 + ai * HALF + m * 16; const float rs = rsc[r]; bf16_t* rowp = O + (size_t)r * NZ + col0;
#pragma unroll
                for (int bj = 0; bj < 2; ++bj) { const v4i32_t i0 = __builtin_bit_cast(v4i32_t, acc[ai][bj][m][0]), i1 = __builtin_bit_cast(v4i32_t, acc[ai][bj][m][1]);
                    const f32x4 v0 = (f32x4){(float)i0.x, (float)i0.y, (float)i0.z, (float)i0.w} * rs * cs[bj][0], v1 = (f32x4){(float)i1.x, (float)i1.y, (float)i1.z, (float)i1.w} * rs * cs[bj][1];
                    u32x4 w; w.x = cvt_pk_bf16(v0[0], v0[1]); w.y = cvt_pk_bf16(v0[2], v0[3]); w.z = cvt_pk_bf16(v1[0], v1[1]); w.w = cvt_pk_bf16(v1[2], v1[3]);
                    *(u32x4*)(rowp + bj * HALF) = w; } }
    }
};
struct EpiMerged {
    static constexpr bool PERM = true; static constexpr int HOOK_T = 8;
    bf16_t* O; const bf16_t* Z;
    __device__ __forceinline__ void mid(f32x4 (&acc)[2][2][4][2], const Unit& u, int wr, int wc, int fr, int fq) const {
        { const int l_ = tid_of(0); fr = l_ & 15; fq = l_ >> 4; }
        int row0 = u.row0 + wr * 64 + fr; asm volatile("" : "+v"(row0)); int col0 = u.pn * BM + wc * 32 + 8 * fq; asm volatile("" : "+v"(col0));
#pragma unroll
        for (int ai = 0; ai < 2; ++ai) {
            u32x4 l0[4][2], l1[4][2];
#pragma unroll
            for (int m = 0; m < 4; ++m) { const bf16_t* zr = Z + (size_t)(row0 + ai * HALF + m * 16) * NZ + col0;
#pragma unroll
                for (int bj = 0; bj < 2; ++bj) { l0[m][bj] = *(const u32x4*)(zr + ZO_GL0 + bj * HALF); l1[m][bj] = *(const u32x4*)(zr + ZO_GL1 + bj * HALF); } }
#pragma unroll
            for (int m = 0; m < 4; ++m)
#pragma unroll
                for (int bj = 0; bj < 2; ++bj) {
                    const unsigned a0[4] = {l0[m][bj].x, l0[m][bj].y, l0[m][bj].z, l0[m][bj].w}, a1[4] = {l1[m][bj].x, l1[m][bj].y, l1[m][bj].z, l1[m][bj].w};
#pragma unroll
                    for (int q = 0; q < 4; ++q) {
                        const float r0 = (1.0f + __expf(-bflo(a0[q]))) * __builtin_amdgcn_rcpf(1.0f + __expf(-bflo(a1[q])));
                        const float r1 = (1.0f + __expf(-bfhi(a0[q]))) * __builtin_amdgcn_rcpf(1.0f + __expf(-bfhi(a1[q])));
                        acc[ai][bj][m][q >> 1][(q & 1) * 2 + 0] *= r0; acc[ai][bj][m][q >> 1][(q & 1) * 2 + 1] *= r1; } }
            asm volatile("" ::: "memory"); }
    }
    __device__ __forceinline__ void operator()(const f32x4 (&acc)[2][2][4][2], const Unit& u, int wr, int wc, int fr, int fq) const {
        { const int l_ = tid_of(0); fr = l_ & 15; fq = l_ >> 4; }
        int row0 = u.row0 + wr * 64 + fr; asm volatile("" : "+v"(row0)); int col0 = u.pn * BM + wc * 32 + 8 * fq; asm volatile("" : "+v"(col0));
        u32x4 l0[2][4][2];
#pragma unroll
        for (int ai = 0; ai < 2; ++ai)
#pragma unroll
            for (int m = 0; m < 4; ++m) { const bf16_t* zr = Z + (size_t)(row0 + ai * HALF + m * 16) * NZ + col0;
#pragma unroll
                for (int bj = 0; bj < 2; ++bj) l0[ai][m][bj] = *(const u32x4*)(zr + ZO_GL0 + bj * HALF); }
#pragma unroll
        for (int ai = 0; ai < 2; ++ai)
#pragma unroll
            for (int m = 0; m < 4; ++m) { bf16_t* orow = O + (size_t)(row0 + ai * HALF + m * 16) * D + col0;
#pragma unroll
                for (int bj = 0; bj < 2; ++bj) {
                    const unsigned a0[4] = {l0[ai][m][bj].x, l0[ai][m][bj].y, l0[ai][m][bj].z, l0[ai][m][bj].w};
                    float o[8];
#pragma unroll
                    for (int q = 0; q < 4; ++q) { o[2 * q] = acc[ai][bj][m][q >> 1][(q & 1) * 2 + 0] * sigmoidf_(bflo(a0[q])); o[2 * q + 1] = acc[ai][bj][m][q >> 1][(q & 1) * 2 + 1] * sigmoidf_(bfhi(a0[q])); }
                    u32x4 w; w.x = cvt_pk_bf16(o[0], o[1]); w.y = cvt_pk_bf16(o[2], o[3]); w.z = cvt_pk_bf16(o[4], o[5]); w.w = cvt_pk_bf16(o[6], o[7]);
                    *(u32x4*)(orow + bj * HALF) = w; } }
    }
};
struct EpiResid {
    static constexpr bool PERM = false; static constexpr int HOOK_T = -1;
    float* X; float* XO; const float* gate;
    __device__ __forceinline__ void mid(f32x4 (&)[2][2][4][2], const Unit&, int, int, int, int) const {}
    __device__ __forceinline__ void operator()(const f32x4 (&acc)[2][2][4][2], const Unit& u, int wr, int wc, int fr, int fq) const {
        { const int l_ = tid_of(0); fr = l_ & 15; fq = l_ >> 4; }
        int row0 = u.row0 + wr * 64 + fr; asm volatile("" : "+v"(row0)); int col0 = u.pn * BM + wc * 32 + 4 * fq; asm volatile("" : "+v"(col0));
        const float* gp = gate + (size_t)(u.row0 / SEQ) * (6 * D) + col0;
        f32x4 gv[2][2];
#pragma unroll
        for (int bj = 0; bj < 2; ++bj)
#pragma unroll
            for (int n = 0; n < 2; ++n) gv[bj][n] = *(const f32x4*)(gp + bj * HALF + n * 16);
#pragma unroll
        for (int ai = 0; ai < 2; ++ai) {
            f32x4 xv[4][2][2];
#pragma unroll
            for (int m = 0; m < 4; ++m) { const float* rowp = X + (size_t)(row0 + ai * HALF + m * 16) * D + col0;
#pragma unroll
                for (int bj = 0; bj < 2; ++bj)
#pragma unroll
                    for (int n = 0; n < 2; ++n) xv[m][bj][n] = *(const f32x4*)(rowp + bj * HALF + n * 16); }
#pragma unroll
            for (int m = 0; m < 4; ++m) { float* rowo = XO + (size_t)(row0 + ai * HALF + m * 16) * D + col0;
#pragma unroll
                for (int bj = 0; bj < 2; ++bj)
#pragma unroll
                    for (int n = 0; n < 2; ++n) *(f32x4*)(rowo + bj * HALF + n * 16) = xv[m][bj][n] + gv[bj][n] * acc[ai][bj][m][n]; }
            asm volatile("" ::: "memory"); }
    }
};
struct EpiSwiglu {
    static constexpr bool PERM = true; static constexpr int HOOK_T = -1;
    unsigned char* ACT; const float* bias; float wscale;
    __device__ __forceinline__ void mid(f32x4 (&)[2][2][4][2], const Unit&, int, int, int, int) const {}
    __device__ __forceinline__ void operator()(const f32x4 (&acc)[2][2][4][2], const Unit& u, int wr, int wc, int fr, int fq) const {
        { const int l_ = tid_of(0); fr = l_ & 15; fq = l_ >> 4; }
        int row0 = u.row0 + wr * 64 + fr; asm volatile("" : "+v"(row0)); int cc = u.pn * HALF + wc * 32 + 8 * fq; asm volatile("" : "+v"(cc));
        const float* bp = bias + (size_t)u.e * 2048 + cc;
        f32x4 bg[2], bu[2];
#pragma unroll
        for (int n = 0; n < 2; ++n) { bg[n] = *(const f32x4*)(bp + 4 * n); bu[n] = *(const f32x4*)(bp + 1024 + 4 * n); }
#pragma unroll
        for (int ai = 0; ai < 2; ++ai)
#pragma unroll
            for (int m = 0; m < 4; ++m) { unsigned char* rowp = ACT + (size_t)(row0 + ai * HALF + m * 16) * D + cc;
                float o[8];
#pragma unroll
                for (int n = 0; n < 2; ++n)
#pragma unroll
                    for (int j = 0; j < 4; ++j) { float g = acc[ai][0][m][n][j] * wscale + bg[n][j], up = acc[ai][1][m][n][j] * wscale + bu[n][j];
                        g = fminf(g, 7.0f); up = fminf(fmaxf(up, -7.0f), 7.0f);
                        o[4 * n + j] = g * sigmoidf_(1.702f * g) * (up + 1.0f); }
                int w0 = 0, w1 = 0;
                w0 = __builtin_amdgcn_cvt_pk_fp8_f32(o[0], o[1], w0, false); w0 = __builtin_amdgcn_cvt_pk_fp8_f32(o[2], o[3], w0, true);
                w1 = __builtin_amdgcn_cvt_pk_fp8_f32(o[4], o[5], w1, false); w1 = __builtin_amdgcn_cvt_pk_fp8_f32(o[6], o[7], w1, true);
                *(u32x2*)rowp = (u32x2){(unsigned)w0, (unsigned)w1}; }
    }
};
struct EpiMoeOut {
    static constexpr bool PERM = true; static constexpr int HOOK_T = -1;
    unsigned char* O; float* SC; const float* bias; float wscale;
    __device__ __forceinline__ void mid(f32x4 (&)[2][2][4][2], const Unit&, int, int, int, int) const {}
    __device__ __forceinline__ void operator()(const f32x4 (&acc)[2][2][4][2], const Unit& u, int wr, int wc, int fr, int fq) const {
        int lane_; { lane_ = tid_of(0); fr = lane_ & 15; fq = lane_ >> 4; }
        int row0 = u.row0 + wr * 64 + fr; asm volatile("" : "+v"(row0)); int col0 = u.pn * BM + wc * 32 + 8 * fq; asm volatile("" : "+v"(col0));
        const float* bp = bias + (size_t)u.e * D + col0;
        f32x4 bv[2][2];
#pragma unroll
        for (int bj = 0; bj < 2; ++bj)
#pragma unroll
            for (int n = 0; n < 2; ++n) bv[bj][n] = *(const f32x4*)(bp + bj * HALF + 4 * n);
#pragma unroll
        for (int ai = 0; ai < 2; ++ai)
#pragma unroll
            for (int m = 0; m < 4; ++m) { const size_t r = (size_t)(row0 + ai * HALF + m * 16);
                f32x4 v[2][2]; float am = 1e-30f;
#pragma unroll
                for (int bj = 0; bj < 2; ++bj)
#pragma unroll
                    for (int n = 0; n < 2; ++n) { v[bj][n] = acc[ai][bj][m][n] * wscale + bv[bj][n];
                        am = fmaxf(am, fmaxf(fmaxf(fabsf(v[bj][n].x), fabsf(v[bj][n].y)), fmaxf(fabsf(v[bj][n].z), fabsf(v[bj][n].w)))); }
                am = fmaxf(am, shflx(am, 16, lane_)); am = fmaxf(am, shflx(am, 32, lane_));
                const float inv = 127.0f * __builtin_amdgcn_rcpf(am) * 0.999f;
                if (fq == 0) SC[r * 16 + wc * 4 + u.pn] = am * (1.0f / (127.0f * 0.999f));
#pragma unroll
                for (int bj = 0; bj < 2; ++bj) { unsigned w0 = 0, w1 = 0;
#pragma unroll
                    for (int j = 0; j < 4; ++j) { w0 |= (unsigned)((int)rintf(v[bj][0][j] * inv) + 128) << (8 * j); w1 |= (unsigned)((int)rintf(v[bj][1][j] * inv) + 128) << (8 * j); }
                    *(u32x2*)(O + r * D + col0 + bj * HALF) = (u32x2){w0, w1}; } }
    }
};
}

#define XB_TMO      128
#define XB_XCNT(j)  (256  + 64 * (j))
#define XB_XSUB(j)  (1280 + 64 * (j))
#define XB_XGEN(j)  (2304 + 64 * (j))
#define XB_TOP      3328
#define XB_TOPGEN   3392
#define XCD_BAR_WORDS 3456
#define XB_SPIN_CAP (1u << 18)
__device__ __forceinline__ unsigned xb_ld(unsigned* p)              { return __hip_atomic_load(p, __ATOMIC_RELAXED, __HIP_MEMORY_SCOPE_AGENT); }
__device__ __forceinline__ unsigned xb_add(unsigned* p, unsigned v) { return __hip_atomic_fetch_add(p, v, __ATOMIC_RELAXED, __HIP_MEMORY_SCOPE_AGENT); }
__device__ __forceinline__ unsigned xb_xcc_id() { return (unsigned)__builtin_amdgcn_s_getreg((3 << 11) | 20) & 0xFu; }
#define XB_SPIN(cond, bar) do { unsigned _sp = 0; while (cond) { __builtin_amdgcn_s_sleep(1); \
    if ((++_sp & 255u) == 0u) { if (xb_ld(&(bar)[XB_TMO])) break; if (_sp > XB_SPIN_CAP) { atomicAdd(&(bar)[XB_TMO], 1u); break; } } } } while (0)
struct XcdBarrier { unsigned* bar; unsigned x; volatile LAS unsigned* st; int wv; };
__device__ __forceinline__ XcdBarrier xcd_barrier_post(unsigned* bar, volatile LAS unsigned* st, int wv) {
    XcdBarrier b; b.bar = bar; b.x = xb_xcc_id(); b.st = st; b.wv = wv;
    if (tid_of(wv) == 0) (void)xb_add(&bar[XB_XCNT(b.x)], 1u);
    return b;
}
__device__ __forceinline__ void xcd_barrier_complete(unsigned* bar, unsigned x, unsigned& nloc, unsigned& nx) {
    const unsigned G = gridDim.x * gridDim.y * gridDim.z;
    unsigned sum, cnt, mine, sp = 0u;
    for (;;) {
        sum = 0u; cnt = 0u; mine = 0u;
#pragma unroll
        for (unsigned j = 0; j < 16; ++j) { const unsigned c = xb_ld(&bar[XB_XCNT(j)]); sum += c; cnt += (c > 0u) ? 1u : 0u; mine = (j == x) ? c : mine; }
        if (sum == G) break;
        __builtin_amdgcn_s_sleep(1);
        if ((++sp & 255u) == 0u) { if (xb_ld(&bar[XB_TMO])) break; if (sp > XB_SPIN_CAP) { atomicAdd(&bar[XB_TMO], 1u); break; } }
    }
    nloc = mine > 0u ? mine : 1u; nx = cnt > 0u ? cnt : 1u;
}
__device__ __forceinline__ void xcd_barrier(const XcdBarrier& b) {
    asm volatile("s_waitcnt vmcnt(0)" ::: "memory");
    __syncthreads();
    if (tid_of(b.wv) == 0) {
        size_t zb = 0; asm volatile("" : "+s"(zb)); unsigned* bar = b.bar + zb; unsigned bx = b.x; asm volatile("" : "+s"(bx));
        __builtin_amdgcn_s_waitcnt(0);
        unsigned nloc = b.st[0], nx = b.st[1];
        if (nloc == 0u) { xcd_barrier_complete(bar, bx, nloc, nx); b.st[0] = nloc; b.st[1] = nx; }
        const unsigned old = xb_add(&bar[XB_XSUB(bx)], 1u);
        const unsigned gen = old / nloc;
        if (old + 1u == (gen + 1u) * nloc) {
            __builtin_amdgcn_fence(__ATOMIC_RELEASE, "agent");
            asm volatile("s_waitcnt vmcnt(0)" ::: "memory");
            const unsigned og = xb_add(&bar[XB_TOP], 1u);
            const unsigned tg = og / nx;
            if (og + 1u == (tg + 1u) * nx) xb_add(&bar[XB_TOPGEN], 1u);
            else XB_SPIN(xb_ld(&bar[XB_TOPGEN]) == tg, bar);
            __builtin_amdgcn_fence(__ATOMIC_ACQUIRE, "agent");
            xb_add(&bar[XB_XGEN(bx)], 1u);
            asm volatile("s_waitcnt vmcnt(0)" ::: "memory");
        } else {
            XB_SPIN(xb_ld(&bar[XB_XGEN(bx)]) == gen, bar);
            __builtin_amdgcn_fence(__ATOMIC_ACQUIRE, "agent");
            asm volatile("s_waitcnt vmcnt(0)" ::: "memory");
        }
    }
    __syncthreads();
}

struct Args { const float* in[26]; float* out; unsigned char* ws; int ph_lo, ph_hi; };
enum { I_X = 0, I_C, I_N1G, I_N2G, I_WADA, I_BADA, I_WIN, I_CONVW, I_CONVB, I_WRGA, I_BRGA, I_WRGX, I_BRGX, I_LAM, I_WPOOL, I_PSCALE, I_WUPA, I_WUPB, I_WOUT, I_WROUTER, I_BROUTER, I_WEIN, I_BEIN, I_WEOUT, I_BEOUT, I_FINALG };

template <int ROWMODE>
__device__ __forceinline__ void tr_item(const float* W, int N, bf16_t* WT, int dst_ld, int dst_off, int k0, int n0, LAS float* scr, int lane) {
    { float tv[32];
#pragma unroll
    for (int i = 0; i < 32; ++i) tv[i] = W[(size_t)(k0 + 2 * i + (lane >> 5)) * N + n0 + (lane & 31)];
#pragma unroll
    for (int i = 0; i < 32; ++i) scr[(2 * i + (lane >> 5)) * 33 + (lane & 31)] = tv[i]; }
    LDS_WAIT();
    const int c = lane & 7;
#pragma unroll
    for (int j = 0; j < 4; ++j) { const int n = (lane >> 3) + 8 * j; const LAS float* s = scr + (8 * c) * 33 + n;
        u32x4 o; o.x = cvt_pk_bf16(s[0 * 33], s[1 * 33]); o.y = cvt_pk_bf16(s[2 * 33], s[3 * 33]); o.z = cvt_pk_bf16(s[4 * 33], s[5 * 33]); o.w = cvt_pk_bf16(s[6 * 33], s[7 * 33]);
        const int nn = n0 + n; int drow = nn;
        if (ROWMODE == 1) { drow = (nn < 1024) ? (256 * (nn >> 7) + (nn & 127)) : (256 * ((nn - 1024) >> 7) + 128 + ((nn - 1024) & 127)); }
        *(u32x4*)(WT + (size_t)drow * dst_ld + dst_off + k0 + 8 * c) = o; }
    LDS_WAIT();
}
template <int ROWMODE>
__device__ __forceinline__ void tr_item_fp8(const float* W, int N, unsigned char* WT, int k0, int n0, LAS float* scr, int lane) {
    { float tv[64];
#pragma unroll
    for (int i = 0; i < 64; ++i) tv[i] = W[(size_t)(k0 + 2 * i + (lane >> 5)) * N + n0 + (lane & 31)];
#pragma unroll
    for (int i = 0; i < 64; ++i) scr[(2 * i + (lane >> 5)) * 33 + (lane & 31)] = tv[i]; }
    LDS_WAIT();
    const int c = lane & 7;
#pragma unroll
    for (int j = 0; j < 4; ++j) { const int n = (lane >> 3) + 8 * j; const LAS float* s = scr + (16 * c) * 33 + n;
        int o[4];
#pragma unroll
        for (int q = 0; q < 4; ++q) { int w = 0; w = __builtin_amdgcn_cvt_pk_fp8_f32(s[(4 * q) * 33] * WEIN_SCALE, s[(4 * q + 1) * 33] * WEIN_SCALE, w, false);
            w = __builtin_amdgcn_cvt_pk_fp8_f32(s[(4 * q + 2) * 33] * WEIN_SCALE, s[(4 * q + 3) * 33] * WEIN_SCALE, w, true); o[q] = w; }
        const int nn = n0 + n; const int drow = (ROWMODE == 0) ? nn : ((nn < 1024) ? (256 * (nn >> 7) + (nn & 127)) : (256 * ((nn - 1024) >> 7) + 128 + ((nn - 1024) & 127)));
        *(u32x4*)(WT + (size_t)drow * 1024 + k0 + 16 * c) = (u32x4){(unsigned)o[0], (unsigned)o[1], (unsigned)o[2], (unsigned)o[3]}; }
    LDS_WAIT();
}
template <int ROWMODE>
__device__ __forceinline__ void tr_job(int item, const float* src, int K, int N, bf16_t* dst, size_t dst_bstride, int dst_ld, int dst_off, LAS float* scr, int lane) {
    const int nnb = N / 32, nkb = K / 64; const int nb = item % nnb; const int r = item / nnb; const int kb = r % nkb; const int bt = r / nkb;
    tr_item<ROWMODE>(src + (size_t)bt * K * N, N, dst + (size_t)bt * dst_bstride, dst_ld, dst_off, 64 * kb, 32 * nb, scr, lane);
}

constexpr int CONV_Q1 = 5, CONV_Q2 = 6;
constexpr int CONV_ITEMS_L = NE * 8 * 64 + NE * 8 * 32, CONV_CHUNKS_L = CONV_ITEMS_L / 8;
__device__ __forceinline__ void conv_expert_item(const Args& a, unsigned char* ws, int l, int r, LAS float* scr, int lane) {
    if (r < NE * 8 * 64) { const int nb = r % 64, r2 = r / 64, kb = r2 % 8, bt = l * NE + r2 / 8;
        tr_item_fp8<1>(a.in[I_WEIN] + (size_t)bt * 1024 * 2048, 2048, (unsigned char*)(ws + WS_WEIN) + (size_t)bt * 2048 * 1024, 128 * kb, 32 * nb, scr, lane); }
    else { r -= NE * 8 * 64; const int nb = r % 32, r2 = r / 32, kb = r2 % 8, bt = l * NE + r2 / 8;
        tr_item_fp8<0>(a.in[I_WEOUT] + (size_t)bt * 1024 * 1024, 1024, (unsigned char*)(ws + WS_WEOUT) + (size_t)bt * 1024 * 1024, 128 * kb, 32 * nb, scr, lane); }
}
__device__ __forceinline__ void conv_drain(const Args& a, int l, int budget, LAS unsigned char* lds, const int wv) {
    asm volatile("" : "+s"(lds));
    int tid_ = tid_of(wv); asm volatile("" : "+v"(tid_)); const int tid = tid_, lane = tid & 63;
    unsigned char* ws = opaque_ptr(a.ws); unsigned* head = (unsigned*)(ws + WS_CTL) + CW_CONVQ + 64 * l;
    LAS float* scr = (LAS float*)(lds + wv * 16896); LAS int* slot = (LAS int*)(lds + LDS_BYTES - 512);
    for (;;) {
        if (budget == 0) break;
        __syncthreads();
        if (tid == 0) *slot = (int)__hip_atomic_fetch_add(head, 1u, __ATOMIC_RELAXED, __HIP_MEMORY_SCOPE_AGENT);
        __syncthreads();
        const int c = __builtin_amdgcn_readfirstlane(*slot);
        if (c >= CONV_CHUNKS_L) break;
        conv_expert_item(a, ws, l, c * 8 + wv, scr, lane);
        if (budget > 0) --budget;
    }
    __syncthreads();
}
__device__ __forceinline__ void phase_prologue(const Args& a, LAS unsigned char* lds, const int wv) {
    asm volatile("" : "+s"(lds));
    int tid_ = tid_of(wv); asm volatile("" : "+v"(tid_)); const int tid = tid_, lane = tid & 63, wave = __builtin_amdgcn_readfirstlane(tid >> 6);
    const int G = gridDim.x;
    unsigned char* ws = opaque_ptr(a.ws); const int bid = opaque_bid();
    {
        LAS float* cact = (LAS float*)lds;
        LAS float* red = (LAS float*)(lds + 32768);
        for (int i = tid; i < NBATCH * D; i += NTHREADS) { const float v = a.in[I_C][i]; cact[i] = v * sigmoidf_(v); }
        __syncthreads();
        float* mod = (float*)(ws + WS_MOD);
        for (int u = bid; u < DEPTH * 96; u += G) {
            const int l = u / 96, cg = u % 96; const int n = cg * 64 + lane;
            const float* w = a.in[I_WADA] + (size_t)l * D * 6144 + n;
            float acc[8] = {0.f, 0.f, 0.f, 0.f, 0.f, 0.f, 0.f, 0.f};
            const int kb = wave * 128;
#pragma unroll 8
            for (int k = 0; k < 128; ++k) { const float wv = w[(size_t)(kb + k) * 6144];
#pragma unroll
                for (int b = 0; b < 8; ++b) acc[b] += cact[b * D + kb + k] * wv; }
#pragma unroll
            for (int b = 0; b < 8; ++b) red[(wave * 8 + b) * 64 + lane] = acc[b];
            __syncthreads();
            { const int b = tid >> 6; float s = 0.f;
#pragma unroll
              for (int w8 = 0; w8 < 8; ++w8) s += red[(w8 * 8 + b) * 64 + lane];
              mod[((size_t)l * NBATCH + b) * 6144 + n] = s + a.in[I_BADA][(size_t)l * 6144 + n]; }
            __syncthreads();
        }
    }
    {
        bf16_t* wrs = (bf16_t*)(ws + WS_WRS);
        for (int idx = bid * NTHREADS + tid; idx < DEPTH * D * NE; idx += G * NTHREADS) { const int e = idx & 31, k = (idx >> 5) & 1023, l = idx >> 15;
            const float w = a.in[I_WROUTER][idx]; const unsigned hi = cvt_pk_bf16(w, 0.f) & 0xffffu; const unsigned lo = cvt_pk_bf16(w - bflo(hi), 0.f) & 0xffffu;
            wrs[((size_t)(l * 2 + 0) * NE + e) * D + k] = (bf16_t)hi; wrs[((size_t)(l * 2 + 1) * NE + e) * D + k] = (bf16_t)lo; }
    }
#if Z_I8
    {
        LAS float* tile = (LAS float*)lds; LAS float* red = (LAS float*)(lds + 1024 * 33 * 4);
        signed char* w8 = (signed char*)(ws + WS_WIN); float* wsc = (float*)(ws + WS_WINSC);
        __syncthreads();
        for (int u = bid; u < DEPTH * (NZ / 32); u += G) {
            const int l = u / (NZ / 32), n0 = (u % (NZ / 32)) * 32; const float* W = a.in[I_WIN] + (size_t)l * D * NZ + n0;
            const int n = tid & 31, kr = tid >> 5;
#pragma unroll 1
            for (int k0 = 0; k0 < 1024; k0 += 256) { float tv[16];
#pragma unroll
                for (int i = 0; i < 16; ++i) tv[i] = W[(size_t)(k0 + 16 * i + kr) * NZ + n];
#pragma unroll
                for (int i = 0; i < 16; ++i) tile[(k0 + 16 * i + kr) * 33 + n] = tv[i]; }
            __syncthreads();
            { float am = 0.f;
#pragma unroll 8
              for (int i = 0; i < 64; ++i) am = fmaxf(am, fabsf(tile[(kr * 64 + i) * 33 + n]));
              red[kr * 32 + n] = am; }
            __syncthreads();
            if (tid < 32) { float am = 1e-30f;
#pragma unroll
                for (int q = 0; q < 16; ++q) am = fmaxf(am, red[q * 32 + tid]);
                red[512 + tid] = 127.0f / am; wsc[(size_t)l * NZ + n0 + tid] = am * (1.0f / 127.0f); }
            __syncthreads();
            { const float inv = red[512 + n]; signed char* dst = w8 + ((size_t)l * NZ + n0 + n) * D + kr * 64;
#pragma unroll
              for (int c = 0; c < 4; ++c) { int w4[4];
#pragma unroll
                  for (int q = 0; q < 4; ++q) { int pk = 0;
#pragma unroll
                      for (int e = 0; e < 4; ++e) pk |= (((int)rintf(tile[(kr * 64 + c * 16 + q * 4 + e) * 33 + n] * inv)) & 0xff) << (8 * e);
                      w4[q] = pk; }
                  *(u32x4*)(dst + 16 * c) = (u32x4){(unsigned)w4[0], (unsigned)w4[1], (unsigned)w4[2], (unsigned)w4[3]}; } }
            __syncthreads();
        }
    }
#endif
    {
        LAS float* scr = (LAS float*)(lds + wave * 16896);
        const int gw = bid * NWAVES + wave, NGW = G * NWAVES;
        constexpr int I_EIN = NE * 8 * 64, I_EOUT = NE * 8 * 32, I_WINI = Z_I8 ? 0 : DEPTH * (Z_FP8 ? 8 : 16) * 144, I_UPA = DEPTH * 16 * 32, I_UPB = DEPTH * 8 * 32, I_OUT = DEPTH * 16 * 32,
                      I_RGA = DEPTH * 8 * 2 * 4, I_RGX = I_RGA, I_POOL = DEPTH * 4 * 2 * 4;
        constexpr int NITEMS = I_EIN + I_EOUT + I_WINI + I_UPA + I_UPB + I_OUT + I_RGA + I_RGX + I_POOL;
        for (int it = gw; it < NITEMS; it += NGW) {
            int r = it;
            if (r < I_EIN) { const int nb = r % 64, r2 = r / 64, kb = r2 % 8, bt = r2 / 8;
                tr_item_fp8<1>(a.in[I_WEIN] + (size_t)bt * 1024 * 2048, 2048, (unsigned char*)(ws + WS_WEIN) + (size_t)bt * 2048 * 1024, 128 * kb, 32 * nb, scr, lane); continue; } r -= I_EIN;
            if (r < I_EOUT) { const int nb = r % 32, r2 = r / 32, kb = r2 % 8, bt = r2 / 8;
                tr_item_fp8<0>(a.in[I_WEOUT] + (size_t)bt * 1024 * 1024, 1024, (unsigned char*)(ws + WS_WEOUT) + (size_t)bt * 1024 * 1024, 128 * kb, 32 * nb, scr, lane); continue; } r -= I_EOUT;
#if Z_I8
#elif Z_FP8
            if (r < I_WINI) { const int nb = r % 144, r2 = r / 144, kb = r2 % 8, bt = r2 / 8;
                tr_item_fp8<0>(a.in[I_WIN] + (size_t)bt * 1024 * NZ, NZ, (unsigned char*)(ws + WS_WIN) + (size_t)bt * NZ * 1024, 128 * kb, 32 * nb, scr, lane); continue; } r -= I_WINI;
#else
            if (r < I_WINI) { tr_job<0>(r, a.in[I_WIN], 1024, NZ, (bf16_t*)(ws + WS_WIN), (size_t)NZ * 1024, 1024, 0, scr, lane); continue; } r -= I_WINI;
#endif
            if (r < I_UPA) { tr_job<0>(r, a.in[I_WUPA], 1024, 1024, (bf16_t*)(ws + WS_WCAT), (size_t)1024 * KCAT, KCAT, 512, scr, lane); continue; } r -= I_UPA;
            if (r < I_UPB) { tr_job<0>(r, a.in[I_WUPB], 512, 1024, (bf16_t*)(ws + WS_WCAT), (size_t)1024 * KCAT, KCAT, 0, scr, lane); continue; } r -= I_UPB;
            if (r < I_OUT) { tr_job<0>(r, a.in[I_WOUT], 1024, 1024, (bf16_t*)(ws + WS_WOUT), (size_t)1024 * 1024, 1024, 0, scr, lane); continue; } r -= I_OUT;
            if (r < I_RGA) { tr_job<0>(r, a.in[I_WRGA], 128, 128, (bf16_t*)(ws + WS_WRG), (size_t)256 * 128, 128, 0, scr, lane); continue; } r -= I_RGA;
            if (r < I_RGX) { tr_job<0>(r, a.in[I_WRGX], 128, 128, (bf16_t*)(ws + WS_WRG) + 128 * 128, (size_t)256 * 128, 128, 0, scr, lane); continue; } r -= I_RGX;
            tr_job<0>(r, a.in[I_WPOOL], 128, 128, (bf16_t*)(ws + WS_WPOOL), (size_t)128 * 128, 128, 0, scr, lane);
        }
    }
}

struct MoeTab { LAS int* cnt; LAS int* padstart; LAS int* tilestart; LAS int* tab; };
__device__ __forceinline__ MoeTab moe_tab_ptrs(LAS unsigned char* lds) { MoeTab t; t.cnt = (LAS int*)(lds + LDS_TAB); t.padstart = t.cnt + 32; t.tilestart = t.padstart + 40; t.tab = t.tilestart + 40; return t; }
__device__ __forceinline__ void moe_tables(const Args& a, int l, LAS unsigned char* lds, const int wv) {
    asm volatile("" : "+s"(lds));
    const MoeTab mt = moe_tab_ptrs(lds); int tid_ = tid_of(wv); asm volatile("" : "+v"(tid_)); const int tid = tid_;
    unsigned* ctl = (unsigned*)(opaque_ptr(a.ws) + WS_CTL);
    __syncthreads();
    if (tid < NE) mt.cnt[tid] = (int)__hip_atomic_load(ctl + CW_CNT + (l * NE + tid) * 16, __ATOMIC_RELAXED, __HIP_MEMORY_SCOPE_AGENT);
    __syncthreads();
    if (tid == 0) { int ps = 0, ts = 0; for (int e = 0; e < NE; ++e) { mt.padstart[e] = ps; mt.tilestart[e] = ts; const int nt = (mt.cnt[e] + 255) >> 8; ps += nt * 256; ts += nt; } mt.padstart[NE] = ps; mt.tilestart[NE] = ts; }
    __syncthreads();
    const int nMt = mt.tilestart[NE];
    for (int m = tid; m < nMt; m += NTHREADS) { int e = 0; for (int q = 1; q < NE; ++q) e = (mt.tilestart[q] <= m) ? q : e; mt.tab[m] = (e << 16) | (m - mt.tilestart[e]); }
    __syncthreads();
}
struct MoeSched1 {
    static constexpr bool DYN_A = true;
    const char* H; const char* W; const int* tokof; MoeTab mt; int nMt, G, c;
    __device__ __forceinline__ bool next(int i, pg8::Unit& u) const { int pm, pn; if (!pg8::order_map(i, G, c, nMt, 8, pm, pn)) return false;
        const int en = __builtin_amdgcn_readfirstlane(mt.tab[pm]); u.pm = pm; u.pn = pn; u.e = en >> 16; u.j = en & 0xffff;
        u.row0 = __builtin_amdgcn_readfirstlane(mt.padstart[u.e]) + 256 * u.j; u.rows = __builtin_amdgcn_readfirstlane(mt.cnt[u.e]) - 256 * u.j; return true; }
    __device__ __forceinline__ const char* a_ptr() const { return H; }
    __device__ __forceinline__ const char* b_ptr() const { return W; }
    __device__ __forceinline__ unsigned a_off(const pg8::Unit&) const { return 0u; }
    __device__ __forceinline__ unsigned b_off(const pg8::Unit& u) const { return ((unsigned)u.e * 2048u + (unsigned)u.pn * 256u) * 1024u; }
    __device__ __forceinline__ void a_voff(const pg8::Unit& u, unsigned (&v)[2][2], int wv) const {
        int tid = tid_of(wv); asm volatile("" : "+v"(tid));
        const int* tl = tokof + (size_t)u.e * T + 256 * u.j; const int rmax = u.rows - 1;
#pragma unroll
        for (int i = 0; i < 2; ++i) { int R, C; pg8::stage_rc(tid * 16 + i * 8192, R, C);
#pragma unroll
            for (int h = 0; h < 2; ++h) { int idx = h * 128 + R; idx = idx < rmax ? idx : rmax; v[h][i] = (unsigned)tl[idx] * 1024u + (unsigned)C * 2u; } }
    }
};
struct MoeSched2 {
    static constexpr bool DYN_A = false;
    const char* ACT; const char* W; MoeTab mt; int nMt, G, c;
    __device__ __forceinline__ bool next(int i, pg8::Unit& u) const { int pm, pn; if (!pg8::order_map(i, G, c, nMt, 4, pm, pn)) return false;
        const int en = __builtin_amdgcn_readfirstlane(mt.tab[pm]); u.pm = pm; u.pn = pn; u.e = en >> 16; u.j = en & 0xffff;
        u.row0 = __builtin_amdgcn_readfirstlane(mt.padstart[u.e]) + 256 * u.j; u.rows = __builtin_amdgcn_readfirstlane(mt.cnt[u.e]) - 256 * u.j; return true; }
    __device__ __forceinline__ const char* a_ptr() const { return ACT; }
    __device__ __forceinline__ const char* b_ptr() const { return W; }
    __device__ __forceinline__ unsigned a_off(const pg8::Unit& u) const { return (unsigned)u.row0 * 1024u; }
    __device__ __forceinline__ unsigned b_off(const pg8::Unit& u) const { return ((unsigned)u.e * 1024u + (unsigned)u.pn * 256u) * 1024u; }
    __device__ __forceinline__ void a_voff(const pg8::Unit&, unsigned (&v)[2][2], int wv) const {
        int tid = tid_of(wv); asm volatile("" : "+v"(tid));
#pragma unroll
        for (int i = 0; i < 2; ++i) { int R, C; pg8::stage_rc(tid * 16 + i * 8192, R, C);
#pragma unroll
            for (int h = 0; h < 2; ++h) v[h][i] = (unsigned)((h * 128 + R) * 512 + C) * 2u; }
    }
};

__device__ __forceinline__ void phase_a(const Args& a, int l, LAS unsigned char* lds, bool dry, const int wv) {
    asm volatile("" : "+s"(lds));
    int tid_ = tid_of(wv); asm volatile("" : "+v"(tid_)); const int tid = tid_, lane = tid & 63, wave = __builtin_amdgcn_readfirstlane(tid >> 6);
    const int G = gridDim.x; unsigned char* ws = opaque_ptr(a.ws); const int bid = opaque_bid();
    const float* mod = (const float*)(ws + WS_MOD);
    float* xres = (float*)(ws + WS_XRES); float* xout = dry ? (float*)(ws + WS_Z) : xres;
    if (l < DEPTH && bid < NBATCH) {
        LAS float* red = (LAS float*)lds;
        const int b = bid, e = tid & 31, kp = tid >> 5;
        const float* sh2 = mod + ((size_t)l * NBATCH + b) * 6144 + 3 * D; const float* wr = a.in[I_WROUTER] + (size_t)l * D * NE;
        float s = 0.f;
        for (int k = kp * 64; k < kp * 64 + 64; ++k) s += sh2[k] * wr[k * NE + e];
        red[kp * 32 + e] = s;
        __syncthreads();
        if (tid < 32) { float t = a.in[I_BROUTER][l * NE + tid]; for (int q = 0; q < 16; ++q) t += red[q * 32 + tid]; ((float*)(ws + WS_CB))[(l * NBATCH + b) * NE + tid] = t; }
        __syncthreads();
    }
    if (l > 0) moe_tables(a, (l - 1) + DEPTH * (REPN(7) - 1), lds, wv);
    const MoeTab mt = moe_tab_ptrs(lds);
    const int* slotinfo = (const int*)(ws + WS_SLOTINFO); const float* wgt = (const float*)(ws + WS_WGT);
    const unsigned char* outb = (const unsigned char*)(ws + WS_OUTB); const float* outsc = (const float*)(ws + WS_OUTSC);
    unsigned char* hb = (unsigned char*)(ws + WS_H);
    for (int chunk = bid; chunk < T / 128; chunk += G) {
        const int rowb = chunk * 128 + wave * 16; const int b = rowb / SEQ;
        const float* xin = (l == 0) ? (a.in[I_X] + (size_t)rowb * D) : (xres + (size_t)rowb * D);
        f32x4 xv[2][4]; int4 si[4]; f32x4 wv[4]; unsigned gv[2][4][4]; f32x4 gs[2][4];
#define PA_SX(r, q) do { if ((r) < 16) { _Pragma("unroll") for (int j = 0; j < 4; ++j) xv[(q) & 1][j] = *(const f32x4*)(xin + (size_t)(r) * D + 4 * lane + 256 * j); } } while (0)
#define PA_S0(r, q) do { if ((r) < 16 && l > 0) { si[(q) & 3] = *(const int4*)(slotinfo + (size_t)(rowb + (r)) * 4); wv[(q) & 3] = *(const f32x4*)(wgt + (size_t)(rowb + (r)) * 4); } } while (0)
#define PA_S1(r, q) do { if ((r) < 16 && l > 0) { const int sl_[4] = {si[(q) & 3].x, si[(q) & 3].y, si[(q) & 3].z, si[(q) & 3].w}; \
            _Pragma("unroll") for (int kk = 0; kk < 4; ++kk) { const int e_ = sl_[kk] >> 24, li_ = sl_[kk] & 0xffffff; const size_t slot_ = (size_t)(mt.padstart[e_] + li_); const unsigned char* orow = outb + slot_ * D + 4 * lane; \
                gs[(q) & 1][kk] = *(const f32x4*)(outsc + slot_ * 16 + ((lane >> 3) & 3) * 4); \
                _Pragma("unroll") for (int j = 0; j < 4; ++j) gv[(q) & 1][kk][j] = *(const unsigned*)(orow + 256 * j); } } } while (0)
        PA_S0(0, 0); PA_S0(1, 1); PA_SX(0, 0); PA_S1(0, 0);
#pragma unroll 1
        for (int i0 = 0; i0 < 16; i0 += 4) {
#pragma unroll
          for (int ii = 0; ii < 4; ++ii) {
            const int i = i0 + ii; const int row = rowb + i;
            PA_S0(i + 2, ii + 2); PA_SX(i + 1, ii + 1); PA_S1(i + 1, ii + 1);
            f32x4 v[4];
#pragma unroll
            for (int j = 0; j < 4; ++j) v[j] = xv[ii & 1][j];
            if (l > 0) {
                f32x4 y[4];
#pragma unroll
                for (int j = 0; j < 4; ++j) y[j] = (f32x4){0.f, 0.f, 0.f, 0.f};
#pragma unroll
                for (int kk = 0; kk < 4; ++kk) { const f32x4 ws4 = gs[ii & 1][kk] * wv[ii][kk];
#pragma unroll
                    for (int j = 0; j < 4; ++j) { const unsigned p = gv[ii & 1][kk][j];
                        y[j] += ws4[j] * ((f32x4){(float)(p & 0xffu), (float)((p >> 8) & 0xffu), (float)((p >> 16) & 0xffu), (float)(p >> 24)} - 128.0f); } }
                const float* g2 = mod + ((size_t)(l - 1) * NBATCH + b) * 6144 + 5 * D + 4 * lane;
#pragma unroll
                for (int j = 0; j < 4; ++j) v[j] += *(const f32x4*)(g2 + 256 * j) * y[j];
            }
            if (l < DEPTH) {
#pragma unroll
                for (int j = 0; j < 4; ++j) *(f32x4*)(xout + (size_t)row * D + 4 * lane + 256 * j) = v[j];
            }
            float ss = 0.f;
#pragma unroll
            for (int j = 0; j < 4; ++j) ss += (v[j].x * v[j].x + v[j].y * v[j].y) + (v[j].z * v[j].z + v[j].w * v[j].w);
            const float rinv = 1.0f / sqrtf(wave_sum(ss, lane) * (1.0f / D) + NORM_EPS);
            if (l < DEPTH) {
                const float* ng = a.in[I_N1G] + (size_t)l * D + 4 * lane; const float* mb = mod + ((size_t)l * NBATCH + b) * 6144 + 4 * lane;
                f32x4 hq[4]; (void)hq;
#pragma unroll
                for (int j = 0; j < 4; ++j) { const f32x4 g = *(const f32x4*)(ng + 256 * j), sh = *(const f32x4*)(mb + 256 * j), sc = *(const f32x4*)(mb + D + 256 * j);
                    const f32x4 h = (v[j] * rinv * g) * (1.0f + sc) + sh;
#if Z_I8
                    hq[j] = h; }
                {   float am = 0.f;
#pragma unroll
                    for (int j = 0; j < 4; ++j) am = fmaxf(fmaxf(fmaxf(fabsf(hq[j].x), fabsf(hq[j].y)), fmaxf(fabsf(hq[j].z), fabsf(hq[j].w))), am);
#pragma unroll
                    for (int o = 1; o < 64; o <<= 1) am = fmaxf(am, shflx(am, o, lane));
                    am = fmaxf(am, 1e-20f); const float inv = 127.0f / am;
                    if (lane == 0) ((float*)(ws + WS_HSC))[row] = am * (1.0f / 127.0f);
#pragma unroll
                    for (int j = 0; j < 4; ++j) { const int q0 = (int)rintf(hq[j].x * inv), q1 = (int)rintf(hq[j].y * inv), q2 = (int)rintf(hq[j].z * inv), q3 = (int)rintf(hq[j].w * inv);
                        *(int*)(hb + (size_t)row * D + 4 * lane + 256 * j) = (q0 & 0xff) | ((q1 & 0xff) << 8) | ((q2 & 0xff) << 16) | ((q3 & 0xff) << 24); }
                }
#elif Z_FP8
                    int p = 0; p = __builtin_amdgcn_cvt_pk_fp8_f32(h.x, h.y, p, false); p = __builtin_amdgcn_cvt_pk_fp8_f32(h.z, h.w, p, true);
                    *(int*)(hb + (size_t)row * D + 4 * lane + 256 * j) = p; }
#else
                    u32x2 p; p.x = cvt_pk_bf16(h.x, h.y); p.y = cvt_pk_bf16(h.z, h.w); *(u32x2*)((bf16_t*)hb + (size_t)row * D + 4 * lane + 256 * j) = p; }
#endif
            } else {
                const float* fg = a.in[I_FINALG] + 4 * lane;
#pragma unroll
                for (int j = 0; j < 4; ++j) *(f32x4*)(a.out + (size_t)row * D + 4 * lane + 256 * j) = v[j] * rinv * *(const f32x4*)(fg + 256 * j);
            }
          }
        }
#undef PA_S0
#undef PA_SX
#undef PA_S1
    }
}

__device__ __forceinline__ void phase_h(const Args& a, int l, int cset, LAS unsigned char* lds, const int wv) {
    asm volatile("" : "+s"(lds));
    int tid_ = tid_of(wv); asm volatile("" : "+v"(tid_)); const int tid = tid_, lane = tid & 63, wave = __builtin_amdgcn_readfirstlane(tid >> 6);
    const int G = gridDim.x; unsigned char* ws = opaque_ptr(a.ws); const int bid = opaque_bid();
    const float* mod = (const float*)(ws + WS_MOD); const float* xres = (const float*)(ws + WS_XRES);
    unsigned char* h8 = (unsigned char*)(ws + WS_H);
    LAS float* rinvs = (LAS float*)lds;
    LAS float* lgt = (LAS float*)(lds + 1024);
    LAS int* hist = (LAS int*)(lds + 1024 + 8 * 16 * 33 * 4);
    LAS int* base = hist + 32;
    unsigned* ctl = (unsigned*)(ws + WS_CTL);
    const float* ng = a.in[I_N2G] + (size_t)l * D;
    const float* cbv = (const float*)(ws + WS_CB);
    int* tokof = (int*)(ws + WS_TOKOF); int* slotinfo = (int*)(ws + WS_SLOTINFO); float* wgt = (float*)(ws + WS_WGT);
    for (int chunk = bid; chunk < T / 128; chunk += G) {
        const int row0 = chunk * 128 + wave * 16; const int b = row0 / SEQ;
        const float* mb = mod + ((size_t)l * NBATCH + b) * 6144 + 3 * D;
        if (tid < 32) hist[tid] = 0;
        f32x4 xq[3][4];
#pragma unroll
        for (int r = 0; r < 2; ++r)
#pragma unroll
            for (int j = 0; j < 4; ++j) xq[r][j] = *(const f32x4*)(xres + (size_t)(row0 + r) * D + 4 * lane + 256 * j);
#pragma unroll
        for (int i = 0; i < 16; ++i) {
            const int row = row0 + i;
            if (i + 2 < 16) {
#pragma unroll
                for (int j = 0; j < 4; ++j) xq[(i + 2) % 3][j] = *(const f32x4*)(xres + (size_t)(row + 2) * D + 4 * lane + 256 * j); }
            f32x4 v[4]; float ss = 0.f;
#pragma unroll
            for (int j = 0; j < 4; ++j) { v[j] = xq[i % 3][j]; ss += (v[j].x * v[j].x + v[j].y * v[j].y) + (v[j].z * v[j].z + v[j].w * v[j].w); }
            const float rinv = 1.0f / sqrtf(wave_sum(ss, lane) * (1.0f / D) + NORM_EPS);
            if (lane == 0) rinvs[wave * 16 + i] = rinv;
#pragma unroll
            for (int j = 0; j < 4; ++j) { const f32x4 g = *(const f32x4*)(ng + 4 * lane + 256 * j), sh = *(const f32x4*)(mb + 4 * lane + 256 * j), sc = *(const f32x4*)(mb + D + 4 * lane + 256 * j);
                const f32x4 h = (v[j] * rinv * g) * (1.0f + sc) + sh;
                int p = 0; p = __builtin_amdgcn_cvt_pk_fp8_f32(h.x, h.y, p, false); p = __builtin_amdgcn_cvt_pk_fp8_f32(h.z, h.w, p, true);
                *(int*)(h8 + (size_t)row * D + 4 * lane + 256 * j) = p; }
        }
        {
            const int ri = lane & 15, q = lane >> 4;
            const float* xr = xres + (size_t)(row0 + ri) * D + 8 * q;
            const bf16_t* wh = (const bf16_t*)(ws + WS_WRS) + ((size_t)(l * 2 + 0) * NE + ri) * D + 8 * q; const bf16_t* wl = wh + (size_t)NE * D;
            f32x4 acc0 = {0.f, 0.f, 0.f, 0.f}, acc1 = {0.f, 0.f, 0.f, 0.f};
#pragma unroll 4
            for (int kb = 0; kb < 32; ++kb) {
                const int k0 = 32 * kb + 8 * q;
                const f32x4 x0 = *(const f32x4*)(xr + 32 * kb), x1 = *(const f32x4*)(xr + 32 * kb + 4);
                const f32x4 g0 = *(const f32x4*)(ng + k0), g1 = *(const f32x4*)(ng + k0 + 4), s0 = *(const f32x4*)(mb + D + k0), s1 = *(const f32x4*)(mb + D + k0 + 4);
                const bf16x8 bh0 = *(const bf16x8*)(wh + 32 * kb), bl0 = *(const bf16x8*)(wl + 32 * kb), bh1 = *(const bf16x8*)(wh + 16 * D + 32 * kb), bl1 = *(const bf16x8*)(wl + 16 * D + 32 * kb);
                const f32x4 a0 = x0 * g0 * (1.0f + s0), a1 = x1 * g1 * (1.0f + s1);
                u32x4 hi, lo;
                hi.x = cvt_pk_bf16(a0.x, a0.y); hi.y = cvt_pk_bf16(a0.z, a0.w); hi.z = cvt_pk_bf16(a1.x, a1.y); hi.w = cvt_pk_bf16(a1.z, a1.w);
                lo.x = cvt_pk_bf16(a0.x - bflo(hi.x), a0.y - bfhi(hi.x)); lo.y = cvt_pk_bf16(a0.z - bflo(hi.y), a0.w - bfhi(hi.y));
                lo.z = cvt_pk_bf16(a1.x - bflo(hi.z), a1.y - bfhi(hi.z)); lo.w = cvt_pk_bf16(a1.z - bflo(hi.w), a1.w - bfhi(hi.w));
                const bf16x8 ah = __builtin_bit_cast(bf16x8, hi), al = __builtin_bit_cast(bf16x8, lo);
                acc0 = __builtin_amdgcn_mfma_f32_16x16x32_bf16(ah, bh0, acc0, 0, 0, 0); acc0 = __builtin_amdgcn_mfma_f32_16x16x32_bf16(ah, bl0, acc0, 0, 0, 0); acc0 = __builtin_amdgcn_mfma_f32_16x16x32_bf16(al, bh0, acc0, 0, 0, 0);
                acc1 = __builtin_amdgcn_mfma_f32_16x16x32_bf16(ah, bh1, acc1, 0, 0, 0); acc1 = __builtin_amdgcn_mfma_f32_16x16x32_bf16(ah, bl1, acc1, 0, 0, 0); acc1 = __builtin_amdgcn_mfma_f32_16x16x32_bf16(al, bh1, acc1, 0, 0, 0);
            }
            LDS_WAIT();
            const float c0 = cbv[(l * NBATCH + b) * NE + ri], c1 = cbv[(l * NBATCH + b) * NE + 16 + ri];
#pragma unroll
            for (int r = 0; r < 4; ++r) { const int ti = 4 * q + r; const float rv = rinvs[wave * 16 + ti];
                lgt[(wave * 16 + ti) * 33 + ri] = acc0[r] * rv + c0; lgt[(wave * 16 + ti) * 33 + 16 + ri] = acc1[r] * rv + c1; }
        }
        __syncthreads();
        int se[4] = {0, 0, 0, 0}; float sw[4] = {0.f, 0.f, 0.f, 0.f}; int rk[4] = {0, 0, 0, 0};
        if (lane < 16) {
            float v[32];
#pragma unroll
            for (int e = 0; e < 32; ++e) v[e] = lgt[(wave * 16 + lane) * 33 + e];
            float sv[4];
#pragma unroll
            for (int kk = 0; kk < 4; ++kk) { float best = v[0]; int bi = 0;
#pragma unroll
                for (int e = 1; e < 32; ++e) { if (v[e] > best) { best = v[e]; bi = e; } }
                sv[kk] = best; se[kk] = bi;
#pragma unroll
                for (int e = 0; e < 32; ++e) v[e] = (e == bi) ? -3.0e38f : v[e]; }
            float den = 0.f;
#pragma unroll
            for (int kk = 0; kk < 4; ++kk) { sw[kk] = __expf(sv[kk] - sv[0]); den += sw[kk]; }
            const float inv = 1.0f / den;
#pragma unroll
            for (int kk = 0; kk < 4; ++kk) { sw[kk] *= inv; rk[kk] = __hip_atomic_fetch_add(hist + se[kk], 1, __ATOMIC_RELAXED, __HIP_MEMORY_SCOPE_WORKGROUP); }
        }
        __syncthreads();
        if (tid < 32) base[tid] = (int)__hip_atomic_fetch_add(ctl + CW_CNT + (cset * NE + tid) * 16, (unsigned)hist[tid], __ATOMIC_RELAXED, __HIP_MEMORY_SCOPE_AGENT);
        __syncthreads();
        if (lane < 16) {
            const int row = row0 + lane; int si[4];
#pragma unroll
            for (int kk = 0; kk < 4; ++kk) { const int li = base[se[kk]] + rk[kk]; tokof[(size_t)se[kk] * T + li] = row; si[kk] = (se[kk] << 24) | li; }
            *(int4*)(slotinfo + (size_t)row * 4) = make_int4(si[0], si[1], si[2], si[3]);
            *(f32x4*)(wgt + (size_t)row * 4) = (f32x4){sw[0], sw[1], sw[2], sw[3]};
        }
        __syncthreads();
    }
}

constexpr int ZT_STRIDE = 528;
__device__ __forceinline__ void lru_unit(const Args& a, int l, int u, LAS unsigned char* lds, const int wv) {
    asm volatile("" : "+s"(lds));
    int tid_ = tid_of(wv); asm volatile("" : "+v"(tid_)); const int tid = tid_, lane = tid & 63, wave = __builtin_amdgcn_readfirstlane(tid >> 6);
    unsigned char* ws = opaque_ptr(a.ws);
    const bf16_t* z = (const bf16_t*)(ws + WS_Z);
    LAS unsigned char* zt = lds; LAS unsigned char* xc = lds + 131 * ZT_STRIDE;
    const int hp = u & 3, b = (u >> 2) & 7, s = u >> 5;
    const int t0 = b * SEQ + s * 128, p0 = s * 128;
    {   u32x4 sv[9];
#pragma unroll
        for (int k = 0; k < 9; ++k) { int idx = tid + NTHREADS * k; idx = idx < 131 * 32 ? idx : 131 * 32 - 1; const int r = idx >> 5, o = idx & 31; const int p = p0 - 3 + r; const int pc = p < 0 ? 0 : p;
            sv[k] = *(const u32x4*)(z + (size_t)(b * SEQ + pc) * NZ + hp * 256 + o * 8); if (p < 0) sv[k] = (u32x4){0u, 0u, 0u, 0u}; }
#pragma unroll
        for (int k = 0; k < 9; ++k) { int idx = tid + NTHREADS * k; idx = idx < 131 * 32 ? idx : 131 * 32 - 1; const int r = idx >> 5, o = idx & 31;
            *(LAS u32x4*)(zt + r * ZT_STRIDE + o * 16) = sv[k]; }
    }
    __syncthreads();
    {
        const int o = tid & 31, rb = tid >> 5; const int ch0 = hp * 256 + o * 8;
        float cw[4][8], cbias[8];
#pragma unroll
        for (int k = 0; k < 4; ++k) { const f32x4 w0 = *(const f32x4*)(a.in[I_CONVW] + ((size_t)l * 4 + k) * D + ch0), w1 = *(const f32x4*)(a.in[I_CONVW] + ((size_t)l * 4 + k) * D + ch0 + 4);
            cw[k][0] = w0.x; cw[k][1] = w0.y; cw[k][2] = w0.z; cw[k][3] = w0.w; cw[k][4] = w1.x; cw[k][5] = w1.y; cw[k][6] = w1.z; cw[k][7] = w1.w; }
        { const f32x4 b0 = *(const f32x4*)(a.in[I_CONVB] + (size_t)l * D + ch0), b1 = *(const f32x4*)(a.in[I_CONVB] + (size_t)l * D + ch0 + 4);
          cbias[0] = b0.x; cbias[1] = b0.y; cbias[2] = b0.z; cbias[3] = b0.w; cbias[4] = b1.x; cbias[5] = b1.y; cbias[6] = b1.z; cbias[7] = b1.w; }
#pragma unroll 2
        for (int i = 0; i < 8; ++i) { const int r = rb + 16 * i; float acc[8];
#pragma unroll
            for (int j = 0; j < 8; ++j) acc[j] = cbias[j];
#pragma unroll
            for (int k = 0; k < 4; ++k) { const u32x4 v = *(const LAS u32x4*)(zt + (r + k) * ZT_STRIDE + o * 16);
                acc[0] += cw[k][0] * bflo(v.x); acc[1] += cw[k][1] * bfhi(v.x); acc[2] += cw[k][2] * bflo(v.y); acc[3] += cw[k][3] * bfhi(v.y);
                acc[4] += cw[k][4] * bflo(v.z); acc[5] += cw[k][5] * bfhi(v.z); acc[6] += cw[k][6] * bflo(v.w); acc[7] += cw[k][7] * bfhi(v.w); }
            u32x4 w; w.x = cvt_pk_bf16(acc[0], acc[1]); w.y = cvt_pk_bf16(acc[2], acc[3]); w.z = cvt_pk_bf16(acc[4], acc[5]); w.w = cvt_pk_bf16(acc[6], acc[7]);
            *(LAS u32x4*)(xc + r * ZT_STRIDE + o * 16) = w; }
    }
    __syncthreads();
    {
        const int hsel = wave >> 2, wc = wave & 3, head = 2 * hp + hsel, c31 = lane & 31, hh = lane >> 5;
        const int ch = head * 128 + 32 * wc + c31;
        const bf16_t* wb = (const bf16_t*)(ws + WS_WRG) + ((size_t)(l * 8 + head) * 256 + 32 * wc + c31) * 128 + 8 * hh;
        bf16x8 Ba[8], Bi[8];
#pragma unroll
        for (int ks = 0; ks < 8; ++ks) { Ba[ks] = *(const bf16x8*)(wb + 16 * ks); Bi[ks] = *(const bf16x8*)(wb + 128 * 128 + 16 * ks); }
        const float ba = a.in[I_BRGA][(size_t)l * D + ch], bx = a.in[I_BRGX][(size_t)l * D + ch];
        const float lam = a.in[I_LAM][(size_t)l * D + ch];
        const float sp8 = 8.0f * log1pf(__expf(-lam));
        typedef __attribute__((address_space(1))) unsigned long long gu64;
        gu64* aggq = (gu64*)(ws + WS_AGG) + ((size_t)l * NBATCH * 32 + (size_t)b * 32) * D + ch;
        float Pr = 1.f, Hr = 0.f;
        unsigned hpk[64];
#pragma unroll
        for (int rb = 0; rb < 4; ++rb) {
            f32x16 aa, ai;
#pragma unroll
            for (int r = 0; r < 16; ++r) { aa[r] = 0.f; ai[r] = 0.f; }
            const LAS unsigned char* ap = xc + (32 * rb + c31) * ZT_STRIDE + (hsel * 128 + 8 * hh) * 2;
#pragma unroll
            for (int ks = 0; ks < 8; ++ks) { const bf16x8 A = *(const LAS bf16x8*)(ap + 32 * ks);
                aa = __builtin_amdgcn_mfma_f32_32x32x16_bf16(A, Ba[ks], aa, 0, 0, 0); ai = __builtin_amdgcn_mfma_f32_32x32x16_bf16(A, Bi[ks], ai, 0, 0, 0); }
            const LAS unsigned char* xp = xc + (32 * rb + 4 * hh) * ZT_STRIDE + (hsel * 128 + 32 * wc + c31) * 2;
#pragma unroll
            for (int q = 0; q < 4; ++q) {
                float p = 1.f, h = 0.f, hl[4], pl[4];
#pragma unroll
                for (int r3 = 0; r3 < 4; ++r3) { const int reg = 4 * q + r3;
                    const float xcv = bf1(*(const LAS bf16_t*)(xp + (8 * q + r3) * ZT_STRIDE));
                    const float rg = sigmoidf_(aa[reg] + ba), ig = sigmoidf_(ai[reg] + bx);
                    const float av = __expf(-sp8 * rg); const float mult = sqrtf(fmaxf(1.0f - av * av, 0.f));
                    h = av * h + mult * (ig * xcv); p *= av; hl[r3] = h; pl[r3] = p; }
                const float Ao = shflx(p, 32, lane), Bo = shflx(h, 32, lane);
                const float A0 = hh ? Ao : p, B0 = hh ? Bo : h, A1 = hh ? p : Ao, B1 = hh ? h : Bo;
                const float P1 = Pr * A0, H1 = Hr * A0 + B0;
                const float Pst = hh ? P1 : Pr, Hst = hh ? H1 : Hr;
                Pr = P1 * A1; Hr = H1 * A1 + B1;
#pragma unroll
                for (int r3 = 0; r3 < 4; ++r3) hpk[rb * 16 + 4 * q + r3] = cvt_pk_bf16(Hst * pl[r3] + hl[r3], Pst * pl[r3]);
            }
        }
        if (hh == 0) __hip_atomic_store(aggq + (size_t)s * D, ((unsigned long long)__float_as_uint(Hr) << 32) | (unsigned long long)__float_as_uint(fmaxf(Pr, 1e-37f)), __ATOMIC_RELAXED, __HIP_MEMORY_SCOPE_AGENT);
        const bf16_t* zg = z + (size_t)t0 * NZ + ZO_GLRU + ch;
        bf16_t* yo = (bf16_t*)(ws + WS_ACAT) + (size_t)t0 * KCAT + 512 + ch;
        bf16_t gcur[16], gnxt[16];
#pragma unroll
        for (int reg = 0; reg < 16; ++reg) gcur[reg] = zg[(size_t)(8 * (reg >> 2) + 4 * hh + (reg & 3)) * NZ];
        float cin = 0.f;
        for (int j0 = 0; j0 < s; j0 += 8) {
            unsigned long long w[8]; unsigned spins = 0;
            for (;;) { bool ok = true;
#pragma unroll
                for (int k = 0; k < 8; ++k) { const int j = (j0 + k < s) ? (j0 + k) : (s - 1); w[k] = __hip_atomic_load(aggq + (size_t)j * D, __ATOMIC_RELAXED, __HIP_MEMORY_SCOPE_AGENT); ok = ok && ((unsigned)w[k] != 0u); }
                if (__all(ok)) break;
                __builtin_amdgcn_s_sleep(4);
                if (++spins > (1u << 17)) break;
            }
#pragma unroll
            for (int k = 0; k < 8; ++k) { if (j0 + k < s) cin = __uint_as_float((unsigned)w[k]) * cin + __uint_as_float((unsigned)(w[k] >> 32)); }
        }
#pragma unroll
        for (int rb = 0; rb < 4; ++rb) {
            if (rb < 3) {
#pragma unroll
                for (int reg = 0; reg < 16; ++reg) gnxt[reg] = zg[(size_t)(32 * (rb + 1) + 8 * (reg >> 2) + 4 * hh + (reg & 3)) * NZ]; }
#pragma unroll
            for (int reg = 0; reg < 16; ++reg) { const int tok = 32 * rb + 8 * (reg >> 2) + 4 * hh + (reg & 3);
                const unsigned pk = hpk[rb * 16 + reg];
                const float hf = bflo(pk) + bfhi(pk) * cin;
                const float g = bf1(gcur[reg]);
                const float ge = g * __builtin_amdgcn_rcpf(1.0f + __expf(-1.5957691216f * (g + 0.044715f * g * g * g)));
                yo[(size_t)tok * KCAT] = (bf16_t)(cvt_pk_bf16(hf * ge, 0.f) & 0xffffu); }
#pragma unroll
            for (int reg = 0; reg < 16; ++reg) gcur[reg] = gnxt[reg];
        }
    }
    __syncthreads();
}
__device__ __forceinline__ void pool_unit(const Args& a, int l, int u, LAS unsigned char* lds, const int wv) {
    asm volatile("" : "+s"(lds));
    int tid_ = tid_of(wv); asm volatile("" : "+v"(tid_)); const int tid = tid_, lane = tid & 63, wave = __builtin_amdgcn_readfirstlane(tid >> 6);
    unsigned char* ws = opaque_ptr(a.ws);
    const bf16_t* z = (const bf16_t*)(ws + WS_Z);
    LAS unsigned char* zt = lds; LAS unsigned char* pt = lds + 143 * ZT_STRIDE;
    const int gp = u & 1, b = (u >> 1) & 7, s = u >> 4;
    const int t0 = b * SEQ + s * 128, p0 = s * 128;
    {   u32x4 sv[9];
#pragma unroll
        for (int k = 0; k < 9; ++k) { int idx = tid + NTHREADS * k; idx = idx < 143 * 32 ? idx : 143 * 32 - 1; const int r = idx >> 5, o = idx & 31; const int p = p0 - 15 + r; const int pc = p < 0 ? 0 : p;
            sv[k] = *(const u32x4*)(z + (size_t)(b * SEQ + pc) * NZ + ZO_XPOOL + gp * 256 + o * 8); if (p < 0) sv[k] = (u32x4){0u, 0u, 0u, 0u}; }
#pragma unroll
        for (int k = 0; k < 9; ++k) { int idx = tid + NTHREADS * k; idx = idx < 143 * 32 ? idx : 143 * 32 - 1; const int r = idx >> 5, o = idx & 31;
            *(LAS u32x4*)(zt + r * ZT_STRIDE + o * 16) = sv[k]; }
    }
    __syncthreads();
    {
        const int o = tid & 31, rb = tid >> 5; const int g = 2 * gp + (o >> 4); const int w = 2 << g;
#pragma unroll 1
        for (int i = 0; i < 8; ++i) { const int r = rb + 16 * i; float acc[8];
#pragma unroll
            for (int j = 0; j < 8; ++j) acc[j] = 0.f;
            for (int jj = 0; jj < w; ++jj) { const u32x4 v = *(const LAS u32x4*)(zt + (r + 15 - jj) * ZT_STRIDE + o * 16);
                acc[0] += bflo(v.x); acc[1] += bfhi(v.x); acc[2] += bflo(v.y); acc[3] += bfhi(v.y); acc[4] += bflo(v.z); acc[5] += bfhi(v.z); acc[6] += bflo(v.w); acc[7] += bfhi(v.w); }
            const int cnt = (p0 + r + 1 < w) ? (p0 + r + 1) : w; const float ic = 1.0f / (float)cnt;
            const u32x4 v = *(const LAS u32x4*)(zt + (r + 15) * ZT_STRIDE + o * 16);
            const float x0[8] = {bflo(v.x), bfhi(v.x), bflo(v.y), bfhi(v.y), bflo(v.z), bfhi(v.z), bflo(v.w), bfhi(v.w)};
#pragma unroll
            for (int j = 0; j < 8; ++j) acc[j] = acc[j] * ic - x0[j];
            u32x4 wv; wv.x = cvt_pk_bf16(acc[0], acc[1]); wv.y = cvt_pk_bf16(acc[2], acc[3]); wv.z = cvt_pk_bf16(acc[4], acc[5]); wv.w = cvt_pk_bf16(acc[6], acc[7]);
            *(LAS u32x4*)(pt + r * ZT_STRIDE + o * 16) = wv; }
    }
    __syncthreads();
    {
        const int gsel = wave >> 2, wc = wave & 3, g = 2 * gp + gsel, c31 = lane & 31, hh = lane >> 5;
        const int oc = g * 128 + 32 * wc + c31;
        const bf16_t* wb = (const bf16_t*)(ws + WS_WPOOL) + ((size_t)(l * 4 + g) * 128 + 32 * wc + c31) * 128 + 8 * hh;
        bf16x8 Bf[8];
#pragma unroll
        for (int ks = 0; ks < 8; ++ks) Bf[ks] = *(const bf16x8*)(wb + 16 * ks);
        const float psc = a.in[I_PSCALE][(size_t)l * 512 + oc];
        bf16_t* yo = (bf16_t*)(ws + WS_ACAT) + (size_t)t0 * KCAT + oc;
#pragma unroll 1
        for (int rb = 0; rb < 4; ++rb) {
            f32x16 acc;
#pragma unroll
            for (int r = 0; r < 16; ++r) acc[r] = 0.f;
            const LAS unsigned char* ap = pt + (32 * rb + c31) * ZT_STRIDE + (gsel * 128 + 8 * hh) * 2;
#pragma unroll
            for (int ks = 0; ks < 8; ++ks) { const bf16x8 A = *(const LAS bf16x8*)(ap + 32 * ks); acc = __builtin_amdgcn_mfma_f32_32x32x16_bf16(A, Bf[ks], acc, 0, 0, 0); }
#pragma unroll
            for (int reg = 0; reg < 16; ++reg) { const int tok = 32 * rb + 8 * (reg >> 2) + 4 * hh + (reg & 3);
                yo[(size_t)tok * KCAT] = (bf16_t)(cvt_pk_bf16(acc[reg] * psc, 0.f) & 0xffffu); }
        }
    }
    __syncthreads();
}

constexpr int PH_PER_LAYER = 9;
constexpr int N_PHASES = 1 + DEPTH * PH_PER_LAYER + 1;

__global__ void __launch_bounds__(NTHREADS, 2) fwd_kernel(Args a) {
    extern __shared__ __attribute__((aligned(16))) unsigned char lds_raw[];
    LAS unsigned char* lds = (LAS unsigned char*)lds_raw;
    const int wv = __builtin_amdgcn_readfirstlane(threadIdx.x >> 6); const int tid = threadIdx.x; const int G = gridDim.x;
    unsigned char* ws0 = a.ws;
    unsigned* ctl = (unsigned*)(ws0 + WS_CTL);
    volatile LAS unsigned* misc = (volatile LAS unsigned*)(lds + LDS_MISC);
    if (tid < 4) misc[tid] = 0u;
    __syncthreads();
    XcdBarrier bar; bar.bar = ctl + CW_BAR; bar.x = 0; bar.st = misc; bar.wv = wv;
#if MK_PER_PHASE
    const int lo = a.ph_lo, hi = a.ph_hi;
#else
    constexpr int lo = 0, hi = N_PHASES;
#endif
    if (hi - lo > 1) bar = xcd_barrier_post(ctl + CW_BAR, misc, wv);
#define IN(k) (lo <= (k) && (k) < hi)
#define SEAM(k) do { if (IN((k) + 1)) xcd_barrier(bar); } while (0)

    if (EN(0) && IN(0)) for (int rr = 0; rr < REPN(0); ++rr) { phase_prologue(a, lds, wv); SEAM(0); }

    for (int l = 0; l < DEPTH; ++l) {
        const int pb = 1 + l * PH_PER_LAYER;
        if (EN(1) && IN(pb + 0)) for (int rr = 0; rr < REPN(1); ++rr) { unsigned char* ws = opaque_ptr(ws0); const int bid = opaque_bid(); (void)bid; (void)ws; phase_a(a, l, lds, rr + 1 < REPN(1), wv); SEAM(pb + 0); }
        if (EN(2) && IN(pb + 1)) for (int rr = 0; rr < REPN(2); ++rr) { unsigned char* ws = opaque_ptr(ws0); const int bid = opaque_bid(); (void)bid; (void)ws;
            #if Z_I8
            pg8::PlainSched S{(const char*)(ws + WS_H), (const char*)(ws + WS_WIN) + (size_t)l * NZ * 1024, 512, T / 256, NZ / 256, G, bid};
            pg8::EpiZI8 E{(bf16_t*)(ws + WS_Z), (const float*)(ws + WS_HSC), (const float*)(ws + WS_WINSC) + (size_t)l * NZ};
            pg8::gemm_phase<pg8::EpiZI8, pg8::PlainSched, true, 2>(lds, 512, S, E, wv);
#elif Z_FP8
            pg8::PlainSched S{(const char*)(ws + WS_H), (const char*)(ws + WS_WIN) + (size_t)l * NZ * 1024, 512, T / 256, NZ / 256, G, bid};
            pg8::EpiBf16 E{(bf16_t*)(ws + WS_Z), NZ, nullptr, (rr + 1 < REPN(2)) && (a.ph_lo == 0), 1.0f / WEIN_SCALE};
            pg8::gemm_phase<pg8::EpiBf16, pg8::PlainSched, true, 1>(lds, 512, S, E, wv);
#else
            pg8::PlainSched S{(const char*)(ws + WS_H), (const char*)(ws + WS_WIN) + (size_t)l * NZ * 1024 * 2, 1024, T / 256, NZ / 256, G, bid};
            pg8::EpiBf16 E{(bf16_t*)(ws + WS_Z), NZ, nullptr, (rr + 1 < REPN(2)) && (a.ph_lo == 0), 1.0f};
            pg8::gemm_phase<pg8::EpiBf16, pg8::PlainSched, true>(lds, 1024, S, E, wv);
#endif
            SEAM(pb + 1);
        }
        if (EN(3) && IN(pb + 2)) for (int rr = 0; rr < REPN(3); ++rr) { unsigned char* ws = opaque_ptr(ws0); const int bid = opaque_bid(); (void)bid; (void)ws;
            for (int u = bid; u < 1024 + 512; u += G) { if (u < 1024) lru_unit(a, l, u, lds, wv); else pool_unit(a, l, u - 1024, lds, wv); }
            SEAM(pb + 2);
        }
        if (EN(5) && IN(pb + 4)) for (int rr = 0; rr < REPN(5); ++rr) { unsigned char* ws = opaque_ptr(ws0); const int bid = opaque_bid(); (void)bid; (void)ws;
            pg8::PlainSched S{(const char*)(ws + WS_ACAT), (const char*)(ws + WS_WCAT) + (size_t)l * 1024 * KCAT * 2, KCAT, T / 256, D / 256, G, bid};
            pg8::EpiMerged E{(bf16_t*)(ws + WS_MERGED), (const bf16_t*)(ws + WS_Z)};
            pg8::gemm_phase<pg8::EpiMerged, pg8::PlainSched, true>(lds, KCAT, S, E, wv);
            SEAM(pb + 4);
        }
        if (EN(6) && IN(pb + 5)) for (int rr = 0; rr < REPN(6); ++rr) { unsigned char* ws = opaque_ptr(ws0); const int bid = opaque_bid(); (void)bid; (void)ws;
            pg8::PlainSched S{(const char*)(ws + WS_MERGED), (const char*)(ws + WS_WOUT) + (size_t)l * 1024 * 1024 * 2, 1024, T / 256, D / 256, G, bid};
            pg8::EpiResid E{(float*)(ws + WS_XRES), (rr + 1 < REPN(6)) ? (float*)(ws + WS_OUTB) : (float*)(ws + WS_XRES), (const float*)(ws + WS_MOD) + (size_t)l * NBATCH * 6144 + 2 * D};
            pg8::gemm_phase<pg8::EpiResid, pg8::PlainSched, true>(lds, 1024, S, E, wv);
            SEAM(pb + 5);
        }
        if (EN(7) && IN(pb + 6)) for (int rr = 0; rr < REPN(7); ++rr) { unsigned char* ws = opaque_ptr(ws0); const int bid = opaque_bid(); (void)bid; (void)ws; if (l > 0 && rr == 0) conv_drain(a, l, -1, lds, wv); phase_h(a, l, l + DEPTH * rr, lds, wv); SEAM(pb + 6); }
        if (EN(8) && IN(pb + 7)) for (int rr = 0; rr < REPN(8); ++rr) { unsigned char* ws = opaque_ptr(ws0); const int bid = opaque_bid(); (void)bid; (void)ws;
            moe_tables(a, l + DEPTH * (REPN(7) - 1), lds, wv);
            LAS unsigned char* lds_o = lds; asm volatile("" : "+s"(lds_o)); const MoeTab mt = moe_tab_ptrs(lds_o);
            MoeSched1 S{(const char*)(ws + WS_H), (const char*)(ws + WS_WEIN) + (size_t)l * NE * 2048 * 1024, (const int*)(ws + WS_TOKOF), mt, __builtin_amdgcn_readfirstlane(mt.tilestart[NE]), G, bid};
            pg8::EpiSwiglu E{(unsigned char*)(ws + WS_ACT), a.in[I_BEIN] + (size_t)l * NE * 2048, 1.0f / WEIN_SCALE};
            pg8::gemm_phase<pg8::EpiSwiglu, MoeSched1, true, 1>(lds, 512, S, E, wv);
            if (l + 1 < DEPTH) {
                const int nwg = S.nMt * 8, maxr = (nwg + G - 1) / G, myr = (nwg - bid + G - 1) / G;
                if (myr < maxr) conv_drain(a, l + 1, CONV_Q1, lds, wv);
            }
            SEAM(pb + 7);
        }
        if (EN(9) && IN(pb + 8)) for (int rr = 0; rr < REPN(9); ++rr) { unsigned char* ws = opaque_ptr(ws0); const int bid = opaque_bid(); (void)bid; (void)ws;
            moe_tables(a, l + DEPTH * (REPN(7) - 1), lds, wv);
            LAS unsigned char* lds_o = lds; asm volatile("" : "+s"(lds_o)); const MoeTab mt = moe_tab_ptrs(lds_o);
            MoeSched2 S{(const char*)(ws + WS_ACT), (const char*)(ws + WS_WEOUT) + (size_t)l * NE * 1024 * 1024, mt, __builtin_amdgcn_readfirstlane(mt.tilestart[NE]), G, bid};
            pg8::EpiMoeOut E{(unsigned char*)(ws + WS_OUTB), (float*)(ws + WS_OUTSC), a.in[I_BEOUT] + (size_t)l * NE * D, 1.0f / WEIN_SCALE};
            pg8::gemm_phase<pg8::EpiMoeOut, MoeSched2, true, 1>(lds, 512, S, E, wv);
            if (l + 1 < DEPTH) {
                const int nwg = S.nMt * 4, maxr = (nwg + G - 1) / G, myr = (nwg - bid + G - 1) / G;
                if (myr < maxr) conv_drain(a, l + 1, CONV_Q2, lds, wv);
            }
            SEAM(pb + 8);
        }
    }
    if (EN(10) && IN(N_PHASES - 1)) phase_a(a, DEPTH, lds, false, wv);
#undef IN
#undef SEAM
}

extern "C" void kernel_launch(void* const* d_in, const int* in_sizes, int n_in, void* d_out, int out_size, void* d_ws, size_t ws_size, hipStream_t stream) {
    static int grid = 0;
    if (grid == 0) {
        if (n_in != 26 || out_size != T * D || ws_size < WS_END) { fprintf(stderr, "kernel_launch: unexpected problem (n_in %d out %d ws %zu)\n", n_in, out_size, ws_size); grid = -1; return; }
        int dev = 0, cus = 0, per_cu = 0;
        if (hipGetDevice(&dev) != hipSuccess || hipDeviceGetAttribute(&cus, hipDeviceAttributeMultiprocessorCount, dev) != hipSuccess) { grid = -1; return; }
        if (hipFuncSetAttribute((const void*)fwd_kernel, hipFuncAttributeMaxDynamicSharedMemorySize, LDS_BYTES) != hipSuccess) { fprintf(stderr, "kernel_launch: hipFuncSetAttribute failed\n"); grid = -1; return; }
        if (hipOccupancyMaxActiveBlocksPerMultiprocessor(&per_cu, (const void*)fwd_kernel, NTHREADS, LDS_BYTES) != hipSuccess || per_cu < 1) fprintf(stderr, "kernel_launch: occupancy query says %d\n", per_cu);
        (void)hipGetLastError();
        grid = cus;
    }
    if (grid < 0) return;
    if (hipMemsetAsync((char*)d_ws + WS_CTL, 0, CTL_ZERO_BYTES, stream) != hipSuccess) return;
    if (hipMemsetAsync((char*)d_ws + WS_AGG, 0, AGG_BYTES, stream) != hipSuccess) return;
    Args a{};
    for (int i = 0; i < 26; ++i) a.in[i] = (const float*)d_in[i];
    a.out = (float*)d_out; a.ws = (unsigned char*)d_ws;
#if MK_PER_PHASE
    for (int p = 0; p < N_PHASES; ++p) { a.ph_lo = p; a.ph_hi = p + 1; hipLaunchKernelGGL(fwd_kernel, dim3(grid), dim3(NTHREADS), LDS_BYTES, stream, a); }
#else
    a.ph_lo = 0; a.ph_hi = N_PHASES;
    hipLaunchKernelGGL(fwd_kernel, dim3(grid), dim3(NTHREADS), LDS_BYTES, stream, a);
#endif
    const hipError_t le = hipPeekAtLastError();
    if (le != hipSuccess) fprintf(stderr, "kernel_launch: launch failed: %s\n", hipGetErrorName(le));
}
```

```cpp
#include <hip/hip_runtime.h>
#include <cstdio>
#include <cstdint>

#define REP_MASK 0x0
#ifndef PH_MASK
#define PH_MASK 0x7ff
#endif
#define EN(b) ((PH_MASK >> (b)) & 1)
#ifndef REP_MASK
#define REP_MASK 0
#endif
#define REPN(b) ((((REP_MASK) >> (b)) & 1) ? 2 : 1)
#ifndef Z_I8
#define Z_I8 1
#endif
#ifndef Z_FP8
#define Z_FP8 0
#endif
#ifndef MK_PER_PHASE
#define MK_PER_PHASE 0
#endif

#define LAS __attribute__((address_space(3)))
typedef unsigned short bf16_t;
typedef short bf16x8 __attribute__((ext_vector_type(8)));
typedef float f32x4 __attribute__((ext_vector_type(4)));
typedef float f32x2 __attribute__((ext_vector_type(2)));
typedef float f32x16 __attribute__((ext_vector_type(16)));
typedef unsigned u32x4 __attribute__((ext_vector_type(4)));
typedef unsigned u32x2 __attribute__((ext_vector_type(2)));

constexpr int D = 1024, NBATCH = 8, SEQ = 4096, T = NBATCH * SEQ, DEPTH = 4;
constexpr int NZ = 4608, ZO_GLRU = 1024, ZO_XPOOL = 2048, ZO_GL0 = 2560, ZO_GL1 = 3584;
constexpr int NE = 32, TOPK = 4;
constexpr int KCAT = 1536;
constexpr int SLOT_CAP = T * TOPK + NE * 256;
constexpr int MAX_MT = SLOT_CAP / 256;
constexpr float NORM_EPS = 1e-6f;
constexpr float WEIN_SCALE = 64.0f;
constexpr int NTHREADS = 512, NWAVES = 8;

constexpr size_t MiB = 1u << 20;
constexpr size_t WS_CTL = 0, CTL_ZERO_BYTES = 256 * 1024;
constexpr size_t WS_MOD = 1 * MiB;
constexpr size_t WS_CB = 2 * MiB;
constexpr size_t WS_AGG = 72 * MiB;
constexpr size_t AGG_BYTES = (size_t)DEPTH * NBATCH * 32 * D * 8;
constexpr size_t WS_WRS = 3 * MiB;
constexpr size_t WS_HSC = 4 * MiB;
constexpr size_t WS_WINSC = 5 * MiB;
constexpr size_t WS_TOKOF = 6 * MiB;
constexpr size_t WS_SLOTINFO = 10 * MiB;
constexpr size_t WS_WGT = 11 * MiB;
constexpr size_t WS_WRG = 12 * MiB;
constexpr size_t WS_WPOOL = 14 * MiB;
constexpr size_t WS_WIN = 16 * MiB;
constexpr size_t WS_WCAT = 52 * MiB;
constexpr size_t WS_WOUT = 64 * MiB;
constexpr size_t WS_WEIN = 128 * MiB;
constexpr size_t WS_WEOUT = 640 * MiB;
constexpr size_t WS_XRES = 896 * MiB;
constexpr size_t WS_H = 1024 * MiB;
constexpr size_t WS_Z = 1088 * MiB;
constexpr size_t WS_ACAT = 1376 * MiB;
constexpr size_t WS_MERGED = 1472 * MiB;
constexpr size_t WS_ACT = 1536 * MiB;
constexpr size_t WS_OUTB = 1808 * MiB;
constexpr size_t WS_OUTSC = WS_OUTB + 144 * MiB;
constexpr size_t WS_END = 2080 * MiB;
static_assert(WS_ACT + (size_t)SLOT_CAP * 1024 * 2 <= WS_OUTB && WS_OUTB + (size_t)SLOT_CAP * 1024 * 2 <= WS_END, "ws map");
constexpr int CW_BAR = 4096;
constexpr int CW_CONVQ = 7680;
constexpr int CW_CNT = 8192;

constexpr int LDS_BYTES = 163840;
constexpr int LDS_TAB = 131072;
constexpr int LDS_NVA = 131072 + 8192;
constexpr int LDS_MISC = LDS_BYTES - 256;

__device__ __forceinline__ unsigned cvt_pk_bf16(float lo, float hi) { unsigned r; asm("v_cvt_pk_bf16_f32 %0, %1, %2" : "=v"(r) : "v"(lo), "v"(hi)); return r; }
__device__ __forceinline__ float bflo(unsigned w) { return __uint_as_float(w << 16); }
__device__ __forceinline__ float bfhi(unsigned w) { return __uint_as_float(w & 0xffff0000u); }
__device__ __forceinline__ float bf1(bf16_t w) { return __uint_as_float(((unsigned)w) << 16); }
__device__ __forceinline__ float sigmoidf_(float x) { return __builtin_amdgcn_rcpf(1.0f + __expf(-x)); }
__device__ __forceinline__ float shflx(float v, int mask, int lane) { return __int_as_float(__builtin_amdgcn_ds_bpermute((lane ^ mask) << 2, __float_as_int(v))); }
__device__ __forceinline__ float wave_sum(float v, int lane) {
#pragma unroll
    for (int o = 1; o < 64; o <<= 1) v += shflx(v, o, lane);
    return v;
}
__device__ __forceinline__ int tid_of(int wv) { int l; asm volatile("v_mbcnt_lo_u32_b32 %0, -1, 0\n\tv_mbcnt_hi_u32_b32 %0, -1, %0" : "=v"(l)); return wv * 64 + l; }
__device__ __forceinline__ int opaque_bid() { int b = blockIdx.x; asm volatile("" : "+s"(b)); return b; }
__device__ __forceinline__ unsigned char* opaque_ptr(unsigned char* p) { size_t z = 0; asm volatile("" : "+s"(z)); return p + z; }
#define LDS_WAIT() asm volatile("s_waitcnt lgkmcnt(0)" ::: "memory")
#define VM_WAIT() asm volatile("s_waitcnt vmcnt(0)" ::: "memory")

namespace pg8 {
constexpr int BM = 256, BK = 64, HALF = 128, HTB = HALF * BK * 2, STAGE_BYTES = 8 * HTB, NXCD = 8, WGM = 8;
__host__ __device__ __forceinline__ int lds_byte(int r, int c) { const int st = (r >> 4) * 2 + (c >> 5), rr = r & 15, cc = c & 31, ob = rr * 64 + cc * 2; return st * 1024 + (ob ^ (((ob >> 9) & 1) << 5)); }
__host__ __device__ __forceinline__ void stage_rc(int b, int& R, int& C) { const int st = b / 1024, sb = b % 1024, swz = sb ^ (((sb >> 9) & 1) << 5); R = (st >> 1) * 16 + swz / 64; C = (st & 1) * 32 + (swz % 64) / 2; }
__host__ __device__ __forceinline__ int perm32(int rho) { const int n = rho >> 4, i = rho & 15; return 8 * (i >> 2) + 4 * n + (i & 3); }

struct Unit { int pm, pn, e, j, row0, rows; };
typedef int v8i32 __attribute__((ext_vector_type(8)));
typedef int v4i32_t __attribute__((ext_vector_type(4)));
__device__ __forceinline__ v8i32 cat8(bf16x8 lo, bf16x8 hi) { typedef int v4i32 __attribute__((ext_vector_type(4))); const v4i32 a = __builtin_bit_cast(v4i32, lo), b = __builtin_bit_cast(v4i32, hi); return (v8i32){a.x, a.y, a.z, a.w, b.x, b.y, b.z, b.w}; }

__device__ __forceinline__ bool order_map(int i, int G, int c, int nM, int nN, int& pm, int& pn) {
    const int nwg = nM * nN; const int L = i * G + c; if (L >= nwg) return false;
    int wgid = L; { const int q = nwg / NXCD, r = nwg % NXCD, xcd = wgid % NXCD, off = wgid / NXCD; wgid = (xcd < r ? xcd * (q + 1) : r * (q + 1) + (xcd - r) * q) + off; }
    const int nig = WGM * nN, gid = wgid / nig, fm = gid * WGM, gsz = (nM - fm) < WGM ? (nM - fm) : WGM;
    pm = fm + ((wgid % nig) % gsz); pn = (wgid % nig) / gsz; return true;
}

struct PlainSched {
    static constexpr bool DYN_A = false;
    const char* A; const char* Bt; int K, nM, nN, G, c;
    __device__ __forceinline__ bool next(int i, Unit& u) const { int pm, pn; if (!order_map(i, G, c, nM, nN, pm, pn)) return false; u.pm = pm; u.pn = pn; u.e = 0; u.j = 0; u.row0 = pm * BM; u.rows = BM; return true; }
    __device__ __forceinline__ const char* a_ptr() const { return A; }
    __device__ __forceinline__ const char* b_ptr() const { return Bt; }
    __device__ __forceinline__ unsigned a_off(const Unit& u) const { return (unsigned)u.row0 * (unsigned)K * 2u; }
    __device__ __forceinline__ unsigned b_off(const Unit& u) const { return (unsigned)u.pn * (unsigned)(BM * K * 2); }
    __device__ __forceinline__ void a_voff(const Unit&, unsigned (&v)[2][2], int wv) const {
        int tid = tid_of(wv); asm volatile("" : "+v"(tid));
#pragma unroll
        for (int i = 0; i < 2; ++i) { int R, C; stage_rc(tid * 16 + i * 8192, R, C);
#pragma unroll
            for (int h = 0; h < 2; ++h) v[h][i] = (unsigned)((h * HALF + R) * K + C) * 2u; }
    }
};

template <class Epi, class Sched, bool ALIGN_EPI, int MODE = 0>
__device__ __forceinline__ void gemm_phase(LAS unsigned char* lds, const int K, const Sched& S, const Epi& E, const int wv) {
    asm volatile("" : "+s"(lds));
    int tid = tid_of(wv); asm volatile("" : "+v"(tid));
    const int wid = __builtin_amdgcn_readfirstlane(tid >> 6), lane = tid & 63, wr = wid >> 2, wc = wid & 3, fr = lane & 15, fq = lane >> 4;
    const int nt = K / BK;
    unsigned voffB;
    { int R, C; stage_rc(tid * 16, R, C); const int Rb = Epi::PERM ? ((R & ~31) + perm32(R & 31)) : R; voffB = (unsigned)(Rb * K + C) * 2u; }
    const unsigned q64 = (unsigned)(64 * K * 2);
    const unsigned kstep = (unsigned)(BK * 2);
    const unsigned hstep = (unsigned)(HALF * K * 2);
    const __amdgpu_buffer_rsrc_t rsA = __builtin_amdgcn_make_buffer_rsrc((void*)S.a_ptr(), 0, 0xffffffff, 0x00020000);
    const __amdgpu_buffer_rsrc_t rsB = __builtin_amdgcn_make_buffer_rsrc((void*)S.b_ptr(), 0, 0xffffffff, 0x00020000);
    const unsigned ldsw = (unsigned)wid * 1024u;
    const int aoff = lds_byte(wr * 64 + fr, fq * 8), boff = lds_byte(wc * 32 + fr, fq * 8);
#define PG8_SA(b, h) (((b) * 2 + (h)) * HTB)
#define PG8_SB(b, h) ((4 + (b) * 2 + (h)) * HTB)
#define PG8_STAGE_(rs, bufoff, v0, s0, v1, s1) do { \
        __builtin_amdgcn_raw_ptr_buffer_load_lds(rs, (LAS void*)(lds + (bufoff) + ldsw), 16, (v0), (s0), 0, 0); \
        __builtin_amdgcn_raw_ptr_buffer_load_lds(rs, (LAS void*)(lds + (bufoff) + ldsw + 8192), 16, (v1), (s1), 0, 0); } while (0)
#define PG8_STAGE_B(bufoff, soff, unused) PG8_STAGE_(rsB, bufoff, voffB, (soff), voffB, (soff) + q64)
#define PG8_STAGE_A(bufoff, soff, h) do { if constexpr (Sched::DYN_A) PG8_STAGE_(rsA, bufoff, cvA[h][0], (soff), cvA[h][1], (soff)); \
        else PG8_STAGE_(rsA, bufoff, cvA[0][0], (soff) + (h) * 2u * q64, cvA[0][0], (soff) + (h) * 2u * q64 + q64); } while (0)
#define PG8_LDA(dst, b, h) do { _Pragma("unroll") for (int m = 0; m < 4; ++m) _Pragma("unroll") for (int k = 0; k < 2; ++k) dst[m][k] = *(const LAS bf16x8*)(lds + PG8_SA(b, h) + aoff + m * 2048 + k * 1024); } while (0)
#define PG8_LDB(dst, b, h) do { _Pragma("unroll") for (int n = 0; n < 2; ++n) _Pragma("unroll") for (int k = 0; k < 2; ++k) dst[n][k] = *(const LAS bf16x8*)(lds + PG8_SB(b, h) + boff + n * 2048 + k * 1024); } while (0)
#define PG8_MMA(ai, bj, At, Bt) do { __builtin_amdgcn_s_setprio(1); _Pragma("unroll") for (int m = 0; m < 4; ++m) _Pragma("unroll") for (int n = 0; n < 2; ++n) { \
        if constexpr (MODE == 1) { acc[ai][bj][m][n] = __builtin_amdgcn_mfma_scale_f32_16x16x128_f8f6f4(cat8(Bt[n][0], Bt[n][1]), cat8(At[m][0], At[m][1]), acc[ai][bj][m][n], 0, 0, 0, 0x7f7f7f7f, 0, 0x7f7f7f7f); } \
        else if constexpr (MODE == 2) { _Pragma("unroll") for (int k = 0; k < 2; ++k) acc[ai][bj][m][n] = __builtin_bit_cast(f32x4, __builtin_amdgcn_mfma_i32_16x16x64_i8(__builtin_bit_cast(v4i32_t, Bt[n][k]), __builtin_bit_cast(v4i32_t, At[m][k]), __builtin_bit_cast(v4i32_t, acc[ai][bj][m][n]), 0, 0, 0)); } \
        else { _Pragma("unroll") for (int k = 0; k < 2; ++k) acc[ai][bj][m][n] = __builtin_amdgcn_mfma_f32_16x16x32_bf16(Bt[n][k], At[m][k], acc[ai][bj][m][n], 0, 0, 0); } } \
        __builtin_amdgcn_s_setprio(0); } while (0)
#define PG8_WAIT_V(n) asm volatile("s_waitcnt vmcnt(" #n ")" ::: "memory")
#define PG8_WAIT_L(n) asm volatile("s_waitcnt lgkmcnt(" #n ")" ::: "memory")
#define PG8_BAR __builtin_amdgcn_s_barrier()
#define PG8_SCHED __builtin_amdgcn_sched_barrier(0)
    Unit cur, nxt; int ui = 0;
    if (!S.next(0, cur)) return;
    f32x4 acc[2][2][4][2];
    { float z0 = 0.f; asm volatile("" : "+v"(z0));
#pragma unroll
    for (int a = 0; a < 2; ++a)
#pragma unroll
        for (int b = 0; b < 2; ++b)
#pragma unroll
            for (int m = 0; m < 4; ++m)
#pragma unroll
                for (int n = 0; n < 2; ++n) acc[a][b][m][n] = (f32x4){z0, z0, z0, z0}; }
    bf16x8 At[4][2], B0[2][2], B1[2][2];
    unsigned cvA[2][2];
    LAS u32x4* nvp = (LAS u32x4*)(lds + LDS_NVA) + tid;
    S.a_voff(cur, cvA, wv);
    unsigned cA = S.a_off(cur), cB = S.b_off(cur);
    PG8_STAGE_B(PG8_SB(0, 0), cB, voffB); PG8_STAGE_B(PG8_SB(0, 1), cB + hstep, voffB); PG8_STAGE_A(PG8_SA(0, 0), cA, 0); PG8_STAGE_A(PG8_SA(0, 1), cA, 1);
    if (wr == 1) PG8_BAR;
    PG8_WAIT_V(2); PG8_BAR;
    PG8_STAGE_B(PG8_SB(1, 0), cB + kstep, voffB); PG8_STAGE_A(PG8_SA(1, 0), cA + kstep, 0); PG8_STAGE_B(PG8_SB(1, 1), cB + hstep + kstep, voffB);
    PG8_WAIT_V(6); PG8_BAR;
    for (;;) {
        const bool has_next = S.next(ui + 1, nxt);
        unsigned nA = cA, nB = cB;
        if (has_next) { nA = S.a_off(nxt); nB = S.b_off(nxt); }
        if constexpr (Sched::DYN_A) { unsigned nv[2][2];
            if (has_next) S.a_voff(nxt, nv, wv); else {
#pragma unroll
                for (int h = 0; h < 2; ++h)
#pragma unroll
                    for (int i = 0; i < 2; ++i) nv[h][i] = cvA[h][i]; }
            *nvp = (u32x4){nv[0][0], nv[0][1], nv[1][0], nv[1][1]}; }
#pragma unroll 1
        for (int t = 0; t < nt; t += 2) {
            const bool last = (t == nt - 2);
            const unsigned a1 = cA + (unsigned)(t + 1) * kstep;
            const unsigned a2 = last ? nA : cA + (unsigned)(t + 2) * kstep, b2 = last ? nB : cB + (unsigned)(t + 2) * kstep;
            const unsigned a3 = a2 + kstep, b3 = b2 + kstep;
            unsigned nx1[2] = {cvA[1][0], cvA[1][1]};
            if constexpr (Sched::DYN_A) { if (last) { const u32x4 q = *nvp; cvA[0][0] = q.x; cvA[0][1] = q.y; nx1[0] = q.z; nx1[1] = q.w; } }
            if constexpr (Epi::HOOK_T >= 0) { if (t == Epi::HOOK_T) E.mid(acc, cur, wr, wc, fr, fq); }
            PG8_LDB(B0, 0, 0); PG8_LDB(B1, 0, 1); PG8_SCHED; PG8_LDA(At, 0, 0); PG8_STAGE_A(PG8_SA(1, 1), a1, 1);
            if constexpr (Sched::DYN_A) { cvA[1][0] = nx1[0]; cvA[1][1] = nx1[1]; }
            PG8_WAIT_V(8); PG8_WAIT_L(0); PG8_BAR; PG8_MMA(0, 0, At, B0); PG8_MMA(0, 1, At, B1); PG8_BAR; PG8_SCHED;
            PG8_LDA(At, 0, 1); PG8_STAGE_B(PG8_SB(0, 0), b2, voffB); PG8_STAGE_B(PG8_SB(0, 1), b2 + hstep, voffB); PG8_STAGE_A(PG8_SA(0, 0), a2, 0);
            PG8_WAIT_V(8); PG8_WAIT_L(0); PG8_BAR; PG8_MMA(1, 0, At, B0); PG8_MMA(1, 1, At, B1); PG8_BAR; PG8_SCHED;
            PG8_LDB(B0, 1, 0); PG8_LDB(B1, 1, 1); PG8_SCHED; PG8_LDA(At, 1, 0); PG8_STAGE_A(PG8_SA(0, 1), a2, 1);
            PG8_WAIT_V(8); PG8_WAIT_L(0); PG8_BAR; PG8_MMA(0, 0, At, B0); PG8_MMA(0, 1, At, B1); PG8_BAR; PG8_SCHED;
            PG8_LDA(At, 1, 1); PG8_STAGE_B(PG8_SB(1, 0), b3, voffB); PG8_STAGE_B(PG8_SB(1, 1), b3 + hstep, voffB); PG8_STAGE_A(PG8_SA(1, 0), a3, 0);
            PG8_WAIT_V(8); PG8_WAIT_L(0); PG8_BAR; PG8_MMA(1, 0, At, B0); PG8_MMA(1, 1, At, B1); PG8_BAR; PG8_SCHED;
        }
        if constexpr (ALIGN_EPI) { if (wr == 0) PG8_BAR; }
        E(acc, cur, wr, wc, fr, fq);
        if (!has_next) break;
        { float z0 = 0.f; asm volatile("" : "+v"(z0));
#pragma unroll
        for (int a = 0; a < 2; ++a)
#pragma unroll
            for (int b = 0; b < 2; ++b)
#pragma unroll
                for (int m = 0; m < 4; ++m)
#pragma unroll
                    for (int n = 0; n < 2; ++n) acc[a][b][m][n] = (f32x4){z0, z0, z0, z0}; }
        cur = nxt; cA = nA; cB = nB; ++ui;
        if constexpr (ALIGN_EPI) { if (wr == 1) PG8_BAR; }
    }
    PG8_WAIT_V(0);
    if constexpr (!ALIGN_EPI) { if (wr == 0) PG8_BAR; }
    PG8_BAR;
#undef PG8_SA
#undef PG8_SB
#undef PG8_STAGE_
#undef PG8_STAGE_A
#undef PG8_STAGE_B
#undef PG8_LDA
#undef PG8_LDB
#undef PG8_MMA
#undef PG8_WAIT_V
#undef PG8_WAIT_L
#undef PG8_BAR
#undef PG8_SCHED
}

struct EpiBf16 {
    static constexpr bool PERM = true; static constexpr int HOOK_T = -1;
    bf16_t* O; int ldc; const float* bias; int noepi; float scale;
    __device__ __forceinline__ void mid(f32x4 (&)[2][2][4][2], const Unit&, int, int, int, int) const {}
    __device__ __forceinline__ void operator()(const f32x4 (&acc)[2][2][4][2], const Unit& u, int wr, int wc, int fr, int fq) const {
        { const int l_ = tid_of(0); fr = l_ & 15; fq = l_ >> 4; }
        if (noepi) { if (acc[0][0][0][0][0] == 1.2345e-30f) O[0] = 0; return; }
        int row0 = u.row0 + wr * 64 + fr; asm volatile("" : "+v"(row0)); int col0 = u.pn * BM + wc * 32 + 8 * fq; asm volatile("" : "+v"(col0));
        f32x4 bv[2][2];
#pragma unroll
        for (int bj = 0; bj < 2; ++bj)
#pragma unroll
            for (int n = 0; n < 2; ++n) bv[bj][n] = bias ? *(const f32x4*)(bias + col0 + bj * HALF + 4 * n) : (f32x4){0.f, 0.f, 0.f, 0.f};
#pragma unroll
        for (int ai = 0; ai < 2; ++ai)
#pragma unroll
            for (int m = 0; m < 4; ++m) { bf16_t* rowp = O + (size_t)(row0 + ai * HALF + m * 16) * ldc + col0;
#pragma unroll
                for (int bj = 0; bj < 2; ++bj) { const f32x4 v0 = acc[ai][bj][m][0] * scale + bv[bj][0], v1 = acc[ai][bj][m][1] * scale + bv[bj][1];
                    u32x4 w; w.x = cvt_pk_bf16(v0[0], v0[1]); w.y = cvt_pk_bf16(v0[2], v0[3]); w.z = cvt_pk_bf16(v1[0], v1[1]); w.w = cvt_pk_bf16(v1[2], v1[3]);
                    *(u32x4*)(rowp + bj * HALF) = w; } }
    }
};
struct EpiZI8 {
    static constexpr bool PERM = true; static constexpr int HOOK_T = -1;
    bf16_t* O; const float* rsc; const float* csc;
    __device__ __forceinline__ void mid(f32x4 (&)[2][2][4][2], const Unit&, int, int, int, int) const {}
    __device__ __forceinline__ void operator()(const f32x4 (&acc)[2][2][4][2], const Unit& u, int wr, int wc, int fr, int fq) const {
        { const int l_ = tid_of(0); fr = l_ & 15; fq = l_ >> 4; }
        int row0 = u.row0 + wr * 64 + fr; asm volatile("" : "+v"(row0)); int col0 = u.pn * BM + wc * 32 + 8 * fq; asm volatile("" : "+v"(col0));
        f32x4 cs[2][2];
#pragma unroll
        for (int bj = 0; bj < 2; ++bj)
#pragma unroll
            for (int n = 0; n < 2; ++n) cs[bj][n] = *(const f32x4*)(csc + col0 + bj * HALF + 4 * n);
#pragma unroll
        for (int ai = 0; ai < 2; ++ai)
#pragma unroll
            for (int m = 0; m < 4; ++m) { const int r = row0 + ai * HALF + m * 16; const float rs = rsc[r]; bf16_t* rowp = O + (size_t)r * NZ + col0;
#pragma unroll
                for (int bj = 0; bj < 2; ++bj) { const v4i32_t i0 = __builtin_bit_cast(v4i32_t, acc[ai][bj][m][0]), i1 = __builtin_bit_cast(v4i32_t, acc[ai][bj][m][1]);
                    const f32x4 v0 = (f32x4){(float)i0.x, (float)i0.y, (float)i0.z, (float)i0.w} * rs * cs[bj][0], v1 = (f32x4){(float)i1.x, (float)i1.y, (float)i1.z, (float)i1.w} * rs * cs[bj][1];
                    u32x4 w; w.x = cvt_pk_bf16(v0[0], v0[1]); w.y = cvt_pk_bf16(v0[2], v0[3]); w.z = cvt_pk_bf16(v1[0], v1[1]); w.w = cvt_pk_bf16(v1[2], v1[3]);
                    *(u32x4*)(rowp + bj * HALF) = w; } }
    }
};
struct EpiMerged {
    static constexpr bool PERM = true; static constexpr int HOOK_T = 8;
    bf16_t* O; const bf16_t* Z;
    __device__ __forceinline__ void mid(f32x4 (&acc)[2][2][4][2], const Unit& u, int wr, int wc, int fr, int fq) const {
        { const int l_ = tid_of(0); fr = l_ & 15; fq = l_ >> 4; }
        int row0 = u.row0 + wr * 64 + fr; asm volatile("" : "+v"(row0)); int col0 = u.pn * BM + wc * 32 + 8 * fq; asm volatile("" : "+v"(col0));
#pragma unroll
        for (int ai = 0; ai < 2; ++ai) {
            u32x4 l0[4][2], l1[4][2];
#pragma unroll
            for (int m = 0; m < 4; ++m) { const bf16_t* zr = Z + (size_t)(row0 + ai * HALF + m * 16) * NZ + col0;
#pragma unroll
                for (int bj = 0; bj < 2; ++bj) { l0[m][bj] = *(const u32x4*)(zr + ZO_GL0 + bj * HALF); l1[m][bj] = *(const u32x4*)(zr + ZO_GL1 + bj * HALF); } }
#pragma unroll
            for (int m = 0; m < 4; ++m)
#pragma unroll
                for (int bj = 0; bj < 2; ++bj) {
                    const unsigned a0[4] = {l0[m][bj].x, l0[m][bj].y, l0[m][bj].z, l0[m][bj].w}, a1[4] = {l1[m][bj].x, l1[m][bj].y, l1[m][bj].z, l1[m][bj].w};
#pragma unroll
                    for (int q = 0; q < 4; ++q) {
                        const float r0 = (1.0f + __expf(-bflo(a0[q]))) * __builtin_amdgcn_rcpf(1.0f + __expf(-bflo(a1[q])));
                        const float r1 = (1.0f + __expf(-bfhi(a0[q]))) * __builtin_amdgcn_rcpf(1.0f + __expf(-bfhi(a1[q])));
                        acc[ai][bj][m][q >> 1][(q & 1) * 2 + 0] *= r0; acc[ai][bj][m][q >> 1][(q & 1) * 2 + 1] *= r1; } }
            asm volatile("" ::: "memory"); }
    }
    __device__ __forceinline__ void operator()(const f32x4 (&acc)[2][2][4][2], const Unit& u, int wr, int wc, int fr, int fq) const {
        { const int l_ = tid_of(0); fr = l_ & 15; fq = l_ >> 4; }
        int row0 = u.row0 + wr * 64 + fr; asm volatile("" : "+v"(row0)); int col0 = u.pn * BM + wc * 32 + 8 * fq; asm volatile("" : "+v"(col0));
        u32x4 l0[2][4][2];
#pragma unroll
        for (int ai = 0; ai < 2; ++ai)
#pragma unroll
            for (int m = 0; m < 4; ++m) { const bf16_t* zr = Z + (size_t)(row0 + ai * HALF + m * 16) * NZ + col0;
#pragma unroll
                for (int bj = 0; bj < 2; ++bj) l0[ai][m][bj] = *(const u32x4*)(zr + ZO_GL0 + bj * HALF); }
#pragma unroll
        for (int ai = 0; ai < 2; ++ai)
#pragma unroll
            for (int m = 0; m < 4; ++m) { bf16_t* orow = O + (size_t)(row0 + ai * HALF + m * 16) * D + col0;
#pragma unroll
                for (int bj = 0; bj < 2; ++bj) {
                    const unsigned a0[4] = {l0[ai][m][bj].x, l0[ai][m][bj].y, l0[ai][m][bj].z, l0[ai][m][bj].w};
                    float o[8];
#pragma unroll
                    for (int q = 0; q < 4; ++q) { o[2 * q] = acc[ai][bj][m][q >> 1][(q & 1) * 2 + 0] * sigmoidf_(bflo(a0[q])); o[2 * q + 1] = acc[ai][bj][m][q >> 1][(q & 1) * 2 + 1] * sigmoidf_(bfhi(a0[q])); }
                    u32x4 w; w.x = cvt_pk_bf16(o[0], o[1]); w.y = cvt_pk_bf16(o[2], o[3]); w.z = cvt_pk_bf16(o[4], o[5]); w.w = cvt_pk_bf16(o[6], o[7]);
                    *(u32x4*)(orow + bj * HALF) = w; } }
    }
};
struct EpiResid {
    static constexpr bool PERM = true; static constexpr int HOOK_T = -1;
    bf16_t* X; bf16_t* XO; const float* gate;
    __device__ __forceinline__ void mid(f32x4 (&)[2][2][4][2], const Unit&, int, int, int, int) const {}
    __device__ __forceinline__ void operator()(const f32x4 (&acc)[2][2][4][2], const Unit& u, int wr, int wc, int fr, int fq) const {
        { const int l_ = tid_of(0); fr = l_ & 15; fq = l_ >> 4; }
        int row0 = u.row0 + wr * 64 + fr; asm volatile("" : "+v"(row0)); int col0 = u.pn * BM + wc * 32 + 8 * fq; asm volatile("" : "+v"(col0));
        const float* gp = gate + (size_t)(u.row0 / SEQ) * (6 * D) + col0;
        f32x4 gv[2][2];
#pragma unroll
        for (int bj = 0; bj < 2; ++bj)
#pragma unroll
            for (int n = 0; n < 2; ++n) gv[bj][n] = *(const f32x4*)(gp + bj * HALF + 4 * n);
#pragma unroll
        for (int ai = 0; ai < 2; ++ai) {
            u32x4 xv[4][2];
#pragma unroll
            for (int m = 0; m < 4; ++m) { const bf16_t* rowp = X + (size_t)(row0 + ai * HALF + m * 16) * D + col0;
#pragma unroll
                for (int bj = 0; bj < 2; ++bj) xv[m][bj] = *(const u32x4*)(rowp + bj * HALF); }
#pragma unroll
            for (int m = 0; m < 4; ++m) { bf16_t* rowo = XO + (size_t)(row0 + ai * HALF + m * 16) * D + col0;
#pragma unroll
                for (int bj = 0; bj < 2; ++bj) { const u32x4 p = xv[m][bj];
                    const f32x4 o0 = (f32x4){bflo(p.x), bfhi(p.x), bflo(p.y), bfhi(p.y)} + gv[bj][0] * acc[ai][bj][m][0], o1 = (f32x4){bflo(p.z), bfhi(p.z), bflo(p.w), bfhi(p.w)} + gv[bj][1] * acc[ai][bj][m][1];
                    u32x4 w; w.x = cvt_pk_bf16(o0[0], o0[1]); w.y = cvt_pk_bf16(o0[2], o0[3]); w.z = cvt_pk_bf16(o1[0], o1[1]); w.w = cvt_pk_bf16(o1[2], o1[3]);
                    *(u32x4*)(rowo + bj * HALF) = w; } }
            asm volatile("" ::: "memory"); }
    }
};
struct EpiSwiglu {
    static constexpr bool PERM = true; static constexpr int HOOK_T = -1;
    unsigned char* ACT; const float* bias; float wscale;
    __device__ __forceinline__ void mid(f32x4 (&)[2][2][4][2], const Unit&, int, int, int, int) const {}
    __device__ __forceinline__ void operator()(const f32x4 (&acc)[2][2][4][2], const Unit& u, int wr, int wc, int fr, int fq) const {
        { const int l_ = tid_of(0); fr = l_ & 15; fq = l_ >> 4; }
        int row0 = u.row0 + wr * 64 + fr; asm volatile("" : "+v"(row0)); int cc = u.pn * HALF + wc * 32 + 8 * fq; asm volatile("" : "+v"(cc));
        const float* bp = bias + (size_t)u.e * 2048 + cc;
        f32x4 bg[2], bu[2];
#pragma unroll
        for (int n = 0; n < 2; ++n) { bg[n] = *(const f32x4*)(bp + 4 * n); bu[n] = *(const f32x4*)(bp + 1024 + 4 * n); }
#pragma unroll
        for (int ai = 0; ai < 2; ++ai)
#pragma unroll
            for (int m = 0; m < 4; ++m) { unsigned char* rowp = ACT + (size_t)(row0 + ai * HALF + m * 16) * D + cc;
                float o[8];
#pragma unroll
                for (int n = 0; n < 2; ++n)
#pragma unroll
                    for (int j = 0; j < 4; ++j) { float g = acc[ai][0][m][n][j] * wscale + bg[n][j], up = acc[ai][1][m][n][j] * wscale + bu[n][j];
                        g = fminf(g, 7.0f); up = fminf(fmaxf(up, -7.0f), 7.0f);
                        o[4 * n + j] = g * sigmoidf_(1.702f * g) * (up + 1.0f); }
                int w0 = 0, w1 = 0;
                w0 = __builtin_amdgcn_cvt_pk_fp8_f32(o[0], o[1], w0, false); w0 = __builtin_amdgcn_cvt_pk_fp8_f32(o[2], o[3], w0, true);
                w1 = __builtin_amdgcn_cvt_pk_fp8_f32(o[4], o[5], w1, false); w1 = __builtin_amdgcn_cvt_pk_fp8_f32(o[6], o[7], w1, true);
                *(u32x2*)rowp = (u32x2){(unsigned)w0, (unsigned)w1}; }
    }
};
struct EpiMoeOut {
    static constexpr bool PERM = true; static constexpr int HOOK_T = -1;
    unsigned char* O; float* SC; const float* bias; float wscale;
    __device__ __forceinline__ void mid(f32x4 (&)[2][2][4][2], const Unit&, int, int, int, int) const {}
    __device__ __forceinline__ void operator()(const f32x4 (&acc)[2][2][4][2], const Unit& u, int wr, int wc, int fr, int fq) const {
        int lane_; { lane_ = tid_of(0); fr = lane_ & 15; fq = lane_ >> 4; }
        int row0 = u.row0 + wr * 64 + fr; asm volatile("" : "+v"(row0)); int col0 = u.pn * BM + wc * 32 + 8 * fq; asm volatile("" : "+v"(col0));
        const float* bp = bias + (size_t)u.e * D + col0;
        f32x4 bv[2][2];
#pragma unroll
        for (int bj = 0; bj < 2; ++bj)
#pragma unroll
            for (int n = 0; n < 2; ++n) bv[bj][n] = *(const f32x4*)(bp + bj * HALF + 4 * n);
#pragma unroll
        for (int ai = 0; ai < 2; ++ai)
#pragma unroll
            for (int m = 0; m < 4; ++m) { const size_t r = (size_t)(row0 + ai * HALF + m * 16);
                f32x4 v[2][2]; float am = 1e-30f;
#pragma unroll
                for (int bj = 0; bj < 2; ++bj)
#pragma unroll
                    for (int n = 0; n < 2; ++n) { v[bj][n] = acc[ai][bj][m][n] * wscale + bv[bj][n];
                        am = fmaxf(am, fmaxf(fmaxf(fabsf(v[bj][n].x), fabsf(v[bj][n].y)), fmaxf(fabsf(v[bj][n].z), fabsf(v[bj][n].w)))); }
                am = fmaxf(am, shflx(am, 16, lane_)); am = fmaxf(am, shflx(am, 32, lane_));
                const float inv = 127.0f * __builtin_amdgcn_rcpf(am) * 0.999f;
                if (fq == 0) SC[r * 16 + wc * 4 + u.pn] = am * (1.0f / (127.0f * 0.999f));
#pragma unroll
                for (int bj = 0; bj < 2; ++bj) { unsigned w0 = 0, w1 = 0;
#pragma unroll
                    for (int j = 0; j < 4; ++j) { w0 |= (unsigned)((int)rintf(v[bj][0][j] * inv) + 128) << (8 * j); w1 |= (unsigned)((int)rintf(v[bj][1][j] * inv) + 128) << (8 * j); }
                    *(u32x2*)(O + r * D + col0 + bj * HALF) = (u32x2){w0, w1}; } }
    }
};
}

#define XB_TMO      128
#define XB_XCNT(j)  (256  + 64 * (j))
#define XB_XSUB(j)  (1280 + 64 * (j))
#define XB_XGEN(j)  (2304 + 64 * (j))
#define XB_TOP      3328
#define XB_TOPGEN   3392
#define XCD_BAR_WORDS 3456
#define XB_SPIN_CAP (1u << 18)
__device__ __forceinline__ unsigned xb_ld(unsigned* p)              { return __hip_atomic_load(p, __ATOMIC_RELAXED, __HIP_MEMORY_SCOPE_AGENT); }
__device__ __forceinline__ unsigned xb_add(unsigned* p, unsigned v) { return __hip_atomic_fetch_add(p, v, __ATOMIC_RELAXED, __HIP_MEMORY_SCOPE_AGENT); }
__device__ __forceinline__ unsigned xb_xcc_id() { return (unsigned)__builtin_amdgcn_s_getreg((3 << 11) | 20) & 0xFu; }
#define XB_SPIN(cond, bar) do { unsigned _sp = 0; while (cond) { __builtin_amdgcn_s_sleep(1); \
    if ((++_sp & 255u) == 0u) { if (xb_ld(&(bar)[XB_TMO])) break; if (_sp > XB_SPIN_CAP) { atomicAdd(&(bar)[XB_TMO], 1u); break; } } } } while (0)
struct XcdBarrier { unsigned* bar; unsigned x; volatile LAS unsigned* st; int wv; };
__device__ __forceinline__ XcdBarrier xcd_barrier_post(unsigned* bar, volatile LAS unsigned* st, int wv) {
    XcdBarrier b; b.bar = bar; b.x = xb_xcc_id(); b.st = st; b.wv = wv;
    if (tid_of(wv) == 0) (void)xb_add(&bar[XB_XCNT(b.x)], 1u);
    return b;
}
__device__ __forceinline__ void xcd_barrier_complete(unsigned* bar, unsigned x, unsigned& nloc, unsigned& nx) {
    const unsigned G = gridDim.x * gridDim.y * gridDim.z;
    unsigned sum, cnt, mine, sp = 0u;
    for (;;) {
        sum = 0u; cnt = 0u; mine = 0u;
#pragma unroll
        for (unsigned j = 0; j < 16; ++j) { const unsigned c = xb_ld(&bar[XB_XCNT(j)]); sum += c; cnt += (c > 0u) ? 1u : 0u; mine = (j == x) ? c : mine; }
        if (sum == G) break;
        __builtin_amdgcn_s_sleep(1);
        if ((++sp & 255u) == 0u) { if (xb_ld(&bar[XB_TMO])) break; if (sp > XB_SPIN_CAP) { atomicAdd(&bar[XB_TMO], 1u); break; } }
    }
    nloc = mine > 0u ? mine : 1u; nx = cnt > 0u ? cnt : 1u;
}
__device__ __forceinline__ void xcd_barrier(const XcdBarrier& b) {
    asm volatile("s_waitcnt vmcnt(0)" ::: "memory");
    __syncthreads();
    if (tid_of(b.wv) == 0) {
        size_t zb = 0; asm volatile("" : "+s"(zb)); unsigned* bar = b.bar + zb; unsigned bx = b.x; asm volatile("" : "+s"(bx));
        __builtin_amdgcn_s_waitcnt(0);
        unsigned nloc = b.st[0], nx = b.st[1];
        if (nloc == 0u) { xcd_barrier_complete(bar, bx, nloc, nx); b.st[0] = nloc; b.st[1] = nx; }
        const unsigned old = xb_add(&bar[XB_XSUB(bx)], 1u);
        const unsigned gen = old / nloc;
        if (old + 1u == (gen + 1u) * nloc) {
            __builtin_amdgcn_fence(__ATOMIC_RELEASE, "agent");
            asm volatile("s_waitcnt vmcnt(0)" ::: "memory");
            const unsigned og = xb_add(&bar[XB_TOP], 1u);
            const unsigned tg = og / nx;
            if (og + 1u == (tg + 1u) * nx) xb_add(&bar[XB_TOPGEN], 1u);
            else XB_SPIN(xb_ld(&bar[XB_TOPGEN]) == tg, bar);
            __builtin_amdgcn_fence(__ATOMIC_ACQUIRE, "agent");
            xb_add(&bar[XB_XGEN(bx)], 1u);
            asm volatile("s_waitcnt vmcnt(0)" ::: "memory");
        } else {
            XB_SPIN(xb_ld(&bar[XB_XGEN(bx)]) == gen, bar);
            __builtin_amdgcn_fence(__ATOMIC_ACQUIRE, "agent");
            asm volatile("s_waitcnt vmcnt(0)" ::: "memory");
        }
    }
    __syncthreads();
}

struct Args { const float* in[26]; float* out; unsigned char* ws; int ph_lo, ph_hi; };
enum { I_X = 0, I_C, I_N1G, I_N2G, I_WADA, I_BADA, I_WIN, I_CONVW, I_CONVB, I_WRGA, I_BRGA, I_WRGX, I_BRGX, I_LAM, I_WPOOL, I_PSCALE, I_WUPA, I_WUPB, I_WOUT, I_WROUTER, I_BROUTER, I_WEIN, I_BEIN, I_WEOUT, I_BEOUT, I_FINALG };

template <int ROWMODE>
__device__ __forceinline__ void tr_item(const float* W, int N, bf16_t* WT, int dst_ld, int dst_off, int k0, int n0, LAS float* scr, int lane) {
    { float tv[32];
#pragma unroll
    for (int i = 0; i < 32; ++i) tv[i] = W[(size_t)(k0 + 2 * i + (lane >> 5)) * N + n0 + (lane & 31)];
#pragma unroll
    for (int i = 0; i < 32; ++i) scr[(2 * i + (lane >> 5)) * 33 + (lane & 31)] = tv[i]; }
    LDS_WAIT();
    const int c = lane & 7;
#pragma unroll
    for (int j = 0; j < 4; ++j) { const int n = (lane >> 3) + 8 * j; const LAS float* s = scr + (8 * c) * 33 + n;
        u32x4 o; o.x = cvt_pk_bf16(s[0 * 33], s[1 * 33]); o.y = cvt_pk_bf16(s[2 * 33], s[3 * 33]); o.z = cvt_pk_bf16(s[4 * 33], s[5 * 33]); o.w = cvt_pk_bf16(s[6 * 33], s[7 * 33]);
        const int nn = n0 + n; int drow = nn;
        if (ROWMODE == 1) { drow = (nn < 1024) ? (256 * (nn >> 7) + (nn & 127)) : (256 * ((nn - 1024) >> 7) + 128 + ((nn - 1024) & 127)); }
        *(u32x4*)(WT + (size_t)drow * dst_ld + dst_off + k0 + 8 * c) = o; }
    LDS_WAIT();
}
template <int ROWMODE>
__device__ __forceinline__ void tr_item_fp8(const float* W, int N, unsigned char* WT, int k0, int n0, LAS float* scr, int lane) {
    { float tv[64];
#pragma unroll
    for (int i = 0; i < 64; ++i) tv[i] = W[(size_t)(k0 + 2 * i + (lane >> 5)) * N + n0 + (lane & 31)];
#pragma unroll
    for (int i = 0; i < 64; ++i) scr[(2 * i + (lane >> 5)) * 33 + (lane & 31)] = tv[i]; }
    LDS_WAIT();
    const int c = lane & 7;
#pragma unroll
    for (int j = 0; j < 4; ++j) { const int n = (lane >> 3) + 8 * j; const LAS float* s = scr + (16 * c) * 33 + n;
        int o[4];
#pragma unroll
        for (int q = 0; q < 4; ++q) { int w = 0; w = __builtin_amdgcn_cvt_pk_fp8_f32(s[(4 * q) * 33] * WEIN_SCALE, s[(4 * q + 1) * 33] * WEIN_SCALE, w, false);
            w = __builtin_amdgcn_cvt_pk_fp8_f32(s[(4 * q + 2) * 33] * WEIN_SCALE, s[(4 * q + 3) * 33] * WEIN_SCALE, w, true); o[q] = w; }
        const int nn = n0 + n; const int drow = (ROWMODE == 0) ? nn : ((nn < 1024) ? (256 * (nn >> 7) + (nn & 127)) : (256 * ((nn - 1024) >> 7) + 128 + ((nn - 1024) & 127)));
        *(u32x4*)(WT + (size_t)drow * 1024 + k0 + 16 * c) = (u32x4){(unsigned)o[0], (unsigned)o[1], (unsigned)o[2], (unsigned)o[3]}; }
    LDS_WAIT();
}
template <int ROWMODE>
__device__ __forceinline__ void tr_job(int item, const float* src, int K, int N, bf16_t* dst, size_t dst_bstride, int dst_ld, int dst_off, LAS float* scr, int lane) {
    const int nnb = N / 32, nkb = K / 64; const int nb = item % nnb; const int r = item / nnb; const int kb = r % nkb; const int bt = r / nkb;
    tr_item<ROWMODE>(src + (size_t)bt * K * N, N, dst + (size_t)bt * dst_bstride, dst_ld, dst_off, 64 * kb, 32 * nb, scr, lane);
}

constexpr int CONV_Q1 = 5, CONV_Q2 = 6;
constexpr int CONV_ITEMS_L = NE * 8 * 64 + NE * 8 * 32, CONV_CHUNKS_L = CONV_ITEMS_L / 8;
__device__ __forceinline__ void conv_expert_item(const Args& a, unsigned char* ws, int l, int r, LAS float* scr, int lane) {
    if (r < NE * 8 * 64) { const int nb = r % 64, r2 = r / 64, kb = r2 % 8, bt = l * NE + r2 / 8;
        tr_item_fp8<1>(a.in[I_WEIN] + (size_t)bt * 1024 * 2048, 2048, (unsigned char*)(ws + WS_WEIN) + (size_t)bt * 2048 * 1024, 128 * kb, 32 * nb, scr, lane); }
    else { r -= NE * 8 * 64; const int nb = r % 32, r2 = r / 32, kb = r2 % 8, bt = l * NE + r2 / 8;
        tr_item_fp8<0>(a.in[I_WEOUT] + (size_t)bt * 1024 * 1024, 1024, (unsigned char*)(ws + WS_WEOUT) + (size_t)bt * 1024 * 1024, 128 * kb, 32 * nb, scr, lane); }
}
__device__ __forceinline__ void conv_drain(const Args& a, int l, int budget, LAS unsigned char* lds, const int wv) {
    asm volatile("" : "+s"(lds));
    int tid_ = tid_of(wv); asm volatile("" : "+v"(tid_)); const int tid = tid_, lane = tid & 63;
    unsigned char* ws = opaque_ptr(a.ws); unsigned* head = (unsigned*)(ws + WS_CTL) + CW_CONVQ + 64 * l;
    LAS float* scr = (LAS float*)(lds + wv * 16896); LAS int* slot = (LAS int*)(lds + LDS_BYTES - 512);
    for (;;) {
        if (budget == 0) break;
        __syncthreads();
        if (tid == 0) *slot = (int)__hip_atomic_fetch_add(head, 1u, __ATOMIC_RELAXED, __HIP_MEMORY_SCOPE_AGENT);
        __syncthreads();
        const int c = __builtin_amdgcn_readfirstlane(*slot);
        if (c >= CONV_CHUNKS_L) break;
        conv_expert_item(a, ws, l, c * 8 + wv, scr, lane);
        if (budget > 0) --budget;
    }
    __syncthreads();
}
__device__ __forceinline__ void phase_prologue(const Args& a, LAS unsigned char* lds, const int wv) {
    asm volatile("" : "+s"(lds));
    int tid_ = tid_of(wv); asm volatile("" : "+v"(tid_)); const int tid = tid_, lane = tid & 63, wave = __builtin_amdgcn_readfirstlane(tid >> 6);
    const int G = gridDim.x;
    unsigned char* ws = opaque_ptr(a.ws); const int bid = opaque_bid();
    {
        LAS float* cact = (LAS float*)lds;
        LAS float* red = (LAS float*)(lds + 32768);
        for (int i = tid; i < NBATCH * D; i += NTHREADS) { const float v = a.in[I_C][i]; cact[i] = v * sigmoidf_(v); }
        __syncthreads();
        float* mod = (float*)(ws + WS_MOD);
        for (int u = bid; u < DEPTH * 96; u += G) {
            const int l = u / 96, cg = u % 96; const int n = cg * 64 + lane;
            const float* w = a.in[I_WADA] + (size_t)l * D * 6144 + n;
            float acc[8] = {0.f, 0.f, 0.f, 0.f, 0.f, 0.f, 0.f, 0.f};
            const int kb = wave * 128;
#pragma unroll 8
            for (int k = 0; k < 128; ++k) { const float wv = w[(size_t)(kb + k) * 6144];
#pragma unroll
                for (int b = 0; b < 8; ++b) acc[b] += cact[b * D + kb + k] * wv; }
#pragma unroll
            for (int b = 0; b < 8; ++b) red[(wave * 8 + b) * 64 + lane] = acc[b];
            __syncthreads();
            { const int b = tid >> 6; float s = 0.f;
#pragma unroll
              for (int w8 = 0; w8 < 8; ++w8) s += red[(w8 * 8 + b) * 64 + lane];
              mod[((size_t)l * NBATCH + b) * 6144 + n] = s + a.in[I_BADA][(size_t)l * 6144 + n]; }
            __syncthreads();
        }
    }
    {
        bf16_t* wrs = (bf16_t*)(ws + WS_WRS);
        for (int idx = bid * NTHREADS + tid; idx < DEPTH * D * NE; idx += G * NTHREADS) { const int e = idx & 31, k = (idx >> 5) & 1023, l = idx >> 15;
            const float w = a.in[I_WROUTER][idx]; const unsigned hi = cvt_pk_bf16(w, 0.f) & 0xffffu; const unsigned lo = cvt_pk_bf16(w - bflo(hi), 0.f) & 0xffffu;
            wrs[((size_t)(l * 2 + 0) * NE + e) * D + k] = (bf16_t)hi; wrs[((size_t)(l * 2 + 1) * NE + e) * D + k] = (bf16_t)lo; }
    }
#if Z_I8
    {
        LAS float* tile = (LAS float*)lds; LAS float* red = (LAS float*)(lds + 1024 * 33 * 4);
        signed char* w8 = (signed char*)(ws + WS_WIN); float* wsc = (float*)(ws + WS_WINSC);
        __syncthreads();
        for (int u = bid; u < DEPTH * (NZ / 32); u += G) {
            const int l = u / (NZ / 32), n0 = (u % (NZ / 32)) * 32; const float* W = a.in[I_WIN] + (size_t)l * D * NZ + n0;
            const int n = tid & 31, kr = tid >> 5;
#pragma unroll 1
            for (int k0 = 0; k0 < 1024; k0 += 256) { float tv[16];
#pragma unroll
                for (int i = 0; i < 16; ++i) tv[i] = W[(size_t)(k0 + 16 * i + kr) * NZ + n];
#pragma unroll
                for (int i = 0; i < 16; ++i) tile[(k0 + 16 * i + kr) * 33 + n] = tv[i]; }
            __syncthreads();
            { float am = 0.f;
#pragma unroll 8
              for (int i = 0; i < 64; ++i) am = fmaxf(am, fabsf(tile[(kr * 64 + i) * 33 + n]));
              red[kr * 32 + n] = am; }
            __syncthreads();
            if (tid < 32) { float am = 1e-30f;
#pragma unroll
                for (int q = 0; q < 16; ++q) am = fmaxf(am, red[q * 32 + tid]);
                red[512 + tid] = 127.0f / am; wsc[(size_t)l * NZ + n0 + tid] = am * (1.0f / 127.0f); }
            __syncthreads();
            { const float inv = red[512 + n]; signed char* dst = w8 + ((size_t)l * NZ + n0 + n) * D + kr * 64;
#pragma unroll
              for (int c = 0; c < 4; ++c) { int w4[4];
#pragma unroll
                  for (int q = 0; q < 4; ++q) { int pk = 0;
#pragma unroll
                      for (int e = 0; e < 4; ++e) pk |= (((int)rintf(tile[(kr * 64 + c * 16 + q * 4 + e) * 33 + n] * inv)) & 0xff) << (8 * e);
                      w4[q] = pk; }
                  *(u32x4*)(dst + 16 * c) = (u32x4){(unsigned)w4[0], (unsigned)w4[1], (unsigned)w4[2], (unsigned)w4[3]}; } }
            __syncthreads();
        }
    }
#endif
    {
        LAS float* scr = (LAS float*)(lds + wave * 16896);
        const int gw = bid * NWAVES + wave, NGW = G * NWAVES;
        constexpr int I_EIN = NE * 8 * 64, I_EOUT = NE * 8 * 32, I_WINI = Z_I8 ? 0 : DEPTH * (Z_FP8 ? 8 : 16) * 144, I_UPA = DEPTH * 16 * 32, I_UPB = DEPTH * 8 * 32, I_OUT = DEPTH * 16 * 32,
                      I_RGA = DEPTH * 8 * 2 * 4, I_RGX = I_RGA, I_POOL = DEPTH * 4 * 2 * 4;
        constexpr int NITEMS = I_EIN + I_EOUT + I_WINI + I_UPA + I_UPB + I_OUT + I_RGA + I_RGX + I_POOL;
        for (int it = gw; it < NITEMS; it += NGW) {
            int r = it;
            if (r < I_EIN) { const int nb = r % 64, r2 = r / 64, kb = r2 % 8, bt = r2 / 8;
                tr_item_fp8<1>(a.in[I_WEIN] + (size_t)bt * 1024 * 2048, 2048, (unsigned char*)(ws + WS_WEIN) + (size_t)bt * 2048 * 1024, 128 * kb, 32 * nb, scr, lane); continue; } r -= I_EIN;
            if (r < I_EOUT) { const int nb = r % 32, r2 = r / 32, kb = r2 % 8, bt = r2 / 8;
                tr_item_fp8<0>(a.in[I_WEOUT] + (size_t)bt * 1024 * 1024, 1024, (unsigned char*)(ws + WS_WEOUT) + (size_t)bt * 1024 * 1024, 128 * kb, 32 * nb, scr, lane); continue; } r -= I_EOUT;
#if Z_I8
#elif Z_FP8
            if (r < I_WINI) { const int nb = r % 144, r2 = r / 144, kb = r2 % 8, bt = r2 / 8;
                tr_item_fp8<0>(a.in[I_WIN] + (size_t)bt * 1024 * NZ, NZ, (unsigned char*)(ws + WS_WIN) + (size_t)bt * NZ * 1024, 128 * kb, 32 * nb, scr, lane); continue; } r -= I_WINI;
#else
            if (r < I_WINI) { tr_job<0>(r, a.in[I_WIN], 1024, NZ, (bf16_t*)(ws + WS_WIN), (size_t)NZ * 1024, 1024, 0, scr, lane); continue; } r -= I_WINI;
#endif
            if (r < I_UPA) { tr_job<0>(r, a.in[I_WUPA], 1024, 1024, (bf16_t*)(ws + WS_WCAT), (size_t)1024 * KCAT, KCAT, 512, scr, lane); continue; } r -= I_UPA;
            if (r < I_UPB) { tr_job<0>(r, a.in[I_WUPB], 512, 1024, (bf16_t*)(ws + WS_WCAT), (size_t)1024 * KCAT, KCAT, 0, scr, lane); continue; } r -= I_UPB;
            if (r < I_OUT) { tr_job<0>(r, a.in[I_WOUT], 1024, 1024, (bf16_t*)(ws + WS_WOUT), (size_t)1024 * 1024, 1024, 0, scr, lane); continue; } r -= I_OUT;
            if (r < I_RGA) { tr_job<0>(r, a.in[I_WRGA], 128, 128, (bf16_t*)(ws + WS_WRG), (size_t)256 * 128, 128, 0, scr, lane); continue; } r -= I_RGA;
            if (r < I_RGX) { tr_job<0>(r, a.in[I_WRGX], 128, 128, (bf16_t*)(ws + WS_WRG) + 128 * 128, (size_t)256 * 128, 128, 0, scr, lane); continue; } r -= I_RGX;
            tr_job<0>(r, a.in[I_WPOOL], 128, 128, (bf16_t*)(ws + WS_WPOOL), (size_t)128 * 128, 128, 0, scr, lane);
        }
    }
}

struct MoeTab { LAS int* cnt; LAS int* padstart; LAS int* tilestart; LAS int* tab; };
__device__ __forceinline__ MoeTab moe_tab_ptrs(LAS unsigned char* lds) { MoeTab t; t.cnt = (LAS int*)(lds + LDS_TAB); t.padstart = t.cnt + 32; t.tilestart = t.padstart + 40; t.tab = t.tilestart + 40; return t; }
__device__ __forceinline__ void moe_tables(const Args& a, int l, LAS unsigned char* lds, const int wv) {
    asm volatile("" : "+s"(lds));
    const MoeTab mt = moe_tab_ptrs(lds); int tid_ = tid_of(wv); asm volatile("" : "+v"(tid_)); const int tid = tid_;
    unsigned* ctl = (unsigned*)(opaque_ptr(a.ws) + WS_CTL);
    __syncthreads();
    if (tid < NE) mt.cnt[tid] = (int)__hip_atomic_load(ctl + CW_CNT + (l * NE + tid) * 16, __ATOMIC_RELAXED, __HIP_MEMORY_SCOPE_AGENT);
    __syncthreads();
    if (tid == 0) { int ps = 0, ts = 0; for (int e = 0; e < NE; ++e) { mt.padstart[e] = ps; mt.tilestart[e] = ts; const int nt = (mt.cnt[e] + 255) >> 8; ps += nt * 256; ts += nt; } mt.padstart[NE] = ps; mt.tilestart[NE] = ts; }
    __syncthreads();
    const int nMt = mt.tilestart[NE];
    for (int m = tid; m < nMt; m += NTHREADS) { int e = 0; for (int q = 1; q < NE; ++q) e = (mt.tilestart[q] <= m) ? q : e; mt.tab[m] = (e << 16) | (m - mt.tilestart[e]); }
    __syncthreads();
}
struct MoeSched1 {
    static constexpr bool DYN_A = true;
    const char* H; const char* W; const int* tokof; MoeTab mt; int nMt, G, c;
    __device__ __forceinline__ bool next(int i, pg8::Unit& u) const { int pm, pn; if (!pg8::order_map(i, G, c, nMt, 8, pm, pn)) return false;
        const int en = __builtin_amdgcn_readfirstlane(mt.tab[pm]); u.pm = pm; u.pn = pn; u.e = en >> 16; u.j = en & 0xffff;
        u.row0 = __builtin_amdgcn_readfirstlane(mt.padstart[u.e]) + 256 * u.j; u.rows = __builtin_amdgcn_readfirstlane(mt.cnt[u.e]) - 256 * u.j; return true; }
    __device__ __forceinline__ const char* a_ptr() const { return H; }
    __device__ __forceinline__ const char* b_ptr() const { return W; }
    __device__ __forceinline__ unsigned a_off(const pg8::Unit&) const { return 0u; }
    __device__ __forceinline__ unsigned b_off(const pg8::Unit& u) const { return ((unsigned)u.e * 2048u + (unsigned)u.pn * 256u) * 1024u; }
    __device__ __forceinline__ void a_voff(const pg8::Unit& u, unsigned (&v)[2][2], int wv) const {
        int tid = tid_of(wv); asm volatile("" : "+v"(tid));
        const int* tl = tokof + (size_t)u.e * T + 256 * u.j; const int rmax = u.rows - 1;
#pragma unroll
        for (int i = 0; i < 2; ++i) { int R, C; pg8::stage_rc(tid * 16 + i * 8192, R, C);
#pragma unroll
            for (int h = 0; h < 2; ++h) { int idx = h * 128 + R; idx = idx < rmax ? idx : rmax; v[h][i] = (unsigned)tl[idx] * 1024u + (unsigned)C * 2u; } }
    }
};
struct MoeSched2 {
    static constexpr bool DYN_A = false;
    const char* ACT; const char* W; MoeTab mt; int nMt, G, c;
    __device__ __forceinline__ bool next(int i, pg8::Unit& u) const { int pm, pn; if (!pg8::order_map(i, G, c, nMt, 4, pm, pn)) return false;
        const int en = __builtin_amdgcn_readfirstlane(mt.tab[pm]); u.pm = pm; u.pn = pn; u.e = en >> 16; u.j = en & 0xffff;
        u.row0 = __builtin_amdgcn_readfirstlane(mt.padstart[u.e]) + 256 * u.j; u.rows = __builtin_amdgcn_readfirstlane(mt.cnt[u.e]) - 256 * u.j; return true; }
    __device__ __forceinline__ const char* a_ptr() const { return ACT; }
    __device__ __forceinline__ const char* b_ptr() const { return W; }
    __device__ __forceinline__ unsigned a_off(const pg8::Unit& u) const { return (unsigned)u.row0 * 1024u; }
    __device__ __forceinline__ unsigned b_off(const pg8::Unit& u) const { return ((unsigned)u.e * 1024u + (unsigned)u.pn * 256u) * 1024u; }
    __device__ __forceinline__ void a_voff(const pg8::Unit&, unsigned (&v)[2][2], int wv) const {
        int tid = tid_of(wv); asm volatile("" : "+v"(tid));
#pragma unroll
        for (int i = 0; i < 2; ++i) { int R, C; pg8::stage_rc(tid * 16 + i * 8192, R, C);
#pragma unroll
            for (int h = 0; h < 2; ++h) v[h][i] = (unsigned)((h * 128 + R) * 512 + C) * 2u; }
    }
};

__device__ __forceinline__ void phase_a(const Args& a, int l, LAS unsigned char* lds, bool dry, const int wv) {
    asm volatile("" : "+s"(lds));
    int tid_ = tid_of(wv); asm volatile("" : "+v"(tid_)); const int tid = tid_, lane = tid & 63, wave = __builtin_amdgcn_readfirstlane(tid >> 6);
    const int G = gridDim.x; unsigned char* ws = opaque_ptr(a.ws); const int bid = opaque_bid();
    const float* mod = (const float*)(ws + WS_MOD);
    bf16_t* xres = (bf16_t*)(ws + WS_XRES); bf16_t* xout = dry ? (bf16_t*)(ws + WS_Z) : xres;
    if (l < DEPTH && bid < NBATCH) {
        LAS float* red = (LAS float*)lds;
        const int b = bid, e = tid & 31, kp = tid >> 5;
        const float* sh2 = mod + ((size_t)l * NBATCH + b) * 6144 + 3 * D; const float* wr = a.in[I_WROUTER] + (size_t)l * D * NE;
        float s = 0.f;
        for (int k = kp * 64; k < kp * 64 + 64; ++k) s += sh2[k] * wr[k * NE + e];
        red[kp * 32 + e] = s;
        __syncthreads();
        if (tid < 32) { float t = a.in[I_BROUTER][l * NE + tid]; for (int q = 0; q < 16; ++q) t += red[q * 32 + tid]; ((float*)(ws + WS_CB))[(l * NBATCH + b) * NE + tid] = t; }
        __syncthreads();
    }
    if (l > 0) moe_tables(a, (l - 1) + DEPTH * (REPN(7) - 1), lds, wv);
    const MoeTab mt = moe_tab_ptrs(lds);
    const int* slotinfo = (const int*)(ws + WS_SLOTINFO); const float* wgt = (const float*)(ws + WS_WGT);
    const unsigned char* outb = (const unsigned char*)(ws + WS_OUTB); const float* outsc = (const float*)(ws + WS_OUTSC);
    unsigned char* hb = (unsigned char*)(ws + WS_H);
    for (int chunk = bid; chunk < T / 128; chunk += G) {
        const int rowb = chunk * 128 + wave * 16; const int b = rowb / SEQ;
        const float* xin = a.in[I_X] + (size_t)rowb * D; const bf16_t* xinb = xres + (size_t)rowb * D;
        f32x4 xv[2][4]; int4 si[4]; f32x4 wv[4]; unsigned gv[2][4][4]; f32x4 gs[2][4];
#define PA_SX(r, q) do { if ((r) < 16) { _Pragma("unroll") for (int j = 0; j < 4; ++j) { if (l == 0) xv[(q) & 1][j] = *(const f32x4*)(xin + (size_t)(r) * D + 4 * lane + 256 * j); \
            else { const f32x2 t_ = *(const f32x2*)(xinb + (size_t)(r) * D + 4 * lane + 256 * j); xv[(q) & 1][j].x = t_.x; xv[(q) & 1][j].y = t_.y; } } } } while (0)
#define PA_S0(r, q) do { if ((r) < 16 && l > 0) { si[(q) & 3] = *(const int4*)(slotinfo + (size_t)(rowb + (r)) * 4); wv[(q) & 3] = *(const f32x4*)(wgt + (size_t)(rowb + (r)) * 4); } } while (0)
#define PA_S1(r, q) do { if ((r) < 16 && l > 0) { const int sl_[4] = {si[(q) & 3].x, si[(q) & 3].y, si[(q) & 3].z, si[(q) & 3].w}; \
            _Pragma("unroll") for (int kk = 0; kk < 4; ++kk) { const int e_ = sl_[kk] >> 24, li_ = sl_[kk] & 0xffffff; const size_t slot_ = (size_t)(mt.padstart[e_] + li_); const unsigned char* orow = outb + slot_ * D + 4 * lane; \
                gs[(q) & 1][kk] = *(const f32x4*)(outsc + slot_ * 16 + ((lane >> 3) & 3) * 4); \
                _Pragma("unroll") for (int j = 0; j < 4; ++j) gv[(q) & 1][kk][j] = *(const unsigned*)(orow + 256 * j); } } } while (0)
        PA_S0(0, 0); PA_S0(1, 1); PA_SX(0, 0); PA_S1(0, 0);
#pragma unroll 1
        for (int i0 = 0; i0 < 16; i0 += 4) {
#pragma unroll
          for (int ii = 0; ii < 4; ++ii) {
            const int i = i0 + ii; const int row = rowb + i;
            PA_S0(i + 2, ii + 2); PA_SX(i + 1, ii + 1); PA_S1(i + 1, ii + 1);
            f32x4 v[4];
#pragma unroll
            for (int j = 0; j < 4; ++j) { v[j] = xv[ii & 1][j];
                if (l > 0) { const unsigned p0 = __float_as_uint(v[j].x), p1 = __float_as_uint(v[j].y); v[j] = (f32x4){bflo(p0), bfhi(p0), bflo(p1), bfhi(p1)}; } }
            if (l > 0) {
                f32x4 y[4];
#pragma unroll
                for (int j = 0; j < 4; ++j) y[j] = (f32x4){0.f, 0.f, 0.f, 0.f};
#pragma unroll
                for (int kk = 0; kk < 4; ++kk) { const f32x4 ws4 = gs[ii & 1][kk] * wv[ii][kk];
#pragma unroll
                    for (int j = 0; j < 4; ++j) { const unsigned p = gv[ii & 1][kk][j];
                        y[j] += ws4[j] * ((f32x4){(float)(p & 0xffu), (float)((p >> 8) & 0xffu), (float)((p >> 16) & 0xffu), (float)(p >> 24)} - 128.0f); } }
                const float* g2 = mod + ((size_t)(l - 1) * NBATCH + b) * 6144 + 5 * D + 4 * lane;
#pragma unroll
                for (int j = 0; j < 4; ++j) v[j] += *(const f32x4*)(g2 + 256 * j) * y[j];
            }
            if (l < DEPTH) {
#pragma unroll
                for (int j = 0; j < 4; ++j) { u32x2 p; p.x = cvt_pk_bf16(v[j].x, v[j].y); p.y = cvt_pk_bf16(v[j].z, v[j].w); *(u32x2*)(xout + (size_t)row * D + 4 * lane + 256 * j) = p; }
            }
            float ss = 0.f;
#pragma unroll
            for (int j = 0; j < 4; ++j) ss += (v[j].x * v[j].x + v[j].y * v[j].y) + (v[j].z * v[j].z + v[j].w * v[j].w);
            const float rinv = 1.0f / sqrtf(wave_sum(ss, lane) * (1.0f / D) + NORM_EPS);
            if (l < DEPTH) {
                const float* ng = a.in[I_N1G] + (size_t)l * D + 4 * lane; const float* mb = mod + ((size_t)l * NBATCH + b) * 6144 + 4 * lane;
                f32x4 hq[4]; (void)hq;
#pragma unroll
                for (int j = 0; j < 4; ++j) { const f32x4 g = *(const f32x4*)(ng + 256 * j), sh = *(const f32x4*)(mb + 256 * j), sc = *(const f32x4*)(mb + D + 256 * j);
                    const f32x4 h = (v[j] * rinv * g) * (1.0f + sc) + sh;
#if Z_I8
                    hq[j] = h; }
                {   float am = 0.f;
#pragma unroll
                    for (int j = 0; j < 4; ++j) am = fmaxf(fmaxf(fmaxf(fabsf(hq[j].x), fabsf(hq[j].y)), fmaxf(fabsf(hq[j].z), fabsf(hq[j].w))), am);
#pragma unroll
                    for (int o = 1; o < 64; o <<= 1) am = fmaxf(am, shflx(am, o, lane));
                    am = fmaxf(am, 1e-20f); const float inv = 127.0f / am;
                    if (lane == 0) ((float*)(ws + WS_HSC))[row] = am * (1.0f / 127.0f);
#pragma unroll
                    for (int j = 0; j < 4; ++j) { const int q0 = (int)rintf(hq[j].x * inv), q1 = (int)rintf(hq[j].y * inv), q2 = (int)rintf(hq[j].z * inv), q3 = (int)rintf(hq[j].w * inv);
                        *(int*)(hb + (size_t)row * D + 4 * lane + 256 * j) = (q0 & 0xff) | ((q1 & 0xff) << 8) | ((q2 & 0xff) << 16) | ((q3 & 0xff) << 24); }
                }
#elif Z_FP8
                    int p = 0; p = __builtin_amdgcn_cvt_pk_fp8_f32(h.x, h.y, p, false); p = __builtin_amdgcn_cvt_pk_fp8_f32(h.z, h.w, p, true);
                    *(int*)(hb + (size_t)row * D + 4 * lane + 256 * j) = p; }
#else
                    u32x2 p; p.x = cvt_pk_bf16(h.x, h.y); p.y = cvt_pk_bf16(h.z, h.w); *(u32x2*)((bf16_t*)hb + (size_t)row * D + 4 * lane + 256 * j) = p; }
#endif
            } else {
                const float* fg = a.in[I_FINALG] + 4 * lane;
#pragma unroll
                for (int j = 0; j < 4; ++j) *(f32x4*)(a.out + (size_t)row * D + 4 * lane + 256 * j) = v[j] * rinv * *(const f32x4*)(fg + 256 * j);
            }
          }
        }
#undef PA_S0
#undef PA_SX
#undef PA_S1
    }
}

__device__ __forceinline__ void phase_h(const Args& a, int l, int cset, LAS unsigned char* lds, const int wv) {
    asm volatile("" : "+s"(lds));
    int tid_ = tid_of(wv); asm volatile("" : "+v"(tid_)); const int tid = tid_, lane = tid & 63, wave = __builtin_amdgcn_readfirstlane(tid >> 6);
    const int G = gridDim.x; unsigned char* ws = opaque_ptr(a.ws); const int bid = opaque_bid();
    const float* mod = (const float*)(ws + WS_MOD); const bf16_t* xres = (const bf16_t*)(ws + WS_XRES);
    unsigned char* h8 = (unsigned char*)(ws + WS_H);
    LAS float* rinvs = (LAS float*)lds;
    LAS float* lgt = (LAS float*)(lds + 1024);
    LAS int* hist = (LAS int*)(lds + 1024 + 8 * 16 * 33 * 4);
    LAS int* base = hist + 32;
    unsigned* ctl = (unsigned*)(ws + WS_CTL);
    const float* ng = a.in[I_N2G] + (size_t)l * D;
    const float* cbv = (const float*)(ws + WS_CB);
    int* tokof = (int*)(ws + WS_TOKOF); int* slotinfo = (int*)(ws + WS_SLOTINFO); float* wgt = (float*)(ws + WS_WGT);
    for (int chunk = bid; chunk < T / 128; chunk += G) {
        const int row0 = chunk * 128 + wave * 16; const int b = row0 / SEQ;
        const float* mb = mod + ((size_t)l * NBATCH + b) * 6144 + 3 * D;
        if (tid < 32) hist[tid] = 0;
        u32x2 xq[3][4];
#pragma unroll
        for (int r = 0; r < 2; ++r)
#pragma unroll
            for (int j = 0; j < 4; ++j) xq[r][j] = *(const u32x2*)(xres + (size_t)(row0 + r) * D + 4 * lane + 256 * j);
#pragma unroll
        for (int i = 0; i < 16; ++i) {
            const int row = row0 + i;
            if (i + 2 < 16) {
#pragma unroll
                for (int j = 0; j < 4; ++j) xq[(i + 2) % 3][j] = *(const u32x2*)(xres + (size_t)(row + 2) * D + 4 * lane + 256 * j); }
            f32x4 v[4]; float ss = 0.f;
#pragma unroll
            for (int j = 0; j < 4; ++j) { const u32x2 p = xq[i % 3][j]; v[j] = (f32x4){bflo(p.x), bfhi(p.x), bflo(p.y), bfhi(p.y)}; ss += (v[j].x * v[j].x + v[j].y * v[j].y) + (v[j].z * v[j].z + v[j].w * v[j].w); }
            const float rinv = 1.0f / sqrtf(wave_sum(ss, lane) * (1.0f / D) + NORM_EPS);
            if (lane == 0) rinvs[wave * 16 + i] = rinv;
#pragma unroll
            for (int j = 0; j < 4; ++j) { const f32x4 g = *(const f32x4*)(ng + 4 * lane + 256 * j), sh = *(const f32x4*)(mb + 4 * lane + 256 * j), sc = *(const f32x4*)(mb + D + 4 * lane + 256 * j);
                const f32x4 h = (v[j] * rinv * g) * (1.0f + sc) + sh;
                int p = 0; p = __builtin_amdgcn_cvt_pk_fp8_f32(h.x, h.y, p, false); p = __builtin_amdgcn_cvt_pk_fp8_f32(h.z, h.w, p, true);
                *(int*)(h8 + (size_t)row * D + 4 * lane + 256 * j) = p; }
        }
        {
            const int ri = lane & 15, q = lane >> 4;
            const bf16_t* xr = xres + (size_t)(row0 + ri) * D + 8 * q;
            const bf16_t* wh = (const bf16_t*)(ws + WS_WRS) + ((size_t)(l * 2 + 0) * NE + ri) * D + 8 * q; const bf16_t* wl = wh + (size_t)NE * D;
            f32x4 acc0 = {0.f, 0.f, 0.f, 0.f}, acc1 = {0.f, 0.f, 0.f, 0.f};
#pragma unroll 4
            for (int kb = 0; kb < 32; ++kb) {
                const int k0 = 32 * kb + 8 * q;
                const u32x4 xp = *(const u32x4*)(xr + 32 * kb); const f32x4 x0 = {bflo(xp.x), bfhi(xp.x), bflo(xp.y), bfhi(xp.y)}, x1 = {bflo(xp.z), bfhi(xp.z), bflo(xp.w), bfhi(xp.w)};
                const f32x4 g0 = *(const f32x4*)(ng + k0), g1 = *(const f32x4*)(ng + k0 + 4), s0 = *(const f32x4*)(mb + D + k0), s1 = *(const f32x4*)(mb + D + k0 + 4);
                const bf16x8 bh0 = *(const bf16x8*)(wh + 32 * kb), bl0 = *(const bf16x8*)(wl + 32 * kb), bh1 = *(const bf16x8*)(wh + 16 * D + 32 * kb), bl1 = *(const bf16x8*)(wl + 16 * D + 32 * kb);
                const f32x4 a0 = x0 * g0 * (1.0f + s0), a1 = x1 * g1 * (1.0f + s1);
                u32x4 hi, lo;
                hi.x = cvt_pk_bf16(a0.x, a0.y); hi.y = cvt_pk_bf16(a0.z, a0.w); hi.z = cvt_pk_bf16(a1.x, a1.y); hi.w = cvt_pk_bf16(a1.z, a1.w);
                lo.x = cvt_pk_bf16(a0.x - bflo(hi.x), a0.y - bfhi(hi.x)); lo.y = cvt_pk_bf16(a0.z - bflo(hi.y), a0.w - bfhi(hi.y));
                lo.z = cvt_pk_bf16(a1.x - bflo(hi.z), a1.y - bfhi(hi.z)); lo.w = cvt_pk_bf16(a1.z - bflo(hi.w), a1.w - bfhi(hi.w));
                const bf16x8 ah = __builtin_bit_cast(bf16x8, hi), al = __builtin_bit_cast(bf16x8, lo);
                acc0 = __builtin_amdgcn_mfma_f32_16x16x32_bf16(ah, bh0, acc0, 0, 0, 0); acc0 = __builtin_amdgcn_mfma_f32_16x16x32_bf16(ah, bl0, acc0, 0, 0, 0); acc0 = __builtin_amdgcn_mfma_f32_16x16x32_bf16(al, bh0, acc0, 0, 0, 0);
                acc1 = __builtin_amdgcn_mfma_f32_16x16x32_bf16(ah, bh1, acc1, 0, 0, 0); acc1 = __builtin_amdgcn_mfma_f32_16x16x32_bf16(ah, bl1, acc1, 0, 0, 0); acc1 = __builtin_amdgcn_mfma_f32_16x16x32_bf16(al, bh1, acc1, 0, 0, 0);
            }
            LDS_WAIT();
            const float c0 = cbv[(l * NBATCH + b) * NE + ri], c1 = cbv[(l * NBATCH + b) * NE + 16 + ri];
#pragma unroll
            for (int r = 0; r < 4; ++r) { const int ti = 4 * q + r; const float rv = rinvs[wave * 16 + ti];
                lgt[(wave * 16 + ti) * 33 + ri] = acc0[r] * rv + c0; lgt[(wave * 16 + ti) * 33 + 16 + ri] = acc1[r] * rv + c1; }
        }
        __syncthreads();
        int se[4] = {0, 0, 0, 0}; float sw[4] = {0.f, 0.f, 0.f, 0.f}; int rk[4] = {0, 0, 0, 0};
        if (lane < 16) {
            float v[32];
#pragma unroll
            for (int e = 0; e < 32; ++e) v[e] = lgt[(wave * 16 + lane) * 33 + e];
            float sv[4];
#pragma unroll
            for (int kk = 0; kk < 4; ++kk) { float best = v[0]; int bi = 0;
#pragma unroll
                for (int e = 1; e < 32; ++e) { if (v[e] > best) { best = v[e]; bi = e; } }
                sv[kk] = best; se[kk] = bi;
#pragma unroll
                for (int e = 0; e < 32; ++e) v[e] = (e == bi) ? -3.0e38f : v[e]; }
            float den = 0.f;
#pragma unroll
            for (int kk = 0; kk < 4; ++kk) { sw[kk] = __expf(sv[kk] - sv[0]); den += sw[kk]; }
            const float inv = 1.0f / den;
#pragma unroll
            for (int kk = 0; kk < 4; ++kk) { sw[kk] *= inv; rk[kk] = __hip_atomic_fetch_add(hist + se[kk], 1, __ATOMIC_RELAXED, __HIP_MEMORY_SCOPE_WORKGROUP); }
        }
        __syncthreads();
        if (tid < 32) base[tid] = (int)__hip_atomic_fetch_add(ctl + CW_CNT + (cset * NE + tid) * 16, (unsigned)hist[tid], __ATOMIC_RELAXED, __HIP_MEMORY_SCOPE_AGENT);
        __syncthreads();
        if (lane < 16) {
            const int row = row0 + lane; int si[4];
#pragma unroll
            for (int kk = 0; kk < 4; ++kk) { const int li = base[se[kk]] + rk[kk]; tokof[(size_t)se[kk] * T + li] = row; si[kk] = (se[kk] << 24) | li; }
            *(int4*)(slotinfo + (size_t)row * 4) = make_int4(si[0], si[1], si[2], si[3]);
            *(f32x4*)(wgt + (size_t)row * 4) = (f32x4){sw[0], sw[1], sw[2], sw[3]};
        }
        __syncthreads();
    }
}

constexpr int ZT_STRIDE = 528;
__device__ __forceinline__ void lru_unit(const Args& a, int l, int u, LAS unsigned char* lds, const int wv) {
    asm volatile("" : "+s"(lds));
    int tid_ = tid_of(wv); asm volatile("" : "+v"(tid_)); const int tid = tid_, lane = tid & 63, wave = __builtin_amdgcn_readfirstlane(tid >> 6);
    unsigned char* ws = opaque_ptr(a.ws);
    const bf16_t* z = (const bf16_t*)(ws + WS_Z);
    LAS unsigned char* zt = lds; LAS unsigned char* xc = lds + 131 * ZT_STRIDE;
    const int hp = u & 3, b = (u >> 2) & 7, s = u >> 5;
    const int t0 = b * SEQ + s * 128, p0 = s * 128;
    {   u32x4 sv[9];
#pragma unroll
        for (int k = 0; k < 9; ++k) { int idx = tid + NTHREADS * k; idx = idx < 131 * 32 ? idx : 131 * 32 - 1; const int r = idx >> 5, o = idx & 31; const int p = p0 - 3 + r; const int pc = p < 0 ? 0 : p;
            sv[k] = *(const u32x4*)(z + (size_t)(b * SEQ + pc) * NZ + hp * 256 + o * 8); if (p < 0) sv[k] = (u32x4){0u, 0u, 0u, 0u}; }
#pragma unroll
        for (int k = 0; k < 9; ++k) { int idx = tid + NTHREADS * k; idx = idx < 131 * 32 ? idx : 131 * 32 - 1; const int r = idx >> 5, o = idx & 31;
            *(LAS u32x4*)(zt + r * ZT_STRIDE + o * 16) = sv[k]; }
    }
    __syncthreads();
    {
        const int o = tid & 31, rb = tid >> 5; const int ch0 = hp * 256 + o * 8;
        float cw[4][8], cbias[8];
#pragma unroll
        for (int k = 0; k < 4; ++k) { const f32x4 w0 = *(const f32x4*)(a.in[I_CONVW] + ((size_t)l * 4 + k) * D + ch0), w1 = *(const f32x4*)(a.in[I_CONVW] + ((size_t)l * 4 + k) * D + ch0 + 4);
            cw[k][0] = w0.x; cw[k][1] = w0.y; cw[k][2] = w0.z; cw[k][3] = w0.w; cw[k][4] = w1.x; cw[k][5] = w1.y; cw[k][6] = w1.z; cw[k][7] = w1.w; }
        { const f32x4 b0 = *(const f32x4*)(a.in[I_CONVB] + (size_t)l * D + ch0), b1 = *(const f32x4*)(a.in[I_CONVB] + (size_t)l * D + ch0 + 4);
          cbias[0] = b0.x; cbias[1] = b0.y; cbias[2] = b0.z; cbias[3] = b0.w; cbias[4] = b1.x; cbias[5] = b1.y; cbias[6] = b1.z; cbias[7] = b1.w; }
#pragma unroll 2
        for (int i = 0; i < 8; ++i) { const int r = rb + 16 * i; float acc[8];
#pragma unroll
            for (int j = 0; j < 8; ++j) acc[j] = cbias[j];
#pragma unroll
            for (int k = 0; k < 4; ++k) { const u32x4 v = *(const LAS u32x4*)(zt + (r + k) * ZT_STRIDE + o * 16);
                acc[0] += cw[k][0] * bflo(v.x); acc[1] += cw[k][1] * bfhi(v.x); acc[2] += cw[k][2] * bflo(v.y); acc[3] += cw[k][3] * bfhi(v.y);
                acc[4] += cw[k][4] * bflo(v.z); acc[5] += cw[k][5] * bfhi(v.z); acc[6] += cw[k][6] * bflo(v.w); acc[7] += cw[k][7] * bfhi(v.w); }
            u32x4 w; w.x = cvt_pk_bf16(acc[0], acc[1]); w.y = cvt_pk_bf16(acc[2], acc[3]); w.z = cvt_pk_bf16(acc[4], acc[5]); w.w = cvt_pk_bf16(acc[6], acc[7]);
            *(LAS u32x4*)(xc + r * ZT_STRIDE + o * 16) = w; }
    }
    __syncthreads();
    {
        const int hsel = wave >> 2, wc = wave & 3, head = 2 * hp + hsel, c31 = lane & 31, hh = lane >> 5;
        const int ch = head * 128 + 32 * wc + c31;
        const bf16_t* wb = (const bf16_t*)(ws + WS_WRG) + ((size_t)(l * 8 + head) * 256 + 32 * wc + c31) * 128 + 8 * hh;
        bf16x8 Ba[8], Bi[8];
#pragma unroll
        for (int ks = 0; ks < 8; ++ks) { Ba[ks] = *(const bf16x8*)(wb + 16 * ks); Bi[ks] = *(const bf16x8*)(wb + 128 * 128 + 16 * ks); }
        const float ba = a.in[I_BRGA][(size_t)l * D + ch], bx = a.in[I_BRGX][(size_t)l * D + ch];
        const float lam = a.in[I_LAM][(size_t)l * D + ch];
        const float sp8 = 8.0f * log1pf(__expf(-lam));
        typedef __attribute__((address_space(1))) unsigned long long gu64;
        gu64* aggq = (gu64*)(ws + WS_AGG) + ((size_t)l * NBATCH * 32 + (size_t)b * 32) * D + ch;
        float Pr = 1.f, Hr = 0.f;
        unsigned hpk[64];
#pragma unroll
        for (int rb = 0; rb < 4; ++rb) {
            f32x16 aa, ai;
#pragma unroll
            for (int r = 0; r < 16; ++r) { aa[r] = 0.f; ai[r] = 0.f; }
            const LAS unsigned char* ap = xc + (32 * rb + c31) * ZT_STRIDE + (hsel * 128 + 8 * hh) * 2;
#pragma unroll
            for (int ks = 0; ks < 8; ++ks) { const bf16x8 A = *(const LAS bf16x8*)(ap + 32 * ks);
                aa = __builtin_amdgcn_mfma_f32_32x32x16_bf16(A, Ba[ks], aa, 0, 0, 0); ai = __builtin_amdgcn_mfma_f32_32x32x16_bf16(A, Bi[ks], ai, 0, 0, 0); }
            const LAS unsigned char* xp = xc + (32 * rb + 4 * hh) * ZT_STRIDE + (hsel * 128 + 32 * wc + c31) * 2;
#pragma unroll
            for (int q = 0; q < 4; ++q) {
                float p = 1.f, h = 0.f, hl[4], pl[4];
#pragma unroll
                for (int r3 = 0; r3 < 4; ++r3) { const int reg = 4 * q + r3;
                    const float xcv = bf1(*(const LAS bf16_t*)(xp + (8 * q + r3) * ZT_STRIDE));
                    const float rg = sigmoidf_(aa[reg] + ba), ig = sigmoidf_(ai[reg] + bx);
                    const float av = __expf(-sp8 * rg); const float mult = sqrtf(fmaxf(1.0f - av * av, 0.f));
                    h = av * h + mult * (ig * xcv); p *= av; hl[r3] = h; pl[r3] = p; }
                const float Ao = shflx(p, 32, lane), Bo = shflx(h, 32, lane);
                const float A0 = hh ? Ao : p, B0 = hh ? Bo : h, A1 = hh ? p : Ao, B1 = hh ? h : Bo;
                const float P1 = Pr * A0, H1 = Hr * A0 + B0;
                const float Pst = hh ? P1 : Pr, Hst = hh ? H1 : Hr;
                Pr = P1 * A1; Hr = H1 * A1 + B1;
#pragma unroll
                for (int r3 = 0; r3 < 4; ++r3) hpk[rb * 16 + 4 * q + r3] = cvt_pk_bf16(Hst * pl[r3] + hl[r3], Pst * pl[r3]);
            }
        }
        if (hh == 0) __hip_atomic_store(aggq + (size_t)s * D, ((unsigned long long)__float_as_uint(Hr) << 32) | (unsigned long long)__float_as_uint(fmaxf(Pr, 1e-37f)), __ATOMIC_RELAXED, __HIP_MEMORY_SCOPE_AGENT);
        const bf16_t* zg = z + (size_t)t0 * NZ + ZO_GLRU + ch;
        bf16_t* yo = (bf16_t*)(ws + WS_ACAT) + (size_t)t0 * KCAT + 512 + ch;
        bf16_t gcur[16], gnxt[16];
#pragma unroll
        for (int reg = 0; reg < 16; ++reg) gcur[reg] = zg[(size_t)(8 * (reg >> 2) + 4 * hh + (reg & 3)) * NZ];
        float cin = 0.f;
        for (int j0 = 0; j0 < s; j0 += 8) {
            unsigned long long w[8]; unsigned spins = 0;
            for (;;) { bool ok = true;
#pragma unroll
                for (int k = 0; k < 8; ++k) { const int j = (j0 + k < s) ? (j0 + k) : (s - 1); w[k] = __hip_atomic_load(aggq + (size_t)j * D, __ATOMIC_RELAXED, __HIP_MEMORY_SCOPE_AGENT); ok = ok && ((unsigned)w[k] != 0u); }
                if (__all(ok)) break;
                __builtin_amdgcn_s_sleep(4);
                if (++spins > (1u << 17)) break;
            }
#pragma unroll
            for (int k = 0; k < 8; ++k) { if (j0 + k < s) cin = __uint_as_float((unsigned)w[k]) * cin + __uint_as_float((unsigned)(w[k] >> 32)); }
        }
#pragma unroll
        for (int rb = 0; rb < 4; ++rb) {
            if (rb < 3) {
#pragma unroll
                for (int reg = 0; reg < 16; ++reg) gnxt[reg] = zg[(size_t)(32 * (rb + 1) + 8 * (reg >> 2) + 4 * hh + (reg & 3)) * NZ]; }
#pragma unroll
            for (int reg = 0; reg < 16; ++reg) { const int tok = 32 * rb + 8 * (reg >> 2) + 4 * hh + (reg & 3);
                const unsigned pk = hpk[rb * 16 + reg];
                const float hf = bflo(pk) + bfhi(pk) * cin;
                const float g = bf1(gcur[reg]);
                const float ge = g * __builtin_amdgcn_rcpf(1.0f + __expf(-1.5957691216f * (g + 0.044715f * g * g * g)));
                yo[(size_t)tok * KCAT] = (bf16_t)(cvt_pk_bf16(hf * ge, 0.f) & 0xffffu); }
#pragma unroll
            for (int reg = 0; reg < 16; ++reg) gcur[reg] = gnxt[reg];
        }
    }
    __syncthreads();
}
__device__ __forceinline__ void pool_unit(const Args& a, int l, int u, LAS unsigned char* lds, const int wv) {
    asm volatile("" : "+s"(lds));
    int tid_ = tid_of(wv); asm volatile("" : "+v"(tid_)); const int tid = tid_, lane = tid & 63, wave = __builtin_amdgcn_readfirstlane(tid >> 6);
    unsigned char* ws = opaque_ptr(a.ws);
    const bf16_t* z = (const bf16_t*)(ws + WS_Z);
    LAS unsigned char* zt = lds; LAS unsigned char* pt = lds + 143 * ZT_STRIDE;
    const int gp = u & 1, b = (u >> 1) & 7, s = u >> 4;
    const int t0 = b * SEQ + s * 128, p0 = s * 128;
    {   u32x4 sv[9];
#pragma unroll
        for (int k = 0; k < 9; ++k) { int idx = tid + NTHREADS * k; idx = idx < 143 * 32 ? idx : 143 * 32 - 1; const int r = idx >> 5, o = idx & 31; const int p = p0 - 15 + r; const int pc = p < 0 ? 0 : p;
            sv[k] = *(const u32x4*)(z + (size_t)(b * SEQ + pc) * NZ + ZO_XPOOL + gp * 256 + o * 8); if (p < 0) sv[k] = (u32x4){0u, 0u, 0u, 0u}; }
#pragma unroll
        for (int k = 0; k < 9; ++k) { int idx = tid + NTHREADS * k; idx = idx < 143 * 32 ? idx : 143 * 32 - 1; const int r = idx >> 5, o = idx & 31;
            *(LAS u32x4*)(zt + r * ZT_STRIDE + o * 16) = sv[k]; }
    }
    __syncthreads();
    {
        const int o = tid & 31, rb = tid >> 5; const int g = 2 * gp + (o >> 4); const int w = 2 << g;
#pragma unroll 1
        for (int i = 0; i < 8; ++i) { const int r = rb + 16 * i; float acc[8];
#pragma unroll
            for (int j = 0; j < 8; ++j) acc[j] = 0.f;
            for (int jj = 0; jj < w; ++jj) { const u32x4 v = *(const LAS u32x4*)(zt + (r + 15 - jj) * ZT_STRIDE + o * 16);
                acc[0] += bflo(v.x); acc[1] += bfhi(v.x); acc[2] += bflo(v.y); acc[3] += bfhi(v.y); acc[4] += bflo(v.z); acc[5] += bfhi(v.z); acc[6] += bflo(v.w); acc[7] += bfhi(v.w); }
            const int cnt = (p0 + r + 1 < w) ? (p0 + r + 1) : w; const float ic = 1.0f / (float)cnt;
            const u32x4 v = *(const LAS u32x4*)(zt + (r + 15) * ZT_STRIDE + o * 16);
            const float x0[8] = {bflo(v.x), bfhi(v.x), bflo(v.y), bfhi(v.y), bflo(v.z), bfhi(v.z), bflo(v.w), bfhi(v.w)};
#pragma unroll
            for (int j = 0; j < 8; ++j) acc[j] = acc[j] * ic - x0[j];
            u32x4 wv; wv.x = cvt_pk_bf16(acc[0], acc[1]); wv.y = cvt_pk_bf16(acc[2], acc[3]); wv.z = cvt_pk_bf16(acc[4], acc[5]); wv.w = cvt_pk_bf16(acc[6], acc[7]);
            *(LAS u32x4*)(pt + r * ZT_STRIDE + o * 16) = wv; }
    }
    __syncthreads();
    {
        const int gsel = wave >> 2, wc = wave & 3, g = 2 * gp + gsel, c31 = lane & 31, hh = lane >> 5;
        const int oc = g * 128 + 32 * wc + c31;
        const bf16_t* wb = (const bf16_t*)(ws + WS_WPOOL) + ((size_t)(l * 4 + g) * 128 + 32 * wc + c31) * 128 + 8 * hh;
        bf16x8 Bf[8];
#pragma unroll
        for (int ks = 0; ks < 8; ++ks) Bf[ks] = *(const bf16x8*)(wb + 16 * ks);
        const float psc = a.in[I_PSCALE][(size_t)l * 512 + oc];
        bf16_t* yo = (bf16_t*)(ws + WS_ACAT) + (size_t)t0 * KCAT + oc;
#pragma unroll 1
        for (int rb = 0; rb < 4; ++rb) {
            f32x16 acc;
#pragma unroll
            for (int r = 0; r < 16; ++r) acc[r] = 0.f;
            const LAS unsigned char* ap = pt + (32 * rb + c31) * ZT_STRIDE + (gsel * 128 + 8 * hh) * 2;
#pragma unroll
            for (int ks = 0; ks < 8; ++ks) { const bf16x8 A = *(const LAS bf16x8*)(ap + 32 * ks); acc = __builtin_amdgcn_mfma_f32_32x32x16_bf16(A, Bf[ks], acc, 0, 0, 0); }
#pragma unroll
            for (int reg = 0; reg < 16; ++reg) { const int tok = 32 * rb + 8 * (reg >> 2) + 4 * hh + (reg & 3);
                yo[(size_t)tok * KCAT] = (bf16_t)(cvt_pk_bf16(acc[reg] * psc, 0.f) & 0xffffu); }
        }
    }
    __syncthreads();
}

constexpr int PH_PER_LAYER = 9;
constexpr int N_PHASES = 1 + DEPTH * PH_PER_LAYER + 1;

__global__ void __launch_bounds__(NTHREADS, 2) fwd_kernel(Args a) {
    extern __shared__ __attribute__((aligned(16))) unsigned char lds_raw[];
    LAS unsigned char* lds = (LAS unsigned char*)lds_raw;
    const int wv = __builtin_amdgcn_readfirstlane(threadIdx.x >> 6); const int tid = threadIdx.x; const int G = gridDim.x;
    unsigned char* ws0 = a.ws;
    unsigned* ctl = (unsigned*)(ws0 + WS_CTL);
    volatile LAS unsigned* misc = (volatile LAS unsigned*)(lds + LDS_MISC);
    if (tid < 4) misc[tid] = 0u;
    __syncthreads();
    XcdBarrier bar; bar.bar = ctl + CW_BAR; bar.x = 0; bar.st = misc; bar.wv = wv;
#if MK_PER_PHASE
    const int lo = a.ph_lo, hi = a.ph_hi;
#else
    constexpr int lo = 0, hi = N_PHASES;
#endif
    if (hi - lo > 1) bar = xcd_barrier_post(ctl + CW_BAR, misc, wv);
#define IN(k) (lo <= (k) && (k) < hi)
#define SEAM(k) do { if (IN((k) + 1)) xcd_barrier(bar); } while (0)

    if (EN(0) && IN(0)) for (int rr = 0; rr < REPN(0); ++rr) { phase_prologue(a, lds, wv); SEAM(0); }

    for (int l = 0; l < DEPTH; ++l) {
        const int pb = 1 + l * PH_PER_LAYER;
        if (EN(1) && IN(pb + 0)) for (int rr = 0; rr < REPN(1); ++rr) { unsigned char* ws = opaque_ptr(ws0); const int bid = opaque_bid(); (void)bid; (void)ws; phase_a(a, l, lds, rr + 1 < REPN(1), wv); SEAM(pb + 0); }
        if (EN(2) && IN(pb + 1)) for (int rr = 0; rr < REPN(2); ++rr) { unsigned char* ws = opaque_ptr(ws0); const int bid = opaque_bid(); (void)bid; (void)ws;
            #if Z_I8
            pg8::PlainSched S{(const char*)(ws + WS_H), (const char*)(ws + WS_WIN) + (size_t)l * NZ * 1024, 512, T / 256, NZ / 256, G, bid};
            pg8::EpiZI8 E{(bf16_t*)(ws + WS_Z), (const float*)(ws + WS_HSC), (const float*)(ws + WS_WINSC) + (size_t)l * NZ};
            pg8::gemm_phase<pg8::EpiZI8, pg8::PlainSched, true, 2>(lds, 512, S, E, wv);
#elif Z_FP8
            pg8::PlainSched S{(const char*)(ws + WS_H), (const char*)(ws + WS_WIN) + (size_t)l * NZ * 1024, 512, T / 256, NZ / 256, G, bid};
            pg8::EpiBf16 E{(bf16_t*)(ws + WS_Z), NZ, nullptr, (rr + 1 < REPN(2)) && (a.ph_lo == 0), 1.0f / WEIN_SCALE};
            pg8::gemm_phase<pg8::EpiBf16, pg8::PlainSched, true, 1>(lds, 512, S, E, wv);
#else
            pg8::PlainSched S{(const char*)(ws + WS_H), (const char*)(ws + WS_WIN) + (size_t)l * NZ * 1024 * 2, 1024, T / 256, NZ / 256, G, bid};
            pg8::EpiBf16 E{(bf16_t*)(ws + WS_Z), NZ, nullptr, (rr + 1 < REPN(2)) && (a.ph_lo == 0), 1.0f};
            pg8::gemm_phase<pg8::EpiBf16, pg8::PlainSched, true>(lds, 1024, S, E, wv);
#endif
            SEAM(pb + 1);
        }
        if (EN(3) && IN(pb + 2)) for (int rr = 0; rr < REPN(3); ++rr) { unsigned char* ws = opaque_ptr(ws0); const int bid = opaque_bid(); (void)bid; (void)ws;
            for (int u = bid; u < 1024 + 512; u += G) { if (u < 1024) lru_unit(a, l, u, lds, wv); else pool_unit(a, l, u - 1024, lds, wv); }
            SEAM(pb + 2);
        }
        if (EN(5) && IN(pb + 4)) for (int rr = 0; rr < REPN(5); ++rr) { unsigned char* ws = opaque_ptr(ws0); const int bid = opaque_bid(); (void)bid; (void)ws;
            pg8::PlainSched S{(const char*)(ws + WS_ACAT), (const char*)(ws + WS_WCAT) + (size_t)l * 1024 * KCAT * 2, KCAT, T / 256, D / 256, G, bid};
            pg8::EpiMerged E{(bf16_t*)(ws + WS_MERGED), (const bf16_t*)(ws + WS_Z)};
            pg8::gemm_phase<pg8::EpiMerged, pg8::PlainSched, true>(lds, KCAT, S, E, wv);
            SEAM(pb + 4);
        }
        if (EN(6) && IN(pb + 5)) for (int rr = 0; rr < REPN(6); ++rr) { unsigned char* ws = opaque_ptr(ws0); const int bid = opaque_bid(); (void)bid; (void)ws;
            pg8::PlainSched S{(const char*)(ws + WS_MERGED), (const char*)(ws + WS_WOUT) + (size_t)l * 1024 * 1024 * 2, 1024, T / 256, D / 256, G, bid};
            pg8::EpiResid E{(bf16_t*)(ws + WS_XRES), (rr + 1 < REPN(6)) ? (bf16_t*)(ws + WS_ACT) : (bf16_t*)(ws + WS_XRES), (const float*)(ws + WS_MOD) + (size_t)l * NBATCH * 6144 + 2 * D};
            pg8::gemm_phase<pg8::EpiResid, pg8::PlainSched, true>(lds, 1024, S, E, wv);
            SEAM(pb + 5);
        }
        if (EN(7) && IN(pb + 6)) for (int rr = 0; rr < REPN(7); ++rr) { unsigned char* ws = opaque_ptr(ws0); const int bid = opaque_bid(); (void)bid; (void)ws; if (l > 0 && rr == 0) conv_drain(a, l, -1, lds, wv); phase_h(a, l, l + DEPTH * rr, lds, wv); SEAM(pb + 6); }
        if (EN(8) && IN(pb + 7)) for (int rr = 0; rr < REPN(8); ++rr) { unsigned char* ws = opaque_ptr(ws0); const int bid = opaque_bid(); (void)bid; (void)ws;
            moe_tables(a, l + DEPTH * (REPN(7) - 1), lds, wv);
            LAS unsigned char* lds_o = lds; asm volatile("" : "+s"(lds_o)); const MoeTab mt = moe_tab_ptrs(lds_o);
            MoeSched1 S{(const char*)(ws + WS_H), (const char*)(ws + WS_WEIN) + (size_t)l * NE * 2048 * 1024, (const int*)(ws + WS_TOKOF), mt, __builtin_amdgcn_readfirstlane(mt.tilestart[NE]), G, bid};
            pg8::EpiSwiglu E{(unsigned char*)(ws + WS_ACT), a.in[I_BEIN] + (size_t)l * NE * 2048, 1.0f / WEIN_SCALE};
            pg8::gemm_phase<pg8::EpiSwiglu, MoeSched1, true, 1>(lds, 512, S, E, wv);
            if (l + 1 < DEPTH) {
                const int nwg = S.nMt * 8, maxr = (nwg + G - 1) / G, myr = (nwg - bid + G - 1) / G;
                if (myr < maxr) conv_drain(a, l + 1, CONV_Q1, lds, wv);
            }
            SEAM(pb + 7);
        }
        if (EN(9) && IN(pb + 8)) for (int rr = 0; rr < REPN(9); ++rr) { unsigned char* ws = opaque_ptr(ws0); const int bid = opaque_bid(); (void)bid; (void)ws;
            moe_tables(a, l + DEPTH * (REPN(7) - 1), lds, wv);
            LAS unsigned char* lds_o = lds; asm volatile("" : "+s"(lds_o)); const MoeTab mt = moe_tab_ptrs(lds_o);
            MoeSched2 S{(const char*)(ws + WS_ACT), (const char*)(ws + WS_WEOUT) + (size_t)l * NE * 1024 * 1024, mt, __builtin_amdgcn_readfirstlane(mt.tilestart[NE]), G, bid};
            pg8::EpiMoeOut E{(unsigned char*)(ws + WS_OUTB), (float*)(ws + WS_OUTSC), a.in[I_BEOUT] + (size_t)l * NE * D, 1.0f / WEIN_SCALE};
            pg8::gemm_phase<pg8::EpiMoeOut, MoeSched2, true, 1>(lds, 512, S, E, wv);
            if (l + 1 < DEPTH) {
                const int nwg = S.nMt * 4, maxr = (nwg + G - 1) / G, myr = (nwg - bid + G - 1) / G;
                if (myr < maxr) conv_drain(a, l + 1, CONV_Q2, lds, wv);
            }
            SEAM(pb + 8);
        }
    }
    if (EN(10) && IN(N_PHASES - 1)) phase_a(a, DEPTH, lds, false, wv);
#undef IN
#undef SEAM
}

extern "C" void kernel_launch(void* const* d_in, const int* in_sizes, int n_in, void* d_out, int out_size, void* d_ws, size_t ws_size, hipStream_t stream) {
    static int grid = 0;
    if (grid == 0) {
        if (n_in != 26 || out_size != T * D || ws_size < WS_END) { fprintf(stderr, "kernel_launch: unexpected problem (n_in %d out %d ws %zu)\n", n_in, out_size, ws_size); grid = -1; return; }
        int dev = 0, cus = 0, per_cu = 0;
        if (hipGetDevice(&dev) != hipSuccess || hipDeviceGetAttribute(&cus, hipDeviceAttributeMultiprocessorCount, dev) != hipSuccess) { grid = -1; return; }
        if (hipFuncSetAttribute((const void*)fwd_kernel, hipFuncAttributeMaxDynamicSharedMemorySize, LDS_BYTES) != hipSuccess) { fprintf(stderr, "kernel_launch: hipFuncSetAttribute failed\n"); grid = -1; return; }
        if (hipOccupancyMaxActiveBlocksPerMultiprocessor(&per_cu, (const void*)fwd_kernel, NTHREADS, LDS_BYTES) != hipSuccess || per_cu < 1) fprintf(stderr, "kernel_launch: occupancy query says %d\n", per_cu);
        (void)hipGetLastError();
        grid = cus;
    }
    if (grid < 0) return;
    if (hipMemsetAsync((char*)d_ws + WS_CTL, 0, CTL_ZERO_BYTES, stream) != hipSuccess) return;
    if (hipMemsetAsync((char*)d_ws + WS_AGG, 0, AGG_BYTES, stream) != hipSuccess) return;
    Args a{};
    for (int i = 0; i < 26; ++i) a.in[i] = (const float*)d_in[i];
    a.out = (float*)d_out; a.ws = (unsigned char*)d_ws;
#if MK_PER_PHASE
    for (int p = 0; p < N_PHASES; ++p) { a.ph_lo = p; a.ph_hi = p + 1; hipLaunchKernelGGL(fwd_kernel, dim3(grid), dim3(NTHREADS), LDS_BYTES, stream, a); }
#else
    a.ph_lo = 0; a.ph_hi = N_PHASES;
    hipLaunchKernelGGL(fwd_kernel, dim3(grid), dim3(NTHREADS), LDS_BYTES, stream, a);
#endif
    const hipError_t le = hipPeekAtLastError();
    if (le != hipSuccess) fprintf(stderr, "kernel_launch: launch failed: %s\n", hipGetErrorName(le));
}
```

```cpp
#include <hip/hip_runtime.h>
#include <cstdio>
#include <cstdint>

#define REP_MASK 0x0
#ifndef PH_MASK
#define PH_MASK 0x7ff
#endif
#define EN(b) ((PH_MASK >> (b)) & 1)
#ifndef REP_MASK
#define REP_MASK 0
#endif
#define REPN(b) ((((REP_MASK) >> (b)) & 1) ? 2 : 1)
#ifndef Z_I8
#define Z_I8 1
#endif
#ifndef Z_FP8
#define Z_FP8 0
#endif
#ifndef MK_PER_PHASE
#define MK_PER_PHASE 0
#endif

#define LAS __attribute__((address_space(3)))
typedef unsigned short bf16_t;
typedef short bf16x8 __attribute__((ext_vector_type(8)));
typedef float f32x4 __attribute__((ext_vector_type(4)));
typedef float f32x2 __attribute__((ext_vector_type(2)));
typedef float f32x16 __attribute__((ext_vector_type(16)));
typedef unsigned u32x4 __attribute__((ext_vector_type(4)));
typedef unsigned u32x2 __attribute__((ext_vector_type(2)));

constexpr int D = 1024, NBATCH = 8, SEQ = 4096, T = NBATCH * SEQ, DEPTH = 4;
constexpr int NZ = 4608, ZO_GLRU = 1024, ZO_XPOOL = 2048, ZO_GL0 = 2560, ZO_GL1 = 3584;
constexpr int NE = 32, TOPK = 4;
constexpr int KCAT = 1536;
constexpr int SLOT_CAP = T * TOPK + NE * 256;
constexpr int MAX_MT = SLOT_CAP / 256;
constexpr float NORM_EPS = 1e-6f;
constexpr float WEIN_SCALE = 64.0f;
constexpr int NTHREADS = 512, NWAVES = 8;

constexpr size_t MiB = 1u << 20;
constexpr size_t WS_CTL = 0, CTL_ZERO_BYTES = 256 * 1024;
constexpr size_t WS_MOD = 1 * MiB;
constexpr size_t WS_CB = 2 * MiB;
constexpr size_t WS_AGG = 72 * MiB;
constexpr size_t AGG_BYTES = (size_t)DEPTH * NBATCH * 32 * D * 8;
constexpr size_t WS_WRS = 3 * MiB;
constexpr size_t WS_HSC = 4 * MiB;
constexpr size_t WS_WINSC = 5 * MiB;
constexpr size_t WS_TOKOF = 6 * MiB;
constexpr size_t WS_SLOTINFO = 10 * MiB;
constexpr size_t WS_WGT = 11 * MiB;
constexpr size_t WS_WRG = 12 * MiB;
constexpr size_t WS_WPOOL = 14 * MiB;
constexpr size_t WS_WIN = 16 * MiB;
constexpr size_t WS_WCAT = 52 * MiB;
constexpr size_t WS_WOUT = 64 * MiB;
constexpr size_t WS_WEIN = 128 * MiB;
constexpr size_t WS_WEOUT = 640 * MiB;
constexpr size_t WS_XRES = 896 * MiB;
constexpr size_t WS_H = 1024 * MiB;
constexpr size_t WS_Z = 1088 * MiB;
constexpr size_t WS_ACAT = 1376 * MiB;
constexpr size_t WS_MERGED = 1472 * MiB;
constexpr size_t WS_ACT = 1536 * MiB;
constexpr size_t WS_OUTB = 1808 * MiB;
constexpr size_t WS_OUTSC = WS_OUTB + 144 * MiB;
constexpr size_t WS_ZG = 2080 * MiB;
constexpr size_t WS_END = 2144 * MiB;
static_assert(WS_ACT + (size_t)SLOT_CAP * 1024 * 2 <= WS_OUTB && WS_OUTB + (size_t)SLOT_CAP * 1024 * 2 <= WS_END, "ws map");
constexpr int CW_BAR = 4096;
constexpr int CW_CONVQ = 7680;
constexpr int CW_CNT = 8192;

constexpr int LDS_BYTES = 163840;
constexpr int LDS_TAB = 131072;
constexpr int LDS_NVA = 131072 + 8192;
constexpr int LDS_MISC = LDS_BYTES - 256;

__device__ __forceinline__ unsigned cvt_pk_bf16(float lo, float hi) { unsigned r; asm("v_cvt_pk_bf16_f32 %0, %1, %2" : "=v"(r) : "v"(lo), "v"(hi)); return r; }
__device__ __forceinline__ float bflo(unsigned w) { return __uint_as_float(w << 16); }
__device__ __forceinline__ float bfhi(unsigned w) { return __uint_as_float(w & 0xffff0000u); }
__device__ __forceinline__ float bf1(bf16_t w) { return __uint_as_float(((unsigned)w) << 16); }
__device__ __forceinline__ float sigmoidf_(float x) { return __builtin_amdgcn_rcpf(1.0f + __expf(-x)); }
__device__ __forceinline__ float shflx(float v, int mask, int lane) { return __int_as_float(__builtin_amdgcn_ds_bpermute((lane ^ mask) << 2, __float_as_int(v))); }
__device__ __forceinline__ float wave_sum(float v, int lane) {
#pragma unroll
    for (int o = 1; o < 64; o <<= 1) v += shflx(v, o, lane);
    return v;
}
__device__ __forceinline__ int tid_of(int wv) { int l; asm volatile("v_mbcnt_lo_u32_b32 %0, -1, 0\n\tv_mbcnt_hi_u32_b32 %0, -1, %0" : "=v"(l)); return wv * 64 + l; }
__device__ __forceinline__ int opaque_bid() { int b = blockIdx.x; asm volatile("" : "+s"(b)); return b; }
__device__ __forceinline__ unsigned char* opaque_ptr(unsigned char* p) { size_t z = 0; asm volatile("" : "+s"(z)); return p + z; }
#define LDS_WAIT() asm volatile("s_waitcnt lgkmcnt(0)" ::: "memory")
#define VM_WAIT() asm volatile("s_waitcnt vmcnt(0)" ::: "memory")

namespace pg8 {
constexpr int BM = 256, BK = 64, HALF = 128, HTB = HALF * BK * 2, STAGE_BYTES = 8 * HTB, NXCD = 8, WGM = 8;
__host__ __device__ __forceinline__ int lds_byte(int r, int c) { const int st = (r >> 4) * 2 + (c >> 5), rr = r & 15, cc = c & 31, ob = rr * 64 + cc * 2; return st * 1024 + (ob ^ (((ob >> 9) & 1) << 5)); }
__host__ __device__ __forceinline__ void stage_rc(int b, int& R, int& C) { const int st = b / 1024, sb = b % 1024, swz = sb ^ (((sb >> 9) & 1) << 5); R = (st >> 1) * 16 + swz / 64; C = (st & 1) * 32 + (swz % 64) / 2; }
__host__ __device__ __forceinline__ int perm32(int rho) { const int n = rho >> 4, i = rho & 15; return 8 * (i >> 2) + 4 * n + (i & 3); }

struct Unit { int pm, pn, e, j, row0, rows; };
typedef int v8i32 __attribute__((ext_vector_type(8)));
typedef int v4i32_t __attribute__((ext_vector_type(4)));
__device__ __forceinline__ v8i32 cat8(bf16x8 lo, bf16x8 hi) { typedef int v4i32 __attribute__((ext_vector_type(4))); const v4i32 a = __builtin_bit_cast(v4i32, lo), b = __builtin_bit_cast(v4i32, hi); return (v8i32){a.x, a.y, a.z, a.w, b.x, b.y, b.z, b.w}; }

__device__ __forceinline__ bool order_map(int i, int G, int c, int nM, int nN, int& pm, int& pn) {
    const int nwg = nM * nN; const int L = i * G + c; if (L >= nwg) return false;
    int wgid = L; { const int q = nwg / NXCD, r = nwg % NXCD, xcd = wgid % NXCD, off = wgid / NXCD; wgid = (xcd < r ? xcd * (q + 1) : r * (q + 1) + (xcd - r) * q) + off; }
    const int nig = WGM * nN, gid = wgid / nig, fm = gid * WGM, gsz = (nM - fm) < WGM ? (nM - fm) : WGM;
    pm = fm + ((wgid % nig) % gsz); pn = (wgid % nig) / gsz; return true;
}

struct PlainSched {
    static constexpr bool DYN_A = false;
    const char* A; const char* Bt; int K, nM, nN, G, c;
    __device__ __forceinline__ bool next(int i, Unit& u) const { int pm, pn; if (!order_map(i, G, c, nM, nN, pm, pn)) return false; u.pm = pm; u.pn = pn; u.e = 0; u.j = 0; u.row0 = pm * BM; u.rows = BM; return true; }
    __device__ __forceinline__ const char* a_ptr() const { return A; }
    __device__ __forceinline__ const char* b_ptr() const { return Bt; }
    __device__ __forceinline__ unsigned a_off(const Unit& u) const { return (unsigned)u.row0 * (unsigned)K * 2u; }
    __device__ __forceinline__ unsigned b_off(const Unit& u) const { return (unsigned)u.pn * (unsigned)(BM * K * 2); }
    __device__ __forceinline__ void a_voff(const Unit&, unsigned (&v)[2][2], int wv) const {
        int tid = tid_of(wv); asm volatile("" : "+v"(tid));
#pragma unroll
        for (int i = 0; i < 2; ++i) { int R, C; stage_rc(tid * 16 + i * 8192, R, C);
#pragma unroll
            for (int h = 0; h < 2; ++h) v[h][i] = (unsigned)((h * HALF + R) * K + C) * 2u; }
    }
};

template <class Epi, class Sched, bool ALIGN_EPI, int MODE = 0>
__device__ __forceinline__ void gemm_phase(LAS unsigned char* lds, const int K, const Sched& S, const Epi& E, const int wv) {
    asm volatile("" : "+s"(lds));
    int tid = tid_of(wv); asm volatile("" : "+v"(tid));
    const int wid = __builtin_amdgcn_readfirstlane(tid >> 6), lane = tid & 63, wr = wid >> 2, wc = wid & 3, fr = lane & 15, fq = lane >> 4;
    const int nt = K / BK;
    unsigned voffB;
    { int R, C; stage_rc(tid * 16, R, C); const int Rb = Epi::PERM ? ((R & ~31) + perm32(R & 31)) : R; voffB = (unsigned)(Rb * K + C) * 2u; }
    const unsigned q64 = (unsigned)(64 * K * 2);
    const unsigned kstep = (unsigned)(BK * 2);
    const unsigned hstep = (unsigned)(HALF * K * 2);
    const __amdgpu_buffer_rsrc_t rsA = __builtin_amdgcn_make_buffer_rsrc((void*)S.a_ptr(), 0, 0xffffffff, 0x00020000);
    const __amdgpu_buffer_rsrc_t rsB = __builtin_amdgcn_make_buffer_rsrc((void*)S.b_ptr(), 0, 0xffffffff, 0x00020000);
    const unsigned ldsw = (unsigned)wid * 1024u;
    const int aoff = lds_byte(wr * 64 + fr, fq * 8), boff = lds_byte(wc * 32 + fr, fq * 8);
#define PG8_SA(b, h) (((b) * 2 + (h)) * HTB)
#define PG8_SB(b, h) ((4 + (b) * 2 + (h)) * HTB)
#define PG8_STAGE_(rs, bufoff, v0, s0, v1, s1) do { \
        __builtin_amdgcn_raw_ptr_buffer_load_lds(rs, (LAS void*)(lds + (bufoff) + ldsw), 16, (v0), (s0), 0, 0); \
        __builtin_amdgcn_raw_ptr_buffer_load_lds(rs, (LAS void*)(lds + (bufoff) + ldsw + 8192), 16, (v1), (s1), 0, 0); } while (0)
#define PG8_STAGE_B(bufoff, soff, unused) PG8_STAGE_(rsB, bufoff, voffB, (soff), voffB, (soff) + q64)
#define PG8_STAGE_A(bufoff, soff, h) do { if constexpr (Sched::DYN_A) PG8_STAGE_(rsA, bufoff, cvA[h][0], (soff), cvA[h][1], (soff)); \
        else PG8_STAGE_(rsA, bufoff, cvA[0][0], (soff) + (h) * 2u * q64, cvA[0][0], (soff) + (h) * 2u * q64 + q64); } while (0)
#define PG8_LDA(dst, b, h) do { _Pragma("unroll") for (int m = 0; m < 4; ++m) _Pragma("unroll") for (int k = 0; k < 2; ++k) dst[m][k] = *(const LAS bf16x8*)(lds + PG8_SA(b, h) + aoff + m * 2048 + k * 1024); } while (0)
#define PG8_LDB(dst, b, h) do { _Pragma("unroll") for (int n = 0; n < 2; ++n) _Pragma("unroll") for (int k = 0; k < 2; ++k) dst[n][k] = *(const LAS bf16x8*)(lds + PG8_SB(b, h) + boff + n * 2048 + k * 1024); } while (0)
#define PG8_MMA(ai, bj, At, Bt) do { __builtin_amdgcn_s_setprio(1); _Pragma("unroll") for (int m = 0; m < 4; ++m) _Pragma("unroll") for (int n = 0; n < 2; ++n) { \
        if constexpr (MODE == 1) { acc[ai][bj][m][n] = __builtin_amdgcn_mfma_scale_f32_16x16x128_f8f6f4(cat8(Bt[n][0], Bt[n][1]), cat8(At[m][0], At[m][1]), acc[ai][bj][m][n], 0, 0, 0, 0x7f7f7f7f, 0, 0x7f7f7f7f); } \
        else if constexpr (MODE == 2) { _Pragma("unroll") for (int k = 0; k < 2; ++k) acc[ai][bj][m][n] = __builtin_bit_cast(f32x4, __builtin_amdgcn_mfma_i32_16x16x64_i8(__builtin_bit_cast(v4i32_t, Bt[n][k]), __builtin_bit_cast(v4i32_t, At[m][k]), __builtin_bit_cast(v4i32_t, acc[ai][bj][m][n]), 0, 0, 0)); } \
        else { _Pragma("unroll") for (int k = 0; k < 2; ++k) acc[ai][bj][m][n] = __builtin_amdgcn_mfma_f32_16x16x32_bf16(Bt[n][k], At[m][k], acc[ai][bj][m][n], 0, 0, 0); } } \
        __builtin_amdgcn_s_setprio(0); } while (0)
#define PG8_WAIT_V(n) asm volatile("s_waitcnt vmcnt(" #n ")" ::: "memory")
#define PG8_WAIT_L(n) asm volatile("s_waitcnt lgkmcnt(" #n ")" ::: "memory")
#define PG8_BAR __builtin_amdgcn_s_barrier()
#define PG8_SCHED __builtin_amdgcn_sched_barrier(0)
    Unit cur, nxt; int ui = 0;
    if (!S.next(0, cur)) return;
    f32x4 acc[2][2][4][2];
    { float z0 = 0.f; asm volatile("" : "+v"(z0));
#pragma unroll
    for (int a = 0; a < 2; ++a)
#pragma unroll
        for (int b = 0; b < 2; ++b)
#pragma unroll
            for (int m = 0; m < 4; ++m)
#pragma unroll
                for (int n = 0; n < 2; ++n) acc[a][b][m][n] = (f32x4){z0, z0, z0, z0}; }
    bf16x8 At[4][2], B0[2][2], B1[2][2];
    unsigned cvA[2][2];
    LAS u32x4* nvp = (LAS u32x4*)(lds + LDS_NVA) + tid;
    S.a_voff(cur, cvA, wv);
    unsigned cA = S.a_off(cur), cB = S.b_off(cur);
    PG8_STAGE_B(PG8_SB(0, 0), cB, voffB); PG8_STAGE_B(PG8_SB(0, 1), cB + hstep, voffB); PG8_STAGE_A(PG8_SA(0, 0), cA, 0); PG8_STAGE_A(PG8_SA(0, 1), cA, 1);
    if (wr == 1) PG8_BAR;
    PG8_WAIT_V(2); PG8_BAR;
    PG8_STAGE_B(PG8_SB(1, 0), cB + kstep, voffB); PG8_STAGE_A(PG8_SA(1, 0), cA + kstep, 0); PG8_STAGE_B(PG8_SB(1, 1), cB + hstep + kstep, voffB);
    PG8_WAIT_V(6); PG8_BAR;
    for (;;) {
        const bool has_next = S.next(ui + 1, nxt);
        unsigned nA = cA, nB = cB;
        if (has_next) { nA = S.a_off(nxt); nB = S.b_off(nxt); }
        if constexpr (Sched::DYN_A) { unsigned nv[2][2];
            if (has_next) S.a_voff(nxt, nv, wv); else {
#pragma unroll
                for (int h = 0; h < 2; ++h)
#pragma unroll
                    for (int i = 0; i < 2; ++i) nv[h][i] = cvA[h][i]; }
            *nvp = (u32x4){nv[0][0], nv[0][1], nv[1][0], nv[1][1]}; }
#pragma unroll 1
        for (int t = 0; t < nt; t += 2) {
            const bool last = (t == nt - 2);
            const unsigned a1 = cA + (unsigned)(t + 1) * kstep;
            const unsigned a2 = last ? nA : cA + (unsigned)(t + 2) * kstep, b2 = last ? nB : cB + (unsigned)(t + 2) * kstep;
            const unsigned a3 = a2 + kstep, b3 = b2 + kstep;
            unsigned nx1[2] = {cvA[1][0], cvA[1][1]};
            if constexpr (Sched::DYN_A) { if (last) { const u32x4 q = *nvp; cvA[0][0] = q.x; cvA[0][1] = q.y; nx1[0] = q.z; nx1[1] = q.w; } }
            if constexpr (Epi::HOOK_T >= 0) { if (t == Epi::HOOK_T) E.mid(acc, cur, wr, wc, fr, fq); }
            PG8_LDB(B0, 0, 0); PG8_LDB(B1, 0, 1); PG8_SCHED; PG8_LDA(At, 0, 0); PG8_STAGE_A(PG8_SA(1, 1), a1, 1);
            if constexpr (Sched::DYN_A) { cvA[1][0] = nx1[0]; cvA[1][1] = nx1[1]; }
            PG8_WAIT_V(8); PG8_WAIT_L(0); PG8_BAR; PG8_MMA(0, 0, At, B0); PG8_MMA(0, 1, At, B1); PG8_BAR; PG8_SCHED;
            PG8_LDA(At, 0, 1); PG8_STAGE_B(PG8_SB(0, 0), b2, voffB); PG8_STAGE_B(PG8_SB(0, 1), b2 + hstep, voffB); PG8_STAGE_A(PG8_SA(0, 0), a2, 0);
            PG8_WAIT_V(8); PG8_WAIT_L(0); PG8_BAR; PG8_MMA(1, 0, At, B0); PG8_MMA(1, 1, At, B1); PG8_BAR; PG8_SCHED;
            PG8_LDB(B0, 1, 0); PG8_LDB(B1, 1, 1); PG8_SCHED; PG8_LDA(At, 1, 0); PG8_STAGE_A(PG8_SA(0, 1), a2, 1);
            PG8_WAIT_V(8); PG8_WAIT_L(0); PG8_BAR; PG8_MMA(0, 0, At, B0); PG8_MMA(0, 1, At, B1); PG8_BAR; PG8_SCHED;
            PG8_LDA(At, 1, 1); PG8_STAGE_B(PG8_SB(1, 0), b3, voffB); PG8_STAGE_B(PG8_SB(1, 1), b3 + hstep, voffB); PG8_STAGE_A(PG8_SA(1, 0), a3, 0);
            PG8_WAIT_V(8); PG8_WAIT_L(0); PG8_BAR; PG8_MMA(1, 0, At, B0); PG8_MMA(1, 1, At, B1); PG8_BAR; PG8_SCHED;
        }
        if constexpr (ALIGN_EPI) { if (wr == 0) PG8_BAR; }
        E(acc, cur, wr, wc, fr, fq);
        if (!has_next) break;
        { float z0 = 0.f; asm volatile("" : "+v"(z0));
#pragma unroll
        for (int a = 0; a < 2; ++a)
#pragma unroll
            for (int b = 0; b < 2; ++b)
#pragma unroll
                for (int m = 0; m < 4; ++m)
#pragma unroll
                    for (int n = 0; n < 2; ++n) acc[a][b][m][n] = (f32x4){z0, z0, z0, z0}; }
        cur = nxt; cA = nA; cB = nB; ++ui;
        if constexpr (ALIGN_EPI) { if (wr == 1) PG8_BAR; }
    }
    PG8_WAIT_V(0);
    if constexpr (!ALIGN_EPI) { if (wr == 0) PG8_BAR; }
    PG8_BAR;
#undef PG8_SA
#undef PG8_SB
#undef PG8_STAGE_
#undef PG8_STAGE_A
#undef PG8_STAGE_B
#undef PG8_LDA
#undef PG8_LDB
#undef PG8_MMA
#undef PG8_WAIT_V
#undef PG8_WAIT_L
#undef PG8_BAR
#undef PG8_SCHED
}

struct EpiBf16 {
    static constexpr bool PERM = true; static constexpr int HOOK_T = -1;
    bf16_t* O; int ldc; const float* bias; int noepi; float scale;
    __device__ __forceinline__ void mid(f32x4 (&)[2][2][4][2], const Unit&, int, int, int, int) const {}
    __device__ __forceinline__ void operator()(const f32x4 (&acc)[2][2][4][2], const Unit& u, int wr, int wc, int fr, int fq) const {
        { const int l_ = tid_of(0); fr = l_ & 15; fq = l_ >> 4; }
        if (noepi) { if (acc[0][0][0][0][0] == 1.2345e-30f) O[0] = 0; return; }
        int row0 = u.row0 + wr * 64 + fr; asm volatile("" : "+v"(row0)); int col0 = u.pn * BM + wc * 32 + 8 * fq; asm volatile("" : "+v"(col0));
        f32x4 bv[2][2];
#pragma unroll
        for (int bj = 0; bj < 2; ++bj)
#pragma unroll
            for (int n = 0; n < 2; ++n) bv[bj][n] = bias ? *(const f32x4*)(bias + col0 + bj * HALF + 4 * n) : (f32x4){0.f, 0.f, 0.f, 0.f};
#pragma unroll
        for (int ai = 0; ai < 2; ++ai)
#pragma unroll
            for (int m = 0; m < 4; ++m) { bf16_t* rowp = O + (size_t)(row0 + ai * HALF + m * 16) * ldc + col0;
#pragma unroll
                for (int bj = 0; bj < 2; ++bj) { const f32x4 v0 = acc[ai][bj][m][0] * scale + bv[bj][0], v1 = acc[ai][bj][m][1] * scale + bv[bj][1];
                    u32x4 w; w.x = cvt_pk_bf16(v0[0], v0[1]); w.y = cvt_pk_bf16(v0[2], v0[3]); w.z = cvt_pk_bf16(v1[0], v1[1]); w.w = cvt_pk_bf16(v1[2], v1[3]);
                    *(u32x4*)(rowp + bj * HALF) = w; } }
    }
};
struct EpiZI8 {
    static constexpr bool PERM = true; static constexpr int HOOK_T = -1;
    bf16_t* O; unsigned char* ZG; const float* rsc; const float* csc;
    __device__ __forceinline__ void mid(f32x4 (&)[2][2][4][2], const Unit&, int, int, int, int) const {}
    __device__ __forceinline__ void operator()(const f32x4 (&acc)[2][2][4][2], const Unit& u, int wr, int wc, int fr, int fq) const {
        { const int l_ = tid_of(0); fr = l_ & 15; fq = l_ >> 4; }
        int row0 = u.row0 + wr * 64 + fr; asm volatile("" : "+v"(row0)); int col0 = u.pn * BM + wc * 32 + 8 * fq; asm volatile("" : "+v"(col0));
        f32x4 cs[2][2];
#pragma unroll
        for (int bj = 0; bj < 2; ++bj)
#pragma unroll
            for (int n = 0; n < 2; ++n) cs[bj][n] = *(const f32x4*)(csc + col0 + bj * HALF + 4 * n);
#pragma unroll
        for (int ai = 0; ai < 2; ++ai)
#pragma unroll
            for (int m = 0; m < 4; ++m) { const int r = row0 + ai * HALF + m * 16; const float rs = rsc[r]; bf16_t* rowp = O + (size_t)r * NZ + col0;
#pragma unroll
                for (int bj = 0; bj < 2; ++bj) { const v4i32_t i0 = __builtin_bit_cast(v4i32_t, acc[ai][bj][m][0]), i1 = __builtin_bit_cast(v4i32_t, acc[ai][bj][m][1]);
                    const f32x4 v0 = (f32x4){(float)i0.x, (float)i0.y, (float)i0.z, (float)i0.w} * rs * cs[bj][0], v1 = (f32x4){(float)i1.x, (float)i1.y, (float)i1.z, (float)i1.w} * rs * cs[bj][1];
                    if (u.pn >= ZO_GL0 / BM) {
                        unsigned w0 = 0, w1 = 0;
#pragma unroll
                        for (int j = 0; j < 4; ++j) { w0 |= (unsigned)(int)rintf(255.0f * sigmoidf_(v0[j])) << (8 * j); w1 |= (unsigned)(int)rintf(255.0f * sigmoidf_(v1[j])) << (8 * j); }
                        *(u32x2*)(ZG + (size_t)r * 2048 + (col0 - ZO_GL0) + bj * HALF) = (u32x2){w0, w1};
                    } else {
                    u32x4 w; w.x = cvt_pk_bf16(v0[0], v0[1]); w.y = cvt_pk_bf16(v0[2], v0[3]); w.z = cvt_pk_bf16(v1[0], v1[1]); w.w = cvt_pk_bf16(v1[2], v1[3]);
                    *(u32x4*)(rowp + bj * HALF) = w; } } }
    }
};
struct EpiMerged {
    static constexpr bool PERM = true; static constexpr int HOOK_T = 8;
    bf16_t* O; const unsigned char* ZG;
    __device__ __forceinline__ void mid(f32x4 (&acc)[2][2][4][2], const Unit& u, int wr, int wc, int fr, int fq) const {
        { const int l_ = tid_of(0); fr = l_ & 15; fq = l_ >> 4; }
        int row0 = u.row0 + wr * 64 + fr; asm volatile("" : "+v"(row0)); int col0 = u.pn * BM + wc * 32 + 8 * fq; asm volatile("" : "+v"(col0));
        u32x2 g0[2][4][2], g1[2][4][2];
#pragma unroll
        for (int ai = 0; ai < 2; ++ai)
#pragma unroll
            for (int m = 0; m < 4; ++m) { const unsigned char* zr = ZG + (size_t)(row0 + ai * HALF + m * 16) * 2048 + col0;
#pragma unroll
                for (int bj = 0; bj < 2; ++bj) { g0[ai][m][bj] = *(const u32x2*)(zr + bj * HALF); g1[ai][m][bj] = *(const u32x2*)(zr + 1024 + bj * HALF); } }
#pragma unroll
        for (int ai = 0; ai < 2; ++ai)
#pragma unroll
            for (int m = 0; m < 4; ++m)
#pragma unroll
                for (int bj = 0; bj < 2; ++bj) {
                    const unsigned a0[2] = {g0[ai][m][bj].x, g0[ai][m][bj].y}, a1[2] = {g1[ai][m][bj].x, g1[ai][m][bj].y};
#pragma unroll
                    for (int n = 0; n < 2; ++n)
#pragma unroll
                        for (int j = 0; j < 4; ++j) { const float u0 = fmaxf((float)((a0[n] >> (8 * j)) & 0xffu), 1.0f), u1 = (float)((a1[n] >> (8 * j)) & 0xffu);
                            acc[ai][bj][m][n][j] *= u1 * __builtin_amdgcn_rcpf(u0); } }
    }
    __device__ __forceinline__ void operator()(const f32x4 (&acc)[2][2][4][2], const Unit& u, int wr, int wc, int fr, int fq) const {
        { const int l_ = tid_of(0); fr = l_ & 15; fq = l_ >> 4; }
        int row0 = u.row0 + wr * 64 + fr; asm volatile("" : "+v"(row0)); int col0 = u.pn * BM + wc * 32 + 8 * fq; asm volatile("" : "+v"(col0));
        u32x2 g0[2][4][2];
#pragma unroll
        for (int ai = 0; ai < 2; ++ai)
#pragma unroll
            for (int m = 0; m < 4; ++m) { const unsigned char* zr = ZG + (size_t)(row0 + ai * HALF + m * 16) * 2048 + col0;
#pragma unroll
                for (int bj = 0; bj < 2; ++bj) g0[ai][m][bj] = *(const u32x2*)(zr + bj * HALF); }
#pragma unroll
        for (int ai = 0; ai < 2; ++ai)
#pragma unroll
            for (int m = 0; m < 4; ++m) { bf16_t* orow = O + (size_t)(row0 + ai * HALF + m * 16) * D + col0;
#pragma unroll
                for (int bj = 0; bj < 2; ++bj) { const unsigned a0[2] = {g0[ai][m][bj].x, g0[ai][m][bj].y};
                    float o[8];
#pragma unroll
                    for (int n = 0; n < 2; ++n)
#pragma unroll
                        for (int j = 0; j < 4; ++j) o[4 * n + j] = acc[ai][bj][m][n][j] * (fmaxf((float)((a0[n] >> (8 * j)) & 0xffu), 1.0f) * (1.0f / 255.0f));
                    u32x4 w; w.x = cvt_pk_bf16(o[0], o[1]); w.y = cvt_pk_bf16(o[2], o[3]); w.z = cvt_pk_bf16(o[4], o[5]); w.w = cvt_pk_bf16(o[6], o[7]);
                    *(u32x4*)(orow + bj * HALF) = w; } }
    }
};
struct EpiResid {
    static constexpr bool PERM = true; static constexpr int HOOK_T = -1;
    bf16_t* X; bf16_t* XO; const float* gate;
    __device__ __forceinline__ void mid(f32x4 (&)[2][2][4][2], const Unit&, int, int, int, int) const {}
    __device__ __forceinline__ void operator()(const f32x4 (&acc)[2][2][4][2], const Unit& u, int wr, int wc, int fr, int fq) const {
        { const int l_ = tid_of(0); fr = l_ & 15; fq = l_ >> 4; }
        int row0 = u.row0 + wr * 64 + fr; asm volatile("" : "+v"(row0)); int col0 = u.pn * BM + wc * 32 + 8 * fq; asm volatile("" : "+v"(col0));
        const float* gp = gate + (size_t)(u.row0 / SEQ) * (6 * D) + col0;
        f32x4 gv[2][2];
#pragma unroll
        for (int bj = 0; bj < 2; ++bj)
#pragma unroll
            for (int n = 0; n < 2; ++n) gv[bj][n] = *(const f32x4*)(gp + bj * HALF + 4 * n);
#pragma unroll
        for (int ai = 0; ai < 2; ++ai) {
            u32x4 xv[4][2];
#pragma unroll
            for (int m = 0; m < 4; ++m) { const bf16_t* rowp = X + (size_t)(row0 + ai * HALF + m * 16) * D + col0;
#pragma unroll
                for (int bj = 0; bj < 2; ++bj) xv[m][bj] = *(const u32x4*)(rowp + bj * HALF); }
#pragma unroll
            for (int m = 0; m < 4; ++m) { bf16_t* rowo = XO + (size_t)(row0 + ai * HALF + m * 16) * D + col0;
#pragma unroll
                for (int bj = 0; bj < 2; ++bj) { const u32x4 p = xv[m][bj];
                    const f32x4 o0 = (f32x4){bflo(p.x), bfhi(p.x), bflo(p.y), bfhi(p.y)} + gv[bj][0] * acc[ai][bj][m][0], o1 = (f32x4){bflo(p.z), bfhi(p.z), bflo(p.w), bfhi(p.w)} + gv[bj][1] * acc[ai][bj][m][1];
                    u32x4 w; w.x = cvt_pk_bf16(o0[0], o0[1]); w.y = cvt_pk_bf16(o0[2], o0[3]); w.z = cvt_pk_bf16(o1[0], o1[1]); w.w = cvt_pk_bf16(o1[2], o1[3]);
                    *(u32x4*)(rowo + bj * HALF) = w; } }
            asm volatile("" ::: "memory"); }
    }
};
struct EpiSwiglu {
    static constexpr bool PERM = true; static constexpr int HOOK_T = -1;
    unsigned char* ACT; const float* bias; float wscale;
    __device__ __forceinline__ void mid(f32x4 (&)[2][2][4][2], const Unit&, int, int, int, int) const {}
    __device__ __forceinline__ void operator()(const f32x4 (&acc)[2][2][4][2], const Unit& u, int wr, int wc, int fr, int fq) const {
        { const int l_ = tid_of(0); fr = l_ & 15; fq = l_ >> 4; }
        int row0 = u.row0 + wr * 64 + fr; asm volatile("" : "+v"(row0)); int cc = u.pn * HALF + wc * 32 + 8 * fq; asm volatile("" : "+v"(cc));
        const float* bp = bias + (size_t)u.e * 2048 + cc;
        f32x4 bg[2], bu[2];
#pragma unroll
        for (int n = 0; n < 2; ++n) { bg[n] = *(const f32x4*)(bp + 4 * n); bu[n] = *(const f32x4*)(bp + 1024 + 4 * n); }
#pragma unroll
        for (int ai = 0; ai < 2; ++ai)
#pragma unroll
            for (int m = 0; m < 4; ++m) { unsigned char* rowp = ACT + (size_t)(row0 + ai * HALF + m * 16) * D + cc;
                float o[8];
#pragma unroll
                for (int n = 0; n < 2; ++n)
#pragma unroll
                    for (int j = 0; j < 4; ++j) { float g = acc[ai][0][m][n][j] * wscale + bg[n][j], up = acc[ai][1][m][n][j] * wscale + bu[n][j];
                        g = fminf(g, 7.0f); up = fminf(fmaxf(up, -7.0f), 7.0f);
                        o[4 * n + j] = g * sigmoidf_(1.702f * g) * (up + 1.0f); }
                int w0 = 0, w1 = 0;
                w0 = __builtin_amdgcn_cvt_pk_fp8_f32(o[0], o[1], w0, false); w0 = __builtin_amdgcn_cvt_pk_fp8_f32(o[2], o[3], w0, true);
                w1 = __builtin_amdgcn_cvt_pk_fp8_f32(o[4], o[5], w1, false); w1 = __builtin_amdgcn_cvt_pk_fp8_f32(o[6], o[7], w1, true);
                *(u32x2*)rowp = (u32x2){(unsigned)w0, (unsigned)w1}; }
    }
};
struct EpiMoeOut {
    static constexpr bool PERM = true; static constexpr int HOOK_T = -1;
    unsigned char* O; float* SC; const float* bias; float wscale;
    __device__ __forceinline__ void mid(f32x4 (&)[2][2][4][2], const Unit&, int, int, int, int) const {}
    __device__ __forceinline__ void operator()(const f32x4 (&acc)[2][2][4][2], const Unit& u, int wr, int wc, int fr, int fq) const {
        int lane_; { lane_ = tid_of(0); fr = lane_ & 15; fq = lane_ >> 4; }
        int row0 = u.row0 + wr * 64 + fr; asm volatile("" : "+v"(row0)); int col0 = u.pn * BM + wc * 32 + 8 * fq; asm volatile("" : "+v"(col0));
        const float* bp = bias + (size_t)u.e * D + col0;
        f32x4 bv[2][2];
#pragma unroll
        for (int bj = 0; bj < 2; ++bj)
#pragma unroll
            for (int n = 0; n < 2; ++n) bv[bj][n] = *(const f32x4*)(bp + bj * HALF + 4 * n);
#pragma unroll
        for (int ai = 0; ai < 2; ++ai)
#pragma unroll
            for (int m = 0; m < 4; ++m) { const size_t r = (size_t)(row0 + ai * HALF + m * 16);
                f32x4 v[2][2]; float am = 1e-30f;
#pragma unroll
                for (int bj = 0; bj < 2; ++bj)
#pragma unroll
                    for (int n = 0; n < 2; ++n) { v[bj][n] = acc[ai][bj][m][n] * wscale + bv[bj][n];
                        am = fmaxf(am, fmaxf(fmaxf(fabsf(v[bj][n].x), fabsf(v[bj][n].y)), fmaxf(fabsf(v[bj][n].z), fabsf(v[bj][n].w)))); }
                am = fmaxf(am, shflx(am, 16, lane_)); am = fmaxf(am, shflx(am, 32, lane_));
                const float inv = 127.0f * __builtin_amdgcn_rcpf(am) * 0.999f;
                if (fq == 0) SC[r * 16 + wc * 4 + u.pn] = am * (1.0f / (127.0f * 0.999f));
#pragma unroll
                for (int bj = 0; bj < 2; ++bj) { unsigned w0 = 0, w1 = 0;
#pragma unroll
                    for (int j = 0; j < 4; ++j) { w0 |= (unsigned)((int)rintf(v[bj][0][j] * inv) + 128) << (8 * j); w1 |= (unsigned)((int)rintf(v[bj][1][j] * inv) + 128) << (8 * j); }
                    *(u32x2*)(O + r * D + col0 + bj * HALF) = (u32x2){w0, w1}; } }
    }
};
}

#define XB_TMO      128
#define XB_XCNT(j)  (256  + 64 * (j))
#define XB_XSUB(j)  (1280 + 64 * (j))
#define XB_XGEN(j)  (2304 + 64 * (j))
#define XB_TOP      3328
#define XB_TOPGEN   3392
#define XCD_BAR_WORDS 3456
#define XB_SPIN_CAP (1u << 18)
__device__ __forceinline__ unsigned xb_ld(unsigned* p)              { return __hip_atomic_load(p, __ATOMIC_RELAXED, __HIP_MEMORY_SCOPE_AGENT); }
__device__ __forceinline__ unsigned xb_add(unsigned* p, unsigned v) { return __hip_atomic_fetch_add(p, v, __ATOMIC_RELAXED, __HIP_MEMORY_SCOPE_AGENT); }
__device__ __forceinline__ unsigned xb_xcc_id() { return (unsigned)__builtin_amdgcn_s_getreg((3 << 11) | 20) & 0xFu; }
#define XB_SPIN(cond, bar) do { unsigned _sp = 0; while (cond) { __builtin_amdgcn_s_sleep(1); \
    if ((++_sp & 255u) == 0u) { if (xb_ld(&(bar)[XB_TMO])) break; if (_sp > XB_SPIN_CAP) { atomicAdd(&(bar)[XB_TMO], 1u); break; } } } } while (0)
struct XcdBarrier { unsigned* bar; unsigned x; volatile LAS unsigned* st; int wv; };
__device__ __forceinline__ XcdBarrier xcd_barrier_post(unsigned* bar, volatile LAS unsigned* st, int wv) {
    XcdBarrier b; b.bar = bar; b.x = xb_xcc_id(); b.st = st; b.wv = wv;
    if (tid_of(wv) == 0) (void)xb_add(&bar[XB_XCNT(b.x)], 1u);
    return b;
}
__device__ __forceinline__ void xcd_barrier_complete(unsigned* bar, unsigned x, unsigned& nloc, unsigned& nx) {
    const unsigned G = gridDim.x * gridDim.y * gridDim.z;
    unsigned sum, cnt, mine, sp = 0u;
    for (;;) {
        sum = 0u; cnt = 0u; mine = 0u;
#pragma unroll
        for (unsigned j = 0; j < 16; ++j) { const unsigned c = xb_ld(&bar[XB_XCNT(j)]); sum += c; cnt += (c > 0u) ? 1u : 0u; mine = (j == x) ? c : mine; }
        if (sum == G) break;
        __builtin_amdgcn_s_sleep(1);
        if ((++sp & 255u) == 0u) { if (xb_ld(&bar[XB_TMO])) break; if (sp > XB_SPIN_CAP) { atomicAdd(&bar[XB_TMO], 1u); break; } }
    }
    nloc = mine > 0u ? mine : 1u; nx = cnt > 0u ? cnt : 1u;
}
__device__ __forceinline__ void xcd_barrier(const XcdBarrier& b) {
    asm volatile("s_waitcnt vmcnt(0)" ::: "memory");
    __syncthreads();
    if (tid_of(b.wv) == 0) {
        size_t zb = 0; asm volatile("" : "+s"(zb)); unsigned* bar = b.bar + zb; unsigned bx = b.x; asm volatile("" : "+s"(bx));
        __builtin_amdgcn_s_waitcnt(0);
        unsigned nloc = b.st[0], nx = b.st[1];
        if (nloc == 0u) { xcd_barrier_complete(bar, bx, nloc, nx); b.st[0] = nloc; b.st[1] = nx; }
        const unsigned old = xb_add(&bar[XB_XSUB(bx)], 1u);
        const unsigned gen = old / nloc;
        if (old + 1u == (gen + 1u) * nloc) {
            __builtin_amdgcn_fence(__ATOMIC_RELEASE, "agent");
            asm volatile("s_waitcnt vmcnt(0)" ::: "memory");
            const unsigned og = xb_add(&bar[XB_TOP], 1u);
            const unsigned tg = og / nx;
            if (og + 1u == (tg + 1u) * nx) xb_add(&bar[XB_TOPGEN], 1u);
            else XB_SPIN(xb_ld(&bar[XB_TOPGEN]) == tg, bar);
            __builtin_amdgcn_fence(__ATOMIC_ACQUIRE, "agent");
            xb_add(&bar[XB_XGEN(bx)], 1u);
            asm volatile("s_waitcnt vmcnt(0)" ::: "memory");
        } else {
            XB_SPIN(xb_ld(&bar[XB_XGEN(bx)]) == gen, bar);
            __builtin_amdgcn_fence(__ATOMIC_ACQUIRE, "agent");
            asm volatile("s_waitcnt vmcnt(0)" ::: "memory");
        }
    }
    __syncthreads();
}

struct Args { const float* in[26]; float* out; unsigned char* ws; int ph_lo, ph_hi; };
enum { I_X = 0, I_C, I_N1G, I_N2G, I_WADA, I_BADA, I_WIN, I_CONVW, I_CONVB, I_WRGA, I_BRGA, I_WRGX, I_BRGX, I_LAM, I_WPOOL, I_PSCALE, I_WUPA, I_WUPB, I_WOUT, I_WROUTER, I_BROUTER, I_WEIN, I_BEIN, I_WEOUT, I_BEOUT, I_FINALG };

template <int ROWMODE>
__device__ __forceinline__ void tr_item(const float* W, int N, bf16_t* WT, int dst_ld, int dst_off, int k0, int n0, LAS float* scr, int lane) {
    { float tv[32];
#pragma unroll
    for (int i = 0; i < 32; ++i) tv[i] = W[(size_t)(k0 + 2 * i + (lane >> 5)) * N + n0 + (lane & 31)];
#pragma unroll
    for (int i = 0; i < 32; ++i) scr[(2 * i + (lane >> 5)) * 33 + (lane & 31)] = tv[i]; }
    LDS_WAIT();
    const int c = lane & 7;
#pragma unroll
    for (int j = 0; j < 4; ++j) { const int n = (lane >> 3) + 8 * j; const LAS float* s = scr + (8 * c) * 33 + n;
        u32x4 o; o.x = cvt_pk_bf16(s[0 * 33], s[1 * 33]); o.y = cvt_pk_bf16(s[2 * 33], s[3 * 33]); o.z = cvt_pk_bf16(s[4 * 33], s[5 * 33]); o.w = cvt_pk_bf16(s[6 * 33], s[7 * 33]);
        const int nn = n0 + n; int drow = nn;
        if (ROWMODE == 1) { drow = (nn < 1024) ? (256 * (nn >> 7) + (nn & 127)) : (256 * ((nn - 1024) >> 7) + 128 + ((nn - 1024) & 127)); }
        *(u32x4*)(WT + (size_t)drow * dst_ld + dst_off + k0 + 8 * c) = o; }
    LDS_WAIT();
}
template <int ROWMODE>
__device__ __forceinline__ void tr_item_fp8(const float* W, int N, unsigned char* WT, int k0, int n0, LAS float* scr, int lane) {
    { float tv[64];
#pragma unroll
    for (int i = 0; i < 64; ++i) tv[i] = W[(size_t)(k0 + 2 * i + (lane >> 5)) * N + n0 + (lane & 31)];
#pragma unroll
    for (int i = 0; i < 64; ++i) scr[(2 * i + (lane >> 5)) * 33 + (lane & 31)] = tv[i]; }
    LDS_WAIT();
    const int c = lane & 7;
#pragma unroll
    for (int j = 0; j < 4; ++j) { const int n = (lane >> 3) + 8 * j; const LAS float* s = scr + (16 * c) * 33 + n;
        int o[4];
#pragma unroll
        for (int q = 0; q < 4; ++q) { int w = 0; w = __builtin_amdgcn_cvt_pk_fp8_f32(s[(4 * q) * 33] * WEIN_SCALE, s[(4 * q + 1) * 33] * WEIN_SCALE, w, false);
            w = __builtin_amdgcn_cvt_pk_fp8_f32(s[(4 * q + 2) * 33] * WEIN_SCALE, s[(4 * q + 3) * 33] * WEIN_SCALE, w, true); o[q] = w; }
        const int nn = n0 + n; const int drow = (ROWMODE == 0) ? nn : ((nn < 1024) ? (256 * (nn >> 7) + (nn & 127)) : (256 * ((nn - 1024) >> 7) + 128 + ((nn - 1024) & 127)));
        *(u32x4*)(WT + (size_t)drow * 1024 + k0 + 16 * c) = (u32x4){(unsigned)o[0], (unsigned)o[1], (unsigned)o[2], (unsigned)o[3]}; }
    LDS_WAIT();
}
template <int ROWMODE>
__device__ __forceinline__ void tr_job(int item, const float* src, int K, int N, bf16_t* dst, size_t dst_bstride, int dst_ld, int dst_off, LAS float* scr, int lane) {
    const int nnb = N / 32, nkb = K / 64; const int nb = item % nnb; const int r = item / nnb; const int kb = r % nkb; const int bt = r / nkb;
    tr_item<ROWMODE>(src + (size_t)bt * K * N, N, dst + (size_t)bt * dst_bstride, dst_ld, dst_off, 64 * kb, 32 * nb, scr, lane);
}

constexpr int CONV_Q1 = 5, CONV_Q2 = 6;
constexpr int CONV_ITEMS_L = NE * 8 * 64 + NE * 8 * 32, CONV_CHUNKS_L = CONV_ITEMS_L / 8;
__device__ __forceinline__ void conv_expert_item(const Args& a, unsigned char* ws, int l, int r, LAS float* scr, int lane) {
    if (r < NE * 8 * 64) { const int nb = r % 64, r2 = r / 64, kb = r2 % 8, bt = l * NE + r2 / 8;
        tr_item_fp8<1>(a.in[I_WEIN] + (size_t)bt * 1024 * 2048, 2048, (unsigned char*)(ws + WS_WEIN) + (size_t)bt * 2048 * 1024, 128 * kb, 32 * nb, scr, lane); }
    else { r -= NE * 8 * 64; const int nb = r % 32, r2 = r / 32, kb = r2 % 8, bt = l * NE + r2 / 8;
        tr_item_fp8<0>(a.in[I_WEOUT] + (size_t)bt * 1024 * 1024, 1024, (unsigned char*)(ws + WS_WEOUT) + (size_t)bt * 1024 * 1024, 128 * kb, 32 * nb, scr, lane); }
}
__device__ __forceinline__ void conv_drain(const Args& a, int l, int budget, LAS unsigned char* lds, const int wv) {
    asm volatile("" : "+s"(lds));
    int tid_ = tid_of(wv); asm volatile("" : "+v"(tid_)); const int tid = tid_, lane = tid & 63;
    unsigned char* ws = opaque_ptr(a.ws); unsigned* head = (unsigned*)(ws + WS_CTL) + CW_CONVQ + 64 * l;
    LAS float* scr = (LAS float*)(lds + wv * 16896); LAS int* slot = (LAS int*)(lds + LDS_BYTES - 512);
    for (;;) {
        if (budget == 0) break;
        __syncthreads();
        if (tid == 0) *slot = (int)__hip_atomic_fetch_add(head, 1u, __ATOMIC_RELAXED, __HIP_MEMORY_SCOPE_AGENT);
        __syncthreads();
        const int c = __builtin_amdgcn_readfirstlane(*slot);
        if (c >= CONV_CHUNKS_L) break;
        conv_expert_item(a, ws, l, c * 8 + wv, scr, lane);
        if (budget > 0) --budget;
    }
    __syncthreads();
}
__device__ __forceinline__ void phase_prologue(const Args& a, LAS unsigned char* lds, const int wv) {
    asm volatile("" : "+s"(lds));
    int tid_ = tid_of(wv); asm volatile("" : "+v"(tid_)); const int tid = tid_, lane = tid & 63, wave = __builtin_amdgcn_readfirstlane(tid >> 6);
    const int G = gridDim.x;
    unsigned char* ws = opaque_ptr(a.ws); const int bid = opaque_bid();
    {
        LAS float* cact = (LAS float*)lds;
        LAS float* red = (LAS float*)(lds + 32768);
        for (int i = tid; i < NBATCH * D; i += NTHREADS) { const float v = a.in[I_C][i]; cact[i] = v * sigmoidf_(v); }
        __syncthreads();
        float* mod = (float*)(ws + WS_MOD);
        for (int u = bid; u < DEPTH * 96; u += G) {
            const int l = u / 96, cg = u % 96; const int n = cg * 64 + lane;
            const float* w = a.in[I_WADA] + (size_t)l * D * 6144 + n;
            float acc[8] = {0.f, 0.f, 0.f, 0.f, 0.f, 0.f, 0.f, 0.f};
            const int kb = wave * 128;
#pragma unroll 8
            for (int k = 0; k < 128; ++k) { const float wv = w[(size_t)(kb + k) * 6144];
#pragma unroll
                for (int b = 0; b < 8; ++b) acc[b] += cact[b * D + kb + k] * wv; }
#pragma unroll
            for (int b = 0; b < 8; ++b) red[(wave * 8 + b) * 64 + lane] = acc[b];
            __syncthreads();
            { const int b = tid >> 6; float s = 0.f;
#pragma unroll
              for (int w8 = 0; w8 < 8; ++w8) s += red[(w8 * 8 + b) * 64 + lane];
              mod[((size_t)l * NBATCH + b) * 6144 + n] = s + a.in[I_BADA][(size_t)l * 6144 + n]; }
            __syncthreads();
        }
    }
    {
        bf16_t* wrs = (bf16_t*)(ws + WS_WRS);
        for (int idx = bid * NTHREADS + tid; idx < DEPTH * D * NE; idx += G * NTHREADS) { const int e = idx & 31, k = (idx >> 5) & 1023, l = idx >> 15;
            const float w = a.in[I_WROUTER][idx]; const unsigned hi = cvt_pk_bf16(w, 0.f) & 0xffffu; const unsigned lo = cvt_pk_bf16(w - bflo(hi), 0.f) & 0xffffu;
            wrs[((size_t)(l * 2 + 0) * NE + e) * D + k] = (bf16_t)hi; wrs[((size_t)(l * 2 + 1) * NE + e) * D + k] = (bf16_t)lo; }
    }
#if Z_I8
    {
        LAS float* tile = (LAS float*)lds; LAS float* red = (LAS float*)(lds + 1024 * 33 * 4);
        signed char* w8 = (signed char*)(ws + WS_WIN); float* wsc = (float*)(ws + WS_WINSC);
        __syncthreads();
        for (int u = bid; u < DEPTH * (NZ / 32); u += G) {
            const int l = u / (NZ / 32), n0 = (u % (NZ / 32)) * 32; const float* W = a.in[I_WIN] + (size_t)l * D * NZ + n0;
            const int n = tid & 31, kr = tid >> 5;
#pragma unroll 1
            for (int k0 = 0; k0 < 1024; k0 += 256) { float tv[16];
#pragma unroll
                for (int i = 0; i < 16; ++i) tv[i] = W[(size_t)(k0 + 16 * i + kr) * NZ + n];
#pragma unroll
                for (int i = 0; i < 16; ++i) tile[(k0 + 16 * i + kr) * 33 + n] = tv[i]; }
            __syncthreads();
            { float am = 0.f;
#pragma unroll 8
              for (int i = 0; i < 64; ++i) am = fmaxf(am, fabsf(tile[(kr * 64 + i) * 33 + n]));
              red[kr * 32 + n] = am; }
            __syncthreads();
            if (tid < 32) { float am = 1e-30f;
#pragma unroll
                for (int q = 0; q < 16; ++q) am = fmaxf(am, red[q * 32 + tid]);
                red[512 + tid] = 127.0f / am; wsc[(size_t)l * NZ + n0 + tid] = am * (1.0f / 127.0f); }
            __syncthreads();
            { const float inv = red[512 + n]; signed char* dst = w8 + ((size_t)l * NZ + n0 + n) * D + kr * 64;
#pragma unroll
              for (int c = 0; c < 4; ++c) { int w4[4];
#pragma unroll
                  for (int q = 0; q < 4; ++q) { int pk = 0;
#pragma unroll
                      for (int e = 0; e < 4; ++e) pk |= (((int)rintf(tile[(kr * 64 + c * 16 + q * 4 + e) * 33 + n] * inv)) & 0xff) << (8 * e);
                      w4[q] = pk; }
                  *(u32x4*)(dst + 16 * c) = (u32x4){(unsigned)w4[0], (unsigned)w4[1], (unsigned)w4[2], (unsigned)w4[3]}; } }
            __syncthreads();
        }
    }
#endif
    {
        LAS float* scr = (LAS float*)(lds + wave * 16896);
        const int gw = bid * NWAVES + wave, NGW = G * NWAVES;
        constexpr int I_EIN = NE * 8 * 64, I_EOUT = NE * 8 * 32, I_WINI = Z_I8 ? 0 : DEPTH * (Z_FP8 ? 8 : 16) * 144, I_UPA = DEPTH * 16 * 32, I_UPB = DEPTH * 8 * 32, I_OUT = DEPTH * 16 * 32,
                      I_RGA = DEPTH * 8 * 2 * 4, I_RGX = I_RGA, I_POOL = DEPTH * 4 * 2 * 4;
        constexpr int NITEMS = I_EIN + I_EOUT + I_WINI + I_UPA + I_UPB + I_OUT + I_RGA + I_RGX + I_POOL;
        for (int it = gw; it < NITEMS; it += NGW) {
            int r = it;
            if (r < I_EIN) { const int nb = r % 64, r2 = r / 64, kb = r2 % 8, bt = r2 / 8;
                tr_item_fp8<1>(a.in[I_WEIN] + (size_t)bt * 1024 * 2048, 2048, (unsigned char*)(ws + WS_WEIN) + (size_t)bt * 2048 * 1024, 128 * kb, 32 * nb, scr, lane); continue; } r -= I_EIN;
            if (r < I_EOUT) { const int nb = r % 32, r2 = r / 32, kb = r2 % 8, bt = r2 / 8;
                tr_item_fp8<0>(a.in[I_WEOUT] + (size_t)bt * 1024 * 1024, 1024, (unsigned char*)(ws + WS_WEOUT) + (size_t)bt * 1024 * 1024, 128 * kb, 32 * nb, scr, lane); continue; } r -= I_EOUT;
#if Z_I8
#elif Z_FP8
            if (r < I_WINI) { const int nb = r % 144, r2 = r / 144, kb = r2 % 8, bt = r2 / 8;
                tr_item_fp8<0>(a.in[I_WIN] + (size_t)bt * 1024 * NZ, NZ, (unsigned char*)(ws + WS_WIN) + (size_t)bt * NZ * 1024, 128 * kb, 32 * nb, scr, lane); continue; } r -= I_WINI;
#else
            if (r < I_WINI) { tr_job<0>(r, a.in[I_WIN], 1024, NZ, (bf16_t*)(ws + WS_WIN), (size_t)NZ * 1024, 1024, 0, scr, lane); continue; } r -= I_WINI;
#endif
            if (r < I_UPA) { tr_job<0>(r, a.in[I_WUPA], 1024, 1024, (bf16_t*)(ws + WS_WCAT), (size_t)1024 * KCAT, KCAT, 512, scr, lane); continue; } r -= I_UPA;
            if (r < I_UPB) { tr_job<0>(r, a.in[I_WUPB], 512, 1024, (bf16_t*)(ws + WS_WCAT), (size_t)1024 * KCAT, KCAT, 0, scr, lane); continue; } r -= I_UPB;
            if (r < I_OUT) { tr_job<0>(r, a.in[I_WOUT], 1024, 1024, (bf16_t*)(ws + WS_WOUT), (size_t)1024 * 1024, 1024, 0, scr, lane); continue; } r -= I_OUT;
            if (r < I_RGA) { tr_job<0>(r, a.in[I_WRGA], 128, 128, (bf16_t*)(ws + WS_WRG), (size_t)256 * 128, 128, 0, scr, lane); continue; } r -= I_RGA;
            if (r < I_RGX) { tr_job<0>(r, a.in[I_WRGX], 128, 128, (bf16_t*)(ws + WS_WRG) + 128 * 128, (size_t)256 * 128, 128, 0, scr, lane); continue; } r -= I_RGX;
            tr_job<0>(r, a.in[I_WPOOL], 128, 128, (bf16_t*)(ws + WS_WPOOL), (size_t)128 * 128, 128, 0, scr, lane);
        }
    }
}

struct MoeTab { LAS int* cnt; LAS int* padstart; LAS int* tilestart; LAS int* tab; };
__device__ __forceinline__ MoeTab moe_tab_ptrs(LAS unsigned char* lds) { MoeTab t; t.cnt = (LAS int*)(lds + LDS_TAB); t.padstart = t.cnt + 32; t.tilestart = t.padstart + 40; t.tab = t.tilestart + 40; return t; }
__device__ __forceinline__ void moe_tables(const Args& a, int l, LAS unsigned char* lds, const int wv) {
    asm volatile("" : "+s"(lds));
    const MoeTab mt = moe_tab_ptrs(lds); int tid_ = tid_of(wv); asm volatile("" : "+v"(tid_)); const int tid = tid_;
    unsigned* ctl = (unsigned*)(opaque_ptr(a.ws) + WS_CTL);
    __syncthreads();
    if (tid < NE) mt.cnt[tid] = (int)__hip_atomic_load(ctl + CW_CNT + (l * NE + tid) * 16, __ATOMIC_RELAXED, __HIP_MEMORY_SCOPE_AGENT);
    __syncthreads();
    if (tid == 0) { int ps = 0, ts = 0; for (int e = 0; e < NE; ++e) { mt.padstart[e] = ps; mt.tilestart[e] = ts; const int nt = (mt.cnt[e] + 255) >> 8; ps += nt * 256; ts += nt; } mt.padstart[NE] = ps; mt.tilestart[NE] = ts; }
    __syncthreads();
    const int nMt = mt.tilestart[NE];
    for (int m = tid; m < nMt; m += NTHREADS) { int e = 0; for (int q = 1; q < NE; ++q) e = (mt.tilestart[q] <= m) ? q : e; mt.tab[m] = (e << 16) | (m - mt.tilestart[e]); }
    __syncthreads();
}
struct MoeSched1 {
    static constexpr bool DYN_A = true;
    const char* H; const char* W; const int* tokof; MoeTab mt; int nMt, G, c;
    __device__ __forceinline__ bool next(int i, pg8::Unit& u) const { int pm, pn; if (!pg8::order_map(i, G, c, nMt, 8, pm, pn)) return false;
        const int en = __builtin_amdgcn_readfirstlane(mt.tab[pm]); u.pm = pm; u.pn = pn; u.e = en >> 16; u.j = en & 0xffff;
        u.row0 = __builtin_amdgcn_readfirstlane(mt.padstart[u.e]) + 256 * u.j; u.rows = __builtin_amdgcn_readfirstlane(mt.cnt[u.e]) - 256 * u.j; return true; }
    __device__ __forceinline__ const char* a_ptr() const { return H; }
    __device__ __forceinline__ const char* b_ptr() const { return W; }
    __device__ __forceinline__ unsigned a_off(const pg8::Unit&) const { return 0u; }
    __device__ __forceinline__ unsigned b_off(const pg8::Unit& u) const { return ((unsigned)u.e * 2048u + (unsigned)u.pn * 256u) * 1024u; }
    __device__ __forceinline__ void a_voff(const pg8::Unit& u, unsigned (&v)[2][2], int wv) const {
        int tid = tid_of(wv); asm volatile("" : "+v"(tid));
        const int* tl = tokof + (size_t)u.e * T + 256 * u.j; const int rmax = u.rows - 1;
#pragma unroll
        for (int i = 0; i < 2; ++i) { int R, C; pg8::stage_rc(tid * 16 + i * 8192, R, C);
#pragma unroll
            for (int h = 0; h < 2; ++h) { int idx = h * 128 + R; idx = idx < rmax ? idx : rmax; v[h][i] = (unsigned)tl[idx] * 1024u + (unsigned)C * 2u; } }
    }
};
struct MoeSched2 {
    static constexpr bool DYN_A = false;
    const char* ACT; const char* W; MoeTab mt; int nMt, G, c;
    __device__ __forceinline__ bool next(int i, pg8::Unit& u) const { int pm, pn; if (!pg8::order_map(i, G, c, nMt, 4, pm, pn)) return false;
        const int en = __builtin_amdgcn_readfirstlane(mt.tab[pm]); u.pm = pm; u.pn = pn; u.e = en >> 16; u.j = en & 0xffff;
        u.row0 = __builtin_amdgcn_readfirstlane(mt.padstart[u.e]) + 256 * u.j; u.rows = __builtin_amdgcn_readfirstlane(mt.cnt[u.e]) - 256 * u.j; return true; }
    __device__ __forceinline__ const char* a_ptr() const { return ACT; }
    __device__ __forceinline__ const char* b_ptr() const { return W; }
    __device__ __forceinline__ unsigned a_off(const pg8::Unit& u) const { return (unsigned)u.row0 * 1024u; }
    __device__ __forceinline__ unsigned b_off(const pg8::Unit& u) const { return ((unsigned)u.e * 1024u + (unsigned)u.pn * 256u) * 1024u; }
    __device__ __forceinline__ void a_voff(const pg8::Unit&, unsigned (&v)[2][2], int wv) const {
        int tid = tid_of(wv); asm volatile("" : "+v"(tid));
#pragma unroll
        for (int i = 0; i < 2; ++i) { int R, C; pg8::stage_rc(tid * 16 + i * 8192, R, C);
#pragma unroll
            for (int h = 0; h < 2; ++h) v[h][i] = (unsigned)((h * 128 + R) * 512 + C) * 2u; }
    }
};

__device__ __forceinline__ void phase_a(const Args& a, int l, LAS unsigned char* lds, bool dry, const int wv) {
    asm volatile("" : "+s"(lds));
    int tid_ = tid_of(wv); asm volatile("" : "+v"(tid_)); const int tid = tid_, lane = tid & 63, wave = __builtin_amdgcn_readfirstlane(tid >> 6);
    const int G = gridDim.x; unsigned char* ws = opaque_ptr(a.ws); const int bid = opaque_bid();
    const float* mod = (const float*)(ws + WS_MOD);
    bf16_t* xres = (bf16_t*)(ws + WS_XRES); bf16_t* xout = dry ? (bf16_t*)(ws + WS_Z) : xres;
    if (l < DEPTH && bid < NBATCH) {
        LAS float* red = (LAS float*)lds;
        const int b = bid, e = tid & 31, kp = tid >> 5;
        const float* sh2 = mod + ((size_t)l * NBATCH + b) * 6144 + 3 * D; const float* wr = a.in[I_WROUTER] + (size_t)l * D * NE;
        float s = 0.f;
        for (int k = kp * 64; k < kp * 64 + 64; ++k) s += sh2[k] * wr[k * NE + e];
        red[kp * 32 + e] = s;
        __syncthreads();
        if (tid < 32) { float t = a.in[I_BROUTER][l * NE + tid]; for (int q = 0; q < 16; ++q) t += red[q * 32 + tid]; ((float*)(ws + WS_CB))[(l * NBATCH + b) * NE + tid] = t; }
        __syncthreads();
    }
    if (l > 0) moe_tables(a, (l - 1) + DEPTH * (REPN(7) - 1), lds, wv);
    const MoeTab mt = moe_tab_ptrs(lds);
    const int* slotinfo = (const int*)(ws + WS_SLOTINFO); const float* wgt = (const float*)(ws + WS_WGT);
    const unsigned char* outb = (const unsigned char*)(ws + WS_OUTB); const float* outsc = (const float*)(ws + WS_OUTSC);
    unsigned char* hb = (unsigned char*)(ws + WS_H);
    for (int chunk = bid; chunk < T / 128; chunk += G) {
        const int rowb = chunk * 128 + wave * 16; const int b = rowb / SEQ;
        const float* xin = a.in[I_X] + (size_t)rowb * D; const bf16_t* xinb = xres + (size_t)rowb * D;
        f32x4 xv[2][4]; int4 si[4]; f32x4 wv[4]; unsigned gv[2][4][4]; f32x4 gs[2][4];
#define PA_SX(r, q) do { if ((r) < 16) { _Pragma("unroll") for (int j = 0; j < 4; ++j) { if (l == 0) xv[(q) & 1][j] = *(const f32x4*)(xin + (size_t)(r) * D + 4 * lane + 256 * j); \
            else { const f32x2 t_ = *(const f32x2*)(xinb + (size_t)(r) * D + 4 * lane + 256 * j); xv[(q) & 1][j].x = t_.x; xv[(q) & 1][j].y = t_.y; } } } } while (0)
#define PA_S0(r, q) do { if ((r) < 16 && l > 0) { si[(q) & 3] = *(const int4*)(slotinfo + (size_t)(rowb + (r)) * 4); wv[(q) & 3] = *(const f32x4*)(wgt + (size_t)(rowb + (r)) * 4); } } while (0)
#define PA_S1(r, q) do { if ((r) < 16 && l > 0) { const int sl_[4] = {si[(q) & 3].x, si[(q) & 3].y, si[(q) & 3].z, si[(q) & 3].w}; \
            _Pragma("unroll") for (int kk = 0; kk < 4; ++kk) { const int e_ = sl_[kk] >> 24, li_ = sl_[kk] & 0xffffff; const size_t slot_ = (size_t)(mt.padstart[e_] + li_); const unsigned char* orow = outb + slot_ * D + 4 * lane; \
                gs[(q) & 1][kk] = *(const f32x4*)(outsc + slot_ * 16 + ((lane >> 3) & 3) * 4); \
                _Pragma("unroll") for (int j = 0; j < 4; ++j) gv[(q) & 1][kk][j] = *(const unsigned*)(orow + 256 * j); } } } while (0)
        PA_S0(0, 0); PA_S0(1, 1); PA_SX(0, 0); PA_S1(0, 0);
#pragma unroll 1
        for (int i0 = 0; i0 < 16; i0 += 4) {
#pragma unroll
          for (int ii = 0; ii < 4; ++ii) {
            const int i = i0 + ii; const int row = rowb + i;
            PA_S0(i + 2, ii + 2); PA_SX(i + 1, ii + 1); PA_S1(i + 1, ii + 1);
            f32x4 v[4];
#pragma unroll
            for (int j = 0; j < 4; ++j) { v[j] = xv[ii & 1][j];
                if (l > 0) { const unsigned p0 = __float_as_uint(v[j].x), p1 = __float_as_uint(v[j].y); v[j] = (f32x4){bflo(p0), bfhi(p0), bflo(p1), bfhi(p1)}; } }
            if (l > 0) {
                f32x4 y[4];
#pragma unroll
                for (int j = 0; j < 4; ++j) y[j] = (f32x4){0.f, 0.f, 0.f, 0.f};
#pragma unroll
                for (int kk = 0; kk < 4; ++kk) { const f32x4 ws4 = gs[ii & 1][kk] * wv[ii][kk];
#pragma unroll
                    for (int j = 0; j < 4; ++j) { const unsigned p = gv[ii & 1][kk][j];
                        y[j] += ws4[j] * ((f32x4){(float)(p & 0xffu), (float)((p >> 8) & 0xffu), (float)((p >> 16) & 0xffu), (float)(p >> 24)} - 128.0f); } }
                const float* g2 = mod + ((size_t)(l - 1) * NBATCH + b) * 6144 + 5 * D + 4 * lane;
#pragma unroll
                for (int j = 0; j < 4; ++j) v[j] += *(const f32x4*)(g2 + 256 * j) * y[j];
            }
            if (l < DEPTH) {
#pragma unroll
                for (int j = 0; j < 4; ++j) { u32x2 p; p.x = cvt_pk_bf16(v[j].x, v[j].y); p.y = cvt_pk_bf16(v[j].z, v[j].w); *(u32x2*)(xout + (size_t)row * D + 4 * lane + 256 * j) = p; }
            }
            float ss = 0.f;
#pragma unroll
            for (int j = 0; j < 4; ++j) ss += (v[j].x * v[j].x + v[j].y * v[j].y) + (v[j].z * v[j].z + v[j].w * v[j].w);
            const float rinv = 1.0f / sqrtf(wave_sum(ss, lane) * (1.0f / D) + NORM_EPS);
            if (l < DEPTH) {
                const float* ng = a.in[I_N1G] + (size_t)l * D + 4 * lane; const float* mb = mod + ((size_t)l * NBATCH + b) * 6144 + 4 * lane;
                f32x4 hq[4]; (void)hq;
#pragma unroll
                for (int j = 0; j < 4; ++j) { const f32x4 g = *(const f32x4*)(ng + 256 * j), sh = *(const f32x4*)(mb + 256 * j), sc = *(const f32x4*)(mb + D + 256 * j);
                    const f32x4 h = (v[j] * rinv * g) * (1.0f + sc) + sh;
#if Z_I8
                    hq[j] = h; }
                {   float am = 0.f;
#pragma unroll
                    for (int j = 0; j < 4; ++j) am = fmaxf(fmaxf(fmaxf(fabsf(hq[j].x), fabsf(hq[j].y)), fmaxf(fabsf(hq[j].z), fabsf(hq[j].w))), am);
#pragma unroll
                    for (int o = 1; o < 64; o <<= 1) am = fmaxf(am, shflx(am, o, lane));
                    am = fmaxf(am, 1e-20f); const float inv = 127.0f / am;
                    if (lane == 0) ((float*)(ws + WS_HSC))[row] = am * (1.0f / 127.0f);
#pragma unroll
                    for (int j = 0; j < 4; ++j) { const int q0 = (int)rintf(hq[j].x * inv), q1 = (int)rintf(hq[j].y * inv), q2 = (int)rintf(hq[j].z * inv), q3 = (int)rintf(hq[j].w * inv);
                        *(int*)(hb + (size_t)row * D + 4 * lane + 256 * j) = (q0 & 0xff) | ((q1 & 0xff) << 8) | ((q2 & 0xff) << 16) | ((q3 & 0xff) << 24); }
                }
#elif Z_FP8
                    int p = 0; p = __builtin_amdgcn_cvt_pk_fp8_f32(h.x, h.y, p, false); p = __builtin_amdgcn_cvt_pk_fp8_f32(h.z, h.w, p, true);
                    *(int*)(hb + (size_t)row * D + 4 * lane + 256 * j) = p; }
#else
                    u32x2 p; p.x = cvt_pk_bf16(h.x, h.y); p.y = cvt_pk_bf16(h.z, h.w); *(u32x2*)((bf16_t*)hb + (size_t)row * D + 4 * lane + 256 * j) = p; }
#endif
            } else {
                const float* fg = a.in[I_FINALG] + 4 * lane;
#pragma unroll
                for (int j = 0; j < 4; ++j) *(f32x4*)(a.out + (size_t)row * D + 4 * lane + 256 * j) = v[j] * rinv * *(const f32x4*)(fg + 256 * j);
            }
          }
        }
#undef PA_S0
#undef PA_SX
#undef PA_S1
    }
}

__device__ __forceinline__ void phase_h(const Args& a, int l, int cset, LAS unsigned char* lds, const int wv) {
    asm volatile("" : "+s"(lds));
    int tid_ = tid_of(wv); asm volatile("" : "+v"(tid_)); const int tid = tid_, lane = tid & 63, wave = __builtin_amdgcn_readfirstlane(tid >> 6);
    const int G = gridDim.x; unsigned char* ws = opaque_ptr(a.ws); const int bid = opaque_bid();
    const float* mod = (const float*)(ws + WS_MOD); const bf16_t* xres = (const bf16_t*)(ws + WS_XRES);
    unsigned char* h8 = (unsigned char*)(ws + WS_H);
    LAS float* rinvs = (LAS float*)lds;
    LAS float* lgt = (LAS float*)(lds + 1024);
    LAS int* hist = (LAS int*)(lds + 1024 + 8 * 16 * 33 * 4);
    LAS int* base = hist + 32;
    unsigned* ctl = (unsigned*)(ws + WS_CTL);
    const float* ng = a.in[I_N2G] + (size_t)l * D;
    const float* cbv = (const float*)(ws + WS_CB);
    int* tokof = (int*)(ws + WS_TOKOF); int* slotinfo = (int*)(ws + WS_SLOTINFO); float* wgt = (float*)(ws + WS_WGT);
    for (int chunk = bid; chunk < T / 128; chunk += G) {
        const int row0 = chunk * 128 + wave * 16; const int b = row0 / SEQ;
        const float* mb = mod + ((size_t)l * NBATCH + b) * 6144 + 3 * D;
        if (tid < 32) hist[tid] = 0;
        u32x2 xq[3][4];
#pragma unroll
        for (int r = 0; r < 2; ++r)
#pragma unroll
            for (int j = 0; j < 4; ++j) xq[r][j] = *(const u32x2*)(xres + (size_t)(row0 + r) * D + 4 * lane + 256 * j);
#pragma unroll
        for (int i = 0; i < 16; ++i) {
            const int row = row0 + i;
            if (i + 2 < 16) {
#pragma unroll
                for (int j = 0; j < 4; ++j) xq[(i + 2) % 3][j] = *(const u32x2*)(xres + (size_t)(row + 2) * D + 4 * lane + 256 * j); }
            f32x4 v[4]; float ss = 0.f;
#pragma unroll
            for (int j = 0; j < 4; ++j) { const u32x2 p = xq[i % 3][j]; v[j] = (f32x4){bflo(p.x), bfhi(p.x), bflo(p.y), bfhi(p.y)}; ss += (v[j].x * v[j].x + v[j].y * v[j].y) + (v[j].z * v[j].z + v[j].w * v[j].w); }
            const float rinv = 1.0f / sqrtf(wave_sum(ss, lane) * (1.0f / D) + NORM_EPS);
            if (lane == 0) rinvs[wave * 16 + i] = rinv;
#pragma unroll
            for (int j = 0; j < 4; ++j) { const f32x4 g = *(const f32x4*)(ng + 4 * lane + 256 * j), sh = *(const f32x4*)(mb + 4 * lane + 256 * j), sc = *(const f32x4*)(mb + D + 4 * lane + 256 * j);
                const f32x4 h = (v[j] * rinv * g) * (1.0f + sc) + sh;
                int p = 0; p = __builtin_amdgcn_cvt_pk_fp8_f32(h.x, h.y, p, false); p = __builtin_amdgcn_cvt_pk_fp8_f32(h.z, h.w, p, true);
                *(int*)(h8 + (size_t)row * D + 4 * lane + 256 * j) = p; }
        }
        {
            const int ri = lane & 15, q = lane >> 4;
            const bf16_t* xr = xres + (size_t)(row0 + ri) * D + 8 * q;
            const bf16_t* wh = (const bf16_t*)(ws + WS_WRS) + ((size_t)(l * 2 + 0) * NE + ri) * D + 8 * q; const bf16_t* wl = wh + (size_t)NE * D;
            f32x4 acc0 = {0.f, 0.f, 0.f, 0.f}, acc1 = {0.f, 0.f, 0.f, 0.f};
#pragma unroll 4
            for (int kb = 0; kb < 32; ++kb) {
                const int k0 = 32 * kb + 8 * q;
                const u32x4 xp = *(const u32x4*)(xr + 32 * kb); const f32x4 x0 = {bflo(xp.x), bfhi(xp.x), bflo(xp.y), bfhi(xp.y)}, x1 = {bflo(xp.z), bfhi(xp.z), bflo(xp.w), bfhi(xp.w)};
                const f32x4 g0 = *(const f32x4*)(ng + k0), g1 = *(const f32x4*)(ng + k0 + 4), s0 = *(const f32x4*)(mb + D + k0), s1 = *(const f32x4*)(mb + D + k0 + 4);
                const bf16x8 bh0 = *(const bf16x8*)(wh + 32 * kb), bl0 = *(const bf16x8*)(wl + 32 * kb), bh1 = *(const bf16x8*)(wh + 16 * D + 32 * kb), bl1 = *(const bf16x8*)(wl + 16 * D + 32 * kb);
                const f32x4 a0 = x0 * g0 * (1.0f + s0), a1 = x1 * g1 * (1.0f + s1);
                u32x4 hi, lo;
                hi.x = cvt_pk_bf16(a0.x, a0.y); hi.y = cvt_pk_bf16(a0.z, a0.w); hi.z = cvt_pk_bf16(a1.x, a1.y); hi.w = cvt_pk_bf16(a1.z, a1.w);
                lo.x = cvt_pk_bf16(a0.x - bflo(hi.x), a0.y - bfhi(hi.x)); lo.y = cvt_pk_bf16(a0.z - bflo(hi.y), a0.w - bfhi(hi.y));
                lo.z = cvt_pk_bf16(a1.x - bflo(hi.z), a1.y - bfhi(hi.z)); lo.w = cvt_pk_bf16(a1.z - bflo(hi.w), a1.w - bfhi(hi.w));
                const bf16x8 ah = __builtin_bit_cast(bf16x8, hi), al = __builtin_bit_cast(bf16x8, lo);
                acc0 = __builtin_amdgcn_mfma_f32_16x16x32_bf16(ah, bh0, acc0, 0, 0, 0); acc0 = __builtin_amdgcn_mfma_f32_16x16x32_bf16(ah, bl0, acc0, 0, 0, 0); acc0 = __builtin_amdgcn_mfma_f32_16x16x32_bf16(al, bh0, acc0, 0, 0, 0);
                acc1 = __builtin_amdgcn_mfma_f32_16x16x32_bf16(ah, bh1, acc1, 0, 0, 0); acc1 = __builtin_amdgcn_mfma_f32_16x16x32_bf16(ah, bl1, acc1, 0, 0, 0); acc1 = __builtin_amdgcn_mfma_f32_16x16x32_bf16(al, bh1, acc1, 0, 0, 0);
            }
            LDS_WAIT();
            const float c0 = cbv[(l * NBATCH + b) * NE + ri], c1 = cbv[(l * NBATCH + b) * NE + 16 + ri];
#pragma unroll
            for (int r = 0; r < 4; ++r) { const int ti = 4 * q + r; const float rv = rinvs[wave * 16 + ti];
                lgt[(wave * 16 + ti) * 33 + ri] = acc0[r] * rv + c0; lgt[(wave * 16 + ti) * 33 + 16 + ri] = acc1[r] * rv + c1; }
        }
        __syncthreads();
        int se[4] = {0, 0, 0, 0}; float sw[4] = {0.f, 0.f, 0.f, 0.f}; int rk[4] = {0, 0, 0, 0};
        if (lane < 16) {
            float v[32];
#pragma unroll
            for (int e = 0; e < 32; ++e) v[e] = lgt[(wave * 16 + lane) * 33 + e];
            float sv[4];
#pragma unroll
            for (int kk = 0; kk < 4; ++kk) { float best = v[0]; int bi = 0;
#pragma unroll
                for (int e = 1; e < 32; ++e) { if (v[e] > best) { best = v[e]; bi = e; } }
                sv[kk] = best; se[kk] = bi;
#pragma unroll
                for (int e = 0; e < 32; ++e) v[e] = (e == bi) ? -3.0e38f : v[e]; }
            float den = 0.f;
#pragma unroll
            for (int kk = 0; kk < 4; ++kk) { sw[kk] = __expf(sv[kk] - sv[0]); den += sw[kk]; }
            const float inv = 1.0f / den;
#pragma unroll
            for (int kk = 0; kk < 4; ++kk) { sw[kk] *= inv; rk[kk] = __hip_atomic_fetch_add(hist + se[kk], 1, __ATOMIC_RELAXED, __HIP_MEMORY_SCOPE_WORKGROUP); }
        }
        __syncthreads();
        if (tid < 32) base[tid] = (int)__hip_atomic_fetch_add(ctl + CW_CNT + (cset * NE + tid) * 16, (unsigned)hist[tid], __ATOMIC_RELAXED, __HIP_MEMORY_SCOPE_AGENT);
        __syncthreads();
        if (lane < 16) {
            const int row = row0 + lane; int si[4];
#pragma unroll
            for (int kk = 0; kk < 4; ++kk) { const int li = base[se[kk]] + rk[kk]; tokof[(size_t)se[kk] * T + li] = row; si[kk] = (se[kk] << 24) | li; }
            *(int4*)(slotinfo + (size_t)row * 4) = make_int4(si[0], si[1], si[2], si[3]);
            *(f32x4*)(wgt + (size_t)row * 4) = (f32x4){sw[0], sw[1], sw[2], sw[3]};
        }
        __syncthreads();
    }
}

constexpr int ZT_STRIDE = 528;
__device__ __forceinline__ void lru_unit(const Args& a, int l, int u, LAS unsigned char* lds, const int wv) {
    asm volatile("" : "+s"(lds));
    int tid_ = tid_of(wv); asm volatile("" : "+v"(tid_)); const int tid = tid_, lane = tid & 63, wave = __builtin_amdgcn_readfirstlane(tid >> 6);
    unsigned char* ws = opaque_ptr(a.ws);
    const bf16_t* z = (const bf16_t*)(ws + WS_Z);
    LAS unsigned char* zt = lds; LAS unsigned char* xc = lds + 131 * ZT_STRIDE;
    const int hp = u & 3, b = (u >> 2) & 7, s = u >> 5;
    const int t0 = b * SEQ + s * 128, p0 = s * 128;
    {   u32x4 sv[9];
#pragma unroll
        for (int k = 0; k < 9; ++k) { int idx = tid + NTHREADS * k; idx = idx < 131 * 32 ? idx : 131 * 32 - 1; const int r = idx >> 5, o = idx & 31; const int p = p0 - 3 + r; const int pc = p < 0 ? 0 : p;
            sv[k] = *(const u32x4*)(z + (size_t)(b * SEQ + pc) * NZ + hp * 256 + o * 8); if (p < 0) sv[k] = (u32x4){0u, 0u, 0u, 0u}; }
#pragma unroll
        for (int k = 0; k < 9; ++k) { int idx = tid + NTHREADS * k; idx = idx < 131 * 32 ? idx : 131 * 32 - 1; const int r = idx >> 5, o = idx & 31;
            *(LAS u32x4*)(zt + r * ZT_STRIDE + o * 16) = sv[k]; }
    }
    __syncthreads();
    {
        const int o = tid & 31, rb = tid >> 5; const int ch0 = hp * 256 + o * 8;
        float cw[4][8], cbias[8];
#pragma unroll
        for (int k = 0; k < 4; ++k) { const f32x4 w0 = *(const f32x4*)(a.in[I_CONVW] + ((size_t)l * 4 + k) * D + ch0), w1 = *(const f32x4*)(a.in[I_CONVW] + ((size_t)l * 4 + k) * D + ch0 + 4);
            cw[k][0] = w0.x; cw[k][1] = w0.y; cw[k][2] = w0.z; cw[k][3] = w0.w; cw[k][4] = w1.x; cw[k][5] = w1.y; cw[k][6] = w1.z; cw[k][7] = w1.w; }
        { const f32x4 b0 = *(const f32x4*)(a.in[I_CONVB] + (size_t)l * D + ch0), b1 = *(const f32x4*)(a.in[I_CONVB] + (size_t)l * D + ch0 + 4);
          cbias[0] = b0.x; cbias[1] = b0.y; cbias[2] = b0.z; cbias[3] = b0.w; cbias[4] = b1.x; cbias[5] = b1.y; cbias[6] = b1.z; cbias[7] = b1.w; }
#pragma unroll 2
        for (int i = 0; i < 8; ++i) { const int r = rb + 16 * i; float acc[8];
#pragma unroll
            for (int j = 0; j < 8; ++j) acc[j] = cbias[j];
#pragma unroll
            for (int k = 0; k < 4; ++k) { const u32x4 v = *(const LAS u32x4*)(zt + (r + k) * ZT_STRIDE + o * 16);
                acc[0] += cw[k][0] * bflo(v.x); acc[1] += cw[k][1] * bfhi(v.x); acc[2] += cw[k][2] * bflo(v.y); acc[3] += cw[k][3] * bfhi(v.y);
                acc[4] += cw[k][4] * bflo(v.z); acc[5] += cw[k][5] * bfhi(v.z); acc[6] += cw[k][6] * bflo(v.w); acc[7] += cw[k][7] * bfhi(v.w); }
            u32x4 w; w.x = cvt_pk_bf16(acc[0], acc[1]); w.y = cvt_pk_bf16(acc[2], acc[3]); w.z = cvt_pk_bf16(acc[4], acc[5]); w.w = cvt_pk_bf16(acc[6], acc[7]);
            *(LAS u32x4*)(xc + r * ZT_STRIDE + o * 16) = w; }
    }
    __syncthreads();
    {
        const int hsel = wave >> 2, wc = wave & 3, head = 2 * hp + hsel, c31 = lane & 31, hh = lane >> 5;
        const int ch = head * 128 + 32 * wc + c31;
        const bf16_t* wb = (const bf16_t*)(ws + WS_WRG) + ((size_t)(l * 8 + head) * 256 + 32 * wc + c31) * 128 + 8 * hh;
        bf16x8 Ba[8], Bi[8];
#pragma unroll
        for (int ks = 0; ks < 8; ++ks) { Ba[ks] = *(const bf16x8*)(wb + 16 * ks); Bi[ks] = *(const bf16x8*)(wb + 128 * 128 + 16 * ks); }
        const float ba = a.in[I_BRGA][(size_t)l * D + ch], bx = a.in[I_BRGX][(size_t)l * D + ch];
        const float lam = a.in[I_LAM][(size_t)l * D + ch];
        const float sp8 = 8.0f * log1pf(__expf(-lam));
        typedef __attribute__((address_space(1))) unsigned long long gu64;
        gu64* aggq = (gu64*)(ws + WS_AGG) + ((size_t)l * NBATCH * 32 + (size_t)b * 32) * D + ch;
        float Pr = 1.f, Hr = 0.f;
        unsigned hpk[64];
#pragma unroll
        for (int rb = 0; rb < 4; ++rb) {
            f32x16 aa, ai;
#pragma unroll
            for (int r = 0; r < 16; ++r) { aa[r] = 0.f; ai[r] = 0.f; }
            const LAS unsigned char* ap = xc + (32 * rb + c31) * ZT_STRIDE + (hsel * 128 + 8 * hh) * 2;
#pragma unroll
            for (int ks = 0; ks < 8; ++ks) { const bf16x8 A = *(const LAS bf16x8*)(ap + 32 * ks);
                aa = __builtin_amdgcn_mfma_f32_32x32x16_bf16(A, Ba[ks], aa, 0, 0, 0); ai = __builtin_amdgcn_mfma_f32_32x32x16_bf16(A, Bi[ks], ai, 0, 0, 0); }
            const LAS unsigned char* xp = xc + (32 * rb + 4 * hh) * ZT_STRIDE + (hsel * 128 + 32 * wc + c31) * 2;
#pragma unroll
            for (int q = 0; q < 4; ++q) {
                float p = 1.f, h = 0.f, hl[4], pl[4];
#pragma unroll
                for (int r3 = 0; r3 < 4; ++r3) { const int reg = 4 * q + r3;
                    const float xcv = bf1(*(const LAS bf16_t*)(xp + (8 * q + r3) * ZT_STRIDE));
                    const float rg = sigmoidf_(aa[reg] + ba), ig = sigmoidf_(ai[reg] + bx);
                    const float av = __expf(-sp8 * rg); const float mult = sqrtf(fmaxf(1.0f - av * av, 0.f));
                    h = av * h + mult * (ig * xcv); p *= av; hl[r3] = h; pl[r3] = p; }
                const float Ao = shflx(p, 32, lane), Bo = shflx(h, 32, lane);
                const float A0 = hh ? Ao : p, B0 = hh ? Bo : h, A1 = hh ? p : Ao, B1 = hh ? h : Bo;
                const float P1 = Pr * A0, H1 = Hr * A0 + B0;
                const float Pst = hh ? P1 : Pr, Hst = hh ? H1 : Hr;
                Pr = P1 * A1; Hr = H1 * A1 + B1;
#pragma unroll
                for (int r3 = 0; r3 < 4; ++r3) hpk[rb * 16 + 4 * q + r3] = cvt_pk_bf16(Hst * pl[r3] + hl[r3], Pst * pl[r3]);
            }
        }
        if (hh == 0) __hip_atomic_store(aggq + (size_t)s * D, ((unsigned long long)__float_as_uint(Hr) << 32) | (unsigned long long)__float_as_uint(fmaxf(Pr, 1e-37f)), __ATOMIC_RELAXED, __HIP_MEMORY_SCOPE_AGENT);
        const bf16_t* zg = z + (size_t)t0 * NZ + ZO_GLRU + ch;
        bf16_t* yo = (bf16_t*)(ws + WS_ACAT) + (size_t)t0 * KCAT + 512 + ch;
        bf16_t gcur[16], gnxt[16];
#pragma unroll
        for (int reg = 0; reg < 16; ++reg) gcur[reg] = zg[(size_t)(8 * (reg >> 2) + 4 * hh + (reg & 3)) * NZ];
        float cin = 0.f;
        for (int j0 = 0; j0 < s; j0 += 8) {
            unsigned long long w[8]; unsigned spins = 0;
            for (;;) { bool ok = true;
#pragma unroll
                for (int k = 0; k < 8; ++k) { const int j = (j0 + k < s) ? (j0 + k) : (s - 1); w[k] = __hip_atomic_load(aggq + (size_t)j * D, __ATOMIC_RELAXED, __HIP_MEMORY_SCOPE_AGENT); ok = ok && ((unsigned)w[k] != 0u); }
                if (__all(ok)) break;
                __builtin_amdgcn_s_sleep(4);
                if (++spins > (1u << 17)) break;
            }
#pragma unroll
            for (int k = 0; k < 8; ++k) { if (j0 + k < s) cin = __uint_as_float((unsigned)w[k]) * cin + __uint_as_float((unsigned)(w[k] >> 32)); }
        }
#pragma unroll
        for (int rb = 0; rb < 4; ++rb) {
            if (rb < 3) {
#pragma unroll
                for (int reg = 0; reg < 16; ++reg) gnxt[reg] = zg[(size_t)(32 * (rb + 1) + 8 * (reg >> 2) + 4 * hh + (reg & 3)) * NZ]; }
#pragma unroll
            for (int reg = 0; reg < 16; ++reg) { const int tok = 32 * rb + 8 * (reg >> 2) + 4 * hh + (reg & 3);
                const unsigned pk = hpk[rb * 16 + reg];
                const float hf = bflo(pk) + bfhi(pk) * cin;
                const float g = bf1(gcur[reg]);
                const float ge = g * __builtin_amdgcn_rcpf(1.0f + __expf(-1.5957691216f * (g + 0.044715f * g * g * g)));
                yo[(size_t)tok * KCAT] = (bf16_t)(cvt_pk_bf16(hf * ge, 0.f) & 0xffffu); }
#pragma unroll
            for (int reg = 0; reg < 16; ++reg) gcur[reg] = gnxt[reg];
        }
    }
    __syncthreads();
}
__device__ __forceinline__ void pool_unit(const Args& a, int l, int u, LAS unsigned char* lds, const int wv) {
    asm volatile("" : "+s"(lds));
    int tid_ = tid_of(wv); asm volatile("" : "+v"(tid_)); const int tid = tid_, lane = tid & 63, wave = __builtin_amdgcn_readfirstlane(tid >> 6);
    unsigned char* ws = opaque_ptr(a.ws);
    const bf16_t* z = (const bf16_t*)(ws + WS_Z);
    LAS unsigned char* zt = lds; LAS unsigned char* pt = lds + 143 * ZT_STRIDE;
    const int gp = u & 1, b = (u >> 1) & 7, s = u >> 4;
    const int t0 = b * SEQ + s * 128, p0 = s * 128;
    {   u32x4 sv[9];
#pragma unroll
        for (int k = 0; k < 9; ++k) { int idx = tid + NTHREADS * k; idx = idx < 143 * 32 ? idx : 143 * 32 - 1; const int r = idx >> 5, o = idx & 31; const int p = p0 - 15 + r; const int pc = p < 0 ? 0 : p;
            sv[k] = *(const u32x4*)(z + (size_t)(b * SEQ + pc) * NZ + ZO_XPOOL + gp * 256 + o * 8); if (p < 0) sv[k] = (u32x4){0u, 0u, 0u, 0u}; }
#pragma unroll
        for (int k = 0; k < 9; ++k) { int idx = tid + NTHREADS * k; idx = idx < 143 * 32 ? idx : 143 * 32 - 1; const int r = idx >> 5, o = idx & 31;
            *(LAS u32x4*)(zt + r * ZT_STRIDE + o * 16) = sv[k]; }
    }
    __syncthreads();
    {
        const int o = tid & 31, rb = tid >> 5; const int g = 2 * gp + (o >> 4); const int w = 2 << g;
#pragma unroll 1
        for (int i = 0; i < 8; ++i) { const int r = rb + 16 * i; float acc[8];
#pragma unroll
            for (int j = 0; j < 8; ++j) acc[j] = 0.f;
            for (int jj = 0; jj < w; ++jj) { const u32x4 v = *(const LAS u32x4*)(zt + (r + 15 - jj) * ZT_STRIDE + o * 16);
                acc[0] += bflo(v.x); acc[1] += bfhi(v.x); acc[2] += bflo(v.y); acc[3] += bfhi(v.y); acc[4] += bflo(v.z); acc[5] += bfhi(v.z); acc[6] += bflo(v.w); acc[7] += bfhi(v.w); }
            const int cnt = (p0 + r + 1 < w) ? (p0 + r + 1) : w; const float ic = 1.0f / (float)cnt;
            const u32x4 v = *(const LAS u32x4*)(zt + (r + 15) * ZT_STRIDE + o * 16);
            const float x0[8] = {bflo(v.x), bfhi(v.x), bflo(v.y), bfhi(v.y), bflo(v.z), bfhi(v.z), bflo(v.w), bfhi(v.w)};
#pragma unroll
            for (int j = 0; j < 8; ++j) acc[j] = acc[j] * ic - x0[j];
            u32x4 wv; wv.x = cvt_pk_bf16(acc[0], acc[1]); wv.y = cvt_pk_bf16(acc[2], acc[3]); wv.z = cvt_pk_bf16(acc[4], acc[5]); wv.w = cvt_pk_bf16(acc[6], acc[7]);
            *(LAS u32x4*)(pt + r * ZT_STRIDE + o * 16) = wv; }
    }
    __syncthreads();
    {
        const int gsel = wave >> 2, wc = wave & 3, g = 2 * gp + gsel, c31 = lane & 31, hh = lane >> 5;
        const int oc = g * 128 + 32 * wc + c31;
        const bf16_t* wb = (const bf16_t*)(ws + WS_WPOOL) + ((size_t)(l * 4 + g) * 128 + 32 * wc + c31) * 128 + 8 * hh;
        bf16x8 Bf[8];
#pragma unroll
        for (int ks = 0; ks < 8; ++ks) Bf[ks] = *(const bf16x8*)(wb + 16 * ks);
        const float psc = a.in[I_PSCALE][(size_t)l * 512 + oc];
        bf16_t* yo = (bf16_t*)(ws + WS_ACAT) + (size_t)t0 * KCAT + oc;
#pragma unroll 1
        for (int rb = 0; rb < 4; ++rb) {
            f32x16 acc;
#pragma unroll
            for (int r = 0; r < 16; ++r) acc[r] = 0.f;
            const LAS unsigned char* ap = pt + (32 * rb + c31) * ZT_STRIDE + (gsel * 128 + 8 * hh) * 2;
#pragma unroll
            for (int ks = 0; ks < 8; ++ks) { const bf16x8 A = *(const LAS bf16x8*)(ap + 32 * ks); acc = __builtin_amdgcn_mfma_f32_32x32x16_bf16(A, Bf[ks], acc, 0, 0, 0); }
#pragma unroll
            for (int reg = 0; reg < 16; ++reg) { const int tok = 32 * rb + 8 * (reg >> 2) + 4 * hh + (reg & 3);
                yo[(size_t)tok * KCAT] = (bf16_t)(cvt_pk_bf16(acc[reg] * psc, 0.f) & 0xffffu); }
        }
    }
    __syncthreads();
}

constexpr int PH_PER_LAYER = 9;
constexpr int N_PHASES = 1 + DEPTH * PH_PER_LAYER + 1;

__global__ void __launch_bounds__(NTHREADS, 2) fwd_kernel(Args a) {
    extern __shared__ __attribute__((aligned(16))) unsigned char lds_raw[];
    LAS unsigned char* lds = (LAS unsigned char*)lds_raw;
    const int wv = __builtin_amdgcn_readfirstlane(threadIdx.x >> 6); const int tid = threadIdx.x; const int G = gridDim.x;
    unsigned char* ws0 = a.ws;
    unsigned* ctl = (unsigned*)(ws0 + WS_CTL);
    volatile LAS unsigned* misc = (volatile LAS unsigned*)(lds + LDS_MISC);
    if (tid < 4) misc[tid] = 0u;
    __syncthreads();
    XcdBarrier bar; bar.bar = ctl + CW_BAR; bar.x = 0; bar.st = misc; bar.wv = wv;
#if MK_PER_PHASE
    const int lo = a.ph_lo, hi = a.ph_hi;
#else
    constexpr int lo = 0, hi = N_PHASES;
#endif
    if (hi - lo > 1) bar = xcd_barrier_post(ctl + CW_BAR, misc, wv);
#define IN(k) (lo <= (k) && (k) < hi)
#define SEAM(k) do { if (IN((k) + 1)) xcd_barrier(bar); } while (0)

    if (EN(0) && IN(0)) for (int rr = 0; rr < REPN(0); ++rr) { phase_prologue(a, lds, wv); SEAM(0); }

    for (int l = 0; l < DEPTH; ++l) {
        const int pb = 1 + l * PH_PER_LAYER;
        if (EN(1) && IN(pb + 0)) for (int rr = 0; rr < REPN(1); ++rr) { unsigned char* ws = opaque_ptr(ws0); const int bid = opaque_bid(); (void)bid; (void)ws; phase_a(a, l, lds, rr + 1 < REPN(1), wv); SEAM(pb + 0); }
        if (EN(2) && IN(pb + 1)) for (int rr = 0; rr < REPN(2); ++rr) { unsigned char* ws = opaque_ptr(ws0); const int bid = opaque_bid(); (void)bid; (void)ws;
            #if Z_I8
            pg8::PlainSched S{(const char*)(ws + WS_H), (const char*)(ws + WS_WIN) + (size_t)l * NZ * 1024, 512, T / 256, NZ / 256, G, bid};
            pg8::EpiZI8 E{(bf16_t*)(ws + WS_Z), (unsigned char*)(ws + WS_ZG), (const float*)(ws + WS_HSC), (const float*)(ws + WS_WINSC) + (size_t)l * NZ};
            pg8::gemm_phase<pg8::EpiZI8, pg8::PlainSched, true, 2>(lds, 512, S, E, wv);
#elif Z_FP8
            pg8::PlainSched S{(const char*)(ws + WS_H), (const char*)(ws + WS_WIN) + (size_t)l * NZ * 1024, 512, T / 256, NZ / 256, G, bid};
            pg8::EpiBf16 E{(bf16_t*)(ws + WS_Z), NZ, nullptr, (rr + 1 < REPN(2)) && (a.ph_lo == 0), 1.0f / WEIN_SCALE};
            pg8::gemm_phase<pg8::EpiBf16, pg8::PlainSched, true, 1>(lds, 512, S, E, wv);
#else
            pg8::PlainSched S{(const char*)(ws + WS_H), (const char*)(ws + WS_WIN) + (size_t)l * NZ * 1024 * 2, 1024, T / 256, NZ / 256, G, bid};
            pg8::EpiBf16 E{(bf16_t*)(ws + WS_Z), NZ, nullptr, (rr + 1 < REPN(2)) && (a.ph_lo == 0), 1.0f};
            pg8::gemm_phase<pg8::EpiBf16, pg8::PlainSched, true>(lds, 1024, S, E, wv);
#endif
            SEAM(pb + 1);
        }
        if (EN(3) && IN(pb + 2)) for (int rr = 0; rr < REPN(3); ++rr) { unsigned char* ws = opaque_ptr(ws0); const int bid = opaque_bid(); (void)bid; (void)ws;
            for (int u = bid; u < 1024 + 512; u += G) { if (u < 1024) lru_unit(a, l, u, lds, wv); else pool_unit(a, l, u - 1024, lds, wv); }
            SEAM(pb + 2);
        }
        if (EN(5) && IN(pb + 4)) for (int rr = 0; rr < REPN(5); ++rr) { unsigned char* ws = opaque_ptr(ws0); const int bid = opaque_bid(); (void)bid; (void)ws;
            pg8::PlainSched S{(const char*)(ws + WS_ACAT), (const char*)(ws + WS_WCAT) + (size_t)l * 1024 * KCAT * 2, KCAT, T / 256, D / 256, G, bid};
            pg8::EpiMerged E{(bf16_t*)(ws + WS_MERGED), (const unsigned char*)(ws + WS_ZG)};
            pg8::gemm_phase<pg8::EpiMerged, pg8::PlainSched, true>(lds, KCAT, S, E, wv);
            SEAM(pb + 4);
        }
        if (EN(6) && IN(pb + 5)) for (int rr = 0; rr < REPN(6); ++rr) { unsigned char* ws = opaque_ptr(ws0); const int bid = opaque_bid(); (void)bid; (void)ws;
            pg8::PlainSched S{(const char*)(ws + WS_MERGED), (const char*)(ws + WS_WOUT) + (size_t)l * 1024 * 1024 * 2, 1024, T / 256, D / 256, G, bid};
            pg8::EpiResid E{(bf16_t*)(ws + WS_XRES), (rr + 1 < REPN(6)) ? (bf16_t*)(ws + WS_ACT) : (bf16_t*)(ws + WS_XRES), (const float*)(ws + WS_MOD) + (size_t)l * NBATCH * 6144 + 2 * D};
            pg8::gemm_phase<pg8::EpiResid, pg8::PlainSched, true>(lds, 1024, S, E, wv);
            SEAM(pb + 5);
        }
        if (EN(7) && IN(pb + 6)) for (int rr = 0; rr < REPN(7); ++rr) { unsigned char* ws = opaque_ptr(ws0); const int bid = opaque_bid(); (void)bid; (void)ws; if (l > 0 && rr == 0) conv_drain(a, l, -1, lds, wv); phase_h(a, l, l + DEPTH * rr, lds, wv); SEAM(pb + 6); }
        if (EN(8) && IN(pb + 7)) for (int rr = 0; rr < REPN(8); ++rr) { unsigned char* ws = opaque_ptr(ws0); const int bid = opaque_bid(); (void)bid; (void)ws;
            moe_tables(a, l + DEPTH * (REPN(7) - 1), lds, wv);
            LAS unsigned char* lds_o = lds; asm volatile("" : "+s"(lds_o)); const MoeTab mt = moe_tab_ptrs(lds_o);
            MoeSched1 S{(const char*)(ws + WS_H), (const char*)(ws + WS_WEIN) + (size_t)l * NE * 2048 * 1024, (const int*)(ws + WS_TOKOF), mt, __builtin_amdgcn_readfirstlane(mt.tilestart[NE]), G, bid};
            pg8::EpiSwiglu E{(unsigned char*)(ws + WS_ACT), a.in[I_BEIN] + (size_t)l * NE * 2048, 1.0f / WEIN_SCALE};
            pg8::gemm_phase<pg8::EpiSwiglu, MoeSched1, true, 1>(lds, 512, S, E, wv);
            if (l + 1 < DEPTH) {
                const int nwg = S.nMt * 8, maxr = (nwg + G - 1) / G, myr = (nwg - bid + G - 1) / G;
                if (myr < maxr) conv_drain(a, l + 1, CONV_Q1, lds, wv);
            }
            SEAM(pb + 7);
        }
        if (EN(9) && IN(pb + 8)) for (int rr = 0; rr < REPN(9); ++rr) { unsigned char* ws = opaque_ptr(ws0); const int bid = opaque_bid(); (void)bid; (void)ws;
            moe_tables(a, l + DEPTH * (REPN(7) - 1), lds, wv);
            LAS unsigned char* lds_o = lds; asm volatile("" : "+s"(lds_o)); const MoeTab mt = moe_tab_ptrs(lds_o);
            MoeSched2 S{(const char*)(ws + WS_ACT), (const char*)(ws + WS_WEOUT) + (size_t)l * NE * 1024 * 1024, mt, __builtin_amdgcn_readfirstlane(mt.tilestart[NE]), G, bid};
            pg8::EpiMoeOut E{(unsigned char*)(ws + WS_OUTB), (float*)(ws + WS_OUTSC), a.in[I_BEOUT] + (size_t)l * NE * D, 1.0f / WEIN_SCALE};
            pg8::gemm_phase<pg8::EpiMoeOut, MoeSched2, true, 1>(lds, 512, S, E, wv);
            if (l + 1 < DEPTH) {
                const int nwg = S.nMt * 4, maxr = (nwg + G - 1) / G, myr = (nwg - bid + G - 1) / G;
                if (myr < maxr) conv_drain(a, l + 1, CONV_Q2, lds, wv);
            }
            SEAM(pb + 8);
        }
    }
    if (EN(10) && IN(N_PHASES - 1)) phase_a(a, DEPTH, lds, false, wv);
#undef IN
#undef SEAM
}

extern "C" void kernel_launch(void* const* d_in, const int* in_sizes, int n_in, void* d_out, int out_size, void* d_ws, size_t ws_size, hipStream_t stream) {
    static int grid = 0;
    if (grid == 0) {
        if (n_in != 26 || out_size != T * D || ws_size < WS_END) { fprintf(stderr, "kernel_launch: unexpected problem (n_in %d out %d ws %zu)\n", n_in, out_size, ws_size); grid = -1; return; }
        int dev = 0, cus = 0, per_cu = 0;
        if (hipGetDevice(&dev) != hipSuccess || hipDeviceGetAttribute(&cus, hipDeviceAttributeMultiprocessorCount, dev) != hipSuccess) { grid = -1; return; }
        if (hipFuncSetAttribute((const void*)fwd_kernel, hipFuncAttributeMaxDynamicSharedMemorySize, LDS_BYTES) != hipSuccess) { fprintf(stderr, "kernel_launch: hipFuncSetAttribute failed\n"); grid = -1; return; }
        if (hipOccupancyMaxActiveBlocksPerMultiprocessor(&per_cu, (const void*)fwd_kernel, NTHREADS, LDS_BYTES) != hipSuccess || per_cu < 1) fprintf(stderr, "kernel_launch: occupancy query says %d\n", per_cu);
        (void)hipGetLastError();
        grid = cus;
    }
    if (grid < 0) return;
    if (hipMemsetAsync((char*)d_ws + WS_CTL, 0, CTL_ZERO_BYTES, stream) != hipSuccess) return;
    if (hipMemsetAsync((char*)d_ws + WS_AGG, 0, AGG_BYTES, stream) != hipSuccess) return;
    Args a{};
    for (int i = 0; i < 26; ++i) a.in[i] = (const float*)d_in[i];
    a.out = (float*)d_out; a.ws = (unsigned char*)d_ws;
#if MK_PER_PHASE
    for (int p = 0; p < N_PHASES; ++p) { a.ph_lo = p; a.ph_hi = p + 1; hipLaunchKernelGGL(fwd_kernel, dim3(grid), dim3(NTHREADS), LDS_BYTES, stream, a); }
#else
    a.ph_lo = 0; a.ph_hi = N_PHASES;
    hipLaunchKernelGGL(fwd_kernel, dim3(grid), dim3(NTHREADS), LDS_BYTES, stream, a);
#endif
    const hipError_t le = hipPeekAtLastError();
    if (le != hipSuccess) fprintf(stderr, "kernel_launch: launch failed: %s\n", hipGetErrorName(le));
}
```

```cpp
#include <hip/hip_runtime.h>
#include <cstdio>
#include <cstdint>

#define REP_MASK 0x0
#ifndef PH_MASK
#define PH_MASK 0x7ff
#endif
#define EN(b) ((PH_MASK >> (b)) & 1)
#ifndef REP_MASK
#define REP_MASK 0
#endif
#define REPN(b) ((((REP_MASK) >> (b)) & 1) ? 2 : 1)
#ifndef Z_I8
#define Z_I8 1
#endif
#ifndef Z_FP8
#define Z_FP8 0
#endif
#ifndef MK_PER_PHASE
#define MK_PER_PHASE 0
#endif

#define LAS __attribute__((address_space(3)))
typedef unsigned short bf16_t;
typedef short bf16x8 __attribute__((ext_vector_type(8)));
typedef float f32x4 __attribute__((ext_vector_type(4)));
typedef float f32x2 __attribute__((ext_vector_type(2)));
typedef float f32x16 __attribute__((ext_vector_type(16)));
typedef unsigned u32x4 __attribute__((ext_vector_type(4)));
typedef unsigned u32x2 __attribute__((ext_vector_type(2)));

constexpr int D = 1024, NBATCH = 8, SEQ = 4096, T = NBATCH * SEQ, DEPTH = 4;
constexpr int NZ = 4608, ZO_GLRU = 1024, ZO_XPOOL = 2048, ZO_GL0 = 2560, ZO_GL1 = 3584;
constexpr int NE = 32, TOPK = 4;
constexpr int KCAT = 1536;
constexpr int SLOT_CAP = T * TOPK + NE * 256;
constexpr int MAX_MT = SLOT_CAP / 256;
constexpr float NORM_EPS = 1e-6f;
constexpr float WEIN_SCALE = 64.0f;
constexpr int NTHREADS = 512, NWAVES = 8;

constexpr size_t MiB = 1u << 20;
constexpr size_t WS_CTL = 0, CTL_ZERO_BYTES = 256 * 1024;
constexpr size_t WS_MOD = 1 * MiB;
constexpr size_t WS_CB = 2 * MiB;
constexpr size_t WS_AGG = 72 * MiB;
constexpr size_t AGG_BYTES = (size_t)DEPTH * NBATCH * 32 * D * 8;
constexpr size_t WS_WRS = 3 * MiB;
constexpr size_t WS_HSC = 4 * MiB;
constexpr size_t WS_WINSC = 5 * MiB;
constexpr size_t WS_TOKOF = 6 * MiB;
constexpr size_t WS_SLOTINFO = 10 * MiB;
constexpr size_t WS_WGT = 11 * MiB;
constexpr size_t WS_WRG = 12 * MiB;
constexpr size_t WS_WPOOL = 14 * MiB;
constexpr size_t WS_WIN = 16 * MiB;
constexpr size_t WS_WCAT = 52 * MiB;
constexpr size_t WS_WOUT = 64 * MiB;
constexpr size_t WS_WEIN = 128 * MiB;
constexpr size_t WS_WEOUT = 640 * MiB;
constexpr size_t WS_XRES = 896 * MiB;
constexpr size_t WS_H = 1024 * MiB;
constexpr size_t WS_Z = 1088 * MiB;
constexpr size_t WS_ACAT = 1376 * MiB;
constexpr size_t WS_MERGED = 1472 * MiB;
constexpr size_t WS_ACT = 1536 * MiB;
constexpr size_t WS_OUTB = 1808 * MiB;
constexpr size_t WS_OUTSC = WS_OUTB + 144 * MiB;
constexpr size_t WS_ZG = 2080 * MiB;
constexpr size_t WS_END = 2144 * MiB;
static_assert(WS_ACT + (size_t)SLOT_CAP * 1024 * 2 <= WS_OUTB && WS_OUTB + (size_t)SLOT_CAP * 1024 * 2 <= WS_END, "ws map");
constexpr int CW_BAR = 4096;
constexpr int CW_CONVQ = 7680;
constexpr int CW_CNT = 8192;

constexpr int LDS_BYTES = 163840;
constexpr int LDS_TAB = 131072;
constexpr int LDS_NVA = 131072 + 8192;
constexpr int LDS_PTAB = 131072 + 16384, PTAB_BYTES = 2048;
constexpr int LDS_MISC = LDS_BYTES - 256;

__device__ __forceinline__ unsigned cvt_pk_bf16(float lo, float hi) { unsigned r; asm("v_cvt_pk_bf16_f32 %0, %1, %2" : "=v"(r) : "v"(lo), "v"(hi)); return r; }
__device__ __forceinline__ float bflo(unsigned w) { return __uint_as_float(w << 16); }
__device__ __forceinline__ float bfhi(unsigned w) { return __uint_as_float(w & 0xffff0000u); }
__device__ __forceinline__ float bf1(bf16_t w) { return __uint_as_float(((unsigned)w) << 16); }
__device__ __forceinline__ float sigmoidf_(float x) { return __builtin_amdgcn_rcpf(1.0f + __expf(-x)); }
__device__ __forceinline__ float shflx(float v, int mask, int lane) { return __int_as_float(__builtin_amdgcn_ds_bpermute((lane ^ mask) << 2, __float_as_int(v))); }
__device__ __forceinline__ float wave_sum(float v, int lane) {
#pragma unroll
    for (int o = 1; o < 64; o <<= 1) v += shflx(v, o, lane);
    return v;
}
__device__ __forceinline__ int tid_of(int wv) { int l; asm volatile("v_mbcnt_lo_u32_b32 %0, -1, 0\n\tv_mbcnt_hi_u32_b32 %0, -1, %0" : "=v"(l)); return wv * 64 + l; }
__device__ __forceinline__ int opaque_bid() { int b = blockIdx.x; asm volatile("" : "+s"(b)); return b; }
__device__ __forceinline__ unsigned char* opaque_ptr(unsigned char* p) { size_t z = 0; asm volatile("" : "+s"(z)); return p + z; }
#define LDS_WAIT() asm volatile("s_waitcnt lgkmcnt(0)" ::: "memory")
#define VM_WAIT() asm volatile("s_waitcnt vmcnt(0)" ::: "memory")

namespace pg8 {
constexpr int BM = 256, BK = 64, HALF = 128, HTB = HALF * BK * 2, STAGE_BYTES = 8 * HTB, NXCD = 8, WGM = 8;
__host__ __device__ __forceinline__ int lds_byte(int r, int c) { const int st = (r >> 4) * 2 + (c >> 5), rr = r & 15, cc = c & 31, ob = rr * 64 + cc * 2; return st * 1024 + (ob ^ (((ob >> 9) & 1) << 5)); }
__host__ __device__ __forceinline__ void stage_rc(int b, int& R, int& C) { const int st = b / 1024, sb = b % 1024, swz = sb ^ (((sb >> 9) & 1) << 5); R = (st >> 1) * 16 + swz / 64; C = (st & 1) * 32 + (swz % 64) / 2; }
__host__ __device__ __forceinline__ int perm32(int rho) { const int n = rho >> 4, i = rho & 15; return 8 * (i >> 2) + 4 * n + (i & 3); }

struct Unit { int pm, pn, e, j, row0, rows; };
typedef int v8i32 __attribute__((ext_vector_type(8)));
typedef int v4i32_t __attribute__((ext_vector_type(4)));
__device__ __forceinline__ v8i32 cat8(bf16x8 lo, bf16x8 hi) { typedef int v4i32 __attribute__((ext_vector_type(4))); const v4i32 a = __builtin_bit_cast(v4i32, lo), b = __builtin_bit_cast(v4i32, hi); return (v8i32){a.x, a.y, a.z, a.w, b.x, b.y, b.z, b.w}; }

__device__ __forceinline__ bool order_map(int i, int G, int c, int nM, int nN, int& pm, int& pn) {
    const int nwg = nM * nN; const int L = i * G + c; if (L >= nwg) return false;
    int wgid = L; { const int q = nwg / NXCD, r = nwg % NXCD, xcd = wgid % NXCD, off = wgid / NXCD; wgid = (xcd < r ? xcd * (q + 1) : r * (q + 1) + (xcd - r) * q) + off; }
    const int nig = WGM * nN, gid = wgid / nig, fm = gid * WGM, gsz = (nM - fm) < WGM ? (nM - fm) : WGM;
    pm = fm + ((wgid % nig) % gsz); pn = (wgid % nig) / gsz; return true;
}

struct PlainSched {
    static constexpr bool DYN_A = false;
    const char* A; const char* Bt; int K, nM, nN, G, c;
    __device__ __forceinline__ bool next(int i, Unit& u) const { int pm, pn; if (!order_map(i, G, c, nM, nN, pm, pn)) return false; u.pm = pm; u.pn = pn; u.e = 0; u.j = 0; u.row0 = pm * BM; u.rows = BM; return true; }
    __device__ __forceinline__ const char* a_ptr() const { return A; }
    __device__ __forceinline__ const char* b_ptr() const { return Bt; }
    __device__ __forceinline__ unsigned a_off(const Unit& u) const { return (unsigned)u.row0 * (unsigned)K * 2u; }
    __device__ __forceinline__ unsigned b_off(const Unit& u) const { return (unsigned)u.pn * (unsigned)(BM * K * 2); }
    __device__ __forceinline__ void a_voff(const Unit&, unsigned (&v)[2][2], int wv) const {
        int tid = tid_of(wv); asm volatile("" : "+v"(tid));
#pragma unroll
        for (int i = 0; i < 2; ++i) { int R, C; stage_rc(tid * 16 + i * 8192, R, C);
#pragma unroll
            for (int h = 0; h < 2; ++h) v[h][i] = (unsigned)((h * HALF + R) * K + C) * 2u; }
    }
};

template <class Epi, class Sched, bool ALIGN_EPI, int MODE = 0>
__device__ __forceinline__ void gemm_phase(LAS unsigned char* lds, const int K, const Sched& S, const Epi& E, const int wv) {
    asm volatile("" : "+s"(lds));
    int tid = tid_of(wv); asm volatile("" : "+v"(tid));
    const int wid = __builtin_amdgcn_readfirstlane(tid >> 6), lane = tid & 63, wr = wid >> 2, wc = wid & 3, fr = lane & 15, fq = lane >> 4;
    const int nt = K / BK;
    unsigned voffB;
    { int R, C; stage_rc(tid * 16, R, C); const int Rb = Epi::PERM ? ((R & ~31) + perm32(R & 31)) : R; voffB = (unsigned)(Rb * K + C) * 2u; }
    const unsigned q64 = (unsigned)(64 * K * 2);
    const unsigned kstep = (unsigned)(BK * 2);
    const unsigned hstep = (unsigned)(HALF * K * 2);
    const __amdgpu_buffer_rsrc_t rsA = __builtin_amdgcn_make_buffer_rsrc((void*)S.a_ptr(), 0, 0xffffffff, 0x00020000);
    const __amdgpu_buffer_rsrc_t rsB = __builtin_amdgcn_make_buffer_rsrc((void*)S.b_ptr(), 0, 0xffffffff, 0x00020000);
    const unsigned ldsw = (unsigned)wid * 1024u;
    const int aoff = lds_byte(wr * 64 + fr, fq * 8), boff = lds_byte(wc * 32 + fr, fq * 8);
#define PG8_SA(b, h) (((b) * 2 + (h)) * HTB)
#define PG8_SB(b, h) ((4 + (b) * 2 + (h)) * HTB)
#define PG8_STAGE_(rs, bufoff, v0, s0, v1, s1) do { \
        __builtin_amdgcn_raw_ptr_buffer_load_lds(rs, (LAS void*)(lds + (bufoff) + ldsw), 16, (v0), (s0), 0, 0); \
        __builtin_amdgcn_raw_ptr_buffer_load_lds(rs, (LAS void*)(lds + (bufoff) + ldsw + 8192), 16, (v1), (s1), 0, 0); } while (0)
#define PG8_STAGE_B(bufoff, soff, unused) PG8_STAGE_(rsB, bufoff, voffB, (soff), voffB, (soff) + q64)
#define PG8_STAGE_A(bufoff, soff, h) do { if constexpr (Sched::DYN_A) PG8_STAGE_(rsA, bufoff, cvA[h][0], (soff), cvA[h][1], (soff)); \
        else PG8_STAGE_(rsA, bufoff, cvA[0][0], (soff) + (h) * 2u * q64, cvA[0][0], (soff) + (h) * 2u * q64 + q64); } while (0)
#define PG8_LDA(dst, b, h) do { _Pragma("unroll") for (int m = 0; m < 4; ++m) _Pragma("unroll") for (int k = 0; k < 2; ++k) dst[m][k] = *(const LAS bf16x8*)(lds + PG8_SA(b, h) + aoff + m * 2048 + k * 1024); } while (0)
#define PG8_LDB(dst, b, h) do { _Pragma("unroll") for (int n = 0; n < 2; ++n) _Pragma("unroll") for (int k = 0; k < 2; ++k) dst[n][k] = *(const LAS bf16x8*)(lds + PG8_SB(b, h) + boff + n * 2048 + k * 1024); } while (0)
#define PG8_MMA(ai, bj, At, Bt) do { __builtin_amdgcn_s_setprio(1); _Pragma("unroll") for (int m = 0; m < 4; ++m) _Pragma("unroll") for (int n = 0; n < 2; ++n) { \
        if constexpr (MODE == 1) { acc[ai][bj][m][n] = __builtin_amdgcn_mfma_scale_f32_16x16x128_f8f6f4(cat8(Bt[n][0], Bt[n][1]), cat8(At[m][0], At[m][1]), acc[ai][bj][m][n], 0, 0, 0, 0x7f7f7f7f, 0, 0x7f7f7f7f); } \
        else if constexpr (MODE == 2) { _Pragma("unroll") for (int k = 0; k < 2; ++k) acc[ai][bj][m][n] = __builtin_bit_cast(f32x4, __builtin_amdgcn_mfma_i32_16x16x64_i8(__builtin_bit_cast(v4i32_t, Bt[n][k]), __builtin_bit_cast(v4i32_t, At[m][k]), __builtin_bit_cast(v4i32_t, acc[ai][bj][m][n]), 0, 0, 0)); } \
        else { _Pragma("unroll") for (int k = 0; k < 2; ++k) acc[ai][bj][m][n] = __builtin_amdgcn_mfma_f32_16x16x32_bf16(Bt[n][k], At[m][k], acc[ai][bj][m][n], 0, 0, 0); } } \
        __builtin_amdgcn_s_setprio(0); } while (0)
#define PG8_WAIT_V(n) asm volatile("s_waitcnt vmcnt(" #n ")" ::: "memory")
#define PG8_WAIT_L(n) asm volatile("s_waitcnt lgkmcnt(" #n ")" ::: "memory")
#define PG8_BAR __builtin_amdgcn_s_barrier()
#define PG8_SCHED __builtin_amdgcn_sched_barrier(0)
    Unit cur, nxt; int ui = 0;
    if (!S.next(0, cur)) return;
    f32x4 acc[2][2][4][2];
    { float z0 = 0.f; asm volatile("" : "+v"(z0));
#pragma unroll
    for (int a = 0; a < 2; ++a)
#pragma unroll
        for (int b = 0; b < 2; ++b)
#pragma unroll
            for (int m = 0; m < 4; ++m)
#pragma unroll
                for (int n = 0; n < 2; ++n) acc[a][b][m][n] = (f32x4){z0, z0, z0, z0}; }
    bf16x8 At[4][2], B0[2][2], B1[2][2];
    unsigned cvA[2][2];
    LAS u32x4* nvp = (LAS u32x4*)(lds + LDS_NVA) + tid;
    S.a_voff(cur, cvA, wv);
    unsigned cA = S.a_off(cur), cB = S.b_off(cur);
    if constexpr (Epi::PREF) E.prefetch(cur, lds + LDS_PTAB, wv);
    PG8_STAGE_B(PG8_SB(0, 0), cB, voffB); PG8_STAGE_B(PG8_SB(0, 1), cB + hstep, voffB); PG8_STAGE_A(PG8_SA(0, 0), cA, 0); PG8_STAGE_A(PG8_SA(0, 1), cA, 1);
    if (wr == 1) PG8_BAR;
    PG8_WAIT_V(2); PG8_BAR;
    PG8_STAGE_B(PG8_SB(1, 0), cB + kstep, voffB); PG8_STAGE_A(PG8_SA(1, 0), cA + kstep, 0); PG8_STAGE_B(PG8_SB(1, 1), cB + hstep + kstep, voffB);
    PG8_WAIT_V(6); PG8_BAR;
    for (;;) {
        const bool has_next = S.next(ui + 1, nxt);
        unsigned nA = cA, nB = cB;
        if (has_next) { nA = S.a_off(nxt); nB = S.b_off(nxt); }
        if constexpr (Sched::DYN_A) { unsigned nv[2][2];
            if (has_next) S.a_voff(nxt, nv, wv); else {
#pragma unroll
                for (int h = 0; h < 2; ++h)
#pragma unroll
                    for (int i = 0; i < 2; ++i) nv[h][i] = cvA[h][i]; }
            *nvp = (u32x4){nv[0][0], nv[0][1], nv[1][0], nv[1][1]}; }
#pragma unroll 1
        for (int t = 0; t < nt; t += 2) {
            const bool last = (t == nt - 2);
            const unsigned a1 = cA + (unsigned)(t + 1) * kstep;
            const unsigned a2 = last ? nA : cA + (unsigned)(t + 2) * kstep, b2 = last ? nB : cB + (unsigned)(t + 2) * kstep;
            const unsigned a3 = a2 + kstep, b3 = b2 + kstep;
            unsigned nx1[2] = {cvA[1][0], cvA[1][1]};
            if constexpr (Sched::DYN_A) { if (last) { const u32x4 q = *nvp; cvA[0][0] = q.x; cvA[0][1] = q.y; nx1[0] = q.z; nx1[1] = q.w; } }
            if constexpr (Epi::HOOK_T >= 0) { if (t == Epi::HOOK_T) E.mid(acc, cur, wr, wc, fr, fq); }
            PG8_LDB(B0, 0, 0); PG8_LDB(B1, 0, 1); PG8_SCHED; PG8_LDA(At, 0, 0); PG8_STAGE_A(PG8_SA(1, 1), a1, 1);
            if constexpr (Sched::DYN_A) { cvA[1][0] = nx1[0]; cvA[1][1] = nx1[1]; }
            PG8_WAIT_V(8); PG8_WAIT_L(0); PG8_BAR; PG8_MMA(0, 0, At, B0); PG8_MMA(0, 1, At, B1); PG8_BAR; PG8_SCHED;
            PG8_LDA(At, 0, 1); PG8_STAGE_B(PG8_SB(0, 0), b2, voffB); PG8_STAGE_B(PG8_SB(0, 1), b2 + hstep, voffB); PG8_STAGE_A(PG8_SA(0, 0), a2, 0);
            PG8_WAIT_V(8); PG8_WAIT_L(0); PG8_BAR; PG8_MMA(1, 0, At, B0); PG8_MMA(1, 1, At, B1); PG8_BAR; PG8_SCHED;
            PG8_LDB(B0, 1, 0); PG8_LDB(B1, 1, 1); PG8_SCHED; PG8_LDA(At, 1, 0); PG8_STAGE_A(PG8_SA(0, 1), a2, 1);
            PG8_WAIT_V(8); PG8_WAIT_L(0); PG8_BAR; PG8_MMA(0, 0, At, B0); PG8_MMA(0, 1, At, B1); PG8_BAR; PG8_SCHED;
            PG8_LDA(At, 1, 1); PG8_STAGE_B(PG8_SB(1, 0), b3, voffB); PG8_STAGE_B(PG8_SB(1, 1), b3 + hstep, voffB); PG8_STAGE_A(PG8_SA(1, 0), a3, 0);
            PG8_WAIT_V(8); PG8_WAIT_L(0); PG8_BAR; PG8_MMA(1, 0, At, B0); PG8_MMA(1, 1, At, B1); PG8_BAR; PG8_SCHED;
        }
        if constexpr (ALIGN_EPI) { if (wr == 0) PG8_BAR; }
        if constexpr (Epi::PREF) E.run(acc, cur, wr, wc, lds + LDS_PTAB + (ui & 1) * PTAB_BYTES); else E(acc, cur, wr, wc, fr, fq);
        if (!has_next) break;
        { float z0 = 0.f; asm volatile("" : "+v"(z0));
#pragma unroll
        for (int a = 0; a < 2; ++a)
#pragma unroll
            for (int b = 0; b < 2; ++b)
#pragma unroll
                for (int m = 0; m < 4; ++m)
#pragma unroll
                    for (int n = 0; n < 2; ++n) acc[a][b][m][n] = (f32x4){z0, z0, z0, z0}; }
        cur = nxt; cA = nA; cB = nB; ++ui;
        if constexpr (Epi::PREF) E.prefetch(cur, lds + LDS_PTAB + (ui & 1) * PTAB_BYTES, wv);
        if constexpr (ALIGN_EPI) { if (wr == 1) PG8_BAR; }
    }
    PG8_WAIT_V(0);
    if constexpr (!ALIGN_EPI) { if (wr == 0) PG8_BAR; }
    PG8_BAR;
#undef PG8_SA
#undef PG8_SB
#undef PG8_STAGE_
#undef PG8_STAGE_A
#undef PG8_STAGE_B
#undef PG8_LDA
#undef PG8_LDB
#undef PG8_MMA
#undef PG8_WAIT_V
#undef PG8_WAIT_L
#undef PG8_BAR
#undef PG8_SCHED
}

struct EpiBf16 {
    static constexpr bool PERM = true; static constexpr int HOOK_T = -1; static constexpr bool PREF = false;
    bf16_t* O; int ldc; const float* bias; int noepi; float scale;
    __device__ __forceinline__ void mid(f32x4 (&)[2][2][4][2], const Unit&, int, int, int, int) const {}
    __device__ __forceinline__ void operator()(const f32x4 (&acc)[2][2][4][2], const Unit& u, int wr, int wc, int fr, int fq) const {
        { const int l_ = tid_of(0); fr = l_ & 15; fq = l_ >> 4; }
        if (noepi) { if (acc[0][0][0][0][0] == 1.2345e-30f) O[0] = 0; return; }
        int row0 = u.row0 + wr * 64 + fr; asm volatile("" : "+v"(row0)); int col0 = u.pn * BM + wc * 32 + 8 * fq; asm volatile("" : "+v"(col0));
        f32x4 bv[2][2];
#pragma unroll
        for (int bj = 0; bj < 2; ++bj)
#pragma unroll
            for (int n = 0; n < 2; ++n) bv[bj][n] = bias ? *(const f32x4*)(bias + col0 + bj * HALF + 4 * n) : (f32x4){0.f, 0.f, 0.f, 0.f};
#pragma unroll
        for (int ai = 0; ai < 2; ++ai)
#pragma unroll
            for (int m = 0; m < 4; ++m) { bf16_t* rowp = O + (size_t)(row0 + ai * HALF + m * 16) * ldc + col0;
#pragma unroll
                for (int bj = 0; bj < 2; ++bj) { const f32x4 v0 = acc[ai][bj][m][0] * scale + bv[bj][0], v1 = acc[ai][bj][m][1] * scale + bv[bj][1];
                    u32x4 w; w.x = cvt_pk_bf16(v0[0], v0[1]); w.y = cvt_pk_bf16(v0[2], v0[3]); w.z = cvt_pk_bf16(v1[0], v1[1]); w.w = cvt_pk_bf16(v1[2], v1[3]);
                    *(u32x4*)(rowp + bj * HALF) = w; } }
    }
};
struct EpiZI8 {
    static constexpr bool PERM = true; static constexpr int HOOK_T = -1; static constexpr bool PREF = true;
    bf16_t* O; unsigned char* ZG; const unsigned char* wsb; unsigned rsc_off, csc_off;
    __device__ __forceinline__ void mid(f32x4 (&)[2][2][4][2], const Unit&, int, int, int, int) const {}
    __device__ __forceinline__ void prefetch(const Unit& u, LAS unsigned char* tab, int wv) const {
        const int t = tid_of(wv);
        const unsigned vo = (t < 256) ? (rsc_off + (unsigned)(u.row0 + t) * 4u) : (csc_off + (unsigned)(u.pn * BM + t - 256) * 4u);
        const __amdgpu_buffer_rsrc_t rs = __builtin_amdgcn_make_buffer_rsrc((void*)wsb, 0, 0xffffffff, 0x00020000);
        __builtin_amdgcn_raw_ptr_buffer_load_lds(rs, (LAS void*)(tab + wv * 256), 4, vo, 0, 0, 0);
    }
    __device__ __forceinline__ void run(const f32x4 (&acc)[2][2][4][2], const Unit& u, int wr, int wc, const LAS unsigned char* tab) const {
        int fr, fq; { const int l_ = tid_of(0); fr = l_ & 15; fq = l_ >> 4; }
        int row0 = u.row0 + wr * 64 + fr; asm volatile("" : "+v"(row0)); int col0 = u.pn * BM + wc * 32 + 8 * fq; asm volatile("" : "+v"(col0));
        const LAS float* tf = (const LAS float*)tab;
        f32x4 cs[2][2];
#pragma unroll
        for (int bj = 0; bj < 2; ++bj)
#pragma unroll
            for (int n = 0; n < 2; ++n) cs[bj][n] = *(const LAS f32x4*)(tf + 256 + bj * HALF + wc * 32 + 8 * fq + 4 * n);
#pragma unroll
        for (int ai = 0; ai < 2; ++ai)
#pragma unroll
            for (int m = 0; m < 4; ++m) { const int r = row0 + ai * HALF + m * 16; const float rs = tf[ai * HALF + wr * 64 + m * 16 + fr]; bf16_t* rowp = O + (size_t)r * NZ + col0;
#pragma unroll
                for (int bj = 0; bj < 2; ++bj) { const v4i32_t i0 = __builtin_bit_cast(v4i32_t, acc[ai][bj][m][0]), i1 = __builtin_bit_cast(v4i32_t, acc[ai][bj][m][1]);
                    const f32x4 v0 = (f32x4){(float)i0.x, (float)i0.y, (float)i0.z, (float)i0.w} * rs * cs[bj][0], v1 = (f32x4){(float)i1.x, (float)i1.y, (float)i1.z, (float)i1.w} * rs * cs[bj][1];
                    if (u.pn >= ZO_GL0 / BM) {
                        unsigned w0 = 0, w1 = 0;
#pragma unroll
                        for (int j = 0; j < 4; ++j) { w0 |= (unsigned)(int)rintf(255.0f * sigmoidf_(v0[j])) << (8 * j); w1 |= (unsigned)(int)rintf(255.0f * sigmoidf_(v1[j])) << (8 * j); }
                        *(u32x2*)(ZG + (size_t)r * 2048 + (col0 - ZO_GL0) + bj * HALF) = (u32x2){w0, w1};
                    } else {
                    u32x4 w; w.x = cvt_pk_bf16(v0[0], v0[1]); w.y = cvt_pk_bf16(v0[2], v0[3]); w.z = cvt_pk_bf16(v1[0], v1[1]); w.w = cvt_pk_bf16(v1[2], v1[3]);
                    *(u32x4*)(rowp + bj * HALF) = w; } } }
    }
    __device__ __forceinline__ void operator()(const f32x4 (&)[2][2][4][2], const Unit&, int, int, int, int) const {}
};
struct EpiMerged {
    static constexpr bool PERM = true; static constexpr int HOOK_T = 8; static constexpr bool PREF = false;
    bf16_t* O; const unsigned char* ZG;
    __device__ __forceinline__ void mid(f32x4 (&acc)[2][2][4][2], const Unit& u, int wr, int wc, int fr, int fq) const {
        { const int l_ = tid_of(0); fr = l_ & 15; fq = l_ >> 4; }
        int row0 = u.row0 + wr * 64 + fr; asm volatile("" : "+v"(row0)); int col0 = u.pn * BM + wc * 32 + 8 * fq; asm volatile("" : "+v"(col0));
        u32x2 g0[2][4][2], g1[2][4][2];
#pragma unroll
        for (int ai = 0; ai < 2; ++ai)
#pragma unroll
            for (int m = 0; m < 4; ++m) { const unsigned char* zr = ZG + (size_t)(row0 + ai * HALF + m * 16) * 2048 + col0;
#pragma unroll
                for (int bj = 0; bj < 2; ++bj) { g0[ai][m][bj] = *(const u32x2*)(zr + bj * HALF); g1[ai][m][bj] = *(const u32x2*)(zr + 1024 + bj * HALF); } }
#pragma unroll
        for (int ai = 0; ai < 2; ++ai)
#pragma unroll
            for (int m = 0; m < 4; ++m)
#pragma unroll
                for (int bj = 0; bj < 2; ++bj) {
                    const unsigned a0[2] = {g0[ai][m][bj].x, g0[ai][m][bj].y}, a1[2] = {g1[ai][m][bj].x, g1[ai][m][bj].y};
#pragma unroll
                    for (int n = 0; n < 2; ++n)
#pragma unroll
                        for (int j = 0; j < 4; ++j) { const float u0 = fmaxf((float)((a0[n] >> (8 * j)) & 0xffu), 1.0f), u1 = (float)((a1[n] >> (8 * j)) & 0xffu);
                            acc[ai][bj][m][n][j] *= u1 * __builtin_amdgcn_rcpf(u0); } }
    }
    __device__ __forceinline__ void operator()(const f32x4 (&acc)[2][2][4][2], const Unit& u, int wr, int wc, int fr, int fq) const {
        { const int l_ = tid_of(0); fr = l_ & 15; fq = l_ >> 4; }
        int row0 = u.row0 + wr * 64 + fr; asm volatile("" : "+v"(row0)); int col0 = u.pn * BM + wc * 32 + 8 * fq; asm volatile("" : "+v"(col0));
        u32x2 g0[2][4][2];
#pragma unroll
        for (int ai = 0; ai < 2; ++ai)
#pragma unroll
            for (int m = 0; m < 4; ++m) { const unsigned char* zr = ZG + (size_t)(row0 + ai * HALF + m * 16) * 2048 + col0;
#pragma unroll
                for (int bj = 0; bj < 2; ++bj) g0[ai][m][bj] = *(const u32x2*)(zr + bj * HALF); }
#pragma unroll
        for (int ai = 0; ai < 2; ++ai)
#pragma unroll
            for (int m = 0; m < 4; ++m) { bf16_t* orow = O + (size_t)(row0 + ai * HALF + m * 16) * D + col0;
#pragma unroll
                for (int bj = 0; bj < 2; ++bj) { const unsigned a0[2] = {g0[ai][m][bj].x, g0[ai][m][bj].y};
                    float o[8];
#pragma unroll
                    for (int n = 0; n < 2; ++n)
#pragma unroll
                        for (int j = 0; j < 4; ++j) o[4 * n + j] = acc[ai][bj][m][n][j] * (fmaxf((float)((a0[n] >> (8 * j)) & 0xffu), 1.0f) * (1.0f / 255.0f));
                    u32x4 w; w.x = cvt_pk_bf16(o[0], o[1]); w.y = cvt_pk_bf16(o[2], o[3]); w.z = cvt_pk_bf16(o[4], o[5]); w.w = cvt_pk_bf16(o[6], o[7]);
                    *(u32x4*)(orow + bj * HALF) = w; } }
    }
};
struct EpiResid {
    static constexpr bool PERM = true; static constexpr int HOOK_T = -1; static constexpr bool PREF = false;
    bf16_t* X; bf16_t* XO; const float* gate;
    __device__ __forceinline__ void mid(f32x4 (&)[2][2][4][2], const Unit&, int, int, int, int) const {}
    __device__ __forceinline__ void operator()(const f32x4 (&acc)[2][2][4][2], const Unit& u, int wr, int wc, int fr, int fq) const {
        { const int l_ = tid_of(0); fr = l_ & 15; fq = l_ >> 4; }
        int row0 = u.row0 + wr * 64 + fr; asm volatile("" : "+v"(row0)); int col0 = u.pn * BM + wc * 32 + 8 * fq; asm volatile("" : "+v"(col0));
        const float* gp = gate + (size_t)(u.row0 / SEQ) * (6 * D) + col0;
        f32x4 gv[2][2];
#pragma unroll
        for (int bj = 0; bj < 2; ++bj)
#pragma unroll
            for (int n = 0; n < 2; ++n) gv[bj][n] = *(const f32x4*)(gp + bj * HALF + 4 * n);
#pragma unroll
        for (int ai = 0; ai < 2; ++ai) {
            u32x4 xv[4][2];
#pragma unroll
            for (int m = 0; m < 4; ++m) { const bf16_t* rowp = X + (size_t)(row0 + ai * HALF + m * 16) * D + col0;
#pragma unroll
                for (int bj = 0; bj < 2; ++bj) xv[m][bj] = *(const u32x4*)(rowp + bj * HALF); }
#pragma unroll
            for (int m = 0; m < 4; ++m) { bf16_t* rowo = XO + (size_t)(row0 + ai * HALF + m * 16) * D + col0;
#pragma unroll
                for (int bj = 0; bj < 2; ++bj) { const u32x4 p = xv[m][bj];
                    const f32x4 o0 = (f32x4){bflo(p.x), bfhi(p.x), bflo(p.y), bfhi(p.y)} + gv[bj][0] * acc[ai][bj][m][0], o1 = (f32x4){bflo(p.z), bfhi(p.z), bflo(p.w), bfhi(p.w)} + gv[bj][1] * acc[ai][bj][m][1];
                    u32x4 w; w.x = cvt_pk_bf16(o0[0], o0[1]); w.y = cvt_pk_bf16(o0[2], o0[3]); w.z = cvt_pk_bf16(o1[0], o1[1]); w.w = cvt_pk_bf16(o1[2], o1[3]);
                    *(u32x4*)(rowo + bj * HALF) = w; } }
            asm volatile("" ::: "memory"); }
    }
};
struct EpiSwiglu {
    static constexpr bool PERM = true; static constexpr int HOOK_T = -1; static constexpr bool PREF = true;
    unsigned char* ACT; const float* bias; float wscale;
    __device__ __forceinline__ void mid(f32x4 (&)[2][2][4][2], const Unit&, int, int, int, int) const {}
    __device__ __forceinline__ void operator()(const f32x4 (&)[2][2][4][2], const Unit&, int, int, int, int) const {}
    __device__ __forceinline__ void prefetch(const Unit& u, LAS unsigned char* tab, int wv) const {
        const int t = tid_of(wv) & 255;
        const __amdgpu_buffer_rsrc_t rs = __builtin_amdgcn_make_buffer_rsrc((void*)bias, 0, 0xffffffff, 0x00020000);
        __builtin_amdgcn_raw_ptr_buffer_load_lds(rs, (LAS void*)(tab + (wv & 3) * 256), 4, (unsigned)(u.e * 2048 + (t >> 7) * 1024 + u.pn * HALF + (t & 127)) * 4u, 0, 0, 0);
    }
    __device__ __forceinline__ void run(const f32x4 (&acc)[2][2][4][2], const Unit& u, int wr, int wc, const LAS unsigned char* tab) const {
        int fr, fq; { const int l_ = tid_of(0); fr = l_ & 15; fq = l_ >> 4; }
        int row0 = u.row0 + wr * 64 + fr; asm volatile("" : "+v"(row0)); int cc = u.pn * HALF + wc * 32 + 8 * fq; asm volatile("" : "+v"(cc));
        const LAS float* tf = (const LAS float*)tab + wc * 32 + 8 * fq;
        f32x4 bg[2], bu[2];
#pragma unroll
        for (int n = 0; n < 2; ++n) { bg[n] = *(const LAS f32x4*)(tf + 4 * n); bu[n] = *(const LAS f32x4*)(tf + HALF + 4 * n); }
#pragma unroll
        for (int ai = 0; ai < 2; ++ai)
#pragma unroll
            for (int m = 0; m < 4; ++m) { unsigned char* rowp = ACT + (size_t)(row0 + ai * HALF + m * 16) * D + cc;
                float o[8];
#pragma unroll
                for (int n = 0; n < 2; ++n)
#pragma unroll
                    for (int j = 0; j < 4; ++j) { float g = acc[ai][0][m][n][j] * wscale + bg[n][j], up = acc[ai][1][m][n][j] * wscale + bu[n][j];
                        g = fminf(g, 7.0f); up = fminf(fmaxf(up, -7.0f), 7.0f);
                        o[4 * n + j] = g * sigmoidf_(1.702f * g) * (up + 1.0f); }
                int w0 = 0, w1 = 0;
                w0 = __builtin_amdgcn_cvt_pk_fp8_f32(o[0], o[1], w0, false); w0 = __builtin_amdgcn_cvt_pk_fp8_f32(o[2], o[3], w0, true);
                w1 = __builtin_amdgcn_cvt_pk_fp8_f32(o[4], o[5], w1, false); w1 = __builtin_amdgcn_cvt_pk_fp8_f32(o[6], o[7], w1, true);
                *(u32x2*)rowp = (u32x2){(unsigned)w0, (unsigned)w1}; }
    }
};
struct EpiMoeOut {
    static constexpr bool PERM = true; static constexpr int HOOK_T = -1; static constexpr bool PREF = true;
    unsigned char* O; float* SC; const float* bias; float wscale;
    __device__ __forceinline__ void mid(f32x4 (&)[2][2][4][2], const Unit&, int, int, int, int) const {}
    __device__ __forceinline__ void operator()(const f32x4 (&)[2][2][4][2], const Unit&, int, int, int, int) const {}
    __device__ __forceinline__ void prefetch(const Unit& u, LAS unsigned char* tab, int wv) const {
        const int t = tid_of(wv) & 255;
        const __amdgpu_buffer_rsrc_t rs = __builtin_amdgcn_make_buffer_rsrc((void*)bias, 0, 0xffffffff, 0x00020000);
        __builtin_amdgcn_raw_ptr_buffer_load_lds(rs, (LAS void*)(tab + (wv & 3) * 256), 4, (unsigned)(u.e * D + u.pn * BM + t) * 4u, 0, 0, 0);
    }
    __device__ __forceinline__ void run(const f32x4 (&acc)[2][2][4][2], const Unit& u, int wr, int wc, const LAS unsigned char* tab) const {
        int fr, fq; int lane_; { lane_ = tid_of(0); fr = lane_ & 15; fq = lane_ >> 4; }
        int row0 = u.row0 + wr * 64 + fr; asm volatile("" : "+v"(row0)); int col0 = u.pn * BM + wc * 32 + 8 * fq; asm volatile("" : "+v"(col0));
        const LAS float* tf = (const LAS float*)tab;
        f32x4 bv[2][2];
#pragma unroll
        for (int bj = 0; bj < 2; ++bj)
#pragma unroll
            for (int n = 0; n < 2; ++n) bv[bj][n] = *(const LAS f32x4*)(tf + bj * HALF + wc * 32 + 8 * fq + 4 * n);
#pragma unroll
        for (int ai = 0; ai < 2; ++ai)
#pragma unroll
            for (int m = 0; m < 4; ++m) { const size_t r = (size_t)(row0 + ai * HALF + m * 16);
                f32x4 v[2][2]; float am = 1e-30f;
#pragma unroll
                for (int bj = 0; bj < 2; ++bj)
#pragma unroll
                    for (int n = 0; n < 2; ++n) { v[bj][n] = acc[ai][bj][m][n] * wscale + bv[bj][n];
                        am = fmaxf(am, fmaxf(fmaxf(fabsf(v[bj][n].x), fabsf(v[bj][n].y)), fmaxf(fabsf(v[bj][n].z), fabsf(v[bj][n].w)))); }
                am = fmaxf(am, shflx(am, 16, lane_)); am = fmaxf(am, shflx(am, 32, lane_));
                const float inv = 127.0f * __builtin_amdgcn_rcpf(am) * 0.999f;
                if (fq == 0) SC[r * 16 + wc * 4 + u.pn] = am * (1.0f / (127.0f * 0.999f));
#pragma unroll
                for (int bj = 0; bj < 2; ++bj) { unsigned w0 = 0, w1 = 0;
#pragma unroll
                    for (int j = 0; j < 4; ++j) { w0 |= (unsigned)((int)rintf(v[bj][0][j] * inv) + 128) << (8 * j); w1 |= (unsigned)((int)rintf(v[bj][1][j] * inv) + 128) << (8 * j); }
                    *(u32x2*)(O + r * D + col0 + bj * HALF) = (u32x2){w0, w1}; } }
    }
};
}

#define XB_TMO      128
#define XB_XCNT(j)  (256  + 64 * (j))
#define XB_XSUB(j)  (1280 + 64 * (j))
#define XB_XGEN(j)  (2304 + 64 * (j))
#define XB_TOP      3328
#define XB_TOPGEN   3392
#define XCD_BAR_WORDS 3456
#define XB_SPIN_CAP (1u << 18)
__device__ __forceinline__ unsigned xb_ld(unsigned* p)              { return __hip_atomic_load(p, __ATOMIC_RELAXED, __HIP_MEMORY_SCOPE_AGENT); }
__device__ __forceinline__ unsigned xb_add(unsigned* p, unsigned v) { return __hip_atomic_fetch_add(p, v, __ATOMIC_RELAXED, __HIP_MEMORY_SCOPE_AGENT); }
__device__ __forceinline__ unsigned xb_xcc_id() { return (unsigned)__builtin_amdgcn_s_getreg((3 << 11) | 20) & 0xFu; }
#define XB_SPIN(cond, bar) do { unsigned _sp = 0; while (cond) { __builtin_amdgcn_s_sleep(1); \
    if ((++_sp & 255u) == 0u) { if (xb_ld(&(bar)[XB_TMO])) break; if (_sp > XB_SPIN_CAP) { atomicAdd(&(bar)[XB_TMO], 1u); break; } } } } while (0)
struct XcdBarrier { unsigned* bar; unsigned x; volatile LAS unsigned* st; int wv; };
__device__ __forceinline__ XcdBarrier xcd_barrier_post(unsigned* bar, volatile LAS unsigned* st, int wv) {
    XcdBarrier b; b.bar = bar; b.x = xb_xcc_id(); b.st = st; b.wv = wv;
    if (tid_of(wv) == 0) (void)xb_add(&bar[XB_XCNT(b.x)], 1u);
    return b;
}
__device__ __forceinline__ void xcd_barrier_complete(unsigned* bar, unsigned x, unsigned& nloc, unsigned& nx) {
    const unsigned G = gridDim.x * gridDim.y * gridDim.z;
    unsigned sum, cnt, mine, sp = 0u;
    for (;;) {
        sum = 0u; cnt = 0u; mine = 0u;
#pragma unroll
        for (unsigned j = 0; j < 16; ++j) { const unsigned c = xb_ld(&bar[XB_XCNT(j)]); sum += c; cnt += (c > 0u) ? 1u : 0u; mine = (j == x) ? c : mine; }
        if (sum == G) break;
        __builtin_amdgcn_s_sleep(1);
        if ((++sp & 255u) == 0u) { if (xb_ld(&bar[XB_TMO])) break; if (sp > XB_SPIN_CAP) { atomicAdd(&bar[XB_TMO], 1u); break; } }
    }
    nloc = mine > 0u ? mine : 1u; nx = cnt > 0u ? cnt : 1u;
}
__device__ __forceinline__ void xcd_barrier(const XcdBarrier& b) {
    asm volatile("s_waitcnt vmcnt(0)" ::: "memory");
    __syncthreads();
    if (tid_of(b.wv) == 0) {
        size_t zb = 0; asm volatile("" : "+s"(zb)); unsigned* bar = b.bar + zb; unsigned bx = b.x; asm volatile("" : "+s"(bx));
        __builtin_amdgcn_s_waitcnt(0);
        unsigned nloc = b.st[0], nx = b.st[1];
        if (nloc == 0u) { xcd_barrier_complete(bar, bx, nloc, nx); b.st[0] = nloc; b.st[1] = nx; }
        const unsigned old = xb_add(&bar[XB_XSUB(bx)], 1u);
        const unsigned gen = old / nloc;
        if (old + 1u == (gen + 1u) * nloc) {
            __builtin_amdgcn_fence(__ATOMIC_RELEASE, "agent");
            asm volatile("s_waitcnt vmcnt(0)" ::: "memory");
            const unsigned og = xb_add(&bar[XB_TOP], 1u);
            const unsigned tg = og / nx;
            if (og + 1u == (tg + 1u) * nx) xb_add(&bar[XB_TOPGEN], 1u);
            else XB_SPIN(xb_ld(&bar[XB_TOPGEN]) == tg, bar);
            __builtin_amdgcn_fence(__ATOMIC_ACQUIRE, "agent");
            xb_add(&bar[XB_XGEN(bx)], 1u);
            asm volatile("s_waitcnt vmcnt(0)" ::: "memory");
        } else {
            XB_SPIN(xb_ld(&bar[XB_XGEN(bx)]) == gen, bar);
            __builtin_amdgcn_fence(__ATOMIC_ACQUIRE, "agent");
            asm volatile("s_waitcnt vmcnt(0)" ::: "memory");
        }
    }
    __syncthreads();
}

struct Args { const float* in[26]; float* out; unsigned char* ws; int ph_lo, ph_hi; };
enum { I_X = 0, I_C, I_N1G, I_N2G, I_WADA, I_BADA, I_WIN, I_CONVW, I_CONVB, I_WRGA, I_BRGA, I_WRGX, I_BRGX, I_LAM, I_WPOOL, I_PSCALE, I_WUPA, I_WUPB, I_WOUT, I_WROUTER, I_BROUTER, I_WEIN, I_BEIN, I_WEOUT, I_BEOUT, I_FINALG };

template <int ROWMODE>
__device__ __forceinline__ void tr_item(const float* W, int N, bf16_t* WT, int dst_ld, int dst_off, int k0, int n0, LAS float* scr, int lane) {
    { float tv[32];
#pragma unroll
    for (int i = 0; i < 32; ++i) tv[i] = W[(size_t)(k0 + 2 * i + (lane >> 5)) * N + n0 + (lane & 31)];
#pragma unroll
    for (int i = 0; i < 32; ++i) scr[(2 * i + (lane >> 5)) * 33 + (lane & 31)] = tv[i]; }
    LDS_WAIT();
    const int c = lane & 7;
#pragma unroll
    for (int j = 0; j < 4; ++j) { const int n = (lane >> 3) + 8 * j; const LAS float* s = scr + (8 * c) * 33 + n;
        u32x4 o; o.x = cvt_pk_bf16(s[0 * 33], s[1 * 33]); o.y = cvt_pk_bf16(s[2 * 33], s[3 * 33]); o.z = cvt_pk_bf16(s[4 * 33], s[5 * 33]); o.w = cvt_pk_bf16(s[6 * 33], s[7 * 33]);
        const int nn = n0 + n; int drow = nn;
        if (ROWMODE == 1) { drow = (nn < 1024) ? (256 * (nn >> 7) + (nn & 127)) : (256 * ((nn - 1024) >> 7) + 128 + ((nn - 1024) & 127)); }
        *(u32x4*)(WT + (size_t)drow * dst_ld + dst_off + k0 + 8 * c) = o; }
    LDS_WAIT();
}
template <int ROWMODE>
__device__ __forceinline__ void tr_item_fp8(const float* W, int N, unsigned char* WT, int k0, int n0, LAS float* scr, int lane) {
    { float tv[64];
#pragma unroll
    for (int i = 0; i < 64; ++i) tv[i] = W[(size_t)(k0 + 2 * i + (lane >> 5)) * N + n0 + (lane & 31)];
#pragma unroll
    for (int i = 0; i < 64; ++i) scr[(2 * i + (lane >> 5)) * 33 + (lane & 31)] = tv[i]; }
    LDS_WAIT();
    const int c = lane & 7;
#pragma unroll
    for (int j = 0; j < 4; ++j) { const int n = (lane >> 3) + 8 * j; const LAS float* s = scr + (16 * c) * 33 + n;
        int o[4];
#pragma unroll
        for (int q = 0; q < 4; ++q) { int w = 0; w = __builtin_amdgcn_cvt_pk_fp8_f32(s[(4 * q) * 33] * WEIN_SCALE, s[(4 * q + 1) * 33] * WEIN_SCALE, w, false);
            w = __builtin_amdgcn_cvt_pk_fp8_f32(s[(4 * q + 2) * 33] * WEIN_SCALE, s[(4 * q + 3) * 33] * WEIN_SCALE, w, true); o[q] = w; }
        const int nn = n0 + n; const int drow = (ROWMODE == 0) ? nn : ((nn < 1024) ? (256 * (nn >> 7) + (nn & 127)) : (256 * ((nn - 1024) >> 7) + 128 + ((nn - 1024) & 127)));
        *(u32x4*)(WT + (size_t)drow * 1024 + k0 + 16 * c) = (u32x4){(unsigned)o[0], (unsigned)o[1], (unsigned)o[2], (unsigned)o[3]}; }
    LDS_WAIT();
}
template <int ROWMODE>
__device__ __forceinline__ void tr_job(int item, const float* src, int K, int N, bf16_t* dst, size_t dst_bstride, int dst_ld, int dst_off, LAS float* scr, int lane) {
    const int nnb = N / 32, nkb = K / 64; const int nb = item % nnb; const int r = item / nnb; const int kb = r % nkb; const int bt = r / nkb;
    tr_item<ROWMODE>(src + (size_t)bt * K * N, N, dst + (size_t)bt * dst_bstride, dst_ld, dst_off, 64 * kb, 32 * nb, scr, lane);
}

constexpr int CONV_Q1 = 5, CONV_Q2 = 6;
constexpr int CONV_ITEMS_L = NE * 8 * 64 + NE * 8 * 32, CONV_CHUNKS_L = CONV_ITEMS_L / 8;
__device__ __forceinline__ void conv_expert_item(const Args& a, unsigned char* ws, int l, int r, LAS float* scr, int lane) {
    if (r < NE * 8 * 64) { const int nb = r % 64, r2 = r / 64, kb = r2 % 8, bt = l * NE + r2 / 8;
        tr_item_fp8<1>(a.in[I_WEIN] + (size_t)bt * 1024 * 2048, 2048, (unsigned char*)(ws + WS_WEIN) + (size_t)bt * 2048 * 1024, 128 * kb, 32 * nb, scr, lane); }
    else { r -= NE * 8 * 64; const int nb = r % 32, r2 = r / 32, kb = r2 % 8, bt = l * NE + r2 / 8;
        tr_item_fp8<0>(a.in[I_WEOUT] + (size_t)bt * 1024 * 1024, 1024, (unsigned char*)(ws + WS_WEOUT) + (size_t)bt * 1024 * 1024, 128 * kb, 32 * nb, scr, lane); }
}
__device__ __forceinline__ void conv_drain(const Args& a, int l, int budget, LAS unsigned char* lds, const int wv) {
    asm volatile("" : "+s"(lds));
    int tid_ = tid_of(wv); asm volatile("" : "+v"(tid_)); const int tid = tid_, lane = tid & 63;
    unsigned char* ws = opaque_ptr(a.ws); unsigned* head = (unsigned*)(ws + WS_CTL) + CW_CONVQ + 64 * l;
    LAS float* scr = (LAS float*)(lds + wv * 16896); LAS int* slot = (LAS int*)(lds + LDS_BYTES - 512);
    for (;;) {
        if (budget == 0) break;
        __syncthreads();
        if (tid == 0) *slot = (int)__hip_atomic_fetch_add(head, 1u, __ATOMIC_RELAXED, __HIP_MEMORY_SCOPE_AGENT);
        __syncthreads();
        const int c = __builtin_amdgcn_readfirstlane(*slot);
        if (c >= CONV_CHUNKS_L) break;
        conv_expert_item(a, ws, l, c * 8 + wv, scr, lane);
        if (budget > 0) --budget;
    }
    __syncthreads();
}
__device__ __forceinline__ void phase_prologue(const Args& a, LAS unsigned char* lds, const int wv) {
    asm volatile("" : "+s"(lds));
    int tid_ = tid_of(wv); asm volatile("" : "+v"(tid_)); const int tid = tid_, lane = tid & 63, wave = __builtin_amdgcn_readfirstlane(tid >> 6);
    const int G = gridDim.x;
    unsigned char* ws = opaque_ptr(a.ws); const int bid = opaque_bid();
    {
        LAS float* cact = (LAS float*)lds;
        LAS float* red = (LAS float*)(lds + 32768);
        for (int i = tid; i < NBATCH * D; i += NTHREADS) { const float v = a.in[I_C][i]; cact[i] = v * sigmoidf_(v); }
        __syncthreads();
        float* mod = (float*)(ws + WS_MOD);
        for (int u = bid; u < DEPTH * 96; u += G) {
            const int l = u / 96, cg = u % 96; const int n = cg * 64 + lane;
            const float* w = a.in[I_WADA] + (size_t)l * D * 6144 + n;
            float acc[8] = {0.f, 0.f, 0.f, 0.f, 0.f, 0.f, 0.f, 0.f};
            const int kb = wave * 128;
#pragma unroll 8
            for (int k = 0; k < 128; ++k) { const float wv = w[(size_t)(kb + k) * 6144];
#pragma unroll
                for (int b = 0; b < 8; ++b) acc[b] += cact[b * D + kb + k] * wv; }
#pragma unroll
            for (int b = 0; b < 8; ++b) red[(wave * 8 + b) * 64 + lane] = acc[b];
            __syncthreads();
            { const int b = tid >> 6; float s = 0.f;
#pragma unroll
              for (int w8 = 0; w8 < 8; ++w8) s += red[(w8 * 8 + b) * 64 + lane];
              mod[((size_t)l * NBATCH + b) * 6144 + n] = s + a.in[I_BADA][(size_t)l * 6144 + n]; }
            __syncthreads();
        }
    }
    {
        bf16_t* wrs = (bf16_t*)(ws + WS_WRS);
        for (int idx = bid * NTHREADS + tid; idx < DEPTH * D * NE; idx += G * NTHREADS) { const int e = idx & 31, k = (idx >> 5) & 1023, l = idx >> 15;
            const float w = a.in[I_WROUTER][idx]; const unsigned hi = cvt_pk_bf16(w, 0.f) & 0xffffu; const unsigned lo = cvt_pk_bf16(w - bflo(hi), 0.f) & 0xffffu;
            wrs[((size_t)(l * 2 + 0) * NE + e) * D + k] = (bf16_t)hi; wrs[((size_t)(l * 2 + 1) * NE + e) * D + k] = (bf16_t)lo; }
    }
#if Z_I8
    {
        LAS float* tile = (LAS float*)lds; LAS float* red = (LAS float*)(lds + 1024 * 33 * 4);
        signed char* w8 = (signed char*)(ws + WS_WIN); float* wsc = (float*)(ws + WS_WINSC);
        __syncthreads();
        for (int u = bid; u < DEPTH * (NZ / 32); u += G) {
            const int l = u / (NZ / 32), n0 = (u % (NZ / 32)) * 32; const float* W = a.in[I_WIN] + (size_t)l * D * NZ + n0;
            const int n = tid & 31, kr = tid >> 5;
#pragma unroll 1
            for (int k0 = 0; k0 < 1024; k0 += 256) { float tv[16];
#pragma unroll
                for (int i = 0; i < 16; ++i) tv[i] = W[(size_t)(k0 + 16 * i + kr) * NZ + n];
#pragma unroll
                for (int i = 0; i < 16; ++i) tile[(k0 + 16 * i + kr) * 33 + n] = tv[i]; }
            __syncthreads();
            { float am = 0.f;
#pragma unroll 8
              for (int i = 0; i < 64; ++i) am = fmaxf(am, fabsf(tile[(kr * 64 + i) * 33 + n]));
              red[kr * 32 + n] = am; }
            __syncthreads();
            if (tid < 32) { float am = 1e-30f;
#pragma unroll
                for (int q = 0; q < 16; ++q) am = fmaxf(am, red[q * 32 + tid]);
                red[512 + tid] = 127.0f / am; wsc[(size_t)l * NZ + n0 + tid] = am * (1.0f / 127.0f); }
            __syncthreads();
            { const float inv = red[512 + n]; signed char* dst = w8 + ((size_t)l * NZ + n0 + n) * D + kr * 64;
#pragma unroll
              for (int c = 0; c < 4; ++c) { int w4[4];
#pragma unroll
                  for (int q = 0; q < 4; ++q) { int pk = 0;
#pragma unroll
                      for (int e = 0; e < 4; ++e) pk |= (((int)rintf(tile[(kr * 64 + c * 16 + q * 4 + e) * 33 + n] * inv)) & 0xff) << (8 * e);
                      w4[q] = pk; }
                  *(u32x4*)(dst + 16 * c) = (u32x4){(unsigned)w4[0], (unsigned)w4[1], (unsigned)w4[2], (unsigned)w4[3]}; } }
            __syncthreads();
        }
    }
#endif
    {
        LAS float* scr = (LAS float*)(lds + wave * 16896);
        const int gw = bid * NWAVES + wave, NGW = G * NWAVES;
        constexpr int I_EIN = NE * 8 * 64, I_EOUT = NE * 8 * 32, I_WINI = Z_I8 ? 0 : DEPTH * (Z_FP8 ? 8 : 16) * 144, I_UPA = DEPTH * 16 * 32, I_UPB = DEPTH * 8 * 32, I_OUT = DEPTH * 16 * 32,
                      I_RGA = DEPTH * 8 * 2 * 4, I_RGX = I_RGA, I_POOL = DEPTH * 4 * 2 * 4;
        constexpr int NITEMS = I_EIN + I_EOUT + I_WINI + I_UPA + I_UPB + I_OUT + I_RGA + I_RGX + I_POOL;
        for (int it = gw; it < NITEMS; it += NGW) {
            int r = it;
            if (r < I_EIN) { const int nb = r % 64, r2 = r / 64, kb = r2 % 8, bt = r2 / 8;
                tr_item_fp8<1>(a.in[I_WEIN] + (size_t)bt * 1024 * 2048, 2048, (unsigned char*)(ws + WS_WEIN) + (size_t)bt * 2048 * 1024, 128 * kb, 32 * nb, scr, lane); continue; } r -= I_EIN;
            if (r < I_EOUT) { const int nb = r % 32, r2 = r / 32, kb = r2 % 8, bt = r2 / 8;
                tr_item_fp8<0>(a.in[I_WEOUT] + (size_t)bt * 1024 * 1024, 1024, (unsigned char*)(ws + WS_WEOUT) + (size_t)bt * 1024 * 1024, 128 * kb, 32 * nb, scr, lane); continue; } r -= I_EOUT;
#if Z_I8
#elif Z_FP8
            if (r < I_WINI) { const int nb = r % 144, r2 = r / 144, kb = r2 % 8, bt = r2 / 8;
                tr_item_fp8<0>(a.in[I_WIN] + (size_t)bt * 1024 * NZ, NZ, (unsigned char*)(ws + WS_WIN) + (size_t)bt * NZ * 1024, 128 * kb, 32 * nb, scr, lane); continue; } r -= I_WINI;
#else
            if (r < I_WINI) { tr_job<0>(r, a.in[I_WIN], 1024, NZ, (bf16_t*)(ws + WS_WIN), (size_t)NZ * 1024, 1024, 0, scr, lane); continue; } r -= I_WINI;
#endif
            if (r < I_UPA) { tr_job<0>(r, a.in[I_WUPA], 1024, 1024, (bf16_t*)(ws + WS_WCAT), (size_t)1024 * KCAT, KCAT, 512, scr, lane); continue; } r -= I_UPA;
            if (r < I_UPB) { tr_job<0>(r, a.in[I_WUPB], 512, 1024, (bf16_t*)(ws + WS_WCAT), (size_t)1024 * KCAT, KCAT, 0, scr, lane); continue; } r -= I_UPB;
            if (r < I_OUT) { tr_job<0>(r, a.in[I_WOUT], 1024, 1024, (bf16_t*)(ws + WS_WOUT), (size_t)1024 * 1024, 1024, 0, scr, lane); continue; } r -= I_OUT;
            if (r < I_RGA) { tr_job<0>(r, a.in[I_WRGA], 128, 128, (bf16_t*)(ws + WS_WRG), (size_t)256 * 128, 128, 0, scr, lane); continue; } r -= I_RGA;
            if (r < I_RGX) { tr_job<0>(r, a.in[I_WRGX], 128, 128, (bf16_t*)(ws + WS_WRG) + 128 * 128, (size_t)256 * 128, 128, 0, scr, lane); continue; } r -= I_RGX;
            tr_job<0>(r, a.in[I_WPOOL], 128, 128, (bf16_t*)(ws + WS_WPOOL), (size_t)128 * 128, 128, 0, scr, lane);
        }
    }
}

struct MoeTab { LAS int* cnt; LAS int* padstart; LAS int* tilestart; LAS int* tab; };
__device__ __forceinline__ MoeTab moe_tab_ptrs(LAS unsigned char* lds) { MoeTab t; t.cnt = (LAS int*)(lds + LDS_TAB); t.padstart = t.cnt + 32; t.tilestart = t.padstart + 40; t.tab = t.tilestart + 40; return t; }
__device__ __forceinline__ void moe_tables(const Args& a, int l, LAS unsigned char* lds, const int wv) {
    asm volatile("" : "+s"(lds));
    const MoeTab mt = moe_tab_ptrs(lds); int tid_ = tid_of(wv); asm volatile("" : "+v"(tid_)); const int tid = tid_;
    unsigned* ctl = (unsigned*)(opaque_ptr(a.ws) + WS_CTL);
    __syncthreads();
    if (tid < NE) mt.cnt[tid] = (int)__hip_atomic_load(ctl + CW_CNT + (l * NE + tid) * 16, __ATOMIC_RELAXED, __HIP_MEMORY_SCOPE_AGENT);
    __syncthreads();
    if (tid == 0) { int ps = 0, ts = 0; for (int e = 0; e < NE; ++e) { mt.padstart[e] = ps; mt.tilestart[e] = ts; const int nt = (mt.cnt[e] + 255) >> 8; ps += nt * 256; ts += nt; } mt.padstart[NE] = ps; mt.tilestart[NE] = ts; }
    __syncthreads();
    const int nMt = mt.tilestart[NE];
    for (int m = tid; m < nMt; m += NTHREADS) { int e = 0; for (int q = 1; q < NE; ++q) e = (mt.tilestart[q] <= m) ? q : e; mt.tab[m] = (e << 16) | (m - mt.tilestart[e]); }
    __syncthreads();
}
struct MoeSched1 {
    static constexpr bool DYN_A = true;
    const char* H; const char* W; const int* tokof; MoeTab mt; int nMt, G, c;
    __device__ __forceinline__ bool next(int i, pg8::Unit& u) const { int pm, pn; if (!pg8::order_map(i, G, c, nMt, 8, pm, pn)) return false;
        const int en = __builtin_amdgcn_readfirstlane(mt.tab[pm]); u.pm = pm; u.pn = pn; u.e = en >> 16; u.j = en & 0xffff;
        u.row0 = __builtin_amdgcn_readfirstlane(mt.padstart[u.e]) + 256 * u.j; u.rows = __builtin_amdgcn_readfirstlane(mt.cnt[u.e]) - 256 * u.j; return true; }
    __device__ __forceinline__ const char* a_ptr() const { return H; }
    __device__ __forceinline__ const char* b_ptr() const { return W; }
    __device__ __forceinline__ unsigned a_off(const pg8::Unit&) const { return 0u; }
    __device__ __forceinline__ unsigned b_off(const pg8::Unit& u) const { return ((unsigned)u.e * 2048u + (unsigned)u.pn * 256u) * 1024u; }
    __device__ __forceinline__ void a_voff(const pg8::Unit& u, unsigned (&v)[2][2], int wv) const {
        int tid = tid_of(wv); asm volatile("" : "+v"(tid));
        const int* tl = tokof + (size_t)u.e * T + 256 * u.j; const int rmax = u.rows - 1;
#pragma unroll
        for (int i = 0; i < 2; ++i) { int R, C; pg8::stage_rc(tid * 16 + i * 8192, R, C);
#pragma unroll
            for (int h = 0; h < 2; ++h) { int idx = h * 128 + R; idx = idx < rmax ? idx : rmax; v[h][i] = (unsigned)tl[idx] * 1024u + (unsigned)C * 2u; } }
    }
};
struct MoeSched2 {
    static constexpr bool DYN_A = false;
    const char* ACT; const char* W; MoeTab mt; int nMt, G, c;
    __device__ __forceinline__ bool next(int i, pg8::Unit& u) const { int pm, pn; if (!pg8::order_map(i, G, c, nMt, 4, pm, pn)) return false;
        const int en = __builtin_amdgcn_readfirstlane(mt.tab[pm]); u.pm = pm; u.pn = pn; u.e = en >> 16; u.j = en & 0xffff;
        u.row0 = __builtin_amdgcn_readfirstlane(mt.padstart[u.e]) + 256 * u.j; u.rows = __builtin_amdgcn_readfirstlane(mt.cnt[u.e]) - 256 * u.j; return true; }
    __device__ __forceinline__ const char* a_ptr() const { return ACT; }
    __device__ __forceinline__ const char* b_ptr() const { return W; }
    __device__ __forceinline__ unsigned a_off(const pg8::Unit& u) const { return (unsigned)u.row0 * 1024u; }
    __device__ __forceinline__ unsigned b_off(const pg8::Unit& u) const { return ((unsigned)u.e * 1024u + (unsigned)u.pn * 256u) * 1024u; }
    __device__ __forceinline__ void a_voff(const pg8::Unit&, unsigned (&v)[2][2], int wv) const {
        int tid = tid_of(wv); asm volatile("" : "+v"(tid));
#pragma unroll
        for (int i = 0; i < 2; ++i) { int R, C; pg8::stage_rc(tid * 16 + i * 8192, R, C);
#pragma unroll
            for (int h = 0; h < 2; ++h) v[h][i] = (unsigned)((h * 128 + R) * 512 + C) * 2u; }
    }
};

__device__ __forceinline__ void phase_a(const Args& a, int l, LAS unsigned char* lds, bool dry, const int wv) {
    asm volatile("" : "+s"(lds));
    int tid_ = tid_of(wv); asm volatile("" : "+v"(tid_)); const int tid = tid_, lane = tid & 63, wave = __builtin_amdgcn_readfirstlane(tid >> 6);
    const int G = gridDim.x; unsigned char* ws = opaque_ptr(a.ws); const int bid = opaque_bid();
    const float* mod = (const float*)(ws + WS_MOD);
    bf16_t* xres = (bf16_t*)(ws + WS_XRES); bf16_t* xout = dry ? (bf16_t*)(ws + WS_Z) : xres;
    if (l < DEPTH && bid < NBATCH) {
        LAS float* red = (LAS float*)lds;
        const int b = bid, e = tid & 31, kp = tid >> 5;
        const float* sh2 = mod + ((size_t)l * NBATCH + b) * 6144 + 3 * D; const float* wr = a.in[I_WROUTER] + (size_t)l * D * NE;
        float s = 0.f;
        for (int k = kp * 64; k < kp * 64 + 64; ++k) s += sh2[k] * wr[k * NE + e];
        red[kp * 32 + e] = s;
        __syncthreads();
        if (tid < 32) { float t = a.in[I_BROUTER][l * NE + tid]; for (int q = 0; q < 16; ++q) t += red[q * 32 + tid]; ((float*)(ws + WS_CB))[(l * NBATCH + b) * NE + tid] = t; }
        __syncthreads();
    }
    if (l > 0) moe_tables(a, (l - 1) + DEPTH * (REPN(7) - 1), lds, wv);
    const MoeTab mt = moe_tab_ptrs(lds);
    const int* slotinfo = (const int*)(ws + WS_SLOTINFO); const float* wgt = (const float*)(ws + WS_WGT);
    const unsigned char* outb = (const unsigned char*)(ws + WS_OUTB); const float* outsc = (const float*)(ws + WS_OUTSC);
    unsigned char* hb = (unsigned char*)(ws + WS_H);
    for (int chunk = bid; chunk < T / 128; chunk += G) {
        const int rowb = chunk * 128 + wave * 16; const int b = rowb / SEQ;
        const float* xin = a.in[I_X] + (size_t)rowb * D; const bf16_t* xinb = xres + (size_t)rowb * D;
        f32x4 xv[2][4]; int4 si[4]; f32x4 wv[4]; unsigned gv[2][4][4]; f32x4 gs[2][4];
#define PA_SX(r, q) do { if ((r) < 16) { _Pragma("unroll") for (int j = 0; j < 4; ++j) { if (l == 0) xv[(q) & 1][j] = *(const f32x4*)(xin + (size_t)(r) * D + 4 * lane + 256 * j); \
            else { const f32x2 t_ = *(const f32x2*)(xinb + (size_t)(r) * D + 4 * lane + 256 * j); xv[(q) & 1][j].x = t_.x; xv[(q) & 1][j].y = t_.y; } } } } while (0)
#define PA_S0(r, q) do { if ((r) < 16 && l > 0) { si[(q) & 3] = *(const int4*)(slotinfo + (size_t)(rowb + (r)) * 4); wv[(q) & 3] = *(const f32x4*)(wgt + (size_t)(rowb + (r)) * 4); } } while (0)
#define PA_S1(r, q) do { if ((r) < 16 && l > 0) { const int sl_[4] = {si[(q) & 3].x, si[(q) & 3].y, si[(q) & 3].z, si[(q) & 3].w}; \
            _Pragma("unroll") for (int kk = 0; kk < 4; ++kk) { const int e_ = sl_[kk] >> 24, li_ = sl_[kk] & 0xffffff; const size_t slot_ = (size_t)(mt.padstart[e_] + li_); const unsigned char* orow = outb + slot_ * D + 4 * lane; \
                gs[(q) & 1][kk] = *(const f32x4*)(outsc + slot_ * 16 + ((lane >> 3) & 3) * 4); \
                _Pragma("unroll") for (int j = 0; j < 4; ++j) gv[(q) & 1][kk][j] = *(const unsigned*)(orow + 256 * j); } } } while (0)
        PA_S0(0, 0); PA_S0(1, 1); PA_SX(0, 0); PA_S1(0, 0);
#pragma unroll 1
        for (int i0 = 0; i0 < 16; i0 += 4) {
#pragma unroll
          for (int ii = 0; ii < 4; ++ii) {
            const int i = i0 + ii; const int row = rowb + i;
            PA_S0(i + 2, ii + 2); PA_SX(i + 1, ii + 1); PA_S1(i + 1, ii + 1);
            f32x4 v[4];
#pragma unroll
            for (int j = 0; j < 4; ++j) { v[j] = xv[ii & 1][j];
                if (l > 0) { const unsigned p0 = __float_as_uint(v[j].x), p1 = __float_as_uint(v[j].y); v[j] = (f32x4){bflo(p0), bfhi(p0), bflo(p1), bfhi(p1)}; } }
            if (l > 0) {
                f32x4 y[4];
#pragma unroll
                for (int j = 0; j < 4; ++j) y[j] = (f32x4){0.f, 0.f, 0.f, 0.f};
#pragma unroll
                for (int kk = 0; kk < 4; ++kk) { const f32x4 ws4 = gs[ii & 1][kk] * wv[ii][kk];
#pragma unroll
                    for (int j = 0; j < 4; ++j) { const unsigned p = gv[ii & 1][kk][j];
                        y[j] += ws4[j] * ((f32x4){(float)(p & 0xffu), (float)((p >> 8) & 0xffu), (float)((p >> 16) & 0xffu), (float)(p >> 24)} - 128.0f); } }
                const float* g2 = mod + ((size_t)(l - 1) * NBATCH + b) * 6144 + 5 * D + 4 * lane;
#pragma unroll
                for (int j = 0; j < 4; ++j) v[j] += *(const f32x4*)(g2 + 256 * j) * y[j];
            }
            if (l < DEPTH) {
#pragma unroll
                for (int j = 0; j < 4; ++j) { u32x2 p; p.x = cvt_pk_bf16(v[j].x, v[j].y); p.y = cvt_pk_bf16(v[j].z, v[j].w); *(u32x2*)(xout + (size_t)row * D + 4 * lane + 256 * j) = p; }
            }
            float ss = 0.f;
#pragma unroll
            for (int j = 0; j < 4; ++j) ss += (v[j].x * v[j].x + v[j].y * v[j].y) + (v[j].z * v[j].z + v[j].w * v[j].w);
            const float rinv = __builtin_amdgcn_rsqf(wave_sum(ss, lane) * (1.0f / D) + NORM_EPS);
            if (l < DEPTH) {
                const float* ng = a.in[I_N1G] + (size_t)l * D + 4 * lane; const float* mb = mod + ((size_t)l * NBATCH + b) * 6144 + 4 * lane;
                f32x4 hq[4]; (void)hq;
#pragma unroll
                for (int j = 0; j < 4; ++j) { const f32x4 g = *(const f32x4*)(ng + 256 * j), sh = *(const f32x4*)(mb + 256 * j), sc = *(const f32x4*)(mb + D + 256 * j);
                    const f32x4 h = (v[j] * rinv * g) * (1.0f + sc) + sh;
#if Z_I8
                    hq[j] = h; }
                {   float am = 0.f;
#pragma unroll
                    for (int j = 0; j < 4; ++j) am = fmaxf(fmaxf(fmaxf(fabsf(hq[j].x), fabsf(hq[j].y)), fmaxf(fabsf(hq[j].z), fabsf(hq[j].w))), am);
#pragma unroll
                    for (int o = 1; o < 64; o <<= 1) am = fmaxf(am, shflx(am, o, lane));
                    am = fmaxf(am, 1e-20f); const float inv = 127.0f / am;
                    if (lane == 0) ((float*)(ws + WS_HSC))[row] = am * (1.0f / 127.0f);
#pragma unroll
                    for (int j = 0; j < 4; ++j) { const int q0 = (int)rintf(hq[j].x * inv), q1 = (int)rintf(hq[j].y * inv), q2 = (int)rintf(hq[j].z * inv), q3 = (int)rintf(hq[j].w * inv);
                        *(int*)(hb + (size_t)row * D + 4 * lane + 256 * j) = (q0 & 0xff) | ((q1 & 0xff) << 8) | ((q2 & 0xff) << 16) | ((q3 & 0xff) << 24); }
                }
#elif Z_FP8
                    int p = 0; p = __builtin_amdgcn_cvt_pk_fp8_f32(h.x, h.y, p, false); p = __builtin_amdgcn_cvt_pk_fp8_f32(h.z, h.w, p, true);
                    *(int*)(hb + (size_t)row * D + 4 * lane + 256 * j) = p; }
#else
                    u32x2 p; p.x = cvt_pk_bf16(h.x, h.y); p.y = cvt_pk_bf16(h.z, h.w); *(u32x2*)((bf16_t*)hb + (size_t)row * D + 4 * lane + 256 * j) = p; }
#endif
            } else {
                const float* fg = a.in[I_FINALG] + 4 * lane;
#pragma unroll
                for (int j = 0; j < 4; ++j) *(f32x4*)(a.out + (size_t)row * D + 4 * lane + 256 * j) = v[j] * rinv * *(const f32x4*)(fg + 256 * j);
            }
          }
        }
#undef PA_S0
#undef PA_SX
#undef PA_S1
    }
}

__device__ __forceinline__ void phase_h(const Args& a, int l, int cset, LAS unsigned char* lds, const int wv) {
    asm volatile("" : "+s"(lds));
    int tid_ = tid_of(wv); asm volatile("" : "+v"(tid_)); const int tid = tid_, lane = tid & 63, wave = __builtin_amdgcn_readfirstlane(tid >> 6);
    const int G = gridDim.x; unsigned char* ws = opaque_ptr(a.ws); const int bid = opaque_bid();
    const float* mod = (const float*)(ws + WS_MOD); const bf16_t* xres = (const bf16_t*)(ws + WS_XRES);
    unsigned char* h8 = (unsigned char*)(ws + WS_H);
    LAS float* rinvs = (LAS float*)lds;
    LAS float* lgt = (LAS float*)(lds + 1024);
    LAS int* hist = (LAS int*)(lds + 1024 + 8 * 16 * 33 * 4);
    LAS int* base = hist + 32;
    unsigned* ctl = (unsigned*)(ws + WS_CTL);
    const float* ng = a.in[I_N2G] + (size_t)l * D;
    const float* cbv = (const float*)(ws + WS_CB);
    int* tokof = (int*)(ws + WS_TOKOF); int* slotinfo = (int*)(ws + WS_SLOTINFO); float* wgt = (float*)(ws + WS_WGT);
    for (int chunk = bid; chunk < T / 128; chunk += G) {
        const int row0 = chunk * 128 + wave * 16; const int b = row0 / SEQ;
        const float* mb = mod + ((size_t)l * NBATCH + b) * 6144 + 3 * D;
        if (tid < 32) hist[tid] = 0;
        u32x2 xq[3][4];
#pragma unroll
        for (int r = 0; r < 2; ++r)
#pragma unroll
            for (int j = 0; j < 4; ++j) xq[r][j] = *(const u32x2*)(xres + (size_t)(row0 + r) * D + 4 * lane + 256 * j);
#pragma unroll
        for (int i = 0; i < 16; ++i) {
            const int row = row0 + i;
            if (i + 2 < 16) {
#pragma unroll
                for (int j = 0; j < 4; ++j) xq[(i + 2) % 3][j] = *(const u32x2*)(xres + (size_t)(row + 2) * D + 4 * lane + 256 * j); }
            f32x4 v[4]; float ss = 0.f;
#pragma unroll
            for (int j = 0; j < 4; ++j) { const u32x2 p = xq[i % 3][j]; v[j] = (f32x4){bflo(p.x), bfhi(p.x), bflo(p.y), bfhi(p.y)}; ss += (v[j].x * v[j].x + v[j].y * v[j].y) + (v[j].z * v[j].z + v[j].w * v[j].w); }
            const float rinv = __builtin_amdgcn_rsqf(wave_sum(ss, lane) * (1.0f / D) + NORM_EPS);
            if (lane == 0) rinvs[wave * 16 + i] = rinv;
#pragma unroll
            for (int j = 0; j < 4; ++j) { const f32x4 g = *(const f32x4*)(ng + 4 * lane + 256 * j), sh = *(const f32x4*)(mb + 4 * lane + 256 * j), sc = *(const f32x4*)(mb + D + 4 * lane + 256 * j);
                const f32x4 h = (v[j] * rinv * g) * (1.0f + sc) + sh;
                int p = 0; p = __builtin_amdgcn_cvt_pk_fp8_f32(h.x, h.y, p, false); p = __builtin_amdgcn_cvt_pk_fp8_f32(h.z, h.w, p, true);
                *(int*)(h8 + (size_t)row * D + 4 * lane + 256 * j) = p; }
        }
        {
            const int ri = lane & 15, q = lane >> 4;
            const bf16_t* xr = xres + (size_t)(row0 + ri) * D + 8 * q;
            const bf16_t* wh = (const bf16_t*)(ws + WS_WRS) + ((size_t)(l * 2 + 0) * NE + ri) * D + 8 * q; const bf16_t* wl = wh + (size_t)NE * D;
            f32x4 acc0 = {0.f, 0.f, 0.f, 0.f}, acc1 = {0.f, 0.f, 0.f, 0.f};
#pragma unroll 4
            for (int kb = 0; kb < 32; ++kb) {
                const int k0 = 32 * kb + 8 * q;
                const u32x4 xp = *(const u32x4*)(xr + 32 * kb); const f32x4 x0 = {bflo(xp.x), bfhi(xp.x), bflo(xp.y), bfhi(xp.y)}, x1 = {bflo(xp.z), bfhi(xp.z), bflo(xp.w), bfhi(xp.w)};
                const f32x4 g0 = *(const f32x4*)(ng + k0), g1 = *(const f32x4*)(ng + k0 + 4), s0 = *(const f32x4*)(mb + D + k0), s1 = *(const f32x4*)(mb + D + k0 + 4);
                const bf16x8 bh0 = *(const bf16x8*)(wh + 32 * kb), bl0 = *(const bf16x8*)(wl + 32 * kb), bh1 = *(const bf16x8*)(wh + 16 * D + 32 * kb), bl1 = *(const bf16x8*)(wl + 16 * D + 32 * kb);
                const f32x4 a0 = x0 * g0 * (1.0f + s0), a1 = x1 * g1 * (1.0f + s1);
                u32x4 hi, lo;
                hi.x = cvt_pk_bf16(a0.x, a0.y); hi.y = cvt_pk_bf16(a0.z, a0.w); hi.z = cvt_pk_bf16(a1.x, a1.y); hi.w = cvt_pk_bf16(a1.z, a1.w);
                lo.x = cvt_pk_bf16(a0.x - bflo(hi.x), a0.y - bfhi(hi.x)); lo.y = cvt_pk_bf16(a0.z - bflo(hi.y), a0.w - bfhi(hi.y));
                lo.z = cvt_pk_bf16(a1.x - bflo(hi.z), a1.y - bfhi(hi.z)); lo.w = cvt_pk_bf16(a1.z - bflo(hi.w), a1.w - bfhi(hi.w));
                const bf16x8 ah = __builtin_bit_cast(bf16x8, hi), al = __builtin_bit_cast(bf16x8, lo);
                acc0 = __builtin_amdgcn_mfma_f32_16x16x32_bf16(ah, bh0, acc0, 0, 0, 0); acc0 = __builtin_amdgcn_mfma_f32_16x16x32_bf16(ah, bl0, acc0, 0, 0, 0); acc0 = __builtin_amdgcn_mfma_f32_16x16x32_bf16(al, bh0, acc0, 0, 0, 0);
                acc1 = __builtin_amdgcn_mfma_f32_16x16x32_bf16(ah, bh1, acc1, 0, 0, 0); acc1 = __builtin_amdgcn_mfma_f32_16x16x32_bf16(ah, bl1, acc1, 0, 0, 0); acc1 = __builtin_amdgcn_mfma_f32_16x16x32_bf16(al, bh1, acc1, 0, 0, 0);
            }
            LDS_WAIT();
            const float c0 = cbv[(l * NBATCH + b) * NE + ri], c1 = cbv[(l * NBATCH + b) * NE + 16 + ri];
#pragma unroll
            for (int r = 0; r < 4; ++r) { const int ti = 4 * q + r; const float rv = rinvs[wave * 16 + ti];
                lgt[(wave * 16 + ti) * 33 + ri] = acc0[r] * rv + c0; lgt[(wave * 16 + ti) * 33 + 16 + ri] = acc1[r] * rv + c1; }
        }
        __syncthreads();
        int se[4] = {0, 0, 0, 0}; float sw[4] = {0.f, 0.f, 0.f, 0.f}; int rk[4] = {0, 0, 0, 0};
        if (lane < 16) {
            float v[32];
#pragma unroll
            for (int e = 0; e < 32; ++e) v[e] = lgt[(wave * 16 + lane) * 33 + e];
            float sv[4];
#pragma unroll
            for (int kk = 0; kk < 4; ++kk) { float best = v[0]; int bi = 0;
#pragma unroll
                for (int e = 1; e < 32; ++e) { if (v[e] > best) { best = v[e]; bi = e; } }
                sv[kk] = best; se[kk] = bi;
#pragma unroll
                for (int e = 0; e < 32; ++e) v[e] = (e == bi) ? -3.0e38f : v[e]; }
            float den = 0.f;
#pragma unroll
            for (int kk = 0; kk < 4; ++kk) { sw[kk] = __expf(sv[kk] - sv[0]); den += sw[kk]; }
            const float inv = 1.0f / den;
#pragma unroll
            for (int kk = 0; kk < 4; ++kk) { sw[kk] *= inv; rk[kk] = __hip_atomic_fetch_add(hist + se[kk], 1, __ATOMIC_RELAXED, __HIP_MEMORY_SCOPE_WORKGROUP); }
        }
        __syncthreads();
        if (tid < 32) base[tid] = (int)__hip_atomic_fetch_add(ctl + CW_CNT + (cset * NE + tid) * 16, (unsigned)hist[tid], __ATOMIC_RELAXED, __HIP_MEMORY_SCOPE_AGENT);
        __syncthreads();
        if (lane < 16) {
            const int row = row0 + lane; int si[4];
#pragma unroll
            for (int kk = 0; kk < 4; ++kk) { const int li = base[se[kk]] + rk[kk]; tokof[(size_t)se[kk] * T + li] = row; si[kk] = (se[kk] << 24) | li; }
            *(int4*)(slotinfo + (size_t)row * 4) = make_int4(si[0], si[1], si[2], si[3]);
            *(f32x4*)(wgt + (size_t)row * 4) = (f32x4){sw[0], sw[1], sw[2], sw[3]};
        }
        __syncthreads();
    }
}

constexpr int ZT_STRIDE = 528;
__device__ __forceinline__ void lru_unit(const Args& a, int l, int u, LAS unsigned char* lds, const int wv) {
    asm volatile("" : "+s"(lds));
    int tid_ = tid_of(wv); asm volatile("" : "+v"(tid_)); const int tid = tid_, lane = tid & 63, wave = __builtin_amdgcn_readfirstlane(tid >> 6);
    unsigned char* ws = opaque_ptr(a.ws);
    const bf16_t* z = (const bf16_t*)(ws + WS_Z);
    LAS unsigned char* zt = lds; LAS unsigned char* xc = lds + 131 * ZT_STRIDE;
    const int hp = u & 3, b = (u >> 2) & 7, s = u >> 5;
    const int t0 = b * SEQ + s * 128, p0 = s * 128;
    {   u32x4 sv[9];
#pragma unroll
        for (int k = 0; k < 9; ++k) { int idx = tid + NTHREADS * k; idx = idx < 131 * 32 ? idx : 131 * 32 - 1; const int r = idx >> 5, o = idx & 31; const int p = p0 - 3 + r; const int pc = p < 0 ? 0 : p;
            sv[k] = *(const u32x4*)(z + (size_t)(b * SEQ + pc) * NZ + hp * 256 + o * 8); if (p < 0) sv[k] = (u32x4){0u, 0u, 0u, 0u}; }
#pragma unroll
        for (int k = 0; k < 9; ++k) { int idx = tid + NTHREADS * k; idx = idx < 131 * 32 ? idx : 131 * 32 - 1; const int r = idx >> 5, o = idx & 31;
            *(LAS u32x4*)(zt + r * ZT_STRIDE + o * 16) = sv[k]; }
    }
    __syncthreads();
    {
        const int o = tid & 31, rb = tid >> 5; const int ch0 = hp * 256 + o * 8;
        float cw[4][8], cbias[8];
#pragma unroll
        for (int k = 0; k < 4; ++k) { const f32x4 w0 = *(const f32x4*)(a.in[I_CONVW] + ((size_t)l * 4 + k) * D + ch0), w1 = *(const f32x4*)(a.in[I_CONVW] + ((size_t)l * 4 + k) * D + ch0 + 4);
            cw[k][0] = w0.x; cw[k][1] = w0.y; cw[k][2] = w0.z; cw[k][3] = w0.w; cw[k][4] = w1.x; cw[k][5] = w1.y; cw[k][6] = w1.z; cw[k][7] = w1.w; }
        { const f32x4 b0 = *(const f32x4*)(a.in[I_CONVB] + (size_t)l * D + ch0), b1 = *(const f32x4*)(a.in[I_CONVB] + (size_t)l * D + ch0 + 4);
          cbias[0] = b0.x; cbias[1] = b0.y; cbias[2] = b0.z; cbias[3] = b0.w; cbias[4] = b1.x; cbias[5] = b1.y; cbias[6] = b1.z; cbias[7] = b1.w; }
#pragma unroll 2
        for (int i = 0; i < 8; ++i) { const int r = rb + 16 * i; float acc[8];
#pragma unroll
            for (int j = 0; j < 8; ++j) acc[j] = cbias[j];
#pragma unroll
            for (int k = 0; k < 4; ++k) { const u32x4 v = *(const LAS u32x4*)(zt + (r + k) * ZT_STRIDE + o * 16);
                acc[0] += cw[k][0] * bflo(v.x); acc[1] += cw[k][1] * bfhi(v.x); acc[2] += cw[k][2] * bflo(v.y); acc[3] += cw[k][3] * bfhi(v.y);
                acc[4] += cw[k][4] * bflo(v.z); acc[5] += cw[k][5] * bfhi(v.z); acc[6] += cw[k][6] * bflo(v.w); acc[7] += cw[k][7] * bfhi(v.w); }
            u32x4 w; w.x = cvt_pk_bf16(acc[0], acc[1]); w.y = cvt_pk_bf16(acc[2], acc[3]); w.z = cvt_pk_bf16(acc[4], acc[5]); w.w = cvt_pk_bf16(acc[6], acc[7]);
            *(LAS u32x4*)(xc + r * ZT_STRIDE + o * 16) = w; }
    }
    __syncthreads();
    {
        const __amdgpu_buffer_rsrc_t rz = __builtin_amdgcn_make_buffer_rsrc((void*)(z + (size_t)t0 * NZ + ZO_GLRU + hp * 256), 0, 0xffffffff, 0x00020000);
        const unsigned vo = (unsigned)(lane >> 5) * (unsigned)(NZ * 2) + (unsigned)(lane & 31) * 16u;
#pragma unroll
        for (int k = 0; k < 8; ++k) __builtin_amdgcn_raw_ptr_buffer_load_lds(rz, (LAS void*)(zt + (wave * 8 + k) * 1024), 16, vo, (unsigned)((wave * 8 + k) * 2 * NZ * 2), 0, 0);
    }
    {
        const int hsel = wave >> 2, wc = wave & 3, head = 2 * hp + hsel, c31 = lane & 31, hh = lane >> 5;
        const int ch = head * 128 + 32 * wc + c31;
        const bf16_t* wb = (const bf16_t*)(ws + WS_WRG) + ((size_t)(l * 8 + head) * 256 + 32 * wc + c31) * 128 + 8 * hh;
        bf16x8 Ba[8], Bi[8];
#pragma unroll
        for (int ks = 0; ks < 8; ++ks) { Ba[ks] = *(const bf16x8*)(wb + 16 * ks); Bi[ks] = *(const bf16x8*)(wb + 128 * 128 + 16 * ks); }
        const float ba = a.in[I_BRGA][(size_t)l * D + ch], bx = a.in[I_BRGX][(size_t)l * D + ch];
        const float lam = a.in[I_LAM][(size_t)l * D + ch];
        const float sp8 = 8.0f * log1pf(__expf(-lam));
        typedef __attribute__((address_space(1))) unsigned long long gu64;
        gu64* aggq = (gu64*)(ws + WS_AGG) + ((size_t)l * NBATCH * 32 + (size_t)b * 32) * D + ch;
        float Pr = 1.f, Hr = 0.f;
        unsigned hpk[64];
#pragma unroll
        for (int rb = 0; rb < 4; ++rb) {
            f32x16 aa, ai;
#pragma unroll
            for (int r = 0; r < 16; ++r) { aa[r] = 0.f; ai[r] = 0.f; }
            const LAS unsigned char* ap = xc + (32 * rb + c31) * ZT_STRIDE + (hsel * 128 + 8 * hh) * 2;
#pragma unroll
            for (int ks = 0; ks < 8; ++ks) { const bf16x8 A = *(const LAS bf16x8*)(ap + 32 * ks);
                aa = __builtin_amdgcn_mfma_f32_32x32x16_bf16(A, Ba[ks], aa, 0, 0, 0); ai = __builtin_amdgcn_mfma_f32_32x32x16_bf16(A, Bi[ks], ai, 0, 0, 0); }
            const LAS unsigned char* xp = xc + (32 * rb + 4 * hh) * ZT_STRIDE + (hsel * 128 + 32 * wc + c31) * 2;
#pragma unroll
            for (int q = 0; q < 4; ++q) {
                float p = 1.f, h = 0.f, hl[4], pl[4];
#pragma unroll
                for (int r3 = 0; r3 < 4; ++r3) { const int reg = 4 * q + r3;
                    const float xcv = bf1(*(const LAS bf16_t*)(xp + (8 * q + r3) * ZT_STRIDE));
                    const float rg = sigmoidf_(aa[reg] + ba), ig = sigmoidf_(ai[reg] + bx);
                    const float av = __expf(-sp8 * rg); const float mult = __builtin_amdgcn_sqrtf(fmaxf(1.0f - av * av, 0.f));
                    h = av * h + mult * (ig * xcv); p *= av; hl[r3] = h; pl[r3] = p; }
                const float Ao = shflx(p, 32, lane), Bo = shflx(h, 32, lane);
                const float A0 = hh ? Ao : p, B0 = hh ? Bo : h, A1 = hh ? p : Ao, B1 = hh ? h : Bo;
                const float P1 = Pr * A0, H1 = Hr * A0 + B0;
                const float Pst = hh ? P1 : Pr, Hst = hh ? H1 : Hr;
                Pr = P1 * A1; Hr = H1 * A1 + B1;
#pragma unroll
                for (int r3 = 0; r3 < 4; ++r3) hpk[rb * 16 + 4 * q + r3] = cvt_pk_bf16(Hst * pl[r3] + hl[r3], Pst * pl[r3]);
            }
        }
        if (hh == 0) __hip_atomic_store(aggq + (size_t)s * D, ((unsigned long long)__float_as_uint(Hr) << 32) | (unsigned long long)__float_as_uint(fmaxf(Pr, 1e-37f)), __ATOMIC_RELAXED, __HIP_MEMORY_SCOPE_AGENT);
        float cin = 0.f;
        for (int j0 = 0; j0 < s; j0 += 8) {
            unsigned long long w[8]; unsigned spins = 0;
            for (;;) { bool ok = true;
#pragma unroll
                for (int k = 0; k < 8; ++k) { const int j = (j0 + k < s) ? (j0 + k) : (s - 1); w[k] = __hip_atomic_load(aggq + (size_t)j * D, __ATOMIC_RELAXED, __HIP_MEMORY_SCOPE_AGENT); ok = ok && ((unsigned)w[k] != 0u); }
                if (__all(ok)) break;
                __builtin_amdgcn_s_sleep(4);
                if (++spins > (1u << 17)) break;
            }
#pragma unroll
            for (int k = 0; k < 8; ++k) { if (j0 + k < s) cin = __uint_as_float((unsigned)w[k]) * cin + __uint_as_float((unsigned)(w[k] >> 32)); }
        }
        asm volatile("s_waitcnt vmcnt(0)" ::: "memory");
        __syncthreads();
        LAS unsigned char* gp = zt + (4 * hh) * 512 + (hsel * 128 + 32 * wc + c31) * 2;
#pragma unroll
        for (int rb = 0; rb < 4; ++rb) {
#pragma unroll
            for (int reg = 0; reg < 16; ++reg) { const int tok = 32 * rb + 8 * (reg >> 2) + (reg & 3);
                const unsigned pk = hpk[rb * 16 + reg];
                const float hf = bflo(pk) + bfhi(pk) * cin;
                LAS bf16_t* cell = (LAS bf16_t*)(gp + tok * 512);
                const float g = bf1(*cell);
                const float ge = g * __builtin_amdgcn_rcpf(1.0f + __expf(-1.5957691216f * (g + 0.044715f * g * g * g)));
                *cell = (bf16_t)(cvt_pk_bf16(hf * ge, 0.f) & 0xffffu); }
        }
    }
    __syncthreads();
    {
        bf16_t* yo = (bf16_t*)(ws + WS_ACAT) + (size_t)t0 * KCAT + 512 + hp * 256;
        u32x4 yv[8];
#pragma unroll
        for (int k = 0; k < 8; ++k) yv[k] = *(const LAS u32x4*)(zt + ((tid >> 5) + 16 * k) * 512 + (tid & 31) * 16);
#pragma unroll
        for (int k = 0; k < 8; ++k) *(u32x4*)(yo + (size_t)((tid >> 5) + 16 * k) * KCAT + (tid & 31) * 8) = yv[k];
    }
    __syncthreads();
}
__device__ __forceinline__ void pool_unit(const Args& a, int l, int u, LAS unsigned char* lds, const int wv) {
    asm volatile("" : "+s"(lds));
    int tid_ = tid_of(wv); asm volatile("" : "+v"(tid_)); const int tid = tid_, lane = tid & 63, wave = __builtin_amdgcn_readfirstlane(tid >> 6);
    unsigned char* ws = opaque_ptr(a.ws);
    const bf16_t* z = (const bf16_t*)(ws + WS_Z);
    LAS unsigned char* zt = lds; LAS unsigned char* pt = lds + 143 * ZT_STRIDE;
    const int gp = u & 1, b = (u >> 1) & 7, s = u >> 4;
    const int t0 = b * SEQ + s * 128, p0 = s * 128;
    {   u32x4 sv[9];
#pragma unroll
        for (int k = 0; k < 9; ++k) { int idx = tid + NTHREADS * k; idx = idx < 143 * 32 ? idx : 143 * 32 - 1; const int r = idx >> 5, o = idx & 31; const int p = p0 - 15 + r; const int pc = p < 0 ? 0 : p;
            sv[k] = *(const u32x4*)(z + (size_t)(b * SEQ + pc) * NZ + ZO_XPOOL + gp * 256 + o * 8); if (p < 0) sv[k] = (u32x4){0u, 0u, 0u, 0u}; }
#pragma unroll
        for (int k = 0; k < 9; ++k) { int idx = tid + NTHREADS * k; idx = idx < 143 * 32 ? idx : 143 * 32 - 1; const int r = idx >> 5, o = idx & 31;
            *(LAS u32x4*)(zt + r * ZT_STRIDE + o * 16) = sv[k]; }
    }
    __syncthreads();
    {
        const int o = tid & 31, rb = tid >> 5; const int g = 2 * gp + (o >> 4); const int w = 2 << g;
#pragma unroll 1
        for (int i = 0; i < 8; ++i) { const int r = rb + 16 * i; float acc[8];
#pragma unroll
            for (int j = 0; j < 8; ++j) acc[j] = 0.f;
            for (int jj = 0; jj < w; ++jj) { const u32x4 v = *(const LAS u32x4*)(zt + (r + 15 - jj) * ZT_STRIDE + o * 16);
                acc[0] += bflo(v.x); acc[1] += bfhi(v.x); acc[2] += bflo(v.y); acc[3] += bfhi(v.y); acc[4] += bflo(v.z); acc[5] += bfhi(v.z); acc[6] += bflo(v.w); acc[7] += bfhi(v.w); }
            const int cnt = (p0 + r + 1 < w) ? (p0 + r + 1) : w; const float ic = 1.0f / (float)cnt;
            const u32x4 v = *(const LAS u32x4*)(zt + (r + 15) * ZT_STRIDE + o * 16);
            const float x0[8] = {bflo(v.x), bfhi(v.x), bflo(v.y), bfhi(v.y), bflo(v.z), bfhi(v.z), bflo(v.w), bfhi(v.w)};
#pragma unroll
            for (int j = 0; j < 8; ++j) acc[j] = acc[j] * ic - x0[j];
            u32x4 wv; wv.x = cvt_pk_bf16(acc[0], acc[1]); wv.y = cvt_pk_bf16(acc[2], acc[3]); wv.z = cvt_pk_bf16(acc[4], acc[5]); wv.w = cvt_pk_bf16(acc[6], acc[7]);
            *(LAS u32x4*)(pt + r * ZT_STRIDE + o * 16) = wv; }
    }
    __syncthreads();
    {
        const int gsel = wave >> 2, wc = wave & 3, g = 2 * gp + gsel, c31 = lane & 31, hh = lane >> 5;
        const int oc = g * 128 + 32 * wc + c31;
        const bf16_t* wb = (const bf16_t*)(ws + WS_WPOOL) + ((size_t)(l * 4 + g) * 128 + 32 * wc + c31) * 128 + 8 * hh;
        bf16x8 Bf[8];
#pragma unroll
        for (int ks = 0; ks < 8; ++ks) Bf[ks] = *(const bf16x8*)(wb + 16 * ks);
        const float psc = a.in[I_PSCALE][(size_t)l * 512 + oc];
        bf16_t* yo = (bf16_t*)(ws + WS_ACAT) + (size_t)t0 * KCAT + oc;
#pragma unroll 1
        for (int rb = 0; rb < 4; ++rb) {
            f32x16 acc;
#pragma unroll
            for (int r = 0; r < 16; ++r) acc[r] = 0.f;
            const LAS unsigned char* ap = pt + (32 * rb + c31) * ZT_STRIDE + (gsel * 128 + 8 * hh) * 2;
#pragma unroll
            for (int ks = 0; ks < 8; ++ks) { const bf16x8 A = *(const LAS bf16x8*)(ap + 32 * ks); acc = __builtin_amdgcn_mfma_f32_32x32x16_bf16(A, Bf[ks], acc, 0, 0, 0); }
#pragma unroll
            for (int reg = 0; reg < 16; ++reg) { const int tok = 32 * rb + 8 * (reg >> 2) + 4 * hh + (reg & 3);
                yo[(size_t)tok * KCAT] = (bf16_t)(cvt_pk_bf16(acc[reg] * psc, 0.f) & 0xffffu); }
        }
    }
    __syncthreads();
}

constexpr int PH_PER_LAYER = 9;
constexpr int N_PHASES = 1 + DEPTH * PH_PER_LAYER + 1;

__global__ void __launch_bounds__(NTHREADS, 2) fwd_kernel(Args a) {
    extern __shared__ __attribute__((aligned(16))) unsigned char lds_raw[];
    LAS unsigned char* lds = (LAS unsigned char*)lds_raw;
    const int wv = __builtin_amdgcn_readfirstlane(threadIdx.x >> 6); const int tid = threadIdx.x; const int G = gridDim.x;
    unsigned char* ws0 = a.ws;
    unsigned* ctl = (unsigned*)(ws0 + WS_CTL);
    volatile LAS unsigned* misc = (volatile LAS unsigned*)(lds + LDS_MISC);
    if (tid < 4) misc[tid] = 0u;
    __syncthreads();
    XcdBarrier bar; bar.bar = ctl + CW_BAR; bar.x = 0; bar.st = misc; bar.wv = wv;
#if MK_PER_PHASE
    const int lo = a.ph_lo, hi = a.ph_hi;
#else
    constexpr int lo = 0, hi = N_PHASES;
#endif
    if (hi - lo > 1) bar = xcd_barrier_post(ctl + CW_BAR, misc, wv);
#define IN(k) (lo <= (k) && (k) < hi)
#define SEAM(k) do { if (IN((k) + 1)) xcd_barrier(bar); } while (0)

    if (EN(0) && IN(0)) for (int rr = 0; rr < REPN(0); ++rr) { phase_prologue(a, lds, wv); SEAM(0); }

    for (int l = 0; l < DEPTH; ++l) {
        const int pb = 1 + l * PH_PER_LAYER;
        if (EN(1) && IN(pb + 0)) for (int rr = 0; rr < REPN(1); ++rr) { unsigned char* ws = opaque_ptr(ws0); const int bid = opaque_bid(); (void)bid; (void)ws; phase_a(a, l, lds, rr + 1 < REPN(1), wv); SEAM(pb + 0); }
        if (EN(2) && IN(pb + 1)) for (int rr = 0; rr < REPN(2); ++rr) { unsigned char* ws = opaque_ptr(ws0); const int bid = opaque_bid(); (void)bid; (void)ws;
            #if Z_I8
            pg8::PlainSched S{(const char*)(ws + WS_H), (const char*)(ws + WS_WIN) + (size_t)l * NZ * 1024, 512, T / 256, NZ / 256, G, bid};
            pg8::EpiZI8 E{(bf16_t*)(ws + WS_Z), (unsigned char*)(ws + WS_ZG), (const unsigned char*)ws, (unsigned)WS_HSC, (unsigned)(WS_WINSC + (size_t)l * NZ * 4)};
            pg8::gemm_phase<pg8::EpiZI8, pg8::PlainSched, true, 2>(lds, 512, S, E, wv);
#elif Z_FP8
            pg8::PlainSched S{(const char*)(ws + WS_H), (const char*)(ws + WS_WIN) + (size_t)l * NZ * 1024, 512, T / 256, NZ / 256, G, bid};
            pg8::EpiBf16 E{(bf16_t*)(ws + WS_Z), NZ, nullptr, (rr + 1 < REPN(2)) && (a.ph_lo == 0), 1.0f / WEIN_SCALE};
            pg8::gemm_phase<pg8::EpiBf16, pg8::PlainSched, true, 1>(lds, 512, S, E, wv);
#else
            pg8::PlainSched S{(const char*)(ws + WS_H), (const char*)(ws + WS_WIN) + (size_t)l * NZ * 1024 * 2, 1024, T / 256, NZ / 256, G, bid};
            pg8::EpiBf16 E{(bf16_t*)(ws + WS_Z), NZ, nullptr, (rr + 1 < REPN(2)) && (a.ph_lo == 0), 1.0f};
            pg8::gemm_phase<pg8::EpiBf16, pg8::PlainSched, true>(lds, 1024, S, E, wv);
#endif
            SEAM(pb + 1);
        }
        if (EN(3) && IN(pb + 2)) for (int rr = 0; rr < REPN(3); ++rr) { unsigned char* ws = opaque_ptr(ws0); const int bid = opaque_bid(); (void)bid; (void)ws;
            for (int u = bid; u < 1024 + 512; u += G) { if (u < 1024) lru_unit(a, l, u, lds, wv); else pool_unit(a, l, u - 1024, lds, wv); }
            SEAM(pb + 2);
        }
        if (EN(5) && IN(pb + 4)) for (int rr = 0; rr < REPN(5); ++rr) { unsigned char* ws = opaque_ptr(ws0); const int bid = opaque_bid(); (void)bid; (void)ws;
            pg8::PlainSched S{(const char*)(ws + WS_ACAT), (const char*)(ws + WS_WCAT) + (size_t)l * 1024 * KCAT * 2, KCAT, T / 256, D / 256, G, bid};
            pg8::EpiMerged E{(bf16_t*)(ws + WS_MERGED), (const unsigned char*)(ws + WS_ZG)};
            pg8::gemm_phase<pg8::EpiMerged, pg8::PlainSched, true>(lds, KCAT, S, E, wv);
            SEAM(pb + 4);
        }
        if (EN(6) && IN(pb + 5)) for (int rr = 0; rr < REPN(6); ++rr) { unsigned char* ws = opaque_ptr(ws0); const int bid = opaque_bid(); (void)bid; (void)ws;
            pg8::PlainSched S{(const char*)(ws + WS_MERGED), (const char*)(ws + WS_WOUT) + (size_t)l * 1024 * 1024 * 2, 1024, T / 256, D / 256, G, bid};
            pg8::EpiResid E{(bf16_t*)(ws + WS_XRES), (rr + 1 < REPN(6)) ? (bf16_t*)(ws + WS_ACT) : (bf16_t*)(ws + WS_XRES), (const float*)(ws + WS_MOD) + (size_t)l * NBATCH * 6144 + 2 * D};
            pg8::gemm_phase<pg8::EpiResid, pg8::PlainSched, true>(lds, 1024, S, E, wv);
            SEAM(pb + 5);
        }
        if (EN(7) && IN(pb + 6)) for (int rr = 0; rr < REPN(7); ++rr) { unsigned char* ws = opaque_ptr(ws0); const int bid = opaque_bid(); (void)bid; (void)ws; if (l > 0 && rr == 0) conv_drain(a, l, -1, lds, wv); phase_h(a, l, l + DEPTH * rr, lds, wv); SEAM(pb + 6); }
        if (EN(8) && IN(pb + 7)) for (int rr = 0; rr < REPN(8); ++rr) { unsigned char* ws = opaque_ptr(ws0); const int bid = opaque_bid(); (void)bid; (void)ws;
            moe_tables(a, l + DEPTH * (REPN(7) - 1), lds, wv);
            LAS unsigned char* lds_o = lds; asm volatile("" : "+s"(lds_o)); const MoeTab mt = moe_tab_ptrs(lds_o);
            MoeSched1 S{(const char*)(ws + WS_H), (const char*)(ws + WS_WEIN) + (size_t)l * NE * 2048 * 1024, (const int*)(ws + WS_TOKOF), mt, __builtin_amdgcn_readfirstlane(mt.tilestart[NE]), G, bid};
            pg8::EpiSwiglu E{(unsigned char*)(ws + WS_ACT), a.in[I_BEIN] + (size_t)l * NE * 2048, 1.0f / WEIN_SCALE};
            pg8::gemm_phase<pg8::EpiSwiglu, MoeSched1, true, 1>(lds, 512, S, E, wv);
            if (l + 1 < DEPTH) {
                const int nwg = S.nMt * 8, maxr = (nwg + G - 1) / G, myr = (nwg - bid + G - 1) / G;
                if (myr < maxr) conv_drain(a, l + 1, CONV_Q1, lds, wv);
            }
            SEAM(pb + 7);
        }
        if (EN(9) && IN(pb + 8)) for (int rr = 0; rr < REPN(9); ++rr) { unsigned char* ws = opaque_ptr(ws0); const int bid = opaque_bid(); (void)bid; (void)ws;
            moe_tables(a, l + DEPTH * (REPN(7) - 1), lds, wv);
            LAS unsigned char* lds_o = lds; asm volatile("" : "+s"(lds_o)); const MoeTab mt = moe_tab_ptrs(lds_o);
            MoeSched2 S{(const char*)(ws + WS_ACT), (const char*)(ws + WS_WEOUT) + (size_t)l * NE * 1024 * 1024, mt, __builtin_amdgcn_readfirstlane(mt.tilestart[NE]), G, bid};
            pg8::EpiMoeOut E{(unsigned char*)(ws + WS_OUTB), (float*)(ws + WS_OUTSC), a.in[I_BEOUT] + (size_t)l * NE * D, 1.0f / WEIN_SCALE};
            pg8::gemm_phase<pg8::EpiMoeOut, MoeSched2, true, 1>(lds, 512, S, E, wv);
            if (l + 1 < DEPTH) {
                const int nwg = S.nMt * 4, maxr = (nwg + G - 1) / G, myr = (nwg - bid + G - 1) / G;
                if (myr < maxr) conv_drain(a, l + 1, CONV_Q2, lds, wv);
            }
            SEAM(pb + 8);
        }
    }
    if (EN(10) && IN(N_PHASES - 1)) phase_a(a, DEPTH, lds, false, wv);
#undef IN
#undef SEAM
}

extern "C" void kernel_launch(void* const* d_in, const int* in_sizes, int n_in, void* d_out, int out_size, void* d_ws, size_t ws_size, hipStream_t stream) {
    static int grid = 0;
    if (grid == 0) {
        if (n_in != 26 || out_size != T * D || ws_size < WS_END) { fprintf(stderr, "kernel_launch: unexpected problem (n_in %d out %d ws %zu)\n", n_in, out_size, ws_size); grid = -1; return; }
        int dev = 0, cus = 0, per_cu = 0;
        if (hipGetDevice(&dev) != hipSuccess || hipDeviceGetAttribute(&cus, hipDeviceAttributeMultiprocessorCount, dev) != hipSuccess) { grid = -1; return; }
        if (hipFuncSetAttribute((const void*)fwd_kernel, hipFuncAttributeMaxDynamicSharedMemorySize, LDS_BYTES) != hipSuccess) { fprintf(stderr, "kernel_launch: hipFuncSetAttribute failed\n"); grid = -1; return; }
        if (hipOccupancyMaxActiveBlocksPerMultiprocessor(&per_cu, (const void*)fwd_kernel, NTHREADS, LDS_BYTES) != hipSuccess || per_cu < 1) fprintf(stderr, "kernel_launch: occupancy query says %d\n", per_cu);
        (void)hipGetLastError();
        grid = cus;
    }
    if (grid < 0) return;
    if (hipMemsetAsync((char*)d_ws + WS_CTL, 0, CTL_ZERO_BYTES, stream) != hipSuccess) return;
    if (hipMemsetAsync((char*)d_ws + WS_AGG, 0, AGG_BYTES, stream) != hipSuccess) return;
    Args a{};
    for (int i = 0; i < 26; ++i) a.in[i] = (const float*)d_in[i];
    a.out = (float*)d_out; a.ws = (unsigned char*)d_ws;
#if MK_PER_PHASE
    for (int p = 0; p < N_PHASES; ++p) { a.ph_lo = p; a.ph_hi = p + 1; hipLaunchKernelGGL(fwd_kernel, dim3(grid), dim3(NTHREADS), LDS_BYTES, stream, a); }
#else
    a.ph_lo = 0; a.ph_hi = N_PHASES;
    hipLaunchKernelGGL(fwd_kernel, dim3(grid), dim3(NTHREADS), LDS_BYTES, stream, a);
#endif
    const hipError_t le = hipPeekAtLastError();
    if (le != hipSuccess) fprintf(stderr, "kernel_launch: launch failed: %s\n", hipGetErrorName(le));
}
```

```cpp
#include <hip/hip_runtime.h>
#include <cstdio>
#include <cstdint>

#define REP_MASK 0x0
#ifndef PH_MASK
#define PH_MASK 0x7ff
#endif
#define EN(b) ((PH_MASK >> (b)) & 1)
#ifndef REP_MASK
#define REP_MASK 0
#endif
#define REPN(b) ((((REP_MASK) >> (b)) & 1) ? 2 : 1)
#ifndef Z_I8
#define Z_I8 1
#endif
#ifndef Z_FP8
#define Z_FP8 0
#endif
#ifndef MK_PER_PHASE
#define MK_PER_PHASE 0
#endif

#define LAS __attribute__((address_space(3)))
typedef unsigned short bf16_t;
typedef short bf16x8 __attribute__((ext_vector_type(8)));
typedef float f32x4 __attribute__((ext_vector_type(4)));
typedef float f32x2 __attribute__((ext_vector_type(2)));
typedef float f32x16 __attribute__((ext_vector_type(16)));
typedef unsigned u32x4 __attribute__((ext_vector_type(4)));
typedef unsigned u32x2 __attribute__((ext_vector_type(2)));

constexpr int D = 1024, NBATCH = 8, SEQ = 4096, T = NBATCH * SEQ, DEPTH = 4;
constexpr int NZ = 4608, ZO_GLRU = 1024, ZO_XPOOL = 2048, ZO_GL0 = 2560, ZO_GL1 = 3584;
constexpr int NE = 32, TOPK = 4;
constexpr int KCAT = 1536;
constexpr int SLOT_CAP = T * TOPK + NE * 256;
constexpr int MAX_MT = SLOT_CAP / 256;
constexpr float NORM_EPS = 1e-6f;
constexpr float WEIN_SCALE = 64.0f;
constexpr int NTHREADS = 512, NWAVES = 8;

constexpr size_t MiB = 1u << 20;
constexpr size_t WS_CTL = 0, CTL_ZERO_BYTES = 256 * 1024;
constexpr size_t WS_MOD = 1 * MiB;
constexpr size_t WS_CB = 2 * MiB;
constexpr size_t WS_AGG = 72 * MiB;
constexpr size_t AGG_BYTES = (size_t)DEPTH * NBATCH * 32 * D * 8;
constexpr size_t WS_WRS = 3 * MiB;
constexpr size_t WS_HSC = 4 * MiB;
constexpr size_t WS_WINSC = 5 * MiB;
constexpr size_t WS_TOKOF = 6 * MiB;
constexpr size_t WS_SLOTINFO = 10 * MiB;
constexpr size_t WS_WGT = 11 * MiB;
constexpr size_t WS_WRG = 12 * MiB;
constexpr size_t WS_WPOOL = 14 * MiB;
constexpr size_t WS_WIN = 16 * MiB;
constexpr size_t WS_WCAT = 52 * MiB;
constexpr size_t WS_WOUT = 64 * MiB;
constexpr size_t WS_WEIN = 128 * MiB;
constexpr size_t WS_WEOUT = 640 * MiB;
constexpr size_t WS_XRES = 896 * MiB;
constexpr size_t WS_H = 1024 * MiB;
constexpr size_t WS_Z = 1088 * MiB;
constexpr size_t WS_ZS = WS_Z + 96 * MiB;
constexpr size_t WS_ACAT = 1376 * MiB;
constexpr size_t WS_MERGED = 1472 * MiB;
constexpr size_t WS_ACT = 1536 * MiB;
constexpr size_t WS_OUTB = 1808 * MiB;
constexpr size_t WS_OUTSC = WS_OUTB + 144 * MiB;
constexpr size_t WS_ZG = 2080 * MiB;
constexpr size_t WS_END = 2144 * MiB;
static_assert(WS_ACT + (size_t)SLOT_CAP * 1024 * 2 <= WS_OUTB && WS_OUTB + (size_t)SLOT_CAP * 1024 * 2 <= WS_END, "ws map");
constexpr int CW_BAR = 4096;
constexpr int CW_CONVQ = 7680;
constexpr int CW_CNT = 8192;

constexpr int LDS_BYTES = 163840;
constexpr int LDS_TAB = 131072;
constexpr int LDS_NVA = 131072 + 8192;
constexpr int LDS_PTAB = 131072 + 16384, PTAB_BYTES = 2048;
constexpr int LDS_MISC = LDS_BYTES - 256;

__device__ __forceinline__ unsigned cvt_pk_bf16(float lo, float hi) { unsigned r; asm("v_cvt_pk_bf16_f32 %0, %1, %2" : "=v"(r) : "v"(lo), "v"(hi)); return r; }
__device__ __forceinline__ float bflo(unsigned w) { return __uint_as_float(w << 16); }
__device__ __forceinline__ float bfhi(unsigned w) { return __uint_as_float(w & 0xffff0000u); }
__device__ __forceinline__ float bf1(bf16_t w) { return __uint_as_float(((unsigned)w) << 16); }
__device__ __forceinline__ float sigmoidf_(float x) { return __builtin_amdgcn_rcpf(1.0f + __expf(-x)); }
__device__ __forceinline__ float shflx(float v, int mask, int lane) { return __int_as_float(__builtin_amdgcn_ds_bpermute((lane ^ mask) << 2, __float_as_int(v))); }
#define DPP_F(v, ctrl) __builtin_bit_cast(float, __builtin_amdgcn_update_dpp(0, __builtin_bit_cast(int, (v)), (ctrl), 0xF, 0xF, true))
#define RDL_F(v, l) __builtin_bit_cast(float, __builtin_amdgcn_readlane(__builtin_bit_cast(int, (v)), (l)))
__device__ __forceinline__ float wave_sum(float v, int) {
    v += DPP_F(v, 0xB1); v += DPP_F(v, 0x4E); v += DPP_F(v, 0x141); v += DPP_F(v, 0x140);
    return (RDL_F(v, 0) + RDL_F(v, 16)) + (RDL_F(v, 32) + RDL_F(v, 48));
}
__device__ __forceinline__ float wave_max(float v) {
    v = fmaxf(v, DPP_F(v, 0xB1)); v = fmaxf(v, DPP_F(v, 0x4E)); v = fmaxf(v, DPP_F(v, 0x141)); v = fmaxf(v, DPP_F(v, 0x140));
    return fmaxf(fmaxf(RDL_F(v, 0), RDL_F(v, 16)), fmaxf(RDL_F(v, 32), RDL_F(v, 48)));
}
__device__ __forceinline__ int tid_of(int wv) { int l; asm volatile("v_mbcnt_lo_u32_b32 %0, -1, 0\n\tv_mbcnt_hi_u32_b32 %0, -1, %0" : "=v"(l)); return wv * 64 + l; }
__device__ __forceinline__ int opaque_bid() { int b = blockIdx.x; asm volatile("" : "+s"(b)); return b; }
__device__ __forceinline__ unsigned char* opaque_ptr(unsigned char* p) { size_t z = 0; asm volatile("" : "+s"(z)); return p + z; }
#define LDS_WAIT() asm volatile("s_waitcnt lgkmcnt(0)" ::: "memory")
#define VM_WAIT() asm volatile("s_waitcnt vmcnt(0)" ::: "memory")

namespace pg8 {
constexpr int BM = 256, BK = 64, HALF = 128, HTB = HALF * BK * 2, STAGE_BYTES = 8 * HTB, NXCD = 8, WGM = 8;
__host__ __device__ __forceinline__ int lds_byte(int r, int c) { const int st = (r >> 4) * 2 + (c >> 5), rr = r & 15, cc = c & 31, ob = rr * 64 + cc * 2; return st * 1024 + (ob ^ (((ob >> 9) & 1) << 5)); }
__host__ __device__ __forceinline__ void stage_rc(int b, int& R, int& C) { const int st = b / 1024, sb = b % 1024, swz = sb ^ (((sb >> 9) & 1) << 5); R = (st >> 1) * 16 + swz / 64; C = (st & 1) * 32 + (swz % 64) / 2; }
__host__ __device__ __forceinline__ int perm32(int rho) { const int n = rho >> 4, i = rho & 15; return 8 * (i >> 2) + 4 * n + (i & 3); }

struct Unit { int pm, pn, e, j, row0, rows; };
typedef int v8i32 __attribute__((ext_vector_type(8)));
typedef int v4i32_t __attribute__((ext_vector_type(4)));
__device__ __forceinline__ v8i32 cat8(bf16x8 lo, bf16x8 hi) { typedef int v4i32 __attribute__((ext_vector_type(4))); const v4i32 a = __builtin_bit_cast(v4i32, lo), b = __builtin_bit_cast(v4i32, hi); return (v8i32){a.x, a.y, a.z, a.w, b.x, b.y, b.z, b.w}; }

template <int WGM_ = WGM>
__device__ __forceinline__ bool order_map(int i, int G, int c, int nM, int nN, int& pm, int& pn) {
    const int nwg = nM * nN; const int L = i * G + c; if (L >= nwg) return false;
    int wgid = L; { const int q = nwg / NXCD, r = nwg % NXCD, xcd = wgid % NXCD, off = wgid / NXCD; wgid = (xcd < r ? xcd * (q + 1) : r * (q + 1) + (xcd - r) * q) + off; }
    const int nig = WGM_ * nN, gid = wgid / nig, fm = gid * WGM_, gsz = (nM - fm) < WGM_ ? (nM - fm) : WGM_;
    pm = fm + ((wgid % nig) % gsz); pn = (wgid % nig) / gsz; return true;
}

struct PlainSched {
    static constexpr bool DYN_A = false;
    const char* A; const char* Bt; int K, nM, nN, G, c;
    __device__ __forceinline__ bool next(int i, Unit& u) const { int pm, pn; if (!order_map(i, G, c, nM, nN, pm, pn)) return false; u.pm = pm; u.pn = pn; u.e = 0; u.j = 0; u.row0 = pm * BM; u.rows = BM; return true; }
    __device__ __forceinline__ const char* a_ptr() const { return A; }
    __device__ __forceinline__ const char* b_ptr() const { return Bt; }
    __device__ __forceinline__ unsigned a_off(const Unit& u) const { return (unsigned)u.row0 * (unsigned)K * 2u; }
    __device__ __forceinline__ unsigned b_off(const Unit& u) const { return (unsigned)u.pn * (unsigned)(BM * K * 2); }
    __device__ __forceinline__ void a_voff(const Unit&, unsigned (&v)[2][2], int wv) const {
        int tid = tid_of(wv); asm volatile("" : "+v"(tid));
#pragma unroll
        for (int i = 0; i < 2; ++i) { int R, C; stage_rc(tid * 16 + i * 8192, R, C);
#pragma unroll
            for (int h = 0; h < 2; ++h) v[h][i] = (unsigned)((h * HALF + R) * K + C) * 2u; }
    }
};

template <class Epi, class Sched, bool ALIGN_EPI, int MODE = 0>
__device__ __forceinline__ void gemm_phase(LAS unsigned char* lds, const int K, const Sched& S, const Epi& E, const int wv) {
    asm volatile("" : "+s"(lds));
    int tid = tid_of(wv); asm volatile("" : "+v"(tid));
    const int wid = __builtin_amdgcn_readfirstlane(tid >> 6), lane = tid & 63, wr = wid >> 2, wc = wid & 3, fr = lane & 15, fq = lane >> 4;
    const int nt = K / BK;
    unsigned voffB;
    { int R, C; stage_rc(tid * 16, R, C); const int Rb = Epi::PERM ? ((R & ~31) + perm32(R & 31)) : R; voffB = (unsigned)(Rb * K + C) * 2u; }
    const unsigned q64 = (unsigned)(64 * K * 2);
    const unsigned kstep = (unsigned)(BK * 2);
    const unsigned hstep = (unsigned)(HALF * K * 2);
    const __amdgpu_buffer_rsrc_t rsA = __builtin_amdgcn_make_buffer_rsrc((void*)S.a_ptr(), 0, 0xffffffff, 0x00020000);
    const __amdgpu_buffer_rsrc_t rsB = __builtin_amdgcn_make_buffer_rsrc((void*)S.b_ptr(), 0, 0xffffffff, 0x00020000);
    const unsigned ldsw = (unsigned)wid * 1024u;
    const int aoff = lds_byte(wr * 64 + fr, fq * 8), boff = lds_byte(wc * 32 + fr, fq * 8);
#define PG8_SA(b, h) (((b) * 2 + (h)) * HTB)
#define PG8_SB(b, h) ((4 + (b) * 2 + (h)) * HTB)
#define PG8_STAGE_(rs, bufoff, v0, s0, v1, s1) do { \
        __builtin_amdgcn_raw_ptr_buffer_load_lds(rs, (LAS void*)(lds + (bufoff) + ldsw), 16, (v0), (s0), 0, 0); \
        __builtin_amdgcn_raw_ptr_buffer_load_lds(rs, (LAS void*)(lds + (bufoff) + ldsw + 8192), 16, (v1), (s1), 0, 0); } while (0)
#define PG8_STAGE_B(bufoff, soff, unused) PG8_STAGE_(rsB, bufoff, voffB, (soff), voffB, (soff) + q64)
#define PG8_STAGE_A(bufoff, soff, h) do { if constexpr (Sched::DYN_A) PG8_STAGE_(rsA, bufoff, cvA[h][0], (soff), cvA[h][1], (soff)); \
        else PG8_STAGE_(rsA, bufoff, cvA[0][0], (soff) + (h) * 2u * q64, cvA[0][0], (soff) + (h) * 2u * q64 + q64); } while (0)
#define PG8_LDA(dst, b, h) do { _Pragma("unroll") for (int m = 0; m < 4; ++m) _Pragma("unroll") for (int k = 0; k < 2; ++k) dst[m][k] = *(const LAS bf16x8*)(lds + PG8_SA(b, h) + aoff + m * 2048 + k * 1024); } while (0)
#define PG8_LDB(dst, b, h) do { _Pragma("unroll") for (int n = 0; n < 2; ++n) _Pragma("unroll") for (int k = 0; k < 2; ++k) dst[n][k] = *(const LAS bf16x8*)(lds + PG8_SB(b, h) + boff + n * 2048 + k * 1024); } while (0)
#define PG8_MMA(ai, bj, At, Bt) do { __builtin_amdgcn_s_setprio(1); _Pragma("unroll") for (int m = 0; m < 4; ++m) _Pragma("unroll") for (int n = 0; n < 2; ++n) { \
        if constexpr (MODE == 1) { acc[ai][bj][m][n] = __builtin_amdgcn_mfma_scale_f32_16x16x128_f8f6f4(cat8(Bt[n][0], Bt[n][1]), cat8(At[m][0], At[m][1]), acc[ai][bj][m][n], 0, 0, 0, 0x7f7f7f7f, 0, 0x7f7f7f7f); } \
        else if constexpr (MODE == 2) { _Pragma("unroll") for (int k = 0; k < 2; ++k) acc[ai][bj][m][n] = __builtin_bit_cast(f32x4, __builtin_amdgcn_mfma_i32_16x16x64_i8(__builtin_bit_cast(v4i32_t, Bt[n][k]), __builtin_bit_cast(v4i32_t, At[m][k]), __builtin_bit_cast(v4i32_t, acc[ai][bj][m][n]), 0, 0, 0)); } \
        else { _Pragma("unroll") for (int k = 0; k < 2; ++k) acc[ai][bj][m][n] = __builtin_amdgcn_mfma_f32_16x16x32_bf16(Bt[n][k], At[m][k], acc[ai][bj][m][n], 0, 0, 0); } } \
        __builtin_amdgcn_s_setprio(0); } while (0)
#define PG8_WAIT_V(n) asm volatile("s_waitcnt vmcnt(" #n ")" ::: "memory")
#define PG8_WAIT_L(n) asm volatile("s_waitcnt lgkmcnt(" #n ")" ::: "memory")
#define PG8_BAR __builtin_amdgcn_s_barrier()
#define PG8_SCHED __builtin_amdgcn_sched_barrier(0)
    Unit cur, nxt; int ui = 0;
    if (!S.next(0, cur)) return;
    f32x4 acc[2][2][4][2];
    { float z0 = 0.f; asm volatile("" : "+v"(z0));
#pragma unroll
    for (int a = 0; a < 2; ++a)
#pragma unroll
        for (int b = 0; b < 2; ++b)
#pragma unroll
            for (int m = 0; m < 4; ++m)
#pragma unroll
                for (int n = 0; n < 2; ++n) acc[a][b][m][n] = (f32x4){z0, z0, z0, z0}; }
    bf16x8 At[4][2], B0[2][2], B1[2][2];
    unsigned cvA[2][2];
    S.a_voff(cur, cvA, wv);
    unsigned cA = S.a_off(cur), cB = S.b_off(cur);
    if constexpr (Epi::PREF) E.prefetch(cur, lds + LDS_PTAB, wv);
    PG8_STAGE_B(PG8_SB(0, 0), cB, voffB); PG8_STAGE_B(PG8_SB(0, 1), cB + hstep, voffB); PG8_STAGE_A(PG8_SA(0, 0), cA, 0); PG8_STAGE_A(PG8_SA(0, 1), cA, 1);
    if (wr == 1) PG8_BAR;
    PG8_WAIT_V(2); PG8_BAR;
    PG8_STAGE_B(PG8_SB(1, 0), cB + kstep, voffB); PG8_STAGE_A(PG8_SA(1, 0), cA + kstep, 0); PG8_STAGE_B(PG8_SB(1, 1), cB + hstep + kstep, voffB);
    PG8_WAIT_V(6); PG8_BAR;
    for (;;) {
        const bool has_next = S.next(ui + 1, nxt);
        unsigned nA = cA, nB = cB;
        if (has_next) { nA = S.a_off(nxt); nB = S.b_off(nxt); }
        if constexpr (Sched::DYN_A) { if (has_next) S.a_dma(nxt, lds + LDS_NVA, wv); }
#pragma unroll 1
        for (int t = 0; t < nt; t += 2) {
            const bool last = (t == nt - 2);
            const unsigned a1 = cA + (unsigned)(t + 1) * kstep;
            const unsigned a2 = last ? nA : cA + (unsigned)(t + 2) * kstep, b2 = last ? nB : cB + (unsigned)(t + 2) * kstep;
            const unsigned a3 = a2 + kstep, b3 = b2 + kstep;
            unsigned nx1[2] = {cvA[1][0], cvA[1][1]};
            if constexpr (Sched::DYN_A) { if (last && has_next) { unsigned q[4]; S.a_fetch(lds + LDS_NVA, wv, q); cvA[0][0] = q[0]; cvA[0][1] = q[1]; nx1[0] = q[2]; nx1[1] = q[3]; } }
            if constexpr (Epi::HOOK_T >= 0) { if (t == Epi::HOOK_T) E.mid(acc, cur, wr, wc, fr, fq); }
            PG8_LDB(B0, 0, 0); PG8_LDB(B1, 0, 1); PG8_SCHED; PG8_LDA(At, 0, 0); PG8_STAGE_A(PG8_SA(1, 1), a1, 1);
            if constexpr (Sched::DYN_A) { cvA[1][0] = nx1[0]; cvA[1][1] = nx1[1]; }
            PG8_WAIT_V(8); PG8_WAIT_L(0); PG8_BAR; PG8_MMA(0, 0, At, B0); PG8_MMA(0, 1, At, B1); PG8_BAR; PG8_SCHED;
            PG8_LDA(At, 0, 1); PG8_STAGE_B(PG8_SB(0, 0), b2, voffB); PG8_STAGE_B(PG8_SB(0, 1), b2 + hstep, voffB); PG8_STAGE_A(PG8_SA(0, 0), a2, 0);
            PG8_WAIT_V(8); PG8_WAIT_L(0); PG8_BAR; PG8_MMA(1, 0, At, B0); PG8_MMA(1, 1, At, B1); PG8_BAR; PG8_SCHED;
            PG8_LDB(B0, 1, 0); PG8_LDB(B1, 1, 1); PG8_SCHED; PG8_LDA(At, 1, 0); PG8_STAGE_A(PG8_SA(0, 1), a2, 1);
            PG8_WAIT_V(8); PG8_WAIT_L(0); PG8_BAR; PG8_MMA(0, 0, At, B0); PG8_MMA(0, 1, At, B1); PG8_BAR; PG8_SCHED;
            PG8_LDA(At, 1, 1); PG8_STAGE_B(PG8_SB(1, 0), b3, voffB); PG8_STAGE_B(PG8_SB(1, 1), b3 + hstep, voffB); PG8_STAGE_A(PG8_SA(1, 0), a3, 0);
            PG8_WAIT_V(8); PG8_WAIT_L(0); PG8_BAR; PG8_MMA(1, 0, At, B0); PG8_MMA(1, 1, At, B1); PG8_BAR; PG8_SCHED;
        }
        if constexpr (ALIGN_EPI) { if (wr == 0) PG8_BAR; }
        if constexpr (Epi::PREF) E.run(acc, cur, wr, wc, lds + LDS_PTAB + (ui & 1) * PTAB_BYTES); else E(acc, cur, wr, wc, fr, fq);
        if (!has_next) break;
        { float z0 = 0.f; asm volatile("" : "+v"(z0));
#pragma unroll
        for (int a = 0; a < 2; ++a)
#pragma unroll
            for (int b = 0; b < 2; ++b)
#pragma unroll
                for (int m = 0; m < 4; ++m)
#pragma unroll
                    for (int n = 0; n < 2; ++n) acc[a][b][m][n] = (f32x4){z0, z0, z0, z0}; }
        cur = nxt; cA = nA; cB = nB; ++ui;
        if constexpr (Epi::PREF) E.prefetch(cur, lds + LDS_PTAB + (ui & 1) * PTAB_BYTES, wv);
        if constexpr (ALIGN_EPI) { if (wr == 1) PG8_BAR; }
    }
    PG8_WAIT_V(0);
    if constexpr (!ALIGN_EPI) { if (wr == 0) PG8_BAR; }
    PG8_BAR;
#undef PG8_SA
#undef PG8_SB
#undef PG8_STAGE_
#undef PG8_STAGE_A
#undef PG8_STAGE_B
#undef PG8_LDA
#undef PG8_LDB
#undef PG8_MMA
#undef PG8_WAIT_V
#undef PG8_WAIT_L
#undef PG8_BAR
#undef PG8_SCHED
}

struct EpiBf16 {
    static constexpr bool PERM = true; static constexpr int HOOK_T = -1; static constexpr bool PREF = false;
    bf16_t* O; int ldc; const float* bias; int noepi; float scale;
    __device__ __forceinline__ void mid(f32x4 (&)[2][2][4][2], const Unit&, int, int, int, int) const {}
    __device__ __forceinline__ void operator()(const f32x4 (&acc)[2][2][4][2], const Unit& u, int wr, int wc, int fr, int fq) const {
        { const int l_ = tid_of(0); fr = l_ & 15; fq = l_ >> 4; }
        if (noepi) { if (acc[0][0][0][0][0] == 1.2345e-30f) O[0] = 0; return; }
        int row0 = u.row0 + wr * 64 + fr; asm volatile("" : "+v"(row0)); int col0 = u.pn * BM + wc * 32 + 8 * fq; asm volatile("" : "+v"(col0));
        f32x4 bv[2][2];
#pragma unroll
        for (int bj = 0; bj < 2; ++bj)
#pragma unroll
            for (int n = 0; n < 2; ++n) bv[bj][n] = bias ? *(const f32x4*)(bias + col0 + bj * HALF + 4 * n) : (f32x4){0.f, 0.f, 0.f, 0.f};
#pragma unroll
        for (int ai = 0; ai < 2; ++ai)
#pragma unroll
            for (int m = 0; m < 4; ++m) { bf16_t* rowp = O + (size_t)(row0 + ai * HALF + m * 16) * ldc + col0;
#pragma unroll
                for (int bj = 0; bj < 2; ++bj) { const f32x4 v0 = acc[ai][bj][m][0] * scale + bv[bj][0], v1 = acc[ai][bj][m][1] * scale + bv[bj][1];
                    u32x4 w; w.x = cvt_pk_bf16(v0[0], v0[1]); w.y = cvt_pk_bf16(v0[2], v0[3]); w.z = cvt_pk_bf16(v1[0], v1[1]); w.w = cvt_pk_bf16(v1[2], v1[3]);
                    *(u32x4*)(rowp + bj * HALF) = w; } }
    }
};
struct EpiZI8 {
    static constexpr bool PERM = true; static constexpr int HOOK_T = -1; static constexpr bool PREF = true;
    bf16_t* O; float* ZS; unsigned char* ZG; const unsigned char* wsb; unsigned rsc_off, csc_off;
    __device__ __forceinline__ void mid(f32x4 (&)[2][2][4][2], const Unit&, int, int, int, int) const {}
    __device__ __forceinline__ void prefetch(const Unit& u, LAS unsigned char* tab, int wv) const {
        const int t = tid_of(wv);
        const unsigned vo = (t < 256) ? (rsc_off + (unsigned)(u.row0 + t) * 4u) : (csc_off + (unsigned)(u.pn * BM + t - 256) * 4u);
        const __amdgpu_buffer_rsrc_t rs = __builtin_amdgcn_make_buffer_rsrc((void*)wsb, 0, 0xffffffff, 0x00020000);
        __builtin_amdgcn_raw_ptr_buffer_load_lds(rs, (LAS void*)(tab + wv * 256), 4, vo, 0, 0, 0);
    }
    __device__ __forceinline__ void run(const f32x4 (&acc)[2][2][4][2], const Unit& u, int wr, int wc, const LAS unsigned char* tab) const {
        int fr, fq; const int lane_ = tid_of(0); fr = lane_ & 15; fq = lane_ >> 4;
        int row0 = u.row0 + wr * 64 + fr; asm volatile("" : "+v"(row0)); int col0 = u.pn * BM + wc * 32 + 8 * fq; asm volatile("" : "+v"(col0));
        const LAS float* tf = (const LAS float*)tab;
        f32x4 cs[2][2];
#pragma unroll
        for (int bj = 0; bj < 2; ++bj)
#pragma unroll
            for (int n = 0; n < 2; ++n) cs[bj][n] = *(const LAS f32x4*)(tf + 256 + bj * HALF + wc * 32 + 8 * fq + 4 * n);
#pragma unroll
        for (int ai = 0; ai < 2; ++ai)
#pragma unroll
            for (int m = 0; m < 4; ++m) { const int r = row0 + ai * HALF + m * 16; const float rs = tf[ai * HALF + wr * 64 + m * 16 + fr]; f32x4 vq[2][2];
#pragma unroll
                for (int bj = 0; bj < 2; ++bj) { const v4i32_t i0 = __builtin_bit_cast(v4i32_t, acc[ai][bj][m][0]), i1 = __builtin_bit_cast(v4i32_t, acc[ai][bj][m][1]);
                    const f32x4 v0 = (f32x4){(float)i0.x, (float)i0.y, (float)i0.z, (float)i0.w} * rs * cs[bj][0], v1 = (f32x4){(float)i1.x, (float)i1.y, (float)i1.z, (float)i1.w} * rs * cs[bj][1];
                    if (u.pn >= ZO_GL0 / BM) {
                        unsigned w0 = 0, w1 = 0;
#pragma unroll
                        for (int j = 0; j < 4; ++j) { w0 |= (unsigned)(int)rintf(255.0f * sigmoidf_(v0[j])) << (8 * j); w1 |= (unsigned)(int)rintf(255.0f * sigmoidf_(v1[j])) << (8 * j); }
                        *(u32x2*)(ZG + (size_t)r * 2048 + (col0 - ZO_GL0) + bj * HALF) = (u32x2){w0, w1};
                    } else { vq[bj][0] = v0; vq[bj][1] = v1; } }
                if (u.pn < ZO_GL0 / BM) {
                    float am = 1e-30f;
#pragma unroll
                    for (int bj = 0; bj < 2; ++bj)
#pragma unroll
                        for (int n = 0; n < 2; ++n) am = fmaxf(am, fmaxf(fmaxf(fabsf(vq[bj][n].x), fabsf(vq[bj][n].y)), fmaxf(fabsf(vq[bj][n].z), fabsf(vq[bj][n].w))));
                    am = fmaxf(am, shflx(am, 16, lane_)); am = fmaxf(am, shflx(am, 32, lane_));
                    const float inv = 127.0f * __builtin_amdgcn_rcpf(am) * 0.999f;
                    if (fq == 0) ZS[(size_t)r * 40 + u.pn * 4 + wc] = am * (1.0f / (127.0f * 0.999f));
#pragma unroll
                    for (int bj = 0; bj < 2; ++bj) { unsigned w0 = 0, w1 = 0;
#pragma unroll
                        for (int j = 0; j < 4; ++j) { w0 |= (unsigned)((int)rintf(vq[bj][0][j] * inv) + 128) << (8 * j); w1 |= (unsigned)((int)rintf(vq[bj][1][j] * inv) + 128) << (8 * j); }
                        *(u32x2*)((unsigned char*)O + (size_t)r * 2560 + col0 + bj * HALF) = (u32x2){w0, w1}; } } }
    }
    __device__ __forceinline__ void operator()(const f32x4 (&)[2][2][4][2], const Unit&, int, int, int, int) const {}
};
struct EpiMerged {
    static constexpr bool PERM = true; static constexpr int HOOK_T = 8; static constexpr bool PREF = false;
    bf16_t* O; const unsigned char* ZG;
    __device__ __forceinline__ void mid(f32x4 (&acc)[2][2][4][2], const Unit& u, int wr, int wc, int fr, int fq) const {
        { const int l_ = tid_of(0); fr = l_ & 15; fq = l_ >> 4; }
        int row0 = u.row0 + wr * 64 + fr; asm volatile("" : "+v"(row0)); int col0 = u.pn * BM + wc * 32 + 8 * fq; asm volatile("" : "+v"(col0));
        u32x2 g0[2][4][2], g1[2][4][2];
#pragma unroll
        for (int ai = 0; ai < 2; ++ai)
#pragma unroll
            for (int m = 0; m < 4; ++m) { const unsigned char* zr = ZG + (size_t)(row0 + ai * HALF + m * 16) * 2048 + col0;
#pragma unroll
                for (int bj = 0; bj < 2; ++bj) { g0[ai][m][bj] = *(const u32x2*)(zr + bj * HALF); g1[ai][m][bj] = *(const u32x2*)(zr + 1024 + bj * HALF); } }
#pragma unroll
        for (int ai = 0; ai < 2; ++ai)
#pragma unroll
            for (int m = 0; m < 4; ++m)
#pragma unroll
                for (int bj = 0; bj < 2; ++bj) {
                    const unsigned a0[2] = {g0[ai][m][bj].x, g0[ai][m][bj].y}, a1[2] = {g1[ai][m][bj].x, g1[ai][m][bj].y};
#pragma unroll
                    for (int n = 0; n < 2; ++n)
#pragma unroll
                        for (int j = 0; j < 4; ++j) { const float u0 = fmaxf((float)((a0[n] >> (8 * j)) & 0xffu), 1.0f), u1 = (float)((a1[n] >> (8 * j)) & 0xffu);
                            acc[ai][bj][m][n][j] *= u1 * __builtin_amdgcn_rcpf(u0); } }
    }
    __device__ __forceinline__ void operator()(const f32x4 (&acc)[2][2][4][2], const Unit& u, int wr, int wc, int fr, int fq) const {
        { const int l_ = tid_of(0); fr = l_ & 15; fq = l_ >> 4; }
        int row0 = u.row0 + wr * 64 + fr; asm volatile("" : "+v"(row0)); int col0 = u.pn * BM + wc * 32 + 8 * fq; asm volatile("" : "+v"(col0));
        u32x2 g0[2][4][2];
#pragma unroll
        for (int ai = 0; ai < 2; ++ai)
#pragma unroll
            for (int m = 0; m < 4; ++m) { const unsigned char* zr = ZG + (size_t)(row0 + ai * HALF + m * 16) * 2048 + col0;
#pragma unroll
                for (int bj = 0; bj < 2; ++bj) g0[ai][m][bj] = *(const u32x2*)(zr + bj * HALF); }
#pragma unroll
        for (int ai = 0; ai < 2; ++ai)
#pragma unroll
            for (int m = 0; m < 4; ++m) { bf16_t* orow = O + (size_t)(row0 + ai * HALF + m * 16) * D + col0;
#pragma unroll
                for (int bj = 0; bj < 2; ++bj) { const unsigned a0[2] = {g0[ai][m][bj].x, g0[ai][m][bj].y};
                    float o[8];
#pragma unroll
                    for (int n = 0; n < 2; ++n)
#pragma unroll
                        for (int j = 0; j < 4; ++j) o[4 * n + j] = acc[ai][bj][m][n][j] * (fmaxf((float)((a0[n] >> (8 * j)) & 0xffu), 1.0f) * (1.0f / 255.0f));
                    u32x4 w; w.x = cvt_pk_bf16(o[0], o[1]); w.y = cvt_pk_bf16(o[2], o[3]); w.z = cvt_pk_bf16(o[4], o[5]); w.w = cvt_pk_bf16(o[6], o[7]);
                    *(u32x4*)(orow + bj * HALF) = w; } }
    }
};
struct EpiResid {
    static constexpr bool PERM = true; static constexpr int HOOK_T = -1; static constexpr bool PREF = false;
    bf16_t* X; bf16_t* XO; const float* gate;
    __device__ __forceinline__ void mid(f32x4 (&)[2][2][4][2], const Unit&, int, int, int, int) const {}
    __device__ __forceinline__ void operator()(const f32x4 (&acc)[2][2][4][2], const Unit& u, int wr, int wc, int fr, int fq) const {
        { const int l_ = tid_of(0); fr = l_ & 15; fq = l_ >> 4; }
        int row0 = u.row0 + wr * 64 + fr; asm volatile("" : "+v"(row0)); int col0 = u.pn * BM + wc * 32 + 8 * fq; asm volatile("" : "+v"(col0));
        const float* gp = gate + (size_t)(u.row0 / SEQ) * (6 * D) + col0;
        f32x4 gv[2][2];
#pragma unroll
        for (int bj = 0; bj < 2; ++bj)
#pragma unroll
            for (int n = 0; n < 2; ++n) gv[bj][n] = *(const f32x4*)(gp + bj * HALF + 4 * n);
#pragma unroll
        for (int ai = 0; ai < 2; ++ai) {
            u32x4 xv[4][2];
#pragma unroll
            for (int m = 0; m < 4; ++m) { const bf16_t* rowp = X + (size_t)(row0 + ai * HALF + m * 16) * D + col0;
#pragma unroll
                for (int bj = 0; bj < 2; ++bj) xv[m][bj] = *(const u32x4*)(rowp + bj * HALF); }
#pragma unroll
            for (int m = 0; m < 4; ++m) { bf16_t* rowo = XO + (size_t)(row0 + ai * HALF + m * 16) * D + col0;
#pragma unroll
                for (int bj = 0; bj < 2; ++bj) { const u32x4 p = xv[m][bj];
                    const f32x4 o0 = (f32x4){bflo(p.x), bfhi(p.x), bflo(p.y), bfhi(p.y)} + gv[bj][0] * acc[ai][bj][m][0], o1 = (f32x4){bflo(p.z), bfhi(p.z), bflo(p.w), bfhi(p.w)} + gv[bj][1] * acc[ai][bj][m][1];
                    u32x4 w; w.x = cvt_pk_bf16(o0[0], o0[1]); w.y = cvt_pk_bf16(o0[2], o0[3]); w.z = cvt_pk_bf16(o1[0], o1[1]); w.w = cvt_pk_bf16(o1[2], o1[3]);
                    *(u32x4*)(rowo + bj * HALF) = w; } }
            asm volatile("" ::: "memory"); }
    }
};
struct EpiSwiglu {
    static constexpr bool PERM = true; static constexpr int HOOK_T = -1; static constexpr bool PREF = true;
    unsigned char* ACT; const float* bias; float wscale;
    __device__ __forceinline__ void mid(f32x4 (&)[2][2][4][2], const Unit&, int, int, int, int) const {}
    __device__ __forceinline__ void operator()(const f32x4 (&)[2][2][4][2], const Unit&, int, int, int, int) const {}
    __device__ __forceinline__ void prefetch(const Unit& u, LAS unsigned char* tab, int wv) const {
        const int t = tid_of(wv) & 255;
        const __amdgpu_buffer_rsrc_t rs = __builtin_amdgcn_make_buffer_rsrc((void*)bias, 0, 0xffffffff, 0x00020000);
        __builtin_amdgcn_raw_ptr_buffer_load_lds(rs, (LAS void*)(tab + (wv & 3) * 256), 4, (unsigned)(u.e * 2048 + (t >> 7) * 1024 + u.pn * HALF + (t & 127)) * 4u, 0, 0, 0);
    }
    __device__ __forceinline__ void run(const f32x4 (&acc)[2][2][4][2], const Unit& u, int wr, int wc, const LAS unsigned char* tab) const {
        int fr, fq; { const int l_ = tid_of(0); fr = l_ & 15; fq = l_ >> 4; }
        int row0 = u.row0 + wr * 64 + fr; asm volatile("" : "+v"(row0)); int cc = u.pn * HALF + wc * 32 + 8 * fq; asm volatile("" : "+v"(cc));
        const LAS float* tf = (const LAS float*)tab + wc * 32 + 8 * fq;
        f32x4 bg[2], bu[2];
#pragma unroll
        for (int n = 0; n < 2; ++n) { bg[n] = *(const LAS f32x4*)(tf + 4 * n); bu[n] = *(const LAS f32x4*)(tf + HALF + 4 * n) + 1.0f; }
#pragma unroll
        for (int ai = 0; ai < 2; ++ai)
#pragma unroll
            for (int m = 0; m < 4; ++m) { unsigned char* rowp = ACT + (size_t)(row0 + ai * HALF + m * 16) * D + cc;
                float o[8];
#pragma unroll
                for (int n = 0; n < 2; ++n)
#pragma unroll
                    for (int j = 0; j < 4; ++j) { float g = acc[ai][0][m][n][j] * wscale + bg[n][j], up = acc[ai][1][m][n][j] * wscale + bu[n][j];
                        g = fminf(g, 7.0f); up = __builtin_amdgcn_fmed3f(up, -6.0f, 8.0f);
                        o[4 * n + j] = g * __builtin_amdgcn_rcpf(1.0f + __builtin_amdgcn_exp2f(g * (-1.702f * 1.4426950408889634f))) * up; }
                int w0 = 0, w1 = 0;
                w0 = __builtin_amdgcn_cvt_pk_fp8_f32(o[0], o[1], w0, false); w0 = __builtin_amdgcn_cvt_pk_fp8_f32(o[2], o[3], w0, true);
                w1 = __builtin_amdgcn_cvt_pk_fp8_f32(o[4], o[5], w1, false); w1 = __builtin_amdgcn_cvt_pk_fp8_f32(o[6], o[7], w1, true);
                *(u32x2*)rowp = (u32x2){(unsigned)w0, (unsigned)w1}; }
    }
};
struct EpiMoeOut {
    static constexpr bool PERM = true; static constexpr int HOOK_T = -1; static constexpr bool PREF = true;
    unsigned char* O; float* SC; const float* bias; float wscale;
    __device__ __forceinline__ void mid(f32x4 (&)[2][2][4][2], const Unit&, int, int, int, int) const {}
    __device__ __forceinline__ void operator()(const f32x4 (&)[2][2][4][2], const Unit&, int, int, int, int) const {}
    __device__ __forceinline__ void prefetch(const Unit& u, LAS unsigned char* tab, int wv) const {
        const int t = tid_of(wv) & 255;
        const __amdgpu_buffer_rsrc_t rs = __builtin_amdgcn_make_buffer_rsrc((void*)bias, 0, 0xffffffff, 0x00020000);
        __builtin_amdgcn_raw_ptr_buffer_load_lds(rs, (LAS void*)(tab + (wv & 3) * 256), 4, (unsigned)(u.e * D + u.pn * BM + t) * 4u, 0, 0, 0);
    }
    __device__ __forceinline__ void run(const f32x4 (&acc)[2][2][4][2], const Unit& u, int wr, int wc, const LAS unsigned char* tab) const {
        int fr, fq; int lane_; { lane_ = tid_of(0); fr = lane_ & 15; fq = lane_ >> 4; }
        int row0 = u.row0 + wr * 64 + fr; asm volatile("" : "+v"(row0)); int col0 = u.pn * BM + wc * 32 + 8 * fq; asm volatile("" : "+v"(col0));
        const LAS float* tf = (const LAS float*)tab;
        f32x4 bv[2][2];
#pragma unroll
        for (int bj = 0; bj < 2; ++bj)
#pragma unroll
            for (int n = 0; n < 2; ++n) bv[bj][n] = *(const LAS f32x4*)(tf + bj * HALF + wc * 32 + 8 * fq + 4 * n);
#pragma unroll
        for (int ai = 0; ai < 2; ++ai)
#pragma unroll
            for (int m = 0; m < 4; ++m) { const size_t r = (size_t)(row0 + ai * HALF + m * 16);
                f32x4 v[2][2]; float am = 1e-30f;
#pragma unroll
                for (int bj = 0; bj < 2; ++bj)
#pragma unroll
                    for (int n = 0; n < 2; ++n) { v[bj][n] = acc[ai][bj][m][n] * wscale + bv[bj][n];
                        am = fmaxf(am, fmaxf(fmaxf(fabsf(v[bj][n].x), fabsf(v[bj][n].y)), fmaxf(fabsf(v[bj][n].z), fabsf(v[bj][n].w)))); }
                am = fmaxf(am, shflx(am, 16, lane_)); am = fmaxf(am, shflx(am, 32, lane_));
                const float inv = 127.0f * __builtin_amdgcn_rcpf(am) * 0.999f;
                if (fq == 0) SC[r * 16 + wc * 4 + u.pn] = am * (1.0f / (127.0f * 0.999f));
#pragma unroll
                for (int bj = 0; bj < 2; ++bj) { unsigned w0 = 0, w1 = 0;
#pragma unroll
                    for (int j = 0; j < 4; ++j) { w0 |= (unsigned)((int)rintf(v[bj][0][j] * inv) + 128) << (8 * j); w1 |= (unsigned)((int)rintf(v[bj][1][j] * inv) + 128) << (8 * j); }
                    *(u32x2*)(O + r * D + col0 + bj * HALF) = (u32x2){w0, w1}; } }
    }
};
}

#define XB_TMO      128
#define XB_XCNT(j)  (256  + 64 * (j))
#define XB_XSUB(j)  (1280 + 64 * (j))
#define XB_XGEN(j)  (2304 + 64 * (j))
#define XB_TOP      3328
#define XB_TOPGEN   3392
#define XCD_BAR_WORDS 3456
#define XB_SPIN_CAP (1u << 18)
__device__ __forceinline__ unsigned xb_ld(unsigned* p)              { return __hip_atomic_load(p, __ATOMIC_RELAXED, __HIP_MEMORY_SCOPE_AGENT); }
__device__ __forceinline__ unsigned xb_add(unsigned* p, unsigned v) { return __hip_atomic_fetch_add(p, v, __ATOMIC_RELAXED, __HIP_MEMORY_SCOPE_AGENT); }
__device__ __forceinline__ unsigned xb_xcc_id() { return (unsigned)__builtin_amdgcn_s_getreg((3 << 11) | 20) & 0xFu; }
#define XB_SPIN(cond, bar) do { unsigned _sp = 0; while (cond) { __builtin_amdgcn_s_sleep(1); \
    if ((++_sp & 255u) == 0u) { if (xb_ld(&(bar)[XB_TMO])) break; if (_sp > XB_SPIN_CAP) { atomicAdd(&(bar)[XB_TMO], 1u); break; } } } } while (0)
struct XcdBarrier { unsigned* bar; unsigned x; volatile LAS unsigned* st; int wv; };
__device__ __forceinline__ XcdBarrier xcd_barrier_post(unsigned* bar, volatile LAS unsigned* st, int wv) {
    XcdBarrier b; b.bar = bar; b.x = xb_xcc_id(); b.st = st; b.wv = wv;
    if (tid_of(wv) == 0) (void)xb_add(&bar[XB_XCNT(b.x)], 1u);
    return b;
}
__device__ __forceinline__ void xcd_barrier_complete(unsigned* bar, unsigned x, unsigned& nloc, unsigned& nx) {
    const unsigned G = gridDim.x * gridDim.y * gridDim.z;
    unsigned sum, cnt, mine, sp = 0u;
    for (;;) {
        sum = 0u; cnt = 0u; mine = 0u;
#pragma unroll
        for (unsigned j = 0; j < 16; ++j) { const unsigned c = xb_ld(&bar[XB_XCNT(j)]); sum += c; cnt += (c > 0u) ? 1u : 0u; mine = (j == x) ? c : mine; }
        if (sum == G) break;
        __builtin_amdgcn_s_sleep(1);
        if ((++sp & 255u) == 0u) { if (xb_ld(&bar[XB_TMO])) break; if (sp > XB_SPIN_CAP) { atomicAdd(&bar[XB_TMO], 1u); break; } }
    }
    nloc = mine > 0u ? mine : 1u; nx = cnt > 0u ? cnt : 1u;
}
__device__ __forceinline__ void xcd_barrier(const XcdBarrier& b) {
    asm volatile("s_waitcnt vmcnt(0)" ::: "memory");
    __syncthreads();
    if (tid_of(b.wv) == 0) {
        size_t zb = 0; asm volatile("" : "+s"(zb)); unsigned* bar = b.bar + zb; unsigned bx = b.x; asm volatile("" : "+s"(bx));
        __builtin_amdgcn_s_waitcnt(0);
        unsigned nloc = b.st[0], nx = b.st[1];
        if (nloc == 0u) { xcd_barrier_complete(bar, bx, nloc, nx); b.st[0] = nloc; b.st[1] = nx; }
        const unsigned old = xb_add(&bar[XB_XSUB(bx)], 1u);
        const unsigned gen = old / nloc;
        if (old + 1u == (gen + 1u) * nloc) {
            __builtin_amdgcn_fence(__ATOMIC_RELEASE, "agent");
            asm volatile("s_waitcnt vmcnt(0)" ::: "memory");
            const unsigned og = xb_add(&bar[XB_TOP], 1u);
            const unsigned tg = og / nx;
            if (og + 1u == (tg + 1u) * nx) xb_add(&bar[XB_TOPGEN], 1u);
            else XB_SPIN(xb_ld(&bar[XB_TOPGEN]) == tg, bar);
            __builtin_amdgcn_fence(__ATOMIC_ACQUIRE, "agent");
            xb_add(&bar[XB_XGEN(bx)], 1u);
            asm volatile("s_waitcnt vmcnt(0)" ::: "memory");
        } else {
            XB_SPIN(xb_ld(&bar[XB_XGEN(bx)]) == gen, bar);
            __builtin_amdgcn_fence(__ATOMIC_ACQUIRE, "agent");
            asm volatile("s_waitcnt vmcnt(0)" ::: "memory");
        }
    }
    __syncthreads();
}

struct Args { const float* in[26]; float* out; unsigned char* ws; int ph_lo, ph_hi; };
enum { I_X = 0, I_C, I_N1G, I_N2G, I_WADA, I_BADA, I_WIN, I_CONVW, I_CONVB, I_WRGA, I_BRGA, I_WRGX, I_BRGX, I_LAM, I_WPOOL, I_PSCALE, I_WUPA, I_WUPB, I_WOUT, I_WROUTER, I_BROUTER, I_WEIN, I_BEIN, I_WEOUT, I_BEOUT, I_FINALG };

template <int ROWMODE>
__device__ __forceinline__ void tr_item(const float* W, int N, bf16_t* WT, int dst_ld, int dst_off, int k0, int n0, LAS float* scr, int lane) {
    { float tv[32];
#pragma unroll
    for (int i = 0; i < 32; ++i) tv[i] = W[(size_t)(k0 + 2 * i + (lane >> 5)) * N + n0 + (lane & 31)];
#pragma unroll
    for (int i = 0; i < 32; ++i) scr[(2 * i + (lane >> 5)) * 33 + (lane & 31)] = tv[i]; }
    LDS_WAIT();
    const int c = lane & 7;
#pragma unroll
    for (int j = 0; j < 4; ++j) { const int n = (lane >> 3) + 8 * j; const LAS float* s = scr + (8 * c) * 33 + n;
        u32x4 o; o.x = cvt_pk_bf16(s[0 * 33], s[1 * 33]); o.y = cvt_pk_bf16(s[2 * 33], s[3 * 33]); o.z = cvt_pk_bf16(s[4 * 33], s[5 * 33]); o.w = cvt_pk_bf16(s[6 * 33], s[7 * 33]);
        const int nn = n0 + n; int drow = nn;
        if (ROWMODE == 1) { drow = (nn < 1024) ? (256 * (nn >> 7) + (nn & 127)) : (256 * ((nn - 1024) >> 7) + 128 + ((nn - 1024) & 127)); }
        *(u32x4*)(WT + (size_t)drow * dst_ld + dst_off + k0 + 8 * c) = o; }
    LDS_WAIT();
}
template <int ROWMODE>
__device__ __forceinline__ void tr_item_fp8(const float* W, int N, unsigned char* WT, int k0, int n0, LAS float* scr, int lane) {
    { float tv[64];
#pragma unroll
    for (int i = 0; i < 64; ++i) tv[i] = W[(size_t)(k0 + 2 * i + (lane >> 5)) * N + n0 + (lane & 31)];
#pragma unroll
    for (int i = 0; i < 64; ++i) scr[(2 * i + (lane >> 5)) * 33 + (lane & 31)] = tv[i]; }
    LDS_WAIT();
    const int c = lane & 7;
#pragma unroll
    for (int j = 0; j < 4; ++j) { const int n = (lane >> 3) + 8 * j; const LAS float* s = scr + (16 * c) * 33 + n;
        int o[4];
#pragma unroll
        for (int q = 0; q < 4; ++q) { int w = 0; w = __builtin_amdgcn_cvt_pk_fp8_f32(s[(4 * q) * 33] * WEIN_SCALE, s[(4 * q + 1) * 33] * WEIN_SCALE, w, false);
            w = __builtin_amdgcn_cvt_pk_fp8_f32(s[(4 * q + 2) * 33] * WEIN_SCALE, s[(4 * q + 3) * 33] * WEIN_SCALE, w, true); o[q] = w; }
        const int nn = n0 + n; const int drow = (ROWMODE == 0) ? nn : ((nn < 1024) ? (256 * (nn >> 7) + (nn & 127)) : (256 * ((nn - 1024) >> 7) + 128 + ((nn - 1024) & 127)));
        *(u32x4*)(WT + (size_t)drow * 1024 + k0 + 16 * c) = (u32x4){(unsigned)o[0], (unsigned)o[1], (unsigned)o[2], (unsigned)o[3]}; }
    LDS_WAIT();
}
template <int ROWMODE>
__device__ __forceinline__ void tr_job(int item, const float* src, int K, int N, bf16_t* dst, size_t dst_bstride, int dst_ld, int dst_off, LAS float* scr, int lane) {
    const int nnb = N / 32, nkb = K / 64; const int nb = item % nnb; const int r = item / nnb; const int kb = r % nkb; const int bt = r / nkb;
    tr_item<ROWMODE>(src + (size_t)bt * K * N, N, dst + (size_t)bt * dst_bstride, dst_ld, dst_off, 64 * kb, 32 * nb, scr, lane);
}

constexpr int CONV_Q1 = 5, CONV_Q2 = 6;
constexpr int CONV_ITEMS_L = NE * 8 * 64 + NE * 8 * 32, CONV_CHUNKS_L = CONV_ITEMS_L / 8;
__device__ __forceinline__ void conv_expert_item(const Args& a, unsigned char* ws, int l, int r, LAS float* scr, int lane) {
    if (r < NE * 8 * 64) { const int nb = r % 64, r2 = r / 64, kb = r2 % 8, bt = l * NE + r2 / 8;
        tr_item_fp8<1>(a.in[I_WEIN] + (size_t)bt * 1024 * 2048, 2048, (unsigned char*)(ws + WS_WEIN) + (size_t)bt * 2048 * 1024, 128 * kb, 32 * nb, scr, lane); }
    else { r -= NE * 8 * 64; const int nb = r % 32, r2 = r / 32, kb = r2 % 8, bt = l * NE + r2 / 8;
        tr_item_fp8<0>(a.in[I_WEOUT] + (size_t)bt * 1024 * 1024, 1024, (unsigned char*)(ws + WS_WEOUT) + (size_t)bt * 1024 * 1024, 128 * kb, 32 * nb, scr, lane); }
}
__device__ __forceinline__ void conv_drain(const Args& a, int l, int budget, LAS unsigned char* lds, const int wv) {
    asm volatile("" : "+s"(lds));
    int tid_ = tid_of(wv); asm volatile("" : "+v"(tid_)); const int tid = tid_, lane = tid & 63;
    unsigned char* ws = opaque_ptr(a.ws); unsigned* head = (unsigned*)(ws + WS_CTL) + CW_CONVQ + 64 * l;
    LAS float* scr = (LAS float*)(lds + wv * 16896); LAS int* slot = (LAS int*)(lds + LDS_BYTES - 512);
    for (;;) {
        if (budget == 0) break;
        __syncthreads();
        if (tid == 0) *slot = (int)__hip_atomic_fetch_add(head, 1u, __ATOMIC_RELAXED, __HIP_MEMORY_SCOPE_AGENT);
        __syncthreads();
        const int c = __builtin_amdgcn_readfirstlane(*slot);
        if (c >= CONV_CHUNKS_L) break;
        conv_expert_item(a, ws, l, c * 8 + wv, scr, lane);
        if (budget > 0) --budget;
    }
    __syncthreads();
}
__device__ __forceinline__ void phase_prologue(const Args& a, LAS unsigned char* lds, const int wv) {
    asm volatile("" : "+s"(lds));
    int tid_ = tid_of(wv); asm volatile("" : "+v"(tid_)); const int tid = tid_, lane = tid & 63, wave = __builtin_amdgcn_readfirstlane(tid >> 6);
    const int G = gridDim.x;
    unsigned char* ws = opaque_ptr(a.ws); const int bid = opaque_bid();
    {
        LAS float* cact = (LAS float*)lds;
        LAS float* red = (LAS float*)(lds + 32768);
        for (int i = tid; i < NBATCH * D; i += NTHREADS) { const float v = a.in[I_C][i]; cact[i] = v * sigmoidf_(v); }
        __syncthreads();
        float* mod = (float*)(ws + WS_MOD);
        for (int u = bid; u < DEPTH * 96; u += G) {
            const int l = u / 96, cg = u % 96; const int n = cg * 64 + lane;
            const float* w = a.in[I_WADA] + (size_t)l * D * 6144 + n;
            float acc[8] = {0.f, 0.f, 0.f, 0.f, 0.f, 0.f, 0.f, 0.f};
            const int kb = wave * 128;
#pragma unroll 8
            for (int k = 0; k < 128; ++k) { const float wv = w[(size_t)(kb + k) * 6144];
#pragma unroll
                for (int b = 0; b < 8; ++b) acc[b] += cact[b * D + kb + k] * wv; }
#pragma unroll
            for (int b = 0; b < 8; ++b) red[(wave * 8 + b) * 64 + lane] = acc[b];
            __syncthreads();
            { const int b = tid >> 6; float s = 0.f;
#pragma unroll
              for (int w8 = 0; w8 < 8; ++w8) s += red[(w8 * 8 + b) * 64 + lane];
              mod[((size_t)l * NBATCH + b) * 6144 + n] = s + a.in[I_BADA][(size_t)l * 6144 + n]; }
            __syncthreads();
        }
    }
    {
        bf16_t* wrs = (bf16_t*)(ws + WS_WRS);
        for (int idx = bid * NTHREADS + tid; idx < DEPTH * D * NE; idx += G * NTHREADS) { const int e = idx & 31, k = (idx >> 5) & 1023, l = idx >> 15;
            const float w = a.in[I_WROUTER][idx]; const unsigned hi = cvt_pk_bf16(w, 0.f) & 0xffffu; const unsigned lo = cvt_pk_bf16(w - bflo(hi), 0.f) & 0xffffu;
            wrs[((size_t)(l * 2 + 0) * NE + e) * D + k] = (bf16_t)hi; wrs[((size_t)(l * 2 + 1) * NE + e) * D + k] = (bf16_t)lo; }
    }
#if Z_I8
    {
        LAS float* tile = (LAS float*)lds; LAS float* red = (LAS float*)(lds + 1024 * 33 * 4);
        signed char* w8 = (signed char*)(ws + WS_WIN); float* wsc = (float*)(ws + WS_WINSC);
        __syncthreads();
        for (int u = bid; u < DEPTH * (NZ / 32); u += G) {
            const int l = u / (NZ / 32), n0 = (u % (NZ / 32)) * 32; const float* W = a.in[I_WIN] + (size_t)l * D * NZ + n0;
            const int n = tid & 31, kr = tid >> 5;
#pragma unroll 1
            for (int k0 = 0; k0 < 1024; k0 += 256) { float tv[16];
#pragma unroll
                for (int i = 0; i < 16; ++i) tv[i] = W[(size_t)(k0 + 16 * i + kr) * NZ + n];
#pragma unroll
                for (int i = 0; i < 16; ++i) tile[(k0 + 16 * i + kr) * 33 + n] = tv[i]; }
            __syncthreads();
            { float am = 0.f;
#pragma unroll 8
              for (int i = 0; i < 64; ++i) am = fmaxf(am, fabsf(tile[(kr * 64 + i) * 33 + n]));
              red[kr * 32 + n] = am; }
            __syncthreads();
            if (tid < 32) { float am = 1e-30f;
#pragma unroll
                for (int q = 0; q < 16; ++q) am = fmaxf(am, red[q * 32 + tid]);
                red[512 + tid] = 127.0f / am; wsc[(size_t)l * NZ + n0 + tid] = am * (1.0f / 127.0f); }
            __syncthreads();
            { const float inv = red[512 + n]; signed char* dst = w8 + ((size_t)l * NZ + n0 + n) * D + kr * 64;
#pragma unroll
              for (int c = 0; c < 4; ++c) { int w4[4];
#pragma unroll
                  for (int q = 0; q < 4; ++q) { int pk = 0;
#pragma unroll
                      for (int e = 0; e < 4; ++e) pk |= (((int)rintf(tile[(kr * 64 + c * 16 + q * 4 + e) * 33 + n] * inv)) & 0xff) << (8 * e);
                      w4[q] = pk; }
                  *(u32x4*)(dst + 16 * c) = (u32x4){(unsigned)w4[0], (unsigned)w4[1], (unsigned)w4[2], (unsigned)w4[3]}; } }
            __syncthreads();
        }
    }
#endif
    {
        LAS float* scr = (LAS float*)(lds + wave * 16896);
        const int gw = bid * NWAVES + wave, NGW = G * NWAVES;
        constexpr int I_EIN = NE * 8 * 64, I_EOUT = NE * 8 * 32, I_WINI = Z_I8 ? 0 : DEPTH * (Z_FP8 ? 8 : 16) * 144, I_UPA = DEPTH * 16 * 32, I_UPB = DEPTH * 8 * 32, I_OUT = DEPTH * 16 * 32,
                      I_RGA = DEPTH * 8 * 2 * 4, I_RGX = I_RGA, I_POOL = DEPTH * 4 * 2 * 4;
        constexpr int NITEMS = I_EIN + I_EOUT + I_WINI + I_UPA + I_UPB + I_OUT + I_RGA + I_RGX + I_POOL;
        for (int it = gw; it < NITEMS; it += NGW) {
            int r = it;
            if (r < I_EIN) { const int nb = r % 64, r2 = r / 64, kb = r2 % 8, bt = r2 / 8;
                tr_item_fp8<1>(a.in[I_WEIN] + (size_t)bt * 1024 * 2048, 2048, (unsigned char*)(ws + WS_WEIN) + (size_t)bt * 2048 * 1024, 128 * kb, 32 * nb, scr, lane); continue; } r -= I_EIN;
            if (r < I_EOUT) { const int nb = r % 32, r2 = r / 32, kb = r2 % 8, bt = r2 / 8;
                tr_item_fp8<0>(a.in[I_WEOUT] + (size_t)bt * 1024 * 1024, 1024, (unsigned char*)(ws + WS_WEOUT) + (size_t)bt * 1024 * 1024, 128 * kb, 32 * nb, scr, lane); continue; } r -= I_EOUT;
#if Z_I8
#elif Z_FP8
            if (r < I_WINI) { const int nb = r % 144, r2 = r / 144, kb = r2 % 8, bt = r2 / 8;
                tr_item_fp8<0>(a.in[I_WIN] + (size_t)bt * 1024 * NZ, NZ, (unsigned char*)(ws + WS_WIN) + (size_t)bt * NZ * 1024, 128 * kb, 32 * nb, scr, lane); continue; } r -= I_WINI;
#else
            if (r < I_WINI) { tr_job<0>(r, a.in[I_WIN], 1024, NZ, (bf16_t*)(ws + WS_WIN), (size_t)NZ * 1024, 1024, 0, scr, lane); continue; } r -= I_WINI;
#endif
            if (r < I_UPA) { tr_job<0>(r, a.in[I_WUPA], 1024, 1024, (bf16_t*)(ws + WS_WCAT), (size_t)1024 * KCAT, KCAT, 512, scr, lane); continue; } r -= I_UPA;
            if (r < I_UPB) { tr_job<0>(r, a.in[I_WUPB], 512, 1024, (bf16_t*)(ws + WS_WCAT), (size_t)1024 * KCAT, KCAT, 0, scr, lane); continue; } r -= I_UPB;
            if (r < I_OUT) { tr_job<0>(r, a.in[I_WOUT], 1024, 1024, (bf16_t*)(ws + WS_WOUT), (size_t)1024 * 1024, 1024, 0, scr, lane); continue; } r -= I_OUT;
            if (r < I_RGA) { tr_job<0>(r, a.in[I_WRGA], 128, 128, (bf16_t*)(ws + WS_WRG), (size_t)256 * 128, 128, 0, scr, lane); continue; } r -= I_RGA;
            if (r < I_RGX) { tr_job<0>(r, a.in[I_WRGX], 128, 128, (bf16_t*)(ws + WS_WRG) + 128 * 128, (size_t)256 * 128, 128, 0, scr, lane); continue; } r -= I_RGX;
            tr_job<0>(r, a.in[I_WPOOL], 128, 128, (bf16_t*)(ws + WS_WPOOL), (size_t)128 * 128, 128, 0, scr, lane);
        }
    }
}

struct MoeTab { LAS int* cnt; LAS int* padstart; LAS int* tilestart; LAS int* tab; };
__device__ __forceinline__ MoeTab moe_tab_ptrs(LAS unsigned char* lds) { MoeTab t; t.cnt = (LAS int*)(lds + LDS_TAB); t.padstart = t.cnt + 32; t.tilestart = t.padstart + 40; t.tab = t.tilestart + 40; return t; }
__device__ __forceinline__ void moe_tables(const Args& a, int l, LAS unsigned char* lds, const int wv) {
    asm volatile("" : "+s"(lds));
    const MoeTab mt = moe_tab_ptrs(lds); int tid_ = tid_of(wv); asm volatile("" : "+v"(tid_)); const int tid = tid_;
    unsigned* ctl = (unsigned*)(opaque_ptr(a.ws) + WS_CTL);
    __syncthreads();
    if (tid < NE) mt.cnt[tid] = (int)__hip_atomic_load(ctl + CW_CNT + (l * NE + tid) * 16, __ATOMIC_RELAXED, __HIP_MEMORY_SCOPE_AGENT);
    __syncthreads();
    if (tid == 0) { int ps = 0, ts = 0; for (int e = 0; e < NE; ++e) { mt.padstart[e] = ps; mt.tilestart[e] = ts; const int nt = (mt.cnt[e] + 255) >> 8; ps += nt * 256; ts += nt; } mt.padstart[NE] = ps; mt.tilestart[NE] = ts; }
    __syncthreads();
    const int nMt = mt.tilestart[NE];
    for (int m = tid; m < nMt; m += NTHREADS) { int e = 0; for (int q = 1; q < NE; ++q) e = (mt.tilestart[q] <= m) ? q : e; mt.tab[m] = (e << 16) | (m - mt.tilestart[e]); }
    __syncthreads();
}
#ifndef MOE_WGM1
#define MOE_WGM1 4
#endif
#ifndef MOE_WGM2
#define MOE_WGM2 8
#endif
struct MoeSched1 {
    static constexpr bool DYN_A = true;
    const char* H; const char* W; const int* tokof; MoeTab mt; int nMt, G, c;
    __device__ __forceinline__ bool next(int i, pg8::Unit& u) const { int pm, pn; if (!pg8::order_map<MOE_WGM1>(i, G, c, nMt, 8, pm, pn)) return false;
        const int en = __builtin_amdgcn_readfirstlane(mt.tab[pm]); u.pm = pm; u.pn = pn; u.e = en >> 16; u.j = en & 0xffff;
        u.row0 = __builtin_amdgcn_readfirstlane(mt.padstart[u.e]) + 256 * u.j; u.rows = __builtin_amdgcn_readfirstlane(mt.cnt[u.e]) - 256 * u.j; return true; }
    __device__ __forceinline__ const char* a_ptr() const { return H; }
    __device__ __forceinline__ const char* b_ptr() const { return W; }
    __device__ __forceinline__ unsigned a_off(const pg8::Unit&) const { return 0u; }
    __device__ __forceinline__ unsigned b_off(const pg8::Unit& u) const { return ((unsigned)u.e * 2048u + (unsigned)u.pn * 256u) * 1024u; }
    __device__ __forceinline__ void a_voff(const pg8::Unit& u, unsigned (&v)[2][2], int wv) const {
        int tid = tid_of(wv); asm volatile("" : "+v"(tid));
        const int* tl = tokof + (size_t)u.e * T + 256 * u.j; const int rmax = u.rows - 1;
#pragma unroll
        for (int i = 0; i < 2; ++i) { int R, C; pg8::stage_rc(tid * 16 + i * 8192, R, C);
#pragma unroll
            for (int h = 0; h < 2; ++h) { int idx = h * 128 + R; idx = idx < rmax ? idx : rmax; v[h][i] = (unsigned)tl[idx] * 1024u + (unsigned)C * 2u; } }
    }
    __device__ __forceinline__ void a_dma(const pg8::Unit& u, LAS unsigned char* slots, int wv) const {
        const int tid = tid_of(wv); const int rmax = u.rows - 1;
        const __amdgpu_buffer_rsrc_t rs = __builtin_amdgcn_make_buffer_rsrc((void*)tokof, 0, 0xffffffff, 0x00020000);
        const unsigned so = (unsigned)(u.e * T + 256 * u.j) * 4u;
#pragma unroll
        for (int i = 0; i < 2; ++i) { int R, C; pg8::stage_rc(tid * 16 + i * 8192, R, C);
#pragma unroll
            for (int h = 0; h < 2; ++h) { int idx = h * 128 + R; idx = idx < rmax ? idx : rmax;
                __builtin_amdgcn_raw_ptr_buffer_load_lds(rs, (LAS void*)(slots + (h * 2 + i) * 2048 + wv * 256), 4, (unsigned)idx * 4u, so, 0, 0); } }
    }
    __device__ __forceinline__ void a_fetch(const LAS unsigned char* slots, int wv, unsigned (&q)[4]) const {
        const int tid = tid_of(wv); int R, C; pg8::stage_rc(tid * 16, R, C);
#pragma unroll
        for (int k = 0; k < 4; ++k) q[k] = *(const LAS unsigned*)(slots + k * 2048 + tid * 4) * 1024u + (unsigned)C * 2u;
    }
};
struct MoeSched2 {
    static constexpr bool DYN_A = false;
    const char* ACT; const char* W; MoeTab mt; int nMt, G, c;
    __device__ __forceinline__ bool next(int i, pg8::Unit& u) const { int pm, pn; if (!pg8::order_map<MOE_WGM2>(i, G, c, nMt, 4, pm, pn)) return false;
        const int en = __builtin_amdgcn_readfirstlane(mt.tab[pm]); u.pm = pm; u.pn = pn; u.e = en >> 16; u.j = en & 0xffff;
        u.row0 = __builtin_amdgcn_readfirstlane(mt.padstart[u.e]) + 256 * u.j; u.rows = __builtin_amdgcn_readfirstlane(mt.cnt[u.e]) - 256 * u.j; return true; }
    __device__ __forceinline__ const char* a_ptr() const { return ACT; }
    __device__ __forceinline__ const char* b_ptr() const { return W; }
    __device__ __forceinline__ unsigned a_off(const pg8::Unit& u) const { return (unsigned)u.row0 * 1024u; }
    __device__ __forceinline__ unsigned b_off(const pg8::Unit& u) const { return ((unsigned)u.e * 1024u + (unsigned)u.pn * 256u) * 1024u; }
    __device__ __forceinline__ void a_voff(const pg8::Unit&, unsigned (&v)[2][2], int wv) const {
        int tid = tid_of(wv); asm volatile("" : "+v"(tid));
#pragma unroll
        for (int i = 0; i < 2; ++i) { int R, C; pg8::stage_rc(tid * 16 + i * 8192, R, C);
#pragma unroll
            for (int h = 0; h < 2; ++h) v[h][i] = (unsigned)((h * 128 + R) * 512 + C) * 2u; }
    }
};

__device__ __forceinline__ void phase_a(const Args& a, int l, LAS unsigned char* lds, bool dry, const int wv) {
    asm volatile("" : "+s"(lds));
    int tid_ = tid_of(wv); asm volatile("" : "+v"(tid_)); const int tid = tid_, lane = tid & 63, wave = __builtin_amdgcn_readfirstlane(tid >> 6);
    const int G = gridDim.x; unsigned char* ws = opaque_ptr(a.ws); const int bid = opaque_bid();
    const float* mod = (const float*)(ws + WS_MOD);
    bf16_t* xres = (bf16_t*)(ws + WS_XRES); bf16_t* xout = dry ? (bf16_t*)(ws + WS_Z) : xres;
    if (l < DEPTH && bid < NBATCH) {
        LAS float* red = (LAS float*)lds;
        const int b = bid, e = tid & 31, kp = tid >> 5;
        const float* sh2 = mod + ((size_t)l * NBATCH + b) * 6144 + 3 * D; const float* wr = a.in[I_WROUTER] + (size_t)l * D * NE;
        float s = 0.f;
        for (int k = kp * 64; k < kp * 64 + 64; ++k) s += sh2[k] * wr[k * NE + e];
        red[kp * 32 + e] = s;
        __syncthreads();
        if (tid < 32) { float t = a.in[I_BROUTER][l * NE + tid]; for (int q = 0; q < 16; ++q) t += red[q * 32 + tid]; ((float*)(ws + WS_CB))[(l * NBATCH + b) * NE + tid] = t; }
        __syncthreads();
    }
    if (l > 0) moe_tables(a, (l - 1) + DEPTH * (REPN(7) - 1), lds, wv);
    const MoeTab mt = moe_tab_ptrs(lds);
    const int* slotinfo = (const int*)(ws + WS_SLOTINFO); const float* wgt = (const float*)(ws + WS_WGT);
    const unsigned char* outb = (const unsigned char*)(ws + WS_OUTB); const float* outsc = (const float*)(ws + WS_OUTSC);
    unsigned char* hb = (unsigned char*)(ws + WS_H);
    for (int chunk = bid; chunk < T / 128; chunk += G) {
        const int rowb = chunk * 128 + wave * 16; const int b = rowb / SEQ;
        const float* xin = a.in[I_X] + (size_t)rowb * D; const bf16_t* xinb = xres + (size_t)rowb * D;
        f32x4 xv[2][4]; int4 si[4]; f32x4 wv[4]; unsigned gv[2][4][4]; f32x4 gs[2][4];
#define PA_SX(r, q) do { if ((r) < 16) { _Pragma("unroll") for (int j = 0; j < 4; ++j) { if (l == 0) xv[(q) & 1][j] = *(const f32x4*)(xin + (size_t)(r) * D + 4 * lane + 256 * j); \
            else { const f32x2 t_ = *(const f32x2*)(xinb + (size_t)(r) * D + 4 * lane + 256 * j); xv[(q) & 1][j].x = t_.x; xv[(q) & 1][j].y = t_.y; } } } } while (0)
#define PA_S0(r, q) do { if ((r) < 16 && l > 0) { si[(q) & 3] = *(const int4*)(slotinfo + (size_t)(rowb + (r)) * 4); wv[(q) & 3] = *(const f32x4*)(wgt + (size_t)(rowb + (r)) * 4); } } while (0)
#define PA_S1(r, q) do { if ((r) < 16 && l > 0) { const int sl_[4] = {si[(q) & 3].x, si[(q) & 3].y, si[(q) & 3].z, si[(q) & 3].w}; \
            _Pragma("unroll") for (int kk = 0; kk < 4; ++kk) { const int e_ = sl_[kk] >> 24, li_ = sl_[kk] & 0xffffff; const size_t slot_ = (size_t)(mt.padstart[e_] + li_); const unsigned char* orow = outb + slot_ * D + 4 * lane; \
                gs[(q) & 1][kk] = *(const f32x4*)(outsc + slot_ * 16 + ((lane >> 3) & 3) * 4); \
                _Pragma("unroll") for (int j = 0; j < 4; ++j) gv[(q) & 1][kk][j] = *(const unsigned*)(orow + 256 * j); } } } while (0)
        PA_S0(0, 0); PA_S0(1, 1); PA_SX(0, 0); PA_S1(0, 0);
#pragma unroll 1
        for (int i0 = 0; i0 < 16; i0 += 4) {
#pragma unroll
          for (int ii = 0; ii < 4; ++ii) {
            const int i = i0 + ii; const int row = rowb + i;
            PA_S0(i + 2, ii + 2); PA_SX(i + 1, ii + 1); PA_S1(i + 1, ii + 1);
            f32x4 v[4];
#pragma unroll
            for (int j = 0; j < 4; ++j) { v[j] = xv[ii & 1][j];
                if (l > 0) { const unsigned p0 = __float_as_uint(v[j].x), p1 = __float_as_uint(v[j].y); v[j] = (f32x4){bflo(p0), bfhi(p0), bflo(p1), bfhi(p1)}; } }
            if (l > 0) {
                f32x4 y[4];
#pragma unroll
                for (int j = 0; j < 4; ++j) y[j] = (f32x4){0.f, 0.f, 0.f, 0.f};
#pragma unroll
                for (int kk = 0; kk < 4; ++kk) { const f32x4 ws4 = gs[ii & 1][kk] * wv[ii][kk];
#pragma unroll
                    for (int j = 0; j < 4; ++j) { const unsigned p = gv[ii & 1][kk][j];
                        y[j] += ws4[j] * ((f32x4){(float)(p & 0xffu), (float)((p >> 8) & 0xffu), (float)((p >> 16) & 0xffu), (float)(p >> 24)} - 128.0f); } }
                const float* g2 = mod + ((size_t)(l - 1) * NBATCH + b) * 6144 + 5 * D + 4 * lane;
#pragma unroll
                for (int j = 0; j < 4; ++j) v[j] += *(const f32x4*)(g2 + 256 * j) * y[j];
            }
            if (l < DEPTH) {
#pragma unroll
                for (int j = 0; j < 4; ++j) { u32x2 p; p.x = cvt_pk_bf16(v[j].x, v[j].y); p.y = cvt_pk_bf16(v[j].z, v[j].w); *(u32x2*)(xout + (size_t)row * D + 4 * lane + 256 * j) = p; }
            }
            float ss = 0.f;
#pragma unroll
            for (int j = 0; j < 4; ++j) ss += (v[j].x * v[j].x + v[j].y * v[j].y) + (v[j].z * v[j].z + v[j].w * v[j].w);
            const float rinv = __builtin_amdgcn_rsqf(wave_sum(ss, lane) * (1.0f / D) + NORM_EPS);
            if (l < DEPTH) {
                const float* ng = a.in[I_N1G] + (size_t)l * D + 4 * lane; const float* mb = mod + ((size_t)l * NBATCH + b) * 6144 + 4 * lane;
                f32x4 hq[4]; (void)hq;
#pragma unroll
                for (int j = 0; j < 4; ++j) { const f32x4 g = *(const f32x4*)(ng + 256 * j), sh = *(const f32x4*)(mb + 256 * j), sc = *(const f32x4*)(mb + D + 256 * j);
                    const f32x4 h = (v[j] * rinv * g) * (1.0f + sc) + sh;
#if Z_I8
                    hq[j] = h; }
                {   float am = 0.f;
#pragma unroll
                    for (int j = 0; j < 4; ++j) am = fmaxf(fmaxf(fmaxf(fabsf(hq[j].x), fabsf(hq[j].y)), fmaxf(fabsf(hq[j].z), fabsf(hq[j].w))), am);
                    am = wave_max(am);
                    am = fmaxf(am, 1e-20f); const float inv = 127.0f / am;
                    if (lane == 0) ((float*)(ws + WS_HSC))[row] = am * (1.0f / 127.0f);
#pragma unroll
                    for (int j = 0; j < 4; ++j) { const int q0 = (int)rintf(hq[j].x * inv), q1 = (int)rintf(hq[j].y * inv), q2 = (int)rintf(hq[j].z * inv), q3 = (int)rintf(hq[j].w * inv);
                        *(int*)(hb + (size_t)row * D + 4 * lane + 256 * j) = (q0 & 0xff) | ((q1 & 0xff) << 8) | ((q2 & 0xff) << 16) | ((q3 & 0xff) << 24); }
                }
#elif Z_FP8
                    int p = 0; p = __builtin_amdgcn_cvt_pk_fp8_f32(h.x, h.y, p, false); p = __builtin_amdgcn_cvt_pk_fp8_f32(h.z, h.w, p, true);
                    *(int*)(hb + (size_t)row * D + 4 * lane + 256 * j) = p; }
#else
                    u32x2 p; p.x = cvt_pk_bf16(h.x, h.y); p.y = cvt_pk_bf16(h.z, h.w); *(u32x2*)((bf16_t*)hb + (size_t)row * D + 4 * lane + 256 * j) = p; }
#endif
            } else {
                const float* fg = a.in[I_FINALG] + 4 * lane;
#pragma unroll
                for (int j = 0; j < 4; ++j) *(f32x4*)(a.out + (size_t)row * D + 4 * lane + 256 * j) = v[j] * rinv * *(const f32x4*)(fg + 256 * j);
            }
          }
        }
#undef PA_S0
#undef PA_SX
#undef PA_S1
    }
}

__device__ __forceinline__ void phase_h(const Args& a, int l, int cset, LAS unsigned char* lds, const int wv) {
    asm volatile("" : "+s"(lds));
    int tid_ = tid_of(wv); asm volatile("" : "+v"(tid_)); const int tid = tid_, lane = tid & 63, wave = __builtin_amdgcn_readfirstlane(tid >> 6);
    const int G = gridDim.x; unsigned char* ws = opaque_ptr(a.ws); const int bid = opaque_bid();
    const float* mod = (const float*)(ws + WS_MOD); const bf16_t* xres = (const bf16_t*)(ws + WS_XRES);
    unsigned char* h8 = (unsigned char*)(ws + WS_H);
    LAS float* rinvs = (LAS float*)lds;
    LAS float* lgt = (LAS float*)(lds + 1024);
    LAS int* hist = (LAS int*)(lds + 1024 + 8 * 16 * 33 * 4);
    LAS int* base = hist + 32;
    unsigned* ctl = (unsigned*)(ws + WS_CTL);
    const float* ng = a.in[I_N2G] + (size_t)l * D;
    const float* cbv = (const float*)(ws + WS_CB);
    int* tokof = (int*)(ws + WS_TOKOF); int* slotinfo = (int*)(ws + WS_SLOTINFO); float* wgt = (float*)(ws + WS_WGT);
    for (int chunk = bid; chunk < T / 128; chunk += G) {
        const int row0 = chunk * 128 + wave * 16; const int b = row0 / SEQ;
        const float* mb = mod + ((size_t)l * NBATCH + b) * 6144 + 3 * D;
        if (tid < 32) hist[tid] = 0;
        u32x2 xq[3][4];
#pragma unroll
        for (int r = 0; r < 2; ++r)
#pragma unroll
            for (int j = 0; j < 4; ++j) xq[r][j] = *(const u32x2*)(xres + (size_t)(row0 + r) * D + 4 * lane + 256 * j);
#pragma unroll
        for (int i = 0; i < 16; ++i) {
            const int row = row0 + i;
            if (i + 2 < 16) {
#pragma unroll
                for (int j = 0; j < 4; ++j) xq[(i + 2) % 3][j] = *(const u32x2*)(xres + (size_t)(row + 2) * D + 4 * lane + 256 * j); }
            f32x4 v[4]; float ss = 0.f;
#pragma unroll
            for (int j = 0; j < 4; ++j) { const u32x2 p = xq[i % 3][j]; v[j] = (f32x4){bflo(p.x), bfhi(p.x), bflo(p.y), bfhi(p.y)}; ss += (v[j].x * v[j].x + v[j].y * v[j].y) + (v[j].z * v[j].z + v[j].w * v[j].w); }
            const float rinv = __builtin_amdgcn_rsqf(wave_sum(ss, lane) * (1.0f / D) + NORM_EPS);
            if (lane == 0) rinvs[wave * 16 + i] = rinv;
#pragma unroll
            for (int j = 0; j < 4; ++j) { const f32x4 g = *(const f32x4*)(ng + 4 * lane + 256 * j), sh = *(const f32x4*)(mb + 4 * lane + 256 * j), sc = *(const f32x4*)(mb + D + 4 * lane + 256 * j);
                const f32x4 h = (v[j] * rinv * g) * (1.0f + sc) + sh;
                int p = 0; p = __builtin_amdgcn_cvt_pk_fp8_f32(h.x, h.y, p, false); p = __builtin_amdgcn_cvt_pk_fp8_f32(h.z, h.w, p, true);
                *(int*)(h8 + (size_t)row * D + 4 * lane + 256 * j) = p; }
        }
        {
            const int ri = lane & 15, q = lane >> 4;
            const bf16_t* xr = xres + (size_t)(row0 + ri) * D + 8 * q;
            const bf16_t* wh = (const bf16_t*)(ws + WS_WRS) + ((size_t)(l * 2 + 0) * NE + ri) * D + 8 * q; const bf16_t* wl = wh + (size_t)NE * D;
            f32x4 acc0 = {0.f, 0.f, 0.f, 0.f}, acc1 = {0.f, 0.f, 0.f, 0.f};
#pragma unroll 4
            for (int kb = 0; kb < 32; ++kb) {
                const int k0 = 32 * kb + 8 * q;
                const u32x4 xp = *(const u32x4*)(xr + 32 * kb); const f32x4 x0 = {bflo(xp.x), bfhi(xp.x), bflo(xp.y), bfhi(xp.y)}, x1 = {bflo(xp.z), bfhi(xp.z), bflo(xp.w), bfhi(xp.w)};
                const f32x4 g0 = *(const f32x4*)(ng + k0), g1 = *(const f32x4*)(ng + k0 + 4), s0 = *(const f32x4*)(mb + D + k0), s1 = *(const f32x4*)(mb + D + k0 + 4);
                const bf16x8 bh0 = *(const bf16x8*)(wh + 32 * kb), bl0 = *(const bf16x8*)(wl + 32 * kb), bh1 = *(const bf16x8*)(wh + 16 * D + 32 * kb), bl1 = *(const bf16x8*)(wl + 16 * D + 32 * kb);
                const f32x4 a0 = x0 * g0 * (1.0f + s0), a1 = x1 * g1 * (1.0f + s1);
                u32x4 hi, lo;
                hi.x = cvt_pk_bf16(a0.x, a0.y); hi.y = cvt_pk_bf16(a0.z, a0.w); hi.z = cvt_pk_bf16(a1.x, a1.y); hi.w = cvt_pk_bf16(a1.z, a1.w);
                lo.x = cvt_pk_bf16(a0.x - bflo(hi.x), a0.y - bfhi(hi.x)); lo.y = cvt_pk_bf16(a0.z - bflo(hi.y), a0.w - bfhi(hi.y));
                lo.z = cvt_pk_bf16(a1.x - bflo(hi.z), a1.y - bfhi(hi.z)); lo.w = cvt_pk_bf16(a1.z - bflo(hi.w), a1.w - bfhi(hi.w));
                const bf16x8 ah = __builtin_bit_cast(bf16x8, hi), al = __builtin_bit_cast(bf16x8, lo);
                acc0 = __builtin_amdgcn_mfma_f32_16x16x32_bf16(ah, bh0, acc0, 0, 0, 0); acc0 = __builtin_amdgcn_mfma_f32_16x16x32_bf16(ah, bl0, acc0, 0, 0, 0); acc0 = __builtin_amdgcn_mfma_f32_16x16x32_bf16(al, bh0, acc0, 0, 0, 0);
                acc1 = __builtin_amdgcn_mfma_f32_16x16x32_bf16(ah, bh1, acc1, 0, 0, 0); acc1 = __builtin_amdgcn_mfma_f32_16x16x32_bf16(ah, bl1, acc1, 0, 0, 0); acc1 = __builtin_amdgcn_mfma_f32_16x16x32_bf16(al, bh1, acc1, 0, 0, 0);
            }
            LDS_WAIT();
            const float c0 = cbv[(l * NBATCH + b) * NE + ri], c1 = cbv[(l * NBATCH + b) * NE + 16 + ri];
#pragma unroll
            for (int r = 0; r < 4; ++r) { const int ti = 4 * q + r; const float rv = rinvs[wave * 16 + ti];
                lgt[(wave * 16 + ti) * 33 + ri] = acc0[r] * rv + c0; lgt[(wave * 16 + ti) * 33 + 16 + ri] = acc1[r] * rv + c1; }
        }
        __syncthreads();
        int se[4] = {0, 0, 0, 0}; float sw[4] = {0.f, 0.f, 0.f, 0.f}; int rk[4] = {0, 0, 0, 0};
        if (lane < 16) {
            float v[32];
#pragma unroll
            for (int e = 0; e < 32; ++e) v[e] = lgt[(wave * 16 + lane) * 33 + e];
            float sv[4];
#pragma unroll
            for (int kk = 0; kk < 4; ++kk) { float best = v[0]; int bi = 0;
#pragma unroll
                for (int e = 1; e < 32; ++e) { if (v[e] > best) { best = v[e]; bi = e; } }
                sv[kk] = best; se[kk] = bi;
#pragma unroll
                for (int e = 0; e < 32; ++e) v[e] = (e == bi) ? -3.0e38f : v[e]; }
            float den = 0.f;
#pragma unroll
            for (int kk = 0; kk < 4; ++kk) { sw[kk] = __expf(sv[kk] - sv[0]); den += sw[kk]; }
            const float inv = 1.0f / den;
#pragma unroll
            for (int kk = 0; kk < 4; ++kk) { sw[kk] *= inv; rk[kk] = __hip_atomic_fetch_add(hist + se[kk], 1, __ATOMIC_RELAXED, __HIP_MEMORY_SCOPE_WORKGROUP); }
        }
        __syncthreads();
        if (tid < 32) base[tid] = (int)__hip_atomic_fetch_add(ctl + CW_CNT + (cset * NE + tid) * 16, (unsigned)hist[tid], __ATOMIC_RELAXED, __HIP_MEMORY_SCOPE_AGENT);
        __syncthreads();
        if (lane < 16) {
            const int row = row0 + lane; int si[4];
#pragma unroll
            for (int kk = 0; kk < 4; ++kk) { const int li = base[se[kk]] + rk[kk]; tokof[(size_t)se[kk] * T + li] = row; si[kk] = (se[kk] << 24) | li; }
            *(int4*)(slotinfo + (size_t)row * 4) = make_int4(si[0], si[1], si[2], si[3]);
            *(f32x4*)(wgt + (size_t)row * 4) = (f32x4){sw[0], sw[1], sw[2], sw[3]};
        }
        __syncthreads();
    }
}

constexpr int ZT_STRIDE = 528;
template <int NR>
__device__ __forceinline__ void stage_z8(const unsigned char* z8, const float* zs, int b, int p_first, int tile, LAS unsigned char* zt, int tid) {
    constexpr int NP = NR * 16, NK = (NP + NTHREADS - 1) / NTHREADS;
    u32x4 q[NK]; float sc[NK];
    const __amdgpu_buffer_rsrc_t rz = __builtin_amdgcn_make_buffer_rsrc((void*)z8, 0, 0xffffffff, 0x00020000), rq = __builtin_amdgcn_make_buffer_rsrc((void*)zs, 0, 0xffffffff, 0x00020000);
#pragma unroll
    for (int k = 0; k < NK; ++k) { int idx = tid + NTHREADS * k; idx = idx < NP ? idx : NP - 1; const int r = idx >> 4, pc = idx & 15; const int p = p_first + r; const unsigned row = (unsigned)(b * SEQ + (p < 0 ? 0 : p));
        q[k] = __builtin_bit_cast(u32x4, __builtin_amdgcn_raw_buffer_load_b128(rz, (int)(row * 2560u + (unsigned)(tile * 256 + pc * 16)), 0, 0));
        const float t = __builtin_bit_cast(float, __builtin_amdgcn_raw_buffer_load_b32(rq, (int)((row * 40u + (unsigned)(tile * 4 + ((pc >> 1) & 3))) * 4u), 0, 0)); sc[k] = p < 0 ? 0.f : t; }
#pragma unroll
    for (int k = 0; k < NK; ++k) { int idx = tid + NTHREADS * k; idx = idx < NP ? idx : NP - 1; const int r = idx >> 4, pc = idx & 15; float m128 = -128.0f; asm volatile("" : "+v"(m128));
        const float sk = sc[k], of = m128 * sk;
        const unsigned w[4] = {q[k].x, q[k].y, q[k].z, q[k].w}; unsigned o[8];
#pragma unroll
        for (int d = 0; d < 4; ++d) { o[2 * d] = cvt_pk_bf16((float)(w[d] & 0xffu) * sk + of, (float)((w[d] >> 8) & 0xffu) * sk + of); o[2 * d + 1] = cvt_pk_bf16((float)((w[d] >> 16) & 0xffu) * sk + of, (float)(w[d] >> 24) * sk + of); }
        *(LAS u32x4*)(zt + r * ZT_STRIDE + pc * 32) = (u32x4){o[0], o[1], o[2], o[3]}; *(LAS u32x4*)(zt + r * ZT_STRIDE + pc * 32 + 16) = (u32x4){o[4], o[5], o[6], o[7]};
        asm volatile("" ::: "memory"); }
}
__device__ __forceinline__ void lru_unit(const Args& a, int l, int u, LAS unsigned char* lds, const int wv) {
    asm volatile("" : "+s"(lds));
    int tid_ = tid_of(wv); asm volatile("" : "+v"(tid_)); const int tid = tid_, lane = tid & 63, wave = __builtin_amdgcn_readfirstlane(tid >> 6);
    unsigned char* ws = opaque_ptr(a.ws);
    const unsigned char* z8 = (const unsigned char*)(ws + WS_Z); const float* zs = (const float*)(ws + WS_ZS);
    LAS unsigned char* zt = lds; LAS unsigned char* xc = lds + 131 * ZT_STRIDE;
    const int hp = u & 3, b = (u >> 2) & 7, s = u >> 5;
    const int t0 = b * SEQ + s * 128, p0 = s * 128;
    stage_z8<131>(z8, zs, b, p0 - 3, hp, zt, tid);
    __syncthreads();
    {
        const int o = tid & 31, rb = tid >> 5; const int ch0 = hp * 256 + o * 8;
        float cw[4][8], cbias[8];
#pragma unroll
        for (int k = 0; k < 4; ++k) { const f32x4 w0 = *(const f32x4*)(a.in[I_CONVW] + ((size_t)l * 4 + k) * D + ch0), w1 = *(const f32x4*)(a.in[I_CONVW] + ((size_t)l * 4 + k) * D + ch0 + 4);
            cw[k][0] = w0.x; cw[k][1] = w0.y; cw[k][2] = w0.z; cw[k][3] = w0.w; cw[k][4] = w1.x; cw[k][5] = w1.y; cw[k][6] = w1.z; cw[k][7] = w1.w; }
        { const f32x4 b0 = *(const f32x4*)(a.in[I_CONVB] + (size_t)l * D + ch0), b1 = *(const f32x4*)(a.in[I_CONVB] + (size_t)l * D + ch0 + 4);
          cbias[0] = b0.x; cbias[1] = b0.y; cbias[2] = b0.z; cbias[3] = b0.w; cbias[4] = b1.x; cbias[5] = b1.y; cbias[6] = b1.z; cbias[7] = b1.w; }
#pragma unroll 2
        for (int i = 0; i < 8; ++i) { const int r = rb + 16 * i; float acc[8];
#pragma unroll
            for (int j = 0; j < 8; ++j) acc[j] = cbias[j];
#pragma unroll
            for (int k = 0; k < 4; ++k) { const u32x4 v = *(const LAS u32x4*)(zt + (r + k) * ZT_STRIDE + o * 16);
                acc[0] += cw[k][0] * bflo(v.x); acc[1] += cw[k][1] * bfhi(v.x); acc[2] += cw[k][2] * bflo(v.y); acc[3] += cw[k][3] * bfhi(v.y);
                acc[4] += cw[k][4] * bflo(v.z); acc[5] += cw[k][5] * bfhi(v.z); acc[6] += cw[k][6] * bflo(v.w); acc[7] += cw[k][7] * bfhi(v.w); }
            u32x4 w; w.x = cvt_pk_bf16(acc[0], acc[1]); w.y = cvt_pk_bf16(acc[2], acc[3]); w.z = cvt_pk_bf16(acc[4], acc[5]); w.w = cvt_pk_bf16(acc[6], acc[7]);
            *(LAS u32x4*)(xc + r * ZT_STRIDE + o * 16) = w; }
    }
    __syncthreads();
    {
        const __amdgpu_buffer_rsrc_t rz = __builtin_amdgcn_make_buffer_rsrc((void*)(z8 + (size_t)t0 * 2560 + (4 + hp) * 256), 0, 0xffffffff, 0x00020000);
        const unsigned vo = (unsigned)(lane >> 4) * 2560u + (unsigned)(lane & 15) * 16u;
#pragma unroll
        for (int k = 0; k < 4; ++k) __builtin_amdgcn_raw_ptr_buffer_load_lds(rz, (LAS void*)(zt + (wave * 4 + k) * 1024), 16, vo, (unsigned)((wave * 4 + k) * 4 * 2560), 0, 0);
        const __amdgpu_buffer_rsrc_t rq = __builtin_amdgcn_make_buffer_rsrc((void*)(zs + (size_t)t0 * 40 + (4 + hp) * 4), 0, 0xffffffff, 0x00020000);
        __builtin_amdgcn_raw_ptr_buffer_load_lds(rq, (LAS void*)(zt + 32768 + wave * 256), 4, (unsigned)(tid >> 2) * 160u + (unsigned)(tid & 3) * 4u, 0, 0, 0);
    }
    {
        const int hsel = wave >> 2, wc = wave & 3, head = 2 * hp + hsel, c31 = lane & 31, hh = lane >> 5;
        const int ch = head * 128 + 32 * wc + c31;
        const bf16_t* wb = (const bf16_t*)(ws + WS_WRG) + ((size_t)(l * 8 + head) * 256 + 32 * wc + c31) * 128 + 8 * hh;
        bf16x8 Ba[8], Bi[8];
#pragma unroll
        for (int ks = 0; ks < 8; ++ks) { Ba[ks] = *(const bf16x8*)(wb + 16 * ks); Bi[ks] = *(const bf16x8*)(wb + 128 * 128 + 16 * ks); }
        const float ba = a.in[I_BRGA][(size_t)l * D + ch], bx = a.in[I_BRGX][(size_t)l * D + ch];
        const float lam = a.in[I_LAM][(size_t)l * D + ch];
        const float sp8 = 8.0f * log1pf(__expf(-lam));
        typedef __attribute__((address_space(1))) unsigned long long gu64;
        gu64* aggq = (gu64*)(ws + WS_AGG) + ((size_t)l * NBATCH * 32 + (size_t)b * 32) * D + ch;
        float Pr = 1.f, Hr = 0.f;
        unsigned hpk[64];
#pragma unroll
        for (int rb = 0; rb < 4; ++rb) {
            f32x16 aa, ai;
#pragma unroll
            for (int r = 0; r < 16; ++r) { aa[r] = 0.f; ai[r] = 0.f; }
            const LAS unsigned char* ap = xc + (32 * rb + c31) * ZT_STRIDE + (hsel * 128 + 8 * hh) * 2;
#pragma unroll
            for (int ks = 0; ks < 8; ++ks) { const bf16x8 A = *(const LAS bf16x8*)(ap + 32 * ks);
                aa = __builtin_amdgcn_mfma_f32_32x32x16_bf16(A, Ba[ks], aa, 0, 0, 0); ai = __builtin_amdgcn_mfma_f32_32x32x16_bf16(A, Bi[ks], ai, 0, 0, 0); }
            const LAS unsigned char* xp = xc + (32 * rb + 4 * hh) * ZT_STRIDE + (hsel * 128 + 32 * wc + c31) * 2;
#pragma unroll
            for (int q = 0; q < 4; ++q) {
                float p = 1.f, h = 0.f, hl[4], pl[4];
#pragma unroll
                for (int r3 = 0; r3 < 4; ++r3) { const int reg = 4 * q + r3;
                    const float xcv = bf1(*(const LAS bf16_t*)(xp + (8 * q + r3) * ZT_STRIDE));
                    const float rg = sigmoidf_(aa[reg] + ba), ig = sigmoidf_(ai[reg] + bx);
                    const float av = __expf(-sp8 * rg); const float mult = __builtin_amdgcn_sqrtf(fmaxf(1.0f - av * av, 0.f));
                    h = av * h + mult * (ig * xcv); p *= av; hl[r3] = h; pl[r3] = p; }
                const float Ao = shflx(p, 32, lane), Bo = shflx(h, 32, lane);
                const float A0 = hh ? Ao : p, B0 = hh ? Bo : h, A1 = hh ? p : Ao, B1 = hh ? h : Bo;
                const float P1 = Pr * A0, H1 = Hr * A0 + B0;
                const float Pst = hh ? P1 : Pr, Hst = hh ? H1 : Hr;
                Pr = P1 * A1; Hr = H1 * A1 + B1;
#pragma unroll
                for (int r3 = 0; r3 < 4; ++r3) hpk[rb * 16 + 4 * q + r3] = cvt_pk_bf16(Hst * pl[r3] + hl[r3], Pst * pl[r3]);
            }
        }
        if (hh == 0) __hip_atomic_store(aggq + (size_t)s * D, ((unsigned long long)__float_as_uint(Hr) << 32) | (unsigned long long)__float_as_uint(fmaxf(Pr, 1e-37f)), __ATOMIC_RELAXED, __HIP_MEMORY_SCOPE_AGENT);
        float cin = 0.f;
        for (int j0 = 0; j0 < s; j0 += 8) {
            unsigned long long w[8]; unsigned spins = 0;
            for (;;) { bool ok = true;
#pragma unroll
                for (int k = 0; k < 8; ++k) { const int j = (j0 + k < s) ? (j0 + k) : (s - 1); w[k] = __hip_atomic_load(aggq + (size_t)j * D, __ATOMIC_RELAXED, __HIP_MEMORY_SCOPE_AGENT); ok = ok && ((unsigned)w[k] != 0u); }
                if (__all(ok)) break;
                __builtin_amdgcn_s_sleep(4);
                if (++spins > (1u << 17)) break;
            }
#pragma unroll
            for (int k = 0; k < 8; ++k) { if (j0 + k < s) cin = __uint_as_float((unsigned)w[k]) * cin + __uint_as_float((unsigned)(w[k] >> 32)); }
        }
        asm volatile("s_waitcnt vmcnt(0)" ::: "memory");
        __syncthreads();
        const LAS unsigned char* gp = zt + (4 * hh) * 256 + (hsel * 128 + 32 * wc + c31);
        const LAS float* gsp = (const LAS float*)(zt + 32768) + (4 * hh) * 4 + wc;
        LAS unsigned char* yp = xc + (4 * hh) * 512 + (hsel * 128 + 32 * wc + c31) * 2;
#pragma unroll
        for (int rb = 0; rb < 4; ++rb) {
#pragma unroll
            for (int reg = 0; reg < 16; ++reg) { const int tok = 32 * rb + 8 * (reg >> 2) + (reg & 3);
                const unsigned pk = hpk[rb * 16 + reg];
                const float hf = bflo(pk) + bfhi(pk) * cin;
                const float g = ((float)gp[tok * 256] - 128.0f) * gsp[tok * 4];
                const float ge = g * __builtin_amdgcn_rcpf(1.0f + __expf(-1.5957691216f * (g + 0.044715f * g * g * g)));
                *(LAS bf16_t*)(yp + tok * 512) = (bf16_t)(cvt_pk_bf16(hf * ge, 0.f) & 0xffffu); }
        }
    }
    __syncthreads();
    {
        bf16_t* yo = (bf16_t*)(ws + WS_ACAT) + (size_t)t0 * KCAT + 512 + hp * 256;
        u32x4 yv[8];
#pragma unroll
        for (int k = 0; k < 8; ++k) yv[k] = *(const LAS u32x4*)(xc + ((tid >> 5) + 16 * k) * 512 + (tid & 31) * 16);
#pragma unroll
        for (int k = 0; k < 8; ++k) *(u32x4*)(yo + (size_t)((tid >> 5) + 16 * k) * KCAT + (tid & 31) * 8) = yv[k];
    }
    __syncthreads();
}
__device__ __forceinline__ void pool_unit(const Args& a, int l, int u, LAS unsigned char* lds, const int wv) {
    asm volatile("" : "+s"(lds));
    int tid_ = tid_of(wv); asm volatile("" : "+v"(tid_)); const int tid = tid_, lane = tid & 63, wave = __builtin_amdgcn_readfirstlane(tid >> 6);
    unsigned char* ws = opaque_ptr(a.ws);
    const unsigned char* z8 = (const unsigned char*)(ws + WS_Z); const float* zs = (const float*)(ws + WS_ZS);
    LAS unsigned char* zt = lds; LAS unsigned char* pt = lds + 143 * ZT_STRIDE;
    const int gp = u & 1, b = (u >> 1) & 7, s = u >> 4;
    const int t0 = b * SEQ + s * 128, p0 = s * 128;
    stage_z8<143>(z8, zs, b, p0 - 15, 8 + gp, zt, tid);
    __syncthreads();
    {
        const int o = tid & 31, rb = tid >> 5; const int g = 2 * gp + (o >> 4); const int w = 2 << g;
#pragma unroll 1
        for (int i = 0; i < 8; ++i) { const int r = rb + 16 * i; float acc[8];
#pragma unroll
            for (int j = 0; j < 8; ++j) acc[j] = 0.f;
            for (int jj = 0; jj < w; ++jj) { const u32x4 v = *(const LAS u32x4*)(zt + (r + 15 - jj) * ZT_STRIDE + o * 16);
                acc[0] += bflo(v.x); acc[1] += bfhi(v.x); acc[2] += bflo(v.y); acc[3] += bfhi(v.y); acc[4] += bflo(v.z); acc[5] += bfhi(v.z); acc[6] += bflo(v.w); acc[7] += bfhi(v.w); }
            const int cnt = (p0 + r + 1 < w) ? (p0 + r + 1) : w; const float ic = 1.0f / (float)cnt;
            const u32x4 v = *(const LAS u32x4*)(zt + (r + 15) * ZT_STRIDE + o * 16);
            const float x0[8] = {bflo(v.x), bfhi(v.x), bflo(v.y), bfhi(v.y), bflo(v.z), bfhi(v.z), bflo(v.w), bfhi(v.w)};
#pragma unroll
            for (int j = 0; j < 8; ++j) acc[j] = acc[j] * ic - x0[j];
            u32x4 wv; wv.x = cvt_pk_bf16(acc[0], acc[1]); wv.y = cvt_pk_bf16(acc[2], acc[3]); wv.z = cvt_pk_bf16(acc[4], acc[5]); wv.w = cvt_pk_bf16(acc[6], acc[7]);
            *(LAS u32x4*)(pt + r * ZT_STRIDE + o * 16) = wv; }
    }
    __syncthreads();
    {
        const int gsel = wave >> 2, wc = wave & 3, g = 2 * gp + gsel, c31 = lane & 31, hh = lane >> 5;
        const int oc = g * 128 + 32 * wc + c31;
        const bf16_t* wb = (const bf16_t*)(ws + WS_WPOOL) + ((size_t)(l * 4 + g) * 128 + 32 * wc + c31) * 128 + 8 * hh;
        bf16x8 Bf[8];
#pragma unroll
        for (int ks = 0; ks < 8; ++ks) Bf[ks] = *(const bf16x8*)(wb + 16 * ks);
        const float psc = a.in[I_PSCALE][(size_t)l * 512 + oc];
        bf16_t* yo = (bf16_t*)(ws + WS_ACAT) + (size_t)t0 * KCAT + oc;
#pragma unroll 1
        for (int rb = 0; rb < 4; ++rb) {
            f32x16 acc;
#pragma unroll
            for (int r = 0; r < 16; ++r) acc[r] = 0.f;
            const LAS unsigned char* ap = pt + (32 * rb + c31) * ZT_STRIDE + (gsel * 128 + 8 * hh) * 2;
#pragma unroll
            for (int ks = 0; ks < 8; ++ks) { const bf16x8 A = *(const LAS bf16x8*)(ap + 32 * ks); acc = __builtin_amdgcn_mfma_f32_32x32x16_bf16(A, Bf[ks], acc, 0, 0, 0); }
#pragma unroll
            for (int reg = 0; reg < 16; ++reg) { const int tok = 32 * rb + 8 * (reg >> 2) + 4 * hh + (reg & 3);
                yo[(size_t)tok * KCAT] = (bf16_t)(cvt_pk_bf16(acc[reg] * psc, 0.f) & 0xffffu); }
        }
    }
    __syncthreads();
}

constexpr int PH_PER_LAYER = 9;
constexpr int N_PHASES = 1 + DEPTH * PH_PER_LAYER + 1;

__global__ void __launch_bounds__(NTHREADS, 2) fwd_kernel(Args a) {
    extern __shared__ __attribute__((aligned(16))) unsigned char lds_raw[];
    LAS unsigned char* lds = (LAS unsigned char*)lds_raw;
    const int wv = __builtin_amdgcn_readfirstlane(threadIdx.x >> 6); const int tid = threadIdx.x; const int G = gridDim.x;
    unsigned char* ws0 = a.ws;
    unsigned* ctl = (unsigned*)(ws0 + WS_CTL);
    volatile LAS unsigned* misc = (volatile LAS unsigned*)(lds + LDS_MISC);
    if (tid < 4) misc[tid] = 0u;
    __syncthreads();
    XcdBarrier bar; bar.bar = ctl + CW_BAR; bar.x = 0; bar.st = misc; bar.wv = wv;
#if MK_PER_PHASE
    const int lo = a.ph_lo, hi = a.ph_hi;
#else
    constexpr int lo = 0, hi = N_PHASES;
#endif
    if (hi - lo > 1) bar = xcd_barrier_post(ctl + CW_BAR, misc, wv);
#define IN(k) (lo <= (k) && (k) < hi)
#define SEAM(k) do { if (IN((k) + 1)) xcd_barrier(bar); } while (0)

    if (EN(0) && IN(0)) for (int rr = 0; rr < REPN(0); ++rr) { phase_prologue(a, lds, wv); SEAM(0); }

    for (int l = 0; l < DEPTH; ++l) {
        const int pb = 1 + l * PH_PER_LAYER;
        if (EN(1) && IN(pb + 0)) for (int rr = 0; rr < REPN(1); ++rr) { unsigned char* ws = opaque_ptr(ws0); const int bid = opaque_bid(); (void)bid; (void)ws; phase_a(a, l, lds, rr + 1 < REPN(1), wv); SEAM(pb + 0); }
        if (EN(2) && IN(pb + 1)) for (int rr = 0; rr < REPN(2); ++rr) { unsigned char* ws = opaque_ptr(ws0); const int bid = opaque_bid(); (void)bid; (void)ws;
            #if Z_I8
            pg8::PlainSched S{(const char*)(ws + WS_H), (const char*)(ws + WS_WIN) + (size_t)l * NZ * 1024, 512, T / 256, NZ / 256, G, bid};
            pg8::EpiZI8 E{(bf16_t*)(ws + WS_Z), (float*)(ws + WS_ZS), (unsigned char*)(ws + WS_ZG), (const unsigned char*)ws, (unsigned)WS_HSC, (unsigned)(WS_WINSC + (size_t)l * NZ * 4)};
            pg8::gemm_phase<pg8::EpiZI8, pg8::PlainSched, true, 2>(lds, 512, S, E, wv);
#elif Z_FP8
            pg8::PlainSched S{(const char*)(ws + WS_H), (const char*)(ws + WS_WIN) + (size_t)l * NZ * 1024, 512, T / 256, NZ / 256, G, bid};
            pg8::EpiBf16 E{(bf16_t*)(ws + WS_Z), NZ, nullptr, (rr + 1 < REPN(2)) && (a.ph_lo == 0), 1.0f / WEIN_SCALE};
            pg8::gemm_phase<pg8::EpiBf16, pg8::PlainSched, true, 1>(lds, 512, S, E, wv);
#else
            pg8::PlainSched S{(const char*)(ws + WS_H), (const char*)(ws + WS_WIN) + (size_t)l * NZ * 1024 * 2, 1024, T / 256, NZ / 256, G, bid};
            pg8::EpiBf16 E{(bf16_t*)(ws + WS_Z), NZ, nullptr, (rr + 1 < REPN(2)) && (a.ph_lo == 0), 1.0f};
            pg8::gemm_phase<pg8::EpiBf16, pg8::PlainSched, true>(lds, 1024, S, E, wv);
#endif
            SEAM(pb + 1);
        }
        if (EN(3) && IN(pb + 2)) for (int rr = 0; rr < REPN(3); ++rr) { unsigned char* ws = opaque_ptr(ws0); const int bid = opaque_bid(); (void)bid; (void)ws;
            for (int u = bid; u < 1024 + 512; u += G) { if (u < 1024) lru_unit(a, l, u, lds, wv); else pool_unit(a, l, u - 1024, lds, wv); }
            SEAM(pb + 2);
        }
        if (EN(5) && IN(pb + 4)) for (int rr = 0; rr < REPN(5); ++rr) { unsigned char* ws = opaque_ptr(ws0); const int bid = opaque_bid(); (void)bid; (void)ws;
            pg8::PlainSched S{(const char*)(ws + WS_ACAT), (const char*)(ws + WS_WCAT) + (size_t)l * 1024 * KCAT * 2, KCAT, T / 256, D / 256, G, bid};
            pg8::EpiMerged E{(bf16_t*)(ws + WS_MERGED), (const unsigned char*)(ws + WS_ZG)};
            pg8::gemm_phase<pg8::EpiMerged, pg8::PlainSched, true>(lds, KCAT, S, E, wv);
            SEAM(pb + 4);
        }
        if (EN(6) && IN(pb + 5)) for (int rr = 0; rr < REPN(6); ++rr) { unsigned char* ws = opaque_ptr(ws0); const int bid = opaque_bid(); (void)bid; (void)ws;
            pg8::PlainSched S{(const char*)(ws + WS_MERGED), (const char*)(ws + WS_WOUT) + (size_t)l * 1024 * 1024 * 2, 1024, T / 256, D / 256, G, bid};
            pg8::EpiResid E{(bf16_t*)(ws + WS_XRES), (rr + 1 < REPN(6)) ? (bf16_t*)(ws + WS_ACT) : (bf16_t*)(ws + WS_XRES), (const float*)(ws + WS_MOD) + (size_t)l * NBATCH * 6144 + 2 * D};
            pg8::gemm_phase<pg8::EpiResid, pg8::PlainSched, true>(lds, 1024, S, E, wv);
            SEAM(pb + 5);
        }
        if (EN(7) && IN(pb + 6)) for (int rr = 0; rr < REPN(7); ++rr) { unsigned char* ws = opaque_ptr(ws0); const int bid = opaque_bid(); (void)bid; (void)ws; if (l > 0 && rr == 0) conv_drain(a, l, -1, lds, wv); phase_h(a, l, l + DEPTH * rr, lds, wv); SEAM(pb + 6); }
        if (EN(8) && IN(pb + 7)) for (int rr = 0; rr < REPN(8); ++rr) { unsigned char* ws = opaque_ptr(ws0); const int bid = opaque_bid(); (void)bid; (void)ws;
            moe_tables(a, l + DEPTH * (REPN(7) - 1), lds, wv);
            LAS unsigned char* lds_o = lds; asm volatile("" : "+s"(lds_o)); const MoeTab mt = moe_tab_ptrs(lds_o);
            MoeSched1 S{(const char*)(ws + WS_H), (const char*)(ws + WS_WEIN) + (size_t)l * NE * 2048 * 1024, (const int*)(ws + WS_TOKOF), mt, __builtin_amdgcn_readfirstlane(mt.tilestart[NE]), G, bid};
            pg8::EpiSwiglu E{(unsigned char*)(ws + WS_ACT), a.in[I_BEIN] + (size_t)l * NE * 2048, 1.0f / WEIN_SCALE};
            pg8::gemm_phase<pg8::EpiSwiglu, MoeSched1, true, 1>(lds, 512, S, E, wv);
            if (l + 1 < DEPTH) {
                const int nwg = S.nMt * 8, maxr = (nwg + G - 1) / G, myr = (nwg - bid + G - 1) / G;
                if (myr < maxr) conv_drain(a, l + 1, CONV_Q1, lds, wv);
            }
            SEAM(pb + 7);
        }
        if (EN(9) && IN(pb + 8)) for (int rr = 0; rr < REPN(9); ++rr) { unsigned char* ws = opaque_ptr(ws0); const int bid = opaque_bid(); (void)bid; (void)ws;
            moe_tables(a, l + DEPTH * (REPN(7) - 1), lds, wv);
            LAS unsigned char* lds_o = lds; asm volatile("" : "+s"(lds_o)); const MoeTab mt = moe_tab_ptrs(lds_o);
            MoeSched2 S{(const char*)(ws + WS_ACT), (const char*)(ws + WS_WEOUT) + (size_t)l * NE * 1024 * 1024, mt, __builtin_amdgcn_readfirstlane(mt.tilestart[NE]), G, bid};
            pg8::EpiMoeOut E{(unsigned char*)(ws + WS_OUTB), (float*)(ws + WS_OUTSC), a.in[I_BEOUT] + (size_t)l * NE * D, 1.0f / WEIN_SCALE};
            pg8::gemm_phase<pg8::EpiMoeOut, MoeSched2, true, 1>(lds, 512, S, E, wv);
            if (l + 1 < DEPTH) {
                const int nwg = S.nMt * 4, maxr = (nwg + G - 1) / G, myr = (nwg - bid + G - 1) / G;
                if (myr < maxr) conv_drain(a, l + 1, CONV_Q2, lds, wv);
            }
            SEAM(pb + 8);
        }
    }
    if (EN(10) && IN(N_PHASES - 1)) phase_a(a, DEPTH, lds, false, wv);
#undef IN
#undef SEAM
}

extern "C" void kernel_launch(void* const* d_in, const int* in_sizes, int n_in, void* d_out, int out_size, void* d_ws, size_t ws_size, hipStream_t stream) {
    static int grid = 0;
    if (grid == 0) {
        if (n_in != 26 || out_size != T * D || ws_size < WS_END) { fprintf(stderr, "kernel_launch: unexpected problem (n_in %d out %d ws %zu)\n", n_in, out_size, ws_size); grid = -1; return; }
        int dev = 0, cus = 0, per_cu = 0;
        if (hipGetDevice(&dev) != hipSuccess || hipDeviceGetAttribute(&cus, hipDeviceAttributeMultiprocessorCount, dev) != hipSuccess) { grid = -1; return; }
        if (hipFuncSetAttribute((const void*)fwd_kernel, hipFuncAttributeMaxDynamicSharedMemorySize, LDS_BYTES) != hipSuccess) { fprintf(stderr, "kernel_launch: hipFuncSetAttribute failed\n"); grid = -1; return; }
        if (hipOccupancyMaxActiveBlocksPerMultiprocessor(&per_cu, (const void*)fwd_kernel, NTHREADS, LDS_BYTES) != hipSuccess || per_cu < 1) fprintf(stderr, "kernel_launch: occupancy query says %d\n", per_cu);
        (void)hipGetLastError();
        grid = cus;
    }
    if (grid < 0) return;
    if (hipMemsetAsync((char*)d_ws + WS_CTL, 0, CTL_ZERO_BYTES, stream) != hipSuccess) return;
    if (hipMemsetAsync((char*)d_ws + WS_AGG, 0, AGG_BYTES, stream) != hipSuccess) return;
    Args a{};
    for (int i = 0; i < 26; ++i) a.in[i] = (const float*)d_in[i];
    a.out = (float*)d_out; a.ws = (unsigned char*)d_ws;
#if MK_PER_PHASE
    for (int p = 0; p < N_PHASES; ++p) { a.ph_lo = p; a.ph_hi = p + 1; hipLaunchKernelGGL(fwd_kernel, dim3(grid), dim3(NTHREADS), LDS_BYTES, stream, a); }
#else
    a.ph_lo = 0; a.ph_hi = N_PHASES;
    hipLaunchKernelGGL(fwd_kernel, dim3(grid), dim3(NTHREADS), LDS_BYTES, stream, a);
#endif
    const hipError_t le = hipPeekAtLastError();
    if (le != hipSuccess) fprintf(stderr, "kernel_launch: launch failed: %s\n", hipGetErrorName(le));
}
```

```cpp
#include <hip/hip_runtime.h>
#include <cstdio>
#include <cstdint>

#define REP_MASK 0x0
#ifndef PH_MASK
#define PH_MASK 0x7ff
#endif
#define EN(b) ((PH_MASK >> (b)) & 1)
#ifndef REP_MASK
#define REP_MASK 0
#endif
#define REPN(b) ((((REP_MASK) >> (b)) & 1) ? 2 : 1)
#ifndef Z_I8
#define Z_I8 1
#endif
#ifndef Z_FP8
#define Z_FP8 0
#endif
#ifndef MK_PER_PHASE
#define MK_PER_PHASE 0
#endif

#define LAS __attribute__((address_space(3)))
typedef unsigned short bf16_t;
typedef short bf16x8 __attribute__((ext_vector_type(8)));
typedef float f32x4 __attribute__((ext_vector_type(4)));
typedef float f32x2 __attribute__((ext_vector_type(2)));
typedef float f32x16 __attribute__((ext_vector_type(16)));
typedef unsigned u32x4 __attribute__((ext_vector_type(4)));
typedef unsigned u32x2 __attribute__((ext_vector_type(2)));

constexpr int D = 1024, NBATCH = 8, SEQ = 4096, T = NBATCH * SEQ, DEPTH = 4;
constexpr int NZ = 4608, ZO_GLRU = 1024, ZO_XPOOL = 2048, ZO_GL0 = 2560, ZO_GL1 = 3584;
constexpr int NE = 32, TOPK = 4;
constexpr int KCAT = 1536;
constexpr int SLOT_CAP = T * TOPK + NE * 256;
constexpr int MAX_MT = SLOT_CAP / 256;
constexpr float NORM_EPS = 1e-6f;
constexpr float WEIN_SCALE = 64.0f;
constexpr int NTHREADS = 512, NWAVES = 8;

constexpr size_t MiB = 1u << 20;
constexpr size_t WS_CTL = 80 * MiB, CTL_ZERO_BYTES = 256 * 1024;
constexpr size_t WS_MOD = 1 * MiB;
constexpr size_t WS_CB = 2 * MiB;
constexpr size_t WS_AGG = 72 * MiB;
constexpr size_t AGG_BYTES = (size_t)DEPTH * NBATCH * 32 * D * 8;
constexpr size_t WS_WRS = 3 * MiB;
constexpr size_t WS_HSC = 4 * MiB;
constexpr size_t WS_WINSC = 5 * MiB;
constexpr size_t WS_WRB = 40 * MiB;
constexpr size_t WS_TOKOF = 6 * MiB;
constexpr size_t WS_SLOTINFO = 10 * MiB;
constexpr size_t WS_WGT = 11 * MiB;
constexpr size_t WS_WRG = 12 * MiB;
constexpr size_t WS_WPOOL = 14 * MiB;
constexpr size_t WS_WIN = 16 * MiB;
constexpr size_t WS_WCAT = 52 * MiB;
constexpr size_t WS_WOUT = 64 * MiB;
constexpr size_t WS_WEIN = 128 * MiB;
constexpr size_t WS_WEOUT = 640 * MiB;
constexpr size_t WS_XRES = 896 * MiB;
constexpr size_t WS_H = 1024 * MiB;
constexpr size_t WS_Z = 1088 * MiB;
constexpr size_t WS_ZS = WS_Z + 96 * MiB;
constexpr size_t WS_ACAT = 1376 * MiB;
constexpr size_t WS_MERGED = 1472 * MiB;
constexpr size_t WS_ACT = 1536 * MiB;
constexpr size_t WS_OUTB = 1808 * MiB;
constexpr size_t WS_OUTSC = WS_OUTB + 144 * MiB;
constexpr size_t WS_ZG = 2080 * MiB;
constexpr size_t WS_END = 2144 * MiB;
static_assert(WS_ACT + (size_t)SLOT_CAP * 1024 * 2 <= WS_OUTB && WS_OUTB + (size_t)SLOT_CAP * 1024 * 2 <= WS_END, "ws map");
constexpr int CW_BAR = 4096;
constexpr int CW_CONVQ = 7680;
constexpr int CW_CNT = 8192;

constexpr int LDS_BYTES = 163840;
constexpr int LDS_TAB = 131072;
constexpr int LDS_NVA = 131072 + 8192;
constexpr int LDS_PTAB = 131072 + 16384, PTAB_BYTES = 2048;
constexpr int LDS_MISC = LDS_BYTES - 256;

__device__ __forceinline__ unsigned cvt_pk_bf16(float lo, float hi) { unsigned r; asm("v_cvt_pk_bf16_f32 %0, %1, %2" : "=v"(r) : "v"(lo), "v"(hi)); return r; }
__device__ __forceinline__ float bflo(unsigned w) { return __uint_as_float(w << 16); }
__device__ __forceinline__ float bfhi(unsigned w) { return __uint_as_float(w & 0xffff0000u); }
__device__ __forceinline__ float bf1(bf16_t w) { return __uint_as_float(((unsigned)w) << 16); }
__device__ __forceinline__ float sigmoidf_(float x) { return __builtin_amdgcn_rcpf(1.0f + __expf(-x)); }
#define Z_OUT_FP8 1
constexpr float Z_FP8_SCALE = 16.0f;
constexpr float OUT_FP8_SCALE = 16.0f;
constexpr float MAGIC_U8 = 12582912.0f, MAGIC_I8 = 12582912.0f + 128.0f;
__device__ __forceinline__ unsigned pack4_lowbytes(f32x4 t) {
    const unsigned p01 = __builtin_amdgcn_perm(__float_as_uint(t.y), __float_as_uint(t.x), 0x0c0c0400u), p23 = __builtin_amdgcn_perm(__float_as_uint(t.w), __float_as_uint(t.z), 0x0c0c0400u);
    return __builtin_amdgcn_perm(p23, p01, 0x05040100u);
}
__device__ __forceinline__ float shflx(float v, int mask, int lane) { return __int_as_float(__builtin_amdgcn_ds_bpermute((lane ^ mask) << 2, __float_as_int(v))); }
#define DPP_F(v, ctrl) __builtin_bit_cast(float, __builtin_amdgcn_update_dpp(0, __builtin_bit_cast(int, (v)), (ctrl), 0xF, 0xF, true))
#define RDL_F(v, l) __builtin_bit_cast(float, __builtin_amdgcn_readlane(__builtin_bit_cast(int, (v)), (l)))
__device__ __forceinline__ float wave_sum(float v, int) {
    v += DPP_F(v, 0xB1); v += DPP_F(v, 0x4E); v += DPP_F(v, 0x141); v += DPP_F(v, 0x140);
    return (RDL_F(v, 0) + RDL_F(v, 16)) + (RDL_F(v, 32) + RDL_F(v, 48));
}
__device__ __forceinline__ float wave_max(float v) {
    v = fmaxf(v, DPP_F(v, 0xB1)); v = fmaxf(v, DPP_F(v, 0x4E)); v = fmaxf(v, DPP_F(v, 0x141)); v = fmaxf(v, DPP_F(v, 0x140));
    return fmaxf(fmaxf(RDL_F(v, 0), RDL_F(v, 16)), fmaxf(RDL_F(v, 32), RDL_F(v, 48)));
}
__device__ __forceinline__ int tid_of(int wv) { int l; asm volatile("v_mbcnt_lo_u32_b32 %0, -1, 0\n\tv_mbcnt_hi_u32_b32 %0, -1, %0" : "=v"(l)); return wv * 64 + l; }
__device__ __forceinline__ int opaque_bid() { int b = blockIdx.x; asm volatile("" : "+s"(b)); return b; }
__device__ __forceinline__ unsigned char* opaque_ptr(unsigned char* p) { size_t z = 0; asm volatile("" : "+s"(z)); return p + z; }
#define LDS_WAIT() asm volatile("s_waitcnt lgkmcnt(0)" ::: "memory")
#define VM_WAIT() asm volatile("s_waitcnt vmcnt(0)" ::: "memory")

namespace pg8 {
constexpr int BM = 256, BK = 64, HALF = 128, HTB = HALF * BK * 2, STAGE_BYTES = 8 * HTB, NXCD = 8, WGM = 8;
__host__ __device__ __forceinline__ int lds_byte(int r, int c) { const int st = (r >> 4) * 2 + (c >> 5), rr = r & 15, cc = c & 31, ob = rr * 64 + cc * 2; return st * 1024 + (ob ^ (((ob >> 9) & 1) << 5)); }
__host__ __device__ __forceinline__ void stage_rc(int b, int& R, int& C) { const int st = b / 1024, sb = b % 1024, swz = sb ^ (((sb >> 9) & 1) << 5); R = (st >> 1) * 16 + swz / 64; C = (st & 1) * 32 + (swz % 64) / 2; }
__host__ __device__ __forceinline__ int perm32(int rho) { const int n = rho >> 4, i = rho & 15; return 8 * (i >> 2) + 4 * n + (i & 3); }

struct Unit { int pm, pn, e, j, row0, rows; };
typedef int v8i32 __attribute__((ext_vector_type(8)));
typedef int v4i32_t __attribute__((ext_vector_type(4)));
__device__ __forceinline__ v8i32 cat8(bf16x8 lo, bf16x8 hi) { typedef int v4i32 __attribute__((ext_vector_type(4))); const v4i32 a = __builtin_bit_cast(v4i32, lo), b = __builtin_bit_cast(v4i32, hi); return (v8i32){a.x, a.y, a.z, a.w, b.x, b.y, b.z, b.w}; }

template <int WGM_ = WGM>
__device__ __forceinline__ bool order_map(int i, int G, int c, int nM, int nN, int& pm, int& pn) {
    const int nwg = nM * nN; const int L = i * G + c; if (L >= nwg) return false;
    int wgid = L; { const int q = nwg / NXCD, r = nwg % NXCD, xcd = wgid % NXCD, off = wgid / NXCD; wgid = (xcd < r ? xcd * (q + 1) : r * (q + 1) + (xcd - r) * q) + off; }
    const int nig = WGM_ * nN, gid = wgid / nig, fm = gid * WGM_, gsz = (nM - fm) < WGM_ ? (nM - fm) : WGM_;
    pm = fm + ((wgid % nig) % gsz); pn = (wgid % nig) / gsz; return true;
}

struct PlainSched {
    static constexpr bool DYN_A = false;
    const char* A; const char* Bt; int K, nM, nN, G, c;
    __device__ __forceinline__ bool next(int i, Unit& u) const { int pm, pn; if (!order_map(i, G, c, nM, nN, pm, pn)) return false; u.pm = pm; u.pn = pn; u.e = 0; u.j = 0; u.row0 = pm * BM; u.rows = BM; return true; }
    __device__ __forceinline__ const char* a_ptr() const { return A; }
    __device__ __forceinline__ const char* b_ptr() const { return Bt; }
    __device__ __forceinline__ unsigned a_off(const Unit& u) const { return (unsigned)u.row0 * (unsigned)K * 2u; }
    __device__ __forceinline__ unsigned b_off(const Unit& u) const { return (unsigned)u.pn * (unsigned)(BM * K * 2); }
    __device__ __forceinline__ void a_voff(const Unit&, unsigned (&v)[2][2], int wv) const {
        int tid = tid_of(wv); asm volatile("" : "+v"(tid));
#pragma unroll
        for (int i = 0; i < 2; ++i) { int R, C; stage_rc(tid * 16 + i * 8192, R, C);
#pragma unroll
            for (int h = 0; h < 2; ++h) v[h][i] = (unsigned)((h * HALF + R) * K + C) * 2u; }
    }
};

template <class Epi, class Sched, bool ALIGN_EPI, int MODE = 0>
__device__ __forceinline__ void gemm_phase(LAS unsigned char* lds, const int K, const Sched& S, const Epi& E, const int wv) {
    asm volatile("" : "+s"(lds));
    int tid = tid_of(wv); asm volatile("" : "+v"(tid));
    const int wid = __builtin_amdgcn_readfirstlane(tid >> 6), lane = tid & 63, wr = wid >> 2, wc = wid & 3, fr = lane & 15, fq = lane >> 4;
    const int nt = K / BK;
    unsigned voffB;
    { int R, C; stage_rc(tid * 16, R, C);
      const int Rb = (Epi::PERM == 2) ? (64 * (R >> 5) + 16 * ((R & 15) >> 2) + 4 * ((R >> 4) & 1) + (R & 3)) : (Epi::PERM == 1) ? ((R & ~31) + perm32(R & 31)) : R; voffB = (unsigned)(Rb * K + C) * 2u; }
    const unsigned q64 = (unsigned)(64 * K * 2);
    const unsigned q64B = (Epi::PERM == 2) ? 2u * q64 : q64;
    const unsigned kstep = (unsigned)(BK * 2);
    const unsigned hstep = (Epi::PERM == 2) ? (unsigned)(8 * K * 2) : (unsigned)(HALF * K * 2);
    const __amdgpu_buffer_rsrc_t rsA = __builtin_amdgcn_make_buffer_rsrc((void*)S.a_ptr(), 0, 0xffffffff, 0x00020000);
    const __amdgpu_buffer_rsrc_t rsB = __builtin_amdgcn_make_buffer_rsrc((void*)S.b_ptr(), 0, 0xffffffff, 0x00020000);
    const unsigned ldsw = (unsigned)wid * 1024u;
    const int aoff = lds_byte(wr * 64 + fr, fq * 8), boff = lds_byte(wc * 32 + fr, fq * 8);
#define PG8_SA(b, h) (((b) * 2 + (h)) * HTB)
#define PG8_SB(b, h) ((4 + (b) * 2 + (h)) * HTB)
#define PG8_STAGE_(rs, bufoff, v0, s0, v1, s1) do { \
        __builtin_amdgcn_raw_ptr_buffer_load_lds(rs, (LAS void*)(lds + (bufoff) + ldsw), 16, (v0), (s0), 0, 0); \
        __builtin_amdgcn_raw_ptr_buffer_load_lds(rs, (LAS void*)(lds + (bufoff) + ldsw + 8192), 16, (v1), (s1), 0, 0); } while (0)
#define PG8_STAGE_B(bufoff, soff, unused) PG8_STAGE_(rsB, bufoff, voffB, (soff), voffB, (soff) + q64B)
#define PG8_STAGE_A(bufoff, soff, h) do { if constexpr (Sched::DYN_A) PG8_STAGE_(rsA, bufoff, cvA[h][0], (soff), cvA[h][1], (soff)); \
        else PG8_STAGE_(rsA, bufoff, cvA[0][0], (soff) + (h) * 2u * q64, cvA[0][0], (soff) + (h) * 2u * q64 + q64); } while (0)
#define PG8_LDA(dst, b, h) do { _Pragma("unroll") for (int m = 0; m < 4; ++m) _Pragma("unroll") for (int k = 0; k < 2; ++k) dst[m][k] = *(const LAS bf16x8*)(lds + PG8_SA(b, h) + aoff + m * 2048 + k * 1024); } while (0)
#define PG8_LDB(dst, b, h) do { _Pragma("unroll") for (int n = 0; n < 2; ++n) _Pragma("unroll") for (int k = 0; k < 2; ++k) dst[n][k] = *(const LAS bf16x8*)(lds + PG8_SB(b, h) + boff + n * 2048 + k * 1024); } while (0)
#define PG8_MMA(ai, bj, At, Bt) do { __builtin_amdgcn_s_setprio(1); _Pragma("unroll") for (int m = 0; m < 4; ++m) _Pragma("unroll") for (int n = 0; n < 2; ++n) { \
        if constexpr (MODE == 1) { acc[ai][bj][m][n] = __builtin_amdgcn_mfma_scale_f32_16x16x128_f8f6f4(cat8(Bt[n][0], Bt[n][1]), cat8(At[m][0], At[m][1]), acc[ai][bj][m][n], 0, 0, 0, 0x7f7f7f7f, 0, 0x7f7f7f7f); } \
        else if constexpr (MODE == 2) { _Pragma("unroll") for (int k = 0; k < 2; ++k) acc[ai][bj][m][n] = __builtin_bit_cast(f32x4, __builtin_amdgcn_mfma_i32_16x16x64_i8(__builtin_bit_cast(v4i32_t, Bt[n][k]), __builtin_bit_cast(v4i32_t, At[m][k]), __builtin_bit_cast(v4i32_t, acc[ai][bj][m][n]), 0, 0, 0)); } \
        else { _Pragma("unroll") for (int k = 0; k < 2; ++k) acc[ai][bj][m][n] = __builtin_amdgcn_mfma_f32_16x16x32_bf16(Bt[n][k], At[m][k], acc[ai][bj][m][n], 0, 0, 0); } } \
        __builtin_amdgcn_s_setprio(0); } while (0)
#define PG8_WAIT_V(n) asm volatile("s_waitcnt vmcnt(" #n ")" ::: "memory")
#define PG8_WAIT_L(n) asm volatile("s_waitcnt lgkmcnt(" #n ")" ::: "memory")
#define PG8_BAR __builtin_amdgcn_s_barrier()
#define PG8_SCHED __builtin_amdgcn_sched_barrier(0)
    Unit cur, nxt; int ui = 0;
    if (!S.next(0, cur)) return;
    f32x4 acc[2][2][4][2];
    { float z0 = 0.f; asm volatile("" : "+v"(z0));
#pragma unroll
    for (int a = 0; a < 2; ++a)
#pragma unroll
        for (int b = 0; b < 2; ++b)
#pragma unroll
            for (int m = 0; m < 4; ++m)
#pragma unroll
                for (int n = 0; n < 2; ++n) acc[a][b][m][n] = (f32x4){z0, z0, z0, z0}; }
    bf16x8 At[4][2], B0[2][2], B1[2][2];
    unsigned cvA[2][2];
    S.a_voff(cur, cvA, wv);
    unsigned cA = S.a_off(cur), cB = S.b_off(cur);
    if constexpr (Epi::PREF) E.prefetch(cur, lds + LDS_PTAB, wv);
    PG8_STAGE_B(PG8_SB(0, 0), cB, voffB); PG8_STAGE_B(PG8_SB(0, 1), cB + hstep, voffB); PG8_STAGE_A(PG8_SA(0, 0), cA, 0); PG8_STAGE_A(PG8_SA(0, 1), cA, 1);
    if (wr == 1) PG8_BAR;
    PG8_WAIT_V(2); PG8_BAR;
    PG8_STAGE_B(PG8_SB(1, 0), cB + kstep, voffB); PG8_STAGE_A(PG8_SA(1, 0), cA + kstep, 0); PG8_STAGE_B(PG8_SB(1, 1), cB + hstep + kstep, voffB);
    PG8_WAIT_V(6); PG8_BAR;
    for (;;) {
        const bool has_next = S.next(ui + 1, nxt);
        unsigned nA = cA, nB = cB;
        if (has_next) { nA = S.a_off(nxt); nB = S.b_off(nxt); }
        if constexpr (Sched::DYN_A) { if (has_next) S.a_dma(nxt, lds + LDS_NVA, wv); }
#pragma unroll 1
        for (int t = 0; t < nt; t += 2) {
            const bool last = (t == nt - 2);
            const unsigned a1 = cA + (unsigned)(t + 1) * kstep;
            const unsigned a2 = last ? nA : cA + (unsigned)(t + 2) * kstep, b2 = last ? nB : cB + (unsigned)(t + 2) * kstep;
            const unsigned a3 = a2 + kstep, b3 = b2 + kstep;
            unsigned nx1[2] = {cvA[1][0], cvA[1][1]};
            if constexpr (Sched::DYN_A) { if (last && has_next) { unsigned q[4]; S.a_fetch(lds + LDS_NVA, wv, q); cvA[0][0] = q[0]; cvA[0][1] = q[1]; nx1[0] = q[2]; nx1[1] = q[3]; } }
            if constexpr (Epi::HOOK_T >= 0) { if (t == Epi::HOOK_T) E.mid(acc, cur, wr, wc, fr, fq); }
            PG8_LDB(B0, 0, 0); PG8_LDB(B1, 0, 1); PG8_SCHED; PG8_LDA(At, 0, 0); PG8_STAGE_A(PG8_SA(1, 1), a1, 1);
            if constexpr (Sched::DYN_A) { cvA[1][0] = nx1[0]; cvA[1][1] = nx1[1]; }
            PG8_WAIT_V(8); PG8_WAIT_L(0); PG8_BAR; PG8_MMA(0, 0, At, B0); PG8_MMA(0, 1, At, B1); PG8_BAR; PG8_SCHED;
            PG8_LDA(At, 0, 1); PG8_STAGE_B(PG8_SB(0, 0), b2, voffB); PG8_STAGE_B(PG8_SB(0, 1), b2 + hstep, voffB); PG8_STAGE_A(PG8_SA(0, 0), a2, 0);
            PG8_WAIT_V(8); PG8_WAIT_L(0); PG8_BAR; PG8_MMA(1, 0, At, B0); PG8_MMA(1, 1, At, B1); PG8_BAR; PG8_SCHED;
            PG8_LDB(B0, 1, 0); PG8_LDB(B1, 1, 1); PG8_SCHED; PG8_LDA(At, 1, 0); PG8_STAGE_A(PG8_SA(0, 1), a2, 1);
            PG8_WAIT_V(8); PG8_WAIT_L(0); PG8_BAR; PG8_MMA(0, 0, At, B0); PG8_MMA(0, 1, At, B1); PG8_BAR; PG8_SCHED;
            PG8_LDA(At, 1, 1); PG8_STAGE_B(PG8_SB(1, 0), b3, voffB); PG8_STAGE_B(PG8_SB(1, 1), b3 + hstep, voffB); PG8_STAGE_A(PG8_SA(1, 0), a3, 0);
            PG8_WAIT_V(8); PG8_WAIT_L(0); PG8_BAR; PG8_MMA(1, 0, At, B0); PG8_MMA(1, 1, At, B1); PG8_BAR; PG8_SCHED;
        }
        if constexpr (ALIGN_EPI) { if (wr == 0) PG8_BAR; }
        if constexpr (Epi::PREF) E.run(acc, cur, wr, wc, lds + LDS_PTAB + (ui & 1) * PTAB_BYTES); else E(acc, cur, wr, wc, fr, fq);
        if (!has_next) break;
        { float z0 = 0.f; asm volatile("" : "+v"(z0));
#pragma unroll
        for (int a = 0; a < 2; ++a)
#pragma unroll
            for (int b = 0; b < 2; ++b)
#pragma unroll
                for (int m = 0; m < 4; ++m)
#pragma unroll
                    for (int n = 0; n < 2; ++n) acc[a][b][m][n] = (f32x4){z0, z0, z0, z0}; }
        cur = nxt; cA = nA; cB = nB; ++ui;
        if constexpr (Epi::PREF) E.prefetch(cur, lds + LDS_PTAB + (ui & 1) * PTAB_BYTES, wv);
        if constexpr (ALIGN_EPI) { if (wr == 1) PG8_BAR; }
    }
    PG8_WAIT_V(0);
    if constexpr (!ALIGN_EPI) { if (wr == 0) PG8_BAR; }
    PG8_BAR;
#undef PG8_SA
#undef PG8_SB
#undef PG8_STAGE_
#undef PG8_STAGE_A
#undef PG8_STAGE_B
#undef PG8_LDA
#undef PG8_LDB
#undef PG8_MMA
#undef PG8_WAIT_V
#undef PG8_WAIT_L
#undef PG8_BAR
#undef PG8_SCHED
}

struct EpiBf16 {
    static constexpr int PERM = 1; static constexpr int HOOK_T = -1; static constexpr bool PREF = false;
    bf16_t* O; int ldc; const float* bias; int noepi; float scale;
    __device__ __forceinline__ void mid(f32x4 (&)[2][2][4][2], const Unit&, int, int, int, int) const {}
    __device__ __forceinline__ void operator()(const f32x4 (&acc)[2][2][4][2], const Unit& u, int wr, int wc, int fr, int fq) const {
        { const int l_ = tid_of(0); fr = l_ & 15; fq = l_ >> 4; }
        if (noepi) { if (acc[0][0][0][0][0] == 1.2345e-30f) O[0] = 0; return; }
        int row0 = u.row0 + wr * 64 + fr; asm volatile("" : "+v"(row0)); int col0 = u.pn * BM + wc * 32 + 8 * fq; asm volatile("" : "+v"(col0));
        f32x4 bv[2][2];
#pragma unroll
        for (int bj = 0; bj < 2; ++bj)
#pragma unroll
            for (int n = 0; n < 2; ++n) bv[bj][n] = bias ? *(const f32x4*)(bias + col0 + bj * HALF + 4 * n) : (f32x4){0.f, 0.f, 0.f, 0.f};
#pragma unroll
        for (int ai = 0; ai < 2; ++ai)
#pragma unroll
            for (int m = 0; m < 4; ++m) { bf16_t* rowp = O + (size_t)(row0 + ai * HALF + m * 16) * ldc + col0;
#pragma unroll
                for (int bj = 0; bj < 2; ++bj) { const f32x4 v0 = acc[ai][bj][m][0] * scale + bv[bj][0], v1 = acc[ai][bj][m][1] * scale + bv[bj][1];
                    u32x4 w; w.x = cvt_pk_bf16(v0[0], v0[1]); w.y = cvt_pk_bf16(v0[2], v0[3]); w.z = cvt_pk_bf16(v1[0], v1[1]); w.w = cvt_pk_bf16(v1[2], v1[3]);
                    *(u32x4*)(rowp + bj * HALF) = w; } }
    }
};
struct EpiZI8 {
    static constexpr int PERM = 2; static constexpr int HOOK_T = -1; static constexpr bool PREF = true;
    bf16_t* O; float* ZS; unsigned char* ZG; const unsigned char* wsb; unsigned rsc_off, csc_off;
    __device__ __forceinline__ void mid(f32x4 (&)[2][2][4][2], const Unit&, int, int, int, int) const {}
    __device__ __forceinline__ void prefetch(const Unit& u, LAS unsigned char* tab, int wv) const {
        const int t = tid_of(wv);
        const unsigned vo = (t < 256) ? (rsc_off + (unsigned)(u.row0 + t) * 4u) : (csc_off + (unsigned)(u.pn * BM + t - 256) * 4u);
        const __amdgpu_buffer_rsrc_t rs = __builtin_amdgcn_make_buffer_rsrc((void*)wsb, 0, 0xffffffff, 0x00020000);
        __builtin_amdgcn_raw_ptr_buffer_load_lds(rs, (LAS void*)(tab + wv * 256), 4, vo, 0, 0, 0);
    }
    __device__ __forceinline__ void run(const f32x4 (&acc)[2][2][4][2], const Unit& u, int wr, int wc, const LAS unsigned char* tab) const {
        int fr, fq; const int lane_ = tid_of(0); fr = lane_ & 15; fq = lane_ >> 4;
        int row0 = u.row0 + wr * 64 + fr; asm volatile("" : "+v"(row0)); int col0 = u.pn * BM + wc * 64 + 16 * fq; asm volatile("" : "+v"(col0));
        const LAS float* tf = (const LAS float*)tab;
        f32x4 cs[2][2];
#pragma unroll
        for (int bj = 0; bj < 2; ++bj)
#pragma unroll
            for (int n = 0; n < 2; ++n) cs[bj][n] = *(const LAS f32x4*)(tf + 256 + wc * 64 + 16 * fq + 8 * bj + 4 * n);
        if (u.pn >= ZO_GL0 / BM) {
#pragma unroll
            for (int bj = 0; bj < 2; ++bj)
#pragma unroll
                for (int n = 0; n < 2; ++n) cs[bj][n] *= -1.4426950408889634f;
#pragma unroll
            for (int ai = 0; ai < 2; ++ai)
#pragma unroll
                for (int m = 0; m < 4; ++m) { const int r = row0 + ai * HALF + m * 16; const float rs = tf[ai * HALF + wr * 64 + m * 16 + fr];
                    unsigned w[4];
#pragma unroll
                    for (int q = 0; q < 4; ++q) { const v4i32_t iv = __builtin_bit_cast(v4i32_t, acc[ai][q >> 1][m][q & 1]);
                        f32x4 e = (f32x4){(float)iv.x, (float)iv.y, (float)iv.z, (float)iv.w} * rs * cs[q >> 1][q & 1];
#pragma unroll
                        for (int j = 0; j < 4; ++j) e[j] = __builtin_amdgcn_exp2f(e[j]);
                        e += 1.0f;
#pragma unroll
                        for (int j = 0; j < 4; ++j) e[j] = __builtin_amdgcn_rcpf(e[j]);
                        w[q] = pack4_lowbytes(e * 255.0f + MAGIC_U8); }
                    *(u32x4*)(ZG + (size_t)r * 2048 + (col0 - ZO_GL0)) = (u32x4){w[0], w[1], w[2], w[3]}; }
        } else {
#if Z_OUT_FP8
#pragma unroll
            for (int bj = 0; bj < 2; ++bj)
#pragma unroll
                for (int n = 0; n < 2; ++n) cs[bj][n] *= Z_FP8_SCALE;
#pragma unroll
            for (int ai = 0; ai < 2; ++ai)
#pragma unroll
                for (int m = 0; m < 4; ++m) { const int r = row0 + ai * HALF + m * 16; const float rs = tf[ai * HALF + wr * 64 + m * 16 + fr];
                    unsigned w[4];
#pragma unroll
                    for (int q = 0; q < 4; ++q) { const v4i32_t iv = __builtin_bit_cast(v4i32_t, acc[ai][q >> 1][m][q & 1]);
                        const f32x4 v = (f32x4){(float)iv.x, (float)iv.y, (float)iv.z, (float)iv.w} * rs * cs[q >> 1][q & 1];
                        int p = 0; p = __builtin_amdgcn_cvt_pk_fp8_f32(v.x, v.y, p, false); p = __builtin_amdgcn_cvt_pk_fp8_f32(v.z, v.w, p, true); w[q] = (unsigned)p; }
                    *(u32x4*)((unsigned char*)O + (size_t)r * 2560 + col0) = (u32x4){w[0], w[1], w[2], w[3]}; }
        }
#else
#pragma unroll
            for (int ai = 0; ai < 2; ++ai)
#pragma unroll
                for (int m = 0; m < 4; ++m) { const int r = row0 + ai * HALF + m * 16; const float rs = tf[ai * HALF + wr * 64 + m * 16 + fr]; f32x4 vq[4];
                    float am = 1e-30f;
#pragma unroll
                    for (int q = 0; q < 4; ++q) { const v4i32_t iv = __builtin_bit_cast(v4i32_t, acc[ai][q >> 1][m][q & 1]);
                        vq[q] = (f32x4){(float)iv.x, (float)iv.y, (float)iv.z, (float)iv.w} * cs[q >> 1][q & 1];
                        am = fmaxf(am, fmaxf(fmaxf(fabsf(vq[q].x), fabsf(vq[q].y)), fmaxf(fabsf(vq[q].z), fabsf(vq[q].w)))); }
                    am = fmaxf(am, shflx(am, 16, lane_)); am = fmaxf(am, shflx(am, 32, lane_));
                    const float inv = 127.0f * __builtin_amdgcn_rcpf(am) * 0.999f;
                    if (fq == 0) ZS[(size_t)r * 40 + u.pn * 4 + wc] = am * rs * (1.0f / (127.0f * 0.999f));
                    unsigned w[4];
#pragma unroll
                    for (int q = 0; q < 4; ++q) w[q] = pack4_lowbytes(vq[q] * inv + MAGIC_I8);
                    *(u32x4*)((unsigned char*)O + (size_t)r * 2560 + col0) = (u32x4){w[0], w[1], w[2], w[3]}; }
        }
#endif
    }
    __device__ __forceinline__ void operator()(const f32x4 (&)[2][2][4][2], const Unit&, int, int, int, int) const {}
};
struct EpiMerged {
    static constexpr int PERM = 2; static constexpr int HOOK_T = 8; static constexpr bool PREF = false;
    bf16_t* O; const unsigned char* ZG;
    __device__ __forceinline__ void mid(f32x4 (&acc)[2][2][4][2], const Unit& u, int wr, int wc, int fr, int fq) const {
        { const int l_ = tid_of(0); fr = l_ & 15; fq = l_ >> 4; }
        int row0 = u.row0 + wr * 64 + fr; asm volatile("" : "+v"(row0)); int col0 = u.pn * BM + wc * 64 + 16 * fq; asm volatile("" : "+v"(col0));
        u32x4 g0[2][4], g1[2][4];
#pragma unroll
        for (int ai = 0; ai < 2; ++ai)
#pragma unroll
            for (int m = 0; m < 4; ++m) { const unsigned char* zr = ZG + (size_t)(row0 + ai * HALF + m * 16) * 2048 + col0;
                g0[ai][m] = *(const u32x4*)zr; g1[ai][m] = *(const u32x4*)(zr + 1024); }
#pragma unroll
        for (int ai = 0; ai < 2; ++ai)
#pragma unroll
            for (int m = 0; m < 4; ++m)
#pragma unroll
                for (int bj = 0; bj < 2; ++bj) {
                    const unsigned a0[2] = {bj ? g0[ai][m].z : g0[ai][m].x, bj ? g0[ai][m].w : g0[ai][m].y}, a1[2] = {bj ? g1[ai][m].z : g1[ai][m].x, bj ? g1[ai][m].w : g1[ai][m].y};
#pragma unroll
                    for (int n = 0; n < 2; ++n)
#pragma unroll
                        for (int j = 0; j < 4; ++j) { const float u0 = fmaxf((float)((a0[n] >> (8 * j)) & 0xffu), 1.0f), u1 = (float)((a1[n] >> (8 * j)) & 0xffu);
                            acc[ai][bj][m][n][j] *= u1 * __builtin_amdgcn_rcpf(u0); } }
    }
    __device__ __forceinline__ void operator()(const f32x4 (&acc)[2][2][4][2], const Unit& u, int wr, int wc, int fr, int fq) const {
        { const int l_ = tid_of(0); fr = l_ & 15; fq = l_ >> 4; }
        int row0 = u.row0 + wr * 64 + fr; asm volatile("" : "+v"(row0)); int col0 = u.pn * BM + wc * 64 + 16 * fq; asm volatile("" : "+v"(col0));
        u32x4 g0[2][4];
#pragma unroll
        for (int ai = 0; ai < 2; ++ai)
#pragma unroll
            for (int m = 0; m < 4; ++m) { const unsigned char* zr = ZG + (size_t)(row0 + ai * HALF + m * 16) * 2048 + col0;
                g0[ai][m] = *(const u32x4*)zr; }
#pragma unroll
        for (int ai = 0; ai < 2; ++ai)
#pragma unroll
            for (int m = 0; m < 4; ++m) { bf16_t* orow = O + (size_t)(row0 + ai * HALF + m * 16) * D + col0;
#pragma unroll
                for (int bj = 0; bj < 2; ++bj) { const unsigned a0[2] = {bj ? g0[ai][m].z : g0[ai][m].x, bj ? g0[ai][m].w : g0[ai][m].y};
                    float o[8];
#pragma unroll
                    for (int n = 0; n < 2; ++n)
#pragma unroll
                        for (int j = 0; j < 4; ++j) o[4 * n + j] = acc[ai][bj][m][n][j] * (fmaxf((float)((a0[n] >> (8 * j)) & 0xffu), 1.0f) * (1.0f / 255.0f));
                    u32x4 w; w.x = cvt_pk_bf16(o[0], o[1]); w.y = cvt_pk_bf16(o[2], o[3]); w.z = cvt_pk_bf16(o[4], o[5]); w.w = cvt_pk_bf16(o[6], o[7]);
                    *(u32x4*)(orow + bj * 8) = w; } }
    }
};
struct EpiResid {
    static constexpr int PERM = 1; static constexpr int HOOK_T = -1; static constexpr bool PREF = false;
    bf16_t* X; bf16_t* XO; const float* gate;
    __device__ __forceinline__ void mid(f32x4 (&)[2][2][4][2], const Unit&, int, int, int, int) const {}
    __device__ __forceinline__ void operator()(const f32x4 (&acc)[2][2][4][2], const Unit& u, int wr, int wc, int fr, int fq) const {
        { const int l_ = tid_of(0); fr = l_ & 15; fq = l_ >> 4; }
        int row0 = u.row0 + wr * 64 + fr; asm volatile("" : "+v"(row0)); int col0 = u.pn * BM + wc * 32 + 8 * fq; asm volatile("" : "+v"(col0));
        const float* gp = gate + (size_t)(u.row0 / SEQ) * (6 * D) + col0;
        f32x4 gv[2][2];
#pragma unroll
        for (int bj = 0; bj < 2; ++bj)
#pragma unroll
            for (int n = 0; n < 2; ++n) gv[bj][n] = *(const f32x4*)(gp + bj * HALF + 4 * n);
#pragma unroll
        for (int ai = 0; ai < 2; ++ai) {
            u32x4 xv[4][2];
#pragma unroll
            for (int m = 0; m < 4; ++m) { const bf16_t* rowp = X + (size_t)(row0 + ai * HALF + m * 16) * D + col0;
#pragma unroll
                for (int bj = 0; bj < 2; ++bj) xv[m][bj] = *(const u32x4*)(rowp + bj * HALF); }
#pragma unroll
            for (int m = 0; m < 4; ++m) { bf16_t* rowo = XO + (size_t)(row0 + ai * HALF + m * 16) * D + col0;
#pragma unroll
                for (int bj = 0; bj < 2; ++bj) { const u32x4 p = xv[m][bj];
                    const f32x4 o0 = (f32x4){bflo(p.x), bfhi(p.x), bflo(p.y), bfhi(p.y)} + gv[bj][0] * acc[ai][bj][m][0], o1 = (f32x4){bflo(p.z), bfhi(p.z), bflo(p.w), bfhi(p.w)} + gv[bj][1] * acc[ai][bj][m][1];
                    u32x4 w; w.x = cvt_pk_bf16(o0[0], o0[1]); w.y = cvt_pk_bf16(o0[2], o0[3]); w.z = cvt_pk_bf16(o1[0], o1[1]); w.w = cvt_pk_bf16(o1[2], o1[3]);
                    *(u32x4*)(rowo + bj * HALF) = w; } }
            asm volatile("" ::: "memory"); }
    }
};
constexpr float SG_C = -1.702f * 1.4426950408889634f;
struct EpiSwiglu {
    static constexpr int PERM = 1; static constexpr int HOOK_T = -1; static constexpr bool PREF = true;
    unsigned char* ACT; const float* bias; float wscale;
    __device__ __forceinline__ void mid(f32x4 (&)[2][2][4][2], const Unit&, int, int, int, int) const {}
    __device__ __forceinline__ void operator()(const f32x4 (&)[2][2][4][2], const Unit&, int, int, int, int) const {}
    __device__ __forceinline__ void prefetch(const Unit& u, LAS unsigned char* tab, int wv) const {
        const int t = tid_of(wv) & 255;
        const __amdgpu_buffer_rsrc_t rs = __builtin_amdgcn_make_buffer_rsrc((void*)bias, 0, 0xffffffff, 0x00020000);
        __builtin_amdgcn_raw_ptr_buffer_load_lds(rs, (LAS void*)(tab + (wv & 3) * 256), 4, (unsigned)(u.e * 2048 + (t >> 7) * 1024 + u.pn * HALF + (t & 127)) * 4u, 0, 0, 0);
    }
    __device__ __forceinline__ void run(const f32x4 (&acc)[2][2][4][2], const Unit& u, int wr, int wc, const LAS unsigned char* tab) const {
        int fr, fq; { const int l_ = tid_of(0); fr = l_ & 15; fq = l_ >> 4; }
        int row0 = u.row0 + wr * 64 + fr; asm volatile("" : "+v"(row0)); int cc = u.pn * HALF + wc * 32 + 8 * fq; asm volatile("" : "+v"(cc));
        const LAS float* tf = (const LAS float*)tab + wc * 32 + 8 * fq;
        f32x4 bg[2], bu[2];
#pragma unroll
        for (int n = 0; n < 2; ++n) { bg[n] = *(const LAS f32x4*)(tf + 4 * n) * SG_C; bu[n] = *(const LAS f32x4*)(tf + HALF + 4 * n) + 1.0f; }
        const float wsc = wscale * SG_C;
#pragma unroll
        for (int ai = 0; ai < 2; ++ai)
#pragma unroll
            for (int m = 0; m < 4; ++m) { unsigned char* rowp = ACT + (size_t)(row0 + ai * HALF + m * 16) * D + cc;
                float o[8];
#pragma unroll
                for (int n = 0; n < 2; ++n) {
                    f32x4 t = acc[ai][0][m][n] * wsc + bg[n], up = acc[ai][1][m][n] * wscale + bu[n], e;
#pragma unroll
                    for (int j = 0; j < 4; ++j) { t[j] = fmaxf(t[j], 7.0f * SG_C); e[j] = __builtin_amdgcn_exp2f(t[j]); up[j] = __builtin_amdgcn_fmed3f(up[j], -6.0f, 8.0f); }
                    e += 1.0f;
#pragma unroll
                    for (int j = 0; j < 4; ++j) e[j] = __builtin_amdgcn_rcpf(e[j]);
                    const f32x4 r = (t * (1.0f / SG_C)) * (e * up);
#pragma unroll
                    for (int j = 0; j < 4; ++j) o[4 * n + j] = r[j]; }
                int w0 = 0, w1 = 0;
                w0 = __builtin_amdgcn_cvt_pk_fp8_f32(o[0], o[1], w0, false); w0 = __builtin_amdgcn_cvt_pk_fp8_f32(o[2], o[3], w0, true);
                w1 = __builtin_amdgcn_cvt_pk_fp8_f32(o[4], o[5], w1, false); w1 = __builtin_amdgcn_cvt_pk_fp8_f32(o[6], o[7], w1, true);
                *(u32x2*)rowp = (u32x2){(unsigned)w0, (unsigned)w1}; }
    }
};
struct EpiMoeOut {
    static constexpr int PERM = 2; static constexpr int HOOK_T = -1; static constexpr bool PREF = true;
    unsigned char* O; float* SC; const float* bias; float wscale;
    __device__ __forceinline__ void mid(f32x4 (&)[2][2][4][2], const Unit&, int, int, int, int) const {}
    __device__ __forceinline__ void operator()(const f32x4 (&)[2][2][4][2], const Unit&, int, int, int, int) const {}
    __device__ __forceinline__ void prefetch(const Unit& u, LAS unsigned char* tab, int wv) const {
        const int t = tid_of(wv) & 255;
        const __amdgpu_buffer_rsrc_t rs = __builtin_amdgcn_make_buffer_rsrc((void*)bias, 0, 0xffffffff, 0x00020000);
        __builtin_amdgcn_raw_ptr_buffer_load_lds(rs, (LAS void*)(tab + (wv & 3) * 256), 4, (unsigned)(u.e * D + u.pn * BM + t) * 4u, 0, 0, 0);
    }
    __device__ __forceinline__ void run(const f32x4 (&acc)[2][2][4][2], const Unit& u, int wr, int wc, const LAS unsigned char* tab) const {
        int fr, fq; { const int lane_ = tid_of(0); fr = lane_ & 15; fq = lane_ >> 4; }
        int row0 = u.row0 + wr * 64 + fr; asm volatile("" : "+v"(row0)); int col0 = u.pn * BM + wc * 64 + 16 * fq; asm volatile("" : "+v"(col0));
        const LAS float* tf = (const LAS float*)tab;
        f32x4 bv[2][2];
#pragma unroll
        for (int bj = 0; bj < 2; ++bj)
#pragma unroll
            for (int n = 0; n < 2; ++n) bv[bj][n] = *(const LAS f32x4*)(tf + wc * 64 + 16 * fq + 8 * bj + 4 * n);
        const float ws16 = wscale * OUT_FP8_SCALE;
#pragma unroll
        for (int bj = 0; bj < 2; ++bj)
#pragma unroll
            for (int n = 0; n < 2; ++n) bv[bj][n] *= OUT_FP8_SCALE;
#pragma unroll
        for (int ai = 0; ai < 2; ++ai)
#pragma unroll
            for (int m = 0; m < 4; ++m) { const size_t r = (size_t)(row0 + ai * HALF + m * 16);
                unsigned w[4];
#pragma unroll
                for (int q = 0; q < 4; ++q) { const f32x4 v = acc[ai][q >> 1][m][q & 1] * ws16 + bv[q >> 1][q & 1];
                    int p = 0; p = __builtin_amdgcn_cvt_pk_fp8_f32(v.x, v.y, p, false); p = __builtin_amdgcn_cvt_pk_fp8_f32(v.z, v.w, p, true); w[q] = (unsigned)p; }
                *(u32x4*)(O + r * D + col0) = (u32x4){w[0], w[1], w[2], w[3]}; }
    }
};
}

#define XB_TMO      128
#define XB_XCNT(j)  (256  + 64 * (j))
#define XB_XSUB(j)  (1280 + 64 * (j))
#define XB_XGEN(j)  (2304 + 64 * (j))
#define XB_TOP      3328
#define XB_TOPGEN   3392
#define XCD_BAR_WORDS 3456
#define XB_SPIN_CAP (1u << 18)
__device__ __forceinline__ unsigned xb_ld(unsigned* p)              { return __hip_atomic_load(p, __ATOMIC_RELAXED, __HIP_MEMORY_SCOPE_AGENT); }
__device__ __forceinline__ unsigned xb_add(unsigned* p, unsigned v) { return __hip_atomic_fetch_add(p, v, __ATOMIC_RELAXED, __HIP_MEMORY_SCOPE_AGENT); }
__device__ __forceinline__ unsigned xb_xcc_id() { return (unsigned)__builtin_amdgcn_s_getreg((3 << 11) | 20) & 0xFu; }
#define XB_SPIN(cond, bar) do { unsigned _sp = 0; while (cond) { __builtin_amdgcn_s_sleep(1); \
    if ((++_sp & 255u) == 0u) { if (xb_ld(&(bar)[XB_TMO])) break; if (_sp > XB_SPIN_CAP) { atomicAdd(&(bar)[XB_TMO], 1u); break; } } } } while (0)
struct XcdBarrier { unsigned* bar; unsigned x; volatile LAS unsigned* st; int wv; };
__device__ __forceinline__ XcdBarrier xcd_barrier_post(unsigned* bar, volatile LAS unsigned* st, int wv) {
    XcdBarrier b; b.bar = bar; b.x = xb_xcc_id(); b.st = st; b.wv = wv;
    if (tid_of(wv) == 0) (void)xb_add(&bar[XB_XCNT(b.x)], 1u);
    return b;
}
__device__ __forceinline__ void xcd_barrier_complete(unsigned* bar, unsigned x, unsigned& nloc, unsigned& nx) {
    const unsigned G = gridDim.x * gridDim.y * gridDim.z;
    unsigned sum, cnt, mine, sp = 0u;
    for (;;) {
        sum = 0u; cnt = 0u; mine = 0u;
#pragma unroll
        for (unsigned j = 0; j < 16; ++j) { const unsigned c = xb_ld(&bar[XB_XCNT(j)]); sum += c; cnt += (c > 0u) ? 1u : 0u; mine = (j == x) ? c : mine; }
        if (sum == G) break;
        __builtin_amdgcn_s_sleep(1);
        if ((++sp & 255u) == 0u) { if (xb_ld(&bar[XB_TMO])) break; if (sp > XB_SPIN_CAP) { atomicAdd(&bar[XB_TMO], 1u); break; } }
    }
    nloc = mine > 0u ? mine : 1u; nx = cnt > 0u ? cnt : 1u;
}
__device__ __forceinline__ void xcd_barrier(const XcdBarrier& b) {
    asm volatile("s_waitcnt vmcnt(0)" ::: "memory");
    __syncthreads();
    if (tid_of(b.wv) == 0) {
        size_t zb = 0; asm volatile("" : "+s"(zb)); unsigned* bar = b.bar + zb; unsigned bx = b.x; asm volatile("" : "+s"(bx));
        __builtin_amdgcn_s_waitcnt(0);
        unsigned nloc = b.st[0], nx = b.st[1];
        if (nloc == 0u) { xcd_barrier_complete(bar, bx, nloc, nx); b.st[0] = nloc; b.st[1] = nx; }
        const unsigned old = xb_add(&bar[XB_XSUB(bx)], 1u);
        const unsigned gen = old / nloc;
        if (old + 1u == (gen + 1u) * nloc) {
            __builtin_amdgcn_fence(__ATOMIC_RELEASE, "agent");
            asm volatile("s_waitcnt vmcnt(0)" ::: "memory");
            const unsigned og = xb_add(&bar[XB_TOP], 1u);
            const unsigned tg = og / nx;
            if (og + 1u == (tg + 1u) * nx) xb_add(&bar[XB_TOPGEN], 1u);
            else XB_SPIN(xb_ld(&bar[XB_TOPGEN]) == tg, bar);
            __builtin_amdgcn_fence(__ATOMIC_ACQUIRE, "agent");
            xb_add(&bar[XB_XGEN(bx)], 1u);
            asm volatile("s_waitcnt vmcnt(0)" ::: "memory");
        } else {
            XB_SPIN(xb_ld(&bar[XB_XGEN(bx)]) == gen, bar);
            __builtin_amdgcn_fence(__ATOMIC_ACQUIRE, "agent");
            asm volatile("s_waitcnt vmcnt(0)" ::: "memory");
        }
    }
    __syncthreads();
}

struct Args { const float* in[26]; float* out; unsigned char* ws; int ph_lo, ph_hi; };
enum { I_X = 0, I_C, I_N1G, I_N2G, I_WADA, I_BADA, I_WIN, I_CONVW, I_CONVB, I_WRGA, I_BRGA, I_WRGX, I_BRGX, I_LAM, I_WPOOL, I_PSCALE, I_WUPA, I_WUPB, I_WOUT, I_WROUTER, I_BROUTER, I_WEIN, I_BEIN, I_WEOUT, I_BEOUT, I_FINALG };

template <int ROWMODE>
__device__ __forceinline__ void tr_item(const float* W, int N, bf16_t* WT, int dst_ld, int dst_off, int k0, int n0, LAS float* scr, int lane) {
    { float tv[32];
#pragma unroll
    for (int i = 0; i < 32; ++i) tv[i] = W[(size_t)(k0 + 2 * i + (lane >> 5)) * N + n0 + (lane & 31)];
#pragma unroll
    for (int i = 0; i < 32; ++i) scr[(2 * i + (lane >> 5)) * 33 + (lane & 31)] = tv[i]; }
    LDS_WAIT();
    const int c = lane & 7;
#pragma unroll
    for (int j = 0; j < 4; ++j) { const int n = (lane >> 3) + 8 * j; const LAS float* s = scr + (8 * c) * 33 + n;
        u32x4 o; o.x = cvt_pk_bf16(s[0 * 33], s[1 * 33]); o.y = cvt_pk_bf16(s[2 * 33], s[3 * 33]); o.z = cvt_pk_bf16(s[4 * 33], s[5 * 33]); o.w = cvt_pk_bf16(s[6 * 33], s[7 * 33]);
        const int nn = n0 + n; int drow = nn;
        if (ROWMODE == 1) { drow = (nn < 1024) ? (256 * (nn >> 7) + (nn & 127)) : (256 * ((nn - 1024) >> 7) + 128 + ((nn - 1024) & 127)); }
        *(u32x4*)(WT + (size_t)drow * dst_ld + dst_off + k0 + 8 * c) = o; }
    LDS_WAIT();
}
template <int ROWMODE>
__device__ __forceinline__ void tr_item_fp8(const float* W, int N, unsigned char* WT, int k0, int n0, LAS float* scr, int lane) {
    { float tv[64];
#pragma unroll
    for (int i = 0; i < 64; ++i) tv[i] = W[(size_t)(k0 + 2 * i + (lane >> 5)) * N + n0 + (lane & 31)];
#pragma unroll
    for (int i = 0; i < 64; ++i) scr[(2 * i + (lane >> 5)) * 33 + (lane & 31)] = tv[i]; }
    LDS_WAIT();
    const int c = lane & 7;
#pragma unroll
    for (int j = 0; j < 4; ++j) { const int n = (lane >> 3) + 8 * j; const LAS float* s = scr + (16 * c) * 33 + n;
        int o[4];
#pragma unroll
        for (int q = 0; q < 4; ++q) { int w = 0; w = __builtin_amdgcn_cvt_pk_fp8_f32(s[(4 * q) * 33] * WEIN_SCALE, s[(4 * q + 1) * 33] * WEIN_SCALE, w, false);
            w = __builtin_amdgcn_cvt_pk_fp8_f32(s[(4 * q + 2) * 33] * WEIN_SCALE, s[(4 * q + 3) * 33] * WEIN_SCALE, w, true); o[q] = w; }
        const int nn = n0 + n; const int drow = (ROWMODE == 0) ? nn : ((nn < 1024) ? (256 * (nn >> 7) + (nn & 127)) : (256 * ((nn - 1024) >> 7) + 128 + ((nn - 1024) & 127)));
        *(u32x4*)(WT + (size_t)drow * 1024 + k0 + 16 * c) = (u32x4){(unsigned)o[0], (unsigned)o[1], (unsigned)o[2], (unsigned)o[3]}; }
    LDS_WAIT();
}
template <int ROWMODE>
__device__ __forceinline__ void tr_job(int item, const float* src, int K, int N, bf16_t* dst, size_t dst_bstride, int dst_ld, int dst_off, LAS float* scr, int lane) {
    const int nnb = N / 32, nkb = K / 64; const int nb = item % nnb; const int r = item / nnb; const int kb = r % nkb; const int bt = r / nkb;
    tr_item<ROWMODE>(src + (size_t)bt * K * N, N, dst + (size_t)bt * dst_bstride, dst_ld, dst_off, 64 * kb, 32 * nb, scr, lane);
}

constexpr int CONV_Q1 = 5, CONV_Q2 = 6;
constexpr int CONV_ITEMS_L = NE * 8 * 64 + NE * 8 * 32, CONV_CHUNKS_L = CONV_ITEMS_L / 8;
__device__ __forceinline__ void conv_expert_item(const Args& a, unsigned char* ws, int l, int r, LAS float* scr, int lane) {
    if (r < NE * 8 * 64) { const int nb = r % 64, r2 = r / 64, kb = r2 % 8, bt = l * NE + r2 / 8;
        tr_item_fp8<1>(a.in[I_WEIN] + (size_t)bt * 1024 * 2048, 2048, (unsigned char*)(ws + WS_WEIN) + (size_t)bt * 2048 * 1024, 128 * kb, 32 * nb, scr, lane); }
    else { r -= NE * 8 * 64; const int nb = r % 32, r2 = r / 32, kb = r2 % 8, bt = l * NE + r2 / 8;
        tr_item_fp8<0>(a.in[I_WEOUT] + (size_t)bt * 1024 * 1024, 1024, (unsigned char*)(ws + WS_WEOUT) + (size_t)bt * 1024 * 1024, 128 * kb, 32 * nb, scr, lane); }
}
__device__ __forceinline__ void conv_drain(const Args& a, int l, int budget, LAS unsigned char* lds, const int wv) {
    asm volatile("" : "+s"(lds));
    int tid_ = tid_of(wv); asm volatile("" : "+v"(tid_)); const int tid = tid_, lane = tid & 63;
    unsigned char* ws = opaque_ptr(a.ws); unsigned* head = (unsigned*)(ws + WS_CTL) + CW_CONVQ + 64 * l;
    LAS float* scr = (LAS float*)(lds + wv * 16896); LAS int* slot = (LAS int*)(lds + LDS_BYTES - 512);
    for (;;) {
        if (budget == 0) break;
        __syncthreads();
        if (tid == 0) *slot = (int)__hip_atomic_fetch_add(head, 1u, __ATOMIC_RELAXED, __HIP_MEMORY_SCOPE_AGENT);
        __syncthreads();
        const int c = __builtin_amdgcn_readfirstlane(*slot);
        if (c >= CONV_CHUNKS_L) break;
        conv_expert_item(a, ws, l, c * 8 + wv, scr, lane);
        if (budget > 0) --budget;
    }
    __syncthreads();
}
__device__ __forceinline__ void phase_prologue(const Args& a, LAS unsigned char* lds, const int wv) {
    asm volatile("" : "+s"(lds));
    int tid_ = tid_of(wv); asm volatile("" : "+v"(tid_)); const int tid = tid_, lane = tid & 63, wave = __builtin_amdgcn_readfirstlane(tid >> 6);
    const int G = gridDim.x;
    unsigned char* ws = opaque_ptr(a.ws); const int bid = opaque_bid();
    {
        LAS float* cact = (LAS float*)lds;
        LAS float* red = (LAS float*)(lds + 32768);
        for (int i = tid; i < NBATCH * D; i += NTHREADS) { const float v = a.in[I_C][i]; cact[i] = v * sigmoidf_(v); }
        __syncthreads();
        float* mod = (float*)(ws + WS_MOD);
        for (int u = bid; u < DEPTH * 96; u += G) {
            const int l = u / 96, cg = u % 96; const int n = cg * 64 + lane;
            const float* w = a.in[I_WADA] + (size_t)l * D * 6144 + n;
            float acc[8] = {0.f, 0.f, 0.f, 0.f, 0.f, 0.f, 0.f, 0.f};
            const int kb = wave * 128;
#pragma unroll 8
            for (int k = 0; k < 128; ++k) { const float wv = w[(size_t)(kb + k) * 6144];
#pragma unroll
                for (int b = 0; b < 8; ++b) acc[b] += cact[b * D + kb + k] * wv; }
#pragma unroll
            for (int b = 0; b < 8; ++b) red[(wave * 8 + b) * 64 + lane] = acc[b];
            __syncthreads();
            { const int b = tid >> 6; float s = 0.f;
#pragma unroll
              for (int w8 = 0; w8 < 8; ++w8) s += red[(w8 * 8 + b) * 64 + lane];
              mod[((size_t)l * NBATCH + b) * 6144 + n] = s + a.in[I_BADA][(size_t)l * 6144 + n]; }
            __syncthreads();
        }
    }
#if Z_I8
    {
        LAS float* tile = (LAS float*)lds; LAS float* red = (LAS float*)(lds + 1024 * 33 * 4);
        signed char* w8 = (signed char*)(ws + WS_WIN); float* wsc = (float*)(ws + WS_WINSC);
        __syncthreads();
        for (int u = bid; u < DEPTH * (NZ / 32); u += G) {
            const int l = u / (NZ / 32), n0 = (u % (NZ / 32)) * 32; const float* W = a.in[I_WIN] + (size_t)l * D * NZ + n0;
            const int n = tid & 31, kr = tid >> 5;
#pragma unroll 1
            for (int k0 = 0; k0 < 1024; k0 += 256) { float tv[16];
#pragma unroll
                for (int i = 0; i < 16; ++i) tv[i] = W[(size_t)(k0 + 16 * i + kr) * NZ + n];
#pragma unroll
                for (int i = 0; i < 16; ++i) tile[(k0 + 16 * i + kr) * 33 + n] = tv[i]; }
            __syncthreads();
            { float am = 0.f;
#pragma unroll 8
              for (int i = 0; i < 64; ++i) am = fmaxf(am, fabsf(tile[(kr * 64 + i) * 33 + n]));
              red[kr * 32 + n] = am; }
            __syncthreads();
            if (tid < 32) { float am = 1e-30f;
#pragma unroll
                for (int q = 0; q < 16; ++q) am = fmaxf(am, red[q * 32 + tid]);
                red[512 + tid] = 127.0f / am; wsc[(size_t)l * NZ + n0 + tid] = am * (1.0f / 127.0f); }
            __syncthreads();
            { const float inv = red[512 + n]; signed char* dst = w8 + ((size_t)l * NZ + n0 + n) * D + kr * 64;
#pragma unroll
              for (int c = 0; c < 4; ++c) { int w4[4];
#pragma unroll
                  for (int q = 0; q < 4; ++q) { int pk = 0;
#pragma unroll
                      for (int e = 0; e < 4; ++e) pk |= (((int)rintf(tile[(kr * 64 + c * 16 + q * 4 + e) * 33 + n] * inv)) & 0xff) << (8 * e);
                      w4[q] = pk; }
                  *(u32x4*)(dst + 16 * c) = (u32x4){(unsigned)w4[0], (unsigned)w4[1], (unsigned)w4[2], (unsigned)w4[3]}; } }
            __syncthreads();
        }
    }
#endif
    {
        LAS float* scr = (LAS float*)(lds + wave * 16896);
        const int gw = bid * NWAVES + wave, NGW = G * NWAVES;
        constexpr int I_EIN = NE * 8 * 64, I_EOUT = NE * 8 * 32, I_WINI = Z_I8 ? 0 : DEPTH * (Z_FP8 ? 8 : 16) * 144, I_UPA = DEPTH * 16 * 32, I_UPB = DEPTH * 8 * 32, I_OUT = DEPTH * 16 * 32,
                      I_RGA = DEPTH * 8 * 2 * 4, I_RGX = I_RGA, I_POOL = DEPTH * 4 * 2 * 4;
        constexpr int NITEMS = I_EIN + I_EOUT + I_WINI + I_UPA + I_UPB + I_OUT + I_RGA + I_RGX + I_POOL;
        for (int it = gw; it < NITEMS; it += NGW) {
            int r = it;
            if (r < I_EIN) { const int nb = r % 64, r2 = r / 64, kb = r2 % 8, bt = r2 / 8;
                tr_item_fp8<1>(a.in[I_WEIN] + (size_t)bt * 1024 * 2048, 2048, (unsigned char*)(ws + WS_WEIN) + (size_t)bt * 2048 * 1024, 128 * kb, 32 * nb, scr, lane); continue; } r -= I_EIN;
            if (r < I_EOUT) { const int nb = r % 32, r2 = r / 32, kb = r2 % 8, bt = r2 / 8;
                tr_item_fp8<0>(a.in[I_WEOUT] + (size_t)bt * 1024 * 1024, 1024, (unsigned char*)(ws + WS_WEOUT) + (size_t)bt * 1024 * 1024, 128 * kb, 32 * nb, scr, lane); continue; } r -= I_EOUT;
#if Z_I8
#elif Z_FP8
            if (r < I_WINI) { const int nb = r % 144, r2 = r / 144, kb = r2 % 8, bt = r2 / 8;
                tr_item_fp8<0>(a.in[I_WIN] + (size_t)bt * 1024 * NZ, NZ, (unsigned char*)(ws + WS_WIN) + (size_t)bt * NZ * 1024, 128 * kb, 32 * nb, scr, lane); continue; } r -= I_WINI;
#else
            if (r < I_WINI) { tr_job<0>(r, a.in[I_WIN], 1024, NZ, (bf16_t*)(ws + WS_WIN), (size_t)NZ * 1024, 1024, 0, scr, lane); continue; } r -= I_WINI;
#endif
            if (r < I_UPA) { tr_job<0>(r, a.in[I_WUPA], 1024, 1024, (bf16_t*)(ws + WS_WCAT), (size_t)1024 * KCAT, KCAT, 512, scr, lane); continue; } r -= I_UPA;
            if (r < I_UPB) { tr_job<0>(r, a.in[I_WUPB], 512, 1024, (bf16_t*)(ws + WS_WCAT), (size_t)1024 * KCAT, KCAT, 0, scr, lane); continue; } r -= I_UPB;
            if (r < I_OUT) { tr_job<0>(r, a.in[I_WOUT], 1024, 1024, (bf16_t*)(ws + WS_WOUT), (size_t)1024 * 1024, 1024, 0, scr, lane); continue; } r -= I_OUT;
            if (r < I_RGA) { tr_job<0>(r, a.in[I_WRGA], 128, 128, (bf16_t*)(ws + WS_WRG), (size_t)256 * 128, 128, 0, scr, lane); continue; } r -= I_RGA;
            if (r < I_RGX) { tr_job<0>(r, a.in[I_WRGX], 128, 128, (bf16_t*)(ws + WS_WRG) + 128 * 128, (size_t)256 * 128, 128, 0, scr, lane); continue; } r -= I_RGX;
            tr_job<0>(r, a.in[I_WPOOL], 128, 128, (bf16_t*)(ws + WS_WPOOL), (size_t)128 * 128, 128, 0, scr, lane);
        }
    }
}

struct MoeTab { LAS int* cnt; LAS int* padstart; LAS int* tilestart; LAS int* tab; };
__device__ __forceinline__ MoeTab moe_tab_ptrs(LAS unsigned char* lds) { MoeTab t; t.cnt = (LAS int*)(lds + LDS_TAB); t.padstart = t.cnt + 32; t.tilestart = t.padstart + 40; t.tab = t.tilestart + 40; return t; }
__device__ __forceinline__ void moe_tables(const Args& a, int l, LAS unsigned char* lds, const int wv) {
    asm volatile("" : "+s"(lds));
    const MoeTab mt = moe_tab_ptrs(lds); int tid_ = tid_of(wv); asm volatile("" : "+v"(tid_)); const int tid = tid_;
    unsigned* ctl = (unsigned*)(opaque_ptr(a.ws) + WS_CTL);
    __syncthreads();
    if (tid < NE) mt.cnt[tid] = (int)__hip_atomic_load(ctl + CW_CNT + (l * NE + tid) * 16, __ATOMIC_RELAXED, __HIP_MEMORY_SCOPE_AGENT);
    __syncthreads();
    if (tid == 0) { int ps = 0, ts = 0; for (int e = 0; e < NE; ++e) { mt.padstart[e] = ps; mt.tilestart[e] = ts; const int nt = (mt.cnt[e] + 255) >> 8; ps += nt * 256; ts += nt; } mt.padstart[NE] = ps; mt.tilestart[NE] = ts; }
    __syncthreads();
    const int nMt = mt.tilestart[NE];
    for (int m = tid; m < nMt; m += NTHREADS) { int e = 0; for (int q = 1; q < NE; ++q) e = (mt.tilestart[q] <= m) ? q : e; mt.tab[m] = (e << 16) | (m - mt.tilestart[e]); }
    __syncthreads();
}
#ifndef MOE_WGM1
#define MOE_WGM1 4
#endif
#ifndef MOE_WGM2
#define MOE_WGM2 8
#endif
struct MoeSched1 {
    static constexpr bool DYN_A = true;
    const char* H; const char* W; const int* tokof; MoeTab mt; int nMt, G, c;
    __device__ __forceinline__ bool next(int i, pg8::Unit& u) const { int pm, pn; if (!pg8::order_map<MOE_WGM1>(i, G, c, nMt, 8, pm, pn)) return false;
        const int en = __builtin_amdgcn_readfirstlane(mt.tab[pm]); u.pm = pm; u.pn = pn; u.e = en >> 16; u.j = en & 0xffff;
        u.row0 = __builtin_amdgcn_readfirstlane(mt.padstart[u.e]) + 256 * u.j; u.rows = __builtin_amdgcn_readfirstlane(mt.cnt[u.e]) - 256 * u.j; return true; }
    __device__ __forceinline__ const char* a_ptr() const { return H; }
    __device__ __forceinline__ const char* b_ptr() const { return W; }
    __device__ __forceinline__ unsigned a_off(const pg8::Unit&) const { return 0u; }
    __device__ __forceinline__ unsigned b_off(const pg8::Unit& u) const { return ((unsigned)u.e * 2048u + (unsigned)u.pn * 256u) * 1024u; }
    __device__ __forceinline__ void a_voff(const pg8::Unit& u, unsigned (&v)[2][2], int wv) const {
        int tid = tid_of(wv); asm volatile("" : "+v"(tid));
        const int* tl = tokof + (size_t)u.e * T + 256 * u.j; const int rmax = u.rows - 1;
#pragma unroll
        for (int i = 0; i < 2; ++i) { int R, C; pg8::stage_rc(tid * 16 + i * 8192, R, C);
#pragma unroll
            for (int h = 0; h < 2; ++h) { int idx = h * 128 + R; idx = idx < rmax ? idx : rmax; v[h][i] = (unsigned)tl[idx] * 1024u + (unsigned)C * 2u; } }
    }
    __device__ __forceinline__ void a_dma(const pg8::Unit& u, LAS unsigned char* slots, int wv) const {
        const int tid = tid_of(wv); const int rmax = u.rows - 1;
        const __amdgpu_buffer_rsrc_t rs = __builtin_amdgcn_make_buffer_rsrc((void*)tokof, 0, 0xffffffff, 0x00020000);
        const unsigned so = (unsigned)(u.e * T + 256 * u.j) * 4u;
#pragma unroll
        for (int i = 0; i < 2; ++i) { int R, C; pg8::stage_rc(tid * 16 + i * 8192, R, C);
#pragma unroll
            for (int h = 0; h < 2; ++h) { int idx = h * 128 + R; idx = idx < rmax ? idx : rmax;
                __builtin_amdgcn_raw_ptr_buffer_load_lds(rs, (LAS void*)(slots + (h * 2 + i) * 2048 + wv * 256), 4, (unsigned)idx * 4u, so, 0, 0); } }
    }
    __device__ __forceinline__ void a_fetch(const LAS unsigned char* slots, int wv, unsigned (&q)[4]) const {
        const int tid = tid_of(wv); int R, C; pg8::stage_rc(tid * 16, R, C);
#pragma unroll
        for (int k = 0; k < 4; ++k) q[k] = *(const LAS unsigned*)(slots + k * 2048 + tid * 4) * 1024u + (unsigned)C * 2u;
    }
};
struct MoeSched2 {
    static constexpr bool DYN_A = false;
    const char* ACT; const char* W; MoeTab mt; int nMt, G, c;
    __device__ __forceinline__ bool next(int i, pg8::Unit& u) const { int pm, pn; if (!pg8::order_map<MOE_WGM2>(i, G, c, nMt, 4, pm, pn)) return false;
        const int en = __builtin_amdgcn_readfirstlane(mt.tab[pm]); u.pm = pm; u.pn = pn; u.e = en >> 16; u.j = en & 0xffff;
        u.row0 = __builtin_amdgcn_readfirstlane(mt.padstart[u.e]) + 256 * u.j; u.rows = __builtin_amdgcn_readfirstlane(mt.cnt[u.e]) - 256 * u.j; return true; }
    __device__ __forceinline__ const char* a_ptr() const { return ACT; }
    __device__ __forceinline__ const char* b_ptr() const { return W; }
    __device__ __forceinline__ unsigned a_off(const pg8::Unit& u) const { return (unsigned)u.row0 * 1024u; }
    __device__ __forceinline__ unsigned b_off(const pg8::Unit& u) const { return ((unsigned)u.e * 1024u + (unsigned)u.pn * 256u) * 1024u; }
    __device__ __forceinline__ void a_voff(const pg8::Unit&, unsigned (&v)[2][2], int wv) const {
        int tid = tid_of(wv); asm volatile("" : "+v"(tid));
#pragma unroll
        for (int i = 0; i < 2; ++i) { int R, C; pg8::stage_rc(tid * 16 + i * 8192, R, C);
#pragma unroll
            for (int h = 0; h < 2; ++h) v[h][i] = (unsigned)((h * 128 + R) * 512 + C) * 2u; }
    }
};

__device__ __forceinline__ void phase_a(const Args& a, int l, LAS unsigned char* lds, bool dry, const int wv) {
    asm volatile("" : "+s"(lds));
    int tid_ = tid_of(wv); asm volatile("" : "+v"(tid_)); const int tid = tid_, lane = tid & 63, wave = __builtin_amdgcn_readfirstlane(tid >> 6);
    const int G = gridDim.x; unsigned char* ws = opaque_ptr(a.ws); const int bid = opaque_bid();
    const float* mod = (const float*)(ws + WS_MOD);
    bf16_t* xres = (bf16_t*)(ws + WS_XRES); bf16_t* xout = dry ? (bf16_t*)(ws + WS_Z) : xres;
    if (l < DEPTH) {
        LAS float* red = (LAS float*)lds;
        for (int wu = bid; wu < NBATCH * NE; wu += G) { const int b2 = wu >> 5, e = wu & 31;
            const float* sh2 = mod + ((size_t)l * NBATCH + b2) * 6144 + 3 * D; const float* wr = a.in[I_WROUTER] + (size_t)l * D * NE;
            float sm = sh2[tid] * wr[tid * NE + e] + sh2[tid + 512] * wr[(tid + 512) * NE + e];
            sm = wave_sum(sm, lane);
            __syncthreads();
            if (lane == 0) red[wave] = sm;
            __syncthreads();
            if (tid == 0) { float t = a.in[I_BROUTER][l * NE + e]; for (int q = 0; q < 8; ++q) t += red[q]; ((float*)(ws + WS_CB))[(l * NBATCH + b2) * NE + e] = t; }
        }
        __syncthreads();
    }
    if (l < DEPTH) {
        for (int wu = bid; wu < NBATCH * 32; wu += G) { const int b2 = wu >> 5, part = wu & 31;
            const float* n2 = a.in[I_N2G] + (size_t)l * D; const float* sc2 = mod + ((size_t)l * NBATCH + b2) * 6144 + 4 * D; const float* wr2 = a.in[I_WROUTER] + (size_t)l * D * NE;
            bf16_t* wrb = (bf16_t*)(ws + WS_WRB) + (size_t)b2 * 2 * NE * D;
#pragma unroll
            for (int r = 0; r < 2; ++r) { const int idx = part * 1024 + r * NTHREADS + tid; const int ee = idx & 31, k = idx >> 5;
                const float w = wr2[idx] * (n2[k] * (1.0f + sc2[k])); const unsigned hi = cvt_pk_bf16(w, 0.f) & 0xffffu; const unsigned lo = cvt_pk_bf16(w - bflo(hi), 0.f) & 0xffffu;
                wrb[(size_t)ee * D + k] = (bf16_t)hi; wrb[(size_t)(NE + ee) * D + k] = (bf16_t)lo; } }
    }
    if (l > 0) moe_tables(a, (l - 1) + DEPTH * (REPN(7) - 1), lds, wv);
    const MoeTab mt = moe_tab_ptrs(lds);
    const int* slotinfo = (const int*)(ws + WS_SLOTINFO); const float* wgt = (const float*)(ws + WS_WGT);
    const unsigned char* outb = (const unsigned char*)(ws + WS_OUTB); const float* outsc = (const float*)(ws + WS_OUTSC);
    unsigned char* hb = (unsigned char*)(ws + WS_H);
    for (int chunk = bid; chunk < T / 128; chunk += G) {
        const int rowb = chunk * 128 + wave * 16; const int b = rowb / SEQ;
        const float* xin = a.in[I_X] + (size_t)rowb * D; const bf16_t* xinb = xres + (size_t)rowb * D;
        f32x4 xv[2][4]; int4 si[4]; f32x4 wv[4]; unsigned gv[2][4][4];
#define PA_SX(r, q) do { if ((r) < 16) { _Pragma("unroll") for (int j = 0; j < 4; ++j) { if (l == 0) xv[(q) & 1][j] = *(const f32x4*)(xin + (size_t)(r) * D + 4 * lane + 256 * j); \
            else { const f32x2 t_ = *(const f32x2*)(xinb + (size_t)(r) * D + 4 * lane + 256 * j); xv[(q) & 1][j].x = t_.x; xv[(q) & 1][j].y = t_.y; } } } } while (0)
#define PA_S0(r, q) do { if ((r) < 16 && l > 0) { si[(q) & 3] = *(const int4*)(slotinfo + (size_t)(rowb + (r)) * 4); wv[(q) & 3] = *(const f32x4*)(wgt + (size_t)(rowb + (r)) * 4); } } while (0)
#define PA_S1(r, q) do { if ((r) < 16 && l > 0) { const int sl_[4] = {si[(q) & 3].x, si[(q) & 3].y, si[(q) & 3].z, si[(q) & 3].w}; \
            _Pragma("unroll") for (int kk = 0; kk < 4; ++kk) { const int e_ = sl_[kk] >> 24, li_ = sl_[kk] & 0xffffff; const size_t slot_ = (size_t)(mt.padstart[e_] + li_); const unsigned char* orow = outb + slot_ * D + 4 * lane; \
                _Pragma("unroll") for (int j = 0; j < 4; ++j) gv[(q) & 1][kk][j] = *(const unsigned*)(orow + 256 * j); } } } while (0)
        f32x4 gmv[4], shv[4], g2v[4];
#pragma unroll
        for (int j = 0; j < 4; ++j) {
            if (l < DEPTH) { const float* ng_ = a.in[I_N1G] + (size_t)l * D + 4 * lane + 256 * j; const float* mb_ = mod + ((size_t)l * NBATCH + b) * 6144 + 4 * lane + 256 * j;
                gmv[j] = *(const f32x4*)ng_ * (1.0f + *(const f32x4*)(mb_ + D)); shv[j] = *(const f32x4*)mb_; }
            else { gmv[j] = *(const f32x4*)(a.in[I_FINALG] + 4 * lane + 256 * j); shv[j] = (f32x4){0.f, 0.f, 0.f, 0.f}; }
            g2v[j] = (l > 0) ? *(const f32x4*)(mod + ((size_t)(l - 1) * NBATCH + b) * 6144 + 5 * D + 4 * lane + 256 * j) : (f32x4){0.f, 0.f, 0.f, 0.f}; }
        PA_S0(0, 0); PA_S0(1, 1); PA_SX(0, 0); PA_S1(0, 0);
#pragma unroll 1
        for (int i0 = 0; i0 < 16; i0 += 4) {
#pragma unroll
          for (int ii = 0; ii < 4; ++ii) {
            const int i = i0 + ii; const int row = rowb + i;
            PA_S0(i + 2, ii + 2); PA_SX(i + 1, ii + 1); PA_S1(i + 1, ii + 1);
            f32x4 v[4];
#pragma unroll
            for (int j = 0; j < 4; ++j) { v[j] = xv[ii & 1][j];
                if (l > 0) { const unsigned p0 = __float_as_uint(v[j].x), p1 = __float_as_uint(v[j].y); v[j] = (f32x4){bflo(p0), bfhi(p0), bflo(p1), bfhi(p1)}; } }
            if (l > 0) {
                f32x4 y[4];
#pragma unroll
                for (int j = 0; j < 4; ++j) y[j] = (f32x4){0.f, 0.f, 0.f, 0.f};
#pragma unroll
                for (int kk = 0; kk < 4; ++kk) { const float wk = wv[ii][kk] * (1.0f / OUT_FP8_SCALE);
#pragma unroll
                    for (int j = 0; j < 4; ++j) { const int p = (int)gv[ii & 1][kk][j];
                        const auto lo = __builtin_amdgcn_cvt_pk_f32_fp8(p, false), hi = __builtin_amdgcn_cvt_pk_f32_fp8(p, true);
                        y[j] += wk * (f32x4){lo[0], lo[1], hi[0], hi[1]}; } }
#pragma unroll
                for (int j = 0; j < 4; ++j) v[j] += g2v[j] * y[j];
            }
            if (l < DEPTH) {
#pragma unroll
                for (int j = 0; j < 4; ++j) { u32x2 p; p.x = cvt_pk_bf16(v[j].x, v[j].y); p.y = cvt_pk_bf16(v[j].z, v[j].w); *(u32x2*)(xout + (size_t)row * D + 4 * lane + 256 * j) = p; }
            }
            float ss = 0.f;
#pragma unroll
            for (int j = 0; j < 4; ++j) ss += (v[j].x * v[j].x + v[j].y * v[j].y) + (v[j].z * v[j].z + v[j].w * v[j].w);
            const float rinv = __builtin_amdgcn_rsqf(wave_sum(ss, lane) * (1.0f / D) + NORM_EPS);
            if (l < DEPTH) {
                f32x4 hq[4]; (void)hq;
#pragma unroll
                for (int j = 0; j < 4; ++j) {
                    const f32x4 h = (v[j] * rinv) * gmv[j] + shv[j];
#if Z_I8
                    hq[j] = h; }
                {   float am = 0.f;
#pragma unroll
                    for (int j = 0; j < 4; ++j) am = fmaxf(fmaxf(fmaxf(fabsf(hq[j].x), fabsf(hq[j].y)), fmaxf(fabsf(hq[j].z), fabsf(hq[j].w))), am);
                    am = wave_max(am);
                    am = fmaxf(am, 1e-20f); const float inv = 127.0f / am;
                    if (lane == 0) ((float*)(ws + WS_HSC))[row] = am * (1.0f / 127.0f);
#pragma unroll
                    for (int j = 0; j < 4; ++j) { const int q0 = (int)rintf(hq[j].x * inv), q1 = (int)rintf(hq[j].y * inv), q2 = (int)rintf(hq[j].z * inv), q3 = (int)rintf(hq[j].w * inv);
                        *(int*)(hb + (size_t)row * D + 4 * lane + 256 * j) = (q0 & 0xff) | ((q1 & 0xff) << 8) | ((q2 & 0xff) << 16) | ((q3 & 0xff) << 24); }
                }
#elif Z_FP8
                    int p = 0; p = __builtin_amdgcn_cvt_pk_fp8_f32(h.x, h.y, p, false); p = __builtin_amdgcn_cvt_pk_fp8_f32(h.z, h.w, p, true);
                    *(int*)(hb + (size_t)row * D + 4 * lane + 256 * j) = p; }
#else
                    u32x2 p; p.x = cvt_pk_bf16(h.x, h.y); p.y = cvt_pk_bf16(h.z, h.w); *(u32x2*)((bf16_t*)hb + (size_t)row * D + 4 * lane + 256 * j) = p; }
#endif
            } else {
#pragma unroll
                for (int j = 0; j < 4; ++j) *(f32x4*)(a.out + (size_t)row * D + 4 * lane + 256 * j) = v[j] * rinv * gmv[j];
            }
          }
        }
#undef PA_S0
#undef PA_SX
#undef PA_S1
    }
}

__device__ __forceinline__ void phase_h(const Args& a, int l, int cset, LAS unsigned char* lds, const int wv) {
    asm volatile("" : "+s"(lds));
    int tid_ = tid_of(wv); asm volatile("" : "+v"(tid_)); const int tid = tid_, lane = tid & 63, wave = __builtin_amdgcn_readfirstlane(tid >> 6);
    const int G = gridDim.x; unsigned char* ws = opaque_ptr(a.ws); const int bid = opaque_bid();
    const float* mod = (const float*)(ws + WS_MOD); const bf16_t* xres = (const bf16_t*)(ws + WS_XRES);
    unsigned char* h8 = (unsigned char*)(ws + WS_H);
    LAS float* rinvs = (LAS float*)lds;
    LAS float* lgt = (LAS float*)(lds + 1024);
    LAS int* hist = (LAS int*)(lds + 1024 + 8 * 16 * 33 * 4);
    LAS int* base = hist + 32;
    unsigned* ctl = (unsigned*)(ws + WS_CTL);
    const float* ng = a.in[I_N2G] + (size_t)l * D;
    const float* cbv = (const float*)(ws + WS_CB);
    int* tokof = (int*)(ws + WS_TOKOF); int* slotinfo = (int*)(ws + WS_SLOTINFO); float* wgt = (float*)(ws + WS_WGT);
    for (int chunk = bid; chunk < T / 128; chunk += G) {
        const int row0 = chunk * 128 + wave * 16; const int b = row0 / SEQ;
        const float* mb = mod + ((size_t)l * NBATCH + b) * 6144 + 3 * D;
        if (tid < 32) hist[tid] = 0;
        f32x4 gm2[4], sh2[4];
#pragma unroll
        for (int j = 0; j < 4; ++j) { gm2[j] = *(const f32x4*)(ng + 4 * lane + 256 * j) * (1.0f + *(const f32x4*)(mb + D + 4 * lane + 256 * j)); sh2[j] = *(const f32x4*)(mb + 4 * lane + 256 * j); }
        u32x2 xq[3][4];
#pragma unroll
        for (int r = 0; r < 2; ++r)
#pragma unroll
            for (int j = 0; j < 4; ++j) xq[r][j] = *(const u32x2*)(xres + (size_t)(row0 + r) * D + 4 * lane + 256 * j);
#pragma unroll
        for (int i = 0; i < 16; ++i) {
            const int row = row0 + i;
            if (i + 2 < 16) {
#pragma unroll
                for (int j = 0; j < 4; ++j) xq[(i + 2) % 3][j] = *(const u32x2*)(xres + (size_t)(row + 2) * D + 4 * lane + 256 * j); }
            f32x4 v[4]; float ss = 0.f;
#pragma unroll
            for (int j = 0; j < 4; ++j) { const u32x2 p = xq[i % 3][j]; v[j] = (f32x4){bflo(p.x), bfhi(p.x), bflo(p.y), bfhi(p.y)}; ss += (v[j].x * v[j].x + v[j].y * v[j].y) + (v[j].z * v[j].z + v[j].w * v[j].w); }
            const float rinv = __builtin_amdgcn_rsqf(wave_sum(ss, lane) * (1.0f / D) + NORM_EPS);
            if (lane == 0) rinvs[wave * 16 + i] = rinv;
#pragma unroll
            for (int j = 0; j < 4; ++j) {
                const f32x4 h = (v[j] * rinv) * gm2[j] + sh2[j];
                int p = 0; p = __builtin_amdgcn_cvt_pk_fp8_f32(h.x, h.y, p, false); p = __builtin_amdgcn_cvt_pk_fp8_f32(h.z, h.w, p, true);
                *(int*)(h8 + (size_t)row * D + 4 * lane + 256 * j) = p; }
        }
        {
            const int ri = lane & 15, q = lane >> 4;
            const bf16_t* xr = xres + (size_t)(row0 + ri) * D + 8 * q;
            const bf16_t* wh = (const bf16_t*)(ws + WS_WRB) + ((size_t)(b * 2 + 0) * NE + ri) * D + 8 * q; const bf16_t* wl = wh + (size_t)NE * D;
            f32x4 acc0 = {0.f, 0.f, 0.f, 0.f}, acc1 = {0.f, 0.f, 0.f, 0.f};
#pragma unroll 8
            for (int kb = 0; kb < 32; ++kb) {
                const bf16x8 ax = *(const bf16x8*)(xr + 32 * kb);
                const bf16x8 bh0 = *(const bf16x8*)(wh + 32 * kb), bl0 = *(const bf16x8*)(wl + 32 * kb), bh1 = *(const bf16x8*)(wh + 16 * D + 32 * kb), bl1 = *(const bf16x8*)(wl + 16 * D + 32 * kb);
                acc0 = __builtin_amdgcn_mfma_f32_16x16x32_bf16(ax, bh0, acc0, 0, 0, 0); acc0 = __builtin_amdgcn_mfma_f32_16x16x32_bf16(ax, bl0, acc0, 0, 0, 0);
                acc1 = __builtin_amdgcn_mfma_f32_16x16x32_bf16(ax, bh1, acc1, 0, 0, 0); acc1 = __builtin_amdgcn_mfma_f32_16x16x32_bf16(ax, bl1, acc1, 0, 0, 0);
            }
            LDS_WAIT();
            const float c0 = cbv[(l * NBATCH + b) * NE + ri], c1 = cbv[(l * NBATCH + b) * NE + 16 + ri];
#pragma unroll
            for (int r = 0; r < 4; ++r) { const int ti = 4 * q + r; const float rv = rinvs[wave * 16 + ti];
                lgt[(wave * 16 + ti) * 33 + ri] = acc0[r] * rv + c0; lgt[(wave * 16 + ti) * 33 + 16 + ri] = acc1[r] * rv + c1; }
        }
        __syncthreads();
        int se[4] = {0, 0, 0, 0}; float sw[4] = {0.f, 0.f, 0.f, 0.f}; int rk[4] = {0, 0, 0, 0};
        if (lane < 16) {
            float v[32];
#pragma unroll
            for (int e = 0; e < 32; ++e) v[e] = lgt[(wave * 16 + lane) * 33 + e];
            float sv[4];
#pragma unroll
            for (int kk = 0; kk < 4; ++kk) { float best = v[0]; int bi = 0;
#pragma unroll
                for (int e = 1; e < 32; ++e) { if (v[e] > best) { best = v[e]; bi = e; } }
                sv[kk] = best; se[kk] = bi;
#pragma unroll
                for (int e = 0; e < 32; ++e) v[e] = (e == bi) ? -3.0e38f : v[e]; }
            float den = 0.f;
#pragma unroll
            for (int kk = 0; kk < 4; ++kk) { sw[kk] = __expf(sv[kk] - sv[0]); den += sw[kk]; }
            const float inv = 1.0f / den;
#pragma unroll
            for (int kk = 0; kk < 4; ++kk) { sw[kk] *= inv; rk[kk] = __hip_atomic_fetch_add(hist + se[kk], 1, __ATOMIC_RELAXED, __HIP_MEMORY_SCOPE_WORKGROUP); }
        }
        __syncthreads();
        if (tid < 32) base[tid] = (int)__hip_atomic_fetch_add(ctl + CW_CNT + (cset * NE + tid) * 16, (unsigned)hist[tid], __ATOMIC_RELAXED, __HIP_MEMORY_SCOPE_AGENT);
        __syncthreads();
        if (lane < 16) {
            const int row = row0 + lane; int si[4];
#pragma unroll
            for (int kk = 0; kk < 4; ++kk) { const int li = base[se[kk]] + rk[kk]; tokof[(size_t)se[kk] * T + li] = row; si[kk] = (se[kk] << 24) | li; }
            *(int4*)(slotinfo + (size_t)row * 4) = make_int4(si[0], si[1], si[2], si[3]);
            *(f32x4*)(wgt + (size_t)row * 4) = (f32x4){sw[0], sw[1], sw[2], sw[3]};
        }
        __syncthreads();
    }
}

constexpr int ZT_STRIDE = 528;
template <int NR>
__device__ __forceinline__ void stage_z8(const unsigned char* z8, const float* zs, int b, int p_first, int tile, LAS unsigned char* zt, int tid) {
    constexpr int NP = NR * 16, NK = (NP + NTHREADS - 1) / NTHREADS;
    u32x4 q[NK]; float sc[NK];
    const __amdgpu_buffer_rsrc_t rz = __builtin_amdgcn_make_buffer_rsrc((void*)z8, 0, 0xffffffff, 0x00020000), rq = __builtin_amdgcn_make_buffer_rsrc((void*)zs, 0, 0xffffffff, 0x00020000);
#pragma unroll
    for (int k = 0; k < NK; ++k) { int idx = tid + NTHREADS * k; idx = idx < NP ? idx : NP - 1; const int r = idx >> 4, pc = idx & 15; const int p = p_first + r; const unsigned row = (unsigned)(b * SEQ + (p < 0 ? 0 : p));
        q[k] = __builtin_bit_cast(u32x4, __builtin_amdgcn_raw_buffer_load_b128(rz, (int)(row * 2560u + (unsigned)(tile * 256 + pc * 16)), 0, 0));
#if Z_OUT_FP8
        (void)rq; sc[k] = p < 0 ? 0.f : (1.0f / Z_FP8_SCALE); }
#else
        const float t = __builtin_bit_cast(float, __builtin_amdgcn_raw_buffer_load_b32(rq, (int)((row * 40u + (unsigned)(tile * 4 + (pc >> 2))) * 4u), 0, 0)); sc[k] = p < 0 ? 0.f : t; }
#endif
#pragma unroll
    for (int k = 0; k < NK; ++k) { int idx = tid + NTHREADS * k; idx = idx < NP ? idx : NP - 1; const int r = idx >> 4, pc = idx & 15; float m128 = -128.0f; asm volatile("" : "+v"(m128));
        const float sk = sc[k], of = m128 * sk;
        const unsigned w[4] = {q[k].x, q[k].y, q[k].z, q[k].w}; unsigned o[8];
#pragma unroll
#if Z_OUT_FP8
        for (int d = 0; d < 4; ++d) { (void)of; const auto lo = __builtin_amdgcn_cvt_pk_f32_fp8((int)w[d], false), hi = __builtin_amdgcn_cvt_pk_f32_fp8((int)w[d], true);
            o[2 * d] = cvt_pk_bf16(lo[0] * sk, lo[1] * sk); o[2 * d + 1] = cvt_pk_bf16(hi[0] * sk, hi[1] * sk); }
#else
        for (int d = 0; d < 4; ++d) { o[2 * d] = cvt_pk_bf16((float)(w[d] & 0xffu) * sk + of, (float)((w[d] >> 8) & 0xffu) * sk + of); o[2 * d + 1] = cvt_pk_bf16((float)((w[d] >> 16) & 0xffu) * sk + of, (float)(w[d] >> 24) * sk + of); }
#endif
        *(LAS u32x4*)(zt + r * ZT_STRIDE + pc * 32) = (u32x4){o[0], o[1], o[2], o[3]}; *(LAS u32x4*)(zt + r * ZT_STRIDE + pc * 32 + 16) = (u32x4){o[4], o[5], o[6], o[7]};
        asm volatile("" ::: "memory"); }
}
__device__ __forceinline__ void lru_unit(const Args& a, int l, int u, LAS unsigned char* lds, const int wv) {
    asm volatile("" : "+s"(lds));
    int tid_ = tid_of(wv); asm volatile("" : "+v"(tid_)); const int tid = tid_, lane = tid & 63, wave = __builtin_amdgcn_readfirstlane(tid >> 6);
    unsigned char* ws = opaque_ptr(a.ws);
    const unsigned char* z8 = (const unsigned char*)(ws + WS_Z); const float* zs = (const float*)(ws + WS_ZS);
    LAS unsigned char* zt = lds; LAS unsigned char* xc = lds + 131 * ZT_STRIDE;
    const int hp = u & 3, b = (u >> 2) & 7, s = u >> 5;
    const int t0 = b * SEQ + s * 128, p0 = s * 128;
    stage_z8<131>(z8, zs, b, p0 - 3, hp, zt, tid);
    __syncthreads();
    {
        const int o = tid & 31, rb = tid >> 5; const int ch0 = hp * 256 + o * 8;
        float cw[4][8], cbias[8];
#pragma unroll
        for (int k = 0; k < 4; ++k) { const f32x4 w0 = *(const f32x4*)(a.in[I_CONVW] + ((size_t)l * 4 + k) * D + ch0), w1 = *(const f32x4*)(a.in[I_CONVW] + ((size_t)l * 4 + k) * D + ch0 + 4);
            cw[k][0] = w0.x; cw[k][1] = w0.y; cw[k][2] = w0.z; cw[k][3] = w0.w; cw[k][4] = w1.x; cw[k][5] = w1.y; cw[k][6] = w1.z; cw[k][7] = w1.w; }
        { const f32x4 b0 = *(const f32x4*)(a.in[I_CONVB] + (size_t)l * D + ch0), b1 = *(const f32x4*)(a.in[I_CONVB] + (size_t)l * D + ch0 + 4);
          cbias[0] = b0.x; cbias[1] = b0.y; cbias[2] = b0.z; cbias[3] = b0.w; cbias[4] = b1.x; cbias[5] = b1.y; cbias[6] = b1.z; cbias[7] = b1.w; }
#pragma unroll 2
        for (int i = 0; i < 8; ++i) { const int r = rb + 16 * i; float acc[8];
#pragma unroll
            for (int j = 0; j < 8; ++j) acc[j] = cbias[j];
#pragma unroll
            for (int k = 0; k < 4; ++k) { const u32x4 v = *(const LAS u32x4*)(zt + (r + k) * ZT_STRIDE + o * 16);
                acc[0] += cw[k][0] * bflo(v.x); acc[1] += cw[k][1] * bfhi(v.x); acc[2] += cw[k][2] * bflo(v.y); acc[3] += cw[k][3] * bfhi(v.y);
                acc[4] += cw[k][4] * bflo(v.z); acc[5] += cw[k][5] * bfhi(v.z); acc[6] += cw[k][6] * bflo(v.w); acc[7] += cw[k][7] * bfhi(v.w); }
            u32x4 w; w.x = cvt_pk_bf16(acc[0], acc[1]); w.y = cvt_pk_bf16(acc[2], acc[3]); w.z = cvt_pk_bf16(acc[4], acc[5]); w.w = cvt_pk_bf16(acc[6], acc[7]);
            *(LAS u32x4*)(xc + r * ZT_STRIDE + o * 16) = w; }
    }
    __syncthreads();
    {
        const __amdgpu_buffer_rsrc_t rz = __builtin_amdgcn_make_buffer_rsrc((void*)(z8 + (size_t)t0 * 2560 + (4 + hp) * 256), 0, 0xffffffff, 0x00020000);
        const unsigned vo = (unsigned)(lane >> 4) * 2560u + (unsigned)(lane & 15) * 16u;
#pragma unroll
        for (int k = 0; k < 4; ++k) __builtin_amdgcn_raw_ptr_buffer_load_lds(rz, (LAS void*)(zt + (wave * 4 + k) * 1024), 16, vo, (unsigned)((wave * 4 + k) * 4 * 2560), 0, 0);
#if !Z_OUT_FP8
        const __amdgpu_buffer_rsrc_t rq = __builtin_amdgcn_make_buffer_rsrc((void*)(zs + (size_t)t0 * 40 + (4 + hp) * 4), 0, 0xffffffff, 0x00020000);
        __builtin_amdgcn_raw_ptr_buffer_load_lds(rq, (LAS void*)(zt + 32768 + wave * 256), 4, (unsigned)(tid >> 2) * 160u + (unsigned)(tid & 3) * 4u, 0, 0, 0);
#endif
    }
    {
        const int hsel = wave >> 2, wc = wave & 3, head = 2 * hp + hsel, c31 = lane & 31, hh = lane >> 5;
        const int ch = head * 128 + 32 * wc + c31;
        const bf16_t* wb = (const bf16_t*)(ws + WS_WRG) + ((size_t)(l * 8 + head) * 256 + 32 * wc + c31) * 128 + 8 * hh;
        bf16x8 Ba[8], Bi[8];
#pragma unroll
        for (int ks = 0; ks < 8; ++ks) { Ba[ks] = *(const bf16x8*)(wb + 16 * ks); Bi[ks] = *(const bf16x8*)(wb + 128 * 128 + 16 * ks); }
        const float ba = a.in[I_BRGA][(size_t)l * D + ch], bx = a.in[I_BRGX][(size_t)l * D + ch];
        const float lam = a.in[I_LAM][(size_t)l * D + ch];
        const float sp8 = 8.0f * log1pf(__expf(-lam));
        typedef __attribute__((address_space(1))) unsigned long long gu64;
        gu64* aggq = (gu64*)(ws + WS_AGG) + ((size_t)l * NBATCH * 32 + (size_t)b * 32) * D + ch;
        float Pr = 1.f, Hr = 0.f;
        unsigned hpk[64];
#pragma unroll
        for (int rb = 0; rb < 4; ++rb) {
            f32x16 aa, ai;
#pragma unroll
            for (int r = 0; r < 16; ++r) { aa[r] = 0.f; ai[r] = 0.f; }
            const LAS unsigned char* ap = xc + (32 * rb + c31) * ZT_STRIDE + (hsel * 128 + 8 * hh) * 2;
#pragma unroll
            for (int ks = 0; ks < 8; ++ks) { const bf16x8 A = *(const LAS bf16x8*)(ap + 32 * ks);
                aa = __builtin_amdgcn_mfma_f32_32x32x16_bf16(A, Ba[ks], aa, 0, 0, 0); ai = __builtin_amdgcn_mfma_f32_32x32x16_bf16(A, Bi[ks], ai, 0, 0, 0); }
            const LAS unsigned char* xp = xc + (32 * rb + 4 * hh) * ZT_STRIDE + (hsel * 128 + 32 * wc + c31) * 2;
#pragma unroll
            for (int q = 0; q < 4; ++q) {
                float p = 1.f, h = 0.f, hl[4], pl[4];
#pragma unroll
                for (int r3 = 0; r3 < 4; ++r3) { const int reg = 4 * q + r3;
                    const float xcv = bf1(*(const LAS bf16_t*)(xp + (8 * q + r3) * ZT_STRIDE));
                    const float rg = sigmoidf_(aa[reg] + ba), ig = sigmoidf_(ai[reg] + bx);
                    const float av = __expf(-sp8 * rg); const float mult = __builtin_amdgcn_sqrtf(fmaxf(1.0f - av * av, 0.f));
                    h = av * h + mult * (ig * xcv); p *= av; hl[r3] = h; pl[r3] = p; }
                const float Ao = shflx(p, 32, lane), Bo = shflx(h, 32, lane);
                const float A0 = hh ? Ao : p, B0 = hh ? Bo : h, A1 = hh ? p : Ao, B1 = hh ? h : Bo;
                const float P1 = Pr * A0, H1 = Hr * A0 + B0;
                const float Pst = hh ? P1 : Pr, Hst = hh ? H1 : Hr;
                Pr = P1 * A1; Hr = H1 * A1 + B1;
#pragma unroll
                for (int r3 = 0; r3 < 4; ++r3) hpk[rb * 16 + 4 * q + r3] = cvt_pk_bf16(Hst * pl[r3] + hl[r3], Pst * pl[r3]);
            }
        }
        if (hh == 0) __hip_atomic_store(aggq + (size_t)s * D, ((unsigned long long)__float_as_uint(Hr) << 32) | (unsigned long long)__float_as_uint(fmaxf(Pr, 1e-37f)), __ATOMIC_RELAXED, __HIP_MEMORY_SCOPE_AGENT);
        float cin = 0.f;
        for (int j0 = 0; j0 < s; j0 += 8) {
            unsigned long long w[8]; unsigned spins = 0;
            for (;;) { bool ok = true;
#pragma unroll
                for (int k = 0; k < 8; ++k) { const int j = (j0 + k < s) ? (j0 + k) : (s - 1); w[k] = __hip_atomic_load(aggq + (size_t)j * D, __ATOMIC_RELAXED, __HIP_MEMORY_SCOPE_AGENT); ok = ok && ((unsigned)w[k] != 0u); }
                if (__all(ok)) break;
                __builtin_amdgcn_s_sleep(4);
                if (++spins > (1u << 17)) break;
            }
#pragma unroll
            for (int k = 0; k < 8; ++k) { if (j0 + k < s) cin = __uint_as_float((unsigned)w[k]) * cin + __uint_as_float((unsigned)(w[k] >> 32)); }
        }
        asm volatile("s_waitcnt vmcnt(0)" ::: "memory");
        __syncthreads();
        const LAS unsigned char* gp = zt + (4 * hh) * 256 + (hsel * 128 + 32 * wc + c31);
        const LAS float* gsp = (const LAS float*)(zt + 32768) + (4 * hh) * 4 + hsel * 2 + (wc >> 1);
        LAS unsigned char* yp = xc + (4 * hh) * 512 + (hsel * 128 + 32 * wc + c31) * 2;
#pragma unroll
        for (int rb = 0; rb < 4; ++rb) {
#pragma unroll
            for (int reg = 0; reg < 16; ++reg) { const int tok = 32 * rb + 8 * (reg >> 2) + (reg & 3);
                const unsigned pk = hpk[rb * 16 + reg];
                const float hf = bflo(pk) + bfhi(pk) * cin;
#if Z_OUT_FP8
                (void)gsp; const float g = __builtin_amdgcn_cvt_f32_fp8((int)gp[tok * 256], 0) * (1.0f / Z_FP8_SCALE);
#else
                const float g = ((float)gp[tok * 256] - 128.0f) * gsp[tok * 4];
#endif
                const float ge = g * __builtin_amdgcn_rcpf(1.0f + __expf(-1.5957691216f * (g + 0.044715f * g * g * g)));
                *(LAS bf16_t*)(yp + tok * 512) = (bf16_t)(cvt_pk_bf16(hf * ge, 0.f) & 0xffffu); }
        }
    }
    __syncthreads();
    {
        bf16_t* yo = (bf16_t*)(ws + WS_ACAT) + (size_t)t0 * KCAT + 512 + hp * 256;
        u32x4 yv[8];
#pragma unroll
        for (int k = 0; k < 8; ++k) yv[k] = *(const LAS u32x4*)(xc + ((tid >> 5) + 16 * k) * 512 + (tid & 31) * 16);
#pragma unroll
        for (int k = 0; k < 8; ++k) *(u32x4*)(yo + (size_t)((tid >> 5) + 16 * k) * KCAT + (tid & 31) * 8) = yv[k];
    }
    __syncthreads();
}
__device__ __forceinline__ void pool_unit(const Args& a, int l, int u, LAS unsigned char* lds, const int wv) {
    asm volatile("" : "+s"(lds));
    int tid_ = tid_of(wv); asm volatile("" : "+v"(tid_)); const int tid = tid_, lane = tid & 63, wave = __builtin_amdgcn_readfirstlane(tid >> 6);
    unsigned char* ws = opaque_ptr(a.ws);
    const unsigned char* z8 = (const unsigned char*)(ws + WS_Z); const float* zs = (const float*)(ws + WS_ZS);
    LAS unsigned char* zt = lds; LAS unsigned char* pt = lds + 143 * ZT_STRIDE;
    const int gp = u & 1, b = (u >> 1) & 7, s = u >> 4;
    const int t0 = b * SEQ + s * 128, p0 = s * 128;
    stage_z8<143>(z8, zs, b, p0 - 15, 8 + gp, zt, tid);
    __syncthreads();
    {
        const int o = tid & 31, rb = tid >> 5; const int g = 2 * gp + (o >> 4); const int w = 2 << g;
#pragma unroll 1
        for (int i = 0; i < 8; ++i) { const int r = rb + 16 * i; float acc[8];
#pragma unroll
            for (int j = 0; j < 8; ++j) acc[j] = 0.f;
            for (int jj = 0; jj < w; ++jj) { const u32x4 v = *(const LAS u32x4*)(zt + (r + 15 - jj) * ZT_STRIDE + o * 16);
                acc[0] += bflo(v.x); acc[1] += bfhi(v.x); acc[2] += bflo(v.y); acc[3] += bfhi(v.y); acc[4] += bflo(v.z); acc[5] += bfhi(v.z); acc[6] += bflo(v.w); acc[7] += bfhi(v.w); }
            const int cnt = (p0 + r + 1 < w) ? (p0 + r + 1) : w; const float ic = 1.0f / (float)cnt;
            const u32x4 v = *(const LAS u32x4*)(zt + (r + 15) * ZT_STRIDE + o * 16);
            const float x0[8] = {bflo(v.x), bfhi(v.x), bflo(v.y), bfhi(v.y), bflo(v.z), bfhi(v.z), bflo(v.w), bfhi(v.w)};
#pragma unroll
            for (int j = 0; j < 8; ++j) acc[j] = acc[j] * ic - x0[j];
            u32x4 wv; wv.x = cvt_pk_bf16(acc[0], acc[1]); wv.y = cvt_pk_bf16(acc[2], acc[3]); wv.z = cvt_pk_bf16(acc[4], acc[5]); wv.w = cvt_pk_bf16(acc[6], acc[7]);
            *(LAS u32x4*)(pt + r * ZT_STRIDE + o * 16) = wv; }
    }
    __syncthreads();
    {
        const int gsel = wave >> 2, wc = wave & 3, g = 2 * gp + gsel, c31 = lane & 31, hh = lane >> 5;
        const int oc = g * 128 + 32 * wc + c31;
        const bf16_t* wb = (const bf16_t*)(ws + WS_WPOOL) + ((size_t)(l * 4 + g) * 128 + 32 * wc + c31) * 128 + 8 * hh;
        bf16x8 Bf[8];
#pragma unroll
        for (int ks = 0; ks < 8; ++ks) Bf[ks] = *(const bf16x8*)(wb + 16 * ks);
        const float psc = a.in[I_PSCALE][(size_t)l * 512 + oc];
        bf16_t* yo = (bf16_t*)(ws + WS_ACAT) + (size_t)t0 * KCAT + oc;
#pragma unroll 1
        for (int rb = 0; rb < 4; ++rb) {
            f32x16 acc;
#pragma unroll
            for (int r = 0; r < 16; ++r) acc[r] = 0.f;
            const LAS unsigned char* ap = pt + (32 * rb + c31) * ZT_STRIDE + (gsel * 128 + 8 * hh) * 2;
#pragma unroll
            for (int ks = 0; ks < 8; ++ks) { const bf16x8 A = *(const LAS bf16x8*)(ap + 32 * ks); acc = __builtin_amdgcn_mfma_f32_32x32x16_bf16(A, Bf[ks], acc, 0, 0, 0); }
#pragma unroll
            for (int reg = 0; reg < 16; ++reg) { const int tok = 32 * rb + 8 * (reg >> 2) + 4 * hh + (reg & 3);
                yo[(size_t)tok * KCAT] = (bf16_t)(cvt_pk_bf16(acc[reg] * psc, 0.f) & 0xffffu); }
        }
    }
    __syncthreads();
}

constexpr int PH_PER_LAYER = 9;
constexpr int N_PHASES = 1 + DEPTH * PH_PER_LAYER + 1;

__global__ void __launch_bounds__(NTHREADS, 2) fwd_kernel(Args a) {
    extern __shared__ __attribute__((aligned(16))) unsigned char lds_raw[];
    LAS unsigned char* lds = (LAS unsigned char*)lds_raw;
    const int wv = __builtin_amdgcn_readfirstlane(threadIdx.x >> 6); const int tid = threadIdx.x; const int G = gridDim.x;
    unsigned char* ws0 = a.ws;
    unsigned* ctl = (unsigned*)(ws0 + WS_CTL);
    volatile LAS unsigned* misc = (volatile LAS unsigned*)(lds + LDS_MISC);
    if (tid < 4) misc[tid] = 0u;
    __syncthreads();
    XcdBarrier bar; bar.bar = ctl + CW_BAR; bar.x = 0; bar.st = misc; bar.wv = wv;
#if MK_PER_PHASE
    const int lo = a.ph_lo, hi = a.ph_hi;
#else
    constexpr int lo = 0, hi = N_PHASES;
#endif
    if (hi - lo > 1) bar = xcd_barrier_post(ctl + CW_BAR, misc, wv);
#define IN(k) (lo <= (k) && (k) < hi)
#define SEAM(k) do { if (IN((k) + 1)) xcd_barrier(bar); } while (0)

    if (EN(0) && IN(0)) for (int rr = 0; rr < REPN(0); ++rr) { phase_prologue(a, lds, wv); SEAM(0); }

    for (int l = 0; l < DEPTH; ++l) {
        const int pb = 1 + l * PH_PER_LAYER;
        if (EN(1) && IN(pb + 0)) for (int rr = 0; rr < REPN(1); ++rr) { unsigned char* ws = opaque_ptr(ws0); const int bid = opaque_bid(); (void)bid; (void)ws; phase_a(a, l, lds, rr + 1 < REPN(1), wv); SEAM(pb + 0); }
        if (EN(2) && IN(pb + 1)) for (int rr = 0; rr < REPN(2); ++rr) { unsigned char* ws = opaque_ptr(ws0); const int bid = opaque_bid(); (void)bid; (void)ws;
            #if Z_I8
            pg8::PlainSched S{(const char*)(ws + WS_H), (const char*)(ws + WS_WIN) + (size_t)l * NZ * 1024, 512, T / 256, NZ / 256, G, bid};
            pg8::EpiZI8 E{(bf16_t*)(ws + WS_Z), (float*)(ws + WS_ZS), (unsigned char*)(ws + WS_ZG), (const unsigned char*)ws, (unsigned)WS_HSC, (unsigned)(WS_WINSC + (size_t)l * NZ * 4)};
            pg8::gemm_phase<pg8::EpiZI8, pg8::PlainSched, true, 2>(lds, 512, S, E, wv);
#elif Z_FP8
            pg8::PlainSched S{(const char*)(ws + WS_H), (const char*)(ws + WS_WIN) + (size_t)l * NZ * 1024, 512, T / 256, NZ / 256, G, bid};
            pg8::EpiBf16 E{(bf16_t*)(ws + WS_Z), NZ, nullptr, (rr + 1 < REPN(2)) && (a.ph_lo == 0), 1.0f / WEIN_SCALE};
            pg8::gemm_phase<pg8::EpiBf16, pg8::PlainSched, true, 1>(lds, 512, S, E, wv);
#else
            pg8::PlainSched S{(const char*)(ws + WS_H), (const char*)(ws + WS_WIN) + (size_t)l * NZ * 1024 * 2, 1024, T / 256, NZ / 256, G, bid};
            pg8::EpiBf16 E{(bf16_t*)(ws + WS_Z), NZ, nullptr, (rr + 1 < REPN(2)) && (a.ph_lo == 0), 1.0f};
            pg8::gemm_phase<pg8::EpiBf16, pg8::PlainSched, true>(lds, 1024, S, E, wv);
#endif
            SEAM(pb + 1);
        }
        if (EN(3) && IN(pb + 2)) for (int rr = 0; rr < REPN(3); ++rr) { unsigned char* ws = opaque_ptr(ws0); const int bid = opaque_bid(); (void)bid; (void)ws;
            for (int u = bid; u < 1024 + 512; u += G) { if (u < 1024) lru_unit(a, l, u, lds, wv); else pool_unit(a, l, u - 1024, lds, wv); }
            SEAM(pb + 2);
        }
        if (EN(5) && IN(pb + 4)) for (int rr = 0; rr < REPN(5); ++rr) { unsigned char* ws = opaque_ptr(ws0); const int bid = opaque_bid(); (void)bid; (void)ws;
            pg8::PlainSched S{(const char*)(ws + WS_ACAT), (const char*)(ws + WS_WCAT) + (size_t)l * 1024 * KCAT * 2, KCAT, T / 256, D / 256, G, bid};
            pg8::EpiMerged E{(bf16_t*)(ws + WS_MERGED), (const unsigned char*)(ws + WS_ZG)};
            pg8::gemm_phase<pg8::EpiMerged, pg8::PlainSched, true>(lds, KCAT, S, E, wv);
            SEAM(pb + 4);
        }
        if (EN(6) && IN(pb + 5)) for (int rr = 0; rr < REPN(6); ++rr) { unsigned char* ws = opaque_ptr(ws0); const int bid = opaque_bid(); (void)bid; (void)ws;
            pg8::PlainSched S{(const char*)(ws + WS_MERGED), (const char*)(ws + WS_WOUT) + (size_t)l * 1024 * 1024 * 2, 1024, T / 256, D / 256, G, bid};
            pg8::EpiResid E{(bf16_t*)(ws + WS_XRES), (rr + 1 < REPN(6)) ? (bf16_t*)(ws + WS_ACT) : (bf16_t*)(ws + WS_XRES), (const float*)(ws + WS_MOD) + (size_t)l * NBATCH * 6144 + 2 * D};
            pg8::gemm_phase<pg8::EpiResid, pg8::PlainSched, true>(lds, 1024, S, E, wv);
            SEAM(pb + 5);
        }
        if (EN(7) && IN(pb + 6)) for (int rr = 0; rr < REPN(7); ++rr) { unsigned char* ws = opaque_ptr(ws0); const int bid = opaque_bid(); (void)bid; (void)ws; if (l > 0 && rr == 0) conv_drain(a, l, -1, lds, wv); phase_h(a, l, l + DEPTH * rr, lds, wv); SEAM(pb + 6); }
        if (EN(8) && IN(pb + 7)) for (int rr = 0; rr < REPN(8); ++rr) { unsigned char* ws = opaque_ptr(ws0); const int bid = opaque_bid(); (void)bid; (void)ws;
            moe_tables(a, l + DEPTH * (REPN(7) - 1), lds, wv);
            LAS unsigned char* lds_o = lds; asm volatile("" : "+s"(lds_o)); const MoeTab mt = moe_tab_ptrs(lds_o);
            MoeSched1 S{(const char*)(ws + WS_H), (const char*)(ws + WS_WEIN) + (size_t)l * NE * 2048 * 1024, (const int*)(ws + WS_TOKOF), mt, __builtin_amdgcn_readfirstlane(mt.tilestart[NE]), G, bid};
            pg8::EpiSwiglu E{(unsigned char*)(ws + WS_ACT), a.in[I_BEIN] + (size_t)l * NE * 2048, 1.0f / WEIN_SCALE};
            pg8::gemm_phase<pg8::EpiSwiglu, MoeSched1, true, 1>(lds, 512, S, E, wv);
            if (l + 1 < DEPTH) {
                const int nwg = S.nMt * 8, maxr = (nwg + G - 1) / G, myr = (nwg - bid + G - 1) / G;
                if (myr < maxr) conv_drain(a, l + 1, CONV_Q1, lds, wv);
            }
            SEAM(pb + 7);
        }
        if (EN(9) && IN(pb + 8)) for (int rr = 0; rr < REPN(9); ++rr) { unsigned char* ws = opaque_ptr(ws0); const int bid = opaque_bid(); (void)bid; (void)ws;
            moe_tables(a, l + DEPTH * (REPN(7) - 1), lds, wv);
            LAS unsigned char* lds_o = lds; asm volatile("" : "+s"(lds_o)); const MoeTab mt = moe_tab_ptrs(lds_o);
            MoeSched2 S{(const char*)(ws + WS_ACT), (const char*)(ws + WS_WEOUT) + (size_t)l * NE * 1024 * 1024, mt, __builtin_amdgcn_readfirstlane(mt.tilestart[NE]), G, bid};
            pg8::EpiMoeOut E{(unsigned char*)(ws + WS_OUTB), (float*)(ws + WS_OUTSC), a.in[I_BEOUT] + (size_t)l * NE * D, 1.0f / WEIN_SCALE};
            pg8::gemm_phase<pg8::EpiMoeOut, MoeSched2, true, 1>(lds, 512, S, E, wv);
            if (l + 1 < DEPTH) {
                const int nwg = S.nMt * 4, maxr = (nwg + G - 1) / G, myr = (nwg - bid + G - 1) / G;
                if (myr < maxr) conv_drain(a, l + 1, CONV_Q2, lds, wv);
            }
            SEAM(pb + 8);
        }
    }
    if (EN(10) && IN(N_PHASES - 1)) phase_a(a, DEPTH, lds, false, wv);
#undef IN
#undef SEAM
}

extern "C" void kernel_launch(void* const* d_in, const int* in_sizes, int n_in, void* d_out, int out_size, void* d_ws, size_t ws_size, hipStream_t stream) {
    static int grid = 0;
    if (grid == 0) {
        if (n_in != 26 || out_size != T * D || ws_size < WS_END) { fprintf(stderr, "kernel_launch: unexpected problem (n_in %d out %d ws %zu)\n", n_in, out_size, ws_size); grid = -1; return; }
        int dev = 0, cus = 0, per_cu = 0;
        if (hipGetDevice(&dev) != hipSuccess || hipDeviceGetAttribute(&cus, hipDeviceAttributeMultiprocessorCount, dev) != hipSuccess) { grid = -1; return; }
        if (hipFuncSetAttribute((const void*)fwd_kernel, hipFuncAttributeMaxDynamicSharedMemorySize, LDS_BYTES) != hipSuccess) { fprintf(stderr, "kernel_launch: hipFuncSetAttribute failed\n"); grid = -1; return; }
        if (hipOccupancyMaxActiveBlocksPerMultiprocessor(&per_cu, (const void*)fwd_kernel, NTHREADS, LDS_BYTES) != hipSuccess || per_cu < 1) fprintf(stderr, "kernel_launch: occupancy query says %d\n", per_cu);
        (void)hipGetLastError();
        grid = cus;
    }
    if (grid < 0) return;
    static_assert(WS_AGG + AGG_BYTES == WS_CTL, "the look-back words and the control block are zeroed by ONE memset");
    if (hipMemsetAsync((char*)d_ws + WS_AGG, 0, AGG_BYTES + CTL_ZERO_BYTES, stream) != hipSuccess) return;
    Args a{};
    for (int i = 0; i < 26; ++i) a.in[i] = (const float*)d_in[i];
    a.out = (float*)d_out; a.ws = (unsigned char*)d_ws;
#if MK_PER_PHASE
    for (int p = 0; p < N_PHASES; ++p) { a.ph_lo = p; a.ph_hi = p + 1; hipLaunchKernelGGL(fwd_kernel, dim3(grid), dim3(NTHREADS), LDS_BYTES, stream, a); }
#else
    a.ph_lo = 0; a.ph_hi = N_PHASES;
    hipLaunchKernelGGL(fwd_kernel, dim3(grid), dim3(NTHREADS), LDS_BYTES, stream, a);
#endif
    const hipError_t le = hipPeekAtLastError();
    if (le != hipSuccess) fprintf(stderr, "kernel_launch: launch failed: %s\n", hipGetErrorName(le));
}
```

```cpp
#include <hip/hip_runtime.h>
#include <cstdio>
#include <cstdint>

#define REP_MASK 0x0
#ifndef PH_MASK
#define PH_MASK 0x7ff
#endif
#define EN(b) ((PH_MASK >> (b)) & 1)
#ifndef REP_MASK
#define REP_MASK 0
#endif
#define REPN(b) ((((REP_MASK) >> (b)) & 1) ? 2 : 1)
#ifndef Z_I8
#define Z_I8 1
#endif
#ifndef Z_FP8
#define Z_FP8 0
#endif
#ifndef MK_PER_PHASE
#define MK_PER_PHASE 0
#endif

#define LAS __attribute__((address_space(3)))
typedef unsigned short bf16_t;
typedef short bf16x8 __attribute__((ext_vector_type(8)));
typedef float f32x4 __attribute__((ext_vector_type(4)));
typedef float f32x2 __attribute__((ext_vector_type(2)));
typedef float f32x16 __attribute__((ext_vector_type(16)));
typedef unsigned u32x4 __attribute__((ext_vector_type(4)));
typedef unsigned u32x2 __attribute__((ext_vector_type(2)));

constexpr int D = 1024, NBATCH = 8, SEQ = 4096, T = NBATCH * SEQ, DEPTH = 4;
constexpr int NZ = 4608, ZO_GLRU = 1024, ZO_XPOOL = 2048, ZO_GL0 = 2560, ZO_GL1 = 3584;
constexpr int NE = 32, TOPK = 4;
constexpr int KCAT = 1536;
constexpr int SLOT_CAP = T * TOPK + NE * 256;
constexpr int MAX_MT = SLOT_CAP / 256;
constexpr float NORM_EPS = 1e-6f;
constexpr float WEIN_SCALE = 64.0f;
constexpr int NTHREADS = 512, NWAVES = 8;

constexpr size_t MiB = 1u << 20;
constexpr size_t WS_CTL = 80 * MiB, CTL_ZERO_BYTES = 256 * 1024;
constexpr size_t WS_MOD = 1 * MiB;
constexpr size_t WS_CB = 2 * MiB;
constexpr size_t WS_AGG = 72 * MiB;
constexpr size_t AGG_BYTES = (size_t)DEPTH * NBATCH * 32 * D * 8;
constexpr size_t WS_WRS = 3 * MiB;
constexpr size_t WS_HSC = 4 * MiB;
constexpr size_t WS_WINSC = 5 * MiB;
constexpr size_t WS_WRB = 40 * MiB;
constexpr size_t WS_TOKOF = 6 * MiB;
constexpr size_t WS_SLOTINFO = 10 * MiB;
constexpr size_t WS_WGT = 11 * MiB;
constexpr size_t WS_WRG = 12 * MiB;
constexpr size_t WS_WPOOL = 14 * MiB;
constexpr size_t WS_WIN = 16 * MiB;
constexpr size_t WS_WCAT = 52 * MiB;
constexpr size_t WS_WOUT = 64 * MiB;
constexpr size_t WS_WEIN = 128 * MiB;
constexpr size_t WS_WEOUT = 640 * MiB;
constexpr size_t WS_XRES = 896 * MiB;
constexpr size_t WS_H = 1024 * MiB;
constexpr size_t WS_Z = 1088 * MiB;
constexpr size_t WS_ZS = WS_Z + 96 * MiB;
constexpr size_t WS_ACAT = 1376 * MiB;
constexpr size_t WS_MERGED = 1472 * MiB;
constexpr size_t WS_ACT = 1536 * MiB;
constexpr size_t WS_OUTB = 1808 * MiB;
constexpr size_t WS_OUTSC = WS_OUTB + 144 * MiB;
constexpr size_t WS_ZG = 2080 * MiB;
constexpr size_t WS_END = 2144 * MiB;
static_assert(WS_ACT + (size_t)SLOT_CAP * 1024 * 2 <= WS_OUTB && WS_OUTB + (size_t)SLOT_CAP * 1024 * 2 <= WS_END, "ws map");
constexpr int CW_BAR = 4096;
constexpr int CW_CONVQ = 7680;
constexpr int CW_CNT = 8192;

constexpr int LDS_BYTES = 163840;
constexpr int LDS_TAB = 131072;
constexpr int LDS_NVA = 131072 + 8192;
constexpr int LDS_PTAB = 131072 + 16384, PTAB_BYTES = 2048;
constexpr int LDS_MISC = LDS_BYTES - 256;

__device__ __forceinline__ unsigned cvt_pk_bf16(float lo, float hi) { unsigned r; asm("v_cvt_pk_bf16_f32 %0, %1, %2" : "=v"(r) : "v"(lo), "v"(hi)); return r; }
__device__ __forceinline__ float bflo(unsigned w) { return __uint_as_float(w << 16); }
__device__ __forceinline__ float bfhi(unsigned w) { return __uint_as_float(w & 0xffff0000u); }
__device__ __forceinline__ float bf1(bf16_t w) { return __uint_as_float(((unsigned)w) << 16); }
__device__ __forceinline__ float sigmoidf_(float x) { return __builtin_amdgcn_rcpf(1.0f + __expf(-x)); }
#define Z_OUT_FP8 1
constexpr float Z_FP8_SCALE = 16.0f;
constexpr float OUT_FP8_SCALE = 16.0f;
constexpr float MAGIC_U8 = 12582912.0f, MAGIC_I8 = 12582912.0f + 128.0f;
__device__ __forceinline__ unsigned pack4_lowbytes(f32x4 t) {
    const unsigned p01 = __builtin_amdgcn_perm(__float_as_uint(t.y), __float_as_uint(t.x), 0x0c0c0400u), p23 = __builtin_amdgcn_perm(__float_as_uint(t.w), __float_as_uint(t.z), 0x0c0c0400u);
    return __builtin_amdgcn_perm(p23, p01, 0x05040100u);
}
__device__ __forceinline__ float shflx(float v, int mask, int lane) { return __int_as_float(__builtin_amdgcn_ds_bpermute((lane ^ mask) << 2, __float_as_int(v))); }
#define DPP_F(v, ctrl) __builtin_bit_cast(float, __builtin_amdgcn_update_dpp(0, __builtin_bit_cast(int, (v)), (ctrl), 0xF, 0xF, true))
#define RDL_F(v, l) __builtin_bit_cast(float, __builtin_amdgcn_readlane(__builtin_bit_cast(int, (v)), (l)))
__device__ __forceinline__ float wave_sum(float v, int) {
    v += DPP_F(v, 0xB1); v += DPP_F(v, 0x4E); v += DPP_F(v, 0x141); v += DPP_F(v, 0x140);
    return (RDL_F(v, 0) + RDL_F(v, 16)) + (RDL_F(v, 32) + RDL_F(v, 48));
}
__device__ __forceinline__ float wave_max(float v) {
    v = fmaxf(v, DPP_F(v, 0xB1)); v = fmaxf(v, DPP_F(v, 0x4E)); v = fmaxf(v, DPP_F(v, 0x141)); v = fmaxf(v, DPP_F(v, 0x140));
    return fmaxf(fmaxf(RDL_F(v, 0), RDL_F(v, 16)), fmaxf(RDL_F(v, 32), RDL_F(v, 48)));
}
__device__ __forceinline__ int tid_of(int wv) { int l; asm volatile("v_mbcnt_lo_u32_b32 %0, -1, 0\n\tv_mbcnt_hi_u32_b32 %0, -1, %0" : "=v"(l)); return wv * 64 + l; }
__device__ __forceinline__ int opaque_bid() { int b = blockIdx.x; asm volatile("" : "+s"(b)); return b; }
__device__ __forceinline__ unsigned char* opaque_ptr(unsigned char* p) { size_t z = 0; asm volatile("" : "+s"(z)); return p + z; }
#define LDS_WAIT() asm volatile("s_waitcnt lgkmcnt(0)" ::: "memory")
#define VM_WAIT() asm volatile("s_waitcnt vmcnt(0)" ::: "memory")

namespace pg8 {
constexpr int BM = 256, BK = 64, HALF = 128, HTB = HALF * BK * 2, STAGE_BYTES = 8 * HTB, NXCD = 8, WGM = 8;
__host__ __device__ __forceinline__ int lds_byte(int r, int c) { const int st = (r >> 4) * 2 + (c >> 5), rr = r & 15, cc = c & 31, ob = rr * 64 + cc * 2; return st * 1024 + (ob ^ (((ob >> 9) & 1) << 5)); }
__host__ __device__ __forceinline__ void stage_rc(int b, int& R, int& C) { const int st = b / 1024, sb = b % 1024, swz = sb ^ (((sb >> 9) & 1) << 5); R = (st >> 1) * 16 + swz / 64; C = (st & 1) * 32 + (swz % 64) / 2; }
__host__ __device__ __forceinline__ int perm32(int rho) { const int n = rho >> 4, i = rho & 15; return 8 * (i >> 2) + 4 * n + (i & 3); }

struct Unit { int pm, pn, e, j, row0, rows; };
typedef int v8i32 __attribute__((ext_vector_type(8)));
typedef int v4i32_t __attribute__((ext_vector_type(4)));
__device__ __forceinline__ v8i32 cat8(bf16x8 lo, bf16x8 hi) { typedef int v4i32 __attribute__((ext_vector_type(4))); const v4i32 a = __builtin_bit_cast(v4i32, lo), b = __builtin_bit_cast(v4i32, hi); return (v8i32){a.x, a.y, a.z, a.w, b.x, b.y, b.z, b.w}; }

template <int WGM_ = WGM>
__device__ __forceinline__ bool order_map(int i, int G, int c, int nM, int nN, int& pm, int& pn) {
    const int nwg = nM * nN; const int L = i * G + c; if (L >= nwg) return false;
    int wgid = L; { const int q = nwg / NXCD, r = nwg % NXCD, xcd = wgid % NXCD, off = wgid / NXCD; wgid = (xcd < r ? xcd * (q + 1) : r * (q + 1) + (xcd - r) * q) + off; }
    const int nig = WGM_ * nN, gid = wgid / nig, fm = gid * WGM_, gsz = (nM - fm) < WGM_ ? (nM - fm) : WGM_;
    pm = fm + ((wgid % nig) % gsz); pn = (wgid % nig) / gsz; return true;
}

struct PlainSched {
    static constexpr bool DYN_A = false;
    const char* A; const char* Bt; int K, nM, nN, G, c;
    __device__ __forceinline__ bool next(int i, Unit& u) const { int pm, pn; if (!order_map(i, G, c, nM, nN, pm, pn)) return false; u.pm = pm; u.pn = pn; u.e = 0; u.j = 0; u.row0 = pm * BM; u.rows = BM; return true; }
    __device__ __forceinline__ const char* a_ptr() const { return A; }
    __device__ __forceinline__ const char* b_ptr() const { return Bt; }
    __device__ __forceinline__ unsigned a_off(const Unit& u) const { return (unsigned)u.row0 * (unsigned)K * 2u; }
    __device__ __forceinline__ unsigned b_off(const Unit& u) const { return (unsigned)u.pn * (unsigned)(BM * K * 2); }
    __device__ __forceinline__ void a_voff(const Unit&, unsigned (&v)[2][2], int wv) const {
        int tid = tid_of(wv); asm volatile("" : "+v"(tid));
#pragma unroll
        for (int i = 0; i < 2; ++i) { int R, C; stage_rc(tid * 16 + i * 8192, R, C);
#pragma unroll
            for (int h = 0; h < 2; ++h) v[h][i] = (unsigned)((h * HALF + R) * K + C) * 2u; }
    }
};

template <class Epi, class Sched, bool ALIGN_EPI, int MODE = 0>
__device__ __forceinline__ void gemm_phase(LAS unsigned char* lds, const int K, const Sched& S, const Epi& E, const int wv) {
    asm volatile("" : "+s"(lds));
    int tid = tid_of(wv); asm volatile("" : "+v"(tid));
    const int wid = __builtin_amdgcn_readfirstlane(tid >> 6), lane = tid & 63, wr = wid >> 2, wc = wid & 3, fr = lane & 15, fq = lane >> 4;
    const int nt = K / BK;
    unsigned voffB;
    { int R, C; stage_rc(tid * 16, R, C);
      const int Rb = (Epi::PERM == 2) ? (64 * (R >> 5) + 16 * ((R & 15) >> 2) + 4 * ((R >> 4) & 1) + (R & 3)) : (Epi::PERM == 1) ? ((R & ~31) + perm32(R & 31)) : R; voffB = (unsigned)(Rb * K + C) * 2u; }
    const unsigned q64 = (unsigned)(64 * K * 2);
    const unsigned q64B = (Epi::PERM == 2) ? 2u * q64 : q64;
    const unsigned kstep = (unsigned)(BK * 2);
    const unsigned hstep = (Epi::PERM == 2) ? (unsigned)(8 * K * 2) : (unsigned)(HALF * K * 2);
    const __amdgpu_buffer_rsrc_t rsA = __builtin_amdgcn_make_buffer_rsrc((void*)S.a_ptr(), 0, 0xffffffff, 0x00020000);
    const __amdgpu_buffer_rsrc_t rsB = __builtin_amdgcn_make_buffer_rsrc((void*)S.b_ptr(), 0, 0xffffffff, 0x00020000);
    const unsigned ldsw = (unsigned)wid * 1024u;
    const int aoff = lds_byte(wr * 64 + fr, fq * 8), boff = lds_byte(wc * 32 + fr, fq * 8);
#define PG8_SA(b, h) (((b) * 2 + (h)) * HTB)
#define PG8_SB(b, h) ((4 + (b) * 2 + (h)) * HTB)
#define PG8_STAGE_(rs, bufoff, v0, s0, v1, s1) do { \
        __builtin_amdgcn_raw_ptr_buffer_load_lds(rs, (LAS void*)(lds + (bufoff) + ldsw), 16, (v0), (s0), 0, 0); \
        __builtin_amdgcn_raw_ptr_buffer_load_lds(rs, (LAS void*)(lds + (bufoff) + ldsw + 8192), 16, (v1), (s1), 0, 0); } while (0)
#define PG8_STAGE_B(bufoff, soff, unused) PG8_STAGE_(rsB, bufoff, voffB, (soff), voffB, (soff) + q64B)
#define PG8_STAGE_A(bufoff, soff, h) do { if constexpr (Sched::DYN_A) PG8_STAGE_(rsA, bufoff, cvA[h][0], (soff), cvA[h][1], (soff)); \
        else PG8_STAGE_(rsA, bufoff, cvA[0][0], (soff) + (h) * 2u * q64, cvA[0][0], (soff) + (h) * 2u * q64 + q64); } while (0)
#define PG8_LDA(dst, b, h) do { _Pragma("unroll") for (int m = 0; m < 4; ++m) _Pragma("unroll") for (int k = 0; k < 2; ++k) dst[m][k] = *(const LAS bf16x8*)(lds + PG8_SA(b, h) + aoff + m * 2048 + k * 1024); } while (0)
#define PG8_LDB(dst, b, h) do { _Pragma("unroll") for (int n = 0; n < 2; ++n) _Pragma("unroll") for (int k = 0; k < 2; ++k) dst[n][k] = *(const LAS bf16x8*)(lds + PG8_SB(b, h) + boff + n * 2048 + k * 1024); } while (0)
#define PG8_MMA(ai, bj, At, Bt) do { __builtin_amdgcn_s_setprio(1); _Pragma("unroll") for (int m = 0; m < 4; ++m) _Pragma("unroll") for (int n = 0; n < 2; ++n) { \
        if constexpr (MODE == 1) { acc[ai][bj][m][n] = __builtin_amdgcn_mfma_scale_f32_16x16x128_f8f6f4(cat8(Bt[n][0], Bt[n][1]), cat8(At[m][0], At[m][1]), acc[ai][bj][m][n], 0, 0, 0, 0x7f7f7f7f, 0, 0x7f7f7f7f); } \
        else if constexpr (MODE == 2) { _Pragma("unroll") for (int k = 0; k < 2; ++k) acc[ai][bj][m][n] = __builtin_bit_cast(f32x4, __builtin_amdgcn_mfma_i32_16x16x64_i8(__builtin_bit_cast(v4i32_t, Bt[n][k]), __builtin_bit_cast(v4i32_t, At[m][k]), __builtin_bit_cast(v4i32_t, acc[ai][bj][m][n]), 0, 0, 0)); } \
        else { _Pragma("unroll") for (int k = 0; k < 2; ++k) acc[ai][bj][m][n] = __builtin_amdgcn_mfma_f32_16x16x32_bf16(Bt[n][k], At[m][k], acc[ai][bj][m][n], 0, 0, 0); } } \
        __builtin_amdgcn_s_setprio(0); } while (0)
#define PG8_WAIT_V(n) asm volatile("s_waitcnt vmcnt(" #n ")" ::: "memory")
#define PG8_WAIT_L(n) asm volatile("s_waitcnt lgkmcnt(" #n ")" ::: "memory")
#define PG8_BAR __builtin_amdgcn_s_barrier()
#define PG8_SCHED __builtin_amdgcn_sched_barrier(0)
    Unit cur, nxt; int ui = 0;
    if (!S.next(0, cur)) return;
    f32x4 acc[2][2][4][2];
    { float z0 = 0.f; asm volatile("" : "+v"(z0));
#pragma unroll
    for (int a = 0; a < 2; ++a)
#pragma unroll
        for (int b = 0; b < 2; ++b)
#pragma unroll
            for (int m = 0; m < 4; ++m)
#pragma unroll
                for (int n = 0; n < 2; ++n) acc[a][b][m][n] = (f32x4){z0, z0, z0, z0}; }
    bf16x8 At[4][2], B0[2][2], B1[2][2];
    unsigned cvA[2][2];
    S.a_voff(cur, cvA, wv);
    unsigned cA = S.a_off(cur), cB = S.b_off(cur);
    if constexpr (Epi::PREF) E.prefetch(cur, lds + LDS_PTAB, wv);
    PG8_STAGE_B(PG8_SB(0, 0), cB, voffB); PG8_STAGE_B(PG8_SB(0, 1), cB + hstep, voffB); PG8_STAGE_A(PG8_SA(0, 0), cA, 0); PG8_STAGE_A(PG8_SA(0, 1), cA, 1);
    if (wr == 1) PG8_BAR;
    PG8_WAIT_V(2); PG8_BAR;
    PG8_STAGE_B(PG8_SB(1, 0), cB + kstep, voffB); PG8_STAGE_A(PG8_SA(1, 0), cA + kstep, 0); PG8_STAGE_B(PG8_SB(1, 1), cB + hstep + kstep, voffB);
    PG8_WAIT_V(6); PG8_BAR;
    for (;;) {
        const bool has_next = S.next(ui + 1, nxt);
        unsigned nA = cA, nB = cB;
        if (has_next) { nA = S.a_off(nxt); nB = S.b_off(nxt); }
        if constexpr (Sched::DYN_A) { if (has_next) S.a_dma(nxt, lds + LDS_NVA, wv); }
#pragma unroll 1
        for (int t = 0; t < nt; t += 2) {
            const bool last = (t == nt - 2);
            const unsigned a1 = cA + (unsigned)(t + 1) * kstep;
            const unsigned a2 = last ? nA : cA + (unsigned)(t + 2) * kstep, b2 = last ? nB : cB + (unsigned)(t + 2) * kstep;
            const unsigned a3 = a2 + kstep, b3 = b2 + kstep;
            unsigned nx1[2] = {cvA[1][0], cvA[1][1]};
            if constexpr (Sched::DYN_A) { if (last && has_next) { unsigned q[4]; S.a_fetch(lds + LDS_NVA, wv, q); cvA[0][0] = q[0]; cvA[0][1] = q[1]; nx1[0] = q[2]; nx1[1] = q[3]; } }
            if constexpr (Epi::HOOK_T >= 0) { if (t == Epi::HOOK_T) E.mid(acc, cur, wr, wc, fr, fq); }
            PG8_LDB(B0, 0, 0); PG8_LDB(B1, 0, 1); PG8_SCHED; PG8_LDA(At, 0, 0); PG8_STAGE_A(PG8_SA(1, 1), a1, 1);
            if constexpr (Sched::DYN_A) { cvA[1][0] = nx1[0]; cvA[1][1] = nx1[1]; }
            PG8_WAIT_V(8); PG8_WAIT_L(0); PG8_BAR; PG8_MMA(0, 0, At, B0); PG8_MMA(0, 1, At, B1); PG8_BAR; PG8_SCHED;
            PG8_LDA(At, 0, 1); PG8_STAGE_B(PG8_SB(0, 0), b2, voffB); PG8_STAGE_B(PG8_SB(0, 1), b2 + hstep, voffB); PG8_STAGE_A(PG8_SA(0, 0), a2, 0);
            PG8_WAIT_V(8); PG8_WAIT_L(0); PG8_BAR; PG8_MMA(1, 0, At, B0); PG8_MMA(1, 1, At, B1); PG8_BAR; PG8_SCHED;
            PG8_LDB(B0, 1, 0); PG8_LDB(B1, 1, 1); PG8_SCHED; PG8_LDA(At, 1, 0); PG8_STAGE_A(PG8_SA(0, 1), a2, 1);
            PG8_WAIT_V(8); PG8_WAIT_L(0); PG8_BAR; PG8_MMA(0, 0, At, B0); PG8_MMA(0, 1, At, B1); PG8_BAR; PG8_SCHED;
            PG8_LDA(At, 1, 1); PG8_STAGE_B(PG8_SB(1, 0), b3, voffB); PG8_STAGE_B(PG8_SB(1, 1), b3 + hstep, voffB); PG8_STAGE_A(PG8_SA(1, 0), a3, 0);
            PG8_WAIT_V(8); PG8_WAIT_L(0); PG8_BAR; PG8_MMA(1, 0, At, B0); PG8_MMA(1, 1, At, B1); PG8_BAR; PG8_SCHED;
        }
        if constexpr (ALIGN_EPI) { if (wr == 0) PG8_BAR; }
        if constexpr (Epi::PREF) E.run(acc, cur, wr, wc, lds + LDS_PTAB + (ui & 1) * PTAB_BYTES); else E(acc, cur, wr, wc, fr, fq);
        if (!has_next) break;
        { float z0 = 0.f; asm volatile("" : "+v"(z0));
#pragma unroll
        for (int a = 0; a < 2; ++a)
#pragma unroll
            for (int b = 0; b < 2; ++b)
#pragma unroll
                for (int m = 0; m < 4; ++m)
#pragma unroll
                    for (int n = 0; n < 2; ++n) acc[a][b][m][n] = (f32x4){z0, z0, z0, z0}; }
        cur = nxt; cA = nA; cB = nB; ++ui;
        if constexpr (Epi::PREF) E.prefetch(cur, lds + LDS_PTAB + (ui & 1) * PTAB_BYTES, wv);
        if constexpr (ALIGN_EPI) { if (wr == 1) PG8_BAR; }
    }
    PG8_WAIT_V(0);
    if constexpr (!ALIGN_EPI) { if (wr == 0) PG8_BAR; }
    PG8_BAR;
#undef PG8_SA
#undef PG8_SB
#undef PG8_STAGE_
#undef PG8_STAGE_A
#undef PG8_STAGE_B
#undef PG8_LDA
#undef PG8_LDB
#undef PG8_MMA
#undef PG8_WAIT_V
#undef PG8_WAIT_L
#undef PG8_BAR
#undef PG8_SCHED
}

struct EpiBf16 {
    static constexpr int PERM = 1; static constexpr int HOOK_T = -1; static constexpr bool PREF = false;
    bf16_t* O; int ldc; const float* bias; int noepi; float scale;
    __device__ __forceinline__ void mid(f32x4 (&)[2][2][4][2], const Unit&, int, int, int, int) const {}
    __device__ __forceinline__ void operator()(const f32x4 (&acc)[2][2][4][2], const Unit& u, int wr, int wc, int fr, int fq) const {
        { const int l_ = tid_of(0); fr = l_ & 15; fq = l_ >> 4; }
        if (noepi) { if (acc[0][0][0][0][0] == 1.2345e-30f) O[0] = 0; return; }
        int row0 = u.row0 + wr * 64 + fr; asm volatile("" : "+v"(row0)); int col0 = u.pn * BM + wc * 32 + 8 * fq; asm volatile("" : "+v"(col0));
        f32x4 bv[2][2];
#pragma unroll
        for (int bj = 0; bj < 2; ++bj)
#pragma unroll
            for (int n = 0; n < 2; ++n) bv[bj][n] = bias ? *(const f32x4*)(bias + col0 + bj * HALF + 4 * n) : (f32x4){0.f, 0.f, 0.f, 0.f};
#pragma unroll
        for (int ai = 0; ai < 2; ++ai)
#pragma unroll
            for (int m = 0; m < 4; ++m) { bf16_t* rowp = O + (size_t)(row0 + ai * HALF + m * 16) * ldc + col0;
#pragma unroll
                for (int bj = 0; bj < 2; ++bj) { const f32x4 v0 = acc[ai][bj][m][0] * scale + bv[bj][0], v1 = acc[ai][bj][m][1] * scale + bv[bj][1];
                    u32x4 w; w.x = cvt_pk_bf16(v0[0], v0[1]); w.y = cvt_pk_bf16(v0[2], v0[3]); w.z = cvt_pk_bf16(v1[0], v1[1]); w.w = cvt_pk_bf16(v1[2], v1[3]);
                    *(u32x4*)(rowp + bj * HALF) = w; } }
    }
};
struct EpiZI8 {
    static constexpr int PERM = 2; static constexpr int HOOK_T = -1; static constexpr bool PREF = true;
    bf16_t* O; float* ZS; unsigned char* ZG; const unsigned char* wsb; unsigned rsc_off, csc_off;
    __device__ __forceinline__ void mid(f32x4 (&)[2][2][4][2], const Unit&, int, int, int, int) const {}
    __device__ __forceinline__ void prefetch(const Unit& u, LAS unsigned char* tab, int wv) const {
        const int t = tid_of(wv);
        const unsigned vo = (t < 256) ? (rsc_off + (unsigned)(u.row0 + t) * 4u) : (csc_off + (unsigned)(u.pn * BM + t - 256) * 4u);
        const __amdgpu_buffer_rsrc_t rs = __builtin_amdgcn_make_buffer_rsrc((void*)wsb, 0, 0xffffffff, 0x00020000);
        __builtin_amdgcn_raw_ptr_buffer_load_lds(rs, (LAS void*)(tab + wv * 256), 4, vo, 0, 0, 0);
    }
    __device__ __forceinline__ void run(const f32x4 (&acc)[2][2][4][2], const Unit& u, int wr, int wc, const LAS unsigned char* tab) const {
        int fr, fq; const int lane_ = tid_of(0); fr = lane_ & 15; fq = lane_ >> 4;
        int row0 = u.row0 + wr * 64 + fr; asm volatile("" : "+v"(row0)); int col0 = u.pn * BM + wc * 64 + 16 * fq; asm volatile("" : "+v"(col0));
        const LAS float* tf = (const LAS float*)tab;
        f32x4 cs[2][2];
#pragma unroll
        for (int bj = 0; bj < 2; ++bj)
#pragma unroll
            for (int n = 0; n < 2; ++n) cs[bj][n] = *(const LAS f32x4*)(tf + 256 + wc * 64 + 16 * fq + 8 * bj + 4 * n);
        if (u.pn >= ZO_GL0 / BM) {
#pragma unroll
            for (int bj = 0; bj < 2; ++bj)
#pragma unroll
                for (int n = 0; n < 2; ++n) cs[bj][n] *= -1.4426950408889634f;
#pragma unroll
            for (int ai = 0; ai < 2; ++ai)
#pragma unroll
                for (int m = 0; m < 4; ++m) { const int r = row0 + ai * HALF + m * 16; const float rs = tf[ai * HALF + wr * 64 + m * 16 + fr];
                    unsigned w[4];
#pragma unroll
                    for (int q = 0; q < 4; ++q) { const v4i32_t iv = __builtin_bit_cast(v4i32_t, acc[ai][q >> 1][m][q & 1]);
                        f32x4 e = (f32x4){(float)iv.x, (float)iv.y, (float)iv.z, (float)iv.w} * rs * cs[q >> 1][q & 1];
#pragma unroll
                        for (int j = 0; j < 4; ++j) e[j] = __builtin_amdgcn_exp2f(e[j]);
                        e += 1.0f;
#pragma unroll
                        for (int j = 0; j < 4; ++j) e[j] = __builtin_amdgcn_rcpf(e[j]);
                        w[q] = pack4_lowbytes(e * 255.0f + MAGIC_U8); }
                    *(u32x4*)(ZG + (size_t)r * 2048 + (col0 - ZO_GL0)) = (u32x4){w[0], w[1], w[2], w[3]}; }
        } else {
#if Z_OUT_FP8
#pragma unroll
            for (int bj = 0; bj < 2; ++bj)
#pragma unroll
                for (int n = 0; n < 2; ++n) cs[bj][n] *= Z_FP8_SCALE;
#pragma unroll
            for (int ai = 0; ai < 2; ++ai)
#pragma unroll
                for (int m = 0; m < 4; ++m) { const int r = row0 + ai * HALF + m * 16; const float rs = tf[ai * HALF + wr * 64 + m * 16 + fr];
                    unsigned w[4];
#pragma unroll
                    for (int q = 0; q < 4; ++q) { const v4i32_t iv = __builtin_bit_cast(v4i32_t, acc[ai][q >> 1][m][q & 1]);
                        const f32x4 v = (f32x4){(float)iv.x, (float)iv.y, (float)iv.z, (float)iv.w} * rs * cs[q >> 1][q & 1];
                        int p = 0; p = __builtin_amdgcn_cvt_pk_fp8_f32(v.x, v.y, p, false); p = __builtin_amdgcn_cvt_pk_fp8_f32(v.z, v.w, p, true); w[q] = (unsigned)p; }
                    *(u32x4*)((unsigned char*)O + (size_t)r * 2560 + col0) = (u32x4){w[0], w[1], w[2], w[3]}; }
        }
#else
#pragma unroll
            for (int ai = 0; ai < 2; ++ai)
#pragma unroll
                for (int m = 0; m < 4; ++m) { const int r = row0 + ai * HALF + m * 16; const float rs = tf[ai * HALF + wr * 64 + m * 16 + fr]; f32x4 vq[4];
                    float am = 1e-30f;
#pragma unroll
                    for (int q = 0; q < 4; ++q) { const v4i32_t iv = __builtin_bit_cast(v4i32_t, acc[ai][q >> 1][m][q & 1]);
                        vq[q] = (f32x4){(float)iv.x, (float)iv.y, (float)iv.z, (float)iv.w} * cs[q >> 1][q & 1];
                        am = fmaxf(am, fmaxf(fmaxf(fabsf(vq[q].x), fabsf(vq[q].y)), fmaxf(fabsf(vq[q].z), fabsf(vq[q].w)))); }
                    am = fmaxf(am, shflx(am, 16, lane_)); am = fmaxf(am, shflx(am, 32, lane_));
                    const float inv = 127.0f * __builtin_amdgcn_rcpf(am) * 0.999f;
                    if (fq == 0) ZS[(size_t)r * 40 + u.pn * 4 + wc] = am * rs * (1.0f / (127.0f * 0.999f));
                    unsigned w[4];
#pragma unroll
                    for (int q = 0; q < 4; ++q) w[q] = pack4_lowbytes(vq[q] * inv + MAGIC_I8);
                    *(u32x4*)((unsigned char*)O + (size_t)r * 2560 + col0) = (u32x4){w[0], w[1], w[2], w[3]}; }
        }
#endif
    }
    __device__ __forceinline__ void operator()(const f32x4 (&)[2][2][4][2], const Unit&, int, int, int, int) const {}
};
struct EpiMerged {
    static constexpr int PERM = 2; static constexpr int HOOK_T = 8; static constexpr bool PREF = false;
    bf16_t* O; const unsigned char* ZG;
    __device__ __forceinline__ void mid(f32x4 (&acc)[2][2][4][2], const Unit& u, int wr, int wc, int fr, int fq) const {
        { const int l_ = tid_of(0); fr = l_ & 15; fq = l_ >> 4; }
        int row0 = u.row0 + wr * 64 + fr; asm volatile("" : "+v"(row0)); int col0 = u.pn * BM + wc * 64 + 16 * fq; asm volatile("" : "+v"(col0));
        u32x4 g0[2][4], g1[2][4];
#pragma unroll
        for (int ai = 0; ai < 2; ++ai)
#pragma unroll
            for (int m = 0; m < 4; ++m) { const unsigned char* zr = ZG + (size_t)(row0 + ai * HALF + m * 16) * 2048 + col0;
                g0[ai][m] = *(const u32x4*)zr; g1[ai][m] = *(const u32x4*)(zr + 1024); }
#pragma unroll
        for (int ai = 0; ai < 2; ++ai)
#pragma unroll
            for (int m = 0; m < 4; ++m)
#pragma unroll
                for (int bj = 0; bj < 2; ++bj) {
                    const unsigned a0[2] = {bj ? g0[ai][m].z : g0[ai][m].x, bj ? g0[ai][m].w : g0[ai][m].y}, a1[2] = {bj ? g1[ai][m].z : g1[ai][m].x, bj ? g1[ai][m].w : g1[ai][m].y};
#pragma unroll
                    for (int n = 0; n < 2; ++n)
#pragma unroll
                        for (int j = 0; j < 4; ++j) { const float u0 = fmaxf((float)((a0[n] >> (8 * j)) & 0xffu), 1.0f), u1 = (float)((a1[n] >> (8 * j)) & 0xffu);
                            acc[ai][bj][m][n][j] *= u1 * __builtin_amdgcn_rcpf(u0); } }
    }
    __device__ __forceinline__ void operator()(const f32x4 (&acc)[2][2][4][2], const Unit& u, int wr, int wc, int fr, int fq) const {
        { const int l_ = tid_of(0); fr = l_ & 15; fq = l_ >> 4; }
        int row0 = u.row0 + wr * 64 + fr; asm volatile("" : "+v"(row0)); int col0 = u.pn * BM + wc * 64 + 16 * fq; asm volatile("" : "+v"(col0));
        u32x4 g0[2][4];
#pragma unroll
        for (int ai = 0; ai < 2; ++ai)
#pragma unroll
            for (int m = 0; m < 4; ++m) { const unsigned char* zr = ZG + (size_t)(row0 + ai * HALF + m * 16) * 2048 + col0;
                g0[ai][m] = *(const u32x4*)zr; }
#pragma unroll
        for (int ai = 0; ai < 2; ++ai)
#pragma unroll
            for (int m = 0; m < 4; ++m) { bf16_t* orow = O + (size_t)(row0 + ai * HALF + m * 16) * D + col0;
#pragma unroll
                for (int bj = 0; bj < 2; ++bj) { const unsigned a0[2] = {bj ? g0[ai][m].z : g0[ai][m].x, bj ? g0[ai][m].w : g0[ai][m].y};
                    float o[8];
#pragma unroll
                    for (int n = 0; n < 2; ++n)
#pragma unroll
                        for (int j = 0; j < 4; ++j) o[4 * n + j] = acc[ai][bj][m][n][j] * (fmaxf((float)((a0[n] >> (8 * j)) & 0xffu), 1.0f) * (1.0f / 255.0f));
                    u32x4 w; w.x = cvt_pk_bf16(o[0], o[1]); w.y = cvt_pk_bf16(o[2], o[3]); w.z = cvt_pk_bf16(o[4], o[5]); w.w = cvt_pk_bf16(o[6], o[7]);
                    *(u32x4*)(orow + bj * 8) = w; } }
    }
};
struct EpiResid {
    static constexpr int PERM = 1; static constexpr int HOOK_T = -1; static constexpr bool PREF = false;
    bf16_t* X; bf16_t* XO; const float* gate;
    __device__ __forceinline__ void mid(f32x4 (&)[2][2][4][2], const Unit&, int, int, int, int) const {}
    __device__ __forceinline__ void operator()(const f32x4 (&acc)[2][2][4][2], const Unit& u, int wr, int wc, int fr, int fq) const {
        { const int l_ = tid_of(0); fr = l_ & 15; fq = l_ >> 4; }
        int row0 = u.row0 + wr * 64 + fr; asm volatile("" : "+v"(row0)); int col0 = u.pn * BM + wc * 32 + 8 * fq; asm volatile("" : "+v"(col0));
        const float* gp = gate + (size_t)(u.row0 / SEQ) * (6 * D) + col0;
        f32x4 gv[2][2];
#pragma unroll
        for (int bj = 0; bj < 2; ++bj)
#pragma unroll
            for (int n = 0; n < 2; ++n) gv[bj][n] = *(const f32x4*)(gp + bj * HALF + 4 * n);
#pragma unroll
        for (int ai = 0; ai < 2; ++ai) {
            u32x4 xv[4][2];
#pragma unroll
            for (int m = 0; m < 4; ++m) { const bf16_t* rowp = X + (size_t)(row0 + ai * HALF + m * 16) * D + col0;
#pragma unroll
                for (int bj = 0; bj < 2; ++bj) xv[m][bj] = *(const u32x4*)(rowp + bj * HALF); }
#pragma unroll
            for (int m = 0; m < 4; ++m) { bf16_t* rowo = XO + (size_t)(row0 + ai * HALF + m * 16) * D + col0;
#pragma unroll
                for (int bj = 0; bj < 2; ++bj) { const u32x4 p = xv[m][bj];
                    const f32x4 o0 = (f32x4){bflo(p.x), bfhi(p.x), bflo(p.y), bfhi(p.y)} + gv[bj][0] * acc[ai][bj][m][0], o1 = (f32x4){bflo(p.z), bfhi(p.z), bflo(p.w), bfhi(p.w)} + gv[bj][1] * acc[ai][bj][m][1];
                    u32x4 w; w.x = cvt_pk_bf16(o0[0], o0[1]); w.y = cvt_pk_bf16(o0[2], o0[3]); w.z = cvt_pk_bf16(o1[0], o1[1]); w.w = cvt_pk_bf16(o1[2], o1[3]);
                    *(u32x4*)(rowo + bj * HALF) = w; } }
            asm volatile("" ::: "memory"); }
    }
};
constexpr float SG_C = -1.702f * 1.4426950408889634f;
struct EpiSwiglu {
    static constexpr int PERM = 1; static constexpr int HOOK_T = -1; static constexpr bool PREF = true;
    unsigned char* ACT; const float* bias; float wscale;
    __device__ __forceinline__ void mid(f32x4 (&)[2][2][4][2], const Unit&, int, int, int, int) const {}
    __device__ __forceinline__ void operator()(const f32x4 (&)[2][2][4][2], const Unit&, int, int, int, int) const {}
    __device__ __forceinline__ void prefetch(const Unit& u, LAS unsigned char* tab, int wv) const {
        const int t = tid_of(wv) & 255;
        const __amdgpu_buffer_rsrc_t rs = __builtin_amdgcn_make_buffer_rsrc((void*)bias, 0, 0xffffffff, 0x00020000);
        __builtin_amdgcn_raw_ptr_buffer_load_lds(rs, (LAS void*)(tab + (wv & 3) * 256), 4, (unsigned)(u.e * 2048 + (t >> 7) * 1024 + u.pn * HALF + (t & 127)) * 4u, 0, 0, 0);
    }
    __device__ __forceinline__ void run(const f32x4 (&acc)[2][2][4][2], const Unit& u, int wr, int wc, const LAS unsigned char* tab) const {
        int fr, fq; { const int l_ = tid_of(0); fr = l_ & 15; fq = l_ >> 4; }
        int row0 = u.row0 + wr * 64 + fr; asm volatile("" : "+v"(row0)); int cc = u.pn * HALF + wc * 32 + 8 * fq; asm volatile("" : "+v"(cc));
        const LAS float* tf = (const LAS float*)tab + wc * 32 + 8 * fq;
        f32x4 bg[2], bu[2];
#pragma unroll
        for (int n = 0; n < 2; ++n) { bg[n] = *(const LAS f32x4*)(tf + 4 * n) * SG_C; bu[n] = *(const LAS f32x4*)(tf + HALF + 4 * n) + 1.0f; }
        const float wsc = wscale * SG_C;
#pragma unroll
        for (int ai = 0; ai < 2; ++ai)
#pragma unroll
            for (int m = 0; m < 4; ++m) { unsigned char* rowp = ACT + (size_t)(row0 + ai * HALF + m * 16) * D + cc;
                float o[8];
#pragma unroll
                for (int n = 0; n < 2; ++n) {
                    f32x4 t = acc[ai][0][m][n] * wsc + bg[n], up = acc[ai][1][m][n] * wscale + bu[n], e;
#pragma unroll
                    for (int j = 0; j < 4; ++j) { t[j] = fmaxf(t[j], 7.0f * SG_C); e[j] = __builtin_amdgcn_exp2f(t[j]); up[j] = __builtin_amdgcn_fmed3f(up[j], -6.0f, 8.0f); }
                    e += 1.0f;
#pragma unroll
                    for (int j = 0; j < 4; ++j) e[j] = __builtin_amdgcn_rcpf(e[j]);
                    const f32x4 r = (t * (1.0f / SG_C)) * (e * up);
#pragma unroll
                    for (int j = 0; j < 4; ++j) o[4 * n + j] = r[j]; }
                int w0 = 0, w1 = 0;
                w0 = __builtin_amdgcn_cvt_pk_fp8_f32(o[0], o[1], w0, false); w0 = __builtin_amdgcn_cvt_pk_fp8_f32(o[2], o[3], w0, true);
                w1 = __builtin_amdgcn_cvt_pk_fp8_f32(o[4], o[5], w1, false); w1 = __builtin_amdgcn_cvt_pk_fp8_f32(o[6], o[7], w1, true);
                *(u32x2*)rowp = (u32x2){(unsigned)w0, (unsigned)w1}; }
    }
};
struct EpiMoeOut {
    static constexpr int PERM = 2; static constexpr int HOOK_T = -1; static constexpr bool PREF = true;
    unsigned char* O; float* SC; const float* bias; float wscale;
    __device__ __forceinline__ void mid(f32x4 (&)[2][2][4][2], const Unit&, int, int, int, int) const {}
    __device__ __forceinline__ void operator()(const f32x4 (&)[2][2][4][2], const Unit&, int, int, int, int) const {}
    __device__ __forceinline__ void prefetch(const Unit& u, LAS unsigned char* tab, int wv) const {
        const int t = tid_of(wv) & 255;
        const __amdgpu_buffer_rsrc_t rs = __builtin_amdgcn_make_buffer_rsrc((void*)bias, 0, 0xffffffff, 0x00020000);
        __builtin_amdgcn_raw_ptr_buffer_load_lds(rs, (LAS void*)(tab + (wv & 3) * 256), 4, (unsigned)(u.e * D + u.pn * BM + t) * 4u, 0, 0, 0);
    }
    __device__ __forceinline__ void run(const f32x4 (&acc)[2][2][4][2], const Unit& u, int wr, int wc, const LAS unsigned char* tab) const {
        int fr, fq; { const int lane_ = tid_of(0); fr = lane_ & 15; fq = lane_ >> 4; }
        int row0 = u.row0 + wr * 64 + fr; asm volatile("" : "+v"(row0)); int col0 = u.pn * BM + wc * 64 + 16 * fq; asm volatile("" : "+v"(col0));
        const LAS float* tf = (const LAS float*)tab;
        f32x4 bv[2][2];
#pragma unroll
        for (int bj = 0; bj < 2; ++bj)
#pragma unroll
            for (int n = 0; n < 2; ++n) bv[bj][n] = *(const LAS f32x4*)(tf + wc * 64 + 16 * fq + 8 * bj + 4 * n);
        const float ws16 = wscale * OUT_FP8_SCALE;
#pragma unroll
        for (int bj = 0; bj < 2; ++bj)
#pragma unroll
            for (int n = 0; n < 2; ++n) bv[bj][n] *= OUT_FP8_SCALE;
#pragma unroll
        for (int ai = 0; ai < 2; ++ai)
#pragma unroll
            for (int m = 0; m < 4; ++m) { const size_t r = (size_t)(row0 + ai * HALF + m * 16);
                unsigned w[4];
#pragma unroll
                for (int q = 0; q < 4; ++q) { const f32x4 v = acc[ai][q >> 1][m][q & 1] * ws16 + bv[q >> 1][q & 1];
                    int p = 0; p = __builtin_amdgcn_cvt_pk_fp8_f32(v.x, v.y, p, false); p = __builtin_amdgcn_cvt_pk_fp8_f32(v.z, v.w, p, true); w[q] = (unsigned)p; }
                *(u32x4*)(O + r * D + col0) = (u32x4){w[0], w[1], w[2], w[3]}; }
    }
};
}

#define XB_TMO      128
#define XB_XCNT(j)  (256  + 64 * (j))
#define XB_XSUB(j)  (1280 + 64 * (j))
#define XB_XGEN(j)  (2304 + 64 * (j))
#define XB_TOP      3328
#define XB_TOPGEN   3392
#define XCD_BAR_WORDS 3456
#define XB_SPIN_CAP (1u << 18)
__device__ __forceinline__ unsigned xb_ld(unsigned* p)              { return __hip_atomic_load(p, __ATOMIC_RELAXED, __HIP_MEMORY_SCOPE_AGENT); }
__device__ __forceinline__ unsigned xb_add(unsigned* p, unsigned v) { return __hip_atomic_fetch_add(p, v, __ATOMIC_RELAXED, __HIP_MEMORY_SCOPE_AGENT); }
__device__ __forceinline__ unsigned xb_xcc_id() { return (unsigned)__builtin_amdgcn_s_getreg((3 << 11) | 20) & 0xFu; }
#define XB_SPIN(cond, bar) do { unsigned _sp = 0; while (cond) { __builtin_amdgcn_s_sleep(1); \
    if ((++_sp & 255u) == 0u) { if (xb_ld(&(bar)[XB_TMO])) break; if (_sp > XB_SPIN_CAP) { atomicAdd(&(bar)[XB_TMO], 1u); break; } } } } while (0)
struct XcdBarrier { unsigned* bar; unsigned x; volatile LAS unsigned* st; int wv; };
__device__ __forceinline__ XcdBarrier xcd_barrier_post(unsigned* bar, volatile LAS unsigned* st, int wv) {
    XcdBarrier b; b.bar = bar; b.x = xb_xcc_id(); b.st = st; b.wv = wv;
    if (tid_of(wv) == 0) (void)xb_add(&bar[XB_XCNT(b.x)], 1u);
    return b;
}
__device__ __forceinline__ void xcd_barrier_complete(unsigned* bar, unsigned x, unsigned& nloc, unsigned& nx) {
    const unsigned G = gridDim.x * gridDim.y * gridDim.z;
    unsigned sum, cnt, mine, sp = 0u;
    for (;;) {
        sum = 0u; cnt = 0u; mine = 0u;
#pragma unroll
        for (unsigned j = 0; j < 16; ++j) { const unsigned c = xb_ld(&bar[XB_XCNT(j)]); sum += c; cnt += (c > 0u) ? 1u : 0u; mine = (j == x) ? c : mine; }
        if (sum == G) break;
        __builtin_amdgcn_s_sleep(1);
        if ((++sp & 255u) == 0u) { if (xb_ld(&bar[XB_TMO])) break; if (sp > XB_SPIN_CAP) { atomicAdd(&bar[XB_TMO], 1u); break; } }
    }
    nloc = mine > 0u ? mine : 1u; nx = cnt > 0u ? cnt : 1u;
}
__device__ __forceinline__ void xcd_barrier(const XcdBarrier& b) {
    asm volatile("s_waitcnt vmcnt(0)" ::: "memory");
    __syncthreads();
    if (tid_of(b.wv) == 0) {
        size_t zb = 0; asm volatile("" : "+s"(zb)); unsigned* bar = b.bar + zb; unsigned bx = b.x; asm volatile("" : "+s"(bx));
        __builtin_amdgcn_s_waitcnt(0);
        unsigned nloc = b.st[0], nx = b.st[1];
        if (nloc == 0u) { xcd_barrier_complete(bar, bx, nloc, nx); b.st[0] = nloc; b.st[1] = nx; }
        const unsigned old = xb_add(&bar[XB_XSUB(bx)], 1u);
        const unsigned gen = old / nloc;
        if (old + 1u == (gen + 1u) * nloc) {
            __builtin_amdgcn_fence(__ATOMIC_RELEASE, "agent");
            asm volatile("s_waitcnt vmcnt(0)" ::: "memory");
            const unsigned og = xb_add(&bar[XB_TOP], 1u);
            const unsigned tg = og / nx;
            if (og + 1u == (tg + 1u) * nx) xb_add(&bar[XB_TOPGEN], 1u);
            else XB_SPIN(xb_ld(&bar[XB_TOPGEN]) == tg, bar);
            __builtin_amdgcn_fence(__ATOMIC_ACQUIRE, "agent");
            xb_add(&bar[XB_XGEN(bx)], 1u);
            asm volatile("s_waitcnt vmcnt(0)" ::: "memory");
        } else {
            XB_SPIN(xb_ld(&bar[XB_XGEN(bx)]) == gen, bar);
            __builtin_amdgcn_fence(__ATOMIC_ACQUIRE, "agent");
            asm volatile("s_waitcnt vmcnt(0)" ::: "memory");
        }
    }
    __syncthreads();
}

struct Args { const float* in[26]; float* out; unsigned char* ws; int ph_lo, ph_hi; };
enum { I_X = 0, I_C, I_N1G, I_N2G, I_WADA, I_BADA, I_WIN, I_CONVW, I_CONVB, I_WRGA, I_BRGA, I_WRGX, I_BRGX, I_LAM, I_WPOOL, I_PSCALE, I_WUPA, I_WUPB, I_WOUT, I_WROUTER, I_BROUTER, I_WEIN, I_BEIN, I_WEOUT, I_BEOUT, I_FINALG };

template <int ROWMODE>
__device__ __forceinline__ void tr_item(const float* W, int N, bf16_t* WT, int dst_ld, int dst_off, int k0, int n0, LAS float* scr, int lane) {
    { float tv[32];
#pragma unroll
    for (int i = 0; i < 32; ++i) tv[i] = W[(size_t)(k0 + 2 * i + (lane >> 5)) * N + n0 + (lane & 31)];
#pragma unroll
    for (int i = 0; i < 32; ++i) scr[(2 * i + (lane >> 5)) * 33 + (lane & 31)] = tv[i]; }
    LDS_WAIT();
    const int c = lane & 7;
#pragma unroll
    for (int j = 0; j < 4; ++j) { const int n = (lane >> 3) + 8 * j; const LAS float* s = scr + (8 * c) * 33 + n;
        u32x4 o; o.x = cvt_pk_bf16(s[0 * 33], s[1 * 33]); o.y = cvt_pk_bf16(s[2 * 33], s[3 * 33]); o.z = cvt_pk_bf16(s[4 * 33], s[5 * 33]); o.w = cvt_pk_bf16(s[6 * 33], s[7 * 33]);
        const int nn = n0 + n; int drow = nn;
        if (ROWMODE == 1) { drow = (nn < 1024) ? (256 * (nn >> 7) + (nn & 127)) : (256 * ((nn - 1024) >> 7) + 128 + ((nn - 1024) & 127)); }
        *(u32x4*)(WT + (size_t)drow * dst_ld + dst_off + k0 + 8 * c) = o; }
    LDS_WAIT();
}
template <int ROWMODE>
__device__ __forceinline__ void tr_item_fp8(const float* W, int N, unsigned char* WT, int k0, int n0, LAS float* scr, int lane) {
    { float tv[64];
#pragma unroll
    for (int i = 0; i < 64; ++i) tv[i] = W[(size_t)(k0 + 2 * i + (lane >> 5)) * N + n0 + (lane & 31)];
#pragma unroll
    for (int i = 0; i < 64; ++i) scr[(2 * i + (lane >> 5)) * 33 + (lane & 31)] = tv[i]; }
    LDS_WAIT();
    const int c = lane & 7;
#pragma unroll
    for (int j = 0; j < 4; ++j) { const int n = (lane >> 3) + 8 * j; const LAS float* s = scr + (16 * c) * 33 + n;
        int o[4];
#pragma unroll
        for (int q = 0; q < 4; ++q) { int w = 0; w = __builtin_amdgcn_cvt_pk_fp8_f32(s[(4 * q) * 33] * WEIN_SCALE, s[(4 * q + 1) * 33] * WEIN_SCALE, w, false);
            w = __builtin_amdgcn_cvt_pk_fp8_f32(s[(4 * q + 2) * 33] * WEIN_SCALE, s[(4 * q + 3) * 33] * WEIN_SCALE, w, true); o[q] = w; }
        const int nn = n0 + n; const int drow = (ROWMODE == 0) ? nn : ((nn < 1024) ? (256 * (nn >> 7) + (nn & 127)) : (256 * ((nn - 1024) >> 7) + 128 + ((nn - 1024) & 127)));
        *(u32x4*)(WT + (size_t)drow * 1024 + k0 + 16 * c) = (u32x4){(unsigned)o[0], (unsigned)o[1], (unsigned)o[2], (unsigned)o[3]}; }
    LDS_WAIT();
}
template <int ROWMODE>
__device__ __forceinline__ void tr_job(int item, const float* src, int K, int N, bf16_t* dst, size_t dst_bstride, int dst_ld, int dst_off, LAS float* scr, int lane) {
    const int nnb = N / 32, nkb = K / 64; const int nb = item % nnb; const int r = item / nnb; const int kb = r % nkb; const int bt = r / nkb;
    tr_item<ROWMODE>(src + (size_t)bt * K * N, N, dst + (size_t)bt * dst_bstride, dst_ld, dst_off, 64 * kb, 32 * nb, scr, lane);
}

constexpr int CONV_Q1 = 5, CONV_Q2 = 6;
constexpr int CONV_ITEMS_L = NE * 8 * 64 + NE * 8 * 32, CONV_CHUNKS_L = CONV_ITEMS_L / 8;
__device__ __forceinline__ void conv_expert_item(const Args& a, unsigned char* ws, int l, int r, LAS float* scr, int lane) {
    if (r < NE * 8 * 64) { const int nb = r % 64, r2 = r / 64, kb = r2 % 8, bt = l * NE + r2 / 8;
        tr_item_fp8<1>(a.in[I_WEIN] + (size_t)bt * 1024 * 2048, 2048, (unsigned char*)(ws + WS_WEIN) + (size_t)bt * 2048 * 1024, 128 * kb, 32 * nb, scr, lane); }
    else { r -= NE * 8 * 64; const int nb = r % 32, r2 = r / 32, kb = r2 % 8, bt = l * NE + r2 / 8;
        tr_item_fp8<0>(a.in[I_WEOUT] + (size_t)bt * 1024 * 1024, 1024, (unsigned char*)(ws + WS_WEOUT) + (size_t)bt * 1024 * 1024, 128 * kb, 32 * nb, scr, lane); }
}
__device__ __forceinline__ void conv_drain(const Args& a, int l, int budget, LAS unsigned char* lds, const int wv) {
    asm volatile("" : "+s"(lds));
    int tid_ = tid_of(wv); asm volatile("" : "+v"(tid_)); const int tid = tid_, lane = tid & 63;
    unsigned char* ws = opaque_ptr(a.ws); unsigned* head = (unsigned*)(ws + WS_CTL) + CW_CONVQ + 64 * l;
    LAS float* scr = (LAS float*)(lds + wv * 16896); LAS int* slot = (LAS int*)(lds + LDS_BYTES - 512);
    for (;;) {
        if (budget == 0) break;
        __syncthreads();
        if (tid == 0) *slot = (int)__hip_atomic_fetch_add(head, 1u, __ATOMIC_RELAXED, __HIP_MEMORY_SCOPE_AGENT);
        __syncthreads();
        const int c = __builtin_amdgcn_readfirstlane(*slot);
        if (c >= CONV_CHUNKS_L) break;
        conv_expert_item(a, ws, l, c * 8 + wv, scr, lane);
        if (budget > 0) --budget;
    }
    __syncthreads();
}
__device__ __forceinline__ void phase_prologue(const Args& a, LAS unsigned char* lds, const int wv) {
    asm volatile("" : "+s"(lds));
    int tid_ = tid_of(wv); asm volatile("" : "+v"(tid_)); const int tid = tid_, lane = tid & 63, wave = __builtin_amdgcn_readfirstlane(tid >> 6);
    const int G = gridDim.x;
    unsigned char* ws = opaque_ptr(a.ws); const int bid = opaque_bid();
    {
        LAS float* cact = (LAS float*)lds;
        LAS float* red = (LAS float*)(lds + 32768);
        for (int i = tid; i < NBATCH * D; i += NTHREADS) { const float v = a.in[I_C][i]; cact[i] = v * sigmoidf_(v); }
        __syncthreads();
        float* mod = (float*)(ws + WS_MOD);
        for (int u = bid; u < DEPTH * 96; u += G) {
            const int l = u / 96, cg = u % 96; const int n = cg * 64 + lane;
            const float* w = a.in[I_WADA] + (size_t)l * D * 6144 + n;
            float acc[8] = {0.f, 0.f, 0.f, 0.f, 0.f, 0.f, 0.f, 0.f};
            const int kb = wave * 128;
#pragma unroll 8
            for (int k = 0; k < 128; ++k) { const float wv = w[(size_t)(kb + k) * 6144];
#pragma unroll
                for (int b = 0; b < 8; ++b) acc[b] += cact[b * D + kb + k] * wv; }
#pragma unroll
            for (int b = 0; b < 8; ++b) red[(wave * 8 + b) * 64 + lane] = acc[b];
            __syncthreads();
            { const int b = tid >> 6; float s = 0.f;
#pragma unroll
              for (int w8 = 0; w8 < 8; ++w8) s += red[(w8 * 8 + b) * 64 + lane];
              mod[((size_t)l * NBATCH + b) * 6144 + n] = s + a.in[I_BADA][(size_t)l * 6144 + n]; }
            __syncthreads();
        }
    }
#if Z_I8
    {
        LAS float* tile = (LAS float*)lds; LAS float* red = (LAS float*)(lds + 1024 * 33 * 4);
        signed char* w8 = (signed char*)(ws + WS_WIN); float* wsc = (float*)(ws + WS_WINSC);
        __syncthreads();
        for (int u = bid; u < DEPTH * (NZ / 32); u += G) {
            const int l = u / (NZ / 32), n0 = (u % (NZ / 32)) * 32; const float* W = a.in[I_WIN] + (size_t)l * D * NZ + n0;
            const int n = tid & 31, kr = tid >> 5;
#pragma unroll 1
            for (int k0 = 0; k0 < 1024; k0 += 256) { float tv[16];
#pragma unroll
                for (int i = 0; i < 16; ++i) tv[i] = W[(size_t)(k0 + 16 * i + kr) * NZ + n];
#pragma unroll
                for (int i = 0; i < 16; ++i) tile[(k0 + 16 * i + kr) * 33 + n] = tv[i]; }
            __syncthreads();
            { float am = 0.f;
#pragma unroll 8
              for (int i = 0; i < 64; ++i) am = fmaxf(am, fabsf(tile[(kr * 64 + i) * 33 + n]));
              red[kr * 32 + n] = am; }
            __syncthreads();
            if (tid < 32) { float am = 1e-30f;
#pragma unroll
                for (int q = 0; q < 16; ++q) am = fmaxf(am, red[q * 32 + tid]);
                red[512 + tid] = 127.0f / am; wsc[(size_t)l * NZ + n0 + tid] = am * (1.0f / 127.0f); }
            __syncthreads();
            { const float inv = red[512 + n]; signed char* dst = w8 + ((size_t)l * NZ + n0 + n) * D + kr * 64;
#pragma unroll
              for (int c = 0; c < 4; ++c) { int w4[4];
#pragma unroll
                  for (int q = 0; q < 4; ++q) { int pk = 0;
#pragma unroll
                      for (int e = 0; e < 4; ++e) pk |= (((int)rintf(tile[(kr * 64 + c * 16 + q * 4 + e) * 33 + n] * inv)) & 0xff) << (8 * e);
                      w4[q] = pk; }
                  *(u32x4*)(dst + 16 * c) = (u32x4){(unsigned)w4[0], (unsigned)w4[1], (unsigned)w4[2], (unsigned)w4[3]}; } }
            __syncthreads();
        }
    }
#endif
    {
        LAS float* scr = (LAS float*)(lds + wave * 16896);
        const int gw = bid * NWAVES + wave, NGW = G * NWAVES;
        constexpr int I_EIN = NE * 8 * 64, I_EOUT = NE * 8 * 32, I_WINI = Z_I8 ? 0 : DEPTH * (Z_FP8 ? 8 : 16) * 144, I_UPA = DEPTH * 16 * 32, I_UPB = DEPTH * 8 * 32, I_OUT = DEPTH * 16 * 32,
                      I_RGA = DEPTH * 8 * 2 * 4, I_RGX = I_RGA, I_POOL = DEPTH * 4 * 2 * 4;
        constexpr int NITEMS = I_EIN + I_EOUT + I_WINI + I_UPA + I_UPB + I_OUT + I_RGA + I_RGX + I_POOL;
        for (int it = gw; it < NITEMS; it += NGW) {
            int r = it;
            if (r < I_EIN) { const int nb = r % 64, r2 = r / 64, kb = r2 % 8, bt = r2 / 8;
                tr_item_fp8<1>(a.in[I_WEIN] + (size_t)bt * 1024 * 2048, 2048, (unsigned char*)(ws + WS_WEIN) + (size_t)bt * 2048 * 1024, 128 * kb, 32 * nb, scr, lane); continue; } r -= I_EIN;
            if (r < I_EOUT) { const int nb = r % 32, r2 = r / 32, kb = r2 % 8, bt = r2 / 8;
                tr_item_fp8<0>(a.in[I_WEOUT] + (size_t)bt * 1024 * 1024, 1024, (unsigned char*)(ws + WS_WEOUT) + (size_t)bt * 1024 * 1024, 128 * kb, 32 * nb, scr, lane); continue; } r -= I_EOUT;
#if Z_I8
#elif Z_FP8
            if (r < I_WINI) { const int nb = r % 144, r2 = r / 144, kb = r2 % 8, bt = r2 / 8;
                tr_item_fp8<0>(a.in[I_WIN] + (size_t)bt * 1024 * NZ, NZ, (unsigned char*)(ws + WS_WIN) + (size_t)bt * NZ * 1024, 128 * kb, 32 * nb, scr, lane); continue; } r -= I_WINI;
#else
            if (r < I_WINI) { tr_job<0>(r, a.in[I_WIN], 1024, NZ, (bf16_t*)(ws + WS_WIN), (size_t)NZ * 1024, 1024, 0, scr, lane); continue; } r -= I_WINI;
#endif
            if (r < I_UPA) { tr_job<0>(r, a.in[I_WUPA], 1024, 1024, (bf16_t*)(ws + WS_WCAT), (size_t)1024 * KCAT, KCAT, 512, scr, lane); continue; } r -= I_UPA;
            if (r < I_UPB) { tr_job<0>(r, a.in[I_WUPB], 512, 1024, (bf16_t*)(ws + WS_WCAT), (size_t)1024 * KCAT, KCAT, 0, scr, lane); continue; } r -= I_UPB;
            if (r < I_OUT) { tr_job<0>(r, a.in[I_WOUT], 1024, 1024, (bf16_t*)(ws + WS_WOUT), (size_t)1024 * 1024, 1024, 0, scr, lane); continue; } r -= I_OUT;
            if (r < I_RGA) { tr_job<0>(r, a.in[I_WRGA], 128, 128, (bf16_t*)(ws + WS_WRG), (size_t)256 * 128, 128, 0, scr, lane); continue; } r -= I_RGA;
            if (r < I_RGX) { tr_job<0>(r, a.in[I_WRGX], 128, 128, (bf16_t*)(ws + WS_WRG) + 128 * 128, (size_t)256 * 128, 128, 0, scr, lane); continue; } r -= I_RGX;
            tr_job<0>(r, a.in[I_WPOOL], 128, 128, (bf16_t*)(ws + WS_WPOOL), (size_t)128 * 128, 128, 0, scr, lane);
        }
    }
}

struct MoeTab { LAS int* cnt; LAS int* padstart; LAS int* tilestart; LAS int* tab; };
__device__ __forceinline__ MoeTab moe_tab_ptrs(LAS unsigned char* lds) { MoeTab t; t.cnt = (LAS int*)(lds + LDS_TAB); t.padstart = t.cnt + 32; t.tilestart = t.padstart + 40; t.tab = t.tilestart + 40; return t; }
__device__ __forceinline__ void moe_tables(const Args& a, int l, LAS unsigned char* lds, const int wv) {
    asm volatile("" : "+s"(lds));
    const MoeTab mt = moe_tab_ptrs(lds); int tid_ = tid_of(wv); asm volatile("" : "+v"(tid_)); const int tid = tid_;
    unsigned* ctl = (unsigned*)(opaque_ptr(a.ws) + WS_CTL);
    __syncthreads();
    if (tid < NE) mt.cnt[tid] = (int)__hip_atomic_load(ctl + CW_CNT + (l * NE + tid) * 16, __ATOMIC_RELAXED, __HIP_MEMORY_SCOPE_AGENT);
    __syncthreads();
    if (tid == 0) { int ps = 0, ts = 0; for (int e = 0; e < NE; ++e) { mt.padstart[e] = ps; mt.tilestart[e] = ts; const int nt = (mt.cnt[e] + 255) >> 8; ps += nt * 256; ts += nt; } mt.padstart[NE] = ps; mt.tilestart[NE] = ts; }
    __syncthreads();
    const int nMt = mt.tilestart[NE];
    for (int m = tid; m < nMt; m += NTHREADS) { int e = 0; for (int q = 1; q < NE; ++q) e = (mt.tilestart[q] <= m) ? q : e; mt.tab[m] = (e << 16) | (m - mt.tilestart[e]); }
    __syncthreads();
}
#ifndef MOE_WGM1
#define MOE_WGM1 4
#endif
#ifndef MOE_WGM2
#define MOE_WGM2 8
#endif
struct MoeSched1 {
    static constexpr bool DYN_A = true;
    const char* H; const char* W; const int* tokof; MoeTab mt; int nMt, G, c;
    __device__ __forceinline__ bool next(int i, pg8::Unit& u) const { int pm, pn; if (!pg8::order_map<MOE_WGM1>(i, G, c, nMt, 8, pm, pn)) return false;
        const int en = __builtin_amdgcn_readfirstlane(mt.tab[pm]); u.pm = pm; u.pn = pn; u.e = en >> 16; u.j = en & 0xffff;
        u.row0 = __builtin_amdgcn_readfirstlane(mt.padstart[u.e]) + 256 * u.j; u.rows = __builtin_amdgcn_readfirstlane(mt.cnt[u.e]) - 256 * u.j; return true; }
    __device__ __forceinline__ const char* a_ptr() const { return H; }
    __device__ __forceinline__ const char* b_ptr() const { return W; }
    __device__ __forceinline__ unsigned a_off(const pg8::Unit&) const { return 0u; }
    __device__ __forceinline__ unsigned b_off(const pg8::Unit& u) const { return ((unsigned)u.e * 2048u + (unsigned)u.pn * 256u) * 1024u; }
    __device__ __forceinline__ void a_voff(const pg8::Unit& u, unsigned (&v)[2][2], int wv) const {
        int tid = tid_of(wv); asm volatile("" : "+v"(tid));
        const int* tl = tokof + (size_t)u.e * T + 256 * u.j; const int rmax = u.rows - 1;
#pragma unroll
        for (int i = 0; i < 2; ++i) { int R, C; pg8::stage_rc(tid * 16 + i * 8192, R, C);
#pragma unroll
            for (int h = 0; h < 2; ++h) { int idx = h * 128 + R; idx = idx < rmax ? idx : rmax; v[h][i] = (unsigned)tl[idx] * 1024u + (unsigned)C * 2u; } }
    }
    __device__ __forceinline__ void a_dma(const pg8::Unit& u, LAS unsigned char* slots, int wv) const {
        const int tid = tid_of(wv); const int rmax = u.rows - 1;
        const __amdgpu_buffer_rsrc_t rs = __builtin_amdgcn_make_buffer_rsrc((void*)tokof, 0, 0xffffffff, 0x00020000);
        const unsigned so = (unsigned)(u.e * T + 256 * u.j) * 4u;
#pragma unroll
        for (int i = 0; i < 2; ++i) { int R, C; pg8::stage_rc(tid * 16 + i * 8192, R, C);
#pragma unroll
            for (int h = 0; h < 2; ++h) { int idx = h * 128 + R; idx = idx < rmax ? idx : rmax;
                __builtin_amdgcn_raw_ptr_buffer_load_lds(rs, (LAS void*)(slots + (h * 2 + i) * 2048 + wv * 256), 4, (unsigned)idx * 4u, so, 0, 0); } }
    }
    __device__ __forceinline__ void a_fetch(const LAS unsigned char* slots, int wv, unsigned (&q)[4]) const {
        const int tid = tid_of(wv); int R, C; pg8::stage_rc(tid * 16, R, C);
#pragma unroll
        for (int k = 0; k < 4; ++k) q[k] = *(const LAS unsigned*)(slots + k * 2048 + tid * 4) * 1024u + (unsigned)C * 2u;
    }
};
struct MoeSched2 {
    static constexpr bool DYN_A = false;
    const char* ACT; const char* W; MoeTab mt; int nMt, G, c;
    __device__ __forceinline__ bool next(int i, pg8::Unit& u) const { int pm, pn; if (!pg8::order_map<MOE_WGM2>(i, G, c, nMt, 4, pm, pn)) return false;
        const int en = __builtin_amdgcn_readfirstlane(mt.tab[pm]); u.pm = pm; u.pn = pn; u.e = en >> 16; u.j = en & 0xffff;
        u.row0 = __builtin_amdgcn_readfirstlane(mt.padstart[u.e]) + 256 * u.j; u.rows = __builtin_amdgcn_readfirstlane(mt.cnt[u.e]) - 256 * u.j; return true; }
    __device__ __forceinline__ const char* a_ptr() const { return ACT; }
    __device__ __forceinline__ const char* b_ptr() const { return W; }
    __device__ __forceinline__ unsigned a_off(const pg8::Unit& u) const { return (unsigned)u.row0 * 1024u; }
    __device__ __forceinline__ unsigned b_off(const pg8::Unit& u) const { return ((unsigned)u.e * 1024u + (unsigned)u.pn * 256u) * 1024u; }
    __device__ __forceinline__ void a_voff(const pg8::Unit&, unsigned (&v)[2][2], int wv) const {
        int tid = tid_of(wv); asm volatile("" : "+v"(tid));
#pragma unroll
        for (int i = 0; i < 2; ++i) { int R, C; pg8::stage_rc(tid * 16 + i * 8192, R, C);
#pragma unroll
            for (int h = 0; h < 2; ++h) v[h][i] = (unsigned)((h * 128 + R) * 512 + C) * 2u; }
    }
};

__device__ __forceinline__ void phase_a(const Args& a, int l, LAS unsigned char* lds, bool dry, const int wv) {
    asm volatile("" : "+s"(lds));
    int tid_ = tid_of(wv); asm volatile("" : "+v"(tid_)); const int tid = tid_, lane = tid & 63, wave = __builtin_amdgcn_readfirstlane(tid >> 6);
    const int G = gridDim.x; unsigned char* ws = opaque_ptr(a.ws); const int bid = opaque_bid();
    const float* mod = (const float*)(ws + WS_MOD);
    bf16_t* xres = (bf16_t*)(ws + WS_XRES); bf16_t* xout = dry ? (bf16_t*)(ws + WS_Z) : xres;
    if (l < DEPTH) {
        LAS float* red = (LAS float*)lds;
        for (int wu = bid; wu < NBATCH * NE; wu += G) { const int b2 = wu >> 5, e = wu & 31;
            const float* sh2 = mod + ((size_t)l * NBATCH + b2) * 6144 + 3 * D; const float* wr = a.in[I_WROUTER] + (size_t)l * D * NE;
            float sm = sh2[tid] * wr[tid * NE + e] + sh2[tid + 512] * wr[(tid + 512) * NE + e];
            sm = wave_sum(sm, lane);
            __syncthreads();
            if (lane == 0) red[wave] = sm;
            __syncthreads();
            if (tid == 0) { float t = a.in[I_BROUTER][l * NE + e]; for (int q = 0; q < 8; ++q) t += red[q]; ((float*)(ws + WS_CB))[(l * NBATCH + b2) * NE + e] = t; }
        }
        __syncthreads();
    }
    if (l < DEPTH) {
        for (int wu = bid; wu < NBATCH * 32; wu += G) { const int b2 = wu >> 5, part = wu & 31;
            const float* n2 = a.in[I_N2G] + (size_t)l * D; const float* sc2 = mod + ((size_t)l * NBATCH + b2) * 6144 + 4 * D; const float* wr2 = a.in[I_WROUTER] + (size_t)l * D * NE;
            bf16_t* wrb = (bf16_t*)(ws + WS_WRB) + (size_t)b2 * 2 * NE * D;
#pragma unroll
            for (int r = 0; r < 2; ++r) { const int idx = part * 1024 + r * NTHREADS + tid; const int ee = idx & 31, k = idx >> 5;
                const float w = wr2[idx] * (n2[k] * (1.0f + sc2[k])); const unsigned hi = cvt_pk_bf16(w, 0.f) & 0xffffu; const unsigned lo = cvt_pk_bf16(w - bflo(hi), 0.f) & 0xffffu;
                wrb[(size_t)ee * D + k] = (bf16_t)hi; wrb[(size_t)(NE + ee) * D + k] = (bf16_t)lo; } }
    }
    if (l > 0) moe_tables(a, (l - 1) + DEPTH * (REPN(7) - 1), lds, wv);
    const MoeTab mt = moe_tab_ptrs(lds);
    const int* slotinfo = (const int*)(ws + WS_SLOTINFO); const float* wgt = (const float*)(ws + WS_WGT);
    const unsigned char* outb = (const unsigned char*)(ws + WS_OUTB); const float* outsc = (const float*)(ws + WS_OUTSC);
    unsigned char* hb = (unsigned char*)(ws + WS_H);
    for (int chunk = bid; chunk < T / 128; chunk += G) {
        const int rowb = chunk * 128 + wave * 16; const int b = rowb / SEQ;
        const float* xin = a.in[I_X] + (size_t)rowb * D; const bf16_t* xinb = xres + (size_t)rowb * D;
        f32x4 xv[2][4]; int4 si[4]; f32x4 wv[4]; unsigned gv[2][4][4];
#define PA_SX(r, q) do { if ((r) < 16) { _Pragma("unroll") for (int j = 0; j < 4; ++j) { if (l == 0) xv[(q) & 1][j] = *(const f32x4*)(xin + (size_t)(r) * D + 4 * lane + 256 * j); \
            else { const f32x2 t_ = *(const f32x2*)(xinb + (size_t)(r) * D + 4 * lane + 256 * j); xv[(q) & 1][j].x = t_.x; xv[(q) & 1][j].y = t_.y; } } } } while (0)
#define PA_S0(r, q) do { if ((r) < 16 && l > 0) { si[(q) & 3] = *(const int4*)(slotinfo + (size_t)(rowb + (r)) * 4); wv[(q) & 3] = *(const f32x4*)(wgt + (size_t)(rowb + (r)) * 4); } } while (0)
#define PA_S1(r, q) do { if ((r) < 16 && l > 0) { const int sl_[4] = {si[(q) & 3].x, si[(q) & 3].y, si[(q) & 3].z, si[(q) & 3].w}; \
            _Pragma("unroll") for (int kk = 0; kk < 4; ++kk) { const int e_ = sl_[kk] >> 24, li_ = sl_[kk] & 0xffffff; const size_t slot_ = (size_t)(mt.padstart[e_] + li_); const unsigned char* orow = outb + slot_ * D + 4 * lane; \
                _Pragma("unroll") for (int j = 0; j < 4; ++j) gv[(q) & 1][kk][j] = *(const unsigned*)(orow + 256 * j); } } } while (0)
        f32x4 gmv[4], shv[4], g2v[4];
#pragma unroll
        for (int j = 0; j < 4; ++j) {
            if (l < DEPTH) { const float* ng_ = a.in[I_N1G] + (size_t)l * D + 4 * lane + 256 * j; const float* mb_ = mod + ((size_t)l * NBATCH + b) * 6144 + 4 * lane + 256 * j;
                gmv[j] = *(const f32x4*)ng_ * (1.0f + *(const f32x4*)(mb_ + D)); shv[j] = *(const f32x4*)mb_; }
            else { gmv[j] = *(const f32x4*)(a.in[I_FINALG] + 4 * lane + 256 * j); shv[j] = (f32x4){0.f, 0.f, 0.f, 0.f}; }
            g2v[j] = (l > 0) ? *(const f32x4*)(mod + ((size_t)(l - 1) * NBATCH + b) * 6144 + 5 * D + 4 * lane + 256 * j) : (f32x4){0.f, 0.f, 0.f, 0.f}; }
        PA_S0(0, 0); PA_S0(1, 1); PA_SX(0, 0); PA_S1(0, 0);
#pragma unroll 1
        for (int i0 = 0; i0 < 16; i0 += 4) {
#pragma unroll
          for (int ii = 0; ii < 4; ++ii) {
            const int i = i0 + ii; const int row = rowb + i;
            PA_S0(i + 2, ii + 2); PA_SX(i + 1, ii + 1); PA_S1(i + 1, ii + 1);
            f32x4 v[4];
#pragma unroll
            for (int j = 0; j < 4; ++j) { v[j] = xv[ii & 1][j];
                if (l > 0) { const unsigned p0 = __float_as_uint(v[j].x), p1 = __float_as_uint(v[j].y); v[j] = (f32x4){bflo(p0), bfhi(p0), bflo(p1), bfhi(p1)}; } }
            if (l > 0) {
                f32x4 y[4];
#pragma unroll
                for (int j = 0; j < 4; ++j) y[j] = (f32x4){0.f, 0.f, 0.f, 0.f};
#pragma unroll
                for (int kk = 0; kk < 4; ++kk) { const float wk = wv[ii][kk] * (1.0f / OUT_FP8_SCALE);
#pragma unroll
                    for (int j = 0; j < 4; ++j) { const int p = (int)gv[ii & 1][kk][j];
                        const auto lo = __builtin_amdgcn_cvt_pk_f32_fp8(p, false), hi = __builtin_amdgcn_cvt_pk_f32_fp8(p, true);
                        y[j] += wk * (f32x4){lo[0], lo[1], hi[0], hi[1]}; } }
#pragma unroll
                for (int j = 0; j < 4; ++j) v[j] += g2v[j] * y[j];
            }
            if (l < DEPTH) {
#pragma unroll
                for (int j = 0; j < 4; ++j) { u32x2 p; p.x = cvt_pk_bf16(v[j].x, v[j].y); p.y = cvt_pk_bf16(v[j].z, v[j].w); *(u32x2*)(xout + (size_t)row * D + 4 * lane + 256 * j) = p; }
            }
            float ss = 0.f;
#pragma unroll
            for (int j = 0; j < 4; ++j) ss += (v[j].x * v[j].x + v[j].y * v[j].y) + (v[j].z * v[j].z + v[j].w * v[j].w);
            const float rinv = __builtin_amdgcn_rsqf(wave_sum(ss, lane) * (1.0f / D) + NORM_EPS);
            if (l < DEPTH) {
                f32x4 hq[4]; (void)hq;
#pragma unroll
                for (int j = 0; j < 4; ++j) {
                    const f32x4 h = (v[j] * rinv) * gmv[j] + shv[j];
#if Z_I8
                    hq[j] = h; }
                {   float am = 0.f;
#pragma unroll
                    for (int j = 0; j < 4; ++j) am = fmaxf(fmaxf(fmaxf(fabsf(hq[j].x), fabsf(hq[j].y)), fmaxf(fabsf(hq[j].z), fabsf(hq[j].w))), am);
                    am = wave_max(am);
                    am = fmaxf(am, 1e-20f); const float inv = 127.0f / am;
                    if (lane == 0) ((float*)(ws + WS_HSC))[row] = am * (1.0f / 127.0f);
#pragma unroll
                    for (int j = 0; j < 4; ++j) { const int q0 = (int)rintf(hq[j].x * inv), q1 = (int)rintf(hq[j].y * inv), q2 = (int)rintf(hq[j].z * inv), q3 = (int)rintf(hq[j].w * inv);
                        *(int*)(hb + (size_t)row * D + 4 * lane + 256 * j) = (q0 & 0xff) | ((q1 & 0xff) << 8) | ((q2 & 0xff) << 16) | ((q3 & 0xff) << 24); }
                }
#elif Z_FP8
                    int p = 0; p = __builtin_amdgcn_cvt_pk_fp8_f32(h.x, h.y, p, false); p = __builtin_amdgcn_cvt_pk_fp8_f32(h.z, h.w, p, true);
                    *(int*)(hb + (size_t)row * D + 4 * lane + 256 * j) = p; }
#else
                    u32x2 p; p.x = cvt_pk_bf16(h.x, h.y); p.y = cvt_pk_bf16(h.z, h.w); *(u32x2*)((bf16_t*)hb + (size_t)row * D + 4 * lane + 256 * j) = p; }
#endif
            } else {
#pragma unroll
                for (int j = 0; j < 4; ++j) *(f32x4*)(a.out + (size_t)row * D + 4 * lane + 256 * j) = v[j] * rinv * gmv[j];
            }
          }
        }
#undef PA_S0
#undef PA_SX
#undef PA_S1
    }
}

constexpr int H_WLDS = 20480, H_WROW = 2048 + 16;
static_assert(H_WLDS + 64 * H_WROW <= LDS_BYTES - 512, "phase H LDS map");
__device__ __forceinline__ void phase_h(const Args& a, int l, int cset, LAS unsigned char* lds, const int wv) {
    asm volatile("" : "+s"(lds));
    int tid_ = tid_of(wv); asm volatile("" : "+v"(tid_)); const int tid = tid_, lane = tid & 63, wave = __builtin_amdgcn_readfirstlane(tid >> 6);
    const int G = gridDim.x; unsigned char* ws = opaque_ptr(a.ws); const int bid = opaque_bid();
    const float* mod = (const float*)(ws + WS_MOD); const bf16_t* xres = (const bf16_t*)(ws + WS_XRES);
    unsigned char* h8 = (unsigned char*)(ws + WS_H);
    LAS float* rinvs = (LAS float*)lds;
    LAS float* lgt = (LAS float*)(lds + 1024);
    LAS int* hist = (LAS int*)(lds + 1024 + 8 * 16 * 33 * 4);
    LAS int* base = hist + 32;
    unsigned* ctl = (unsigned*)(ws + WS_CTL);
    const float* ng = a.in[I_N2G] + (size_t)l * D;
    const float* cbv = (const float*)(ws + WS_CB);
    int* tokof = (int*)(ws + WS_TOKOF); int* slotinfo = (int*)(ws + WS_SLOTINFO); float* wgt = (float*)(ws + WS_WGT);
    for (int chunk = bid; chunk < T / 128; chunk += G) {
        const int row0 = chunk * 128 + wave * 16; const int b = row0 / SEQ;
        const float* mb = mod + ((size_t)l * NBATCH + b) * 6144 + 3 * D;
        if (tid < 32) hist[tid] = 0;
        {
            const __amdgpu_buffer_rsrc_t rw = __builtin_amdgcn_make_buffer_rsrc((void*)((const bf16_t*)(ws + WS_WRB) + (size_t)b * 2 * NE * D), 0, 0xffffffff, 0x00020000);
#pragma unroll
            for (int k = 0; k < 16; ++k) { const int wrow = wave * 8 + (k >> 1), half = k & 1;
                __builtin_amdgcn_raw_ptr_buffer_load_lds(rw, (LAS void*)(lds + H_WLDS + wrow * H_WROW + half * 1024), 16, (unsigned)lane * 16u, (unsigned)(wrow * 2048 + half * 1024), 0, 0); }
        }
        f32x4 gm2[4], sh2[4];
#pragma unroll
        for (int j = 0; j < 4; ++j) { gm2[j] = *(const f32x4*)(ng + 4 * lane + 256 * j) * (1.0f + *(const f32x4*)(mb + D + 4 * lane + 256 * j)); sh2[j] = *(const f32x4*)(mb + 4 * lane + 256 * j); }
        u32x2 xq[3][4];
#pragma unroll
        for (int r = 0; r < 2; ++r)
#pragma unroll
            for (int j = 0; j < 4; ++j) xq[r][j] = *(const u32x2*)(xres + (size_t)(row0 + r) * D + 4 * lane + 256 * j);
#pragma unroll
        for (int i = 0; i < 16; ++i) {
            const int row = row0 + i;
            if (i + 2 < 16) {
#pragma unroll
                for (int j = 0; j < 4; ++j) xq[(i + 2) % 3][j] = *(const u32x2*)(xres + (size_t)(row + 2) * D + 4 * lane + 256 * j); }
            f32x4 v[4]; float ss = 0.f;
#pragma unroll
            for (int j = 0; j < 4; ++j) { const u32x2 p = xq[i % 3][j]; v[j] = (f32x4){bflo(p.x), bfhi(p.x), bflo(p.y), bfhi(p.y)}; ss += (v[j].x * v[j].x + v[j].y * v[j].y) + (v[j].z * v[j].z + v[j].w * v[j].w); }
            const float rinv = __builtin_amdgcn_rsqf(wave_sum(ss, lane) * (1.0f / D) + NORM_EPS);
            if (lane == 0) rinvs[wave * 16 + i] = rinv;
#pragma unroll
            for (int j = 0; j < 4; ++j) {
                const f32x4 h = (v[j] * rinv) * gm2[j] + sh2[j];
                int p = 0; p = __builtin_amdgcn_cvt_pk_fp8_f32(h.x, h.y, p, false); p = __builtin_amdgcn_cvt_pk_fp8_f32(h.z, h.w, p, true);
                *(int*)(h8 + (size_t)row * D + 4 * lane + 256 * j) = p; }
        }
        {
            const int ri = lane & 15, q = lane >> 4;
            const bf16_t* xr = xres + (size_t)(row0 + ri) * D + 8 * q;
            bf16x8 axs[32];
#pragma unroll
            for (int kb = 0; kb < 32; ++kb) axs[kb] = *(const bf16x8*)(xr + 32 * kb);
            asm volatile("s_waitcnt vmcnt(0)" ::: "memory");
            __syncthreads();
            const LAS unsigned char* wh = lds + H_WLDS + ri * H_WROW + 16 * q; const LAS unsigned char* wl = wh + NE * H_WROW;
            f32x4 acc0 = {0.f, 0.f, 0.f, 0.f}, acc1 = {0.f, 0.f, 0.f, 0.f};
#pragma unroll
            for (int kb = 0; kb < 32; ++kb) {
                const bf16x8 ax = axs[kb];
                const bf16x8 bh0 = *(const LAS bf16x8*)(wh + 64 * kb), bl0 = *(const LAS bf16x8*)(wl + 64 * kb), bh1 = *(const LAS bf16x8*)(wh + 16 * H_WROW + 64 * kb), bl1 = *(const LAS bf16x8*)(wl + 16 * H_WROW + 64 * kb);
                acc0 = __builtin_amdgcn_mfma_f32_16x16x32_bf16(ax, bh0, acc0, 0, 0, 0); acc0 = __builtin_amdgcn_mfma_f32_16x16x32_bf16(ax, bl0, acc0, 0, 0, 0);
                acc1 = __builtin_amdgcn_mfma_f32_16x16x32_bf16(ax, bh1, acc1, 0, 0, 0); acc1 = __builtin_amdgcn_mfma_f32_16x16x32_bf16(ax, bl1, acc1, 0, 0, 0);
            }
            LDS_WAIT();
            const float c0 = cbv[(l * NBATCH + b) * NE + ri], c1 = cbv[(l * NBATCH + b) * NE + 16 + ri];
#pragma unroll
            for (int r = 0; r < 4; ++r) { const int ti = 4 * q + r; const float rv = rinvs[wave * 16 + ti];
                lgt[(wave * 16 + ti) * 33 + ri] = acc0[r] * rv + c0; lgt[(wave * 16 + ti) * 33 + 16 + ri] = acc1[r] * rv + c1; }
        }
        __syncthreads();
        int se[4] = {0, 0, 0, 0}; float sw[4] = {0.f, 0.f, 0.f, 0.f}; int rk[4] = {0, 0, 0, 0};
        if (lane < 16) {
            float v[32];
#pragma unroll
            for (int e = 0; e < 32; ++e) v[e] = lgt[(wave * 16 + lane) * 33 + e];
            float sv[4];
#pragma unroll
            for (int kk = 0; kk < 4; ++kk) { float best = v[0]; int bi = 0;
#pragma unroll
                for (int e = 1; e < 32; ++e) { if (v[e] > best) { best = v[e]; bi = e; } }
                sv[kk] = best; se[kk] = bi;
#pragma unroll
                for (int e = 0; e < 32; ++e) v[e] = (e == bi) ? -3.0e38f : v[e]; }
            float den = 0.f;
#pragma unroll
            for (int kk = 0; kk < 4; ++kk) { sw[kk] = __expf(sv[kk] - sv[0]); den += sw[kk]; }
            const float inv = 1.0f / den;
#pragma unroll
            for (int kk = 0; kk < 4; ++kk) { sw[kk] *= inv; rk[kk] = __hip_atomic_fetch_add(hist + se[kk], 1, __ATOMIC_RELAXED, __HIP_MEMORY_SCOPE_WORKGROUP); }
        }
        __syncthreads();
        if (tid < 32) base[tid] = (int)__hip_atomic_fetch_add(ctl + CW_CNT + (cset * NE + tid) * 16, (unsigned)hist[tid], __ATOMIC_RELAXED, __HIP_MEMORY_SCOPE_AGENT);
        __syncthreads();
        if (lane < 16) {
            const int row = row0 + lane; int si[4];
#pragma unroll
            for (int kk = 0; kk < 4; ++kk) { const int li = base[se[kk]] + rk[kk]; tokof[(size_t)se[kk] * T + li] = row; si[kk] = (se[kk] << 24) | li; }
            *(int4*)(slotinfo + (size_t)row * 4) = make_int4(si[0], si[1], si[2], si[3]);
            *(f32x4*)(wgt + (size_t)row * 4) = (f32x4){sw[0], sw[1], sw[2], sw[3]};
        }
        __syncthreads();
    }
}

constexpr int ZT_STRIDE = 528;
template <int NR>
__device__ __forceinline__ void stage_z8(const unsigned char* z8, const float* zs, int b, int p_first, int tile, LAS unsigned char* zt, int tid) {
    constexpr int NP = NR * 16, NK = (NP + NTHREADS - 1) / NTHREADS;
    u32x4 q[NK]; float sc[NK];
    const __amdgpu_buffer_rsrc_t rz = __builtin_amdgcn_make_buffer_rsrc((void*)z8, 0, 0xffffffff, 0x00020000), rq = __builtin_amdgcn_make_buffer_rsrc((void*)zs, 0, 0xffffffff, 0x00020000);
#pragma unroll
    for (int k = 0; k < NK; ++k) { int idx = tid + NTHREADS * k; idx = idx < NP ? idx : NP - 1; const int r = idx >> 4, pc = idx & 15; const int p = p_first + r; const unsigned row = (unsigned)(b * SEQ + (p < 0 ? 0 : p));
        q[k] = __builtin_bit_cast(u32x4, __builtin_amdgcn_raw_buffer_load_b128(rz, (int)(row * 2560u + (unsigned)(tile * 256 + pc * 16)), 0, 0));
#if Z_OUT_FP8
        (void)rq; sc[k] = p < 0 ? 0.f : (1.0f / Z_FP8_SCALE); }
#else
        const float t = __builtin_bit_cast(float, __builtin_amdgcn_raw_buffer_load_b32(rq, (int)((row * 40u + (unsigned)(tile * 4 + (pc >> 2))) * 4u), 0, 0)); sc[k] = p < 0 ? 0.f : t; }
#endif
#pragma unroll
    for (int k = 0; k < NK; ++k) { int idx = tid + NTHREADS * k; idx = idx < NP ? idx : NP - 1; const int r = idx >> 4, pc = idx & 15; float m128 = -128.0f; asm volatile("" : "+v"(m128));
        const float sk = sc[k], of = m128 * sk;
        const unsigned w[4] = {q[k].x, q[k].y, q[k].z, q[k].w}; unsigned o[8];
#pragma unroll
#if Z_OUT_FP8
        for (int d = 0; d < 4; ++d) { (void)of; const auto lo = __builtin_amdgcn_cvt_pk_f32_fp8((int)w[d], false), hi = __builtin_amdgcn_cvt_pk_f32_fp8((int)w[d], true);
            o[2 * d] = cvt_pk_bf16(lo[0] * sk, lo[1] * sk); o[2 * d + 1] = cvt_pk_bf16(hi[0] * sk, hi[1] * sk); }
#else
        for (int d = 0; d < 4; ++d) { o[2 * d] = cvt_pk_bf16((float)(w[d] & 0xffu) * sk + of, (float)((w[d] >> 8) & 0xffu) * sk + of); o[2 * d + 1] = cvt_pk_bf16((float)((w[d] >> 16) & 0xffu) * sk + of, (float)(w[d] >> 24) * sk + of); }
#endif
        *(LAS u32x4*)(zt + r * ZT_STRIDE + pc * 32) = (u32x4){o[0], o[1], o[2], o[3]}; *(LAS u32x4*)(zt + r * ZT_STRIDE + pc * 32 + 16) = (u32x4){o[4], o[5], o[6], o[7]};
        asm volatile("" ::: "memory"); }
}
__device__ __forceinline__ void lru_unit(const Args& a, int l, int u, LAS unsigned char* lds, const int wv) {
    asm volatile("" : "+s"(lds));
    int tid_ = tid_of(wv); asm volatile("" : "+v"(tid_)); const int tid = tid_, lane = tid & 63, wave = __builtin_amdgcn_readfirstlane(tid >> 6);
    unsigned char* ws = opaque_ptr(a.ws);
    const unsigned char* z8 = (const unsigned char*)(ws + WS_Z); const float* zs = (const float*)(ws + WS_ZS);
    LAS unsigned char* zt = lds; LAS unsigned char* xc = lds + 131 * ZT_STRIDE;
    const int hp = u & 3, b = (u >> 2) & 7, s = u >> 5;
    const int t0 = b * SEQ + s * 128, p0 = s * 128;
    stage_z8<131>(z8, zs, b, p0 - 3, hp, zt, tid);
    __syncthreads();
    {
        const int o = tid & 31, rb = tid >> 5; const int ch0 = hp * 256 + o * 8;
        float cw[4][8], cbias[8];
#pragma unroll
        for (int k = 0; k < 4; ++k) { const f32x4 w0 = *(const f32x4*)(a.in[I_CONVW] + ((size_t)l * 4 + k) * D + ch0), w1 = *(const f32x4*)(a.in[I_CONVW] + ((size_t)l * 4 + k) * D + ch0 + 4);
            cw[k][0] = w0.x; cw[k][1] = w0.y; cw[k][2] = w0.z; cw[k][3] = w0.w; cw[k][4] = w1.x; cw[k][5] = w1.y; cw[k][6] = w1.z; cw[k][7] = w1.w; }
        { const f32x4 b0 = *(const f32x4*)(a.in[I_CONVB] + (size_t)l * D + ch0), b1 = *(const f32x4*)(a.in[I_CONVB] + (size_t)l * D + ch0 + 4);
          cbias[0] = b0.x; cbias[1] = b0.y; cbias[2] = b0.z; cbias[3] = b0.w; cbias[4] = b1.x; cbias[5] = b1.y; cbias[6] = b1.z; cbias[7] = b1.w; }
#pragma unroll 2
        for (int i = 0; i < 8; ++i) { const int r = rb + 16 * i; float acc[8];
#pragma unroll
            for (int j = 0; j < 8; ++j) acc[j] = cbias[j];
#pragma unroll
            for (int k = 0; k < 4; ++k) { const u32x4 v = *(const LAS u32x4*)(zt + (r + k) * ZT_STRIDE + o * 16);
                acc[0] += cw[k][0] * bflo(v.x); acc[1] += cw[k][1] * bfhi(v.x); acc[2] += cw[k][2] * bflo(v.y); acc[3] += cw[k][3] * bfhi(v.y);
                acc[4] += cw[k][4] * bflo(v.z); acc[5] += cw[k][5] * bfhi(v.z); acc[6] += cw[k][6] * bflo(v.w); acc[7] += cw[k][7] * bfhi(v.w); }
            u32x4 w; w.x = cvt_pk_bf16(acc[0], acc[1]); w.y = cvt_pk_bf16(acc[2], acc[3]); w.z = cvt_pk_bf16(acc[4], acc[5]); w.w = cvt_pk_bf16(acc[6], acc[7]);
            *(LAS u32x4*)(xc + r * ZT_STRIDE + o * 16) = w; }
    }
    __syncthreads();
    {
        const __amdgpu_buffer_rsrc_t rz = __builtin_amdgcn_make_buffer_rsrc((void*)(z8 + (size_t)t0 * 2560 + (4 + hp) * 256), 0, 0xffffffff, 0x00020000);
        const unsigned vo = (unsigned)(lane >> 4) * 2560u + (unsigned)(lane & 15) * 16u;
#pragma unroll
        for (int k = 0; k < 4; ++k) __builtin_amdgcn_raw_ptr_buffer_load_lds(rz, (LAS void*)(zt + (wave * 4 + k) * 1024), 16, vo, (unsigned)((wave * 4 + k) * 4 * 2560), 0, 0);
#if !Z_OUT_FP8
        const __amdgpu_buffer_rsrc_t rq = __builtin_amdgcn_make_buffer_rsrc((void*)(zs + (size_t)t0 * 40 + (4 + hp) * 4), 0, 0xffffffff, 0x00020000);
        __builtin_amdgcn_raw_ptr_buffer_load_lds(rq, (LAS void*)(zt + 32768 + wave * 256), 4, (unsigned)(tid >> 2) * 160u + (unsigned)(tid & 3) * 4u, 0, 0, 0);
#endif
    }
    {
        const int hsel = wave >> 2, wc = wave & 3, head = 2 * hp + hsel, c31 = lane & 31, hh = lane >> 5;
        const int ch = head * 128 + 32 * wc + c31;
        const bf16_t* wb = (const bf16_t*)(ws + WS_WRG) + ((size_t)(l * 8 + head) * 256 + 32 * wc + c31) * 128 + 8 * hh;
        bf16x8 Ba[8], Bi[8];
#pragma unroll
        for (int ks = 0; ks < 8; ++ks) { Ba[ks] = *(const bf16x8*)(wb + 16 * ks); Bi[ks] = *(const bf16x8*)(wb + 128 * 128 + 16 * ks); }
        const float ba = a.in[I_BRGA][(size_t)l * D + ch], bx = a.in[I_BRGX][(size_t)l * D + ch];
        const float lam = a.in[I_LAM][(size_t)l * D + ch];
        const float sp8 = 8.0f * log1pf(__expf(-lam));
        typedef __attribute__((address_space(1))) unsigned long long gu64;
        gu64* aggq = (gu64*)(ws + WS_AGG) + ((size_t)l * NBATCH * 32 + (size_t)b * 32) * D + ch;
        float Pr = 1.f, Hr = 0.f;
        unsigned hpk[64];
#pragma unroll
        for (int rb = 0; rb < 4; ++rb) {
            f32x16 aa, ai;
#pragma unroll
            for (int r = 0; r < 16; ++r) { aa[r] = 0.f; ai[r] = 0.f; }
            const LAS unsigned char* ap = xc + (32 * rb + c31) * ZT_STRIDE + (hsel * 128 + 8 * hh) * 2;
#pragma unroll
            for (int ks = 0; ks < 8; ++ks) { const bf16x8 A = *(const LAS bf16x8*)(ap + 32 * ks);
                aa = __builtin_amdgcn_mfma_f32_32x32x16_bf16(A, Ba[ks], aa, 0, 0, 0); ai = __builtin_amdgcn_mfma_f32_32x32x16_bf16(A, Bi[ks], ai, 0, 0, 0); }
            const LAS unsigned char* xp = xc + (32 * rb + 4 * hh) * ZT_STRIDE + (hsel * 128 + 32 * wc + c31) * 2;
#pragma unroll
            for (int q = 0; q < 4; ++q) {
                float p = 1.f, h = 0.f, hl[4], pl[4];
#pragma unroll
                for (int r3 = 0; r3 < 4; ++r3) { const int reg = 4 * q + r3;
                    const float xcv = bf1(*(const LAS bf16_t*)(xp + (8 * q + r3) * ZT_STRIDE));
                    const float rg = sigmoidf_(aa[reg] + ba), ig = sigmoidf_(ai[reg] + bx);
                    const float av = __expf(-sp8 * rg); const float mult = __builtin_amdgcn_sqrtf(fmaxf(1.0f - av * av, 0.f));
                    h = av * h + mult * (ig * xcv); p *= av; hl[r3] = h; pl[r3] = p; }
                const float Ao = shflx(p, 32, lane), Bo = shflx(h, 32, lane);
                const float A0 = hh ? Ao : p, B0 = hh ? Bo : h, A1 = hh ? p : Ao, B1 = hh ? h : Bo;
                const float P1 = Pr * A0, H1 = Hr * A0 + B0;
                const float Pst = hh ? P1 : Pr, Hst = hh ? H1 : Hr;
                Pr = P1 * A1; Hr = H1 * A1 + B1;
#pragma unroll
                for (int r3 = 0; r3 < 4; ++r3) hpk[rb * 16 + 4 * q + r3] = cvt_pk_bf16(Hst * pl[r3] + hl[r3], Pst * pl[r3]);
            }
        }
        if (hh == 0) __hip_atomic_store(aggq + (size_t)s * D, ((unsigned long long)__float_as_uint(Hr) << 32) | (unsigned long long)__float_as_uint(fmaxf(Pr, 1e-37f)), __ATOMIC_RELAXED, __HIP_MEMORY_SCOPE_AGENT);
        float cin = 0.f;
        for (int j0 = 0; j0 < s; j0 += 8) {
            unsigned long long w[8]; unsigned spins = 0;
            for (;;) { bool ok = true;
#pragma unroll
                for (int k = 0; k < 8; ++k) { const int j = (j0 + k < s) ? (j0 + k) : (s - 1); w[k] = __hip_atomic_load(aggq + (size_t)j * D, __ATOMIC_RELAXED, __HIP_MEMORY_SCOPE_AGENT); ok = ok && ((unsigned)w[k] != 0u); }
                if (__all(ok)) break;
                __builtin_amdgcn_s_sleep(4);
                if (++spins > (1u << 17)) break;
            }
#pragma unroll
            for (int k = 0; k < 8; ++k) { if (j0 + k < s) cin = __uint_as_float((unsigned)w[k]) * cin + __uint_as_float((unsigned)(w[k] >> 32)); }
        }
        asm volatile("s_waitcnt vmcnt(0)" ::: "memory");
        __syncthreads();
        const LAS unsigned char* gp = zt + (4 * hh) * 256 + (hsel * 128 + 32 * wc + c31);
        const LAS float* gsp = (const LAS float*)(zt + 32768) + (4 * hh) * 4 + hsel * 2 + (wc >> 1);
        LAS unsigned char* yp = xc + (4 * hh) * 512 + (hsel * 128 + 32 * wc + c31) * 2;
#pragma unroll
        for (int rb = 0; rb < 4; ++rb) {
#pragma unroll
            for (int reg = 0; reg < 16; ++reg) { const int tok = 32 * rb + 8 * (reg >> 2) + (reg & 3);
                const unsigned pk = hpk[rb * 16 + reg];
                const float hf = bflo(pk) + bfhi(pk) * cin;
#if Z_OUT_FP8
                (void)gsp; const float g = __builtin_amdgcn_cvt_f32_fp8((int)gp[tok * 256], 0) * (1.0f / Z_FP8_SCALE);
#else
                const float g = ((float)gp[tok * 256] - 128.0f) * gsp[tok * 4];
#endif
                const float ge = g * __builtin_amdgcn_rcpf(1.0f + __expf(-1.5957691216f * (g + 0.044715f * g * g * g)));
                *(LAS bf16_t*)(yp + tok * 512) = (bf16_t)(cvt_pk_bf16(hf * ge, 0.f) & 0xffffu); }
        }
    }
    __syncthreads();
    {
        bf16_t* yo = (bf16_t*)(ws + WS_ACAT) + (size_t)t0 * KCAT + 512 + hp * 256;
        u32x4 yv[8];
#pragma unroll
        for (int k = 0; k < 8; ++k) yv[k] = *(const LAS u32x4*)(xc + ((tid >> 5) + 16 * k) * 512 + (tid & 31) * 16);
#pragma unroll
        for (int k = 0; k < 8; ++k) *(u32x4*)(yo + (size_t)((tid >> 5) + 16 * k) * KCAT + (tid & 31) * 8) = yv[k];
    }
    __syncthreads();
}
__device__ __forceinline__ void pool_unit(const Args& a, int l, int u, LAS unsigned char* lds, const int wv) {
    asm volatile("" : "+s"(lds));
    int tid_ = tid_of(wv); asm volatile("" : "+v"(tid_)); const int tid = tid_, lane = tid & 63, wave = __builtin_amdgcn_readfirstlane(tid >> 6);
    unsigned char* ws = opaque_ptr(a.ws);
    const unsigned char* z8 = (const unsigned char*)(ws + WS_Z); const float* zs = (const float*)(ws + WS_ZS);
    LAS unsigned char* zt = lds; LAS unsigned char* pt = lds + 143 * ZT_STRIDE;
    const int gp = u & 1, b = (u >> 1) & 7, s = u >> 4;
    const int t0 = b * SEQ + s * 128, p0 = s * 128;
    stage_z8<143>(z8, zs, b, p0 - 15, 8 + gp, zt, tid);
    __syncthreads();
    {
        const int o = tid & 31, rb = tid >> 5; const int g = 2 * gp + (o >> 4); const int w = 2 << g;
#pragma unroll 1
        for (int i = 0; i < 8; ++i) { const int r = rb + 16 * i; float acc[8];
#pragma unroll
            for (int j = 0; j < 8; ++j) acc[j] = 0.f;
            for (int jj = 0; jj < w; ++jj) { const u32x4 v = *(const LAS u32x4*)(zt + (r + 15 - jj) * ZT_STRIDE + o * 16);
                acc[0] += bflo(v.x); acc[1] += bfhi(v.x); acc[2] += bflo(v.y); acc[3] += bfhi(v.y); acc[4] += bflo(v.z); acc[5] += bfhi(v.z); acc[6] += bflo(v.w); acc[7] += bfhi(v.w); }
            const int cnt = (p0 + r + 1 < w) ? (p0 + r + 1) : w; const float ic = 1.0f / (float)cnt;
            const u32x4 v = *(const LAS u32x4*)(zt + (r + 15) * ZT_STRIDE + o * 16);
            const float x0[8] = {bflo(v.x), bfhi(v.x), bflo(v.y), bfhi(v.y), bflo(v.z), bfhi(v.z), bflo(v.w), bfhi(v.w)};
#pragma unroll
            for (int j = 0; j < 8; ++j) acc[j] = acc[j] * ic - x0[j];
            u32x4 wv; wv.x = cvt_pk_bf16(acc[0], acc[1]); wv.y = cvt_pk_bf16(acc[2], acc[3]); wv.z = cvt_pk_bf16(acc[4], acc[5]); wv.w = cvt_pk_bf16(acc[6], acc[7]);
            *(LAS u32x4*)(pt + r * ZT_STRIDE + o * 16) = wv; }
    }
    __syncthreads();
    {
        const int gsel = wave >> 2, wc = wave & 3, g = 2 * gp + gsel, c31 = lane & 31, hh = lane >> 5;
        const int oc = g * 128 + 32 * wc + c31;
        const bf16_t* wb = (const bf16_t*)(ws + WS_WPOOL) + ((size_t)(l * 4 + g) * 128 + 32 * wc + c31) * 128 + 8 * hh;
        bf16x8 Bf[8];
#pragma unroll
        for (int ks = 0; ks < 8; ++ks) Bf[ks] = *(const bf16x8*)(wb + 16 * ks);
        const float psc = a.in[I_PSCALE][(size_t)l * 512 + oc];
        bf16_t* yo = (bf16_t*)(ws + WS_ACAT) + (size_t)t0 * KCAT + oc;
#pragma unroll 1
        for (int rb = 0; rb < 4; ++rb) {
            f32x16 acc;
#pragma unroll
            for (int r = 0; r < 16; ++r) acc[r] = 0.f;
            const LAS unsigned char* ap = pt + (32 * rb + c31) * ZT_STRIDE + (gsel * 128 + 8 * hh) * 2;
#pragma unroll
            for (int ks = 0; ks < 8; ++ks) { const bf16x8 A = *(const LAS bf16x8*)(ap + 32 * ks); acc = __builtin_amdgcn_mfma_f32_32x32x16_bf16(A, Bf[ks], acc, 0, 0, 0); }
#pragma unroll
            for (int reg = 0; reg < 16; ++reg) { const int tok = 32 * rb + 8 * (reg >> 2) + 4 * hh + (reg & 3);
                yo[(size_t)tok * KCAT] = (bf16_t)(cvt_pk_bf16(acc[reg] * psc, 0.f) & 0xffffu); }
        }
    }
    __syncthreads();
}

constexpr int PH_PER_LAYER = 9;
constexpr int N_PHASES = 1 + DEPTH * PH_PER_LAYER + 1;

__global__ void __launch_bounds__(NTHREADS, 2) fwd_kernel(Args a) {
    extern __shared__ __attribute__((aligned(16))) unsigned char lds_raw[];
    LAS unsigned char* lds = (LAS unsigned char*)lds_raw;
    const int wv = __builtin_amdgcn_readfirstlane(threadIdx.x >> 6); const int tid = threadIdx.x; const int G = gridDim.x;
    unsigned char* ws0 = a.ws;
    unsigned* ctl = (unsigned*)(ws0 + WS_CTL);
    volatile LAS unsigned* misc = (volatile LAS unsigned*)(lds + LDS_MISC);
    if (tid < 4) misc[tid] = 0u;
    __syncthreads();
    XcdBarrier bar; bar.bar = ctl + CW_BAR; bar.x = 0; bar.st = misc; bar.wv = wv;
#if MK_PER_PHASE
    const int lo = a.ph_lo, hi = a.ph_hi;
#else
    constexpr int lo = 0, hi = N_PHASES;
#endif
    if (hi - lo > 1) bar = xcd_barrier_post(ctl + CW_BAR, misc, wv);
#define IN(k) (lo <= (k) && (k) < hi)
#define SEAM(k) do { if (IN((k) + 1)) xcd_barrier(bar); } while (0)

    if (EN(0) && IN(0)) for (int rr = 0; rr < REPN(0); ++rr) { phase_prologue(a, lds, wv); SEAM(0); }

    for (int l = 0; l < DEPTH; ++l) {
        const int pb = 1 + l * PH_PER_LAYER;
        if (EN(1) && IN(pb + 0)) for (int rr = 0; rr < REPN(1); ++rr) { unsigned char* ws = opaque_ptr(ws0); const int bid = opaque_bid(); (void)bid; (void)ws; phase_a(a, l, lds, rr + 1 < REPN(1), wv); SEAM(pb + 0); }
        if (EN(2) && IN(pb + 1)) for (int rr = 0; rr < REPN(2); ++rr) { unsigned char* ws = opaque_ptr(ws0); const int bid = opaque_bid(); (void)bid; (void)ws;
            #if Z_I8
            pg8::PlainSched S{(const char*)(ws + WS_H), (const char*)(ws + WS_WIN) + (size_t)l * NZ * 1024, 512, T / 256, NZ / 256, G, bid};
            pg8::EpiZI8 E{(bf16_t*)(ws + WS_Z), (float*)(ws + WS_ZS), (unsigned char*)(ws + WS_ZG), (const unsigned char*)ws, (unsigned)WS_HSC, (unsigned)(WS_WINSC + (size_t)l * NZ * 4)};
            pg8::gemm_phase<pg8::EpiZI8, pg8::PlainSched, true, 2>(lds, 512, S, E, wv);
#elif Z_FP8
            pg8::PlainSched S{(const char*)(ws + WS_H), (const char*)(ws + WS_WIN) + (size_t)l * NZ * 1024, 512, T / 256, NZ / 256, G, bid};
            pg8::EpiBf16 E{(bf16_t*)(ws + WS_Z), NZ, nullptr, (rr + 1 < REPN(2)) && (a.ph_lo == 0), 1.0f / WEIN_SCALE};
            pg8::gemm_phase<pg8::EpiBf16, pg8::PlainSched, true, 1>(lds, 512, S, E, wv);
#else
            pg8::PlainSched S{(const char*)(ws + WS_H), (const char*)(ws + WS_WIN) + (size_t)l * NZ * 1024 * 2, 1024, T / 256, NZ / 256, G, bid};
            pg8::EpiBf16 E{(bf16_t*)(ws + WS_Z), NZ, nullptr, (rr + 1 < REPN(2)) && (a.ph_lo == 0), 1.0f};
            pg8::gemm_phase<pg8::EpiBf16, pg8::PlainSched, true>(lds, 1024, S, E, wv);
#endif
            SEAM(pb + 1);
        }
        if (EN(3) && IN(pb + 2)) for (int rr = 0; rr < REPN(3); ++rr) { unsigned char* ws = opaque_ptr(ws0); const int bid = opaque_bid(); (void)bid; (void)ws;
            for (int u = bid; u < 1024 + 512; u += G) { if (u < 1024) lru_unit(a, l, u, lds, wv); else pool_unit(a, l, u - 1024, lds, wv); }
            SEAM(pb + 2);
        }
        if (EN(5) && IN(pb + 4)) for (int rr = 0; rr < REPN(5); ++rr) { unsigned char* ws = opaque_ptr(ws0); const int bid = opaque_bid(); (void)bid; (void)ws;
            pg8::PlainSched S{(const char*)(ws + WS_ACAT), (const char*)(ws + WS_WCAT) + (size_t)l * 1024 * KCAT * 2, KCAT, T / 256, D / 256, G, bid};
            pg8::EpiMerged E{(bf16_t*)(ws + WS_MERGED), (const unsigned char*)(ws + WS_ZG)};
            pg8::gemm_phase<pg8::EpiMerged, pg8::PlainSched, true>(lds, KCAT, S, E, wv);
            SEAM(pb + 4);
        }
        if (EN(6) && IN(pb + 5)) for (int rr = 0; rr < REPN(6); ++rr) { unsigned char* ws = opaque_ptr(ws0); const int bid = opaque_bid(); (void)bid; (void)ws;
            pg8::PlainSched S{(const char*)(ws + WS_MERGED), (const char*)(ws + WS_WOUT) + (size_t)l * 1024 * 1024 * 2, 1024, T / 256, D / 256, G, bid};
            pg8::EpiResid E{(bf16_t*)(ws + WS_XRES), (rr + 1 < REPN(6)) ? (bf16_t*)(ws + WS_ACT) : (bf16_t*)(ws + WS_XRES), (const float*)(ws + WS_MOD) + (size_t)l * NBATCH * 6144 + 2 * D};
            pg8::gemm_phase<pg8::EpiResid, pg8::PlainSched, true>(lds, 1024, S, E, wv);
            SEAM(pb + 5);
        }
        if (EN(7) && IN(pb + 6)) for (int rr = 0; rr < REPN(7); ++rr) { unsigned char* ws = opaque_ptr(ws0); const int bid = opaque_bid(); (void)bid; (void)ws; if (l > 0 && rr == 0) conv_drain(a, l, -1, lds, wv); phase_h(a, l, l + DEPTH * rr, lds, wv); SEAM(pb + 6); }
        if (EN(8) && IN(pb + 7)) for (int rr = 0; rr < REPN(8); ++rr) { unsigned char* ws = opaque_ptr(ws0); const int bid = opaque_bid(); (void)bid; (void)ws;
            moe_tables(a, l + DEPTH * (REPN(7) - 1), lds, wv);
            LAS unsigned char* lds_o = lds; asm volatile("" : "+s"(lds_o)); const MoeTab mt = moe_tab_ptrs(lds_o);
            MoeSched1 S{(const char*)(ws + WS_H), (const char*)(ws + WS_WEIN) + (size_t)l * NE * 2048 * 1024, (const int*)(ws + WS_TOKOF), mt, __builtin_amdgcn_readfirstlane(mt.tilestart[NE]), G, bid};
            pg8::EpiSwiglu E{(unsigned char*)(ws + WS_ACT), a.in[I_BEIN] + (size_t)l * NE * 2048, 1.0f / WEIN_SCALE};
            pg8::gemm_phase<pg8::EpiSwiglu, MoeSched1, true, 1>(lds, 512, S, E, wv);
            if (l + 1 < DEPTH) {
                const int nwg = S.nMt * 8, maxr = (nwg + G - 1) / G, myr = (nwg - bid + G - 1) / G;
                if (myr < maxr) conv_drain(a, l + 1, CONV_Q1, lds, wv);
            }
            SEAM(pb + 7);
        }
        if (EN(9) && IN(pb + 8)) for (int rr = 0; rr < REPN(9); ++rr) { unsigned char* ws = opaque_ptr(ws0); const int bid = opaque_bid(); (void)bid; (void)ws;
            moe_tables(a, l + DEPTH * (REPN(7) - 1), lds, wv);
            LAS unsigned char* lds_o = lds; asm volatile("" : "+s"(lds_o)); const MoeTab mt = moe_tab_ptrs(lds_o);
            MoeSched2 S{(const char*)(ws + WS_ACT), (const char*)(ws + WS_WEOUT) + (size_t)l * NE * 1024 * 1024, mt, __builtin_amdgcn_readfirstlane(mt.tilestart[NE]), G, bid};
            pg8::EpiMoeOut E{(unsigned char*)(ws + WS_OUTB), (float*)(ws + WS_OUTSC), a.in[I_BEOUT] + (size_t)l * NE * D, 1.0f / WEIN_SCALE};
            pg8::gemm_phase<pg8::EpiMoeOut, MoeSched2, true, 1>(lds, 512, S, E, wv);
            if (l + 1 < DEPTH) {
                const int nwg = S.nMt * 4, maxr = (nwg + G - 1) / G, myr = (nwg - bid + G - 1) / G;
                if (myr < maxr) conv_drain(a, l + 1, CONV_Q2, lds, wv);
            }
            SEAM(pb + 8);
        }
    }
    if (EN(10) && IN(N_PHASES - 1)) phase_a(a, DEPTH, lds, false, wv);
#undef IN
#undef SEAM
}

extern "C" void kernel_launch(void* const* d_in, const int* in_sizes, int n_in, void* d_out, int out_size, void* d_ws, size_t ws_size, hipStream_t stream) {
    static int grid = 0;
    if (grid == 0) {
        if (n_in != 26 || out_size != T * D || ws_size < WS_END) { fprintf(stderr, "kernel_launch: unexpected problem (n_in %d out %d ws %zu)\n", n_in, out_size, ws_size); grid = -1; return; }
        int dev = 0, cus = 0, per_cu = 0;
        if (hipGetDevice(&dev) != hipSuccess || hipDeviceGetAttribute(&cus, hipDeviceAttributeMultiprocessorCount, dev) != hipSuccess) { grid = -1; return; }
        if (hipFuncSetAttribute((const void*)fwd_kernel, hipFuncAttributeMaxDynamicSharedMemorySize, LDS_BYTES) != hipSuccess) { fprintf(stderr, "kernel_launch: hipFuncSetAttribute failed\n"); grid = -1; return; }
        if (hipOccupancyMaxActiveBlocksPerMultiprocessor(&per_cu, (const void*)fwd_kernel, NTHREADS, LDS_BYTES) != hipSuccess || per_cu < 1) fprintf(stderr, "kernel_launch: occupancy query says %d\n", per_cu);
        (void)hipGetLastError();
        grid = cus;
    }
    if (grid < 0) return;
    static_assert(WS_AGG + AGG_BYTES == WS_CTL, "the look-back words and the control block are zeroed by ONE memset");
    if (hipMemsetAsync((char*)d_ws + WS_AGG, 0, AGG_BYTES + CTL_ZERO_BYTES, stream) != hipSuccess) return;
    Args a{};
    for (int i = 0; i < 26; ++i) a.in[i] = (const float*)d_in[i];
    a.out = (float*)d_out; a.ws = (unsigned char*)d_ws;
#if MK_PER_PHASE
    for (int p = 0; p < N_PHASES; ++p) { a.ph_lo = p; a.ph_hi = p + 1; hipLaunchKernelGGL(fwd_kernel, dim3(grid), dim3(NTHREADS), LDS_BYTES, stream, a); }
#else
    a.ph_lo = 0; a.ph_hi = N_PHASES;
    hipLaunchKernelGGL(fwd_kernel, dim3(grid), dim3(NTHREADS), LDS_BYTES, stream, a);
#endif
    const hipError_t le = hipPeekAtLastError();
    if (le != hipSuccess) fprintf(stderr, "kernel_launch: launch failed: %s\n", hipGetErrorName(le));
}
```

```cpp
#include <hip/hip_runtime.h>
#include <cstdio>
#include <cstdint>

#define REP_MASK 0x0
#ifndef PH_MASK
#define PH_MASK 0x7ff
#endif
#define EN(b) ((PH_MASK >> (b)) & 1)
#ifndef REP_MASK
#define REP_MASK 0
#endif
#define REPN(b) ((((REP_MASK) >> (b)) & 1) ? 2 : 1)
#ifndef Z_I8
#define Z_I8 1
#endif
#ifndef Z_FP8
#define Z_FP8 0
#endif
#ifndef MK_PER_PHASE
#define MK_PER_PHASE 0
#endif

#define LAS __attribute__((address_space(3)))
typedef unsigned short bf16_t;
typedef short bf16x8 __attribute__((ext_vector_type(8)));
typedef float f32x4 __attribute__((ext_vector_type(4)));
typedef float f32x2 __attribute__((ext_vector_type(2)));
typedef float f32x16 __attribute__((ext_vector_type(16)));
typedef unsigned u32x4 __attribute__((ext_vector_type(4)));
typedef unsigned u32x2 __attribute__((ext_vector_type(2)));

constexpr int D = 1024, NBATCH = 8, SEQ = 4096, T = NBATCH * SEQ, DEPTH = 4;
constexpr int NZ = 4608, ZO_GLRU = 1024, ZO_XPOOL = 2048, ZO_GL0 = 2560, ZO_GL1 = 3584;
constexpr int NE = 32, TOPK = 4;
constexpr int KCAT = 1536;
constexpr int SLOT_CAP = T * TOPK + NE * 256;
constexpr int MAX_MT = SLOT_CAP / 256;
constexpr float NORM_EPS = 1e-6f;
constexpr float WEIN_SCALE = 64.0f;
constexpr int NTHREADS = 512, NWAVES = 8;

constexpr size_t MiB = 1u << 20;
constexpr size_t WS_CTL = 80 * MiB, CTL_ZERO_BYTES = 256 * 1024;
constexpr size_t WS_MOD = 1 * MiB;
constexpr size_t WS_CB = 2 * MiB;
constexpr size_t WS_AGG = 72 * MiB;
constexpr size_t AGG_BYTES = (size_t)DEPTH * NBATCH * 32 * D * 8;
constexpr size_t WS_WRS = 3 * MiB;
constexpr size_t WS_HSC = 4 * MiB;
constexpr size_t WS_WINSC = 5 * MiB;
constexpr size_t WS_WRB = 40 * MiB;
constexpr size_t WS_TOKOF = 6 * MiB;
constexpr size_t WS_SLOTINFO = 10 * MiB;
constexpr size_t WS_WGT = 11 * MiB;
constexpr size_t WS_WRG = 12 * MiB;
constexpr size_t WS_WPOOL = 14 * MiB;
constexpr size_t WS_WIN = 16 * MiB;
constexpr size_t WS_WCAT = 52 * MiB;
constexpr size_t WS_WOUT = 64 * MiB;
constexpr size_t WS_WEIN = 128 * MiB;
constexpr size_t WS_WEOUT = 640 * MiB;
constexpr size_t WS_XRES = 896 * MiB;
constexpr size_t WS_H = 1024 * MiB;
constexpr size_t WS_Z = 1088 * MiB;
constexpr size_t WS_ZS = WS_Z + 96 * MiB;
constexpr size_t WS_ACAT = 1376 * MiB;
constexpr size_t WS_MERGED = 1472 * MiB;
constexpr size_t WS_ACT = 1536 * MiB;
constexpr size_t WS_OUTB = 1808 * MiB;
constexpr size_t WS_OUTSC = WS_OUTB + 144 * MiB;
constexpr size_t WS_ZG = 2080 * MiB;
constexpr size_t WS_END = 2144 * MiB;
static_assert(WS_ACT + (size_t)SLOT_CAP * 1024 * 2 <= WS_OUTB && WS_OUTB + (size_t)SLOT_CAP * 1024 * 2 <= WS_END, "ws map");
constexpr int CW_BAR = 4096;
constexpr int CW_CONVQ = 7680;
constexpr int CW_CNT = 8192;

constexpr int LDS_BYTES = 163840;
constexpr int LDS_TAB = 131072;
constexpr int LDS_NVA = 131072 + 8192;
constexpr int LDS_PTAB = 131072 + 16384, PTAB_BYTES = 2048;
constexpr int LDS_MISC = LDS_BYTES - 256;

__device__ __forceinline__ unsigned cvt_pk_bf16(float lo, float hi) { unsigned r; asm("v_cvt_pk_bf16_f32 %0, %1, %2" : "=v"(r) : "v"(lo), "v"(hi)); return r; }
__device__ __forceinline__ float bflo(unsigned w) { return __uint_as_float(w << 16); }
__device__ __forceinline__ float bfhi(unsigned w) { return __uint_as_float(w & 0xffff0000u); }
__device__ __forceinline__ float bf1(bf16_t w) { return __uint_as_float(((unsigned)w) << 16); }
__device__ __forceinline__ float sigmoidf_(float x) { return __builtin_amdgcn_rcpf(1.0f + __expf(-x)); }
#define Z_OUT_FP8 1
constexpr float Z_FP8_SCALE = 16.0f;
constexpr float OUT_FP8_SCALE = 16.0f;
constexpr float MAGIC_U8 = 12582912.0f, MAGIC_I8 = 12582912.0f + 128.0f;
__device__ __forceinline__ unsigned pack4_lowbytes(f32x4 t) {
    const unsigned p01 = __builtin_amdgcn_perm(__float_as_uint(t.y), __float_as_uint(t.x), 0x0c0c0400u), p23 = __builtin_amdgcn_perm(__float_as_uint(t.w), __float_as_uint(t.z), 0x0c0c0400u);
    return __builtin_amdgcn_perm(p23, p01, 0x05040100u);
}
__device__ __forceinline__ float shflx(float v, int mask, int lane) { return __int_as_float(__builtin_amdgcn_ds_bpermute((lane ^ mask) << 2, __float_as_int(v))); }
#define DPP_F(v, ctrl) __builtin_bit_cast(float, __builtin_amdgcn_update_dpp(0, __builtin_bit_cast(int, (v)), (ctrl), 0xF, 0xF, true))
#define RDL_F(v, l) __builtin_bit_cast(float, __builtin_amdgcn_readlane(__builtin_bit_cast(int, (v)), (l)))
__device__ __forceinline__ float wave_sum(float v, int) {
    v += DPP_F(v, 0xB1); v += DPP_F(v, 0x4E); v += DPP_F(v, 0x141); v += DPP_F(v, 0x140);
    return (RDL_F(v, 0) + RDL_F(v, 16)) + (RDL_F(v, 32) + RDL_F(v, 48));
}
__device__ __forceinline__ float wave_max(float v) {
    v = fmaxf(v, DPP_F(v, 0xB1)); v = fmaxf(v, DPP_F(v, 0x4E)); v = fmaxf(v, DPP_F(v, 0x141)); v = fmaxf(v, DPP_F(v, 0x140));
    return fmaxf(fmaxf(RDL_F(v, 0), RDL_F(v, 16)), fmaxf(RDL_F(v, 32), RDL_F(v, 48)));
}
__device__ __forceinline__ int tid_of(int wv) { int l; asm volatile("v_mbcnt_lo_u32_b32 %0, -1, 0\n\tv_mbcnt_hi_u32_b32 %0, -1, %0" : "=v"(l)); return wv * 64 + l; }
__device__ __forceinline__ int opaque_bid() { int b = blockIdx.x; asm volatile("" : "+s"(b)); return b; }
__device__ __forceinline__ unsigned char* opaque_ptr(unsigned char* p) { size_t z = 0; asm volatile("" : "+s"(z)); return p + z; }
#define LDS_WAIT() asm volatile("s_waitcnt lgkmcnt(0)" ::: "memory")
#define VM_WAIT() asm volatile("s_waitcnt vmcnt(0)" ::: "memory")

namespace pg8 {
constexpr int BM = 256, BK = 64, HALF = 128, HTB = HALF * BK * 2, STAGE_BYTES = 8 * HTB, NXCD = 8, WGM = 8;
__host__ __device__ __forceinline__ int lds_byte(int r, int c) { const int st = (r >> 4) * 2 + (c >> 5), rr = r & 15, cc = c & 31, ob = rr * 64 + cc * 2; return st * 1024 + (ob ^ (((ob >> 9) & 1) << 5)); }
__host__ __device__ __forceinline__ void stage_rc(int b, int& R, int& C) { const int st = b / 1024, sb = b % 1024, swz = sb ^ (((sb >> 9) & 1) << 5); R = (st >> 1) * 16 + swz / 64; C = (st & 1) * 32 + (swz % 64) / 2; }
__host__ __device__ __forceinline__ int perm32(int rho) { const int n = rho >> 4, i = rho & 15; return 8 * (i >> 2) + 4 * n + (i & 3); }

struct Unit { int pm, pn, e, j, row0, rows; };
typedef int v8i32 __attribute__((ext_vector_type(8)));
typedef int v4i32_t __attribute__((ext_vector_type(4)));
__device__ __forceinline__ v8i32 cat8(bf16x8 lo, bf16x8 hi) { typedef int v4i32 __attribute__((ext_vector_type(4))); const v4i32 a = __builtin_bit_cast(v4i32, lo), b = __builtin_bit_cast(v4i32, hi); return (v8i32){a.x, a.y, a.z, a.w, b.x, b.y, b.z, b.w}; }

template <int WGM_ = WGM>
__device__ __forceinline__ bool order_map(int i, int G, int c, int nM, int nN, int& pm, int& pn) {
    const int nwg = nM * nN; const int L = i * G + c; if (L >= nwg) return false;
    int wgid = L; { const int q = nwg / NXCD, r = nwg % NXCD, xcd = wgid % NXCD, off = wgid / NXCD; wgid = (xcd < r ? xcd * (q + 1) : r * (q + 1) + (xcd - r) * q) + off; }
    const int nig = WGM_ * nN, gid = wgid / nig, fm = gid * WGM_, gsz = (nM - fm) < WGM_ ? (nM - fm) : WGM_;
    pm = fm + ((wgid % nig) % gsz); pn = (wgid % nig) / gsz; return true;
}

struct PlainSched {
    static constexpr bool DYN_A = false;
    const char* A; const char* Bt; int K, nM, nN, G, c;
    __device__ __forceinline__ bool next(int i, Unit& u) const { int pm, pn; if (!order_map(i, G, c, nM, nN, pm, pn)) return false; u.pm = pm; u.pn = pn; u.e = 0; u.j = 0; u.row0 = pm * BM; u.rows = BM; return true; }
    __device__ __forceinline__ const char* a_ptr() const { return A; }
    __device__ __forceinline__ const char* b_ptr() const { return Bt; }
    __device__ __forceinline__ unsigned a_off(const Unit& u) const { return (unsigned)u.row0 * (unsigned)K * 2u; }
    __device__ __forceinline__ unsigned b_off(const Unit& u) const { return (unsigned)u.pn * (unsigned)(BM * K * 2); }
    __device__ __forceinline__ void a_voff(const Unit&, unsigned (&v)[2][2], int wv) const {
        int tid = tid_of(wv); asm volatile("" : "+v"(tid));
#pragma unroll
        for (int i = 0; i < 2; ++i) { int R, C; stage_rc(tid * 16 + i * 8192, R, C);
#pragma unroll
            for (int h = 0; h < 2; ++h) v[h][i] = (unsigned)((h * HALF + R) * K + C) * 2u; }
    }
};

template <class Epi, class Sched, bool ALIGN_EPI, int MODE = 0>
__device__ __forceinline__ void gemm_phase(LAS unsigned char* lds, const int K, const Sched& S, const Epi& E, const int wv) {
    asm volatile("" : "+s"(lds));
    int tid = tid_of(wv); asm volatile("" : "+v"(tid));
    const int wid = __builtin_amdgcn_readfirstlane(tid >> 6), lane = tid & 63, wr = wid >> 2, wc = wid & 3, fr = lane & 15, fq = lane >> 4;
    const int nt = K / BK;
    unsigned voffB;
    { int R, C; stage_rc(tid * 16, R, C);
      const int Rb = (Epi::PERM == 2) ? (64 * (R >> 5) + 16 * ((R & 15) >> 2) + 4 * ((R >> 4) & 1) + (R & 3)) : (Epi::PERM == 1) ? ((R & ~31) + perm32(R & 31)) : R; voffB = (unsigned)(Rb * K + C) * 2u; }
    const unsigned q64 = (unsigned)(64 * K * 2);
    const unsigned q64B = (Epi::PERM == 2) ? 2u * q64 : q64;
    const unsigned kstep = (unsigned)(BK * 2);
    const unsigned hstep = (Epi::PERM == 2) ? (unsigned)(8 * K * 2) : (unsigned)(HALF * K * 2);
    const __amdgpu_buffer_rsrc_t rsA = __builtin_amdgcn_make_buffer_rsrc((void*)S.a_ptr(), 0, 0xffffffff, 0x00020000);
    const __amdgpu_buffer_rsrc_t rsB = __builtin_amdgcn_make_buffer_rsrc((void*)S.b_ptr(), 0, 0xffffffff, 0x00020000);
    const unsigned ldsw = (unsigned)wid * 1024u;
    const int aoff = lds_byte(wr * 64 + fr, fq * 8), boff = lds_byte(wc * 32 + fr, fq * 8);
#define PG8_SA(b, h) (((b) * 2 + (h)) * HTB)
#define PG8_SB(b, h) ((4 + (b) * 2 + (h)) * HTB)
#define PG8_STAGE_(rs, bufoff, v0, s0, v1, s1) do { \
        __builtin_amdgcn_raw_ptr_buffer_load_lds(rs, (LAS void*)(lds + (bufoff) + ldsw), 16, (v0), (s0), 0, 0); \
        __builtin_amdgcn_raw_ptr_buffer_load_lds(rs, (LAS void*)(lds + (bufoff) + ldsw + 8192), 16, (v1), (s1), 0, 0); } while (0)
#define PG8_STAGE_B(bufoff, soff, unused) PG8_STAGE_(rsB, bufoff, voffB, (soff), voffB, (soff) + q64B)
#define PG8_STAGE_A(bufoff, soff, h) do { if constexpr (Sched::DYN_A) PG8_STAGE_(rsA, bufoff, cvA[h][0], (soff), cvA[h][1], (soff)); \
        else PG8_STAGE_(rsA, bufoff, cvA[0][0], (soff) + (h) * 2u * q64, cvA[0][0], (soff) + (h) * 2u * q64 + q64); } while (0)
#define PG8_LDA(dst, b, h) do { _Pragma("unroll") for (int m = 0; m < 4; ++m) _Pragma("unroll") for (int k = 0; k < 2; ++k) dst[m][k] = *(const LAS bf16x8*)(lds + PG8_SA(b, h) + aoff + m * 2048 + k * 1024); } while (0)
#define PG8_LDB(dst, b, h) do { _Pragma("unroll") for (int n = 0; n < 2; ++n) _Pragma("unroll") for (int k = 0; k < 2; ++k) dst[n][k] = *(const LAS bf16x8*)(lds + PG8_SB(b, h) + boff + n * 2048 + k * 1024); } while (0)
#define PG8_MMA(ai, bj, At, Bt) do { __builtin_amdgcn_s_setprio(1); _Pragma("unroll") for (int m = 0; m < 4; ++m) _Pragma("unroll") for (int n = 0; n < 2; ++n) { \
        if constexpr (MODE == 1) { acc[ai][bj][m][n] = __builtin_amdgcn_mfma_scale_f32_16x16x128_f8f6f4(cat8(Bt[n][0], Bt[n][1]), cat8(At[m][0], At[m][1]), acc[ai][bj][m][n], 0, 0, 0, 0x7f7f7f7f, 0, 0x7f7f7f7f); } \
        else if constexpr (MODE == 2) { _Pragma("unroll") for (int k = 0; k < 2; ++k) acc[ai][bj][m][n] = __builtin_bit_cast(f32x4, __builtin_amdgcn_mfma_i32_16x16x64_i8(__builtin_bit_cast(v4i32_t, Bt[n][k]), __builtin_bit_cast(v4i32_t, At[m][k]), __builtin_bit_cast(v4i32_t, acc[ai][bj][m][n]), 0, 0, 0)); } \
        else { _Pragma("unroll") for (int k = 0; k < 2; ++k) acc[ai][bj][m][n] = __builtin_amdgcn_mfma_f32_16x16x32_bf16(Bt[n][k], At[m][k], acc[ai][bj][m][n], 0, 0, 0); } } \
        __builtin_amdgcn_s_setprio(0); } while (0)
#define PG8_WAIT_V(n) asm volatile("s_waitcnt vmcnt(" #n ")" ::: "memory")
#define PG8_WAIT_L(n) asm volatile("s_waitcnt lgkmcnt(" #n ")" ::: "memory")
#define PG8_BAR __builtin_amdgcn_s_barrier()
#define PG8_SCHED __builtin_amdgcn_sched_barrier(0)
    Unit cur, nxt; int ui = 0;
    if (!S.next(0, cur)) return;
    f32x4 acc[2][2][4][2];
    { float z0 = 0.f; asm volatile("" : "+v"(z0));
#pragma unroll
    for (int a = 0; a < 2; ++a)
#pragma unroll
        for (int b = 0; b < 2; ++b)
#pragma unroll
            for (int m = 0; m < 4; ++m)
#pragma unroll
                for (int n = 0; n < 2; ++n) acc[a][b][m][n] = (f32x4){z0, z0, z0, z0}; }
    bf16x8 At[4][2], B0[2][2], B1[2][2];
    unsigned cvA[2][2];
    S.a_voff(cur, cvA, wv);
    unsigned cA = S.a_off(cur), cB = S.b_off(cur);
    if constexpr (Epi::PREF) E.prefetch(cur, lds + LDS_PTAB, wv);
    PG8_STAGE_B(PG8_SB(0, 0), cB, voffB); PG8_STAGE_B(PG8_SB(0, 1), cB + hstep, voffB); PG8_STAGE_A(PG8_SA(0, 0), cA, 0); PG8_STAGE_A(PG8_SA(0, 1), cA, 1);
    if (wr == 1) PG8_BAR;
    PG8_WAIT_V(2); PG8_BAR;
    PG8_STAGE_B(PG8_SB(1, 0), cB + kstep, voffB); PG8_STAGE_A(PG8_SA(1, 0), cA + kstep, 0); PG8_STAGE_B(PG8_SB(1, 1), cB + hstep + kstep, voffB);
    PG8_WAIT_V(6); PG8_BAR;
    for (;;) {
        const bool has_next = S.next(ui + 1, nxt);
        unsigned nA = cA, nB = cB;
        if (has_next) { nA = S.a_off(nxt); nB = S.b_off(nxt); }
        if constexpr (Sched::DYN_A) { if (has_next) S.a_dma(nxt, lds + LDS_NVA, wv); }
#pragma unroll 1
        for (int t = 0; t < nt; t += 2) {
            const bool last = (t == nt - 2);
            const unsigned a1 = cA + (unsigned)(t + 1) * kstep;
            const unsigned a2 = last ? nA : cA + (unsigned)(t + 2) * kstep, b2 = last ? nB : cB + (unsigned)(t + 2) * kstep;
            const unsigned a3 = a2 + kstep, b3 = b2 + kstep;
            unsigned nx1[2] = {cvA[1][0], cvA[1][1]};
            if constexpr (Sched::DYN_A) { if (last && has_next) { unsigned q[4]; S.a_fetch(lds + LDS_NVA, wv, q); cvA[0][0] = q[0]; cvA[0][1] = q[1]; nx1[0] = q[2]; nx1[1] = q[3]; } }
            if constexpr (Epi::HOOK_T >= 0) { if (t == Epi::HOOK_T) E.mid(acc, cur, wr, wc, fr, fq); }
            PG8_LDB(B0, 0, 0); PG8_LDB(B1, 0, 1); PG8_SCHED; PG8_LDA(At, 0, 0); PG8_STAGE_A(PG8_SA(1, 1), a1, 1);
            if constexpr (Sched::DYN_A) { cvA[1][0] = nx1[0]; cvA[1][1] = nx1[1]; }
            PG8_WAIT_V(8); PG8_WAIT_L(0); PG8_BAR; PG8_MMA(0, 0, At, B0); PG8_MMA(0, 1, At, B1); PG8_BAR; PG8_SCHED;
            PG8_LDA(At, 0, 1); PG8_STAGE_B(PG8_SB(0, 0), b2, voffB); PG8_STAGE_B(PG8_SB(0, 1), b2 + hstep, voffB); PG8_STAGE_A(PG8_SA(0, 0), a2, 0);
            PG8_WAIT_V(8); PG8_WAIT_L(0); PG8_BAR; PG8_MMA(1, 0, At, B0); PG8_MMA(1, 1, At, B1); PG8_BAR; PG8_SCHED;
            PG8_LDB(B0, 1, 0); PG8_LDB(B1, 1, 1); PG8_SCHED; PG8_LDA(At, 1, 0); PG8_STAGE_A(PG8_SA(0, 1), a2, 1);
            PG8_WAIT_V(8); PG8_WAIT_L(0); PG8_BAR; PG8_MMA(0, 0, At, B0); PG8_MMA(0, 1, At, B1); PG8_BAR; PG8_SCHED;
            PG8_LDA(At, 1, 1); PG8_STAGE_B(PG8_SB(1, 0), b3, voffB); PG8_STAGE_B(PG8_SB(1, 1), b3 + hstep, voffB); PG8_STAGE_A(PG8_SA(1, 0), a3, 0);
            PG8_WAIT_V(8); PG8_WAIT_L(0); PG8_BAR; PG8_MMA(1, 0, At, B0); PG8_MMA(1, 1, At, B1); PG8_BAR; PG8_SCHED;
        }
        if constexpr (ALIGN_EPI) { if (wr == 0) PG8_BAR; }
        if constexpr (Epi::PREF) E.run(acc, cur, wr, wc, lds + LDS_PTAB + (ui & 1) * PTAB_BYTES); else E(acc, cur, wr, wc, fr, fq);
        if (!has_next) break;
        { float z0 = 0.f; asm volatile("" : "+v"(z0));
#pragma unroll
        for (int a = 0; a < 2; ++a)
#pragma unroll
            for (int b = 0; b < 2; ++b)
#pragma unroll
                for (int m = 0; m < 4; ++m)
#pragma unroll
                    for (int n = 0; n < 2; ++n) acc[a][b][m][n] = (f32x4){z0, z0, z0, z0}; }
        cur = nxt; cA = nA; cB = nB; ++ui;
        if constexpr (Epi::PREF) E.prefetch(cur, lds + LDS_PTAB + (ui & 1) * PTAB_BYTES, wv);
        if constexpr (ALIGN_EPI) { if (wr == 1) PG8_BAR; }
    }
    PG8_WAIT_V(0);
    if constexpr (!ALIGN_EPI) { if (wr == 0) PG8_BAR; }
    PG8_BAR;
#undef PG8_SA
#undef PG8_SB
#undef PG8_STAGE_
#undef PG8_STAGE_A
#undef PG8_STAGE_B
#undef PG8_LDA
#undef PG8_LDB
#undef PG8_MMA
#undef PG8_WAIT_V
#undef PG8_WAIT_L
#undef PG8_BAR
#undef PG8_SCHED
}

struct EpiBf16 {
    static constexpr int PERM = 1; static constexpr int HOOK_T = -1; static constexpr bool PREF = false;
    bf16_t* O; int ldc; const float* bias; int noepi; float scale;
    __device__ __forceinline__ void mid(f32x4 (&)[2][2][4][2], const Unit&, int, int, int, int) const {}
    __device__ __forceinline__ void operator()(const f32x4 (&acc)[2][2][4][2], const Unit& u, int wr, int wc, int fr, int fq) const {
        { const int l_ = tid_of(0); fr = l_ & 15; fq = l_ >> 4; }
        if (noepi) { if (acc[0][0][0][0][0] == 1.2345e-30f) O[0] = 0; return; }
        int row0 = u.row0 + wr * 64 + fr; asm volatile("" : "+v"(row0)); int col0 = u.pn * BM + wc * 32 + 8 * fq; asm volatile("" : "+v"(col0));
        f32x4 bv[2][2];
#pragma unroll
        for (int bj = 0; bj < 2; ++bj)
#pragma unroll
            for (int n = 0; n < 2; ++n) bv[bj][n] = bias ? *(const f32x4*)(bias + col0 + bj * HALF + 4 * n) : (f32x4){0.f, 0.f, 0.f, 0.f};
#pragma unroll
        for (int ai = 0; ai < 2; ++ai)
#pragma unroll
            for (int m = 0; m < 4; ++m) { bf16_t* rowp = O + (size_t)(row0 + ai * HALF + m * 16) * ldc + col0;
#pragma unroll
                for (int bj = 0; bj < 2; ++bj) { const f32x4 v0 = acc[ai][bj][m][0] * scale + bv[bj][0], v1 = acc[ai][bj][m][1] * scale + bv[bj][1];
                    u32x4 w; w.x = cvt_pk_bf16(v0[0], v0[1]); w.y = cvt_pk_bf16(v0[2], v0[3]); w.z = cvt_pk_bf16(v1[0], v1[1]); w.w = cvt_pk_bf16(v1[2], v1[3]);
                    *(u32x4*)(rowp + bj * HALF) = w; } }
    }
};
struct EpiZI8 {
    static constexpr int PERM = 2; static constexpr int HOOK_T = -1; static constexpr bool PREF = true;
    bf16_t* O; float* ZS; unsigned char* ZG; const unsigned char* wsb; unsigned rsc_off, csc_off;
    __device__ __forceinline__ void mid(f32x4 (&)[2][2][4][2], const Unit&, int, int, int, int) const {}
    __device__ __forceinline__ void prefetch(const Unit& u, LAS unsigned char* tab, int wv) const {
        const int t = tid_of(wv);
        const unsigned vo = (t < 256) ? (rsc_off + (unsigned)(u.row0 + t) * 4u) : (csc_off + (unsigned)(u.pn * BM + t - 256) * 4u);
        const __amdgpu_buffer_rsrc_t rs = __builtin_amdgcn_make_buffer_rsrc((void*)wsb, 0, 0xffffffff, 0x00020000);
        __builtin_amdgcn_raw_ptr_buffer_load_lds(rs, (LAS void*)(tab + wv * 256), 4, vo, 0, 0, 0);
    }
    __device__ __forceinline__ void run(const f32x4 (&acc)[2][2][4][2], const Unit& u, int wr, int wc, const LAS unsigned char* tab) const {
        int fr, fq; const int lane_ = tid_of(0); fr = lane_ & 15; fq = lane_ >> 4;
        int row0 = u.row0 + wr * 64 + fr; asm volatile("" : "+v"(row0)); int col0 = u.pn * BM + wc * 64 + 16 * fq; asm volatile("" : "+v"(col0));
        const LAS float* tf = (const LAS float*)tab;
        f32x4 cs[2][2];
#pragma unroll
        for (int bj = 0; bj < 2; ++bj)
#pragma unroll
            for (int n = 0; n < 2; ++n) cs[bj][n] = *(const LAS f32x4*)(tf + 256 + wc * 64 + 16 * fq + 8 * bj + 4 * n);
        if (u.pn >= ZO_GL0 / BM) {
#pragma unroll
            for (int bj = 0; bj < 2; ++bj)
#pragma unroll
                for (int n = 0; n < 2; ++n) cs[bj][n] *= -1.4426950408889634f;
#pragma unroll
            for (int ai = 0; ai < 2; ++ai)
#pragma unroll
                for (int m = 0; m < 4; ++m) { const int r = row0 + ai * HALF + m * 16; const float rs = tf[ai * HALF + wr * 64 + m * 16 + fr];
                    unsigned w[4];
#pragma unroll
                    for (int q = 0; q < 4; ++q) { const v4i32_t iv = __builtin_bit_cast(v4i32_t, acc[ai][q >> 1][m][q & 1]);
                        f32x4 e = (f32x4){(float)iv.x, (float)iv.y, (float)iv.z, (float)iv.w} * rs * cs[q >> 1][q & 1];
#pragma unroll
                        for (int j = 0; j < 4; ++j) e[j] = __builtin_amdgcn_exp2f(e[j]);
                        e += 1.0f;
#pragma unroll
                        for (int j = 0; j < 4; ++j) e[j] = __builtin_amdgcn_rcpf(e[j]);
                        w[q] = pack4_lowbytes(e * 255.0f + MAGIC_U8); }
                    *(u32x4*)(ZG + (size_t)r * 2048 + (col0 - ZO_GL0)) = (u32x4){w[0], w[1], w[2], w[3]}; }
        } else {
#if Z_OUT_FP8
#pragma unroll
            for (int bj = 0; bj < 2; ++bj)
#pragma unroll
                for (int n = 0; n < 2; ++n) cs[bj][n] *= Z_FP8_SCALE;
#pragma unroll
            for (int ai = 0; ai < 2; ++ai)
#pragma unroll
                for (int m = 0; m < 4; ++m) { const int r = row0 + ai * HALF + m * 16; const float rs = tf[ai * HALF + wr * 64 + m * 16 + fr];
                    unsigned w[4];
#pragma unroll
                    for (int q = 0; q < 4; ++q) { const v4i32_t iv = __builtin_bit_cast(v4i32_t, acc[ai][q >> 1][m][q & 1]);
                        const f32x4 v = (f32x4){(float)iv.x, (float)iv.y, (float)iv.z, (float)iv.w} * rs * cs[q >> 1][q & 1];
                        int p = 0; p = __builtin_amdgcn_cvt_pk_fp8_f32(v.x, v.y, p, false); p = __builtin_amdgcn_cvt_pk_fp8_f32(v.z, v.w, p, true); w[q] = (unsigned)p; }
                    *(u32x4*)((unsigned char*)O + (size_t)r * 2560 + col0) = (u32x4){w[0], w[1], w[2], w[3]}; }
        }
#else
#pragma unroll
            for (int ai = 0; ai < 2; ++ai)
#pragma unroll
                for (int m = 0; m < 4; ++m) { const int r = row0 + ai * HALF + m * 16; const float rs = tf[ai * HALF + wr * 64 + m * 16 + fr]; f32x4 vq[4];
                    float am = 1e-30f;
#pragma unroll
                    for (int q = 0; q < 4; ++q) { const v4i32_t iv = __builtin_bit_cast(v4i32_t, acc[ai][q >> 1][m][q & 1]);
                        vq[q] = (f32x4){(float)iv.x, (float)iv.y, (float)iv.z, (float)iv.w} * cs[q >> 1][q & 1];
                        am = fmaxf(am, fmaxf(fmaxf(fabsf(vq[q].x), fabsf(vq[q].y)), fmaxf(fabsf(vq[q].z), fabsf(vq[q].w)))); }
                    am = fmaxf(am, shflx(am, 16, lane_)); am = fmaxf(am, shflx(am, 32, lane_));
                    const float inv = 127.0f * __builtin_amdgcn_rcpf(am) * 0.999f;
                    if (fq == 0) ZS[(size_t)r * 40 + u.pn * 4 + wc] = am * rs * (1.0f / (127.0f * 0.999f));
                    unsigned w[4];
#pragma unroll
                    for (int q = 0; q < 4; ++q) w[q] = pack4_lowbytes(vq[q] * inv + MAGIC_I8);
                    *(u32x4*)((unsigned char*)O + (size_t)r * 2560 + col0) = (u32x4){w[0], w[1], w[2], w[3]}; }
        }
#endif
    }
    __device__ __forceinline__ void operator()(const f32x4 (&)[2][2][4][2], const Unit&, int, int, int, int) const {}
};
struct EpiMerged {
    static constexpr int PERM = 2; static constexpr int HOOK_T = 8; static constexpr bool PREF = false;
    bf16_t* O; const unsigned char* ZG;
    __device__ __forceinline__ void mid(f32x4 (&acc)[2][2][4][2], const Unit& u, int wr, int wc, int fr, int fq) const {
        { const int l_ = tid_of(0); fr = l_ & 15; fq = l_ >> 4; }
        int row0 = u.row0 + wr * 64 + fr; asm volatile("" : "+v"(row0)); int col0 = u.pn * BM + wc * 64 + 16 * fq; asm volatile("" : "+v"(col0));
        u32x4 g0[2][4], g1[2][4];
#pragma unroll
        for (int ai = 0; ai < 2; ++ai)
#pragma unroll
            for (int m = 0; m < 4; ++m) { const unsigned char* zr = ZG + (size_t)(row0 + ai * HALF + m * 16) * 2048 + col0;
                g0[ai][m] = *(const u32x4*)zr; g1[ai][m] = *(const u32x4*)(zr + 1024); }
#pragma unroll
        for (int ai = 0; ai < 2; ++ai)
#pragma unroll
            for (int m = 0; m < 4; ++m)
#pragma unroll
                for (int bj = 0; bj < 2; ++bj) {
                    const unsigned a0[2] = {bj ? g0[ai][m].z : g0[ai][m].x, bj ? g0[ai][m].w : g0[ai][m].y}, a1[2] = {bj ? g1[ai][m].z : g1[ai][m].x, bj ? g1[ai][m].w : g1[ai][m].y};
#pragma unroll
                    for (int n = 0; n < 2; ++n)
#pragma unroll
                        for (int j = 0; j < 4; ++j) { const float u0 = fmaxf((float)((a0[n] >> (8 * j)) & 0xffu), 1.0f), u1 = (float)((a1[n] >> (8 * j)) & 0xffu);
                            acc[ai][bj][m][n][j] *= u1 * __builtin_amdgcn_rcpf(u0); } }
    }
    __device__ __forceinline__ void operator()(const f32x4 (&acc)[2][2][4][2], const Unit& u, int wr, int wc, int fr, int fq) const {
        { const int l_ = tid_of(0); fr = l_ & 15; fq = l_ >> 4; }
        int row0 = u.row0 + wr * 64 + fr; asm volatile("" : "+v"(row0)); int col0 = u.pn * BM + wc * 64 + 16 * fq; asm volatile("" : "+v"(col0));
        u32x4 g0[2][4];
#pragma unroll
        for (int ai = 0; ai < 2; ++ai)
#pragma unroll
            for (int m = 0; m < 4; ++m) { const unsigned char* zr = ZG + (size_t)(row0 + ai * HALF + m * 16) * 2048 + col0;
                g0[ai][m] = *(const u32x4*)zr; }
#pragma unroll
        for (int ai = 0; ai < 2; ++ai)
#pragma unroll
            for (int m = 0; m < 4; ++m) { bf16_t* orow = O + (size_t)(row0 + ai * HALF + m * 16) * D + col0;
#pragma unroll
                for (int bj = 0; bj < 2; ++bj) { const unsigned a0[2] = {bj ? g0[ai][m].z : g0[ai][m].x, bj ? g0[ai][m].w : g0[ai][m].y};
                    float o[8];
#pragma unroll
                    for (int n = 0; n < 2; ++n)
#pragma unroll
                        for (int j = 0; j < 4; ++j) o[4 * n + j] = acc[ai][bj][m][n][j] * (fmaxf((float)((a0[n] >> (8 * j)) & 0xffu), 1.0f) * (1.0f / 255.0f));
                    u32x4 w; w.x = cvt_pk_bf16(o[0], o[1]); w.y = cvt_pk_bf16(o[2], o[3]); w.z = cvt_pk_bf16(o[4], o[5]); w.w = cvt_pk_bf16(o[6], o[7]);
                    *(u32x4*)(orow + bj * 8) = w; } }
    }
};
struct EpiResid {
    static constexpr int PERM = 1; static constexpr int HOOK_T = -1; static constexpr bool PREF = false;
    bf16_t* X; bf16_t* XO; const float* gate;
    __device__ __forceinline__ void mid(f32x4 (&)[2][2][4][2], const Unit&, int, int, int, int) const {}
    __device__ __forceinline__ void operator()(const f32x4 (&acc)[2][2][4][2], const Unit& u, int wr, int wc, int fr, int fq) const {
        { const int l_ = tid_of(0); fr = l_ & 15; fq = l_ >> 4; }
        int row0 = u.row0 + wr * 64 + fr; asm volatile("" : "+v"(row0)); int col0 = u.pn * BM + wc * 32 + 8 * fq; asm volatile("" : "+v"(col0));
        const float* gp = gate + (size_t)(u.row0 / SEQ) * (6 * D) + col0;
        f32x4 gv[2][2];
#pragma unroll
        for (int bj = 0; bj < 2; ++bj)
#pragma unroll
            for (int n = 0; n < 2; ++n) gv[bj][n] = *(const f32x4*)(gp + bj * HALF + 4 * n);
#pragma unroll
        for (int ai = 0; ai < 2; ++ai) {
            u32x4 xv[4][2];
#pragma unroll
            for (int m = 0; m < 4; ++m) { const bf16_t* rowp = X + (size_t)(row0 + ai * HALF + m * 16) * D + col0;
#pragma unroll
                for (int bj = 0; bj < 2; ++bj) xv[m][bj] = *(const u32x4*)(rowp + bj * HALF); }
#pragma unroll
            for (int m = 0; m < 4; ++m) { bf16_t* rowo = XO + (size_t)(row0 + ai * HALF + m * 16) * D + col0;
#pragma unroll
                for (int bj = 0; bj < 2; ++bj) { const u32x4 p = xv[m][bj];
                    const f32x4 o0 = (f32x4){bflo(p.x), bfhi(p.x), bflo(p.y), bfhi(p.y)} + gv[bj][0] * acc[ai][bj][m][0], o1 = (f32x4){bflo(p.z), bfhi(p.z), bflo(p.w), bfhi(p.w)} + gv[bj][1] * acc[ai][bj][m][1];
                    u32x4 w; w.x = cvt_pk_bf16(o0[0], o0[1]); w.y = cvt_pk_bf16(o0[2], o0[3]); w.z = cvt_pk_bf16(o1[0], o1[1]); w.w = cvt_pk_bf16(o1[2], o1[3]);
                    *(u32x4*)(rowo + bj * HALF) = w; } }
            asm volatile("" ::: "memory"); }
    }
};
constexpr float SG_C = -1.702f * 1.4426950408889634f;
struct EpiSwiglu {
    static constexpr int PERM = 1; static constexpr int HOOK_T = -1; static constexpr bool PREF = true;
    unsigned char* ACT; const float* bias; float wscale;
    __device__ __forceinline__ void mid(f32x4 (&)[2][2][4][2], const Unit&, int, int, int, int) const {}
    __device__ __forceinline__ void operator()(const f32x4 (&)[2][2][4][2], const Unit&, int, int, int, int) const {}
    __device__ __forceinline__ void prefetch(const Unit& u, LAS unsigned char* tab, int wv) const {
        const int t = tid_of(wv) & 255;
        const __amdgpu_buffer_rsrc_t rs = __builtin_amdgcn_make_buffer_rsrc((void*)bias, 0, 0xffffffff, 0x00020000);
        __builtin_amdgcn_raw_ptr_buffer_load_lds(rs, (LAS void*)(tab + (wv & 3) * 256), 4, (unsigned)(u.e * 2048 + (t >> 7) * 1024 + u.pn * HALF + (t & 127)) * 4u, 0, 0, 0);
    }
    __device__ __forceinline__ void run(const f32x4 (&acc)[2][2][4][2], const Unit& u, int wr, int wc, const LAS unsigned char* tab) const {
        int fr, fq; { const int l_ = tid_of(0); fr = l_ & 15; fq = l_ >> 4; }
        int row0 = u.row0 + wr * 64 + fr; asm volatile("" : "+v"(row0)); int cc = u.pn * HALF + wc * 32 + 8 * fq; asm volatile("" : "+v"(cc));
        const LAS float* tf = (const LAS float*)tab + wc * 32 + 8 * fq;
        f32x4 bg[2], bu[2];
#pragma unroll
        for (int n = 0; n < 2; ++n) { bg[n] = *(const LAS f32x4*)(tf + 4 * n) * SG_C; bu[n] = *(const LAS f32x4*)(tf + HALF + 4 * n) + 1.0f; }
        const float wsc = wscale * SG_C;
#pragma unroll
        for (int ai = 0; ai < 2; ++ai)
#pragma unroll
            for (int m = 0; m < 4; ++m) { unsigned char* rowp = ACT + (size_t)(row0 + ai * HALF + m * 16) * D + cc;
                float o[8];
#pragma unroll
                for (int n = 0; n < 2; ++n) {
                    f32x4 t = acc[ai][0][m][n] * wsc + bg[n], up = acc[ai][1][m][n] * wscale + bu[n], e;
#pragma unroll
                    for (int j = 0; j < 4; ++j) { t[j] = fmaxf(t[j], 7.0f * SG_C); e[j] = __builtin_amdgcn_exp2f(t[j]); up[j] = __builtin_amdgcn_fmed3f(up[j], -6.0f, 8.0f); }
                    e += 1.0f;
#pragma unroll
                    for (int j = 0; j < 4; ++j) e[j] = __builtin_amdgcn_rcpf(e[j]);
                    const f32x4 r = (t * (1.0f / SG_C)) * (e * up);
#pragma unroll
                    for (int j = 0; j < 4; ++j) o[4 * n + j] = r[j]; }
                int w0 = 0, w1 = 0;
                w0 = __builtin_amdgcn_cvt_pk_fp8_f32(o[0], o[1], w0, false); w0 = __builtin_amdgcn_cvt_pk_fp8_f32(o[2], o[3], w0, true);
                w1 = __builtin_amdgcn_cvt_pk_fp8_f32(o[4], o[5], w1, false); w1 = __builtin_amdgcn_cvt_pk_fp8_f32(o[6], o[7], w1, true);
                *(u32x2*)rowp = (u32x2){(unsigned)w0, (unsigned)w1}; }
    }
};
struct EpiMoeOut {
    static constexpr int PERM = 2; static constexpr int HOOK_T = -1; static constexpr bool PREF = true;
    unsigned char* O; float* SC; const float* bias; float wscale;
    __device__ __forceinline__ void mid(f32x4 (&)[2][2][4][2], const Unit&, int, int, int, int) const {}
    __device__ __forceinline__ void operator()(const f32x4 (&)[2][2][4][2], const Unit&, int, int, int, int) const {}
    __device__ __forceinline__ void prefetch(const Unit& u, LAS unsigned char* tab, int wv) const {
        const int t = tid_of(wv) & 255;
        const __amdgpu_buffer_rsrc_t rs = __builtin_amdgcn_make_buffer_rsrc((void*)bias, 0, 0xffffffff, 0x00020000);
        __builtin_amdgcn_raw_ptr_buffer_load_lds(rs, (LAS void*)(tab + (wv & 3) * 256), 4, (unsigned)(u.e * D + u.pn * BM + t) * 4u, 0, 0, 0);
    }
    __device__ __forceinline__ void run(const f32x4 (&acc)[2][2][4][2], const Unit& u, int wr, int wc, const LAS unsigned char* tab) const {
        int fr, fq; { const int lane_ = tid_of(0); fr = lane_ & 15; fq = lane_ >> 4; }
        int row0 = u.row0 + wr * 64 + fr; asm volatile("" : "+v"(row0)); int col0 = u.pn * BM + wc * 64 + 16 * fq; asm volatile("" : "+v"(col0));
        const LAS float* tf = (const LAS float*)tab;
        f32x4 bv[2][2];
#pragma unroll
        for (int bj = 0; bj < 2; ++bj)
#pragma unroll
            for (int n = 0; n < 2; ++n) bv[bj][n] = *(const LAS f32x4*)(tf + wc * 64 + 16 * fq + 8 * bj + 4 * n);
        const float ws16 = wscale * OUT_FP8_SCALE;
#pragma unroll
        for (int bj = 0; bj < 2; ++bj)
#pragma unroll
            for (int n = 0; n < 2; ++n) bv[bj][n] *= OUT_FP8_SCALE;
#pragma unroll
        for (int ai = 0; ai < 2; ++ai)
#pragma unroll
            for (int m = 0; m < 4; ++m) { const size_t r = (size_t)(row0 + ai * HALF + m * 16);
                unsigned w[4];
#pragma unroll
                for (int q = 0; q < 4; ++q) { const f32x4 v = acc[ai][q >> 1][m][q & 1] * ws16 + bv[q >> 1][q & 1];
                    int p = 0; p = __builtin_amdgcn_cvt_pk_fp8_f32(v.x, v.y, p, false); p = __builtin_amdgcn_cvt_pk_fp8_f32(v.z, v.w, p, true); w[q] = (unsigned)p; }
                *(u32x4*)(O + r * D + col0) = (u32x4){w[0], w[1], w[2], w[3]}; }
    }
};
}

#define XB_TMO      128
#define XB_XCNT(j)  (256  + 64 * (j))
#define XB_XSUB(j)  (1280 + 64 * (j))
#define XB_XGEN(j)  (2304 + 64 * (j))
#define XB_TOP      3328
#define XB_TOPGEN   3392
#define XCD_BAR_WORDS 3456
#define XB_SPIN_CAP (1u << 18)
__device__ __forceinline__ unsigned xb_ld(unsigned* p)              { return __hip_atomic_load(p, __ATOMIC_RELAXED, __HIP_MEMORY_SCOPE_AGENT); }
__device__ __forceinline__ unsigned xb_add(unsigned* p, unsigned v) { return __hip_atomic_fetch_add(p, v, __ATOMIC_RELAXED, __HIP_MEMORY_SCOPE_AGENT); }
__device__ __forceinline__ unsigned xb_xcc_id() { return (unsigned)__builtin_amdgcn_s_getreg((3 << 11) | 20) & 0xFu; }
#define XB_SPIN(cond, bar) do { unsigned _sp = 0; while (cond) { __builtin_amdgcn_s_sleep(1); \
    if ((++_sp & 255u) == 0u) { if (xb_ld(&(bar)[XB_TMO])) break; if (_sp > XB_SPIN_CAP) { atomicAdd(&(bar)[XB_TMO], 1u); break; } } } } while (0)
struct XcdBarrier { unsigned* bar; unsigned x; volatile LAS unsigned* st; int wv; };
__device__ __forceinline__ XcdBarrier xcd_barrier_post(unsigned* bar, volatile LAS unsigned* st, int wv) {
    XcdBarrier b; b.bar = bar; b.x = xb_xcc_id(); b.st = st; b.wv = wv;
    if (tid_of(wv) == 0) (void)xb_add(&bar[XB_XCNT(b.x)], 1u);
    return b;
}
__device__ __forceinline__ void xcd_barrier_complete(unsigned* bar, unsigned x, unsigned& nloc, unsigned& nx) {
    const unsigned G = gridDim.x * gridDim.y * gridDim.z;
    unsigned sum, cnt, mine, sp = 0u;
    for (;;) {
        sum = 0u; cnt = 0u; mine = 0u;
#pragma unroll
        for (unsigned j = 0; j < 16; ++j) { const unsigned c = xb_ld(&bar[XB_XCNT(j)]); sum += c; cnt += (c > 0u) ? 1u : 0u; mine = (j == x) ? c : mine; }
        if (sum == G) break;
        __builtin_amdgcn_s_sleep(1);
        if ((++sp & 255u) == 0u) { if (xb_ld(&bar[XB_TMO])) break; if (sp > XB_SPIN_CAP) { atomicAdd(&bar[XB_TMO], 1u); break; } }
    }
    nloc = mine > 0u ? mine : 1u; nx = cnt > 0u ? cnt : 1u;
}
__device__ __forceinline__ void xcd_barrier(const XcdBarrier& b) {
    asm volatile("s_waitcnt vmcnt(0)" ::: "memory");
    __syncthreads();
    if (tid_of(b.wv) == 0) {
        size_t zb = 0; asm volatile("" : "+s"(zb)); unsigned* bar = b.bar + zb; unsigned bx = b.x; asm volatile("" : "+s"(bx));
        __builtin_amdgcn_s_waitcnt(0);
        unsigned nloc = b.st[0], nx = b.st[1];
        if (nloc == 0u) { xcd_barrier_complete(bar, bx, nloc, nx); b.st[0] = nloc; b.st[1] = nx; }
        const unsigned old = xb_add(&bar[XB_XSUB(bx)], 1u);
        const unsigned gen = old / nloc;
        if (old + 1u == (gen + 1u) * nloc) {
            __builtin_amdgcn_fence(__ATOMIC_RELEASE, "agent");
            asm volatile("s_waitcnt vmcnt(0)" ::: "memory");
            const unsigned og = xb_add(&bar[XB_TOP], 1u);
            const unsigned tg = og / nx;
            if (og + 1u == (tg + 1u) * nx) xb_add(&bar[XB_TOPGEN], 1u);
            else XB_SPIN(xb_ld(&bar[XB_TOPGEN]) == tg, bar);
            __builtin_amdgcn_fence(__ATOMIC_ACQUIRE, "agent");
            xb_add(&bar[XB_XGEN(bx)], 1u);
            asm volatile("s_waitcnt vmcnt(0)" ::: "memory");
        } else {
            XB_SPIN(xb_ld(&bar[XB_XGEN(bx)]) == gen, bar);
            __builtin_amdgcn_fence(__ATOMIC_ACQUIRE, "agent");
            asm volatile("s_waitcnt vmcnt(0)" ::: "memory");
        }
    }
    __syncthreads();
}

struct Args { const float* in[26]; float* out; unsigned char* ws; int ph_lo, ph_hi; };
enum { I_X = 0, I_C, I_N1G, I_N2G, I_WADA, I_BADA, I_WIN, I_CONVW, I_CONVB, I_WRGA, I_BRGA, I_WRGX, I_BRGX, I_LAM, I_WPOOL, I_PSCALE, I_WUPA, I_WUPB, I_WOUT, I_WROUTER, I_BROUTER, I_WEIN, I_BEIN, I_WEOUT, I_BEOUT, I_FINALG };

template <int ROWMODE>
__device__ __forceinline__ void tr_item(const float* W, int N, bf16_t* WT, int dst_ld, int dst_off, int k0, int n0, LAS float* scr, int lane) {
    { float tv[32];
#pragma unroll
    for (int i = 0; i < 32; ++i) tv[i] = W[(size_t)(k0 + 2 * i + (lane >> 5)) * N + n0 + (lane & 31)];
#pragma unroll
    for (int i = 0; i < 32; ++i) scr[(2 * i + (lane >> 5)) * 33 + (lane & 31)] = tv[i]; }
    LDS_WAIT();
    const int c = lane & 7;
#pragma unroll
    for (int j = 0; j < 4; ++j) { const int n = (lane >> 3) + 8 * j; const LAS float* s = scr + (8 * c) * 33 + n;
        u32x4 o; o.x = cvt_pk_bf16(s[0 * 33], s[1 * 33]); o.y = cvt_pk_bf16(s[2 * 33], s[3 * 33]); o.z = cvt_pk_bf16(s[4 * 33], s[5 * 33]); o.w = cvt_pk_bf16(s[6 * 33], s[7 * 33]);
        const int nn = n0 + n; int drow = nn;
        if (ROWMODE == 1) { drow = (nn < 1024) ? (256 * (nn >> 7) + (nn & 127)) : (256 * ((nn - 1024) >> 7) + 128 + ((nn - 1024) & 127)); }
        *(u32x4*)(WT + (size_t)drow * dst_ld + dst_off + k0 + 8 * c) = o; }
    LDS_WAIT();
}
template <int ROWMODE>
__device__ __forceinline__ void tr_item_fp8(const float* W, int N, unsigned char* WT, int k0, int n0, LAS float* scr, int lane) {
    { float tv[64];
#pragma unroll
    for (int i = 0; i < 64; ++i) tv[i] = W[(size_t)(k0 + 2 * i + (lane >> 5)) * N + n0 + (lane & 31)];
#pragma unroll
    for (int i = 0; i < 64; ++i) scr[(2 * i + (lane >> 5)) * 33 + (lane & 31)] = tv[i]; }
    LDS_WAIT();
    const int c = lane & 7;
#pragma unroll
    for (int j = 0; j < 4; ++j) { const int n = (lane >> 3) + 8 * j; const LAS float* s = scr + (16 * c) * 33 + n;
        int o[4];
#pragma unroll
        for (int q = 0; q < 4; ++q) { int w = 0; w = __builtin_amdgcn_cvt_pk_fp8_f32(s[(4 * q) * 33] * WEIN_SCALE, s[(4 * q + 1) * 33] * WEIN_SCALE, w, false);
            w = __builtin_amdgcn_cvt_pk_fp8_f32(s[(4 * q + 2) * 33] * WEIN_SCALE, s[(4 * q + 3) * 33] * WEIN_SCALE, w, true); o[q] = w; }
        const int nn = n0 + n; const int drow = (ROWMODE == 0) ? nn : ((nn < 1024) ? (256 * (nn >> 7) + (nn & 127)) : (256 * ((nn - 1024) >> 7) + 128 + ((nn - 1024) & 127)));
        *(u32x4*)(WT + (size_t)drow * 1024 + k0 + 16 * c) = (u32x4){(unsigned)o[0], (unsigned)o[1], (unsigned)o[2], (unsigned)o[3]}; }
    LDS_WAIT();
}
template <int ROWMODE>
__device__ __forceinline__ void tr_job(int item, const float* src, int K, int N, bf16_t* dst, size_t dst_bstride, int dst_ld, int dst_off, LAS float* scr, int lane) {
    const int nnb = N / 32, nkb = K / 64; const int nb = item % nnb; const int r = item / nnb; const int kb = r % nkb; const int bt = r / nkb;
    tr_item<ROWMODE>(src + (size_t)bt * K * N, N, dst + (size_t)bt * dst_bstride, dst_ld, dst_off, 64 * kb, 32 * nb, scr, lane);
}

constexpr int CONV_Q1 = 5, CONV_Q2 = 6;
constexpr int CONV_ITEMS_L = NE * 8 * 64 + NE * 8 * 32, CONV_CHUNKS_L = CONV_ITEMS_L / 8;
__device__ __forceinline__ void conv_expert_item(const Args& a, unsigned char* ws, int l, int r, LAS float* scr, int lane) {
    if (r < NE * 8 * 64) { const int nb = r % 64, r2 = r / 64, kb = r2 % 8, bt = l * NE + r2 / 8;
        tr_item_fp8<1>(a.in[I_WEIN] + (size_t)bt * 1024 * 2048, 2048, (unsigned char*)(ws + WS_WEIN) + (size_t)bt * 2048 * 1024, 128 * kb, 32 * nb, scr, lane); }
    else { r -= NE * 8 * 64; const int nb = r % 32, r2 = r / 32, kb = r2 % 8, bt = l * NE + r2 / 8;
        tr_item_fp8<0>(a.in[I_WEOUT] + (size_t)bt * 1024 * 1024, 1024, (unsigned char*)(ws + WS_WEOUT) + (size_t)bt * 1024 * 1024, 128 * kb, 32 * nb, scr, lane); }
}
__device__ __forceinline__ void conv_drain(const Args& a, int l, int budget, LAS unsigned char* lds, const int wv) {
    asm volatile("" : "+s"(lds));
    int tid_ = tid_of(wv); asm volatile("" : "+v"(tid_)); const int tid = tid_, lane = tid & 63;
    unsigned char* ws = opaque_ptr(a.ws); unsigned* head = (unsigned*)(ws + WS_CTL) + CW_CONVQ + 64 * l;
    LAS float* scr = (LAS float*)(lds + wv * 16896); LAS int* slot = (LAS int*)(lds + LDS_BYTES - 512);
    for (;;) {
        if (budget == 0) break;
        __syncthreads();
        if (tid == 0) *slot = (int)__hip_atomic_fetch_add(head, 1u, __ATOMIC_RELAXED, __HIP_MEMORY_SCOPE_AGENT);
        __syncthreads();
        const int c = __builtin_amdgcn_readfirstlane(*slot);
        if (c >= CONV_CHUNKS_L) break;
        conv_expert_item(a, ws, l, c * 8 + wv, scr, lane);
        if (budget > 0) --budget;
    }
    __syncthreads();
}
__device__ __forceinline__ void phase_prologue(const Args& a, LAS unsigned char* lds, const int wv) {
    asm volatile("" : "+s"(lds));
    int tid_ = tid_of(wv); asm volatile("" : "+v"(tid_)); const int tid = tid_, lane = tid & 63, wave = __builtin_amdgcn_readfirstlane(tid >> 6);
    const int G = gridDim.x;
    unsigned char* ws = opaque_ptr(a.ws); const int bid = opaque_bid();
    {
        LAS float* cact = (LAS float*)lds;
        LAS float* red = (LAS float*)(lds + 32768);
        for (int i = tid; i < NBATCH * D; i += NTHREADS) { const float v = a.in[I_C][i]; cact[i] = v * sigmoidf_(v); }
        __syncthreads();
        float* mod = (float*)(ws + WS_MOD);
        for (int u = bid; u < DEPTH * 96; u += G) {
            const int l = u / 96, cg = u % 96; const int n = cg * 64 + lane;
            const float* w = a.in[I_WADA] + (size_t)l * D * 6144 + n;
            float acc[8] = {0.f, 0.f, 0.f, 0.f, 0.f, 0.f, 0.f, 0.f};
            const int kb = wave * 128;
#pragma unroll 8
            for (int k = 0; k < 128; ++k) { const float wv = w[(size_t)(kb + k) * 6144];
#pragma unroll
                for (int b = 0; b < 8; ++b) acc[b] += cact[b * D + kb + k] * wv; }
#pragma unroll
            for (int b = 0; b < 8; ++b) red[(wave * 8 + b) * 64 + lane] = acc[b];
            __syncthreads();
            { const int b = tid >> 6; float s = 0.f;
#pragma unroll
              for (int w8 = 0; w8 < 8; ++w8) s += red[(w8 * 8 + b) * 64 + lane];
              mod[((size_t)l * NBATCH + b) * 6144 + n] = s + a.in[I_BADA][(size_t)l * 6144 + n]; }
            __syncthreads();
        }
    }
#if Z_I8
    {
        LAS float* tile = (LAS float*)lds; LAS float* red = (LAS float*)(lds + 1024 * 33 * 4);
        signed char* w8 = (signed char*)(ws + WS_WIN); float* wsc = (float*)(ws + WS_WINSC);
        __syncthreads();
        for (int u = bid; u < DEPTH * (NZ / 32); u += G) {
            const int l = u / (NZ / 32), n0 = (u % (NZ / 32)) * 32; const float* W = a.in[I_WIN] + (size_t)l * D * NZ + n0;
            const int n = tid & 31, kr = tid >> 5;
#pragma unroll 1
            for (int k0 = 0; k0 < 1024; k0 += 256) { float tv[16];
#pragma unroll
                for (int i = 0; i < 16; ++i) tv[i] = W[(size_t)(k0 + 16 * i + kr) * NZ + n];
#pragma unroll
                for (int i = 0; i < 16; ++i) tile[(k0 + 16 * i + kr) * 33 + n] = tv[i]; }
            __syncthreads();
            { float am = 0.f;
#pragma unroll 8
              for (int i = 0; i < 64; ++i) am = fmaxf(am, fabsf(tile[(kr * 64 + i) * 33 + n]));
              red[kr * 32 + n] = am; }
            __syncthreads();
            if (tid < 32) { float am = 1e-30f;
#pragma unroll
                for (int q = 0; q < 16; ++q) am = fmaxf(am, red[q * 32 + tid]);
                red[512 + tid] = 127.0f / am; wsc[(size_t)l * NZ + n0 + tid] = am * (1.0f / 127.0f); }
            __syncthreads();
            { const float inv = red[512 + n]; signed char* dst = w8 + ((size_t)l * NZ + n0 + n) * D + kr * 64;
#pragma unroll
              for (int c = 0; c < 4; ++c) { int w4[4];
#pragma unroll
                  for (int q = 0; q < 4; ++q) { int pk = 0;
#pragma unroll
                      for (int e = 0; e < 4; ++e) pk |= (((int)rintf(tile[(kr * 64 + c * 16 + q * 4 + e) * 33 + n] * inv)) & 0xff) << (8 * e);
                      w4[q] = pk; }
                  *(u32x4*)(dst + 16 * c) = (u32x4){(unsigned)w4[0], (unsigned)w4[1], (unsigned)w4[2], (unsigned)w4[3]}; } }
            __syncthreads();
        }
    }
#endif
    {
        LAS float* scr = (LAS float*)(lds + wave * 16896);
        const int gw = bid * NWAVES + wave, NGW = G * NWAVES;
        constexpr int I_EIN = NE * 8 * 64, I_EOUT = NE * 8 * 32, I_WINI = Z_I8 ? 0 : DEPTH * (Z_FP8 ? 8 : 16) * 144, I_UPA = DEPTH * 16 * 32, I_UPB = DEPTH * 8 * 32, I_OUT = DEPTH * 16 * 32,
                      I_RGA = DEPTH * 8 * 2 * 4, I_RGX = I_RGA, I_POOL = DEPTH * 4 * 2 * 4;
        constexpr int NITEMS = I_EIN + I_EOUT + I_WINI + I_UPA + I_UPB + I_OUT + I_RGA + I_RGX + I_POOL;
        for (int it = gw; it < NITEMS; it += NGW) {
            int r = it;
            if (r < I_EIN) { const int nb = r % 64, r2 = r / 64, kb = r2 % 8, bt = r2 / 8;
                tr_item_fp8<1>(a.in[I_WEIN] + (size_t)bt * 1024 * 2048, 2048, (unsigned char*)(ws + WS_WEIN) + (size_t)bt * 2048 * 1024, 128 * kb, 32 * nb, scr, lane); continue; } r -= I_EIN;
            if (r < I_EOUT) { const int nb = r % 32, r2 = r / 32, kb = r2 % 8, bt = r2 / 8;
                tr_item_fp8<0>(a.in[I_WEOUT] + (size_t)bt * 1024 * 1024, 1024, (unsigned char*)(ws + WS_WEOUT) + (size_t)bt * 1024 * 1024, 128 * kb, 32 * nb, scr, lane); continue; } r -= I_EOUT;
#if Z_I8
#elif Z_FP8
            if (r < I_WINI) { const int nb = r % 144, r2 = r / 144, kb = r2 % 8, bt = r2 / 8;
                tr_item_fp8<0>(a.in[I_WIN] + (size_t)bt * 1024 * NZ, NZ, (unsigned char*)(ws + WS_WIN) + (size_t)bt * NZ * 1024, 128 * kb, 32 * nb, scr, lane); continue; } r -= I_WINI;
#else
            if (r < I_WINI) { tr_job<0>(r, a.in[I_WIN], 1024, NZ, (bf16_t*)(ws + WS_WIN), (size_t)NZ * 1024, 1024, 0, scr, lane); continue; } r -= I_WINI;
#endif
            if (r < I_UPA) { tr_job<0>(r, a.in[I_WUPA], 1024, 1024, (bf16_t*)(ws + WS_WCAT), (size_t)1024 * KCAT, KCAT, 512, scr, lane); continue; } r -= I_UPA;
            if (r < I_UPB) { tr_job<0>(r, a.in[I_WUPB], 512, 1024, (bf16_t*)(ws + WS_WCAT), (size_t)1024 * KCAT, KCAT, 0, scr, lane); continue; } r -= I_UPB;
            if (r < I_OUT) { tr_job<0>(r, a.in[I_WOUT], 1024, 1024, (bf16_t*)(ws + WS_WOUT), (size_t)1024 * 1024, 1024, 0, scr, lane); continue; } r -= I_OUT;
            if (r < I_RGA) { tr_job<0>(r, a.in[I_WRGA], 128, 128, (bf16_t*)(ws + WS_WRG), (size_t)256 * 128, 128, 0, scr, lane); continue; } r -= I_RGA;
            if (r < I_RGX) { tr_job<0>(r, a.in[I_WRGX], 128, 128, (bf16_t*)(ws + WS_WRG) + 128 * 128, (size_t)256 * 128, 128, 0, scr, lane); continue; } r -= I_RGX;
            tr_job<0>(r, a.in[I_WPOOL], 128, 128, (bf16_t*)(ws + WS_WPOOL), (size_t)128 * 128, 128, 0, scr, lane);
        }
    }
}

struct MoeTab { LAS int* cnt; LAS int* padstart; LAS int* tilestart; LAS int* tab; };
__device__ __forceinline__ MoeTab moe_tab_ptrs(LAS unsigned char* lds) { MoeTab t; t.cnt = (LAS int*)(lds + LDS_TAB); t.padstart = t.cnt + 32; t.tilestart = t.padstart + 40; t.tab = t.tilestart + 40; return t; }
__device__ __forceinline__ void moe_tables(const Args& a, int l, LAS unsigned char* lds, const int wv) {
    asm volatile("" : "+s"(lds));
    const MoeTab mt = moe_tab_ptrs(lds); int tid_ = tid_of(wv); asm volatile("" : "+v"(tid_)); const int tid = tid_;
    unsigned* ctl = (unsigned*)(opaque_ptr(a.ws) + WS_CTL);
    __syncthreads();
    if (tid < NE) mt.cnt[tid] = (int)__hip_atomic_load(ctl + CW_CNT + (l * NE + tid) * 16, __ATOMIC_RELAXED, __HIP_MEMORY_SCOPE_AGENT);
    __syncthreads();
    if (tid == 0) { int ps = 0, ts = 0; for (int e = 0; e < NE; ++e) { mt.padstart[e] = ps; mt.tilestart[e] = ts; const int nt = (mt.cnt[e] + 255) >> 8; ps += nt * 256; ts += nt; } mt.padstart[NE] = ps; mt.tilestart[NE] = ts; }
    __syncthreads();
    const int nMt = mt.tilestart[NE];
    for (int m = tid; m < nMt; m += NTHREADS) { int e = 0; for (int q = 1; q < NE; ++q) e = (mt.tilestart[q] <= m) ? q : e; mt.tab[m] = (e << 16) | (m - mt.tilestart[e]); }
    __syncthreads();
}
#ifndef MOE_WGM1
#define MOE_WGM1 4
#endif
#ifndef MOE_WGM2
#define MOE_WGM2 8
#endif
struct MoeSched1 {
    static constexpr bool DYN_A = true;
    const char* H; const char* W; const int* tokof; MoeTab mt; int nMt, G, c;
    __device__ __forceinline__ bool next(int i, pg8::Unit& u) const { int pm, pn; if (!pg8::order_map<MOE_WGM1>(i, G, c, nMt, 8, pm, pn)) return false;
        const int en = __builtin_amdgcn_readfirstlane(mt.tab[pm]); u.pm = pm; u.pn = pn; u.e = en >> 16; u.j = en & 0xffff;
        u.row0 = __builtin_amdgcn_readfirstlane(mt.padstart[u.e]) + 256 * u.j; u.rows = __builtin_amdgcn_readfirstlane(mt.cnt[u.e]) - 256 * u.j; return true; }
    __device__ __forceinline__ const char* a_ptr() const { return H; }
    __device__ __forceinline__ const char* b_ptr() const { return W; }
    __device__ __forceinline__ unsigned a_off(const pg8::Unit&) const { return 0u; }
    __device__ __forceinline__ unsigned b_off(const pg8::Unit& u) const { return ((unsigned)u.e * 2048u + (unsigned)u.pn * 256u) * 1024u; }
    __device__ __forceinline__ void a_voff(const pg8::Unit& u, unsigned (&v)[2][2], int wv) const {
        int tid = tid_of(wv); asm volatile("" : "+v"(tid));
        const int* tl = tokof + (size_t)u.e * T + 256 * u.j; const int rmax = u.rows - 1;
        int tk[2][2], cc[2];
#pragma unroll
        for (int i = 0; i < 2; ++i) { int R, C; pg8::stage_rc(tid * 16 + i * 8192, R, C); cc[i] = C;
#pragma unroll
            for (int h = 0; h < 2; ++h) { int idx = h * 128 + R; idx = idx < rmax ? idx : rmax; tk[h][i] = tl[idx]; } }
        asm volatile("" ::: "memory");
#pragma unroll
        for (int i = 0; i < 2; ++i)
#pragma unroll
            for (int h = 0; h < 2; ++h) v[h][i] = (unsigned)tk[h][i] * 1024u + (unsigned)cc[i] * 2u;
    }
    __device__ __forceinline__ void a_dma(const pg8::Unit& u, LAS unsigned char* slots, int wv) const {
        const int tid = tid_of(wv); const int rmax = u.rows - 1;
        const __amdgpu_buffer_rsrc_t rs = __builtin_amdgcn_make_buffer_rsrc((void*)tokof, 0, 0xffffffff, 0x00020000);
        const unsigned so = (unsigned)(u.e * T + 256 * u.j) * 4u;
#pragma unroll
        for (int i = 0; i < 2; ++i) { int R, C; pg8::stage_rc(tid * 16 + i * 8192, R, C);
#pragma unroll
            for (int h = 0; h < 2; ++h) { int idx = h * 128 + R; idx = idx < rmax ? idx : rmax;
                __builtin_amdgcn_raw_ptr_buffer_load_lds(rs, (LAS void*)(slots + (h * 2 + i) * 2048 + wv * 256), 4, (unsigned)idx * 4u, so, 0, 0); } }
    }
    __device__ __forceinline__ void a_fetch(const LAS unsigned char* slots, int wv, unsigned (&q)[4]) const {
        const int tid = tid_of(wv); int R, C; pg8::stage_rc(tid * 16, R, C);
#pragma unroll
        for (int k = 0; k < 4; ++k) q[k] = *(const LAS unsigned*)(slots + k * 2048 + tid * 4) * 1024u + (unsigned)C * 2u;
    }
};
struct MoeSched2 {
    static constexpr bool DYN_A = false;
    const char* ACT; const char* W; MoeTab mt; int nMt, G, c;
    __device__ __forceinline__ bool next(int i, pg8::Unit& u) const { int pm, pn; if (!pg8::order_map<MOE_WGM2>(i, G, c, nMt, 4, pm, pn)) return false;
        const int en = __builtin_amdgcn_readfirstlane(mt.tab[pm]); u.pm = pm; u.pn = pn; u.e = en >> 16; u.j = en & 0xffff;
        u.row0 = __builtin_amdgcn_readfirstlane(mt.padstart[u.e]) + 256 * u.j; u.rows = __builtin_amdgcn_readfirstlane(mt.cnt[u.e]) - 256 * u.j; return true; }
    __device__ __forceinline__ const char* a_ptr() const { return ACT; }
    __device__ __forceinline__ const char* b_ptr() const { return W; }
    __device__ __forceinline__ unsigned a_off(const pg8::Unit& u) const { return (unsigned)u.row0 * 1024u; }
    __device__ __forceinline__ unsigned b_off(const pg8::Unit& u) const { return ((unsigned)u.e * 1024u + (unsigned)u.pn * 256u) * 1024u; }
    __device__ __forceinline__ void a_voff(const pg8::Unit&, unsigned (&v)[2][2], int wv) const {
        int tid = tid_of(wv); asm volatile("" : "+v"(tid));
#pragma unroll
        for (int i = 0; i < 2; ++i) { int R, C; pg8::stage_rc(tid * 16 + i * 8192, R, C);
#pragma unroll
            for (int h = 0; h < 2; ++h) v[h][i] = (unsigned)((h * 128 + R) * 512 + C) * 2u; }
    }
};

template <int LK>
__device__ __forceinline__ void phase_a(const Args& a, int l, LAS unsigned char* lds, bool dry, const int wv) {
    asm volatile("" : "+s"(lds));
    int tid_ = tid_of(wv); asm volatile("" : "+v"(tid_)); const int tid = tid_, lane = tid & 63, wave = __builtin_amdgcn_readfirstlane(tid >> 6);
    const int G = gridDim.x; unsigned char* ws = opaque_ptr(a.ws); const int bid = opaque_bid();
    const float* mod = (const float*)(ws + WS_MOD);
    bf16_t* xres = (bf16_t*)(ws + WS_XRES); bf16_t* xout = dry ? (bf16_t*)(ws + WS_Z) : xres;
    if ((LK != 2)) {
        LAS float* red = (LAS float*)lds;
        for (int wu = bid; wu < NBATCH * NE; wu += G) { const int b2 = wu >> 5, e = wu & 31;
            const float* sh2 = mod + ((size_t)l * NBATCH + b2) * 6144 + 3 * D; const float* wr = a.in[I_WROUTER] + (size_t)l * D * NE;
            float sm = sh2[tid] * wr[tid * NE + e] + sh2[tid + 512] * wr[(tid + 512) * NE + e];
            sm = wave_sum(sm, lane);
            __syncthreads();
            if (lane == 0) red[wave] = sm;
            __syncthreads();
            if (tid == 0) { float t = a.in[I_BROUTER][l * NE + e]; for (int q = 0; q < 8; ++q) t += red[q]; ((float*)(ws + WS_CB))[(l * NBATCH + b2) * NE + e] = t; }
        }
        __syncthreads();
    }
    if ((LK != 2)) {
        for (int wu = bid; wu < NBATCH * 32; wu += G) { const int b2 = wu >> 5, part = wu & 31;
            const float* n2 = a.in[I_N2G] + (size_t)l * D; const float* sc2 = mod + ((size_t)l * NBATCH + b2) * 6144 + 4 * D; const float* wr2 = a.in[I_WROUTER] + (size_t)l * D * NE;
            bf16_t* wrb = (bf16_t*)(ws + WS_WRB) + (size_t)b2 * 2 * NE * D;
#pragma unroll
            for (int r = 0; r < 2; ++r) { const int idx = part * 1024 + r * NTHREADS + tid; const int ee = idx & 31, k = idx >> 5;
                const float w = wr2[idx] * (n2[k] * (1.0f + sc2[k])); const unsigned hi = cvt_pk_bf16(w, 0.f) & 0xffffu; const unsigned lo = cvt_pk_bf16(w - bflo(hi), 0.f) & 0xffffu;
                wrb[(size_t)ee * D + k] = (bf16_t)hi; wrb[(size_t)(NE + ee) * D + k] = (bf16_t)lo; } }
    }
    if ((LK != 0)) moe_tables(a, (l - 1) + DEPTH * (REPN(7) - 1), lds, wv);
    const MoeTab mt = moe_tab_ptrs(lds);
    const int* slotinfo = (const int*)(ws + WS_SLOTINFO); const float* wgt = (const float*)(ws + WS_WGT);
    const unsigned char* outb = (const unsigned char*)(ws + WS_OUTB); const float* outsc = (const float*)(ws + WS_OUTSC);
    unsigned char* hb = (unsigned char*)(ws + WS_H);
    for (int chunk = bid; chunk < T / 128; chunk += G) {
        const int rowb = chunk * 128 + wave * 16; const int b = rowb / SEQ;
        const float* xin = a.in[I_X] + (size_t)rowb * D; const bf16_t* xinb = xres + (size_t)rowb * D;
        f32x4 xv[2][4]; int4 si[4]; f32x4 wv[4]; unsigned gv[2][4][4];
#define PA_SX(r, q) do { if ((r) < 16) { _Pragma("unroll") for (int j = 0; j < 4; ++j) { if ((LK == 0)) xv[(q) & 1][j] = *(const f32x4*)(xin + (size_t)(r) * D + 4 * lane + 256 * j); \
            else { const f32x2 t_ = *(const f32x2*)(xinb + (size_t)(r) * D + 4 * lane + 256 * j); xv[(q) & 1][j].x = t_.x; xv[(q) & 1][j].y = t_.y; } } } } while (0)
#define PA_S0(r, q) do { if ((r) < 16 && (LK != 0)) { si[(q) & 3] = *(const int4*)(slotinfo + (size_t)(rowb + (r)) * 4); wv[(q) & 3] = *(const f32x4*)(wgt + (size_t)(rowb + (r)) * 4); } } while (0)
#define PA_S1(r, q) do { if ((r) < 16 && (LK != 0)) { const int sl_[4] = {si[(q) & 3].x, si[(q) & 3].y, si[(q) & 3].z, si[(q) & 3].w}; \
            _Pragma("unroll") for (int kk = 0; kk < 4; ++kk) { const int e_ = sl_[kk] >> 24, li_ = sl_[kk] & 0xffffff; const size_t slot_ = (size_t)(mt.padstart[e_] + li_); const unsigned char* orow = outb + slot_ * D + 4 * lane; \
                _Pragma("unroll") for (int j = 0; j < 4; ++j) gv[(q) & 1][kk][j] = *(const unsigned*)(orow + 256 * j); } } } while (0)
        f32x4 gmv[4], shv[4], g2v[4];
#pragma unroll
        for (int j = 0; j < 4; ++j) {
            if ((LK != 2)) { const float* ng_ = a.in[I_N1G] + (size_t)l * D + 4 * lane + 256 * j; const float* mb_ = mod + ((size_t)l * NBATCH + b) * 6144 + 4 * lane + 256 * j;
                gmv[j] = *(const f32x4*)ng_ * (1.0f + *(const f32x4*)(mb_ + D)); shv[j] = *(const f32x4*)mb_; }
            else { gmv[j] = *(const f32x4*)(a.in[I_FINALG] + 4 * lane + 256 * j); shv[j] = (f32x4){0.f, 0.f, 0.f, 0.f}; }
            g2v[j] = ((LK != 0)) ? *(const f32x4*)(mod + ((size_t)(l - 1) * NBATCH + b) * 6144 + 5 * D + 4 * lane + 256 * j) : (f32x4){0.f, 0.f, 0.f, 0.f}; }
        PA_S0(0, 0); PA_S0(1, 1); PA_SX(0, 0); PA_S1(0, 0);
#pragma unroll 1
        for (int i0 = 0; i0 < 16; i0 += 4) {
#pragma unroll
          for (int ii = 0; ii < 4; ++ii) {
            const int i = i0 + ii; const int row = rowb + i;
            PA_S0(i + 2, ii + 2); PA_SX(i + 1, ii + 1); PA_S1(i + 1, ii + 1);
            f32x4 v[4];
#pragma unroll
            for (int j = 0; j < 4; ++j) { v[j] = xv[ii & 1][j];
                if ((LK != 0)) { const unsigned p0 = __float_as_uint(v[j].x), p1 = __float_as_uint(v[j].y); v[j] = (f32x4){bflo(p0), bfhi(p0), bflo(p1), bfhi(p1)}; } }
            if ((LK != 0)) {
                f32x4 y[4];
#pragma unroll
                for (int j = 0; j < 4; ++j) y[j] = (f32x4){0.f, 0.f, 0.f, 0.f};
#pragma unroll
                for (int kk = 0; kk < 4; ++kk) { const float wk = wv[ii][kk] * (1.0f / OUT_FP8_SCALE);
#pragma unroll
                    for (int j = 0; j < 4; ++j) { const int p = (int)gv[ii & 1][kk][j];
                        const auto lo = __builtin_amdgcn_cvt_pk_f32_fp8(p, false), hi = __builtin_amdgcn_cvt_pk_f32_fp8(p, true);
                        y[j] += wk * (f32x4){lo[0], lo[1], hi[0], hi[1]}; } }
#pragma unroll
                for (int j = 0; j < 4; ++j) v[j] += g2v[j] * y[j];
            }
            if ((LK != 2)) {
#pragma unroll
                for (int j = 0; j < 4; ++j) { u32x2 p; p.x = cvt_pk_bf16(v[j].x, v[j].y); p.y = cvt_pk_bf16(v[j].z, v[j].w); *(u32x2*)(xout + (size_t)row * D + 4 * lane + 256 * j) = p; }
            }
            float ss = 0.f;
#pragma unroll
            for (int j = 0; j < 4; ++j) ss += (v[j].x * v[j].x + v[j].y * v[j].y) + (v[j].z * v[j].z + v[j].w * v[j].w);
            const float rinv = __builtin_amdgcn_rsqf(wave_sum(ss, lane) * (1.0f / D) + NORM_EPS);
            if ((LK != 2)) {
                f32x4 hq[4]; (void)hq;
#pragma unroll
                for (int j = 0; j < 4; ++j) {
                    const f32x4 h = (v[j] * rinv) * gmv[j] + shv[j];
#if Z_I8
                    hq[j] = h; }
                {   float am = 0.f;
#pragma unroll
                    for (int j = 0; j < 4; ++j) am = fmaxf(fmaxf(fmaxf(fabsf(hq[j].x), fabsf(hq[j].y)), fmaxf(fabsf(hq[j].z), fabsf(hq[j].w))), am);
                    am = wave_max(am);
                    am = fmaxf(am, 1e-20f); const float inv = 127.0f / am;
                    if (lane == 0) ((float*)(ws + WS_HSC))[row] = am * (1.0f / 127.0f);
#pragma unroll
                    for (int j = 0; j < 4; ++j) { const int q0 = (int)rintf(hq[j].x * inv), q1 = (int)rintf(hq[j].y * inv), q2 = (int)rintf(hq[j].z * inv), q3 = (int)rintf(hq[j].w * inv);
                        *(int*)(hb + (size_t)row * D + 4 * lane + 256 * j) = (q0 & 0xff) | ((q1 & 0xff) << 8) | ((q2 & 0xff) << 16) | ((q3 & 0xff) << 24); }
                }
#elif Z_FP8
                    int p = 0; p = __builtin_amdgcn_cvt_pk_fp8_f32(h.x, h.y, p, false); p = __builtin_amdgcn_cvt_pk_fp8_f32(h.z, h.w, p, true);
                    *(int*)(hb + (size_t)row * D + 4 * lane + 256 * j) = p; }
#else
                    u32x2 p; p.x = cvt_pk_bf16(h.x, h.y); p.y = cvt_pk_bf16(h.z, h.w); *(u32x2*)((bf16_t*)hb + (size_t)row * D + 4 * lane + 256 * j) = p; }
#endif
            } else {
#pragma unroll
                for (int j = 0; j < 4; ++j) *(f32x4*)(a.out + (size_t)row * D + 4 * lane + 256 * j) = v[j] * rinv * gmv[j];
            }
          }
        }
#undef PA_S0
#undef PA_SX
#undef PA_S1
    }
}

constexpr int H_WLDS = 20480, H_WROW = 2048 + 16;
static_assert(H_WLDS + 64 * H_WROW <= LDS_BYTES - 512, "phase H LDS map");
__device__ __forceinline__ void phase_h(const Args& a, int l, int cset, LAS unsigned char* lds, const int wv) {
    asm volatile("" : "+s"(lds));
    int tid_ = tid_of(wv); asm volatile("" : "+v"(tid_)); const int tid = tid_, lane = tid & 63, wave = __builtin_amdgcn_readfirstlane(tid >> 6);
    const int G = gridDim.x; unsigned char* ws = opaque_ptr(a.ws); const int bid = opaque_bid();
    const float* mod = (const float*)(ws + WS_MOD); const bf16_t* xres = (const bf16_t*)(ws + WS_XRES);
    unsigned char* h8 = (unsigned char*)(ws + WS_H);
    LAS float* rinvs = (LAS float*)lds;
    LAS float* lgt = (LAS float*)(lds + 1024);
    LAS int* hist = (LAS int*)(lds + 1024 + 8 * 16 * 33 * 4);
    LAS int* base = hist + 32;
    unsigned* ctl = (unsigned*)(ws + WS_CTL);
    const float* ng = a.in[I_N2G] + (size_t)l * D;
    const float* cbv = (const float*)(ws + WS_CB);
    int* tokof = (int*)(ws + WS_TOKOF); int* slotinfo = (int*)(ws + WS_SLOTINFO); float* wgt = (float*)(ws + WS_WGT);
    for (int chunk = bid; chunk < T / 128; chunk += G) {
        const int row0 = chunk * 128 + wave * 16; const int b = row0 / SEQ;
        const float* mb = mod + ((size_t)l * NBATCH + b) * 6144 + 3 * D;
        if (tid < 32) hist[tid] = 0;
        {
            const __amdgpu_buffer_rsrc_t rw = __builtin_amdgcn_make_buffer_rsrc((void*)((const bf16_t*)(ws + WS_WRB) + (size_t)b * 2 * NE * D), 0, 0xffffffff, 0x00020000);
#pragma unroll
            for (int k = 0; k < 16; ++k) { const int wrow = wave * 8 + (k >> 1), half = k & 1;
                __builtin_amdgcn_raw_ptr_buffer_load_lds(rw, (LAS void*)(lds + H_WLDS + wrow * H_WROW + half * 1024), 16, (unsigned)lane * 16u, (unsigned)(wrow * 2048 + half * 1024), 0, 0); }
        }
        f32x4 gm2[4], sh2[4];
#pragma unroll
        for (int j = 0; j < 4; ++j) { gm2[j] = *(const f32x4*)(ng + 4 * lane + 256 * j) * (1.0f + *(const f32x4*)(mb + D + 4 * lane + 256 * j)); sh2[j] = *(const f32x4*)(mb + 4 * lane + 256 * j); }
        u32x2 xq[16][4];
#pragma unroll
        for (int r = 0; r < 16; ++r)
#pragma unroll
            for (int j = 0; j < 4; ++j) xq[r][j] = *(const u32x2*)(xres + (size_t)(row0 + r) * D + 4 * lane + 256 * j);
        asm volatile("" ::: "memory");
#pragma unroll
        for (int i = 0; i < 16; ++i) {
            const int row = row0 + i;
            f32x4 v[4]; float ss = 0.f;
#pragma unroll
            for (int j = 0; j < 4; ++j) { const u32x2 p = xq[i][j]; v[j] = (f32x4){bflo(p.x), bfhi(p.x), bflo(p.y), bfhi(p.y)}; ss += (v[j].x * v[j].x + v[j].y * v[j].y) + (v[j].z * v[j].z + v[j].w * v[j].w); }
            const float rinv = __builtin_amdgcn_rsqf(wave_sum(ss, lane) * (1.0f / D) + NORM_EPS);
            if (lane == 0) rinvs[wave * 16 + i] = rinv;
#pragma unroll
            for (int j = 0; j < 4; ++j) {
                const f32x4 h = (v[j] * rinv) * gm2[j] + sh2[j];
                int p = 0; p = __builtin_amdgcn_cvt_pk_fp8_f32(h.x, h.y, p, false); p = __builtin_amdgcn_cvt_pk_fp8_f32(h.z, h.w, p, true);
                *(int*)(h8 + (size_t)row * D + 4 * lane + 256 * j) = p; }
        }
        {
            const int ri = lane & 15, q = lane >> 4;
            const bf16_t* xr = xres + (size_t)(row0 + ri) * D + 8 * q;
            bf16x8 axs[32];
#pragma unroll
            for (int kb = 0; kb < 32; ++kb) axs[kb] = *(const bf16x8*)(xr + 32 * kb);
            asm volatile("s_waitcnt vmcnt(0)" ::: "memory");
            __syncthreads();
            const LAS unsigned char* wh = lds + H_WLDS + ri * H_WROW + 16 * q; const LAS unsigned char* wl = wh + NE * H_WROW;
            f32x4 acc0 = {0.f, 0.f, 0.f, 0.f}, acc1 = {0.f, 0.f, 0.f, 0.f};
#pragma unroll
            for (int kb = 0; kb < 32; ++kb) {
                const bf16x8 ax = axs[kb];
                const bf16x8 bh0 = *(const LAS bf16x8*)(wh + 64 * kb), bl0 = *(const LAS bf16x8*)(wl + 64 * kb), bh1 = *(const LAS bf16x8*)(wh + 16 * H_WROW + 64 * kb), bl1 = *(const LAS bf16x8*)(wl + 16 * H_WROW + 64 * kb);
                acc0 = __builtin_amdgcn_mfma_f32_16x16x32_bf16(ax, bh0, acc0, 0, 0, 0); acc0 = __builtin_amdgcn_mfma_f32_16x16x32_bf16(ax, bl0, acc0, 0, 0, 0);
                acc1 = __builtin_amdgcn_mfma_f32_16x16x32_bf16(ax, bh1, acc1, 0, 0, 0); acc1 = __builtin_amdgcn_mfma_f32_16x16x32_bf16(ax, bl1, acc1, 0, 0, 0);
            }
            LDS_WAIT();
            const float c0 = cbv[(l * NBATCH + b) * NE + ri], c1 = cbv[(l * NBATCH + b) * NE + 16 + ri];
#pragma unroll
            for (int r = 0; r < 4; ++r) { const int ti = 4 * q + r; const float rv = rinvs[wave * 16 + ti];
                lgt[(wave * 16 + ti) * 33 + ri] = acc0[r] * rv + c0; lgt[(wave * 16 + ti) * 33 + 16 + ri] = acc1[r] * rv + c1; }
        }
        __syncthreads();
        int se[4] = {0, 0, 0, 0}; float sw[4] = {0.f, 0.f, 0.f, 0.f}; int rk[4] = {0, 0, 0, 0};
        if (lane < 16) {
            float v[32];
#pragma unroll
            for (int e = 0; e < 32; ++e) v[e] = lgt[(wave * 16 + lane) * 33 + e];
            float sv[4];
#pragma unroll
            for (int kk = 0; kk < 4; ++kk) { float best = v[0]; int bi = 0;
#pragma unroll
                for (int e = 1; e < 32; ++e) { if (v[e] > best) { best = v[e]; bi = e; } }
                sv[kk] = best; se[kk] = bi;
#pragma unroll
                for (int e = 0; e < 32; ++e) v[e] = (e == bi) ? -3.0e38f : v[e]; }
            float den = 0.f;
#pragma unroll
            for (int kk = 0; kk < 4; ++kk) { sw[kk] = __expf(sv[kk] - sv[0]); den += sw[kk]; }
            const float inv = 1.0f / den;
#pragma unroll
            for (int kk = 0; kk < 4; ++kk) { sw[kk] *= inv; rk[kk] = __hip_atomic_fetch_add(hist + se[kk], 1, __ATOMIC_RELAXED, __HIP_MEMORY_SCOPE_WORKGROUP); }
        }
        __syncthreads();
        if (tid < 32) base[tid] = (int)__hip_atomic_fetch_add(ctl + CW_CNT + (cset * NE + tid) * 16, (unsigned)hist[tid], __ATOMIC_RELAXED, __HIP_MEMORY_SCOPE_AGENT);
        __syncthreads();
        if (lane < 16) {
            const int row = row0 + lane; int si[4];
#pragma unroll
            for (int kk = 0; kk < 4; ++kk) { const int li = base[se[kk]] + rk[kk]; tokof[(size_t)se[kk] * T + li] = row; si[kk] = (se[kk] << 24) | li; }
            *(int4*)(slotinfo + (size_t)row * 4) = make_int4(si[0], si[1], si[2], si[3]);
            *(f32x4*)(wgt + (size_t)row * 4) = (f32x4){sw[0], sw[1], sw[2], sw[3]};
        }
        __syncthreads();
    }
}

constexpr int ZT_STRIDE = 528;
template <int NR>
__device__ __forceinline__ void stage_z8(const unsigned char* z8, const float* zs, int b, int p_first, int tile, LAS unsigned char* zt, int tid) {
    constexpr int NP = NR * 16, NK = (NP + NTHREADS - 1) / NTHREADS;
    u32x4 q[NK]; float sc[NK];
    const __amdgpu_buffer_rsrc_t rz = __builtin_amdgcn_make_buffer_rsrc((void*)z8, 0, 0xffffffff, 0x00020000), rq = __builtin_amdgcn_make_buffer_rsrc((void*)zs, 0, 0xffffffff, 0x00020000);
#pragma unroll
    for (int k = 0; k < NK; ++k) { int idx = tid + NTHREADS * k; idx = idx < NP ? idx : NP - 1; const int r = idx >> 4, pc = idx & 15; const int p = p_first + r; const unsigned row = (unsigned)(b * SEQ + (p < 0 ? 0 : p));
        q[k] = __builtin_bit_cast(u32x4, __builtin_amdgcn_raw_buffer_load_b128(rz, (int)(row * 2560u + (unsigned)(tile * 256 + pc * 16)), 0, 0));
#if Z_OUT_FP8
        (void)rq; sc[k] = p < 0 ? 0.f : (1.0f / Z_FP8_SCALE); }
#else
        const float t = __builtin_bit_cast(float, __builtin_amdgcn_raw_buffer_load_b32(rq, (int)((row * 40u + (unsigned)(tile * 4 + (pc >> 2))) * 4u), 0, 0)); sc[k] = p < 0 ? 0.f : t; }
#endif
#pragma unroll
    for (int k = 0; k < NK; ++k) { int idx = tid + NTHREADS * k; idx = idx < NP ? idx : NP - 1; const int r = idx >> 4, pc = idx & 15; float m128 = -128.0f; asm volatile("" : "+v"(m128));
        const float sk = sc[k], of = m128 * sk;
        const unsigned w[4] = {q[k].x, q[k].y, q[k].z, q[k].w}; unsigned o[8];
#pragma unroll
#if Z_OUT_FP8
        for (int d = 0; d < 4; ++d) { (void)of; const auto lo = __builtin_amdgcn_cvt_pk_f32_fp8((int)w[d], false), hi = __builtin_amdgcn_cvt_pk_f32_fp8((int)w[d], true);
            o[2 * d] = cvt_pk_bf16(lo[0] * sk, lo[1] * sk); o[2 * d + 1] = cvt_pk_bf16(hi[0] * sk, hi[1] * sk); }
#else
        for (int d = 0; d < 4; ++d) { o[2 * d] = cvt_pk_bf16((float)(w[d] & 0xffu) * sk + of, (float)((w[d] >> 8) & 0xffu) * sk + of); o[2 * d + 1] = cvt_pk_bf16((float)((w[d] >> 16) & 0xffu) * sk + of, (float)(w[d] >> 24) * sk + of); }
#endif
        *(LAS u32x4*)(zt + r * ZT_STRIDE + pc * 32) = (u32x4){o[0], o[1], o[2], o[3]}; *(LAS u32x4*)(zt + r * ZT_STRIDE + pc * 32 + 16) = (u32x4){o[4], o[5], o[6], o[7]};
        asm volatile("" ::: "memory"); }
}
__device__ __forceinline__ void lru_unit(const Args& a, int l, int u, LAS unsigned char* lds, const int wv) {
    asm volatile("" : "+s"(lds));
    int tid_ = tid_of(wv); asm volatile("" : "+v"(tid_)); const int tid = tid_, lane = tid & 63, wave = __builtin_amdgcn_readfirstlane(tid >> 6);
    unsigned char* ws = opaque_ptr(a.ws);
    const unsigned char* z8 = (const unsigned char*)(ws + WS_Z); const float* zs = (const float*)(ws + WS_ZS);
    LAS unsigned char* zt = lds; LAS unsigned char* xc = lds + 131 * ZT_STRIDE;
    const int hp = u & 3, b = (u >> 2) & 7, s = u >> 5;
    const int t0 = b * SEQ + s * 128, p0 = s * 128;
    stage_z8<131>(z8, zs, b, p0 - 3, hp, zt, tid);
    __syncthreads();
    {
        const int o = tid & 31, rb = tid >> 5; const int ch0 = hp * 256 + o * 8;
        float cw[4][8], cbias[8];
#pragma unroll
        for (int k = 0; k < 4; ++k) { const f32x4 w0 = *(const f32x4*)(a.in[I_CONVW] + ((size_t)l * 4 + k) * D + ch0), w1 = *(const f32x4*)(a.in[I_CONVW] + ((size_t)l * 4 + k) * D + ch0 + 4);
            cw[k][0] = w0.x; cw[k][1] = w0.y; cw[k][2] = w0.z; cw[k][3] = w0.w; cw[k][4] = w1.x; cw[k][5] = w1.y; cw[k][6] = w1.z; cw[k][7] = w1.w; }
        { const f32x4 b0 = *(const f32x4*)(a.in[I_CONVB] + (size_t)l * D + ch0), b1 = *(const f32x4*)(a.in[I_CONVB] + (size_t)l * D + ch0 + 4);
          cbias[0] = b0.x; cbias[1] = b0.y; cbias[2] = b0.z; cbias[3] = b0.w; cbias[4] = b1.x; cbias[5] = b1.y; cbias[6] = b1.z; cbias[7] = b1.w; }
#pragma unroll 2
        for (int i = 0; i < 8; ++i) { const int r = rb + 16 * i; float acc[8];
#pragma unroll
            for (int j = 0; j < 8; ++j) acc[j] = cbias[j];
#pragma unroll
            for (int k = 0; k < 4; ++k) { const u32x4 v = *(const LAS u32x4*)(zt + (r + k) * ZT_STRIDE + o * 16);
                acc[0] += cw[k][0] * bflo(v.x); acc[1] += cw[k][1] * bfhi(v.x); acc[2] += cw[k][2] * bflo(v.y); acc[3] += cw[k][3] * bfhi(v.y);
                acc[4] += cw[k][4] * bflo(v.z); acc[5] += cw[k][5] * bfhi(v.z); acc[6] += cw[k][6] * bflo(v.w); acc[7] += cw[k][7] * bfhi(v.w); }
            u32x4 w; w.x = cvt_pk_bf16(acc[0], acc[1]); w.y = cvt_pk_bf16(acc[2], acc[3]); w.z = cvt_pk_bf16(acc[4], acc[5]); w.w = cvt_pk_bf16(acc[6], acc[7]);
            *(LAS u32x4*)(xc + r * ZT_STRIDE + o * 16) = w; }
    }
    __syncthreads();
    {
        const __amdgpu_buffer_rsrc_t rz = __builtin_amdgcn_make_buffer_rsrc((void*)(z8 + (size_t)t0 * 2560 + (4 + hp) * 256), 0, 0xffffffff, 0x00020000);
        const unsigned vo = (unsigned)(lane >> 4) * 2560u + (unsigned)(lane & 15) * 16u;
#pragma unroll
        for (int k = 0; k < 4; ++k) __builtin_amdgcn_raw_ptr_buffer_load_lds(rz, (LAS void*)(zt + (wave * 4 + k) * 1024), 16, vo, (unsigned)((wave * 4 + k) * 4 * 2560), 0, 0);
#if !Z_OUT_FP8
        const __amdgpu_buffer_rsrc_t rq = __builtin_amdgcn_make_buffer_rsrc((void*)(zs + (size_t)t0 * 40 + (4 + hp) * 4), 0, 0xffffffff, 0x00020000);
        __builtin_amdgcn_raw_ptr_buffer_load_lds(rq, (LAS void*)(zt + 32768 + wave * 256), 4, (unsigned)(tid >> 2) * 160u + (unsigned)(tid & 3) * 4u, 0, 0, 0);
#endif
    }
    {
        const int hsel = wave >> 2, wc = wave & 3, head = 2 * hp + hsel, c31 = lane & 31, hh = lane >> 5;
        const int ch = head * 128 + 32 * wc + c31;
        const bf16_t* wb = (const bf16_t*)(ws + WS_WRG) + ((size_t)(l * 8 + head) * 256 + 32 * wc + c31) * 128 + 8 * hh;
        bf16x8 Ba[8], Bi[8];
#pragma unroll
        for (int ks = 0; ks < 8; ++ks) { Ba[ks] = *(const bf16x8*)(wb + 16 * ks); Bi[ks] = *(const bf16x8*)(wb + 128 * 128 + 16 * ks); }
        const float ba = a.in[I_BRGA][(size_t)l * D + ch], bx = a.in[I_BRGX][(size_t)l * D + ch];
        const float lam = a.in[I_LAM][(size_t)l * D + ch];
        const float sp8 = 8.0f * log1pf(__expf(-lam));
        typedef __attribute__((address_space(1))) unsigned long long gu64;
        gu64* aggq = (gu64*)(ws + WS_AGG) + ((size_t)l * NBATCH * 32 + (size_t)b * 32) * D + ch;
        float Pr = 1.f, Hr = 0.f;
        unsigned hpk[64];
#pragma unroll
        for (int rb = 0; rb < 4; ++rb) {
            f32x16 aa, ai;
#pragma unroll
            for (int r = 0; r < 16; ++r) { aa[r] = 0.f; ai[r] = 0.f; }
            const LAS unsigned char* ap = xc + (32 * rb + c31) * ZT_STRIDE + (hsel * 128 + 8 * hh) * 2;
#pragma unroll
            for (int ks = 0; ks < 8; ++ks) { const bf16x8 A = *(const LAS bf16x8*)(ap + 32 * ks);
                aa = __builtin_amdgcn_mfma_f32_32x32x16_bf16(A, Ba[ks], aa, 0, 0, 0); ai = __builtin_amdgcn_mfma_f32_32x32x16_bf16(A, Bi[ks], ai, 0, 0, 0); }
            const LAS unsigned char* xp = xc + (32 * rb + 4 * hh) * ZT_STRIDE + (hsel * 128 + 32 * wc + c31) * 2;
#pragma unroll
            for (int q = 0; q < 4; ++q) {
                float p = 1.f, h = 0.f, hl[4], pl[4];
#pragma unroll
                for (int r3 = 0; r3 < 4; ++r3) { const int reg = 4 * q + r3;
                    const float xcv = bf1(*(const LAS bf16_t*)(xp + (8 * q + r3) * ZT_STRIDE));
                    const float rg = sigmoidf_(aa[reg] + ba), ig = sigmoidf_(ai[reg] + bx);
                    const float av = __expf(-sp8 * rg); const float mult = __builtin_amdgcn_sqrtf(fmaxf(1.0f - av * av, 0.f));
                    h = av * h + mult * (ig * xcv); p *= av; hl[r3] = h; pl[r3] = p; }
                const float Ao = shflx(p, 32, lane), Bo = shflx(h, 32, lane);
                const float A0 = hh ? Ao : p, B0 = hh ? Bo : h, A1 = hh ? p : Ao, B1 = hh ? h : Bo;
                const float P1 = Pr * A0, H1 = Hr * A0 + B0;
                const float Pst = hh ? P1 : Pr, Hst = hh ? H1 : Hr;
                Pr = P1 * A1; Hr = H1 * A1 + B1;
#pragma unroll
                for (int r3 = 0; r3 < 4; ++r3) hpk[rb * 16 + 4 * q + r3] = cvt_pk_bf16(Hst * pl[r3] + hl[r3], Pst * pl[r3]);
            }
        }
        if (hh == 0) __hip_atomic_store(aggq + (size_t)s * D, ((unsigned long long)__float_as_uint(Hr) << 32) | (unsigned long long)__float_as_uint(fmaxf(Pr, 1e-37f)), __ATOMIC_RELAXED, __HIP_MEMORY_SCOPE_AGENT);
        float cin = 0.f;
        for (int j0 = 0; j0 < s; j0 += 8) {
            unsigned long long w[8]; unsigned spins = 0;
            for (;;) { bool ok = true;
#pragma unroll
                for (int k = 0; k < 8; ++k) { const int j = (j0 + k < s) ? (j0 + k) : (s - 1); w[k] = __hip_atomic_load(aggq + (size_t)j * D, __ATOMIC_RELAXED, __HIP_MEMORY_SCOPE_AGENT); ok = ok && ((unsigned)w[k] != 0u); }
                if (__all(ok)) break;
                __builtin_amdgcn_s_sleep(4);
                if (++spins > (1u << 17)) break;
            }
#pragma unroll
            for (int k = 0; k < 8; ++k) { if (j0 + k < s) cin = __uint_as_float((unsigned)w[k]) * cin + __uint_as_float((unsigned)(w[k] >> 32)); }
        }
        asm volatile("s_waitcnt vmcnt(0)" ::: "memory");
        __syncthreads();
        const LAS unsigned char* gp = zt + (4 * hh) * 256 + (hsel * 128 + 32 * wc + c31);
        const LAS float* gsp = (const LAS float*)(zt + 32768) + (4 * hh) * 4 + hsel * 2 + (wc >> 1);
        LAS unsigned char* yp = xc + (4 * hh) * 512 + (hsel * 128 + 32 * wc + c31) * 2;
#pragma unroll
        for (int rb = 0; rb < 4; ++rb) {
#pragma unroll
            for (int reg = 0; reg < 16; ++reg) { const int tok = 32 * rb + 8 * (reg >> 2) + (reg & 3);
                const unsigned pk = hpk[rb * 16 + reg];
                const float hf = bflo(pk) + bfhi(pk) * cin;
#if Z_OUT_FP8
                (void)gsp; const float g = __builtin_amdgcn_cvt_f32_fp8((int)gp[tok * 256], 0) * (1.0f / Z_FP8_SCALE);
#else
                const float g = ((float)gp[tok * 256] - 128.0f) * gsp[tok * 4];
#endif
                const float ge = g * __builtin_amdgcn_rcpf(1.0f + __expf(-1.5957691216f * (g + 0.044715f * g * g * g)));
                *(LAS bf16_t*)(yp + tok * 512) = (bf16_t)(cvt_pk_bf16(hf * ge, 0.f) & 0xffffu); }
        }
    }
    __syncthreads();
    {
        bf16_t* yo = (bf16_t*)(ws + WS_ACAT) + (size_t)t0 * KCAT + 512 + hp * 256;
        u32x4 yv[8];
#pragma unroll
        for (int k = 0; k < 8; ++k) yv[k] = *(const LAS u32x4*)(xc + ((tid >> 5) + 16 * k) * 512 + (tid & 31) * 16);
#pragma unroll
        for (int k = 0; k < 8; ++k) *(u32x4*)(yo + (size_t)((tid >> 5) + 16 * k) * KCAT + (tid & 31) * 8) = yv[k];
    }
    __syncthreads();
}
__device__ __forceinline__ void pool_unit(const Args& a, int l, int u, LAS unsigned char* lds, const int wv) {
    asm volatile("" : "+s"(lds));
    int tid_ = tid_of(wv); asm volatile("" : "+v"(tid_)); const int tid = tid_, lane = tid & 63, wave = __builtin_amdgcn_readfirstlane(tid >> 6);
    unsigned char* ws = opaque_ptr(a.ws);
    const unsigned char* z8 = (const unsigned char*)(ws + WS_Z); const float* zs = (const float*)(ws + WS_ZS);
    LAS unsigned char* zt = lds; LAS unsigned char* pt = lds + 143 * ZT_STRIDE;
    const int gp = u & 1, b = (u >> 1) & 7, s = u >> 4;
    const int t0 = b * SEQ + s * 128, p0 = s * 128;
    stage_z8<143>(z8, zs, b, p0 - 15, 8 + gp, zt, tid);
    __syncthreads();
    {
        const int o = tid & 31, rb = tid >> 5; const int g = 2 * gp + (o >> 4); const int w = 2 << g;
#pragma unroll 1
        for (int i = 0; i < 8; ++i) { const int r = rb + 16 * i; float acc[8];
#pragma unroll
            for (int j = 0; j < 8; ++j) acc[j] = 0.f;
            for (int jj = 0; jj < w; ++jj) { const u32x4 v = *(const LAS u32x4*)(zt + (r + 15 - jj) * ZT_STRIDE + o * 16);
                acc[0] += bflo(v.x); acc[1] += bfhi(v.x); acc[2] += bflo(v.y); acc[3] += bfhi(v.y); acc[4] += bflo(v.z); acc[5] += bfhi(v.z); acc[6] += bflo(v.w); acc[7] += bfhi(v.w); }
            const int cnt = (p0 + r + 1 < w) ? (p0 + r + 1) : w; const float ic = 1.0f / (float)cnt;
            const u32x4 v = *(const LAS u32x4*)(zt + (r + 15) * ZT_STRIDE + o * 16);
            const float x0[8] = {bflo(v.x), bfhi(v.x), bflo(v.y), bfhi(v.y), bflo(v.z), bfhi(v.z), bflo(v.w), bfhi(v.w)};
#pragma unroll
            for (int j = 0; j < 8; ++j) acc[j] = acc[j] * ic - x0[j];
            u32x4 wv; wv.x = cvt_pk_bf16(acc[0], acc[1]); wv.y = cvt_pk_bf16(acc[2], acc[3]); wv.z = cvt_pk_bf16(acc[4], acc[5]); wv.w = cvt_pk_bf16(acc[6], acc[7]);
            *(LAS u32x4*)(pt + r * ZT_STRIDE + o * 16) = wv; }
    }
    __syncthreads();
    {
        const int gsel = wave >> 2, wc = wave & 3, g = 2 * gp + gsel, c31 = lane & 31, hh = lane >> 5;
        const int oc = g * 128 + 32 * wc + c31;
        const bf16_t* wb = (const bf16_t*)(ws + WS_WPOOL) + ((size_t)(l * 4 + g) * 128 + 32 * wc + c31) * 128 + 8 * hh;
        bf16x8 Bf[8];
#pragma unroll
        for (int ks = 0; ks < 8; ++ks) Bf[ks] = *(const bf16x8*)(wb + 16 * ks);
        const float psc = a.in[I_PSCALE][(size_t)l * 512 + oc];
        bf16_t* yo = (bf16_t*)(ws + WS_ACAT) + (size_t)t0 * KCAT + oc;
#pragma unroll 1
        for (int rb = 0; rb < 4; ++rb) {
            f32x16 acc;
#pragma unroll
            for (int r = 0; r < 16; ++r) acc[r] = 0.f;
            const LAS unsigned char* ap = pt + (32 * rb + c31) * ZT_STRIDE + (gsel * 128 + 8 * hh) * 2;
#pragma unroll
            for (int ks = 0; ks < 8; ++ks) { const bf16x8 A = *(const LAS bf16x8*)(ap + 32 * ks); acc = __builtin_amdgcn_mfma_f32_32x32x16_bf16(A, Bf[ks], acc, 0, 0, 0); }
#pragma unroll
            for (int reg = 0; reg < 16; ++reg) { const int tok = 32 * rb + 8 * (reg >> 2) + 4 * hh + (reg & 3);
                yo[(size_t)tok * KCAT] = (bf16_t)(cvt_pk_bf16(acc[reg] * psc, 0.f) & 0xffffu); }
        }
    }
    __syncthreads();
}

constexpr int PH_PER_LAYER = 9;
constexpr int N_PHASES = 1 + DEPTH * PH_PER_LAYER + 1;

__global__ void __launch_bounds__(NTHREADS, 2) fwd_kernel(Args a) {
    extern __shared__ __attribute__((aligned(16))) unsigned char lds_raw[];
    LAS unsigned char* lds = (LAS unsigned char*)lds_raw;
    const int wv = __builtin_amdgcn_readfirstlane(threadIdx.x >> 6); const int tid = threadIdx.x; const int G = gridDim.x;
    unsigned char* ws0 = a.ws;
    unsigned* ctl = (unsigned*)(ws0 + WS_CTL);
    volatile LAS unsigned* misc = (volatile LAS unsigned*)(lds + LDS_MISC);
    if (tid < 4) misc[tid] = 0u;
    __syncthreads();
    XcdBarrier bar; bar.bar = ctl + CW_BAR; bar.x = 0; bar.st = misc; bar.wv = wv;
#if MK_PER_PHASE
    const int lo = a.ph_lo, hi = a.ph_hi;
#else
    constexpr int lo = 0, hi = N_PHASES;
#endif
    if (hi - lo > 1) bar = xcd_barrier_post(ctl + CW_BAR, misc, wv);
#define IN(k) (lo <= (k) && (k) < hi)
#define SEAM(k) do { if (IN((k) + 1)) xcd_barrier(bar); } while (0)

    if (EN(0) && IN(0)) for (int rr = 0; rr < REPN(0); ++rr) { phase_prologue(a, lds, wv); SEAM(0); }

    for (int l = 0; l < DEPTH; ++l) {
        const int pb = 1 + l * PH_PER_LAYER;
        if (EN(1) && IN(pb + 0)) for (int rr = 0; rr < REPN(1); ++rr) { unsigned char* ws = opaque_ptr(ws0); const int bid = opaque_bid(); (void)bid; (void)ws; if (l == 0) phase_a<0>(a, l, lds, rr + 1 < REPN(1), wv); else phase_a<1>(a, l, lds, rr + 1 < REPN(1), wv); SEAM(pb + 0); }
        if (EN(2) && IN(pb + 1)) for (int rr = 0; rr < REPN(2); ++rr) { unsigned char* ws = opaque_ptr(ws0); const int bid = opaque_bid(); (void)bid; (void)ws;
            #if Z_I8
            pg8::PlainSched S{(const char*)(ws + WS_H), (const char*)(ws + WS_WIN) + (size_t)l * NZ * 1024, 512, T / 256, NZ / 256, G, bid};
            pg8::EpiZI8 E{(bf16_t*)(ws + WS_Z), (float*)(ws + WS_ZS), (unsigned char*)(ws + WS_ZG), (const unsigned char*)ws, (unsigned)WS_HSC, (unsigned)(WS_WINSC + (size_t)l * NZ * 4)};
            pg8::gemm_phase<pg8::EpiZI8, pg8::PlainSched, true, 2>(lds, 512, S, E, wv);
#elif Z_FP8
            pg8::PlainSched S{(const char*)(ws + WS_H), (const char*)(ws + WS_WIN) + (size_t)l * NZ * 1024, 512, T / 256, NZ / 256, G, bid};
            pg8::EpiBf16 E{(bf16_t*)(ws + WS_Z), NZ, nullptr, (rr + 1 < REPN(2)) && (a.ph_lo == 0), 1.0f / WEIN_SCALE};
            pg8::gemm_phase<pg8::EpiBf16, pg8::PlainSched, true, 1>(lds, 512, S, E, wv);
#else
            pg8::PlainSched S{(const char*)(ws + WS_H), (const char*)(ws + WS_WIN) + (size_t)l * NZ * 1024 * 2, 1024, T / 256, NZ / 256, G, bid};
            pg8::EpiBf16 E{(bf16_t*)(ws + WS_Z), NZ, nullptr, (rr + 1 < REPN(2)) && (a.ph_lo == 0), 1.0f};
            pg8::gemm_phase<pg8::EpiBf16, pg8::PlainSched, true>(lds, 1024, S, E, wv);
#endif
            SEAM(pb + 1);
        }
        if (EN(3) && IN(pb + 2)) for (int rr = 0; rr < REPN(3); ++rr) { unsigned char* ws = opaque_ptr(ws0); const int bid = opaque_bid(); (void)bid; (void)ws;
            for (int u = bid; u < 1024 + 512; u += G) { if (u < 1024) lru_unit(a, l, u, lds, wv); else pool_unit(a, l, u - 1024, lds, wv); }
            SEAM(pb + 2);
        }
        if (EN(5) && IN(pb + 4)) for (int rr = 0; rr < REPN(5); ++rr) { unsigned char* ws = opaque_ptr(ws0); const int bid = opaque_bid(); (void)bid; (void)ws;
            pg8::PlainSched S{(const char*)(ws + WS_ACAT), (const char*)(ws + WS_WCAT) + (size_t)l * 1024 * KCAT * 2, KCAT, T / 256, D / 256, G, bid};
            pg8::EpiMerged E{(bf16_t*)(ws + WS_MERGED), (const unsigned char*)(ws + WS_ZG)};
            pg8::gemm_phase<pg8::EpiMerged, pg8::PlainSched, true>(lds, KCAT, S, E, wv);
            SEAM(pb + 4);
        }
        if (EN(6) && IN(pb + 5)) for (int rr = 0; rr < REPN(6); ++rr) { unsigned char* ws = opaque_ptr(ws0); const int bid = opaque_bid(); (void)bid; (void)ws;
            pg8::PlainSched S{(const char*)(ws + WS_MERGED), (const char*)(ws + WS_WOUT) + (size_t)l * 1024 * 1024 * 2, 1024, T / 256, D / 256, G, bid};
            pg8::EpiResid E{(bf16_t*)(ws + WS_XRES), (rr + 1 < REPN(6)) ? (bf16_t*)(ws + WS_ACT) : (bf16_t*)(ws + WS_XRES), (const float*)(ws + WS_MOD) + (size_t)l * NBATCH * 6144 + 2 * D};
            pg8::gemm_phase<pg8::EpiResid, pg8::PlainSched, true>(lds, 1024, S, E, wv);
            SEAM(pb + 5);
        }
        if (EN(7) && IN(pb + 6)) for (int rr = 0; rr < REPN(7); ++rr) { unsigned char* ws = opaque_ptr(ws0); const int bid = opaque_bid(); (void)bid; (void)ws; if (l > 0 && rr == 0) conv_drain(a, l, -1, lds, wv); phase_h(a, l, l + DEPTH * rr, lds, wv); SEAM(pb + 6); }
        if (EN(8) && IN(pb + 7)) for (int rr = 0; rr < REPN(8); ++rr) { unsigned char* ws = opaque_ptr(ws0); const int bid = opaque_bid(); (void)bid; (void)ws;
            moe_tables(a, l + DEPTH * (REPN(7) - 1), lds, wv);
            LAS unsigned char* lds_o = lds; asm volatile("" : "+s"(lds_o)); const MoeTab mt = moe_tab_ptrs(lds_o);
            MoeSched1 S{(const char*)(ws + WS_H), (const char*)(ws + WS_WEIN) + (size_t)l * NE * 2048 * 1024, (const int*)(ws + WS_TOKOF), mt, __builtin_amdgcn_readfirstlane(mt.tilestart[NE]), G, bid};
            pg8::EpiSwiglu E{(unsigned char*)(ws + WS_ACT), a.in[I_BEIN] + (size_t)l * NE * 2048, 1.0f / WEIN_SCALE};
            pg8::gemm_phase<pg8::EpiSwiglu, MoeSched1, true, 1>(lds, 512, S, E, wv);
            if (l + 1 < DEPTH) {
                const int nwg = S.nMt * 8, maxr = (nwg + G - 1) / G, myr = (nwg - bid + G - 1) / G;
                if (myr < maxr) conv_drain(a, l + 1, CONV_Q1, lds, wv);
            }
            SEAM(pb + 7);
        }
        if (EN(9) && IN(pb + 8)) for (int rr = 0; rr < REPN(9); ++rr) { unsigned char* ws = opaque_ptr(ws0); const int bid = opaque_bid(); (void)bid; (void)ws;
            moe_tables(a, l + DEPTH * (REPN(7) - 1), lds, wv);
            LAS unsigned char* lds_o = lds; asm volatile("" : "+s"(lds_o)); const MoeTab mt = moe_tab_ptrs(lds_o);
            MoeSched2 S{(const char*)(ws + WS_ACT), (const char*)(ws + WS_WEOUT) + (size_t)l * NE * 1024 * 1024, mt, __builtin_amdgcn_readfirstlane(mt.tilestart[NE]), G, bid};
            pg8::EpiMoeOut E{(unsigned char*)(ws + WS_OUTB), (float*)(ws + WS_OUTSC), a.in[I_BEOUT] + (size_t)l * NE * D, 1.0f / WEIN_SCALE};
            pg8::gemm_phase<pg8::EpiMoeOut, MoeSched2, true, 1>(lds, 512, S, E, wv);
            if (l + 1 < DEPTH) {
                const int nwg = S.nMt * 4, maxr = (nwg + G - 1) / G, myr = (nwg - bid + G - 1) / G;
                if (myr < maxr) conv_drain(a, l + 1, CONV_Q2, lds, wv);
            }
            SEAM(pb + 8);
        }
    }
    if (EN(10) && IN(N_PHASES - 1)) phase_a<2>(a, DEPTH, lds, false, wv);
#undef IN
#undef SEAM
}

extern "C" void kernel_launch(void* const* d_in, const int* in_sizes, int n_in, void* d_out, int out_size, void* d_ws, size_t ws_size, hipStream_t stream) {
    static int grid = 0;
    if (grid == 0) {
        if (n_in != 26 || out_size != T * D || ws_size < WS_END) { fprintf(stderr, "kernel_launch: unexpected problem (n_in %d out %d ws %zu)\n", n_in, out_size, ws_size); grid = -1; return; }
        int dev = 0, cus = 0, per_cu = 0;
        if (hipGetDevice(&dev) != hipSuccess || hipDeviceGetAttribute(&cus, hipDeviceAttributeMultiprocessorCount, dev) != hipSuccess) { grid = -1; return; }
        if (hipFuncSetAttribute((const void*)fwd_kernel, hipFuncAttributeMaxDynamicSharedMemorySize, LDS_BYTES) != hipSuccess) { fprintf(stderr, "kernel_launch: hipFuncSetAttribute failed\n"); grid = -1; return; }
        if (hipOccupancyMaxActiveBlocksPerMultiprocessor(&per_cu, (const void*)fwd_kernel, NTHREADS, LDS_BYTES) != hipSuccess || per_cu < 1) fprintf(stderr, "kernel_launch: occupancy query says %d\n", per_cu);
        (void)hipGetLastError();
        grid = cus;
    }
    if (grid < 0) return;
    static_assert(WS_AGG + AGG_BYTES == WS_CTL, "the look-back words and the control block are zeroed by ONE memset");
    if (hipMemsetAsync((char*)d_ws + WS_AGG, 0, AGG_BYTES + CTL_ZERO_BYTES, stream) != hipSuccess) return;
    Args a{};
    for (int i = 0; i < 26; ++i) a.in[i] = (const float*)d_in[i];
    a.out = (float*)d_out; a.ws = (unsigned char*)d_ws;
#if MK_PER_PHASE
    for (int p = 0; p < N_PHASES; ++p) { a.ph_lo = p; a.ph_hi = p + 1; hipLaunchKernelGGL(fwd_kernel, dim3(grid), dim3(NTHREADS), LDS_BYTES, stream, a); }
#else
    a.ph_lo = 0; a.ph_hi = N_PHASES;
    hipLaunchKernelGGL(fwd_kernel, dim3(grid), dim3(NTHREADS), LDS_BYTES, stream, a);
#endif
    const hipError_t le = hipPeekAtLastError();
    if (le != hipSuccess) fprintf(stderr, "kernel_launch: launch failed: %s\n", hipGetErrorName(le));
}
```

```cpp
#include <hip/hip_runtime.h>
#include <cstdio>
#include <cstdint>

#define REP_MASK 0x0
#ifndef PH_MASK
#define PH_MASK 0x7ff
#endif
#define EN(b) ((PH_MASK >> (b)) & 1)
#ifndef REP_MASK
#define REP_MASK 0
#endif
#define REPN(b) ((((REP_MASK) >> (b)) & 1) ? 2 : 1)
#ifndef Z_I8
#define Z_I8 1
#endif
#ifndef Z_FP8
#define Z_FP8 0
#endif
#ifndef MK_PER_PHASE
#define MK_PER_PHASE 0
#endif

#define LAS __attribute__((address_space(3)))
typedef unsigned short bf16_t;
typedef short bf16x8 __attribute__((ext_vector_type(8)));
typedef float f32x4 __attribute__((ext_vector_type(4)));
typedef float f32x2 __attribute__((ext_vector_type(2)));
typedef float f32x16 __attribute__((ext_vector_type(16)));
typedef unsigned u32x4 __attribute__((ext_vector_type(4)));
typedef unsigned u32x2 __attribute__((ext_vector_type(2)));

constexpr int D = 1024, NBATCH = 8, SEQ = 4096, T = NBATCH * SEQ, DEPTH = 4;
constexpr int NZ = 4608, ZO_GLRU = 1024, ZO_XPOOL = 2048, ZO_GL0 = 2560, ZO_GL1 = 3584;
constexpr int NE = 32, TOPK = 4;
constexpr int KCAT = 1536;
constexpr int SLOT_CAP = T * TOPK + NE * 256;
constexpr int MAX_MT = SLOT_CAP / 256;
constexpr float NORM_EPS = 1e-6f;
constexpr float WEIN_SCALE = 64.0f;
constexpr int NTHREADS = 512, NWAVES = 8;

constexpr size_t MiB = 1u << 20;
constexpr size_t WS_CTL = 80 * MiB, CTL_ZERO_BYTES = 256 * 1024;
constexpr size_t WS_MOD = 1 * MiB;
constexpr size_t WS_CB = 2 * MiB;
constexpr size_t WS_AGG = 72 * MiB;
constexpr size_t AGG_BYTES = (size_t)DEPTH * NBATCH * 32 * D * 8;
constexpr size_t WS_WRS = 3 * MiB;
constexpr size_t WS_HSC = 4 * MiB;
constexpr size_t WS_WINSC = 5 * MiB;
constexpr size_t WS_WRB = 40 * MiB;
constexpr size_t WS_TOKOF = 6 * MiB;
constexpr size_t WS_SLOTINFO = 10 * MiB;
constexpr size_t WS_WGT = 11 * MiB;
constexpr size_t WS_WRG = 12 * MiB;
constexpr size_t WS_WPOOL = 14 * MiB;
constexpr size_t WS_WIN = 16 * MiB;
constexpr size_t WS_WCAT = 52 * MiB;
constexpr size_t WS_WOUT = 64 * MiB;
constexpr size_t WS_WEIN = 128 * MiB;
constexpr size_t WS_WEOUT = 640 * MiB;
constexpr size_t WS_XRES = 896 * MiB;
constexpr size_t WS_H = 1024 * MiB;
constexpr size_t WS_Z = 1088 * MiB;
constexpr size_t WS_ZS = WS_Z + 96 * MiB;
constexpr size_t WS_ACAT = 1376 * MiB;
constexpr size_t WS_MERGED = 1472 * MiB;
constexpr size_t WS_ACT = 1536 * MiB;
constexpr size_t WS_OUTB = 1808 * MiB;
constexpr size_t WS_OUTSC = WS_OUTB + 144 * MiB;
constexpr size_t WS_ZG = 2080 * MiB;
constexpr size_t WS_END = 2144 * MiB;
static_assert(WS_ACT + (size_t)SLOT_CAP * 1024 * 2 <= WS_OUTB && WS_OUTB + (size_t)SLOT_CAP * 1024 * 2 <= WS_END, "ws map");
constexpr int CW_BAR = 4096;
constexpr int CW_CONVQ = 7680;
constexpr int CW_CNT = 8192;

constexpr int LDS_BYTES = 163840;
constexpr int LDS_TAB = 131072;
constexpr int LDS_NVA = 131072 + 8192;
constexpr int LDS_PTAB = 131072 + 16384, PTAB_BYTES = 2048;
constexpr int LDS_MISC = LDS_BYTES - 256;

__device__ __forceinline__ unsigned cvt_pk_bf16(float lo, float hi) { unsigned r; asm("v_cvt_pk_bf16_f32 %0, %1, %2" : "=v"(r) : "v"(lo), "v"(hi)); return r; }
__device__ __forceinline__ float bflo(unsigned w) { return __uint_as_float(w << 16); }
__device__ __forceinline__ float bfhi(unsigned w) { return __uint_as_float(w & 0xffff0000u); }
__device__ __forceinline__ float bf1(bf16_t w) { return __uint_as_float(((unsigned)w) << 16); }
__device__ __forceinline__ float sigmoidf_(float x) { return __builtin_amdgcn_rcpf(1.0f + __expf(-x)); }
#define Z_OUT_FP8 1
constexpr float Z_FP8_SCALE = 16.0f;
#define G_FP8 1
constexpr float MRG_FP8_SCALE = 16.0f;
constexpr float OUT_FP8_SCALE = 16.0f;
constexpr float MAGIC_U8 = 12582912.0f, MAGIC_I8 = 12582912.0f + 128.0f;
__device__ __forceinline__ unsigned pack4_lowbytes(f32x4 t) {
    const unsigned p01 = __builtin_amdgcn_perm(__float_as_uint(t.y), __float_as_uint(t.x), 0x0c0c0400u), p23 = __builtin_amdgcn_perm(__float_as_uint(t.w), __float_as_uint(t.z), 0x0c0c0400u);
    return __builtin_amdgcn_perm(p23, p01, 0x05040100u);
}
__device__ __forceinline__ float shflx(float v, int mask, int lane) { return __int_as_float(__builtin_amdgcn_ds_bpermute((lane ^ mask) << 2, __float_as_int(v))); }
#define DPP_F(v, ctrl) __builtin_bit_cast(float, __builtin_amdgcn_update_dpp(0, __builtin_bit_cast(int, (v)), (ctrl), 0xF, 0xF, true))
#define RDL_F(v, l) __builtin_bit_cast(float, __builtin_amdgcn_readlane(__builtin_bit_cast(int, (v)), (l)))
__device__ __forceinline__ float wave_sum(float v, int) {
    v += DPP_F(v, 0xB1); v += DPP_F(v, 0x4E); v += DPP_F(v, 0x141); v += DPP_F(v, 0x140);
    return (RDL_F(v, 0) + RDL_F(v, 16)) + (RDL_F(v, 32) + RDL_F(v, 48));
}
__device__ __forceinline__ float wave_max(float v) {
    v = fmaxf(v, DPP_F(v, 0xB1)); v = fmaxf(v, DPP_F(v, 0x4E)); v = fmaxf(v, DPP_F(v, 0x141)); v = fmaxf(v, DPP_F(v, 0x140));
    return fmaxf(fmaxf(RDL_F(v, 0), RDL_F(v, 16)), fmaxf(RDL_F(v, 32), RDL_F(v, 48)));
}
__device__ __forceinline__ int tid_of(int wv) { int l; asm volatile("v_mbcnt_lo_u32_b32 %0, -1, 0\n\tv_mbcnt_hi_u32_b32 %0, -1, %0" : "=v"(l)); return wv * 64 + l; }
__device__ __forceinline__ int opaque_bid() { int b = blockIdx.x; asm volatile("" : "+s"(b)); return b; }
__device__ __forceinline__ unsigned char* opaque_ptr(unsigned char* p) { size_t z = 0; asm volatile("" : "+s"(z)); return p + z; }
#define LDS_WAIT() asm volatile("s_waitcnt lgkmcnt(0)" ::: "memory")
#define VM_WAIT() asm volatile("s_waitcnt vmcnt(0)" ::: "memory")

namespace pg8 {
constexpr int BM = 256, BK = 64, HALF = 128, HTB = HALF * BK * 2, STAGE_BYTES = 8 * HTB, NXCD = 8, WGM = 8;
__host__ __device__ __forceinline__ int lds_byte(int r, int c) { const int st = (r >> 4) * 2 + (c >> 5), rr = r & 15, cc = c & 31, ob = rr * 64 + cc * 2; return st * 1024 + (ob ^ (((ob >> 9) & 1) << 5)); }
__host__ __device__ __forceinline__ void stage_rc(int b, int& R, int& C) { const int st = b / 1024, sb = b % 1024, swz = sb ^ (((sb >> 9) & 1) << 5); R = (st >> 1) * 16 + swz / 64; C = (st & 1) * 32 + (swz % 64) / 2; }
__host__ __device__ __forceinline__ int perm32(int rho) { const int n = rho >> 4, i = rho & 15; return 8 * (i >> 2) + 4 * n + (i & 3); }

struct Unit { int pm, pn, e, j, row0, rows; };
typedef int v8i32 __attribute__((ext_vector_type(8)));
typedef int v4i32_t __attribute__((ext_vector_type(4)));
__device__ __forceinline__ v8i32 cat8(bf16x8 lo, bf16x8 hi) { typedef int v4i32 __attribute__((ext_vector_type(4))); const v4i32 a = __builtin_bit_cast(v4i32, lo), b = __builtin_bit_cast(v4i32, hi); return (v8i32){a.x, a.y, a.z, a.w, b.x, b.y, b.z, b.w}; }

template <int WGM_ = WGM>
__device__ __forceinline__ bool order_map(int i, int G, int c, int nM, int nN, int& pm, int& pn) {
    const int nwg = nM * nN; const int L = i * G + c; if (L >= nwg) return false;
    int wgid = L; { const int q = nwg / NXCD, r = nwg % NXCD, xcd = wgid % NXCD, off = wgid / NXCD; wgid = (xcd < r ? xcd * (q + 1) : r * (q + 1) + (xcd - r) * q) + off; }
    const int nig = WGM_ * nN, gid = wgid / nig, fm = gid * WGM_, gsz = (nM - fm) < WGM_ ? (nM - fm) : WGM_;
    pm = fm + ((wgid % nig) % gsz); pn = (wgid % nig) / gsz; return true;
}

struct PlainSched {
    static constexpr bool DYN_A = false;
    const char* A; const char* Bt; int K, nM, nN, G, c;
    __device__ __forceinline__ bool next(int i, Unit& u) const { int pm, pn; if (!order_map(i, G, c, nM, nN, pm, pn)) return false; u.pm = pm; u.pn = pn; u.e = 0; u.j = 0; u.row0 = pm * BM; u.rows = BM; return true; }
    __device__ __forceinline__ const char* a_ptr() const { return A; }
    __device__ __forceinline__ const char* b_ptr() const { return Bt; }
    __device__ __forceinline__ unsigned a_off(const Unit& u) const { return (unsigned)u.row0 * (unsigned)K * 2u; }
    __device__ __forceinline__ unsigned b_off(const Unit& u) const { return (unsigned)u.pn * (unsigned)(BM * K * 2); }
    __device__ __forceinline__ void a_voff(const Unit&, unsigned (&v)[2][2], int wv) const {
        int tid = tid_of(wv); asm volatile("" : "+v"(tid));
#pragma unroll
        for (int i = 0; i < 2; ++i) { int R, C; stage_rc(tid * 16 + i * 8192, R, C);
#pragma unroll
            for (int h = 0; h < 2; ++h) v[h][i] = (unsigned)((h * HALF + R) * K + C) * 2u; }
    }
};

template <class Epi, class Sched, bool ALIGN_EPI, int MODE = 0>
__device__ __forceinline__ void gemm_phase(LAS unsigned char* lds, const int K, const Sched& S, const Epi& E, const int wv) {
    asm volatile("" : "+s"(lds));
    int tid = tid_of(wv); asm volatile("" : "+v"(tid));
    const int wid = __builtin_amdgcn_readfirstlane(tid >> 6), lane = tid & 63, wr = wid >> 2, wc = wid & 3, fr = lane & 15, fq = lane >> 4;
    const int nt = K / BK;
    unsigned voffB;
    { int R, C; stage_rc(tid * 16, R, C);
      const int Rb = (Epi::PERM == 2) ? (64 * (R >> 5) + 16 * ((R & 15) >> 2) + 4 * ((R >> 4) & 1) + (R & 3)) : (Epi::PERM == 1) ? ((R & ~31) + perm32(R & 31)) : R; voffB = (unsigned)(Rb * K + C) * 2u; }
    const unsigned q64 = (unsigned)(64 * K * 2);
    const unsigned q64B = (Epi::PERM == 2) ? 2u * q64 : q64;
    const unsigned kstep = (unsigned)(BK * 2);
    const unsigned hstep = (Epi::PERM == 2) ? (unsigned)(8 * K * 2) : (unsigned)(HALF * K * 2);
    const __amdgpu_buffer_rsrc_t rsA = __builtin_amdgcn_make_buffer_rsrc((void*)S.a_ptr(), 0, 0xffffffff, 0x00020000);
    const __amdgpu_buffer_rsrc_t rsB = __builtin_amdgcn_make_buffer_rsrc((void*)S.b_ptr(), 0, 0xffffffff, 0x00020000);
    const unsigned ldsw = (unsigned)wid * 1024u;
    const int aoff = lds_byte(wr * 64 + fr, fq * 8), boff = lds_byte(wc * 32 + fr, fq * 8);
#define PG8_SA(b, h) (((b) * 2 + (h)) * HTB)
#define PG8_SB(b, h) ((4 + (b) * 2 + (h)) * HTB)
#define PG8_STAGE_(rs, bufoff, v0, s0, v1, s1) do { \
        __builtin_amdgcn_raw_ptr_buffer_load_lds(rs, (LAS void*)(lds + (bufoff) + ldsw), 16, (v0), (s0), 0, 0); \
        __builtin_amdgcn_raw_ptr_buffer_load_lds(rs, (LAS void*)(lds + (bufoff) + ldsw + 8192), 16, (v1), (s1), 0, 0); } while (0)
#define PG8_STAGE_B(bufoff, soff, unused) PG8_STAGE_(rsB, bufoff, voffB, (soff), voffB, (soff) + q64B)
#define PG8_STAGE_A(bufoff, soff, h) do { if constexpr (Sched::DYN_A) PG8_STAGE_(rsA, bufoff, cvA[h][0], (soff), cvA[h][1], (soff)); \
        else PG8_STAGE_(rsA, bufoff, cvA[0][0], (soff) + (h) * 2u * q64, cvA[0][0], (soff) + (h) * 2u * q64 + q64); } while (0)
#define PG8_LDA(dst, b, h) do { _Pragma("unroll") for (int m = 0; m < 4; ++m) _Pragma("unroll") for (int k = 0; k < 2; ++k) dst[m][k] = *(const LAS bf16x8*)(lds + PG8_SA(b, h) + aoff + m * 2048 + k * 1024); } while (0)
#define PG8_LDB(dst, b, h) do { _Pragma("unroll") for (int n = 0; n < 2; ++n) _Pragma("unroll") for (int k = 0; k < 2; ++k) dst[n][k] = *(const LAS bf16x8*)(lds + PG8_SB(b, h) + boff + n * 2048 + k * 1024); } while (0)
#define PG8_MMA(ai, bj, At, Bt) do { __builtin_amdgcn_s_setprio(1); _Pragma("unroll") for (int m = 0; m < 4; ++m) _Pragma("unroll") for (int n = 0; n < 2; ++n) { \
        if constexpr (MODE == 1) { acc[ai][bj][m][n] = __builtin_amdgcn_mfma_scale_f32_16x16x128_f8f6f4(cat8(Bt[n][0], Bt[n][1]), cat8(At[m][0], At[m][1]), acc[ai][bj][m][n], 0, 0, 0, 0x7f7f7f7f, 0, 0x7f7f7f7f); } \
        else if constexpr (MODE == 2) { _Pragma("unroll") for (int k = 0; k < 2; ++k) acc[ai][bj][m][n] = __builtin_bit_cast(f32x4, __builtin_amdgcn_mfma_i32_16x16x64_i8(__builtin_bit_cast(v4i32_t, Bt[n][k]), __builtin_bit_cast(v4i32_t, At[m][k]), __builtin_bit_cast(v4i32_t, acc[ai][bj][m][n]), 0, 0, 0)); } \
        else { _Pragma("unroll") for (int k = 0; k < 2; ++k) acc[ai][bj][m][n] = __builtin_amdgcn_mfma_f32_16x16x32_bf16(Bt[n][k], At[m][k], acc[ai][bj][m][n], 0, 0, 0); } } \
        __builtin_amdgcn_s_setprio(0); } while (0)
#define PG8_WAIT_V(n) asm volatile("s_waitcnt vmcnt(" #n ")" ::: "memory")
#define PG8_WAIT_L(n) asm volatile("s_waitcnt lgkmcnt(" #n ")" ::: "memory")
#define PG8_BAR __builtin_amdgcn_s_barrier()
#define PG8_SCHED __builtin_amdgcn_sched_barrier(0)
    Unit cur, nxt; int ui = 0;
    if (!S.next(0, cur)) return;
    f32x4 acc[2][2][4][2];
    { float z0 = 0.f; asm volatile("" : "+v"(z0));
#pragma unroll
    for (int a = 0; a < 2; ++a)
#pragma unroll
        for (int b = 0; b < 2; ++b)
#pragma unroll
            for (int m = 0; m < 4; ++m)
#pragma unroll
                for (int n = 0; n < 2; ++n) acc[a][b][m][n] = (f32x4){z0, z0, z0, z0}; }
    bf16x8 At[4][2], B0[2][2], B1[2][2];
    unsigned cvA[2][2];
    S.a_voff(cur, cvA, wv);
    unsigned cA = S.a_off(cur), cB = S.b_off(cur);
    if constexpr (Epi::PREF) E.prefetch(cur, lds + LDS_PTAB, wv);
    PG8_STAGE_B(PG8_SB(0, 0), cB, voffB); PG8_STAGE_B(PG8_SB(0, 1), cB + hstep, voffB); PG8_STAGE_A(PG8_SA(0, 0), cA, 0); PG8_STAGE_A(PG8_SA(0, 1), cA, 1);
    if (wr == 1) PG8_BAR;
    PG8_WAIT_V(2); PG8_BAR;
    PG8_STAGE_B(PG8_SB(1, 0), cB + kstep, voffB); PG8_STAGE_A(PG8_SA(1, 0), cA + kstep, 0); PG8_STAGE_B(PG8_SB(1, 1), cB + hstep + kstep, voffB);
    PG8_WAIT_V(6); PG8_BAR;
    for (;;) {
        const bool has_next = S.next(ui + 1, nxt);
        unsigned nA = cA, nB = cB;
        if (has_next) { nA = S.a_off(nxt); nB = S.b_off(nxt); }
        if constexpr (Sched::DYN_A) { if (has_next) S.a_dma(nxt, lds + LDS_NVA, wv); }
#pragma unroll 1
        for (int t = 0; t < nt; t += 2) {
            const bool last = (t == nt - 2);
            const unsigned a1 = cA + (unsigned)(t + 1) * kstep;
            const unsigned a2 = last ? nA : cA + (unsigned)(t + 2) * kstep, b2 = last ? nB : cB + (unsigned)(t + 2) * kstep;
            const unsigned a3 = a2 + kstep, b3 = b2 + kstep;
            unsigned nx1[2] = {cvA[1][0], cvA[1][1]};
            if constexpr (Sched::DYN_A) { if (last && has_next) { unsigned q[4]; S.a_fetch(lds + LDS_NVA, wv, q); cvA[0][0] = q[0]; cvA[0][1] = q[1]; nx1[0] = q[2]; nx1[1] = q[3]; } }
            if constexpr (Epi::HOOK_T >= 0) { if (t == Epi::HOOK_T) E.mid(acc, cur, wr, wc, fr, fq); }
            PG8_LDB(B0, 0, 0); PG8_LDB(B1, 0, 1); PG8_SCHED; PG8_LDA(At, 0, 0); PG8_STAGE_A(PG8_SA(1, 1), a1, 1);
            if constexpr (Sched::DYN_A) { cvA[1][0] = nx1[0]; cvA[1][1] = nx1[1]; }
            PG8_WAIT_V(8); PG8_WAIT_L(0); PG8_BAR; PG8_MMA(0, 0, At, B0); PG8_MMA(0, 1, At, B1); PG8_BAR; PG8_SCHED;
            PG8_LDA(At, 0, 1); PG8_STAGE_B(PG8_SB(0, 0), b2, voffB); PG8_STAGE_B(PG8_SB(0, 1), b2 + hstep, voffB); PG8_STAGE_A(PG8_SA(0, 0), a2, 0);
            PG8_WAIT_V(8); PG8_WAIT_L(0); PG8_BAR; PG8_MMA(1, 0, At, B0); PG8_MMA(1, 1, At, B1); PG8_BAR; PG8_SCHED;
            PG8_LDB(B0, 1, 0); PG8_LDB(B1, 1, 1); PG8_SCHED; PG8_LDA(At, 1, 0); PG8_STAGE_A(PG8_SA(0, 1), a2, 1);
            PG8_WAIT_V(8); PG8_WAIT_L(0); PG8_BAR; PG8_MMA(0, 0, At, B0); PG8_MMA(0, 1, At, B1); PG8_BAR; PG8_SCHED;
            PG8_LDA(At, 1, 1); PG8_STAGE_B(PG8_SB(1, 0), b3, voffB); PG8_STAGE_B(PG8_SB(1, 1), b3 + hstep, voffB); PG8_STAGE_A(PG8_SA(1, 0), a3, 0);
            PG8_WAIT_V(8); PG8_WAIT_L(0); PG8_BAR; PG8_MMA(1, 0, At, B0); PG8_MMA(1, 1, At, B1); PG8_BAR; PG8_SCHED;
        }
        if constexpr (ALIGN_EPI) { if (wr == 0) PG8_BAR; }
        if constexpr (Epi::PREF) E.run(acc, cur, wr, wc, lds + LDS_PTAB + (ui & 1) * PTAB_BYTES); else E(acc, cur, wr, wc, fr, fq);
        if (!has_next) break;
        { float z0 = 0.f; asm volatile("" : "+v"(z0));
#pragma unroll
        for (int a = 0; a < 2; ++a)
#pragma unroll
            for (int b = 0; b < 2; ++b)
#pragma unroll
                for (int m = 0; m < 4; ++m)
#pragma unroll
                    for (int n = 0; n < 2; ++n) acc[a][b][m][n] = (f32x4){z0, z0, z0, z0}; }
        cur = nxt; cA = nA; cB = nB; ++ui;
        if constexpr (Epi::PREF) E.prefetch(cur, lds + LDS_PTAB + (ui & 1) * PTAB_BYTES, wv);
        if constexpr (ALIGN_EPI) { if (wr == 1) PG8_BAR; }
    }
    PG8_WAIT_V(0);
    if constexpr (!ALIGN_EPI) { if (wr == 0) PG8_BAR; }
    PG8_BAR;
#undef PG8_SA
#undef PG8_SB
#undef PG8_STAGE_
#undef PG8_STAGE_A
#undef PG8_STAGE_B
#undef PG8_LDA
#undef PG8_LDB
#undef PG8_MMA
#undef PG8_WAIT_V
#undef PG8_WAIT_L
#undef PG8_BAR
#undef PG8_SCHED
}

struct EpiBf16 {
    static constexpr int PERM = 1; static constexpr int HOOK_T = -1; static constexpr bool PREF = false;
    bf16_t* O; int ldc; const float* bias; int noepi; float scale;
    __device__ __forceinline__ void mid(f32x4 (&)[2][2][4][2], const Unit&, int, int, int, int) const {}
    __device__ __forceinline__ void operator()(const f32x4 (&acc)[2][2][4][2], const Unit& u, int wr, int wc, int fr, int fq) const {
        { const int l_ = tid_of(0); fr = l_ & 15; fq = l_ >> 4; }
        if (noepi) { if (acc[0][0][0][0][0] == 1.2345e-30f) O[0] = 0; return; }
        int row0 = u.row0 + wr * 64 + fr; asm volatile("" : "+v"(row0)); int col0 = u.pn * BM + wc * 32 + 8 * fq; asm volatile("" : "+v"(col0));
        f32x4 bv[2][2];
#pragma unroll
        for (int bj = 0; bj < 2; ++bj)
#pragma unroll
            for (int n = 0; n < 2; ++n) bv[bj][n] = bias ? *(const f32x4*)(bias + col0 + bj * HALF + 4 * n) : (f32x4){0.f, 0.f, 0.f, 0.f};
#pragma unroll
        for (int ai = 0; ai < 2; ++ai)
#pragma unroll
            for (int m = 0; m < 4; ++m) { bf16_t* rowp = O + (size_t)(row0 + ai * HALF + m * 16) * ldc + col0;
#pragma unroll
                for (int bj = 0; bj < 2; ++bj) { const f32x4 v0 = acc[ai][bj][m][0] * scale + bv[bj][0], v1 = acc[ai][bj][m][1] * scale + bv[bj][1];
                    u32x4 w; w.x = cvt_pk_bf16(v0[0], v0[1]); w.y = cvt_pk_bf16(v0[2], v0[3]); w.z = cvt_pk_bf16(v1[0], v1[1]); w.w = cvt_pk_bf16(v1[2], v1[3]);
                    *(u32x4*)(rowp + bj * HALF) = w; } }
    }
};
__device__ __forceinline__ size_t zg_off(int pm, int cb, int piece, int wr, int wc, int lane) { return ((((size_t)(pm * 8 + cb) * 8 + piece) * 8 + (wr * 4 + wc)) * 64 + lane) * 16; }
struct EpiZI8 {
    static constexpr int PERM = 2; static constexpr int HOOK_T = -1; static constexpr bool PREF = true;
    bf16_t* O; float* ZS; unsigned char* ZG; const unsigned char* wsb; unsigned rsc_off, csc_off;
    __device__ __forceinline__ void mid(f32x4 (&)[2][2][4][2], const Unit&, int, int, int, int) const {}
    __device__ __forceinline__ void prefetch(const Unit& u, LAS unsigned char* tab, int wv) const {
        const int t = tid_of(wv);
        const unsigned vo = (t < 256) ? (rsc_off + (unsigned)(u.row0 + t) * 4u) : (csc_off + (unsigned)(u.pn * BM + t - 256) * 4u);
        const __amdgpu_buffer_rsrc_t rs = __builtin_amdgcn_make_buffer_rsrc((void*)wsb, 0, 0xffffffff, 0x00020000);
        __builtin_amdgcn_raw_ptr_buffer_load_lds(rs, (LAS void*)(tab + wv * 256), 4, vo, 0, 0, 0);
    }
    __device__ __forceinline__ void run(const f32x4 (&acc)[2][2][4][2], const Unit& u, int wr, int wc, const LAS unsigned char* tab) const {
        int fr, fq; const int lane_ = tid_of(0); fr = lane_ & 15; fq = lane_ >> 4;
        int row0 = u.row0 + wr * 64 + fr; asm volatile("" : "+v"(row0)); int col0 = u.pn * BM + wc * 64 + 16 * fq; asm volatile("" : "+v"(col0));
        const LAS float* tf = (const LAS float*)tab;
        f32x4 cs[2][2];
#pragma unroll
        for (int bj = 0; bj < 2; ++bj)
#pragma unroll
            for (int n = 0; n < 2; ++n) cs[bj][n] = *(const LAS f32x4*)(tf + 256 + wc * 64 + 16 * fq + 8 * bj + 4 * n);
        if (u.pn >= ZO_GL0 / BM) {
#pragma unroll
            for (int bj = 0; bj < 2; ++bj)
#pragma unroll
                for (int n = 0; n < 2; ++n) cs[bj][n] *= -1.4426950408889634f;
#pragma unroll
            for (int ai = 0; ai < 2; ++ai)
#pragma unroll
                for (int m = 0; m < 4; ++m) { const int r = row0 + ai * HALF + m * 16; const float rs = tf[ai * HALF + wr * 64 + m * 16 + fr];
                    unsigned w[4];
#pragma unroll
                    for (int q = 0; q < 4; ++q) { const v4i32_t iv = __builtin_bit_cast(v4i32_t, acc[ai][q >> 1][m][q & 1]);
                        f32x4 e = (f32x4){(float)iv.x, (float)iv.y, (float)iv.z, (float)iv.w} * rs * cs[q >> 1][q & 1];
#pragma unroll
                        for (int j = 0; j < 4; ++j) e[j] = __builtin_amdgcn_exp2f(e[j]);
                        e += 1.0f;
#pragma unroll
                        for (int j = 0; j < 4; ++j) e[j] = __builtin_amdgcn_rcpf(e[j]);
                        w[q] = pack4_lowbytes(e * 255.0f + MAGIC_U8); }
                    (void)r; *(u32x4*)(ZG + zg_off(u.pm, u.pn - ZO_GL0 / BM, ai * 4 + m, wr, wc, lane_)) = (u32x4){w[0], w[1], w[2], w[3]}; }
        } else {
#if Z_OUT_FP8
#pragma unroll
            for (int bj = 0; bj < 2; ++bj)
#pragma unroll
                for (int n = 0; n < 2; ++n) cs[bj][n] *= Z_FP8_SCALE;
#pragma unroll
            for (int ai = 0; ai < 2; ++ai)
#pragma unroll
                for (int m = 0; m < 4; ++m) { const int r = row0 + ai * HALF + m * 16; const float rs = tf[ai * HALF + wr * 64 + m * 16 + fr];
                    unsigned w[4];
#pragma unroll
                    for (int q = 0; q < 4; ++q) { const v4i32_t iv = __builtin_bit_cast(v4i32_t, acc[ai][q >> 1][m][q & 1]);
                        const f32x4 v = (f32x4){(float)iv.x, (float)iv.y, (float)iv.z, (float)iv.w} * rs * cs[q >> 1][q & 1];
                        int p = 0; p = __builtin_amdgcn_cvt_pk_fp8_f32(v.x, v.y, p, false); p = __builtin_amdgcn_cvt_pk_fp8_f32(v.z, v.w, p, true); w[q] = (unsigned)p; }
                    *(u32x4*)((unsigned char*)O + (size_t)r * 2560 + col0) = (u32x4){w[0], w[1], w[2], w[3]}; }
        }
#else
#pragma unroll
            for (int ai = 0; ai < 2; ++ai)
#pragma unroll
                for (int m = 0; m < 4; ++m) { const int r = row0 + ai * HALF + m * 16; const float rs = tf[ai * HALF + wr * 64 + m * 16 + fr]; f32x4 vq[4];
                    float am = 1e-30f;
#pragma unroll
                    for (int q = 0; q < 4; ++q) { const v4i32_t iv = __builtin_bit_cast(v4i32_t, acc[ai][q >> 1][m][q & 1]);
                        vq[q] = (f32x4){(float)iv.x, (float)iv.y, (float)iv.z, (float)iv.w} * cs[q >> 1][q & 1];
                        am = fmaxf(am, fmaxf(fmaxf(fabsf(vq[q].x), fabsf(vq[q].y)), fmaxf(fabsf(vq[q].z), fabsf(vq[q].w)))); }
                    am = fmaxf(am, shflx(am, 16, lane_)); am = fmaxf(am, shflx(am, 32, lane_));
                    const float inv = 127.0f * __builtin_amdgcn_rcpf(am) * 0.999f;
                    if (fq == 0) ZS[(size_t)r * 40 + u.pn * 4 + wc] = am * rs * (1.0f / (127.0f * 0.999f));
                    unsigned w[4];
#pragma unroll
                    for (int q = 0; q < 4; ++q) w[q] = pack4_lowbytes(vq[q] * inv + MAGIC_I8);
                    *(u32x4*)((unsigned char*)O + (size_t)r * 2560 + col0) = (u32x4){w[0], w[1], w[2], w[3]}; }
        }
#endif
    }
    __device__ __forceinline__ void operator()(const f32x4 (&)[2][2][4][2], const Unit&, int, int, int, int) const {}
};
struct EpiMerged {
    static constexpr int PERM = 2; static constexpr int HOOK_T = 8; static constexpr bool PREF = false;
    bf16_t* O; const unsigned char* ZG;
    __device__ __forceinline__ void mid(f32x4 (&acc)[2][2][4][2], const Unit& u, int wr, int wc, int fr, int fq) const {
        { const int l_ = tid_of(0); fr = l_ & 15; fq = l_ >> 4; }
        int row0 = u.row0 + wr * 64 + fr; asm volatile("" : "+v"(row0)); int col0 = u.pn * BM + wc * 64 + 16 * fq; asm volatile("" : "+v"(col0));
        u32x4 g0[2][4], g1[2][4];
#pragma unroll
        for (int ai = 0; ai < 2; ++ai)
#pragma unroll
            for (int m = 0; m < 4; ++m) { g0[ai][m] = *(const u32x4*)(ZG + zg_off(u.pm, u.pn, ai * 4 + m, wr, wc, fr + 16 * fq)); g1[ai][m] = *(const u32x4*)(ZG + zg_off(u.pm, u.pn + 4, ai * 4 + m, wr, wc, fr + 16 * fq)); }
#pragma unroll
        for (int ai = 0; ai < 2; ++ai)
#pragma unroll
            for (int m = 0; m < 4; ++m)
#pragma unroll
                for (int bj = 0; bj < 2; ++bj) {
                    const unsigned a0[2] = {bj ? g0[ai][m].z : g0[ai][m].x, bj ? g0[ai][m].w : g0[ai][m].y}, a1[2] = {bj ? g1[ai][m].z : g1[ai][m].x, bj ? g1[ai][m].w : g1[ai][m].y};
#pragma unroll
                    for (int n = 0; n < 2; ++n)
#pragma unroll
                        for (int j = 0; j < 4; ++j) { const float u0 = fmaxf((float)((a0[n] >> (8 * j)) & 0xffu), 1.0f), u1 = (float)((a1[n] >> (8 * j)) & 0xffu);
                            acc[ai][bj][m][n][j] *= u1 * __builtin_amdgcn_rcpf(u0); } }
    }
    __device__ __forceinline__ void operator()(const f32x4 (&acc)[2][2][4][2], const Unit& u, int wr, int wc, int fr, int fq) const {
        { const int l_ = tid_of(0); fr = l_ & 15; fq = l_ >> 4; }
        int row0 = u.row0 + wr * 64 + fr; asm volatile("" : "+v"(row0)); int col0 = u.pn * BM + wc * 64 + 16 * fq; asm volatile("" : "+v"(col0));
        u32x4 g0[2][4];
#pragma unroll
        for (int ai = 0; ai < 2; ++ai)
#pragma unroll
            for (int m = 0; m < 4; ++m) g0[ai][m] = *(const u32x4*)(ZG + zg_off(u.pm, u.pn, ai * 4 + m, wr, wc, fr + 16 * fq));
#pragma unroll
        for (int ai = 0; ai < 2; ++ai)
#pragma unroll
            for (int m = 0; m < 4; ++m) { bf16_t* orow = O + (size_t)(row0 + ai * HALF + m * 16) * D + col0; unsigned w8[4]; (void)w8; (void)orow;
#pragma unroll
                for (int bj = 0; bj < 2; ++bj) { const unsigned a0[2] = {bj ? g0[ai][m].z : g0[ai][m].x, bj ? g0[ai][m].w : g0[ai][m].y};
                    float o[8];
#pragma unroll
                    for (int n = 0; n < 2; ++n)
#pragma unroll
                        for (int j = 0; j < 4; ++j) o[4 * n + j] = acc[ai][bj][m][n][j] * (fmaxf((float)((a0[n] >> (8 * j)) & 0xffu), 1.0f) * ((G_FP8 ? MRG_FP8_SCALE : 1.0f) / 255.0f));
#if G_FP8
                    { int p = 0; p = __builtin_amdgcn_cvt_pk_fp8_f32(o[0], o[1], p, false); p = __builtin_amdgcn_cvt_pk_fp8_f32(o[2], o[3], p, true); w8[2 * bj] = (unsigned)p;
                      int q = 0; q = __builtin_amdgcn_cvt_pk_fp8_f32(o[4], o[5], q, false); q = __builtin_amdgcn_cvt_pk_fp8_f32(o[6], o[7], q, true); w8[2 * bj + 1] = (unsigned)q; } }
                *(u32x4*)((unsigned char*)O + (size_t)(row0 + ai * HALF + m * 16) * D + col0) = (u32x4){w8[0], w8[1], w8[2], w8[3]}; }
#else
                    u32x4 w; w.x = cvt_pk_bf16(o[0], o[1]); w.y = cvt_pk_bf16(o[2], o[3]); w.z = cvt_pk_bf16(o[4], o[5]); w.w = cvt_pk_bf16(o[6], o[7]);
                    *(u32x4*)(orow + bj * 8) = w; } }
#endif
    }
};
struct EpiResid {
    static constexpr int PERM = 1; static constexpr int HOOK_T = -1; static constexpr bool PREF = false;
    bf16_t* X; bf16_t* XO; const float* gate; float gsc;
    __device__ __forceinline__ void mid(f32x4 (&)[2][2][4][2], const Unit&, int, int, int, int) const {}
    __device__ __forceinline__ void operator()(const f32x4 (&acc)[2][2][4][2], const Unit& u, int wr, int wc, int fr, int fq) const {
        { const int l_ = tid_of(0); fr = l_ & 15; fq = l_ >> 4; }
        int row0 = u.row0 + wr * 64 + fr; asm volatile("" : "+v"(row0)); int col0 = u.pn * BM + wc * 32 + 8 * fq; asm volatile("" : "+v"(col0));
        const float* gp = gate + (size_t)(u.row0 / SEQ) * (6 * D) + col0;
        f32x4 gv[2][2];
#pragma unroll
        for (int bj = 0; bj < 2; ++bj)
#pragma unroll
            for (int n = 0; n < 2; ++n) gv[bj][n] = *(const f32x4*)(gp + bj * HALF + 4 * n) * gsc;
#pragma unroll
        for (int ai = 0; ai < 2; ++ai) {
            u32x4 xv[4][2];
#pragma unroll
            for (int m = 0; m < 4; ++m) { const bf16_t* rowp = X + (size_t)(row0 + ai * HALF + m * 16) * D + col0;
#pragma unroll
                for (int bj = 0; bj < 2; ++bj) xv[m][bj] = *(const u32x4*)(rowp + bj * HALF); }
#pragma unroll
            for (int m = 0; m < 4; ++m) { bf16_t* rowo = XO + (size_t)(row0 + ai * HALF + m * 16) * D + col0;
#pragma unroll
                for (int bj = 0; bj < 2; ++bj) { const u32x4 p = xv[m][bj];
                    const f32x4 o0 = (f32x4){bflo(p.x), bfhi(p.x), bflo(p.y), bfhi(p.y)} + gv[bj][0] * acc[ai][bj][m][0], o1 = (f32x4){bflo(p.z), bfhi(p.z), bflo(p.w), bfhi(p.w)} + gv[bj][1] * acc[ai][bj][m][1];
                    u32x4 w; w.x = cvt_pk_bf16(o0[0], o0[1]); w.y = cvt_pk_bf16(o0[2], o0[3]); w.z = cvt_pk_bf16(o1[0], o1[1]); w.w = cvt_pk_bf16(o1[2], o1[3]);
                    *(u32x4*)(rowo + bj * HALF) = w; } }
            asm volatile("" ::: "memory"); }
    }
};
constexpr float SG_C = -1.702f * 1.4426950408889634f;
struct EpiSwiglu {
    static constexpr int PERM = 1; static constexpr int HOOK_T = -1; static constexpr bool PREF = true;
    unsigned char* ACT; const float* bias; float wscale;
    __device__ __forceinline__ void mid(f32x4 (&)[2][2][4][2], const Unit&, int, int, int, int) const {}
    __device__ __forceinline__ void operator()(const f32x4 (&)[2][2][4][2], const Unit&, int, int, int, int) const {}
    __device__ __forceinline__ void prefetch(const Unit& u, LAS unsigned char* tab, int wv) const {
        const int t = tid_of(wv) & 255;
        const __amdgpu_buffer_rsrc_t rs = __builtin_amdgcn_make_buffer_rsrc((void*)bias, 0, 0xffffffff, 0x00020000);
        __builtin_amdgcn_raw_ptr_buffer_load_lds(rs, (LAS void*)(tab + (wv & 3) * 256), 4, (unsigned)(u.e * 2048 + (t >> 7) * 1024 + u.pn * HALF + (t & 127)) * 4u, 0, 0, 0);
    }
    __device__ __forceinline__ void run(const f32x4 (&acc)[2][2][4][2], const Unit& u, int wr, int wc, const LAS unsigned char* tab) const {
        int fr, fq; { const int l_ = tid_of(0); fr = l_ & 15; fq = l_ >> 4; }
        int row0 = u.row0 + wr * 64 + fr; asm volatile("" : "+v"(row0)); int cc = u.pn * HALF + wc * 32 + 8 * fq; asm volatile("" : "+v"(cc));
        const LAS float* tf = (const LAS float*)tab + wc * 32 + 8 * fq;
        f32x4 bg[2], bu[2];
#pragma unroll
        for (int n = 0; n < 2; ++n) { bg[n] = *(const LAS f32x4*)(tf + 4 * n) * SG_C; bu[n] = *(const LAS f32x4*)(tf + HALF + 4 * n) + 1.0f; }
        const float wsc = wscale * SG_C;
#pragma unroll
        for (int ai = 0; ai < 2; ++ai)
#pragma unroll
            for (int m = 0; m < 4; ++m) { unsigned char* rowp = ACT + (size_t)(row0 + ai * HALF + m * 16) * D + cc;
                float o[8];
#pragma unroll
                for (int n = 0; n < 2; ++n) {
                    f32x4 t = acc[ai][0][m][n] * wsc + bg[n], up = acc[ai][1][m][n] * wscale + bu[n], e;
#pragma unroll
                    for (int j = 0; j < 4; ++j) { t[j] = fmaxf(t[j], 7.0f * SG_C); e[j] = __builtin_amdgcn_exp2f(t[j]); up[j] = __builtin_amdgcn_fmed3f(up[j], -6.0f, 8.0f); }
                    e += 1.0f;
#pragma unroll
                    for (int j = 0; j < 4; ++j) e[j] = __builtin_amdgcn_rcpf(e[j]);
                    const f32x4 r = (t * (1.0f / SG_C)) * (e * up);
#pragma unroll
                    for (int j = 0; j < 4; ++j) o[4 * n + j] = r[j]; }
                int w0 = 0, w1 = 0;
                w0 = __builtin_amdgcn_cvt_pk_fp8_f32(o[0], o[1], w0, false); w0 = __builtin_amdgcn_cvt_pk_fp8_f32(o[2], o[3], w0, true);
                w1 = __builtin_amdgcn_cvt_pk_fp8_f32(o[4], o[5], w1, false); w1 = __builtin_amdgcn_cvt_pk_fp8_f32(o[6], o[7], w1, true);
                *(u32x2*)rowp = (u32x2){(unsigned)w0, (unsigned)w1}; }
    }
};
struct EpiMoeOut {
    static constexpr int PERM = 2; static constexpr int HOOK_T = -1; static constexpr bool PREF = true;
    unsigned char* O; float* SC; const float* bias; float wscale;
    __device__ __forceinline__ void mid(f32x4 (&)[2][2][4][2], const Unit&, int, int, int, int) const {}
    __device__ __forceinline__ void operator()(const f32x4 (&)[2][2][4][2], const Unit&, int, int, int, int) const {}
    __device__ __forceinline__ void prefetch(const Unit& u, LAS unsigned char* tab, int wv) const {
        const int t = tid_of(wv) & 255;
        const __amdgpu_buffer_rsrc_t rs = __builtin_amdgcn_make_buffer_rsrc((void*)bias, 0, 0xffffffff, 0x00020000);
        __builtin_amdgcn_raw_ptr_buffer_load_lds(rs, (LAS void*)(tab + (wv & 3) * 256), 4, (unsigned)(u.e * D + u.pn * BM + t) * 4u, 0, 0, 0);
    }
    __device__ __forceinline__ void run(const f32x4 (&acc)[2][2][4][2], const Unit& u, int wr, int wc, const LAS unsigned char* tab) const {
        int fr, fq; { const int lane_ = tid_of(0); fr = lane_ & 15; fq = lane_ >> 4; }
        int row0 = u.row0 + wr * 64 + fr; asm volatile("" : "+v"(row0)); int col0 = u.pn * BM + wc * 64 + 16 * fq; asm volatile("" : "+v"(col0));
        const LAS float* tf = (const LAS float*)tab;
        f32x4 bv[2][2];
#pragma unroll
        for (int bj = 0; bj < 2; ++bj)
#pragma unroll
            for (int n = 0; n < 2; ++n) bv[bj][n] = *(const LAS f32x4*)(tf + wc * 64 + 16 * fq + 8 * bj + 4 * n);
        const float ws16 = wscale * OUT_FP8_SCALE;
#pragma unroll
        for (int bj = 0; bj < 2; ++bj)
#pragma unroll
            for (int n = 0; n < 2; ++n) bv[bj][n] *= OUT_FP8_SCALE;
#pragma unroll
        for (int ai = 0; ai < 2; ++ai)
#pragma unroll
            for (int m = 0; m < 4; ++m) { const size_t r = (size_t)(row0 + ai * HALF + m * 16);
                unsigned w[4];
#pragma unroll
                for (int q = 0; q < 4; ++q) { const f32x4 v = acc[ai][q >> 1][m][q & 1] * ws16 + bv[q >> 1][q & 1];
                    int p = 0; p = __builtin_amdgcn_cvt_pk_fp8_f32(v.x, v.y, p, false); p = __builtin_amdgcn_cvt_pk_fp8_f32(v.z, v.w, p, true); w[q] = (unsigned)p; }
                *(u32x4*)(O + r * D + col0) = (u32x4){w[0], w[1], w[2], w[3]}; }
    }
};
}

#define XB_TMO      128
#define XB_XCNT(j)  (256  + 64 * (j))
#define XB_XSUB(j)  (1280 + 64 * (j))
#define XB_XGEN(j)  (2304 + 64 * (j))
#define XB_TOP      3328
#define XB_TOPGEN   3392
#define XCD_BAR_WORDS 3456
#define XB_SPIN_CAP (1u << 18)
__device__ __forceinline__ unsigned xb_ld(unsigned* p)              { return __hip_atomic_load(p, __ATOMIC_RELAXED, __HIP_MEMORY_SCOPE_AGENT); }
__device__ __forceinline__ unsigned xb_add(unsigned* p, unsigned v) { return __hip_atomic_fetch_add(p, v, __ATOMIC_RELAXED, __HIP_MEMORY_SCOPE_AGENT); }
__device__ __forceinline__ unsigned xb_xcc_id() { return (unsigned)__builtin_amdgcn_s_getreg((3 << 11) | 20) & 0xFu; }
#define XB_SPIN(cond, bar) do { unsigned _sp = 0; while (cond) { __builtin_amdgcn_s_sleep(1); \
    if ((++_sp & 255u) == 0u) { if (xb_ld(&(bar)[XB_TMO])) break; if (_sp > XB_SPIN_CAP) { atomicAdd(&(bar)[XB_TMO], 1u); break; } } } } while (0)
struct XcdBarrier { unsigned* bar; unsigned x; volatile LAS unsigned* st; int wv; };
__device__ __forceinline__ XcdBarrier xcd_barrier_post(unsigned* bar, volatile LAS unsigned* st, int wv) {
    XcdBarrier b; b.bar = bar; b.x = xb_xcc_id(); b.st = st; b.wv = wv;
    if (tid_of(wv) == 0) (void)xb_add(&bar[XB_XCNT(b.x)], 1u);
    return b;
}
__device__ __forceinline__ void xcd_barrier_complete(unsigned* bar, unsigned x, unsigned& nloc, unsigned& nx) {
    const unsigned G = gridDim.x * gridDim.y * gridDim.z;
    unsigned sum, cnt, mine, sp = 0u;
    for (;;) {
        sum = 0u; cnt = 0u; mine = 0u;
#pragma unroll
        for (unsigned j = 0; j < 16; ++j) { const unsigned c = xb_ld(&bar[XB_XCNT(j)]); sum += c; cnt += (c > 0u) ? 1u : 0u; mine = (j == x) ? c : mine; }
        if (sum == G) break;
        __builtin_amdgcn_s_sleep(1);
        if ((++sp & 255u) == 0u) { if (xb_ld(&bar[XB_TMO])) break; if (sp > XB_SPIN_CAP) { atomicAdd(&bar[XB_TMO], 1u); break; } }
    }
    nloc = mine > 0u ? mine : 1u; nx = cnt > 0u ? cnt : 1u;
}
__device__ __forceinline__ void xcd_barrier(const XcdBarrier& b) {
    asm volatile("s_waitcnt vmcnt(0)" ::: "memory");
    __syncthreads();
    if (tid_of(b.wv) == 0) {
        size_t zb = 0; asm volatile("" : "+s"(zb)); unsigned* bar = b.bar + zb; unsigned bx = b.x; asm volatile("" : "+s"(bx));
        __builtin_amdgcn_s_waitcnt(0);
        unsigned nloc = b.st[0], nx = b.st[1];
        if (nloc == 0u) { xcd_barrier_complete(bar, bx, nloc, nx); b.st[0] = nloc; b.st[1] = nx; }
        const unsigned old = xb_add(&bar[XB_XSUB(bx)], 1u);
        const unsigned gen = old / nloc;
        if (old + 1u == (gen + 1u) * nloc) {
            __builtin_amdgcn_fence(__ATOMIC_RELEASE, "agent");
            asm volatile("s_waitcnt vmcnt(0)" ::: "memory");
            const unsigned og = xb_add(&bar[XB_TOP], 1u);
            const unsigned tg = og / nx;
            if (og + 1u == (tg + 1u) * nx) xb_add(&bar[XB_TOPGEN], 1u);
            else XB_SPIN(xb_ld(&bar[XB_TOPGEN]) == tg, bar);
            __builtin_amdgcn_fence(__ATOMIC_ACQUIRE, "agent");
            xb_add(&bar[XB_XGEN(bx)], 1u);
            asm volatile("s_waitcnt vmcnt(0)" ::: "memory");
        } else {
            XB_SPIN(xb_ld(&bar[XB_XGEN(bx)]) == gen, bar);
            __builtin_amdgcn_fence(__ATOMIC_ACQUIRE, "agent");
            asm volatile("s_waitcnt vmcnt(0)" ::: "memory");
        }
    }
    __syncthreads();
}

struct Args { const float* in[26]; float* out; unsigned char* ws; int ph_lo, ph_hi; };
enum { I_X = 0, I_C, I_N1G, I_N2G, I_WADA, I_BADA, I_WIN, I_CONVW, I_CONVB, I_WRGA, I_BRGA, I_WRGX, I_BRGX, I_LAM, I_WPOOL, I_PSCALE, I_WUPA, I_WUPB, I_WOUT, I_WROUTER, I_BROUTER, I_WEIN, I_BEIN, I_WEOUT, I_BEOUT, I_FINALG };

template <int ROWMODE>
__device__ __forceinline__ void tr_item(const float* W, int N, bf16_t* WT, int dst_ld, int dst_off, int k0, int n0, LAS float* scr, int lane) {
    { float tv[32];
#pragma unroll
    for (int i = 0; i < 32; ++i) tv[i] = W[(size_t)(k0 + 2 * i + (lane >> 5)) * N + n0 + (lane & 31)];
#pragma unroll
    for (int i = 0; i < 32; ++i) scr[(2 * i + (lane >> 5)) * 33 + (lane & 31)] = tv[i]; }
    LDS_WAIT();
    const int c = lane & 7;
#pragma unroll
    for (int j = 0; j < 4; ++j) { const int n = (lane >> 3) + 8 * j; const LAS float* s = scr + (8 * c) * 33 + n;
        u32x4 o; o.x = cvt_pk_bf16(s[0 * 33], s[1 * 33]); o.y = cvt_pk_bf16(s[2 * 33], s[3 * 33]); o.z = cvt_pk_bf16(s[4 * 33], s[5 * 33]); o.w = cvt_pk_bf16(s[6 * 33], s[7 * 33]);
        const int nn = n0 + n; int drow = nn;
        if (ROWMODE == 1) { drow = (nn < 1024) ? (256 * (nn >> 7) + (nn & 127)) : (256 * ((nn - 1024) >> 7) + 128 + ((nn - 1024) & 127)); }
        *(u32x4*)(WT + (size_t)drow * dst_ld + dst_off + k0 + 8 * c) = o; }
    LDS_WAIT();
}
template <int ROWMODE>
__device__ __forceinline__ void tr_item_fp8(const float* W, int N, unsigned char* WT, int k0, int n0, LAS float* scr, int lane) {
    { float tv[64];
#pragma unroll
    for (int i = 0; i < 64; ++i) tv[i] = W[(size_t)(k0 + 2 * i + (lane >> 5)) * N + n0 + (lane & 31)];
#pragma unroll
    for (int i = 0; i < 64; ++i) scr[(2 * i + (lane >> 5)) * 33 + (lane & 31)] = tv[i]; }
    LDS_WAIT();
    const int c = lane & 7;
#pragma unroll
    for (int j = 0; j < 4; ++j) { const int n = (lane >> 3) + 8 * j; const LAS float* s = scr + (16 * c) * 33 + n;
        int o[4];
#pragma unroll
        for (int q = 0; q < 4; ++q) { int w = 0; w = __builtin_amdgcn_cvt_pk_fp8_f32(s[(4 * q) * 33] * WEIN_SCALE, s[(4 * q + 1) * 33] * WEIN_SCALE, w, false);
            w = __builtin_amdgcn_cvt_pk_fp8_f32(s[(4 * q + 2) * 33] * WEIN_SCALE, s[(4 * q + 3) * 33] * WEIN_SCALE, w, true); o[q] = w; }
        const int nn = n0 + n; const int drow = (ROWMODE == 0) ? nn : ((nn < 1024) ? (256 * (nn >> 7) + (nn & 127)) : (256 * ((nn - 1024) >> 7) + 128 + ((nn - 1024) & 127)));
        *(u32x4*)(WT + (size_t)drow * 1024 + k0 + 16 * c) = (u32x4){(unsigned)o[0], (unsigned)o[1], (unsigned)o[2], (unsigned)o[3]}; }
    LDS_WAIT();
}
template <int ROWMODE>
__device__ __forceinline__ void tr_job(int item, const float* src, int K, int N, bf16_t* dst, size_t dst_bstride, int dst_ld, int dst_off, LAS float* scr, int lane) {
    const int nnb = N / 32, nkb = K / 64; const int nb = item % nnb; const int r = item / nnb; const int kb = r % nkb; const int bt = r / nkb;
    tr_item<ROWMODE>(src + (size_t)bt * K * N, N, dst + (size_t)bt * dst_bstride, dst_ld, dst_off, 64 * kb, 32 * nb, scr, lane);
}

constexpr int CONV_Q1 = 3, CONV_Q2 = 3;
constexpr int CONV_ITEMS_L = NE * 8 * 64 + NE * 8 * 32, CONV_CHUNKS_L = CONV_ITEMS_L / 8;
template <int ROWMODE>
__device__ __forceinline__ void tr_item_fp8_nolds(const float* W, int N, unsigned char* WT, int k0, int n0, int lane) {
    float tv[64];
#pragma unroll
    for (int i = 0; i < 64; ++i) tv[i] = W[(size_t)(k0 + 2 * i + (lane >> 5)) * N + n0 + (lane & 31)];
    unsigned o[16];
#pragma unroll
    for (int i = 0; i < 32; ++i) {
        const auto sw = __builtin_amdgcn_permlane32_swap(__float_as_uint(tv[i + 32]), __float_as_uint(tv[i]), false, false);
        const float e_ = __uint_as_float(sw[0]) * WEIN_SCALE, d_ = __uint_as_float(sw[1]) * WEIN_SCALE;
        if (i & 1) o[i >> 1] = (unsigned)__builtin_amdgcn_cvt_pk_fp8_f32(e_, d_, (int)o[i >> 1], true); else o[i >> 1] = (unsigned)__builtin_amdgcn_cvt_pk_fp8_f32(e_, d_, 0, false); }
    const int nn = n0 + (lane & 31); const int drow = (ROWMODE == 0) ? nn : ((nn < 1024) ? (256 * (nn >> 7) + (nn & 127)) : (256 * ((nn - 1024) >> 7) + 128 + ((nn - 1024) & 127)));
    unsigned char* dst = WT + (size_t)drow * 1024 + k0 + ((lane < 32) ? 64 : 0);
#pragma unroll
    for (int q = 0; q < 4; ++q) *(u32x4*)(dst + 16 * q) = (u32x4){o[4 * q], o[4 * q + 1], o[4 * q + 2], o[4 * q + 3]};
}
__device__ __forceinline__ void conv_expert_item(const Args& a, unsigned char* ws, int l, int r, LAS float* scr, int lane) {
    if (r < NE * 8 * 64) { const int nb = r % 64, r2 = r / 64, kb = r2 % 8, bt = l * NE + r2 / 8;
        (void)scr; tr_item_fp8_nolds<1>(a.in[I_WEIN] + (size_t)bt * 1024 * 2048, 2048, (unsigned char*)(ws + WS_WEIN) + (size_t)bt * 2048 * 1024, 128 * kb, 32 * nb, lane); }
    else { r -= NE * 8 * 64; const int nb = r % 32, r2 = r / 32, kb = r2 % 8, bt = l * NE + r2 / 8;
        tr_item_fp8_nolds<0>(a.in[I_WEOUT] + (size_t)bt * 1024 * 1024, 1024, (unsigned char*)(ws + WS_WEOUT) + (size_t)bt * 1024 * 1024, 128 * kb, 32 * nb, lane); }
}
__device__ __forceinline__ void conv_drain(const Args& a, int l, int budget, LAS unsigned char* lds, const int wv) {
    asm volatile("" : "+s"(lds));
    int tid_ = tid_of(wv); asm volatile("" : "+v"(tid_)); const int tid = tid_, lane = tid & 63;
    unsigned char* ws = opaque_ptr(a.ws); unsigned* head = (unsigned*)(ws + WS_CTL) + CW_CONVQ + 64 * l;
    LAS float* scr = (LAS float*)(lds + (wv < 7 ? wv * 16896 : LDS_NVA)); LAS int* slot = (LAS int*)(lds + LDS_BYTES - 512);
    static_assert(7 * 16896 <= LDS_TAB && LDS_NVA + 16896 <= LDS_BYTES - 512, "conversion scratch vs MoE tables");
    for (;;) {
        if (budget == 0) break;
        __syncthreads();
        if (tid == 0) *slot = (int)__hip_atomic_fetch_add(head, 16u, __ATOMIC_RELAXED, __HIP_MEMORY_SCOPE_AGENT);
        __syncthreads();
        const int c = __builtin_amdgcn_readfirstlane(*slot);
        if (c >= CONV_ITEMS_L) break;
        if (c + wv < CONV_ITEMS_L) conv_expert_item(a, ws, l, c + wv, scr, lane);
        if (c + 8 + wv < CONV_ITEMS_L) conv_expert_item(a, ws, l, c + 8 + wv, scr, lane);
        if (budget > 0) --budget;
    }
    __syncthreads();
}
__device__ __forceinline__ void phase_prologue(const Args& a, LAS unsigned char* lds, const int wv) {
    asm volatile("" : "+s"(lds));
    int tid_ = tid_of(wv); asm volatile("" : "+v"(tid_)); const int tid = tid_, lane = tid & 63, wave = __builtin_amdgcn_readfirstlane(tid >> 6);
    const int G = gridDim.x;
    unsigned char* ws = opaque_ptr(a.ws); const int bid = opaque_bid();
    {
        LAS float* cact = (LAS float*)lds;
        LAS float* red = (LAS float*)(lds + 32768);
        for (int i = tid; i < NBATCH * D; i += NTHREADS) { const float v = a.in[I_C][i]; cact[i] = v * sigmoidf_(v); }
        __syncthreads();
        float* mod = (float*)(ws + WS_MOD);
        for (int u = bid; u < DEPTH * 96; u += G) {
            const int l = u / 96, cg = u % 96; const int n = cg * 64 + lane;
            const float* w = a.in[I_WADA] + (size_t)l * D * 6144 + n;
            float acc[8] = {0.f, 0.f, 0.f, 0.f, 0.f, 0.f, 0.f, 0.f};
            const int kb = wave * 128;
#pragma unroll 8
            for (int k = 0; k < 128; ++k) { const float wv = w[(size_t)(kb + k) * 6144];
#pragma unroll
                for (int b = 0; b < 8; ++b) acc[b] += cact[b * D + kb + k] * wv; }
#pragma unroll
            for (int b = 0; b < 8; ++b) red[(wave * 8 + b) * 64 + lane] = acc[b];
            __syncthreads();
            { const int b = tid >> 6; float s = 0.f;
#pragma unroll
              for (int w8 = 0; w8 < 8; ++w8) s += red[(w8 * 8 + b) * 64 + lane];
              mod[((size_t)l * NBATCH + b) * 6144 + n] = s + a.in[I_BADA][(size_t)l * 6144 + n]; }
            __syncthreads();
        }
    }
#if Z_I8
    {
        LAS float* tile = (LAS float*)lds; LAS float* red = (LAS float*)(lds + 1024 * 33 * 4);
        signed char* w8 = (signed char*)(ws + WS_WIN); float* wsc = (float*)(ws + WS_WINSC);
        __syncthreads();
        for (int u = bid; u < DEPTH * (NZ / 32); u += G) {
            const int l = u / (NZ / 32), n0 = (u % (NZ / 32)) * 32; const float* W = a.in[I_WIN] + (size_t)l * D * NZ + n0;
            const int n = tid & 31, kr = tid >> 5;
#pragma unroll 1
            for (int k0 = 0; k0 < 1024; k0 += 256) { float tv[16];
#pragma unroll
                for (int i = 0; i < 16; ++i) tv[i] = W[(size_t)(k0 + 16 * i + kr) * NZ + n];
#pragma unroll
                for (int i = 0; i < 16; ++i) tile[(k0 + 16 * i + kr) * 33 + n] = tv[i]; }
            __syncthreads();
            { float am = 0.f;
#pragma unroll 8
              for (int i = 0; i < 64; ++i) am = fmaxf(am, fabsf(tile[(kr * 64 + i) * 33 + n]));
              red[kr * 32 + n] = am; }
            __syncthreads();
            if (tid < 32) { float am = 1e-30f;
#pragma unroll
                for (int q = 0; q < 16; ++q) am = fmaxf(am, red[q * 32 + tid]);
                red[512 + tid] = 127.0f / am; wsc[(size_t)l * NZ + n0 + tid] = am * (1.0f / 127.0f); }
            __syncthreads();
            { const float inv = red[512 + n]; signed char* dst = w8 + ((size_t)l * NZ + n0 + n) * D + kr * 64;
#pragma unroll
              for (int c = 0; c < 4; ++c) { int w4[4];
#pragma unroll
                  for (int q = 0; q < 4; ++q) { int pk = 0;
#pragma unroll
                      for (int e = 0; e < 4; ++e) pk |= (((int)rintf(tile[(kr * 64 + c * 16 + q * 4 + e) * 33 + n] * inv)) & 0xff) << (8 * e);
                      w4[q] = pk; }
                  *(u32x4*)(dst + 16 * c) = (u32x4){(unsigned)w4[0], (unsigned)w4[1], (unsigned)w4[2], (unsigned)w4[3]}; } }
            __syncthreads();
        }
    }
#endif
    {
        LAS float* scr = (LAS float*)(lds + wave * 16896);
        const int gw = bid * NWAVES + wave, NGW = G * NWAVES;
        constexpr int I_EIN = NE * 8 * 64, I_EOUT = NE * 8 * 32, I_WINI = Z_I8 ? 0 : DEPTH * (Z_FP8 ? 8 : 16) * 144, I_UPA = DEPTH * 16 * 32, I_UPB = DEPTH * 8 * 32, I_OUT = DEPTH * (G_FP8 ? 8 : 16) * 32,
                      I_RGA = DEPTH * 8 * 2 * 4, I_RGX = I_RGA, I_POOL = DEPTH * 4 * 2 * 4;
        constexpr int NITEMS = I_EIN + I_EOUT + I_WINI + I_UPA + I_UPB + I_OUT + I_RGA + I_RGX + I_POOL;
        for (int it = gw; it < NITEMS; it += NGW) {
            int r = it;
            if (r < I_EIN) { const int nb = r % 64, r2 = r / 64, kb = r2 % 8, bt = r2 / 8;
                tr_item_fp8<1>(a.in[I_WEIN] + (size_t)bt * 1024 * 2048, 2048, (unsigned char*)(ws + WS_WEIN) + (size_t)bt * 2048 * 1024, 128 * kb, 32 * nb, scr, lane); continue; } r -= I_EIN;
            if (r < I_EOUT) { const int nb = r % 32, r2 = r / 32, kb = r2 % 8, bt = r2 / 8;
                tr_item_fp8<0>(a.in[I_WEOUT] + (size_t)bt * 1024 * 1024, 1024, (unsigned char*)(ws + WS_WEOUT) + (size_t)bt * 1024 * 1024, 128 * kb, 32 * nb, scr, lane); continue; } r -= I_EOUT;
#if Z_I8
#elif Z_FP8
            if (r < I_WINI) { const int nb = r % 144, r2 = r / 144, kb = r2 % 8, bt = r2 / 8;
                tr_item_fp8<0>(a.in[I_WIN] + (size_t)bt * 1024 * NZ, NZ, (unsigned char*)(ws + WS_WIN) + (size_t)bt * NZ * 1024, 128 * kb, 32 * nb, scr, lane); continue; } r -= I_WINI;
#else
            if (r < I_WINI) { tr_job<0>(r, a.in[I_WIN], 1024, NZ, (bf16_t*)(ws + WS_WIN), (size_t)NZ * 1024, 1024, 0, scr, lane); continue; } r -= I_WINI;
#endif
            if (r < I_UPA) { tr_job<0>(r, a.in[I_WUPA], 1024, 1024, (bf16_t*)(ws + WS_WCAT), (size_t)1024 * KCAT, KCAT, 512, scr, lane); continue; } r -= I_UPA;
            if (r < I_UPB) { tr_job<0>(r, a.in[I_WUPB], 512, 1024, (bf16_t*)(ws + WS_WCAT), (size_t)1024 * KCAT, KCAT, 0, scr, lane); continue; } r -= I_UPB;
#if G_FP8
            if (r < I_OUT) { const int nb = r % 32, r2 = r / 32, kb = r2 % 8, bt = r2 / 8;
                tr_item_fp8<0>(a.in[I_WOUT] + (size_t)bt * 1024 * 1024, 1024, (unsigned char*)(ws + WS_WOUT) + (size_t)bt * 1024 * 1024, 128 * kb, 32 * nb, scr, lane); continue; } r -= I_OUT;
#else
            if (r < I_OUT) { tr_job<0>(r, a.in[I_WOUT], 1024, 1024, (bf16_t*)(ws + WS_WOUT), (size_t)1024 * 1024, 1024, 0, scr, lane); continue; } r -= I_OUT;
#endif
            if (r < I_RGA) { tr_job<0>(r, a.in[I_WRGA], 128, 128, (bf16_t*)(ws + WS_WRG), (size_t)256 * 128, 128, 0, scr, lane); continue; } r -= I_RGA;
            if (r < I_RGX) { tr_job<0>(r, a.in[I_WRGX], 128, 128, (bf16_t*)(ws + WS_WRG) + 128 * 128, (size_t)256 * 128, 128, 0, scr, lane); continue; } r -= I_RGX;
            tr_job<0>(r, a.in[I_WPOOL], 128, 128, (bf16_t*)(ws + WS_WPOOL), (size_t)128 * 128, 128, 0, scr, lane);
        }
    }
}

struct MoeTab { LAS int* cnt; LAS int* padstart; LAS int* tilestart; LAS int* tab; };
__device__ __forceinline__ MoeTab moe_tab_ptrs(LAS unsigned char* lds) { MoeTab t; t.cnt = (LAS int*)(lds + LDS_TAB); t.padstart = t.cnt + 32; t.tilestart = t.padstart + 40; t.tab = t.tilestart + 40; return t; }
__device__ __forceinline__ void moe_tables(const Args& a, int l, LAS unsigned char* lds, const int wv) {
    asm volatile("" : "+s"(lds));
    const MoeTab mt = moe_tab_ptrs(lds); int tid_ = tid_of(wv); asm volatile("" : "+v"(tid_)); const int tid = tid_;
    unsigned* ctl = (unsigned*)(opaque_ptr(a.ws) + WS_CTL);
    __syncthreads();
    if (tid < NE) mt.cnt[tid] = (int)__hip_atomic_load(ctl + CW_CNT + (l * NE + tid) * 16, __ATOMIC_RELAXED, __HIP_MEMORY_SCOPE_AGENT);
    __syncthreads();
    if (tid == 0) { int ps = 0, ts = 0; for (int e = 0; e < NE; ++e) { mt.padstart[e] = ps; mt.tilestart[e] = ts; const int nt = (mt.cnt[e] + 255) >> 8; ps += nt * 256; ts += nt; } mt.padstart[NE] = ps; mt.tilestart[NE] = ts; }
    __syncthreads();
    const int nMt = mt.tilestart[NE];
    for (int m = tid; m < nMt; m += NTHREADS) { int e = 0; for (int q = 1; q < NE; ++q) e = (mt.tilestart[q] <= m) ? q : e; mt.tab[m] = (e << 16) | (m - mt.tilestart[e]); }
    __syncthreads();
}
#ifndef MOE_WGM1
#define MOE_WGM1 4
#endif
#ifndef MOE_WGM2
#define MOE_WGM2 8
#endif
struct MoeSched1 {
    static constexpr bool DYN_A = true;
    const char* H; const char* W; const int* tokof; MoeTab mt; int nMt, G, c;
    __device__ __forceinline__ bool next(int i, pg8::Unit& u) const { int pm, pn; if (!pg8::order_map<MOE_WGM1>(i, G, c, nMt, 8, pm, pn)) return false;
        const int en = __builtin_amdgcn_readfirstlane(mt.tab[pm]); u.pm = pm; u.pn = pn; u.e = en >> 16; u.j = en & 0xffff;
        u.row0 = __builtin_amdgcn_readfirstlane(mt.padstart[u.e]) + 256 * u.j; u.rows = __builtin_amdgcn_readfirstlane(mt.cnt[u.e]) - 256 * u.j; return true; }
    __device__ __forceinline__ const char* a_ptr() const { return H; }
    __device__ __forceinline__ const char* b_ptr() const { return W; }
    __device__ __forceinline__ unsigned a_off(const pg8::Unit&) const { return 0u; }
    __device__ __forceinline__ unsigned b_off(const pg8::Unit& u) const { return ((unsigned)u.e * 2048u + (unsigned)u.pn * 256u) * 1024u; }
    __device__ __forceinline__ void a_voff(const pg8::Unit& u, unsigned (&v)[2][2], int wv) const {
        int tid = tid_of(wv); asm volatile("" : "+v"(tid));
        const int* tl = tokof + (size_t)u.e * T + 256 * u.j; const int rmax = u.rows - 1;
        int tk[2][2], cc[2];
#pragma unroll
        for (int i = 0; i < 2; ++i) { int R, C; pg8::stage_rc(tid * 16 + i * 8192, R, C); cc[i] = C;
#pragma unroll
            for (int h = 0; h < 2; ++h) { int idx = h * 128 + R; idx = idx < rmax ? idx : rmax; tk[h][i] = tl[idx]; } }
        asm volatile("" ::: "memory");
#pragma unroll
        for (int i = 0; i < 2; ++i)
#pragma unroll
            for (int h = 0; h < 2; ++h) v[h][i] = (unsigned)tk[h][i] * 1024u + (unsigned)cc[i] * 2u;
    }
    __device__ __forceinline__ void a_dma(const pg8::Unit& u, LAS unsigned char* slots, int wv) const {
        const int tid = tid_of(wv); const int rmax = u.rows - 1;
        const __amdgpu_buffer_rsrc_t rs = __builtin_amdgcn_make_buffer_rsrc((void*)tokof, 0, 0xffffffff, 0x00020000);
        const unsigned so = (unsigned)(u.e * T + 256 * u.j) * 4u;
#pragma unroll
        for (int i = 0; i < 2; ++i) { int R, C; pg8::stage_rc(tid * 16 + i * 8192, R, C);
#pragma unroll
            for (int h = 0; h < 2; ++h) { int idx = h * 128 + R; idx = idx < rmax ? idx : rmax;
                __builtin_amdgcn_raw_ptr_buffer_load_lds(rs, (LAS void*)(slots + (h * 2 + i) * 2048 + wv * 256), 4, (unsigned)idx * 4u, so, 0, 0); } }
    }
    __device__ __forceinline__ void a_fetch(const LAS unsigned char* slots, int wv, unsigned (&q)[4]) const {
        const int tid = tid_of(wv); int R, C; pg8::stage_rc(tid * 16, R, C);
#pragma unroll
        for (int k = 0; k < 4; ++k) q[k] = *(const LAS unsigned*)(slots + k * 2048 + tid * 4) * 1024u + (unsigned)C * 2u;
    }
};
struct MoeSched2 {
    static constexpr bool DYN_A = false;
    const char* ACT; const char* W; MoeTab mt; int nMt, G, c;
    __device__ __forceinline__ bool next(int i, pg8::Unit& u) const { int pm, pn; if (!pg8::order_map<MOE_WGM2>(i, G, c, nMt, 4, pm, pn)) return false;
        const int en = __builtin_amdgcn_readfirstlane(mt.tab[pm]); u.pm = pm; u.pn = pn; u.e = en >> 16; u.j = en & 0xffff;
        u.row0 = __builtin_amdgcn_readfirstlane(mt.padstart[u.e]) + 256 * u.j; u.rows = __builtin_amdgcn_readfirstlane(mt.cnt[u.e]) - 256 * u.j; return true; }
    __device__ __forceinline__ const char* a_ptr() const { return ACT; }
    __device__ __forceinline__ const char* b_ptr() const { return W; }
    __device__ __forceinline__ unsigned a_off(const pg8::Unit& u) const { return (unsigned)u.row0 * 1024u; }
    __device__ __forceinline__ unsigned b_off(const pg8::Unit& u) const { return ((unsigned)u.e * 1024u + (unsigned)u.pn * 256u) * 1024u; }
    __device__ __forceinline__ void a_voff(const pg8::Unit&, unsigned (&v)[2][2], int wv) const {
        int tid = tid_of(wv); asm volatile("" : "+v"(tid));
#pragma unroll
        for (int i = 0; i < 2; ++i) { int R, C; pg8::stage_rc(tid * 16 + i * 8192, R, C);
#pragma unroll
            for (int h = 0; h < 2; ++h) v[h][i] = (unsigned)((h * 128 + R) * 512 + C) * 2u; }
    }
};

template <int LK>
__device__ __forceinline__ void phase_a(const Args& a, int l, LAS unsigned char* lds, bool dry, const int wv) {
    asm volatile("" : "+s"(lds));
    int tid_ = tid_of(wv); asm volatile("" : "+v"(tid_)); const int tid = tid_, lane = tid & 63, wave = __builtin_amdgcn_readfirstlane(tid >> 6);
    const int G = gridDim.x; unsigned char* ws = opaque_ptr(a.ws); const int bid = opaque_bid();
    const float* mod = (const float*)(ws + WS_MOD);
    bf16_t* xres = (bf16_t*)(ws + WS_XRES); bf16_t* xout = dry ? (bf16_t*)(ws + WS_Z) : xres;
    if ((LK != 2)) {
        LAS float* red = (LAS float*)lds;
        for (int wu = bid; wu < NBATCH * NE; wu += G) { const int b2 = wu >> 5, e = wu & 31;
            const float* sh2 = mod + ((size_t)l * NBATCH + b2) * 6144 + 3 * D; const float* wr = a.in[I_WROUTER] + (size_t)l * D * NE;
            float sm = sh2[tid] * wr[tid * NE + e] + sh2[tid + 512] * wr[(tid + 512) * NE + e];
            sm = wave_sum(sm, lane);
            __syncthreads();
            if (lane == 0) red[wave] = sm;
            __syncthreads();
            if (tid == 0) { float t = a.in[I_BROUTER][l * NE + e]; for (int q = 0; q < 8; ++q) t += red[q]; ((float*)(ws + WS_CB))[(l * NBATCH + b2) * NE + e] = t; }
        }
        __syncthreads();
    }
    if ((LK != 2)) {
        for (int wu = bid; wu < NBATCH * 32; wu += G) { const int b2 = wu >> 5, part = wu & 31;
            const float* n2 = a.in[I_N2G] + (size_t)l * D; const float* sc2 = mod + ((size_t)l * NBATCH + b2) * 6144 + 4 * D; const float* wr2 = a.in[I_WROUTER] + (size_t)l * D * NE;
            bf16_t* wrb = (bf16_t*)(ws + WS_WRB) + (size_t)b2 * 2 * NE * D;
#pragma unroll
            for (int r = 0; r < 2; ++r) { const int idx = part * 1024 + r * NTHREADS + tid; const int ee = idx & 31, k = idx >> 5;
                const float w = wr2[idx] * (n2[k] * (1.0f + sc2[k])); const unsigned hi = cvt_pk_bf16(w, 0.f) & 0xffffu; const unsigned lo = cvt_pk_bf16(w - bflo(hi), 0.f) & 0xffffu;
                wrb[(size_t)ee * D + k] = (bf16_t)hi; wrb[(size_t)(NE + ee) * D + k] = (bf16_t)lo; } }
    }
    if ((LK != 0) && REP_MASK != 0) moe_tables(a, (l - 1) + DEPTH * (REPN(7) - 1), lds, wv);
    const MoeTab mt = moe_tab_ptrs(lds);
    const int* slotinfo = (const int*)(ws + WS_SLOTINFO); const float* wgt = (const float*)(ws + WS_WGT);
    const unsigned char* outb = (const unsigned char*)(ws + WS_OUTB); const float* outsc = (const float*)(ws + WS_OUTSC);
    unsigned char* hb = (unsigned char*)(ws + WS_H);
    for (int chunk = bid; chunk < T / 128; chunk += G) {
        const int rowb = chunk * 128 + wave * 16; const int b = rowb / SEQ;
        const float* xin = a.in[I_X] + (size_t)rowb * D; const bf16_t* xinb = xres + (size_t)rowb * D;
        f32x4 xv[2][4]; int4 si[4]; f32x4 wv[4]; unsigned gv[2][4][4];
#define PA_SX(r, q) do { if ((r) < 16) { _Pragma("unroll") for (int j = 0; j < 4; ++j) { if ((LK == 0)) xv[(q) & 1][j] = *(const f32x4*)(xin + (size_t)(r) * D + 4 * lane + 256 * j); \
            else { const f32x2 t_ = *(const f32x2*)(xinb + (size_t)(r) * D + 4 * lane + 256 * j); xv[(q) & 1][j].x = t_.x; xv[(q) & 1][j].y = t_.y; } } } } while (0)
#define PA_S0(r, q) do { if ((r) < 16 && (LK != 0)) { si[(q) & 3] = *(const int4*)(slotinfo + (size_t)(rowb + (r)) * 4); wv[(q) & 3] = *(const f32x4*)(wgt + (size_t)(rowb + (r)) * 4); } } while (0)
#define PA_S1(r, q) do { if ((r) < 16 && (LK != 0)) { const int sl_[4] = {si[(q) & 3].x, si[(q) & 3].y, si[(q) & 3].z, si[(q) & 3].w}; \
            _Pragma("unroll") for (int kk = 0; kk < 4; ++kk) { const int e_ = sl_[kk] >> 24, li_ = sl_[kk] & 0xffffff; const size_t slot_ = (size_t)(mt.padstart[e_] + li_); const unsigned char* orow = outb + slot_ * D + 4 * lane; \
                _Pragma("unroll") for (int j = 0; j < 4; ++j) gv[(q) & 1][kk][j] = *(const unsigned*)(orow + 256 * j); } } } while (0)
        f32x4 gmv[4], shv[4], g2v[4];
#pragma unroll
        for (int j = 0; j < 4; ++j) {
            if ((LK != 2)) { const float* ng_ = a.in[I_N1G] + (size_t)l * D + 4 * lane + 256 * j; const float* mb_ = mod + ((size_t)l * NBATCH + b) * 6144 + 4 * lane + 256 * j;
                gmv[j] = *(const f32x4*)ng_ * (1.0f + *(const f32x4*)(mb_ + D)); shv[j] = *(const f32x4*)mb_; }
            else { gmv[j] = *(const f32x4*)(a.in[I_FINALG] + 4 * lane + 256 * j); shv[j] = (f32x4){0.f, 0.f, 0.f, 0.f}; }
            g2v[j] = ((LK != 0)) ? *(const f32x4*)(mod + ((size_t)(l - 1) * NBATCH + b) * 6144 + 5 * D + 4 * lane + 256 * j) : (f32x4){0.f, 0.f, 0.f, 0.f}; }
        PA_S0(0, 0); PA_S0(1, 1); PA_SX(0, 0); PA_S1(0, 0);
#pragma unroll 1
        for (int i0 = 0; i0 < 16; i0 += 4) {
#pragma unroll
          for (int ii = 0; ii < 4; ++ii) {
            const int i = i0 + ii; const int row = rowb + i;
            PA_S0(i + 2, ii + 2); PA_SX(i + 1, ii + 1); PA_S1(i + 1, ii + 1);
            f32x4 v[4];
#pragma unroll
            for (int j = 0; j < 4; ++j) { v[j] = xv[ii & 1][j];
                if ((LK != 0)) { const unsigned p0 = __float_as_uint(v[j].x), p1 = __float_as_uint(v[j].y); v[j] = (f32x4){bflo(p0), bfhi(p0), bflo(p1), bfhi(p1)}; } }
            if ((LK != 0)) {
                f32x4 y[4];
#pragma unroll
                for (int j = 0; j < 4; ++j) y[j] = (f32x4){0.f, 0.f, 0.f, 0.f};
#pragma unroll
                for (int kk = 0; kk < 4; ++kk) { const float wk = wv[ii][kk] * (1.0f / OUT_FP8_SCALE);
#pragma unroll
                    for (int j = 0; j < 4; ++j) { const int p = (int)gv[ii & 1][kk][j];
                        const auto lo = __builtin_amdgcn_cvt_pk_f32_fp8(p, false), hi = __builtin_amdgcn_cvt_pk_f32_fp8(p, true);
                        y[j] += wk * (f32x4){lo[0], lo[1], hi[0], hi[1]}; } }
#pragma unroll
                for (int j = 0; j < 4; ++j) v[j] += g2v[j] * y[j];
            }
            if ((LK != 2)) {
#pragma unroll
                for (int j = 0; j < 4; ++j) { u32x2 p; p.x = cvt_pk_bf16(v[j].x, v[j].y); p.y = cvt_pk_bf16(v[j].z, v[j].w); *(u32x2*)(xout + (size_t)row * D + 4 * lane + 256 * j) = p; }
            }
            float ss = 0.f;
#pragma unroll
            for (int j = 0; j < 4; ++j) ss += (v[j].x * v[j].x + v[j].y * v[j].y) + (v[j].z * v[j].z + v[j].w * v[j].w);
            const float rinv = __builtin_amdgcn_rsqf(wave_sum(ss, lane) * (1.0f / D) + NORM_EPS);
            if ((LK != 2)) {
                f32x4 hq[4]; (void)hq;
#pragma unroll
                for (int j = 0; j < 4; ++j) {
                    const f32x4 h = (v[j] * rinv) * gmv[j] + shv[j];
#if Z_I8
                    hq[j] = h; }
                {   float am = 0.f;
#pragma unroll
                    for (int j = 0; j < 4; ++j) am = fmaxf(fmaxf(fmaxf(fabsf(hq[j].x), fabsf(hq[j].y)), fmaxf(fabsf(hq[j].z), fabsf(hq[j].w))), am);
                    am = wave_max(am);
                    am = fmaxf(am, 1e-20f); const float inv = 127.0f / am;
                    if (lane == 0) ((float*)(ws + WS_HSC))[row] = am * (1.0f / 127.0f);
#pragma unroll
                    for (int j = 0; j < 4; ++j) { const int q0 = (int)rintf(hq[j].x * inv), q1 = (int)rintf(hq[j].y * inv), q2 = (int)rintf(hq[j].z * inv), q3 = (int)rintf(hq[j].w * inv);
                        *(int*)(hb + (size_t)row * D + 4 * lane + 256 * j) = (q0 & 0xff) | ((q1 & 0xff) << 8) | ((q2 & 0xff) << 16) | ((q3 & 0xff) << 24); }
                }
#elif Z_FP8
                    int p = 0; p = __builtin_amdgcn_cvt_pk_fp8_f32(h.x, h.y, p, false); p = __builtin_amdgcn_cvt_pk_fp8_f32(h.z, h.w, p, true);
                    *(int*)(hb + (size_t)row * D + 4 * lane + 256 * j) = p; }
#else
                    u32x2 p; p.x = cvt_pk_bf16(h.x, h.y); p.y = cvt_pk_bf16(h.z, h.w); *(u32x2*)((bf16_t*)hb + (size_t)row * D + 4 * lane + 256 * j) = p; }
#endif
            } else {
#pragma unroll
                for (int j = 0; j < 4; ++j) *(f32x4*)(a.out + (size_t)row * D + 4 * lane + 256 * j) = v[j] * rinv * gmv[j];
            }
          }
        }
#undef PA_S0
#undef PA_SX
#undef PA_S1
    }
}

__device__ __forceinline__ bool conv_wave_pop(const Args& a, unsigned char* ws, int l, int lane) {
    unsigned* head = (unsigned*)(ws + WS_CTL) + CW_CONVQ + 64 * l;
    unsigned r = 0;
    if (lane == 0) r = __hip_atomic_fetch_add(head, 1u, __ATOMIC_RELAXED, __HIP_MEMORY_SCOPE_AGENT);
    r = (unsigned)__builtin_amdgcn_readfirstlane((int)r);
    if (r >= (unsigned)CONV_ITEMS_L) return false;
    conv_expert_item(a, ws, l, (int)r, nullptr, lane);
    return true;
}
constexpr int H_WLDS = 20480, H_WROW = 2048 + 16;
static_assert(H_WLDS + 64 * H_WROW <= LDS_BYTES - 512, "phase H LDS map");
__device__ __forceinline__ void phase_h(const Args& a, int l, int cset, int conv_l, LAS unsigned char* lds, const int wv) {
    asm volatile("" : "+s"(lds));
    int tid_ = tid_of(wv); asm volatile("" : "+v"(tid_)); const int tid = tid_, lane = tid & 63, wave = __builtin_amdgcn_readfirstlane(tid >> 6);
    const int G = gridDim.x; unsigned char* ws = opaque_ptr(a.ws); const int bid = opaque_bid();
    const float* mod = (const float*)(ws + WS_MOD); const bf16_t* xres = (const bf16_t*)(ws + WS_XRES);
    unsigned char* h8 = (unsigned char*)(ws + WS_H);
    LAS float* rinvs = (LAS float*)lds;
    LAS float* lgt = (LAS float*)(lds + 1024);
    LAS int* hist = (LAS int*)(lds + 1024 + 8 * 16 * 33 * 4);
    LAS int* base = hist + 32;
    unsigned* ctl = (unsigned*)(ws + WS_CTL);
    const float* ng = a.in[I_N2G] + (size_t)l * D;
    const float* cbv = (const float*)(ws + WS_CB);
    int* tokof = (int*)(ws + WS_TOKOF); int* slotinfo = (int*)(ws + WS_SLOTINFO); float* wgt = (float*)(ws + WS_WGT);
    for (int chunk = bid; chunk < T / 128; chunk += G) {
        const int row0 = chunk * 128 + wave * 16; const int b = row0 / SEQ;
        const float* mb = mod + ((size_t)l * NBATCH + b) * 6144 + 3 * D;
        if (tid < 32) hist[tid] = 0;
        {
            const __amdgpu_buffer_rsrc_t rw = __builtin_amdgcn_make_buffer_rsrc((void*)((const bf16_t*)(ws + WS_WRB) + (size_t)b * 2 * NE * D), 0, 0xffffffff, 0x00020000);
#pragma unroll
            for (int k = 0; k < 16; ++k) { const int wrow = wave * 8 + (k >> 1), half = k & 1;
                __builtin_amdgcn_raw_ptr_buffer_load_lds(rw, (LAS void*)(lds + H_WLDS + wrow * H_WROW + half * 1024), 16, (unsigned)lane * 16u, (unsigned)(wrow * 2048 + half * 1024), 0, 0); }
        }
        const bool split = conv_l >= 0;
        unsigned hq_ = 0;
        if (split && wave >= 4 && lane == 0) hq_ = __hip_atomic_load((unsigned*)(ws + WS_CTL) + CW_CONVQ + 64 * conv_l, __ATOMIC_RELAXED, __HIP_MEMORY_SCOPE_AGENT);
        asm volatile("s_waitcnt vmcnt(0)" ::: "memory");
        __syncthreads();
        if (split && wave >= 4) {
            const unsigned h0 = (unsigned)__builtin_amdgcn_readfirstlane((int)hq_);
            for (unsigned r = h0 + (unsigned)(bid * 4 + (wave - 4)); r < (unsigned)CONV_ITEMS_L; r += (unsigned)(G * 4)) conv_expert_item(a, ws, conv_l, (int)r, nullptr, lane);
        }
        else {
        const int npass = split ? 2 : 1;
        for (int pass = 0; pass < npass; ++pass) { const int vw = wave + 4 * pass; const int row0 = chunk * 128 + vw * 16;
        f32x4 gm2[4], sh2[4];
#pragma unroll
        for (int j = 0; j < 4; ++j) { gm2[j] = *(const f32x4*)(ng + 4 * lane + 256 * j) * (1.0f + *(const f32x4*)(mb + D + 4 * lane + 256 * j)); sh2[j] = *(const f32x4*)(mb + 4 * lane + 256 * j); }
        u32x2 xq[16][4];
#pragma unroll
        for (int r = 0; r < 16; ++r)
#pragma unroll
            for (int j = 0; j < 4; ++j) xq[r][j] = *(const u32x2*)(xres + (size_t)(row0 + r) * D + 4 * lane + 256 * j);
        asm volatile("" ::: "memory");
#pragma unroll
        for (int i = 0; i < 16; ++i) {
            const int row = row0 + i;
            f32x4 v[4]; float ss = 0.f;
#pragma unroll
            for (int j = 0; j < 4; ++j) { const u32x2 p = xq[i][j]; v[j] = (f32x4){bflo(p.x), bfhi(p.x), bflo(p.y), bfhi(p.y)}; ss += (v[j].x * v[j].x + v[j].y * v[j].y) + (v[j].z * v[j].z + v[j].w * v[j].w); }
            const float rinv = __builtin_amdgcn_rsqf(wave_sum(ss, lane) * (1.0f / D) + NORM_EPS);
            if (lane == 0) rinvs[vw * 16 + i] = rinv;
#pragma unroll
            for (int j = 0; j < 4; ++j) {
                const f32x4 h = (v[j] * rinv) * gm2[j] + sh2[j];
                int p = 0; p = __builtin_amdgcn_cvt_pk_fp8_f32(h.x, h.y, p, false); p = __builtin_amdgcn_cvt_pk_fp8_f32(h.z, h.w, p, true);
                *(int*)(h8 + (size_t)row * D + 4 * lane + 256 * j) = p; }
        }
        {
            const int ri = lane & 15, q = lane >> 4;
            const bf16_t* xr = xres + (size_t)(row0 + ri) * D + 8 * q;
            bf16x8 axs[32];
#pragma unroll
            for (int kb = 0; kb < 32; ++kb) axs[kb] = *(const bf16x8*)(xr + 32 * kb);
            const LAS unsigned char* wh = lds + H_WLDS + ri * H_WROW + 16 * q; const LAS unsigned char* wl = wh + NE * H_WROW;
            f32x4 acc0 = {0.f, 0.f, 0.f, 0.f}, acc1 = {0.f, 0.f, 0.f, 0.f};
#pragma unroll
            for (int kb = 0; kb < 32; ++kb) {
                const bf16x8 ax = axs[kb];
                const bf16x8 bh0 = *(const LAS bf16x8*)(wh + 64 * kb), bl0 = *(const LAS bf16x8*)(wl + 64 * kb), bh1 = *(const LAS bf16x8*)(wh + 16 * H_WROW + 64 * kb), bl1 = *(const LAS bf16x8*)(wl + 16 * H_WROW + 64 * kb);
                acc0 = __builtin_amdgcn_mfma_f32_16x16x32_bf16(ax, bh0, acc0, 0, 0, 0); acc0 = __builtin_amdgcn_mfma_f32_16x16x32_bf16(ax, bl0, acc0, 0, 0, 0);
                acc1 = __builtin_amdgcn_mfma_f32_16x16x32_bf16(ax, bh1, acc1, 0, 0, 0); acc1 = __builtin_amdgcn_mfma_f32_16x16x32_bf16(ax, bl1, acc1, 0, 0, 0);
            }
            LDS_WAIT();
            const float c0 = cbv[(l * NBATCH + b) * NE + ri], c1 = cbv[(l * NBATCH + b) * NE + 16 + ri];
#pragma unroll
            for (int r = 0; r < 4; ++r) { const int ti = 4 * q + r; const float rv = rinvs[vw * 16 + ti];
                lgt[(vw * 16 + ti) * 33 + ri] = acc0[r] * rv + c0; lgt[(vw * 16 + ti) * 33 + 16 + ri] = acc1[r] * rv + c1; }
        }
        }
        }
        __syncthreads();
        int se[4] = {0, 0, 0, 0}; float sw[4] = {0.f, 0.f, 0.f, 0.f}; int rk[4] = {0, 0, 0, 0};
        if (lane < 16) {
            float v[32];
#pragma unroll
            for (int e = 0; e < 32; ++e) v[e] = lgt[(wave * 16 + lane) * 33 + e];
            float sv[4];
#pragma unroll
            for (int kk = 0; kk < 4; ++kk) { float best = v[0]; int bi = 0;
#pragma unroll
                for (int e = 1; e < 32; ++e) { if (v[e] > best) { best = v[e]; bi = e; } }
                sv[kk] = best; se[kk] = bi;
#pragma unroll
                for (int e = 0; e < 32; ++e) v[e] = (e == bi) ? -3.0e38f : v[e]; }
            float den = 0.f;
#pragma unroll
            for (int kk = 0; kk < 4; ++kk) { sw[kk] = __expf(sv[kk] - sv[0]); den += sw[kk]; }
            const float inv = 1.0f / den;
#pragma unroll
            for (int kk = 0; kk < 4; ++kk) { sw[kk] *= inv; rk[kk] = __hip_atomic_fetch_add(hist + se[kk], 1, __ATOMIC_RELAXED, __HIP_MEMORY_SCOPE_WORKGROUP); }
        }
        __syncthreads();
        if (tid < 32) base[tid] = (int)__hip_atomic_fetch_add(ctl + CW_CNT + (cset * NE + tid) * 16, (unsigned)hist[tid], __ATOMIC_RELAXED, __HIP_MEMORY_SCOPE_AGENT);
        __syncthreads();
        if (lane < 16) {
            const int row = row0 + lane; int si[4];
#pragma unroll
            for (int kk = 0; kk < 4; ++kk) { const int li = base[se[kk]] + rk[kk]; tokof[(size_t)se[kk] * T + li] = row; si[kk] = (se[kk] << 24) | li; }
            *(int4*)(slotinfo + (size_t)row * 4) = make_int4(si[0], si[1], si[2], si[3]);
            *(f32x4*)(wgt + (size_t)row * 4) = (f32x4){sw[0], sw[1], sw[2], sw[3]};
        }
        __syncthreads();
    }
}

constexpr int ZT_STRIDE = 528;
template <int NR>
__device__ __forceinline__ void stage_z8(const unsigned char* z8, const float* zs, int b, int p_first, int tile, LAS unsigned char* zt, int tid) {
    constexpr int NP = NR * 16, NK = (NP + NTHREADS - 1) / NTHREADS;
    u32x4 q[NK]; float sc[NK];
    const __amdgpu_buffer_rsrc_t rz = __builtin_amdgcn_make_buffer_rsrc((void*)z8, 0, 0xffffffff, 0x00020000), rq = __builtin_amdgcn_make_buffer_rsrc((void*)zs, 0, 0xffffffff, 0x00020000);
#pragma unroll
    for (int k = 0; k < NK; ++k) { int idx = tid + NTHREADS * k; idx = idx < NP ? idx : NP - 1; const int r = idx >> 4, pc = idx & 15; const int p = p_first + r; const unsigned row = (unsigned)(b * SEQ + (p < 0 ? 0 : p));
        q[k] = __builtin_bit_cast(u32x4, __builtin_amdgcn_raw_buffer_load_b128(rz, (int)(row * 2560u + (unsigned)(tile * 256 + pc * 16)), 0, 0));
#if Z_OUT_FP8
        (void)rq; sc[k] = p < 0 ? 0.f : (1.0f / Z_FP8_SCALE); }
#else
        const float t = __builtin_bit_cast(float, __builtin_amdgcn_raw_buffer_load_b32(rq, (int)((row * 40u + (unsigned)(tile * 4 + (pc >> 2))) * 4u), 0, 0)); sc[k] = p < 0 ? 0.f : t; }
#endif
#pragma unroll
    for (int k = 0; k < NK; ++k) { int idx = tid + NTHREADS * k; idx = idx < NP ? idx : NP - 1; const int r = idx >> 4, pc = idx & 15; float m128 = -128.0f; asm volatile("" : "+v"(m128));
        const float sk = sc[k], of = m128 * sk;
        const unsigned w[4] = {q[k].x, q[k].y, q[k].z, q[k].w}; unsigned o[8];
#pragma unroll
#if Z_OUT_FP8
        for (int d = 0; d < 4; ++d) { (void)of; const auto lo = __builtin_amdgcn_cvt_pk_f32_fp8((int)w[d], false), hi = __builtin_amdgcn_cvt_pk_f32_fp8((int)w[d], true);
            o[2 * d] = cvt_pk_bf16(lo[0] * sk, lo[1] * sk); o[2 * d + 1] = cvt_pk_bf16(hi[0] * sk, hi[1] * sk); }
#else
        for (int d = 0; d < 4; ++d) { o[2 * d] = cvt_pk_bf16((float)(w[d] & 0xffu) * sk + of, (float)((w[d] >> 8) & 0xffu) * sk + of); o[2 * d + 1] = cvt_pk_bf16((float)((w[d] >> 16) & 0xffu) * sk + of, (float)(w[d] >> 24) * sk + of); }
#endif
        *(LAS u32x4*)(zt + r * ZT_STRIDE + pc * 32) = (u32x4){o[0], o[1], o[2], o[3]}; *(LAS u32x4*)(zt + r * ZT_STRIDE + pc * 32 + 16) = (u32x4){o[4], o[5], o[6], o[7]};
        asm volatile("" ::: "memory"); }
}
__device__ __forceinline__ void lru_unit(const Args& a, int l, int u, LAS unsigned char* lds, const int wv) {
    asm volatile("" : "+s"(lds));
    int tid_ = tid_of(wv); asm volatile("" : "+v"(tid_)); const int tid = tid_, lane = tid & 63, wave = __builtin_amdgcn_readfirstlane(tid >> 6);
    unsigned char* ws = opaque_ptr(a.ws);
    const unsigned char* z8 = (const unsigned char*)(ws + WS_Z); const float* zs = (const float*)(ws + WS_ZS);
    LAS unsigned char* zt = lds; LAS unsigned char* xc = lds + 131 * ZT_STRIDE;
    const int hp = u & 3, b = (u >> 2) & 7, s = u >> 5;
    const int t0 = b * SEQ + s * 128, p0 = s * 128;
    stage_z8<131>(z8, zs, b, p0 - 3, hp, zt, tid);
    __syncthreads();
    {
        const int o = tid & 31, rb = tid >> 5; const int ch0 = hp * 256 + o * 8;
        float cw[4][8], cbias[8];
#pragma unroll
        for (int k = 0; k < 4; ++k) { const f32x4 w0 = *(const f32x4*)(a.in[I_CONVW] + ((size_t)l * 4 + k) * D + ch0), w1 = *(const f32x4*)(a.in[I_CONVW] + ((size_t)l * 4 + k) * D + ch0 + 4);
            cw[k][0] = w0.x; cw[k][1] = w0.y; cw[k][2] = w0.z; cw[k][3] = w0.w; cw[k][4] = w1.x; cw[k][5] = w1.y; cw[k][6] = w1.z; cw[k][7] = w1.w; }
        { const f32x4 b0 = *(const f32x4*)(a.in[I_CONVB] + (size_t)l * D + ch0), b1 = *(const f32x4*)(a.in[I_CONVB] + (size_t)l * D + ch0 + 4);
          cbias[0] = b0.x; cbias[1] = b0.y; cbias[2] = b0.z; cbias[3] = b0.w; cbias[4] = b1.x; cbias[5] = b1.y; cbias[6] = b1.z; cbias[7] = b1.w; }
#pragma unroll 2
        for (int i = 0; i < 8; ++i) { const int r = rb + 16 * i; float acc[8];
#pragma unroll
            for (int j = 0; j < 8; ++j) acc[j] = cbias[j];
#pragma unroll
            for (int k = 0; k < 4; ++k) { const u32x4 v = *(const LAS u32x4*)(zt + (r + k) * ZT_STRIDE + o * 16);
                acc[0] += cw[k][0] * bflo(v.x); acc[1] += cw[k][1] * bfhi(v.x); acc[2] += cw[k][2] * bflo(v.y); acc[3] += cw[k][3] * bfhi(v.y);
                acc[4] += cw[k][4] * bflo(v.z); acc[5] += cw[k][5] * bfhi(v.z); acc[6] += cw[k][6] * bflo(v.w); acc[7] += cw[k][7] * bfhi(v.w); }
            u32x4 w; w.x = cvt_pk_bf16(acc[0], acc[1]); w.y = cvt_pk_bf16(acc[2], acc[3]); w.z = cvt_pk_bf16(acc[4], acc[5]); w.w = cvt_pk_bf16(acc[6], acc[7]);
            *(LAS u32x4*)(xc + r * ZT_STRIDE + o * 16) = w; }
    }
    __syncthreads();
    {
        const __amdgpu_buffer_rsrc_t rz = __builtin_amdgcn_make_buffer_rsrc((void*)(z8 + (size_t)t0 * 2560 + (4 + hp) * 256), 0, 0xffffffff, 0x00020000);
        const unsigned vo = (unsigned)(lane >> 4) * 2560u + (unsigned)(lane & 15) * 16u;
#pragma unroll
        for (int k = 0; k < 4; ++k) __builtin_amdgcn_raw_ptr_buffer_load_lds(rz, (LAS void*)(zt + (wave * 4 + k) * 1024), 16, vo, (unsigned)((wave * 4 + k) * 4 * 2560), 0, 0);
#if !Z_OUT_FP8
        const __amdgpu_buffer_rsrc_t rq = __builtin_amdgcn_make_buffer_rsrc((void*)(zs + (size_t)t0 * 40 + (4 + hp) * 4), 0, 0xffffffff, 0x00020000);
        __builtin_amdgcn_raw_ptr_buffer_load_lds(rq, (LAS void*)(zt + 32768 + wave * 256), 4, (unsigned)(tid >> 2) * 160u + (unsigned)(tid & 3) * 4u, 0, 0, 0);
#endif
    }
    {
        const int hsel = wave >> 2, wc = wave & 3, head = 2 * hp + hsel, c31 = lane & 31, hh = lane >> 5;
        const int ch = head * 128 + 32 * wc + c31;
        const bf16_t* wb = (const bf16_t*)(ws + WS_WRG) + ((size_t)(l * 8 + head) * 256 + 32 * wc + c31) * 128 + 8 * hh;
        bf16x8 Ba[8], Bi[8];
#pragma unroll
        for (int ks = 0; ks < 8; ++ks) { Ba[ks] = *(const bf16x8*)(wb + 16 * ks); Bi[ks] = *(const bf16x8*)(wb + 128 * 128 + 16 * ks); }
        const float ba = a.in[I_BRGA][(size_t)l * D + ch], bx = a.in[I_BRGX][(size_t)l * D + ch];
        const float lam = a.in[I_LAM][(size_t)l * D + ch];
        constexpr float NL2E = -1.4426950408889634f;
        const f32x2 gb2 = {ba * NL2E, bx * NL2E};
        const float sp8 = 8.0f * log1pf(__expf(-lam)) * NL2E;
        typedef __attribute__((address_space(1))) unsigned long long gu64;
        gu64* aggq = (gu64*)(ws + WS_AGG) + ((size_t)l * NBATCH * 32 + (size_t)b * 32) * D + ch;
        float Pr = 1.f, Hr = 0.f;
        unsigned hpk[64];
#pragma unroll
        for (int rb = 0; rb < 4; ++rb) {
            f32x16 aa, ai;
#pragma unroll
            for (int r = 0; r < 16; ++r) { aa[r] = 0.f; ai[r] = 0.f; }
            const LAS unsigned char* ap = xc + (32 * rb + c31) * ZT_STRIDE + (hsel * 128 + 8 * hh) * 2;
#pragma unroll
            for (int ks = 0; ks < 8; ++ks) { const bf16x8 A = *(const LAS bf16x8*)(ap + 32 * ks);
                aa = __builtin_amdgcn_mfma_f32_32x32x16_bf16(A, Ba[ks], aa, 0, 0, 0); ai = __builtin_amdgcn_mfma_f32_32x32x16_bf16(A, Bi[ks], ai, 0, 0, 0); }
            const LAS unsigned char* xp = xc + (32 * rb + 4 * hh) * ZT_STRIDE + (hsel * 128 + 32 * wc + c31) * 2;
#pragma unroll
            for (int q = 0; q < 4; ++q) {
                float p = 1.f, h = 0.f, hl[4], pl[4];
#pragma unroll
                for (int r3 = 0; r3 < 4; ++r3) { const int reg = 4 * q + r3;
                    const float xcv = bf1(*(const LAS bf16_t*)(xp + (8 * q + r3) * ZT_STRIDE));
                    const f32x2 x2 = (f32x2){aa[reg], ai[reg]} * NL2E + gb2; f32x2 e2 = {__builtin_amdgcn_exp2f(x2.x), __builtin_amdgcn_exp2f(x2.y)}; e2 += 1.0f;
                    const float rg = __builtin_amdgcn_rcpf(e2.x), ig = __builtin_amdgcn_rcpf(e2.y);
                    const float av = __builtin_amdgcn_exp2f(sp8 * rg); const float mult = __builtin_amdgcn_sqrtf(fmaxf(1.0f - av * av, 0.f));
                    h = av * h + mult * (ig * xcv); p *= av; hl[r3] = h; pl[r3] = p; }
                const auto sp_ = __builtin_amdgcn_permlane32_swap(__float_as_uint(p), __float_as_uint(p), false, false), sh_ = __builtin_amdgcn_permlane32_swap(__float_as_uint(h), __float_as_uint(h), false, false);
                const float A0 = __uint_as_float(sp_[0]), A1 = __uint_as_float(sp_[1]), B0 = __uint_as_float(sh_[0]), B1 = __uint_as_float(sh_[1]);
                const float P1 = Pr * A0, H1 = Hr * A0 + B0;
                const float Pst = hh ? P1 : Pr, Hst = hh ? H1 : Hr;
                Pr = P1 * A1; Hr = H1 * A1 + B1;
#pragma unroll
                for (int r3 = 0; r3 < 4; ++r3) hpk[rb * 16 + 4 * q + r3] = cvt_pk_bf16(Hst * pl[r3] + hl[r3], Pst * pl[r3]);
            }
        }
        if (hh == 0) __hip_atomic_store(aggq + (size_t)s * D, ((unsigned long long)__float_as_uint(Hr) << 32) | (unsigned long long)__float_as_uint(fmaxf(Pr, 1e-37f)), __ATOMIC_RELAXED, __HIP_MEMORY_SCOPE_AGENT);
        float cin = 0.f;
        for (int j0 = 0; j0 < s; j0 += 8) {
            unsigned long long w[8]; unsigned spins = 0;
            for (;;) { bool ok = true;
#pragma unroll
                for (int k = 0; k < 8; ++k) { const int j = (j0 + k < s) ? (j0 + k) : (s - 1); w[k] = __hip_atomic_load(aggq + (size_t)j * D, __ATOMIC_RELAXED, __HIP_MEMORY_SCOPE_AGENT); ok = ok && ((unsigned)w[k] != 0u); }
                if (__all(ok)) break;
                __builtin_amdgcn_s_sleep(4);
                if (++spins > (1u << 17)) break;
            }
#pragma unroll
            for (int k = 0; k < 8; ++k) { if (j0 + k < s) cin = __uint_as_float((unsigned)w[k]) * cin + __uint_as_float((unsigned)(w[k] >> 32)); }
        }
        asm volatile("s_waitcnt vmcnt(0)" ::: "memory");
        __syncthreads();
        const LAS unsigned char* gp = zt + (4 * hh) * 256 + (hsel * 128 + 32 * wc + c31);
        const LAS float* gsp = (const LAS float*)(zt + 32768) + (4 * hh) * 4 + hsel * 2 + (wc >> 1);
        LAS unsigned char* yp = xc + (4 * hh) * 512 + (hsel * 128 + 32 * wc + c31) * 2;
#if Z_OUT_FP8
        (void)gsp;
        constexpr float GK1 = -1.5957691216f * 1.4426950408889634f / Z_FP8_SCALE, GK2 = 0.044715f / (Z_FP8_SCALE * Z_FP8_SCALE);
        const f32x2 cin2 = {cin, cin};
#pragma unroll
        for (int rb = 0; rb < 4; ++rb) {
#pragma unroll
            for (int rp = 0; rp < 8; ++rp) { const int reg = 2 * rp; const int tok = 32 * rb + 8 * (reg >> 2) + (reg & 3);
                const unsigned pk0 = hpk[rb * 16 + reg], pk1 = hpk[rb * 16 + reg + 1];
                const f32x2 hf = (f32x2){bfhi(pk0), bfhi(pk1)} * cin2 + (f32x2){bflo(pk0), bflo(pk1)};
                const f32x2 G = {__builtin_amdgcn_cvt_f32_fp8((int)gp[tok * 256], 0), __builtin_amdgcn_cvt_f32_fp8((int)gp[(tok + 1) * 256], 0)};
                const f32x2 arg = (G * GK1) * (G * G * GK2 + 1.0f);
                f32x2 e = {__builtin_amdgcn_exp2f(arg.x), __builtin_amdgcn_exp2f(arg.y)};
                e = e * Z_FP8_SCALE + Z_FP8_SCALE;
                const f32x2 r = {__builtin_amdgcn_rcpf(e.x), __builtin_amdgcn_rcpf(e.y)};
                const f32x2 o = (hf * G) * r;
                const unsigned w = cvt_pk_bf16(o.x, o.y);
                *(LAS bf16_t*)(yp + tok * 512) = (bf16_t)(w & 0xffffu); *(LAS bf16_t*)(yp + (tok + 1) * 512) = (bf16_t)(w >> 16); }
        }
#else
#pragma unroll
        for (int rb = 0; rb < 4; ++rb) {
#pragma unroll
            for (int reg = 0; reg < 16; ++reg) { const int tok = 32 * rb + 8 * (reg >> 2) + (reg & 3);
                const unsigned pk = hpk[rb * 16 + reg];
                const float hf = bflo(pk) + bfhi(pk) * cin;
                const float g = ((float)gp[tok * 256] - 128.0f) * gsp[tok * 4];
                const float ge = g * __builtin_amdgcn_rcpf(1.0f + __expf(-1.5957691216f * (g + 0.044715f * g * g * g)));
                *(LAS bf16_t*)(yp + tok * 512) = (bf16_t)(cvt_pk_bf16(hf * ge, 0.f) & 0xffffu); }
        }
#endif
    }
    __syncthreads();
    {
        bf16_t* yo = (bf16_t*)(ws + WS_ACAT) + (size_t)t0 * KCAT + 512 + hp * 256;
        u32x4 yv[8];
#pragma unroll
        for (int k = 0; k < 8; ++k) yv[k] = *(const LAS u32x4*)(xc + ((tid >> 5) + 16 * k) * 512 + (tid & 31) * 16);
#pragma unroll
        for (int k = 0; k < 8; ++k) *(u32x4*)(yo + (size_t)((tid >> 5) + 16 * k) * KCAT + (tid & 31) * 8) = yv[k];
    }
    __syncthreads();
}
__device__ __forceinline__ void pool_unit(const Args& a, int l, int u, LAS unsigned char* lds, const int wv) {
    asm volatile("" : "+s"(lds));
    int tid_ = tid_of(wv); asm volatile("" : "+v"(tid_)); const int tid = tid_, lane = tid & 63, wave = __builtin_amdgcn_readfirstlane(tid >> 6);
    unsigned char* ws = opaque_ptr(a.ws);
    const unsigned char* z8 = (const unsigned char*)(ws + WS_Z); const float* zs = (const float*)(ws + WS_ZS);
    LAS unsigned char* zt = lds; LAS unsigned char* pt = lds + 143 * ZT_STRIDE;
    const int gp = u & 1, b = (u >> 1) & 7, s = u >> 4;
    const int t0 = b * SEQ + s * 128, p0 = s * 128;
    stage_z8<143>(z8, zs, b, p0 - 15, 8 + gp, zt, tid);
    __syncthreads();
    {
        const int o = tid & 31, rb = tid >> 5; const int g = 2 * gp + (o >> 4); const int w = 2 << g;
#pragma unroll 1
        for (int i = 0; i < 8; ++i) { const int r = rb + 16 * i; float acc[8];
#pragma unroll
            for (int j = 0; j < 8; ++j) acc[j] = 0.f;
            for (int jj = 0; jj < w; ++jj) { const u32x4 v = *(const LAS u32x4*)(zt + (r + 15 - jj) * ZT_STRIDE + o * 16);
                acc[0] += bflo(v.x); acc[1] += bfhi(v.x); acc[2] += bflo(v.y); acc[3] += bfhi(v.y); acc[4] += bflo(v.z); acc[5] += bfhi(v.z); acc[6] += bflo(v.w); acc[7] += bfhi(v.w); }
            const int cnt = (p0 + r + 1 < w) ? (p0 + r + 1) : w; const float ic = 1.0f / (float)cnt;
            const u32x4 v = *(const LAS u32x4*)(zt + (r + 15) * ZT_STRIDE + o * 16);
            const float x0[8] = {bflo(v.x), bfhi(v.x), bflo(v.y), bfhi(v.y), bflo(v.z), bfhi(v.z), bflo(v.w), bfhi(v.w)};
#pragma unroll
            for (int j = 0; j < 8; ++j) acc[j] = acc[j] * ic - x0[j];
            u32x4 wv; wv.x = cvt_pk_bf16(acc[0], acc[1]); wv.y = cvt_pk_bf16(acc[2], acc[3]); wv.z = cvt_pk_bf16(acc[4], acc[5]); wv.w = cvt_pk_bf16(acc[6], acc[7]);
            *(LAS u32x4*)(pt + r * ZT_STRIDE + o * 16) = wv; }
    }
    __syncthreads();
    {
        const int gsel = wave >> 2, wc = wave & 3, g = 2 * gp + gsel, c31 = lane & 31, hh = lane >> 5;
        const int oc = g * 128 + 32 * wc + c31;
        const bf16_t* wb = (const bf16_t*)(ws + WS_WPOOL) + ((size_t)(l * 4 + g) * 128 + 32 * wc + c31) * 128 + 8 * hh;
        bf16x8 Bf[8];
#pragma unroll
        for (int ks = 0; ks < 8; ++ks) Bf[ks] = *(const bf16x8*)(wb + 16 * ks);
        const float psc = a.in[I_PSCALE][(size_t)l * 512 + oc];
        bf16_t* yo = (bf16_t*)(ws + WS_ACAT) + (size_t)t0 * KCAT + oc;
#pragma unroll 1
        for (int rb = 0; rb < 4; ++rb) {
            f32x16 acc;
#pragma unroll
            for (int r = 0; r < 16; ++r) acc[r] = 0.f;
            const LAS unsigned char* ap = pt + (32 * rb + c31) * ZT_STRIDE + (gsel * 128 + 8 * hh) * 2;
#pragma unroll
            for (int ks = 0; ks < 8; ++ks) { const bf16x8 A = *(const LAS bf16x8*)(ap + 32 * ks); acc = __builtin_amdgcn_mfma_f32_32x32x16_bf16(A, Bf[ks], acc, 0, 0, 0); }
#pragma unroll
            for (int reg = 0; reg < 16; ++reg) { const int tok = 32 * rb + 8 * (reg >> 2) + 4 * hh + (reg & 3);
                yo[(size_t)tok * KCAT] = (bf16_t)(cvt_pk_bf16(acc[reg] * psc, 0.f) & 0xffffu); }
        }
    }
    __syncthreads();
}

constexpr int PH_PER_LAYER = 9;
constexpr int N_PHASES = 1 + DEPTH * PH_PER_LAYER + 1;

__global__ void __launch_bounds__(NTHREADS, 2) fwd_kernel(Args a) {
    extern __shared__ __attribute__((aligned(16))) unsigned char lds_raw[];
    LAS unsigned char* lds = (LAS unsigned char*)lds_raw;
    const int wv = __builtin_amdgcn_readfirstlane(threadIdx.x >> 6); const int tid = threadIdx.x; const int G = gridDim.x;
    unsigned char* ws0 = a.ws;
    unsigned* ctl = (unsigned*)(ws0 + WS_CTL);
    volatile LAS unsigned* misc = (volatile LAS unsigned*)(lds + LDS_MISC);
    if (tid < 4) misc[tid] = 0u;
    __syncthreads();
    XcdBarrier bar; bar.bar = ctl + CW_BAR; bar.x = 0; bar.st = misc; bar.wv = wv;
#if MK_PER_PHASE
    const int lo = a.ph_lo, hi = a.ph_hi;
#else
    constexpr int lo = 0, hi = N_PHASES;
#endif
    if (hi - lo > 1) bar = xcd_barrier_post(ctl + CW_BAR, misc, wv);
#define IN(k) (lo <= (k) && (k) < hi)
#define SEAM(k) do { if (IN((k) + 1)) xcd_barrier(bar); } while (0)

    if (EN(0) && IN(0)) for (int rr = 0; rr < REPN(0); ++rr) { phase_prologue(a, lds, wv); SEAM(0); }

    for (int l = 0; l < DEPTH; ++l) {
        const int pb = 1 + l * PH_PER_LAYER;
        if (EN(1) && IN(pb + 0)) for (int rr = 0; rr < REPN(1); ++rr) { unsigned char* ws = opaque_ptr(ws0); const int bid = opaque_bid(); (void)bid; (void)ws; if (l == 0) phase_a<0>(a, l, lds, rr + 1 < REPN(1), wv); else phase_a<1>(a, l, lds, rr + 1 < REPN(1), wv); SEAM(pb + 0); }
        if (EN(2) && IN(pb + 1)) for (int rr = 0; rr < REPN(2); ++rr) { unsigned char* ws = opaque_ptr(ws0); const int bid = opaque_bid(); (void)bid; (void)ws;
            #if Z_I8
            pg8::PlainSched S{(const char*)(ws + WS_H), (const char*)(ws + WS_WIN) + (size_t)l * NZ * 1024, 512, T / 256, NZ / 256, G, bid};
            pg8::EpiZI8 E{(bf16_t*)(ws + WS_Z), (float*)(ws + WS_ZS), (unsigned char*)(ws + WS_ZG), (const unsigned char*)ws, (unsigned)WS_HSC, (unsigned)(WS_WINSC + (size_t)l * NZ * 4)};
            pg8::gemm_phase<pg8::EpiZI8, pg8::PlainSched, true, 2>(lds, 512, S, E, wv);
#elif Z_FP8
            pg8::PlainSched S{(const char*)(ws + WS_H), (const char*)(ws + WS_WIN) + (size_t)l * NZ * 1024, 512, T / 256, NZ / 256, G, bid};
            pg8::EpiBf16 E{(bf16_t*)(ws + WS_Z), NZ, nullptr, (rr + 1 < REPN(2)) && (a.ph_lo == 0), 1.0f / WEIN_SCALE};
            pg8::gemm_phase<pg8::EpiBf16, pg8::PlainSched, true, 1>(lds, 512, S, E, wv);
#else
            pg8::PlainSched S{(const char*)(ws + WS_H), (const char*)(ws + WS_WIN) + (size_t)l * NZ * 1024 * 2, 1024, T / 256, NZ / 256, G, bid};
            pg8::EpiBf16 E{(bf16_t*)(ws + WS_Z), NZ, nullptr, (rr + 1 < REPN(2)) && (a.ph_lo == 0), 1.0f};
            pg8::gemm_phase<pg8::EpiBf16, pg8::PlainSched, true>(lds, 1024, S, E, wv);
#endif
            SEAM(pb + 1);
        }
        if (EN(3) && IN(pb + 2)) for (int rr = 0; rr < REPN(3); ++rr) { unsigned char* ws = opaque_ptr(ws0); const int bid = opaque_bid(); (void)bid; (void)ws;
            for (int u = bid; u < 1024 + 512; u += G) { if (u < 1024) lru_unit(a, l, u, lds, wv); else pool_unit(a, l, u - 1024, lds, wv); }
            SEAM(pb + 2);
        }
        if (EN(5) && IN(pb + 4)) for (int rr = 0; rr < REPN(5); ++rr) { unsigned char* ws = opaque_ptr(ws0); const int bid = opaque_bid(); (void)bid; (void)ws;
            pg8::PlainSched S{(const char*)(ws + WS_ACAT), (const char*)(ws + WS_WCAT) + (size_t)l * 1024 * KCAT * 2, KCAT, T / 256, D / 256, G, bid};
            pg8::EpiMerged E{(bf16_t*)(ws + WS_MERGED), (const unsigned char*)(ws + WS_ZG)};
            pg8::gemm_phase<pg8::EpiMerged, pg8::PlainSched, true>(lds, KCAT, S, E, wv);
            SEAM(pb + 4);
        }
        if (EN(6) && IN(pb + 5)) for (int rr = 0; rr < REPN(6); ++rr) { unsigned char* ws = opaque_ptr(ws0); const int bid = opaque_bid(); (void)bid; (void)ws;
#if G_FP8
            pg8::PlainSched S{(const char*)(ws + WS_MERGED), (const char*)(ws + WS_WOUT) + (size_t)l * 1024 * 1024, 512, T / 256, D / 256, G, bid};
            pg8::EpiResid E{(bf16_t*)(ws + WS_XRES), (rr + 1 < REPN(6)) ? (bf16_t*)(ws + WS_ACT) : (bf16_t*)(ws + WS_XRES), (const float*)(ws + WS_MOD) + (size_t)l * NBATCH * 6144 + 2 * D, 1.0f / (WEIN_SCALE * MRG_FP8_SCALE)};
            pg8::gemm_phase<pg8::EpiResid, pg8::PlainSched, true, 1>(lds, 512, S, E, wv);
#else
            pg8::PlainSched S{(const char*)(ws + WS_MERGED), (const char*)(ws + WS_WOUT) + (size_t)l * 1024 * 1024 * 2, 1024, T / 256, D / 256, G, bid};
            pg8::EpiResid E{(bf16_t*)(ws + WS_XRES), (rr + 1 < REPN(6)) ? (bf16_t*)(ws + WS_ACT) : (bf16_t*)(ws + WS_XRES), (const float*)(ws + WS_MOD) + (size_t)l * NBATCH * 6144 + 2 * D, 1.0f};
            pg8::gemm_phase<pg8::EpiResid, pg8::PlainSched, true>(lds, 1024, S, E, wv);
#endif
            SEAM(pb + 5);
        }
        if (EN(7) && IN(pb + 6)) for (int rr = 0; rr < REPN(7); ++rr) { unsigned char* ws = opaque_ptr(ws0); const int bid = opaque_bid(); (void)bid; (void)ws; phase_h(a, l, l + DEPTH * rr, (l > 0 && rr == 0) ? l : -1, lds, wv); SEAM(pb + 6); }
        if (EN(8) && IN(pb + 7)) for (int rr = 0; rr < REPN(8); ++rr) { unsigned char* ws = opaque_ptr(ws0); const int bid = opaque_bid(); (void)bid; (void)ws;
            moe_tables(a, l + DEPTH * (REPN(7) - 1), lds, wv);
            LAS unsigned char* lds_o = lds; asm volatile("" : "+s"(lds_o)); const MoeTab mt = moe_tab_ptrs(lds_o);
            MoeSched1 S{(const char*)(ws + WS_H), (const char*)(ws + WS_WEIN) + (size_t)l * NE * 2048 * 1024, (const int*)(ws + WS_TOKOF), mt, __builtin_amdgcn_readfirstlane(mt.tilestart[NE]), G, bid};
            pg8::EpiSwiglu E{(unsigned char*)(ws + WS_ACT), a.in[I_BEIN] + (size_t)l * NE * 2048, 1.0f / WEIN_SCALE};
            pg8::gemm_phase<pg8::EpiSwiglu, MoeSched1, true, 1>(lds, 512, S, E, wv);
            if (l + 1 < DEPTH) {
                const int nwg = S.nMt * 8, maxr = (nwg + G - 1) / G, myr = (nwg - bid + G - 1) / G;
                if (myr < maxr) conv_drain(a, l + 1, CONV_Q1, lds, wv);
            }
            SEAM(pb + 7);
        }
        if (EN(9) && IN(pb + 8)) for (int rr = 0; rr < REPN(9); ++rr) { unsigned char* ws = opaque_ptr(ws0); const int bid = opaque_bid(); (void)bid; (void)ws;
            if (REP_MASK != 0) moe_tables(a, l + DEPTH * (REPN(7) - 1), lds, wv);
            LAS unsigned char* lds_o = lds; asm volatile("" : "+s"(lds_o)); const MoeTab mt = moe_tab_ptrs(lds_o);
            MoeSched2 S{(const char*)(ws + WS_ACT), (const char*)(ws + WS_WEOUT) + (size_t)l * NE * 1024 * 1024, mt, __builtin_amdgcn_readfirstlane(mt.tilestart[NE]), G, bid};
            pg8::EpiMoeOut E{(unsigned char*)(ws + WS_OUTB), (float*)(ws + WS_OUTSC), a.in[I_BEOUT] + (size_t)l * NE * D, 1.0f / WEIN_SCALE};
            pg8::gemm_phase<pg8::EpiMoeOut, MoeSched2, true, 1>(lds, 512, S, E, wv);
            if (l + 1 < DEPTH) {
                const int nwg = S.nMt * 4, maxr = (nwg + G - 1) / G, myr = (nwg - bid + G - 1) / G;
                if (myr < maxr) conv_drain(a, l + 1, CONV_Q2, lds, wv);
            }
            SEAM(pb + 8);
        }
    }
    if (EN(10) && IN(N_PHASES - 1)) phase_a<2>(a, DEPTH, lds, false, wv);
#undef IN
#undef SEAM
}

extern "C" void kernel_launch(void* const* d_in, const int* in_sizes, int n_in, void* d_out, int out_size, void* d_ws, size_t ws_size, hipStream_t stream) {
    static int grid = 0;
    if (grid == 0) {
        if (n_in != 26 || out_size != T * D || ws_size < WS_END) { fprintf(stderr, "kernel_launch: unexpected problem (n_in %d out %d ws %zu)\n", n_in, out_size, ws_size); grid = -1; return; }
        int dev = 0, cus = 0, per_cu = 0;
        if (hipGetDevice(&dev) != hipSuccess || hipDeviceGetAttribute(&cus, hipDeviceAttributeMultiprocessorCount, dev) != hipSuccess) { grid = -1; return; }
        if (hipFuncSetAttribute((const void*)fwd_kernel, hipFuncAttributeMaxDynamicSharedMemorySize, LDS_BYTES) != hipSuccess) { fprintf(stderr, "kernel_launch: hipFuncSetAttribute failed\n"); grid = -1; return; }
        if (hipOccupancyMaxActiveBlocksPerMultiprocessor(&per_cu, (const void*)fwd_kernel, NTHREADS, LDS_BYTES) != hipSuccess || per_cu < 1) fprintf(stderr, "kernel_launch: occupancy query says %d\n", per_cu);
        (void)hipGetLastError();
        grid = cus;
    }
    if (grid < 0) return;
    static_assert(WS_AGG + AGG_BYTES == WS_CTL, "the look-back words and the control block are zeroed by ONE memset");
    if (hipMemsetAsync((char*)d_ws + WS_AGG, 0, AGG_BYTES + CTL_ZERO_BYTES, stream) != hipSuccess) return;
    Args a{};
    for (int i = 0; i < 26; ++i) a.in[i] = (const float*)d_in[i];
    a.out = (float*)d_out; a.ws = (unsigned char*)d_ws;
#if MK_PER_PHASE
    for (int p = 0; p < N_PHASES; ++p) { a.ph_lo = p; a.ph_hi = p + 1; hipLaunchKernelGGL(fwd_kernel, dim3(grid), dim3(NTHREADS), LDS_BYTES, stream, a); }
#else
    a.ph_lo = 0; a.ph_hi = N_PHASES;
    hipLaunchKernelGGL(fwd_kernel, dim3(grid), dim3(NTHREADS), LDS_BYTES, stream, a);
#endif
    const hipError_t le = hipPeekAtLastError();
    if (le != hipSuccess) fprintf(stderr, "kernel_launch: launch failed: %s\n", hipGetErrorName(le));
}
```
